# Optimizing an MI355X kernel written in HIP

```python
import math
import jax, jax.numpy as jnp
from jax import lax
import numpy as np

D_MODEL = 1024
BATCH = 2
SEQ = 16384
DEPTH = 2

N_A_LAYERS = DEPTH // 2
N_B_LAYERS = DEPTH - N_A_LAYERS

LRU_WIDTH = D_MODEL
LRU_BLOCKS = 4
LRU_BLOCK_W = LRU_WIDTH // LRU_BLOCKS
CONV_WIDTH = 4
LRU_C = 8.0

ATT_HEADS = 8
HEAD_DIM = 64
DILATION_PATTERNS = ((128, 1), (512, 4), (2048, 16))
N_GROUPS = len(DILATION_PATTERNS)
ATT_BLOCK = 128
Q_WIDTH = N_GROUPS * ATT_HEADS * HEAD_DIM
O_WIDTH = ATT_HEADS * HEAD_DIM

N_EXPERTS = 256
TOP_K = 8
N_EXPERT_GROUPS = 8
TOPK_GROUPS = 4
D_EXPERT = 256
ROUTED_SCALE = 2.5
EXPERT_BLOCK = 128

DEEPNORM_ALPHA = (2 * DEPTH) ** 0.25
DEEPNORM_BETA = (8 * DEPTH) ** -0.25
LN_EPS = 1e-5
MASK_VALUE = -1e30

kernel_name = 'yoco_rglru_dilated_attn_moe_deepnorm'


def layer_norm(x, g, b):
    xf = x.astype(jnp.float32)
    mu = jnp.mean(xf, axis=-1, keepdims=True)
    var = jnp.mean(jnp.square(xf - mu), axis=-1, keepdims=True)
    y = (xf - mu) * lax.rsqrt(var + LN_EPS)
    return (y * g.astype(jnp.float32) + b.astype(jnp.float32)).astype(x.dtype)


def _linear_combine(c1, c2):
    a1, b1 = c1
    a2, b2 = c2
    return a1 * a2, a2 * b1 + b2


def rglru_block(x, w_in, conv_w, conv_b, w_gate_a, b_gate_a, w_gate_x, b_gate_x, lam, w_out):
    B_, S_, _ = x.shape
    xz = x @ w_in
    xr, gate = jnp.split(xz, 2, axis=-1)
    xc = lax.conv_general_dilated(
        xr, conv_w[:, None, :], window_strides=(1,), padding=[(CONV_WIDTH - 1, 0)],
        dimension_numbers=('NWC', 'WIO', 'NWC'), feature_group_count=LRU_WIDTH) + conv_b
    xb = xc.reshape(B_, S_, LRU_BLOCKS, LRU_BLOCK_W)
    r = jax.nn.sigmoid(jnp.einsum('bsni,nij->bsnj', xb, w_gate_a).reshape(B_, S_, LRU_WIDTH) + b_gate_a)
    i = jax.nn.sigmoid(jnp.einsum('bsni,nij->bsnj', xb, w_gate_x).reshape(B_, S_, LRU_WIDTH) + b_gate_x)
    log_a = -LRU_C * r.astype(jnp.float32) * jax.nn.softplus(-lam.astype(jnp.float32))
    a = jnp.exp(log_a)
    mult = jnp.sqrt(-jnp.expm1(2.0 * log_a))
    u = mult * (i * xc).astype(jnp.float32)
    _, h = lax.associative_scan(_linear_combine, (a, u), axis=1)
    y = h.astype(x.dtype) * jax.nn.gelu(gate, approximate=True)
    return y @ w_out


def alibi_slopes():
    return 2.0 ** (-8.0 * jnp.arange(1, ATT_HEADS + 1, dtype=jnp.float32) / ATT_HEADS)


def dilated_branch(q, k, v, window, dilation, slopes):
    B_, S_, H, Dh = q.shape
    T = ATT_BLOCK
    n_steps = window // dilation
    span = dilation * T
    s_pad = -(-S_ // span) * span
    L = s_pad // dilation
    nb = L // T

    def to_sub(t):
        t = jnp.pad(t, ((0, 0), (0, s_pad - S_), (0, 0), (0, 0)))
        t = t.reshape(B_, L, dilation, H, Dh).transpose(0, 2, 1, 3, 4)
        return t.reshape(B_, dilation, nb, T, H, Dh)

    def with_prev(t):
        prev = jnp.pad(t[:, :, :-1], ((0, 0), (0, 0), (1, 0), (0, 0), (0, 0), (0, 0)))
        return jnp.concatenate([prev, t], axis=3)

    qs = to_sub(q)
    kb = with_prev(to_sub(k))
    vb = with_prev(to_sub(v))
    scores = jnp.einsum('brnqhd,brnkhd->brnhqk', qs, kb,
                        preferred_element_type=jnp.float32) * (HEAD_DIM ** -0.5)
    dist = (T + jnp.arange(T))[:, None] - jnp.arange(2 * T)[None, :]
    band = (dist >= 0) & (dist <= n_steps)
    not_first = (jnp.arange(nb) > 0)[:, None, None] | (jnp.arange(2 * T) >= T)[None, None, :]
    valid = band[None] & not_first
    bias = -slopes[:, None, None] * (dilation * dist).astype(jnp.float32)[None]
    scores = jnp.where(valid[:, None], scores + bias, MASK_VALUE)
    m = jnp.max(scores, axis=-1, keepdims=True)
    p = jnp.exp(scores - m)
    l = jnp.sum(p, axis=-1, keepdims=True)
    o = jnp.einsum('brnhqk,brnkhd->brnqhd', p / l, vb.astype(jnp.float32))
    lse = (m + jnp.log(l))[..., 0]
    o = o.reshape(B_, dilation, L, H, Dh).transpose(0, 2, 1, 3, 4).reshape(B_, s_pad, H, Dh)[:, :S_]
    lse = lse.transpose(0, 1, 2, 4, 3).reshape(B_, dilation, L, H).transpose(0, 2, 1, 3)
    lse = lse.reshape(B_, s_pad, H)[:, :S_]
    return o, lse


def dilated_attention(x, k_shared, v_shared, w_q, w_o, slopes):
    B_, S_, _ = x.shape
    q = (x @ w_q).reshape(B_, S_, N_GROUPS, ATT_HEADS, HEAD_DIM)
    outs, lses = [], []
    for g, (window, dil) in enumerate(DILATION_PATTERNS):
        o, lse = dilated_branch(q[:, :, g], k_shared[:, :, g], v_shared[:, :, g], window, dil, slopes)
        outs.append(o)
        lses.append(lse)
    w = jax.nn.softmax(jnp.stack(lses), axis=0)
    o = jnp.sum(w[..., None] * jnp.stack(outs), axis=0)
    return o.astype(x.dtype).reshape(B_, S_, O_WIDTH) @ w_o


def moe_ffn(x, w_router, router_bias, w1, w3, w2, ws1, ws3, ws2):
    B_, S_, D = x.shape
    N = B_ * S_
    xf = x.reshape(N, D)
    scores = jax.nn.sigmoid((xf @ w_router).astype(jnp.float32))
    biased = scores + router_bias.astype(jnp.float32)
    grp_score = jnp.sum(lax.top_k(biased.reshape(N, N_EXPERT_GROUPS, -1), 2)[0], axis=-1)
    _, grp_idx = lax.top_k(grp_score, TOPK_GROUPS)
    grp_mask = jnp.sum(jax.nn.one_hot(grp_idx, N_EXPERT_GROUPS, dtype=jnp.float32), axis=1) > 0
    expert_mask = jnp.repeat(grp_mask, N_EXPERTS // N_EXPERT_GROUPS, axis=1)
    _, top_idx = lax.top_k(jnp.where(expert_mask, biased, MASK_VALUE), TOP_K)
    top_s = jnp.take_along_axis(scores, top_idx, axis=1)
    gates = top_s / jnp.sum(top_s, axis=-1, keepdims=True) * ROUTED_SCALE

    T = EXPERT_BLOCK
    n_assign = N * TOP_K
    n_rows = -(-(n_assign + N_EXPERTS * (T - 1)) // T) * T
    n_blocks = n_rows // T
    flat_e = top_idx.reshape(-1).astype(jnp.int32)
    order = jnp.argsort(flat_e).astype(jnp.int32)
    sorted_e = flat_e[order]
    counts = jnp.zeros((N_EXPERTS,), jnp.int32).at[flat_e].add(1)
    padded = ((counts + T - 1) // T) * T
    pad_end = jnp.cumsum(padded)
    pad_start = pad_end - padded
    start = jnp.cumsum(counts) - counts
    dest = pad_start[sorted_e] + jnp.arange(n_assign, dtype=jnp.int32) - start[sorted_e]
    row_assign = jnp.full((n_rows,), n_assign, jnp.int32).at[dest].set(order)
    row_tok = row_assign // TOP_K
    block_expert = jnp.clip(jnp.searchsorted(pad_end, jnp.arange(n_blocks, dtype=jnp.int32) * T,
                                             side='right'), 0, N_EXPERTS - 1)
    x_rows = jnp.concatenate([xf, jnp.zeros((1, D), xf.dtype)], axis=0)[row_tok].reshape(n_blocks, T, D)

    def expert_block(args):
        xb, e = args
        h = jax.nn.silu(xb @ w1[e]) * (xb @ w3[e])
        return h @ w2[e]

    y_rows = lax.map(expert_block, (x_rows, block_expert)).reshape(n_rows, D)
    gate_rows = jnp.concatenate([gates.reshape(-1), jnp.zeros((1,), jnp.float32)])[row_assign]
    routed = jnp.zeros((N + 1, D), jnp.float32).at[row_tok].add(
        y_rows.astype(jnp.float32) * gate_rows[:, None])[:N]
    shared = (jax.nn.silu(xf @ ws1) * (xf @ ws3)) @ ws2
    return (routed.astype(x.dtype) + shared).reshape(B_, S_, D)


def setup_inputs(seed: int = 0) -> dict:
    key = jax.random.key(seed)
    ks = jax.random.split(key, 24)

    def nrm(k, shape, scale):
        return jax.random.normal(k, shape, jnp.float32) * scale

    x = nrm(ks[0], (BATCH, SEQ, D_MODEL), 1.0)
    a_w_in = nrm(ks[1], (N_A_LAYERS, D_MODEL, 2 * LRU_WIDTH), D_MODEL ** -0.5)
    a_conv_w = nrm(ks[2], (N_A_LAYERS, CONV_WIDTH, LRU_WIDTH), CONV_WIDTH ** -0.5)
    a_conv_b = nrm(ks[3], (N_A_LAYERS, LRU_WIDTH), 0.01)
    a_w_gate_a = nrm(ks[4], (N_A_LAYERS, LRU_BLOCKS, LRU_BLOCK_W, LRU_BLOCK_W), LRU_BLOCK_W ** -0.5)
    a_b_gate_a = nrm(ks[5], (N_A_LAYERS, LRU_WIDTH), 0.01)
    a_w_gate_x = nrm(ks[6], (N_A_LAYERS, LRU_BLOCKS, LRU_BLOCK_W, LRU_BLOCK_W), LRU_BLOCK_W ** -0.5)
    a_b_gate_x = nrm(ks[7], (N_A_LAYERS, LRU_WIDTH), 0.01)
    u = jax.random.uniform(ks[8], (N_A_LAYERS, LRU_WIDTH), jnp.float32, 0.9, 0.999)
    base = u ** (1.0 / LRU_C)
    a_lambda = jnp.log(base) - jnp.log1p(-base)
    a_w_out = nrm(ks[9], (N_A_LAYERS, LRU_WIDTH, D_MODEL), LRU_WIDTH ** -0.5 * DEEPNORM_BETA)
    w_k = nrm(ks[10], (D_MODEL, Q_WIDTH), D_MODEL ** -0.5)
    w_v = nrm(ks[11], (D_MODEL, Q_WIDTH), D_MODEL ** -0.5 * DEEPNORM_BETA)
    w_kv_shared = jnp.concatenate([w_k, w_v], axis=1)
    b_w_q = nrm(ks[12], (N_B_LAYERS, D_MODEL, Q_WIDTH), D_MODEL ** -0.5)
    b_w_o = nrm(ks[13], (N_B_LAYERS, O_WIDTH, D_MODEL), O_WIDTH ** -0.5 * DEEPNORM_BETA)
    moe_w_router = nrm(ks[14], (DEPTH, D_MODEL, N_EXPERTS), D_MODEL ** -0.5)
    moe_router_bias = nrm(ks[15], (DEPTH, N_EXPERTS), 0.01)
    moe_w1 = nrm(ks[16], (DEPTH, N_EXPERTS, D_MODEL, D_EXPERT), D_MODEL ** -0.5)
    moe_w3 = nrm(ks[17], (DEPTH, N_EXPERTS, D_MODEL, D_EXPERT), D_MODEL ** -0.5)
    moe_w2 = nrm(ks[18], (DEPTH, N_EXPERTS, D_EXPERT, D_MODEL), D_EXPERT ** -0.5 * DEEPNORM_BETA)
    moe_ws1 = nrm(ks[19], (DEPTH, D_MODEL, D_EXPERT), D_MODEL ** -0.5)
    moe_ws3 = nrm(ks[20], (DEPTH, D_MODEL, D_EXPERT), D_MODEL ** -0.5)
    moe_ws2 = nrm(ks[21], (DEPTH, D_EXPERT, D_MODEL), D_EXPERT ** -0.5 * DEEPNORM_BETA)
    ln_g = 1.0 + nrm(ks[22], (DEPTH, 2, D_MODEL), 0.02)
    ln_b = nrm(ks[23], (DEPTH, 2, D_MODEL), 0.02)
    return {'x': x, 'a_w_in': a_w_in, 'a_conv_w': a_conv_w, 'a_conv_b': a_conv_b,
            'a_w_gate_a': a_w_gate_a, 'a_b_gate_a': a_b_gate_a, 'a_w_gate_x': a_w_gate_x,
            'a_b_gate_x': a_b_gate_x, 'a_lambda': a_lambda, 'a_w_out': a_w_out,
            'w_kv_shared': w_kv_shared, 'b_w_q': b_w_q, 'b_w_o': b_w_o,
            'moe_w_router': moe_w_router, 'moe_router_bias': moe_router_bias,
            'moe_w1': moe_w1, 'moe_w3': moe_w3, 'moe_w2': moe_w2,
            'moe_ws1': moe_ws1, 'moe_ws3': moe_ws3, 'moe_ws2': moe_ws2,
            'ln_g': ln_g, 'ln_b': ln_b}


def reference(x, a_w_in, a_conv_w, a_conv_b, a_w_gate_a, a_b_gate_a, a_w_gate_x, a_b_gate_x,
              a_lambda, a_w_out, w_kv_shared, b_w_q, b_w_o, moe_w_router, moe_router_bias,
              moe_w1, moe_w3, moe_w2, moe_ws1, moe_ws3, moe_ws2, ln_g, ln_b):
    B_, S_, _ = x.shape
    slopes = alibi_slopes()
    h = x
    k_shared = None
    v_shared = None
    for layer in range(DEPTH):
        if layer < N_A_LAYERS:
            i = layer
            mix = rglru_block(h, a_w_in[i], a_conv_w[i], a_conv_b[i], a_w_gate_a[i], a_b_gate_a[i],
                              a_w_gate_x[i], a_b_gate_x[i], a_lambda[i], a_w_out[i])
        else:
            j = layer - N_A_LAYERS
            mix = dilated_attention(h, k_shared, v_shared, b_w_q[j], b_w_o[j], slopes)
        h = layer_norm(DEEPNORM_ALPHA * h + mix, ln_g[layer, 0], ln_b[layer, 0])
        ffn = moe_ffn(h, moe_w_router[layer], moe_router_bias[layer], moe_w1[layer], moe_w3[layer],
                      moe_w2[layer], moe_ws1[layer], moe_ws3[layer], moe_ws2[layer])
        h = layer_norm(DEEPNORM_ALPHA * h + ffn, ln_g[layer, 1], ln_b[layer, 1])
        if layer == N_A_LAYERS - 1:
            kv = (h @ w_kv_shared).reshape(B_, S_, 2, N_GROUPS, ATT_HEADS, HEAD_DIM)
            k_shared = kv[:, :, 0]
            v_shared = kv[:, :, 1]
    return h
```

```cpp
#include <hip/hip_runtime.h>
#include <cstdio>
#include <cstdint>

#ifndef MK_ONE_LAUNCH
#define MK_ONE_LAUNCH 0
#endif

constexpr int D = 1024, BATCH = 2, SEQ = 16384, M = BATCH * SEQ;
constexpr int NE = 256, TOPK = 8, DE = 256;
constexpr int HEADS = 8, HD = 64, QW = 1536, OW = 512;
constexpr float LN_EPS = 1e-5f, ALPHA = 1.41421356237f;
constexpr int RBMAX = 1024 + 256 + 128;
constexpr int NWG = 256, NTHR = 512, NWAVES = 8;
constexpr int NGW = NWG * NWAVES, NGT = NWG * NTHR;

constexpr size_t MiB = 1u << 20;
constexpr size_t WS_CTL = 0, CTL_ZERO_BYTES = 1 * MiB;
constexpr size_t WS_HIST = 1 * MiB, WS_BLKE = 1 * MiB + 512 * 1024, WS_META = 1 * MiB + 768 * 1024;
constexpr size_t WS_ROWA = 2 * MiB, WS_TOPI = 4 * MiB, WS_GATE = 5 * MiB, WS_CHP = 6 * MiB, WS_CHH = 8 * MiB, WS_CIN = 10 * MiB, WS_LSE = 12 * MiB;
constexpr size_t WS_WIN = 16 * MiB, WS_WG = 20 * MiB, WS_WOUT = 21 * MiB, WS_WQK = 23 * MiB, WS_WV = 29 * MiB, WS_WO = 32 * MiB, WS_WR = 33 * MiB;
constexpr size_t WS_LOGITS = 34 * MiB;
constexpr size_t WS_W13 = 66 * MiB, WS_W2 = 323 * MiB;
constexpr size_t WS_V = 452 * MiB, WS_HA = 580 * MiB, WS_HAB = 708 * MiB, WS_HB = 772 * MiB, WS_HBB = 900 * MiB, WS_HID = 964 * MiB;
constexpr size_t WS_RA = 1140 * MiB;
constexpr size_t RA_XB = 0, RA_XR = 64 * MiB, RA_GG = 128 * MiB, RA_XC = 192 * MiB, RA_LA = 256 * MiB, RA_U = 384 * MiB, RA_YB = 512 * MiB;
constexpr size_t RA_QK = 0, RA_VT = 192 * MiB, RA_OG = 288 * MiB, RA_OM = 384 * MiB;
constexpr size_t WS_END = 1716 * MiB;

constexpr int LDS_BYTES = 147456;

#define GAS __attribute__((address_space(1)))
#define LAS __attribute__((address_space(3)))
typedef unsigned short bf16;
typedef unsigned u32x4 __attribute__((ext_vector_type(4)));
typedef unsigned u32x2 __attribute__((ext_vector_type(2)));
typedef float f32x4 __attribute__((ext_vector_type(4)));
typedef float f32x16 __attribute__((ext_vector_type(16)));
typedef short bf16x8 __attribute__((ext_vector_type(8)));
typedef GAS unsigned gu32;
#define RLX_AGENT __ATOMIC_RELAXED, __HIP_MEMORY_SCOPE_AGENT
#define LDS_WAIT() asm volatile("s_waitcnt lgkmcnt(0)" ::: "memory")
#define VM_WAIT() asm volatile("s_waitcnt vmcnt(0)" ::: "memory")

__device__ __forceinline__ unsigned pk2(float lo, float hi) { unsigned r; asm("v_cvt_pk_bf16_f32 %0, %1, %2" : "=v"(r) : "v"(lo), "v"(hi)); return r; }
__device__ __forceinline__ float bf_lo(unsigned w) { return __uint_as_float(w << 16); }
__device__ __forceinline__ float bf_hi(unsigned w) { return __uint_as_float(w & 0xffff0000u); }
__device__ __forceinline__ float wave_sum(float v) {
#pragma unroll
    for (int o = 1; o < 64; o <<= 1) v += __shfl_xor(v, o);
    return v;
}
__device__ __forceinline__ float gelu_tanh(float x) {
    const float u = 0.7978845608028654f * (x + 0.044715f * x * x * x);
    const float e = __expf(2.0f * u);
    const float t = 1.0f - 2.0f / (e + 1.0f);
    return 0.5f * x * (1.0f + t);
}
__device__ __forceinline__ float sigmoidf_(float x) { return 1.0f / (1.0f + __expf(-x)); }

#define XB_TMO      128
#define XB_XCNT(j)  (256  + 64 * (j))
#define XB_XSUB(j)  (1280 + 64 * (j))
#define XB_XGEN(j)  (2304 + 64 * (j))
#define XB_TOP      3328
#define XB_TOPGEN   3392
#define XCD_BAR_WORDS 3456
#define XB_SPIN_CAP (1u << 18)
__device__ __forceinline__ unsigned xb_ld(unsigned* p)              { return __hip_atomic_load(p, __ATOMIC_RELAXED, __HIP_MEMORY_SCOPE_AGENT); }
__device__ __forceinline__ unsigned xb_add(unsigned* p, unsigned v) { return __hip_atomic_fetch_add(p, v, __ATOMIC_RELAXED, __HIP_MEMORY_SCOPE_AGENT); }
__device__ __forceinline__ unsigned xb_xcc_id() { return (unsigned)__builtin_amdgcn_s_getreg((3 << 11) | 20) & 0xFu; }
#define XB_SPIN(cond, bar) do { unsigned _sp = 0; while (cond) { __builtin_amdgcn_s_sleep(1); \
    if ((++_sp & 255u) == 0u) { if (xb_ld(&(bar)[XB_TMO])) break; if (_sp > XB_SPIN_CAP) { atomicAdd(&(bar)[XB_TMO], 1u); break; } } } } while (0)
struct XcdBarrier { unsigned* bar; unsigned x; volatile LAS unsigned* st; };
__device__ __forceinline__ XcdBarrier xcd_barrier_post(unsigned* bar, volatile LAS unsigned* st) {
    XcdBarrier b; b.bar = bar; b.x = xb_xcc_id(); b.st = st;
    if (threadIdx.x == 0) (void)xb_add(&bar[XB_XCNT(b.x)], 1u);
    return b;
}
__device__ __forceinline__ void xcd_barrier_complete(unsigned* bar, unsigned x, unsigned& nloc, unsigned& nx) {
    const unsigned G = gridDim.x * gridDim.y * gridDim.z;
    unsigned sum, cnt, mine, sp = 0u;
    for (;;) {
        sum = 0u; cnt = 0u; mine = 0u;
#pragma unroll
        for (unsigned j = 0; j < 16; ++j) { const unsigned c = xb_ld(&bar[XB_XCNT(j)]); sum += c; cnt += (c > 0u) ? 1u : 0u; mine = (j == x) ? c : mine; }
        if (sum == G) break;
        __builtin_amdgcn_s_sleep(1);
        if ((++sp & 255u) == 0u) { if (xb_ld(&bar[XB_TMO])) break; if (sp > XB_SPIN_CAP) { atomicAdd(&bar[XB_TMO], 1u); break; } }
    }
    nloc = mine > 0u ? mine : 1u; nx = cnt > 0u ? cnt : 1u;
}
__device__ __forceinline__ void xcd_barrier(const XcdBarrier& b) {
    asm volatile("s_waitcnt vmcnt(0)" ::: "memory");
    __syncthreads();
    if (threadIdx.x == 0) {
        unsigned* bar = b.bar;
        __builtin_amdgcn_s_waitcnt(0);
        unsigned nloc = b.st[0], nx = b.st[1];
        if (nloc == 0u) { xcd_barrier_complete(bar, b.x, nloc, nx); b.st[0] = nloc; b.st[1] = nx; }
        const unsigned old = xb_add(&bar[XB_XSUB(b.x)], 1u);
        const unsigned gen = old / nloc;
        if (old + 1u == (gen + 1u) * nloc) {
            __builtin_amdgcn_fence(__ATOMIC_RELEASE, "agent");
            asm volatile("s_waitcnt vmcnt(0)" ::: "memory");
            const unsigned og = xb_add(&bar[XB_TOP], 1u);
            const unsigned tg = og / nx;
            if (og + 1u == (tg + 1u) * nx) xb_add(&bar[XB_TOPGEN], 1u);
            else XB_SPIN(xb_ld(&bar[XB_TOPGEN]) == tg, bar);
            __builtin_amdgcn_fence(__ATOMIC_ACQUIRE, "agent");
            xb_add(&bar[XB_XGEN(b.x)], 1u);
            asm volatile("s_waitcnt vmcnt(0)" ::: "memory");
        } else {
            XB_SPIN(xb_ld(&bar[XB_XGEN(b.x)]) == gen, bar);
            __builtin_amdgcn_fence(__ATOMIC_ACQUIRE, "agent");
            asm volatile("s_waitcnt vmcnt(0)" ::: "memory");
        }
    }
    __syncthreads();
}

struct Args { const float* in[23]; float* out; unsigned char* ws; int ph_lo, ph_hi; };
static_assert(sizeof(Args) == 23 * 8 + 8 + 8 + 8, "Args has no padding");
struct Frame {
    LAS unsigned char* lds;
    int tid, lane, wave, vcu;
    unsigned char* ws;
};
#define WSP(T, off) ((T*)(F.ws + (off)))

template <class S, class E>
__device__ __forceinline__ void gemm_simple(LAS unsigned char* lds, const S& sch, const E& epi) {
    const int tid = threadIdx.x, wid = tid >> 6, lane = tid & 63, wr = wid >> 2, wc = wid & 3, fr = lane & 15, fq = lane >> 4;
    constexpr int PITCH = 144;
    LAS unsigned char* As = lds; LAS unsigned char* Bs = lds + 256 * PITCH;
    typename S::U u;
    for (int i = 0; sch.next(i, u); ++i) {
        f32x4 acc[2][2][4][2];
#pragma unroll
        for (int a = 0; a < 2; ++a)
#pragma unroll
            for (int b = 0; b < 2; ++b)
#pragma unroll
                for (int m = 0; m < 4; ++m)
#pragma unroll
                    for (int n = 0; n < 2; ++n) acc[a][b][m][n] = (f32x4){0.f, 0.f, 0.f, 0.f};
        const int nt = sch.K(u) / 64;
        const char* pa[4]; const char* pb[4];
#pragma unroll
        for (int j = 0; j < 4; ++j) { const int row = (tid >> 3) + 64 * j; pa[j] = sch.rowA(u, row) + (tid & 7) * 16; pb[j] = sch.rowB(u, row) + (tid & 7) * 16; }
        for (int kt = 0; kt < nt; ++kt) {
            u32x4 va[4], vb[4];
#pragma unroll
            for (int j = 0; j < 4; ++j) { va[j] = *(const u32x4*)(pa[j] + kt * 128); vb[j] = *(const u32x4*)(pb[j] + kt * 128); }
            __syncthreads();
#pragma unroll
            for (int j = 0; j < 4; ++j) { const int row = (tid >> 3) + 64 * j;
                *(LAS u32x4*)(As + row * PITCH + (tid & 7) * 16) = va[j]; *(LAS u32x4*)(Bs + row * PITCH + (tid & 7) * 16) = vb[j]; }
            __syncthreads();
#pragma unroll
            for (int kk = 0; kk < 2; ++kk) {
                bf16x8 Bf[2][2];
#pragma unroll
                for (int b = 0; b < 2; ++b)
#pragma unroll
                    for (int n = 0; n < 2; ++n) Bf[b][n] = *(const LAS bf16x8*)(Bs + (b * 128 + wc * 32 + n * 16 + fr) * PITCH + kk * 64 + fq * 16);
#pragma unroll
                for (int a = 0; a < 2; ++a) {
                    bf16x8 Af[4];
#pragma unroll
                    for (int m = 0; m < 4; ++m) Af[m] = *(const LAS bf16x8*)(As + (a * 128 + wr * 64 + m * 16 + fr) * PITCH + kk * 64 + fq * 16);
#pragma unroll
                    for (int b = 0; b < 2; ++b)
#pragma unroll
                        for (int m = 0; m < 4; ++m)
#pragma unroll
                            for (int n = 0; n < 2; ++n) acc[a][b][m][n] = __builtin_amdgcn_mfma_f32_16x16x32_bf16(Bf[b][n], Af[m], acc[a][b][m][n], 0, 0, 0);
                }
            }
        }
        epi(acc, u, wr, wc, fr, fq);
    }
    __syncthreads();
}
#define GEMM_PHASE(lds, S, E) gemm_simple(lds, S, E)

#define ROWLOOP _Pragma("unroll") for (int ai = 0; ai < 2; ++ai) _Pragma("unroll") for (int m = 0; m < 4; ++m)
#define UROW (ai * 128 + wr * 64 + m * 16 + fr)
#define UCOL(bj, n) ((bj) * 128 + wc * 32 + (n) * 16 + 4 * fq)
typedef f32x4 AccT[2][2][4][2];

struct UnitD { int pm, pn; };
struct SchedDense {
    typedef UnitD U;
    const bf16* A; const bf16* Bt; int lda, ldb, Kk, nM, nN, vcu;
    __device__ __forceinline__ bool next(int i, U& u) const { const int L = i * NWG + vcu; if (L >= nM * nN) return false; u.pm = L / nN; u.pn = L % nN; return true; }
    __device__ __forceinline__ int K(const U&) const { return Kk; }
    __device__ __forceinline__ const char* rowA(const U& u, int r) const { return (const char*)(A + (size_t)(u.pm * 256 + r) * lda); }
    __device__ __forceinline__ const char* rowB(const U& u, int r) const { return (const char*)(Bt + (size_t)(u.pn * 256 + r) * ldb); }
};
struct EpiXZ {
    bf16* XR; bf16* GG;
    __device__ __forceinline__ void operator()(const AccT& acc, const UnitD& u, int wr, int wc, int fr, int fq) const {
        const bool isg = u.pn >= 4; bf16* base = isg ? GG : XR; const int c0 = (u.pn & 3) * 256;
        ROWLOOP { bf16* rp = base + (size_t)(u.pm * 256 + UROW) * D + c0;
#pragma unroll
            for (int bj = 0; bj < 2; ++bj)
#pragma unroll
                for (int n = 0; n < 2; ++n) { f32x4 v = acc[ai][bj][m][n];
                    if (isg) { v.x = gelu_tanh(v.x); v.y = gelu_tanh(v.y); v.z = gelu_tanh(v.z); v.w = gelu_tanh(v.w); }
                    u32x2 w; w.x = pk2(v.x, v.y); w.y = pk2(v.z, v.w); *(u32x2*)(rp + UCOL(bj, n)) = w; } }
    }
};
struct EpiResF32 {
    const float* R; float* O; int ldc;
    __device__ __forceinline__ void operator()(const AccT& acc, const UnitD& u, int wr, int wc, int fr, int fq) const {
        ROWLOOP { const size_t ro = (size_t)(u.pm * 256 + UROW) * ldc + u.pn * 256;
#pragma unroll
            for (int bj = 0; bj < 2; ++bj)
#pragma unroll
                for (int n = 0; n < 2; ++n) { const f32x4 r = *(const f32x4*)(R + ro + UCOL(bj, n)); *(f32x4*)(O + ro + UCOL(bj, n)) = r * ALPHA + acc[ai][bj][m][n]; } }
    }
};
struct EpiF32 {
    float* O; int ldc;
    __device__ __forceinline__ void operator()(const AccT& acc, const UnitD& u, int wr, int wc, int fr, int fq) const {
        ROWLOOP { const size_t ro = (size_t)(u.pm * 256 + UROW) * ldc + u.pn * 256;
#pragma unroll
            for (int bj = 0; bj < 2; ++bj)
#pragma unroll
                for (int n = 0; n < 2; ++n) *(f32x4*)(O + ro + UCOL(bj, n)) = acc[ai][bj][m][n]; }
    }
};

struct UnitG { int pm, blk, pn; };
struct SchedGate {
    typedef UnitG U;
    const bf16* XC; const bf16* WgT; int vcu;
    __device__ __forceinline__ bool next(int i, U& u) const { const int L = i * NWG + vcu; if (L >= 128 * 8) return false; u.pm = L >> 3; u.blk = (L >> 1) & 3; u.pn = L & 1; return true; }
    __device__ __forceinline__ int K(const U&) const { return 256; }
    __device__ __forceinline__ const char* rowA(const U& u, int r) const { return (const char*)(XC + (size_t)(u.pm * 256 + r) * D + u.blk * 256); }
    __device__ __forceinline__ const char* rowB(const U& u, int r) const { return (const char*)(WgT + (size_t)(u.blk * 512 + u.pn * 256 + r) * 256); }
};
struct EpiGate {
    const bf16* XC; const float *ba, *bx, *lam; float* LA; float* UU;
    __device__ __forceinline__ void operator()(const AccT& acc, const UnitG& u, int wr, int wc, int fr, int fq) const {
#pragma unroll
        for (int n = 0; n < 2; ++n) { const int c0 = u.blk * 256 + u.pn * 128 + wc * 32 + n * 16 + 4 * fq;
            const f32x4 vba = *(const f32x4*)(ba + c0), vbx = *(const f32x4*)(bx + c0), vl = *(const f32x4*)(lam + c0);
            f32x4 sp;
#pragma unroll
            for (int j = 0; j < 4; ++j) sp[j] = 8.0f * log1pf(__expf(-vl[j]));
            ROWLOOP { const size_t ro = (size_t)(u.pm * 256 + UROW) * D + c0;
                const u32x2 xw = *(const u32x2*)(XC + ro); const f32x4 xc = {bf_lo(xw.x), bf_hi(xw.x), bf_lo(xw.y), bf_hi(xw.y)};
                const f32x4 ga = acc[ai][0][m][n] + vba, gx = acc[ai][1][m][n] + vbx; f32x4 la, uu;
#pragma unroll
                for (int j = 0; j < 4; ++j) { const float r = sigmoidf_(ga[j]), ig = sigmoidf_(gx[j]); const float l = -r * sp[j]; la[j] = l;
                    const float mult = sqrtf(-expm1f(2.0f * l)); uu[j] = mult * ig * xc[j]; }
                *(f32x4*)(LA + ro) = la; *(f32x4*)(UU + ro) = uu; } }
    }
};

struct UnitE { int rb, pn, e; };
struct SchedG1 {
    typedef UnitE U;
    const bf16* X; const bf16* W13T; const int* ROWA; const int* BLKE; int nrbt, vcu;
    __device__ __forceinline__ bool next(int i, U& u) const { const int rb = (i >> 1) * NWG + vcu; if (rb >= nrbt) return false; u.rb = rb; u.pn = i & 1; u.e = BLKE[rb]; return true; }
    __device__ __forceinline__ int K(const U&) const { return D; }
    __device__ __forceinline__ const char* rowA(const U& u, int r) const { const int a = ROWA[u.rb * 256 + r]; const int tok = a < 0 ? 0 : (a < 8 * M ? (a >> 3) : a - 8 * M); return (const char*)(X + (size_t)tok * D); }
    __device__ __forceinline__ const char* rowB(const U& u, int r) const { return (const char*)(W13T + ((size_t)u.e * 512 + u.pn * 256 + r) * D); }
};
struct EpiSwiGLU {
    bf16* HID;
    __device__ __forceinline__ void operator()(const AccT& acc, const UnitE& u, int wr, int wc, int fr, int fq) const {
        ROWLOOP { bf16* rp = HID + (size_t)(u.rb * 256 + UROW) * DE + u.pn * 128;
#pragma unroll
            for (int n = 0; n < 2; ++n) { const f32x4 a = acc[ai][0][m][n], b = acc[ai][1][m][n]; f32x4 h;
#pragma unroll
                for (int j = 0; j < 4; ++j) h[j] = a[j] * sigmoidf_(a[j]) * b[j];
                u32x2 w; w.x = pk2(h.x, h.y); w.y = pk2(h.z, h.w); *(u32x2*)(rp + wc * 32 + n * 16 + 4 * fq) = w; } }
    }
};
struct SchedG2 {
    typedef UnitE U;
    const bf16* HID; const bf16* W2T; const int* BLKE; int nrbt, vcu;
    __device__ __forceinline__ bool next(int i, U& u) const { const int rb = (i >> 2) * NWG + vcu; if (rb >= nrbt) return false; u.rb = rb; u.pn = i & 3; u.e = BLKE[rb]; return true; }
    __device__ __forceinline__ int K(const U&) const { return DE; }
    __device__ __forceinline__ const char* rowA(const U& u, int r) const { return (const char*)(HID + (size_t)(u.rb * 256 + r) * DE); }
    __device__ __forceinline__ const char* rowB(const U& u, int r) const { return (const char*)(W2T + ((size_t)u.e * D + u.pn * 256 + r) * DE); }
};
struct EpiScatter {
    bf16* YA; const int* ROWA;
    __device__ __forceinline__ void operator()(const AccT& acc, const UnitE& u, int wr, int wc, int fr, int fq) const {
        ROWLOOP { const int a = ROWA[u.rb * 256 + UROW];
            if (a >= 0) { bf16* rp = YA + (size_t)a * D + u.pn * 256;
#pragma unroll
                for (int bj = 0; bj < 2; ++bj)
#pragma unroll
                    for (int n = 0; n < 2; ++n) { const f32x4 v = acc[ai][bj][m][n]; u32x2 w; w.x = pk2(v.x, v.y); w.y = pk2(v.z, v.w); *(u32x2*)(rp + UCOL(bj, n)) = w; } } }
    }
};

__device__ __forceinline__ int rho_to_tok(int rho, int g) { const int sh = 14 - 2 * g; const int rp = rho & 16383; return (rho & ~16383) + (rp >> sh) + ((rp & ((1 << sh) - 1)) << (2 * g)); }
__device__ __forceinline__ int tok_to_rho(int t, int g) { const int sh = 14 - 2 * g; const int tp = t & 16383; return (t & ~16383) + ((tp & ((1 << (2 * g)) - 1)) << sh) + (tp >> (2 * g)); }
struct UnitQ { int type, g, pm, pn; };
struct SchedQKV {
    typedef UnitQ U;
    const bf16* X; const bf16* WqkT; const bf16* WvT; int vcu;
    __device__ __forceinline__ bool next(int i, U& u) const { const int L = i * NWG + vcu; if (L >= 2304) return false;
        const bool qk = L < 1536; const int L2 = L - 1536;
        const int type = qk ? 0 : 1, g = qk ? (L >> 9) : (L2 >> 8), pm = qk ? ((L & 511) >> 2) : (L2 & 1), pn = qk ? (L & 3) : ((L2 & 255) >> 1);
        u.type = type; u.g = g; u.pm = pm; u.pn = pn; return true; }
    __device__ __forceinline__ int K(const U&) const { return D; }
    __device__ __forceinline__ const char* rowA(const U& u, int r) const {
        if (u.type == 0) return (const char*)(X + (size_t)rho_to_tok(u.pm * 256 + r, u.g) * D);
        return (const char*)(WvT + ((size_t)u.g * 512 + u.pm * 256 + r) * D); }
    __device__ __forceinline__ const char* rowB(const U& u, int r) const {
        if (u.type == 0) return (const char*)(WqkT + ((size_t)u.g * 1024 + u.pn * 256 + r) * D);
        return (const char*)(X + (size_t)rho_to_tok(u.pn * 256 + r, u.g) * D); }
};
struct EpiQKV {
    bf16* QK; bf16* VT;
    __device__ __forceinline__ void operator()(const AccT& acc, const UnitQ& u, int wr, int wc, int fr, int fq) const {
        bf16* base; size_t ldc;
        if (u.type == 0) { base = QK + (size_t)u.g * M * 1024; ldc = 1024; } else { base = VT + (size_t)u.g * 512 * M; ldc = M; }
        ROWLOOP { bf16* rp = base + (size_t)(u.pm * 256 + UROW) * ldc + u.pn * 256;
#pragma unroll
            for (int bj = 0; bj < 2; ++bj)
#pragma unroll
                for (int n = 0; n < 2; ++n) { const f32x4 v = acc[ai][bj][m][n]; u32x2 w; w.x = pk2(v.x, v.y); w.y = pk2(v.z, v.w); *(u32x2*)(rp + UCOL(bj, n)) = w; } }
    }
};

__device__ __forceinline__ void tr_item(const float* src, int spitch, bf16* dst, int dpitch, LAS float* scr, int lane) {
#pragma unroll 4
    for (int i = 0; i < 16; ++i) { const int k = 4 * i + (lane >> 4), n4 = (lane & 15) * 4; const f32x4 v = *(const f32x4*)(src + (size_t)k * spitch + n4);
        LAS float* s = scr + k * 65 + n4; s[0] = v.x; s[1] = v.y; s[2] = v.z; s[3] = v.w; }
    LDS_WAIT(); asm volatile("" ::: "memory");
    const int c = lane & 7;
#pragma unroll
    for (int j = 0; j < 8; ++j) { const int n = 8 * j + (lane >> 3); const LAS float* s = scr + (8 * c) * 65 + n;
        u32x4 o; o.x = pk2(s[0], s[65]); o.y = pk2(s[2 * 65], s[3 * 65]); o.z = pk2(s[4 * 65], s[5 * 65]); o.w = pk2(s[6 * 65], s[7 * 65]);
        *(u32x4*)(dst + (size_t)n * dpitch + 8 * c) = o; }
    LDS_WAIT(); asm volatile("" ::: "memory");
}
template <class RowMap>
__device__ __forceinline__ void tr_matrix(Frame& F, const float* W, int K, int N, bf16* WT, int dpitch, RowMap drow) {
    LAS float* scr = (LAS float*)(F.lds + F.wave * 16640);
    const int nkb = K / 64, nnb = N / 64;
    for (int it = F.vcu * NWAVES + F.wave; it < nkb * nnb; it += NGW) { const int kb = it / nnb, nb = it % nnb;
        tr_item(W + (size_t)(kb * 64) * N + nb * 64, N, WT + (size_t)drow(nb * 64) * dpitch + kb * 64, dpitch, scr, F.lane); }
}
__device__ __forceinline__ void convert_experts(Frame& F, const float* w1, const float* w3, const float* w2, const float* s1, const float* s3, const float* s2) {
    LAS float* scr = (LAS float*)(F.lds + F.wave * 16640);
    bf16* W13T = WSP(bf16, WS_W13); bf16* W2T = WSP(bf16, WS_W2);
    for (int it = F.vcu * NWAVES + F.wave; it < 257 * 192; it += NGW) {
        const int e = it / 192, r = it % 192, which = r >> 6, tile = r & 63;
        if (which < 2) {
            const float* W = (e < 256) ? (which == 0 ? w1 : w3) + (size_t)e * (size_t)(D * DE) : (which == 0 ? s1 : s3);
            const int kb = tile >> 2, nb = tile & 3; const int drow = (nb >> 1) * 256 + which * 128 + (nb & 1) * 64;
            tr_item(W + (size_t)(kb * 64) * DE + nb * 64, DE, W13T + ((size_t)e * 512 + drow) * D + kb * 64, D, scr, F.lane);
        } else {
            const float* W = (e < 256) ? w2 + (size_t)e * (size_t)(DE * D) : s2;
            const int kb = tile >> 4, nb = tile & 15;
            tr_item(W + (size_t)(kb * 64) * D + nb * 64, D, W2T + ((size_t)e * D + nb * 64) * DE + kb * 64, DE, scr, F.lane);
        }
    }
}
struct MapId { __device__ int operator()(int n0) const { return n0; } };
struct MapGate { int which; __device__ int operator()(int n0) const { return (n0 >> 7) * 256 + which * 128 + (n0 & 127); } };
struct MapQ { __device__ int operator()(int n0) const { return (n0 >> 9) * 1024 + (n0 & 511); } };
struct MapKV { __device__ int operator()(int n0) const { return n0 < 1536 ? (n0 >> 9) * 1024 + 512 + (n0 & 511) : 3072 + (n0 - 1536); } };

__device__ __forceinline__ void p0_prologue(Frame& F, const Args& A) {
    { const float* x = A.in[0]; bf16* XB = WSP(bf16, WS_RA + RA_XB);
      for (size_t i = (size_t)F.vcu * NTHR + F.tid; i < (size_t)M * D / 8; i += NGT) { const f32x4 a = *(const f32x4*)(x + i * 8), b = *(const f32x4*)(x + i * 8 + 4);
          u32x4 o; o.x = pk2(a.x, a.y); o.y = pk2(a.z, a.w); o.z = pk2(b.x, b.y); o.w = pk2(b.z, b.w); *(u32x4*)(XB + i * 8) = o; } }
    tr_matrix(F, A.in[1], D, 2048, WSP(bf16, WS_WIN), D, MapId());
    for (int b = 0; b < 4; ++b) { tr_matrix(F, A.in[4] + b * 65536, 256, 256, WSP(bf16, WS_WG) + (size_t)b * 512 * 256, 256, MapGate{0});
                                  tr_matrix(F, A.in[6] + b * 65536, 256, 256, WSP(bf16, WS_WG) + (size_t)b * 512 * 256, 256, MapGate{1}); }
    tr_matrix(F, A.in[9], D, D, WSP(bf16, WS_WOUT), D, MapId());
    tr_matrix(F, A.in[11], D, QW, WSP(bf16, WS_WQK), D, MapQ());
    tr_matrix(F, A.in[10], D, 2 * QW, WSP(bf16, WS_WQK), D, MapKV());
    tr_matrix(F, A.in[12], OW, D, WSP(bf16, WS_WO), OW, MapId());
    for (int l = 0; l < 2; ++l) tr_matrix(F, A.in[13] + (size_t)l * D * NE, D, NE, WSP(bf16, WS_WR) + (size_t)l * NE * D, D, MapId());
    convert_experts(F, A.in[15], A.in[16], A.in[17], A.in[18], A.in[19], A.in[20]);
}
static_assert(WS_WV == WS_WQK + (size_t)3072 * 1024 * 2, "WvT must follow WqkT");

__device__ __forceinline__ void ln_store(f32x4 (&v)[4], const float* g, const float* b, float* of, bf16* ob, int lane) {
    float s = 0.f;
#pragma unroll
    for (int j = 0; j < 4; ++j) s += (v[j].x + v[j].y) + (v[j].z + v[j].w);
    const float mean = wave_sum(s) * (1.f / D); float s2 = 0.f;
#pragma unroll
    for (int j = 0; j < 4; ++j) { v[j] = v[j] - mean; s2 += (v[j].x * v[j].x + v[j].y * v[j].y) + (v[j].z * v[j].z + v[j].w * v[j].w); }
    const float rstd = 1.f / sqrtf(wave_sum(s2) * (1.f / D) + LN_EPS);
#pragma unroll
    for (int j = 0; j < 4; ++j) { const int c = 4 * lane + 256 * j; const f32x4 gg = *(const f32x4*)(g + c), bb = *(const f32x4*)(b + c); const f32x4 y = v[j] * rstd * gg + bb;
        if (of) *(f32x4*)(of + c) = y;
        if (ob) { u32x2 w; w.x = pk2(y.x, y.y); w.y = pk2(y.z, y.w); *(u32x2*)(ob + c) = w; } }
}

__device__ __forceinline__ void p_conv(Frame& F, const float* cw, const float* cb) {
    const bf16* XR = WSP(bf16, WS_RA + RA_XR); bf16* XC = WSP(bf16, WS_RA + RA_XC);
    for (int i = F.vcu * NTHR + F.tid; i < M * (D / 8); i += NGT) { const int t = i >> 7, c = (i & 127) * 8; const int ts = t & (SEQ - 1);
        float a[8];
#pragma unroll
        for (int q = 0; q < 8; ++q) a[q] = cb[c + q];
#pragma unroll
        for (int j = 0; j < 4; ++j) { if (ts - 3 + j >= 0) { const u32x4 w = *(const u32x4*)(XR + (size_t)(t - 3 + j) * D + c); const float* wj = cw + j * D + c;
            a[0] += wj[0] * bf_lo(w.x); a[1] += wj[1] * bf_hi(w.x); a[2] += wj[2] * bf_lo(w.y); a[3] += wj[3] * bf_hi(w.y);
            a[4] += wj[4] * bf_lo(w.z); a[5] += wj[5] * bf_hi(w.z); a[6] += wj[6] * bf_lo(w.w); a[7] += wj[7] * bf_hi(w.w); } }
        u32x4 o; o.x = pk2(a[0], a[1]); o.y = pk2(a[2], a[3]); o.z = pk2(a[4], a[5]); o.w = pk2(a[6], a[7]); *(u32x4*)(XC + (size_t)t * D + c) = o; }
}
constexpr int CH = 64, NCH = SEQ / CH;
__device__ __forceinline__ void p_scan1(Frame& F) {
    const float* LA = WSP(float, WS_RA + RA_LA); const float* UU = WSP(float, WS_RA + RA_U); float* CP = WSP(float, WS_CHP); float* CHh = WSP(float, WS_CHH);
    for (int i = F.vcu * NTHR + F.tid; i < BATCH * NCH * (D / 4); i += NGT) { const int c4 = (i & 255) * 4, ck = (i >> 8) & (NCH - 1), b = i >> 16;
        const size_t r0 = ((size_t)b * SEQ + (size_t)ck * CH) * D + c4; f32x4 h = {0.f, 0.f, 0.f, 0.f}, sl = {0.f, 0.f, 0.f, 0.f};
#pragma unroll 4
        for (int t = 0; t < CH; ++t) { const f32x4 la = *(const f32x4*)(LA + r0 + (size_t)t * D), u = *(const f32x4*)(UU + r0 + (size_t)t * D);
#pragma unroll
            for (int j = 0; j < 4; ++j) { h[j] = __expf(la[j]) * h[j] + u[j]; sl[j] += la[j]; } }
#pragma unroll
        for (int j = 0; j < 4; ++j) { const size_t o = ((size_t)b * D + c4 + j) * NCH + ck; CP[o] = __expf(sl[j]); CHh[o] = h[j]; } }
}
__device__ __forceinline__ void p_scan2(Frame& F) {
    const float* CP = WSP(float, WS_CHP); const float* CHh = WSP(float, WS_CHH); float* CIN = WSP(float, WS_CIN);
    for (int s = F.vcu * NWAVES + F.wave; s < BATCH * D; s += NGW) { const size_t o = (size_t)s * NCH + 4 * F.lane;
        const f32x4 p4 = *(const f32x4*)(CP + o), h4 = *(const f32x4*)(CHh + o);
        float p = p4.x, h = h4.x; h = p4.y * h + h4.y; p *= p4.y; h = p4.z * h + h4.z; p *= p4.z; h = p4.w * h + h4.w; p *= p4.w;
#pragma unroll
        for (int off = 1; off < 64; off <<= 1) { const float pp = __shfl_up(p, off), hp = __shfl_up(h, off); if (F.lane >= off) { h = p * hp + h; p = pp * p; } }
        float c0 = __shfl_up(h, 1); if (F.lane == 0) c0 = 0.f;
        f32x4 ci; ci.x = c0; ci.y = p4.x * ci.x + h4.x; ci.z = p4.y * ci.y + h4.y; ci.w = p4.z * ci.z + h4.z;
        *(f32x4*)(CIN + o) = ci; }
}
__device__ __forceinline__ void p_scan3(Frame& F) {
    const float* LA = WSP(float, WS_RA + RA_LA); const float* UU = WSP(float, WS_RA + RA_U); const float* CIN = WSP(float, WS_CIN);
    const bf16* GG = WSP(bf16, WS_RA + RA_GG); bf16* YB = WSP(bf16, WS_RA + RA_YB);
    for (int i = F.vcu * NTHR + F.tid; i < BATCH * NCH * (D / 4); i += NGT) { const int c4 = (i & 255) * 4, ck = (i >> 8) & (NCH - 1), b = i >> 16;
        const size_t r0 = ((size_t)b * SEQ + (size_t)ck * CH) * D + c4; f32x4 h;
#pragma unroll
        for (int j = 0; j < 4; ++j) h[j] = CIN[((size_t)b * D + c4 + j) * NCH + ck];
#pragma unroll 4
        for (int t = 0; t < CH; ++t) { const f32x4 la = *(const f32x4*)(LA + r0 + (size_t)t * D), u = *(const f32x4*)(UU + r0 + (size_t)t * D);
            const u32x2 gw = *(const u32x2*)(GG + r0 + (size_t)t * D);
#pragma unroll
            for (int j = 0; j < 4; ++j) h[j] = __expf(la[j]) * h[j] + u[j];
            u32x2 o; o.x = pk2(h.x * bf_lo(gw.x), h.y * bf_hi(gw.x)); o.y = pk2(h.z * bf_lo(gw.y), h.w * bf_hi(gw.y)); *(u32x2*)(YB + r0 + (size_t)t * D) = o; } }
}
__device__ __forceinline__ void p_ln(Frame& F, const float* V, const float* g, const float* b, float* Hf, bf16* Hb) {
    for (int r = F.vcu * NWAVES + F.wave; r < M; r += NGW) { const f32x4* xr = (const f32x4*)(V + (size_t)r * D) + F.lane; f32x4 v[4];
#pragma unroll
        for (int j = 0; j < 4; ++j) v[j] = xr[64 * j];
        ln_store(v, g, b, Hf + (size_t)r * D, Hb + (size_t)r * D, F.lane); }
}
__device__ __forceinline__ void p_route(Frame& F, const float* bias) {
    const float* LG = WSP(float, WS_LOGITS); int* TOPI = WSP(int, WS_TOPI); float* GATE = WSP(float, WS_GATE); int* HIST = WSP(int, WS_HIST);
    LAS int* hist = (LAS int*)F.lds; const int lane = F.lane;
    if (F.tid < 256) hist[F.tid] = 0;
    __syncthreads();
    const f32x4 bv = *(const f32x4*)(bias + 4 * lane);
    for (int j = 0; j < 16; ++j) { const int t = F.vcu * 128 + F.wave * 16 + j;
        const f32x4 z = *(const f32x4*)(LG + (size_t)t * NE + 4 * lane);
        const float s0 = sigmoidf_(z.x), s1 = sigmoidf_(z.y), s2 = sigmoidf_(z.z), s3 = sigmoidf_(z.w);
        float v0 = s0 + bv.x, v1 = s1 + bv.y, v2 = s2 + bv.z, v3 = s3 + bv.w;
        float m1, m2; { const float a = fmaxf(v0, v1), b = fminf(v0, v1), c = fmaxf(v2, v3), d = fminf(v2, v3); m1 = fmaxf(a, c); m2 = fmaxf(fminf(a, c), fmaxf(b, d)); }
#pragma unroll
        for (int off = 1; off < 8; off <<= 1) { const float o1 = __shfl_xor(m1, off), o2 = __shfl_xor(m2, off); const float n1 = fmaxf(m1, o1), n2 = fmaxf(fminf(m1, o1), fmaxf(m2, o2)); m1 = n1; m2 = n2; }
        const float gs = m1 + m2; const int g = lane >> 3; int rank = 0;
#pragma unroll
        for (int q = 0; q < 8; ++q) { const float o = __shfl(gs, 8 * q); rank += (o > gs || (o == gs && q < g)) ? 1 : 0; }
        if (rank >= 4) { v0 = -1e30f; v1 = -1e30f; v2 = -1e30f; v3 = -1e30f; }
        int myidx = 0; float mys = 0.f;
#pragma unroll
        for (int k = 0; k < TOPK; ++k) {
            float bvv = v0; int bi = 0; if (v1 > bvv) { bvv = v1; bi = 1; } if (v2 > bvv) { bvv = v2; bi = 2; } if (v3 > bvv) { bvv = v3; bi = 3; }
            int idx = 4 * lane + bi;
#pragma unroll
            for (int off = 32; off >= 1; off >>= 1) { const float ov = __shfl_xor(bvv, off); const int oi = __shfl_xor(idx, off); if (ov > bvv || (ov == bvv && oi < idx)) { bvv = ov; idx = oi; } }
            const int q = idx & 3; const float sq = q == 0 ? s0 : (q == 1 ? s1 : (q == 2 ? s2 : s3)); const float sw = __shfl(sq, idx >> 2);
            if ((idx >> 2) == lane) { if (q == 0) v0 = -3e38f; else if (q == 1) v1 = -3e38f; else if (q == 2) v2 = -3e38f; else v3 = -3e38f; }
            if (lane == k) { myidx = idx; mys = sw; }
        }
        const float tot = wave_sum(lane < TOPK ? mys : 0.f);
        if (lane < TOPK) { TOPI[t * TOPK + lane] = myidx; GATE[t * TOPK + lane] = mys / tot * 2.5f; atomicAdd((int*)&hist[myidx], 1); }
    }
    __syncthreads();
    if (F.tid < 256) HIST[F.vcu * 256 + F.tid] = hist[F.tid];
    __syncthreads();
}
__device__ __forceinline__ void p_sort(Frame& F) {
    const int* HIST = WSP(int, WS_HIST); const int* TOPI = WSP(int, WS_TOPI); int* ROWA = WSP(int, WS_ROWA); int* BLKE = WSP(int, WS_BLKE); int* META = WSP(int, WS_META);
    LAS int* cnt = (LAS int*)F.lds; LAS int* myoff = cnt + 256; LAS int* nb = cnt + 512; LAS int* blk0 = cnt + 768; LAS int* lcnt = cnt + 1024;
    if (F.tid < 256) { const int e = F.tid; int c = 0, mo = 0;
        for (int w = 0; w < NWG; ++w) { const int h = HIST[w * 256 + e]; c += h; mo += (w < F.vcu) ? h : 0; }
        cnt[e] = c; myoff[e] = mo; nb[e] = (c + 255) >> 8; lcnt[e] = 0; }
    __syncthreads();
    if (F.tid < 256) { int b = 0; for (int j = 0; j < F.tid; ++j) b += nb[j]; blk0[F.tid] = b; }
    __syncthreads();
    for (int al = F.tid; al < 1024; al += NTHR) { const int a = F.vcu * 1024 + al; const int e = TOPI[a]; const int pos = blk0[e] * 256 + myoff[e] + atomicAdd((int*)&lcnt[e], 1); ROWA[pos] = a; }
    const int nrb = blk0[255] + nb[255];
    { const int e = F.vcu; const int start = blk0[e] * 256 + cnt[e], end = (blk0[e] + nb[e]) * 256;
      for (int p = start + F.tid; p < end; p += NTHR) ROWA[p] = -1;
      for (int j = F.tid; j < nb[e]; j += NTHR) BLKE[blk0[e] + j] = e; }
    for (int tl = F.tid; tl < 128; tl += NTHR) { const int t = F.vcu * 128 + tl; ROWA[nrb * 256 + t] = 8 * M + t; }
    if (F.vcu == 0) { for (int j = F.tid; j < 128; j += NTHR) BLKE[nrb + j] = 256; if (F.tid == 0) META[0] = nrb + 128; }
    __syncthreads();
}
__device__ __forceinline__ void p_combine(Frame& F, const float* Hin, const float* g, const float* b, float* Hf, bf16* Hb) {
    const bf16* YA = WSP(bf16, WS_RA); const float* GATE = WSP(float, WS_GATE);
    for (int t = F.vcu * NWAVES + F.wave; t < M; t += NGW) { f32x4 v[4];
        const f32x4* hr = (const f32x4*)(Hin + (size_t)t * D) + F.lane;
#pragma unroll
        for (int j = 0; j < 4; ++j) v[j] = hr[64 * j] * ALPHA;
        f32x4 r[4];
#pragma unroll
        for (int j = 0; j < 4; ++j) r[j] = (f32x4){0.f, 0.f, 0.f, 0.f};
#pragma unroll
        for (int k = 0; k < TOPK; ++k) { const float gk = GATE[t * TOPK + k]; const u32x2* yr = (const u32x2*)(YA + ((size_t)t * TOPK + k) * D) + F.lane;
#pragma unroll
            for (int j = 0; j < 4; ++j) { const u32x2 w = yr[64 * j]; r[j].x += gk * bf_lo(w.x); r[j].y += gk * bf_hi(w.x); r[j].z += gk * bf_lo(w.y); r[j].w += gk * bf_hi(w.y); } }
        { const u32x2* yr = (const u32x2*)(YA + ((size_t)8 * M + t) * D) + F.lane;
#pragma unroll
            for (int j = 0; j < 4; ++j) { const u32x2 w = yr[64 * j]; v[j].x += r[j].x + bf_lo(w.x); v[j].y += r[j].y + bf_hi(w.x); v[j].z += r[j].z + bf_lo(w.y); v[j].w += r[j].w + bf_hi(w.y); } }
        ln_store(v, g, b, Hf + (size_t)t * D, Hb ? Hb + (size_t)t * D : nullptr, F.lane); }
}
__device__ __forceinline__ void p_attn(Frame& F) {
    const bf16* QKb = WSP(bf16, WS_RA + RA_QK); const bf16* VTb = WSP(bf16, WS_RA + RA_VT); bf16* OGb = WSP(bf16, WS_RA + RA_OG); float* LSE = WSP(float, WS_LSE);
    const int lane = F.lane, q = lane & 31, hh = lane >> 5;
#pragma unroll 1
    for (int it = F.vcu * NWAVES + F.wave; it < 3 * 8192; it += NGW) {
        const int g = it >> 13, rem = it & 8191, tile = rem >> 3, h = rem & 7;
        const int sh = 14 - 2 * g, rq0 = tile * 32, i0 = rq0 & ((1 << sh) - 1);
        const bf16* QK = QKb + (size_t)g * M * 1024; const bf16* VT = VTb + (size_t)g * 512 * M;
        bf16x8 Qf[4];
        { const bf16* qp = QK + (size_t)(rq0 + q) * 1024 + h * 64 + 8 * hh;
#pragma unroll
          for (int s = 0; s < 4; ++s) Qf[s] = *(const bf16x8*)(qp + 16 * s); }
        const float slope2 = exp2f(-(float)(h + 1)) * (float)(1 << (2 * g)) * 1.4426950408889634f, sc = 0.125f * 1.4426950408889634f;
        float m_run = -1e30f, l_run = 0.f; f32x16 O0, O1;
#pragma unroll
        for (int r = 0; r < 16; ++r) { O0[r] = 0.f; O1[r] = 0.f; }
#pragma unroll 1
        for (int kt = 0; kt < 5; ++kt) { const int ik0 = i0 - 128 + 32 * kt; if (ik0 < 0) continue; const int rk0 = rq0 - 128 + 32 * kt;
            bf16x8 Kf[4];
            { const bf16* kp = QK + (size_t)(rk0 + q) * 1024 + 512 + h * 64 + 8 * hh;
#pragma unroll
              for (int s = 0; s < 4; ++s) Kf[s] = *(const bf16x8*)(kp + 16 * s); }
            bf16x8 Vf[2][2];
#pragma unroll
            for (int dd = 0; dd < 2; ++dd)
#pragma unroll
                for (int s = 0; s < 2; ++s) { const bf16* vp = VT + (size_t)(h * 64 + 32 * dd + q) * M + rk0 + 16 * s + 4 * hh;
                    const u32x2 lo = *(const u32x2*)vp, hi = *(const u32x2*)(vp + 8); u32x4 w; w.x = lo.x; w.y = lo.y; w.z = hi.x; w.w = hi.y; Vf[dd][s] = __builtin_bit_cast(bf16x8, w); }
            f32x16 S;
#pragma unroll
            for (int r = 0; r < 16; ++r) S[r] = 0.f;
#pragma unroll
            for (int s = 0; s < 4; ++s) S = __builtin_amdgcn_mfma_f32_32x32x16_bf16(Kf[s], Qf[s], S, 0, 0, 0);
            float mx = -1e30f;
#pragma unroll
            for (int r = 0; r < 16; ++r) { const int krow = (r & 3) + 8 * (r >> 2) + 4 * hh; const int dist = 128 - 32 * kt + q - krow;
                const float sv = (dist >= 0 && dist <= 128) ? S[r] * sc - slope2 * (float)dist : -1e30f; S[r] = sv; mx = fmaxf(mx, sv); }
            mx = fmaxf(mx, __shfl_xor(mx, 32));
            const float m_new = fmaxf(m_run, mx), alpha = exp2f(m_run - m_new); float rs = 0.f;
#pragma unroll
            for (int r = 0; r < 16; ++r) { const float p = exp2f(S[r] - m_new); S[r] = p; rs += p; }
            rs += __shfl_xor(rs, 32);
            l_run = l_run * alpha + rs; m_run = m_new;
#pragma unroll
            for (int r = 0; r < 16; ++r) { O0[r] *= alpha; O1[r] *= alpha; }
            bf16x8 Pf[2];
#pragma unroll
            for (int s = 0; s < 2; ++s) { u32x4 w; w.x = pk2(S[8 * s + 0], S[8 * s + 1]); w.y = pk2(S[8 * s + 2], S[8 * s + 3]); w.z = pk2(S[8 * s + 4], S[8 * s + 5]); w.w = pk2(S[8 * s + 6], S[8 * s + 7]); Pf[s] = __builtin_bit_cast(bf16x8, w); }
#pragma unroll
            for (int s = 0; s < 2; ++s) { O0 = __builtin_amdgcn_mfma_f32_32x32x16_bf16(Vf[0][s], Pf[s], O0, 0, 0, 0); O1 = __builtin_amdgcn_mfma_f32_32x32x16_bf16(Vf[1][s], Pf[s], O1, 0, 0, 0); }
        }
        const float inv = 1.0f / l_run;
        bf16* op = OGb + ((size_t)g * M + rq0 + q) * 512 + h * 64 + 4 * hh;
#pragma unroll
        for (int rg = 0; rg < 4; ++rg) { u32x2 w; w.x = pk2(O0[4 * rg] * inv, O0[4 * rg + 1] * inv); w.y = pk2(O0[4 * rg + 2] * inv, O0[4 * rg + 3] * inv); *(u32x2*)(op + 8 * rg) = w;
            u32x2 w1; w1.x = pk2(O1[4 * rg] * inv, O1[4 * rg + 1] * inv); w1.y = pk2(O1[4 * rg + 2] * inv, O1[4 * rg + 3] * inv); *(u32x2*)(op + 32 + 8 * rg) = w1; }
        if (hh == 0) LSE[((size_t)g * M + rq0 + q) * 8 + h] = (m_run + log2f(l_run)) * 0.6931471805599453f;
    }
}
__device__ __forceinline__ void p_merge(Frame& F) {
    const bf16* OGb = WSP(bf16, WS_RA + RA_OG); const float* LSE = WSP(float, WS_LSE); bf16* OM = WSP(bf16, WS_RA + RA_OM);
    for (int t = F.vcu * NWAVES + F.wave; t < M; t += NGW) { const int hd = F.lane >> 3; float ls[3]; size_t ro[3];
#pragma unroll
        for (int g = 0; g < 3; ++g) { const int rho = tok_to_rho(t, g); ro[g] = ((size_t)g * M + rho); ls[g] = LSE[ro[g] * 8 + hd]; }
        const float mx = fmaxf(ls[0], fmaxf(ls[1], ls[2])); float w[3], ws = 0.f;
#pragma unroll
        for (int g = 0; g < 3; ++g) { w[g] = __expf(ls[g] - mx); ws += w[g]; }
        const float inv = 1.0f / ws; float o[8];
#pragma unroll
        for (int j = 0; j < 8; ++j) o[j] = 0.f;
#pragma unroll
        for (int g = 0; g < 3; ++g) { const u32x4 x = *(const u32x4*)(OGb + ro[g] * 512 + 8 * F.lane); const float wg = w[g] * inv;
            o[0] += wg * bf_lo(x.x); o[1] += wg * bf_hi(x.x); o[2] += wg * bf_lo(x.y); o[3] += wg * bf_hi(x.y); o[4] += wg * bf_lo(x.z); o[5] += wg * bf_hi(x.z); o[6] += wg * bf_lo(x.w); o[7] += wg * bf_hi(x.w); }
        u32x4 r; r.x = pk2(o[0], o[1]); r.y = pk2(o[2], o[3]); r.z = pk2(o[4], o[5]); r.w = pk2(o[6], o[7]); *(u32x4*)(OM + (size_t)t * OW + 8 * F.lane) = r; }
}

constexpr int NPHASE = 26;

__global__ void __launch_bounds__(NTHR, 2) yoco_fwd(Args args) {
    extern __shared__ __attribute__((aligned(16))) unsigned char lds[];
    Frame F;
    F.lds = (LAS unsigned char*)lds;
    F.tid = threadIdx.x; F.lane = F.tid & 63; F.wave = __builtin_amdgcn_readfirstlane(F.tid >> 6);
    { const int bx = blockIdx.x; F.vcu = (bx % 8) * (NWG / 8) + bx / 8; }
    F.ws = args.ws;
    volatile LAS unsigned* MISC = (volatile LAS unsigned*)(F.lds + LDS_BYTES - 64);
    if (F.tid < 16) MISC[F.tid] = 0u;
    __syncthreads();
    const int lo = args.ph_lo, hi = args.ph_hi;
    XcdBarrier bar; bar.bar = (unsigned*)(F.ws + WS_CTL) + 4096; bar.x = 0; bar.st = nullptr;
    if (hi - lo > 1) bar = xcd_barrier_post((unsigned*)(F.ws + WS_CTL) + 4096, MISC + 8);
#ifndef PH_MASK
#define PH_MASK 0xFFFFFFFFu
#endif
#define IN(k) (((PH_MASK >> (k)) & 1u) && lo <= (k) && (k) < hi)
#define SEAM(k) do { if (IN(k) && IN((k) + 1)) xcd_barrier(bar); } while (0)

    if (IN(0)) { p0_prologue(F, args); } SEAM(0);
    if (IN(1)) { SchedDense S{WSP(bf16, WS_RA + RA_XB), WSP(bf16, WS_WIN), D, D, D, M / 256, 8, F.vcu}; EpiXZ E{WSP(bf16, WS_RA + RA_XR), WSP(bf16, WS_RA + RA_GG)}; GEMM_PHASE(F.lds, S, E); } SEAM(1);
    if (IN(2)) { p_conv(F, args.in[2], args.in[3]); } SEAM(2);
    if (IN(3)) { SchedGate S{WSP(bf16, WS_RA + RA_XC), WSP(bf16, WS_WG), F.vcu}; EpiGate E{WSP(bf16, WS_RA + RA_XC), args.in[5], args.in[7], args.in[8], WSP(float, WS_RA + RA_LA), WSP(float, WS_RA + RA_U)}; GEMM_PHASE(F.lds, S, E); } SEAM(3);
    if (IN(4)) { p_scan1(F); } SEAM(4);
    if (IN(5)) { p_scan2(F); } SEAM(5);
    if (IN(6)) { p_scan3(F); } SEAM(6);
    if (IN(7)) { SchedDense S{WSP(bf16, WS_RA + RA_YB), WSP(bf16, WS_WOUT), D, D, D, M / 256, 4, F.vcu}; EpiResF32 E{args.in[0], WSP(float, WS_V), D}; GEMM_PHASE(F.lds, S, E); } SEAM(7);
    if (IN(8)) { p_ln(F, WSP(float, WS_V), args.in[21] + 0 * D, args.in[22] + 0 * D, WSP(float, WS_HA), WSP(bf16, WS_HAB)); } SEAM(8);
    if (IN(9)) { SchedDense S{WSP(bf16, WS_HAB), WSP(bf16, WS_WR), D, D, D, M / 256, 1, F.vcu}; EpiF32 E{WSP(float, WS_LOGITS), NE}; GEMM_PHASE(F.lds, S, E); } SEAM(9);
    if (IN(10)) { p_route(F, args.in[14]); } SEAM(10);
    if (IN(11)) { p_sort(F); } SEAM(11);
    if (IN(12)) { SchedG1 S{WSP(bf16, WS_HAB), WSP(bf16, WS_W13), WSP(int, WS_ROWA), WSP(int, WS_BLKE), *WSP(int, WS_META), F.vcu}; EpiSwiGLU E{WSP(bf16, WS_HID)}; GEMM_PHASE(F.lds, S, E); } SEAM(12);
    if (IN(13)) { SchedG2 S{WSP(bf16, WS_HID), WSP(bf16, WS_W2), WSP(int, WS_BLKE), *WSP(int, WS_META), F.vcu}; EpiScatter E{WSP(bf16, WS_RA), WSP(int, WS_ROWA)}; GEMM_PHASE(F.lds, S, E); } SEAM(13);
    if (IN(14)) { p_combine(F, WSP(float, WS_HA), args.in[21] + 1 * D, args.in[22] + 1 * D, WSP(float, WS_HB), WSP(bf16, WS_HBB)); convert_experts(F, args.in[15] + (size_t)NE * D * DE, args.in[16] + (size_t)NE * D * DE, args.in[17] + (size_t)NE * D * DE, args.in[18] + (size_t)D * DE, args.in[19] + (size_t)D * DE, args.in[20] + (size_t)D * DE); } SEAM(14);
    if (IN(15)) { SchedQKV S{WSP(bf16, WS_HBB), WSP(bf16, WS_WQK), WSP(bf16, WS_WV), F.vcu}; EpiQKV E{WSP(bf16, WS_RA + RA_QK), WSP(bf16, WS_RA + RA_VT)}; GEMM_PHASE(F.lds, S, E); } SEAM(15);
    if (IN(16)) { p_attn(F); } SEAM(16);
    if (IN(17)) { p_merge(F); } SEAM(17);
    if (IN(18)) { SchedDense S{WSP(bf16, WS_RA + RA_OM), WSP(bf16, WS_WO), OW, OW, OW, M / 256, 4, F.vcu}; EpiResF32 E{WSP(float, WS_HB), WSP(float, WS_V), D}; GEMM_PHASE(F.lds, S, E); } SEAM(18);
    if (IN(19)) { p_ln(F, WSP(float, WS_V), args.in[21] + 2 * D, args.in[22] + 2 * D, WSP(float, WS_HA), WSP(bf16, WS_HAB)); } SEAM(19);
    if (IN(20)) { SchedDense S{WSP(bf16, WS_HAB), WSP(bf16, WS_WR) + (size_t)NE * D, D, D, D, M / 256, 1, F.vcu}; EpiF32 E{WSP(float, WS_LOGITS), NE}; GEMM_PHASE(F.lds, S, E); } SEAM(20);
    if (IN(21)) { p_route(F, args.in[14] + NE); } SEAM(21);
    if (IN(22)) { p_sort(F); } SEAM(22);
    if (IN(23)) { SchedG1 S{WSP(bf16, WS_HAB), WSP(bf16, WS_W13), WSP(int, WS_ROWA), WSP(int, WS_BLKE), *WSP(int, WS_META), F.vcu}; EpiSwiGLU E{WSP(bf16, WS_HID)}; GEMM_PHASE(F.lds, S, E); } SEAM(23);
    if (IN(24)) { SchedG2 S{WSP(bf16, WS_HID), WSP(bf16, WS_W2), WSP(int, WS_BLKE), *WSP(int, WS_META), F.vcu}; EpiScatter E{WSP(bf16, WS_RA), WSP(int, WS_ROWA)}; GEMM_PHASE(F.lds, S, E); } SEAM(24);
    if (IN(25)) { p_combine(F, WSP(float, WS_HA), args.in[21] + 3 * D, args.in[22] + 3 * D, args.out, nullptr); }
#undef IN
#undef SEAM
}

extern "C" void kernel_launch(void* const* d_in, const int* in_sizes, int n_in, void* d_out, int out_size, void* d_ws, size_t ws_size, hipStream_t stream) {
    static int ok = 0;
    if (ok == 0) {
        if (n_in != 23 || in_sizes[0] != M * D || out_size != M * D || ws_size < WS_END) { fprintf(stderr, "kernel_launch: unexpected shapes (n_in %d, in0 %d, out %d, ws %zu < %zu)\n", n_in, n_in > 0 ? in_sizes[0] : -1, out_size, ws_size, (size_t)WS_END); ok = -1; return; }
        if (hipFuncSetAttribute((const void*)yoco_fwd, hipFuncAttributeMaxDynamicSharedMemorySize, LDS_BYTES) != hipSuccess) { fprintf(stderr, "kernel_launch: hipFuncSetAttribute failed\n"); ok = -1; return; }
        int per_cu = 0;
        if (hipOccupancyMaxActiveBlocksPerMultiprocessor(&per_cu, (const void*)yoco_fwd, NTHR, LDS_BYTES) != hipSuccess || per_cu < 1) fprintf(stderr, "kernel_launch: occupancy query says %d\n", per_cu);
        (void)hipGetLastError();
        ok = 1;
    }
    if (ok < 0) return;
    if (hipMemsetAsync((char*)d_ws + WS_CTL, 0, CTL_ZERO_BYTES, stream) != hipSuccess) return;
    Args a{};
    for (int i = 0; i < 23; ++i) a.in[i] = (const float*)d_in[i];
    a.out = (float*)d_out; a.ws = (unsigned char*)d_ws;
#if MK_ONE_LAUNCH
    a.ph_lo = 0; a.ph_hi = NPHASE;
    hipLaunchKernelGGL(yoco_fwd, dim3(NWG), dim3(NTHR), LDS_BYTES, stream, a);
#else
    for (int p = 0; p < NPHASE; ++p) { a.ph_lo = p; a.ph_hi = p + 1; hipLaunchKernelGGL(yoco_fwd, dim3(NWG), dim3(NTHR), LDS_BYTES, stream, a); }
#endif
}
```

```cpp
#include <hip/hip_runtime.h>
#include <cstdio>
#include <cstdint>

#ifndef MK_ONE_LAUNCH
#define MK_ONE_LAUNCH 1
#endif

constexpr int D = 1024, BATCH = 2, SEQ = 16384, M = BATCH * SEQ;
constexpr int NE = 256, TOPK = 8, DE = 256;
constexpr int HEADS = 8, HD = 64, QW = 1536, OW = 512;
constexpr float LN_EPS = 1e-5f, ALPHA = 1.41421356237f;
constexpr int RBMAX = 1024 + 256 + 128;
constexpr int NWG = 256, NTHR = 512, NWAVES = 8;
constexpr int NGW = NWG * NWAVES, NGT = NWG * NTHR;

constexpr size_t MiB = 1u << 20;
constexpr size_t WS_CTL = 0, CTL_ZERO_BYTES = 1 * MiB;
constexpr size_t WS_HIST = 1 * MiB, WS_BLKE = 1 * MiB + 512 * 1024, WS_META = 1 * MiB + 768 * 1024;
constexpr size_t WS_ROWA = 2 * MiB, WS_TOPI = 4 * MiB, WS_GATE = 5 * MiB, WS_CHP = 6 * MiB, WS_CHH = 8 * MiB, WS_CIN = 10 * MiB, WS_LSE = 12 * MiB;
constexpr size_t WS_WIN = 16 * MiB, WS_WG = 20 * MiB, WS_WOUT = 21 * MiB, WS_WQK = 23 * MiB, WS_WV = 29 * MiB, WS_WO = 32 * MiB, WS_WR = 33 * MiB;
constexpr size_t WS_LOGITS = 34 * MiB;
constexpr size_t WS_W13 = 66 * MiB, WS_W2 = 323 * MiB;
constexpr size_t WS_V = 452 * MiB, WS_HA = 580 * MiB, WS_HAB = 708 * MiB, WS_HB = 772 * MiB, WS_HBB = 900 * MiB, WS_HID = 964 * MiB;
constexpr size_t WS_RA = 1140 * MiB;
constexpr size_t RA_XB = 0, RA_XR = 64 * MiB, RA_GG = 128 * MiB, RA_XC = 192 * MiB, RA_LA = 256 * MiB, RA_U = 384 * MiB, RA_YB = 512 * MiB;
constexpr size_t RA_QK = 0, RA_VT = 192 * MiB, RA_OG = 288 * MiB, RA_OM = 384 * MiB;
constexpr size_t WS_END = 1716 * MiB;

constexpr int LDS_BYTES = 147456;

#define GAS __attribute__((address_space(1)))
#define LAS __attribute__((address_space(3)))
typedef unsigned short bf16;
typedef unsigned u32x4 __attribute__((ext_vector_type(4)));
typedef unsigned u32x2 __attribute__((ext_vector_type(2)));
typedef float f32x4 __attribute__((ext_vector_type(4)));
typedef float f32x16 __attribute__((ext_vector_type(16)));
typedef short bf16x8 __attribute__((ext_vector_type(8)));
typedef GAS unsigned gu32;
#define RLX_AGENT __ATOMIC_RELAXED, __HIP_MEMORY_SCOPE_AGENT
#define LDS_WAIT() asm volatile("s_waitcnt lgkmcnt(0)" ::: "memory")
#define VM_WAIT() asm volatile("s_waitcnt vmcnt(0)" ::: "memory")

__device__ __forceinline__ unsigned pk2(float lo, float hi) { unsigned r; asm("v_cvt_pk_bf16_f32 %0, %1, %2" : "=v"(r) : "v"(lo), "v"(hi)); return r; }
__device__ __forceinline__ float bf_lo(unsigned w) { return __uint_as_float(w << 16); }
__device__ __forceinline__ float bf_hi(unsigned w) { return __uint_as_float(w & 0xffff0000u); }
__device__ __forceinline__ float wave_sum(float v) {
#pragma unroll
    for (int o = 1; o < 64; o <<= 1) v += __shfl_xor(v, o);
    return v;
}
__device__ __forceinline__ float gelu_tanh(float x) {
    const float u = 0.7978845608028654f * (x + 0.044715f * x * x * x);
    const float e = __expf(2.0f * u);
    const float t = 1.0f - 2.0f / (e + 1.0f);
    return 0.5f * x * (1.0f + t);
}
__device__ __forceinline__ float sigmoidf_(float x) { return 1.0f / (1.0f + __expf(-x)); }

#define XB_TMO      128
#define XB_XCNT(j)  (256  + 64 * (j))
#define XB_XSUB(j)  (1280 + 64 * (j))
#define XB_XGEN(j)  (2304 + 64 * (j))
#define XB_TOP      3328
#define XB_TOPGEN   3392
#define XCD_BAR_WORDS 3456
#define XB_SPIN_CAP (1u << 18)
__device__ __forceinline__ unsigned xb_ld(unsigned* p)              { return __hip_atomic_load(p, __ATOMIC_RELAXED, __HIP_MEMORY_SCOPE_AGENT); }
__device__ __forceinline__ unsigned xb_add(unsigned* p, unsigned v) { return __hip_atomic_fetch_add(p, v, __ATOMIC_RELAXED, __HIP_MEMORY_SCOPE_AGENT); }
__device__ __forceinline__ unsigned xb_xcc_id() { return (unsigned)__builtin_amdgcn_s_getreg((3 << 11) | 20) & 0xFu; }
#define XB_SPIN(cond, bar) do { unsigned _sp = 0; while (cond) { __builtin_amdgcn_s_sleep(1); \
    if ((++_sp & 255u) == 0u) { if (xb_ld(&(bar)[XB_TMO])) break; if (_sp > XB_SPIN_CAP) { atomicAdd(&(bar)[XB_TMO], 1u); break; } } } } while (0)
struct XcdBarrier { unsigned* bar; unsigned x; volatile LAS unsigned* st; };
__device__ __forceinline__ XcdBarrier xcd_barrier_post(unsigned* bar, volatile LAS unsigned* st) {
    XcdBarrier b; b.bar = bar; b.x = xb_xcc_id(); b.st = st;
    if (threadIdx.x == 0) (void)xb_add(&bar[XB_XCNT(b.x)], 1u);
    return b;
}
__device__ __forceinline__ void xcd_barrier_complete(unsigned* bar, unsigned x, unsigned& nloc, unsigned& nx) {
    const unsigned G = gridDim.x * gridDim.y * gridDim.z;
    unsigned sum, cnt, mine, sp = 0u;
    for (;;) {
        sum = 0u; cnt = 0u; mine = 0u;
#pragma unroll
        for (unsigned j = 0; j < 16; ++j) { const unsigned c = xb_ld(&bar[XB_XCNT(j)]); sum += c; cnt += (c > 0u) ? 1u : 0u; mine = (j == x) ? c : mine; }
        if (sum == G) break;
        __builtin_amdgcn_s_sleep(1);
        if ((++sp & 255u) == 0u) { if (xb_ld(&bar[XB_TMO])) break; if (sp > XB_SPIN_CAP) { atomicAdd(&bar[XB_TMO], 1u); break; } }
    }
    nloc = mine > 0u ? mine : 1u; nx = cnt > 0u ? cnt : 1u;
}
__device__ __forceinline__ void xcd_barrier(const XcdBarrier& b) {
    asm volatile("s_waitcnt vmcnt(0)" ::: "memory");
    __syncthreads();
    if (threadIdx.x == 0) {
        unsigned* bar = b.bar;
        __builtin_amdgcn_s_waitcnt(0);
        unsigned nloc = b.st[0], nx = b.st[1];
        if (nloc == 0u) { xcd_barrier_complete(bar, b.x, nloc, nx); b.st[0] = nloc; b.st[1] = nx; }
        const unsigned old = xb_add(&bar[XB_XSUB(b.x)], 1u);
        const unsigned gen = old / nloc;
        if (old + 1u == (gen + 1u) * nloc) {
            __builtin_amdgcn_fence(__ATOMIC_RELEASE, "agent");
            asm volatile("s_waitcnt vmcnt(0)" ::: "memory");
            const unsigned og = xb_add(&bar[XB_TOP], 1u);
            const unsigned tg = og / nx;
            if (og + 1u == (tg + 1u) * nx) xb_add(&bar[XB_TOPGEN], 1u);
            else XB_SPIN(xb_ld(&bar[XB_TOPGEN]) == tg, bar);
            __builtin_amdgcn_fence(__ATOMIC_ACQUIRE, "agent");
            xb_add(&bar[XB_XGEN(b.x)], 1u);
            asm volatile("s_waitcnt vmcnt(0)" ::: "memory");
        } else {
            XB_SPIN(xb_ld(&bar[XB_XGEN(b.x)]) == gen, bar);
            __builtin_amdgcn_fence(__ATOMIC_ACQUIRE, "agent");
            asm volatile("s_waitcnt vmcnt(0)" ::: "memory");
        }
    }
    __syncthreads();
}

struct Args { const float* in[23]; float* out; unsigned char* ws; int ph_lo, ph_hi; };
static_assert(sizeof(Args) == 23 * 8 + 8 + 8 + 8, "Args has no padding");
struct Frame {
    LAS unsigned char* lds;
    int tid, lane, wave, vcu;
    unsigned char* ws;
};
#define WSP(T, off) ((T*)(F.ws + (off)))

template <class S, class E>
__device__ __forceinline__ void gemm_simple(LAS unsigned char* lds, const S& sch, const E& epi) {
    const int tid = threadIdx.x, wid = tid >> 6, lane = tid & 63, wr = wid >> 2, wc = wid & 3, fr = lane & 15, fq = lane >> 4;
    constexpr int PITCH = 144;
    LAS unsigned char* As = lds; LAS unsigned char* Bs = lds + 256 * PITCH;
    typename S::U u;
    for (int i = 0; sch.next(i, u); ++i) {
        f32x4 acc[2][2][4][2];
#pragma unroll
        for (int a = 0; a < 2; ++a)
#pragma unroll
            for (int b = 0; b < 2; ++b)
#pragma unroll
                for (int m = 0; m < 4; ++m)
#pragma unroll
                    for (int n = 0; n < 2; ++n) acc[a][b][m][n] = (f32x4){0.f, 0.f, 0.f, 0.f};
        const int nt = sch.K(u) / 64;
        const char* pa[4]; const char* pb[4];
#pragma unroll
        for (int j = 0; j < 4; ++j) { const int row = (tid >> 3) + 64 * j; pa[j] = sch.rowA(u, row) + (tid & 7) * 16; pb[j] = sch.rowB(u, row) + (tid & 7) * 16; }
        for (int kt = 0; kt < nt; ++kt) {
            u32x4 va[4], vb[4];
#pragma unroll
            for (int j = 0; j < 4; ++j) { va[j] = *(const u32x4*)(pa[j] + kt * 128); vb[j] = *(const u32x4*)(pb[j] + kt * 128); }
            __syncthreads();
#pragma unroll
            for (int j = 0; j < 4; ++j) { const int row = (tid >> 3) + 64 * j;
                *(LAS u32x4*)(As + row * PITCH + (tid & 7) * 16) = va[j]; *(LAS u32x4*)(Bs + row * PITCH + (tid & 7) * 16) = vb[j]; }
            __syncthreads();
#pragma unroll
            for (int kk = 0; kk < 2; ++kk) {
                bf16x8 Bf[2][2];
#pragma unroll
                for (int b = 0; b < 2; ++b)
#pragma unroll
                    for (int n = 0; n < 2; ++n) Bf[b][n] = *(const LAS bf16x8*)(Bs + (b * 128 + wc * 32 + n * 16 + fr) * PITCH + kk * 64 + fq * 16);
#pragma unroll
                for (int a = 0; a < 2; ++a) {
                    bf16x8 Af[4];
#pragma unroll
                    for (int m = 0; m < 4; ++m) Af[m] = *(const LAS bf16x8*)(As + (a * 128 + wr * 64 + m * 16 + fr) * PITCH + kk * 64 + fq * 16);
#pragma unroll
                    for (int b = 0; b < 2; ++b)
#pragma unroll
                        for (int m = 0; m < 4; ++m)
#pragma unroll
                            for (int n = 0; n < 2; ++n) acc[a][b][m][n] = __builtin_amdgcn_mfma_f32_16x16x32_bf16(Bf[b][n], Af[m], acc[a][b][m][n], 0, 0, 0);
                }
            }
        }
        epi(acc, u, wr, wc, fr, fq);
    }
    __syncthreads();
}
#define GEMM_PHASE(lds, S, E) gemm_simple(lds, S, E)

#define ROWLOOP _Pragma("unroll") for (int ai = 0; ai < 2; ++ai) _Pragma("unroll") for (int m = 0; m < 4; ++m)
#define UROW (ai * 128 + wr * 64 + m * 16 + fr)
#define UCOL(bj, n) ((bj) * 128 + wc * 32 + (n) * 16 + 4 * fq)
typedef f32x4 AccT[2][2][4][2];

struct UnitD { int pm, pn; };
struct SchedDense {
    typedef UnitD U;
    const bf16* A; const bf16* Bt; int lda, ldb, Kk, nM, nN, vcu;
    __device__ __forceinline__ bool next(int i, U& u) const { const int L = i * NWG + vcu; if (L >= nM * nN) return false; u.pm = L / nN; u.pn = L % nN; return true; }
    __device__ __forceinline__ int K(const U&) const { return Kk; }
    __device__ __forceinline__ const char* rowA(const U& u, int r) const { return (const char*)(A + (size_t)(u.pm * 256 + r) * lda); }
    __device__ __forceinline__ const char* rowB(const U& u, int r) const { return (const char*)(Bt + (size_t)(u.pn * 256 + r) * ldb); }
};
struct EpiXZ {
    bf16* XR; bf16* GG;
    __device__ __forceinline__ void operator()(const AccT& acc, const UnitD& u, int wr, int wc, int fr, int fq) const {
        const bool isg = u.pn >= 4; bf16* base = isg ? GG : XR; const int c0 = (u.pn & 3) * 256;
        ROWLOOP { bf16* rp = base + (size_t)(u.pm * 256 + UROW) * D + c0;
#pragma unroll
            for (int bj = 0; bj < 2; ++bj)
#pragma unroll
                for (int n = 0; n < 2; ++n) { f32x4 v = acc[ai][bj][m][n];
                    if (isg) { v.x = gelu_tanh(v.x); v.y = gelu_tanh(v.y); v.z = gelu_tanh(v.z); v.w = gelu_tanh(v.w); }
                    u32x2 w; w.x = pk2(v.x, v.y); w.y = pk2(v.z, v.w); *(u32x2*)(rp + UCOL(bj, n)) = w; } }
    }
};
struct EpiResF32 {
    const float* R; float* O; int ldc;
    __device__ __forceinline__ void operator()(const AccT& acc, const UnitD& u, int wr, int wc, int fr, int fq) const {
        ROWLOOP { const size_t ro = (size_t)(u.pm * 256 + UROW) * ldc + u.pn * 256;
#pragma unroll
            for (int bj = 0; bj < 2; ++bj)
#pragma unroll
                for (int n = 0; n < 2; ++n) { const f32x4 r = *(const f32x4*)(R + ro + UCOL(bj, n)); *(f32x4*)(O + ro + UCOL(bj, n)) = r * ALPHA + acc[ai][bj][m][n]; } }
    }
};
struct EpiF32 {
    float* O; int ldc;
    __device__ __forceinline__ void operator()(const AccT& acc, const UnitD& u, int wr, int wc, int fr, int fq) const {
        ROWLOOP { const size_t ro = (size_t)(u.pm * 256 + UROW) * ldc + u.pn * 256;
#pragma unroll
            for (int bj = 0; bj < 2; ++bj)
#pragma unroll
                for (int n = 0; n < 2; ++n) *(f32x4*)(O + ro + UCOL(bj, n)) = acc[ai][bj][m][n]; }
    }
};

struct UnitG { int pm, blk, pn; };
struct SchedGate {
    typedef UnitG U;
    const bf16* XC; const bf16* WgT; int vcu;
    __device__ __forceinline__ bool next(int i, U& u) const { const int L = i * NWG + vcu; if (L >= 128 * 8) return false; u.pm = L >> 3; u.blk = (L >> 1) & 3; u.pn = L & 1; return true; }
    __device__ __forceinline__ int K(const U&) const { return 256; }
    __device__ __forceinline__ const char* rowA(const U& u, int r) const { return (const char*)(XC + (size_t)(u.pm * 256 + r) * D + u.blk * 256); }
    __device__ __forceinline__ const char* rowB(const U& u, int r) const { return (const char*)(WgT + (size_t)(u.blk * 512 + u.pn * 256 + r) * 256); }
};
struct EpiGate {
    const bf16* XC; const float *ba, *bx, *lam; float* LA; float* UU;
    __device__ __forceinline__ void operator()(const AccT& acc, const UnitG& u, int wr, int wc, int fr, int fq) const {
#pragma unroll
        for (int n = 0; n < 2; ++n) { const int c0 = u.blk * 256 + u.pn * 128 + wc * 32 + n * 16 + 4 * fq;
            const f32x4 vba = *(const f32x4*)(ba + c0), vbx = *(const f32x4*)(bx + c0), vl = *(const f32x4*)(lam + c0);
            f32x4 sp;
#pragma unroll
            for (int j = 0; j < 4; ++j) sp[j] = 8.0f * log1pf(__expf(-vl[j]));
            ROWLOOP { const size_t ro = (size_t)(u.pm * 256 + UROW) * D + c0;
                const u32x2 xw = *(const u32x2*)(XC + ro); const f32x4 xc = {bf_lo(xw.x), bf_hi(xw.x), bf_lo(xw.y), bf_hi(xw.y)};
                const f32x4 ga = acc[ai][0][m][n] + vba, gx = acc[ai][1][m][n] + vbx; f32x4 la, uu;
#pragma unroll
                for (int j = 0; j < 4; ++j) { const float r = sigmoidf_(ga[j]), ig = sigmoidf_(gx[j]); const float l = -r * sp[j]; la[j] = l;
                    const float mult = sqrtf(-expm1f(2.0f * l)); uu[j] = mult * ig * xc[j]; }
                *(f32x4*)(LA + ro) = la; *(f32x4*)(UU + ro) = uu; } }
    }
};

struct UnitE { int rb, pn, e; };
struct SchedG1 {
    typedef UnitE U;
    const bf16* X; const bf16* W13T; const int* ROWA; const int* BLKE; int nrbt, vcu;
    __device__ __forceinline__ bool next(int i, U& u) const { const int rb = (i >> 1) * NWG + vcu; if (rb >= nrbt) return false; u.rb = rb; u.pn = i & 1; u.e = BLKE[rb]; return true; }
    __device__ __forceinline__ int K(const U&) const { return D; }
    __device__ __forceinline__ const char* rowA(const U& u, int r) const { const int a = ROWA[u.rb * 256 + r]; const int tok = a < 0 ? 0 : (a < 8 * M ? (a >> 3) : a - 8 * M); return (const char*)(X + (size_t)tok * D); }
    __device__ __forceinline__ const char* rowB(const U& u, int r) const { return (const char*)(W13T + ((size_t)u.e * 512 + u.pn * 256 + r) * D); }
};
struct EpiSwiGLU {
    bf16* HID;
    __device__ __forceinline__ void operator()(const AccT& acc, const UnitE& u, int wr, int wc, int fr, int fq) const {
        ROWLOOP { bf16* rp = HID + (size_t)(u.rb * 256 + UROW) * DE + u.pn * 128;
#pragma unroll
            for (int n = 0; n < 2; ++n) { const f32x4 a = acc[ai][0][m][n], b = acc[ai][1][m][n]; f32x4 h;
#pragma unroll
                for (int j = 0; j < 4; ++j) h[j] = a[j] * sigmoidf_(a[j]) * b[j];
                u32x2 w; w.x = pk2(h.x, h.y); w.y = pk2(h.z, h.w); *(u32x2*)(rp + wc * 32 + n * 16 + 4 * fq) = w; } }
    }
};
struct SchedG2 {
    typedef UnitE U;
    const bf16* HID; const bf16* W2T; const int* BLKE; int nrbt, vcu;
    __device__ __forceinline__ bool next(int i, U& u) const { const int rb = (i >> 2) * NWG + vcu; if (rb >= nrbt) return false; u.rb = rb; u.pn = i & 3; u.e = BLKE[rb]; return true; }
    __device__ __forceinline__ int K(const U&) const { return DE; }
    __device__ __forceinline__ const char* rowA(const U& u, int r) const { return (const char*)(HID + (size_t)(u.rb * 256 + r) * DE); }
    __device__ __forceinline__ const char* rowB(const U& u, int r) const { return (const char*)(W2T + ((size_t)u.e * D + u.pn * 256 + r) * DE); }
};
struct EpiScatter {
    bf16* YA; const int* ROWA;
    __device__ __forceinline__ void operator()(const AccT& acc, const UnitE& u, int wr, int wc, int fr, int fq) const {
        ROWLOOP { const int a = ROWA[u.rb * 256 + UROW];
            if (a >= 0) { bf16* rp = YA + (size_t)a * D + u.pn * 256;
#pragma unroll
                for (int bj = 0; bj < 2; ++bj)
#pragma unroll
                    for (int n = 0; n < 2; ++n) { const f32x4 v = acc[ai][bj][m][n]; u32x2 w; w.x = pk2(v.x, v.y); w.y = pk2(v.z, v.w); *(u32x2*)(rp + UCOL(bj, n)) = w; } } }
    }
};

__device__ __forceinline__ int rho_to_tok(int rho, int g) { const int sh = 14 - 2 * g; const int rp = rho & 16383; return (rho & ~16383) + (rp >> sh) + ((rp & ((1 << sh) - 1)) << (2 * g)); }
__device__ __forceinline__ int tok_to_rho(int t, int g) { const int sh = 14 - 2 * g; const int tp = t & 16383; return (t & ~16383) + ((tp & ((1 << (2 * g)) - 1)) << sh) + (tp >> (2 * g)); }
struct UnitQ { int type, g, pm, pn; };
struct SchedQKV {
    typedef UnitQ U;
    const bf16* X; const bf16* WqkT; const bf16* WvT; int vcu;
    __device__ __forceinline__ bool next(int i, U& u) const { const int L = i * NWG + vcu; if (L >= 2304) return false;
        const bool qk = L < 1536; const int L2 = L - 1536;
        const int type = qk ? 0 : 1, g = qk ? (L >> 9) : (L2 >> 8), pm = qk ? ((L & 511) >> 2) : (L2 & 1), pn = qk ? (L & 3) : ((L2 & 255) >> 1);
        u.type = type; u.g = g; u.pm = pm; u.pn = pn; return true; }
    __device__ __forceinline__ int K(const U&) const { return D; }
    __device__ __forceinline__ const char* rowA(const U& u, int r) const {
        if (u.type == 0) return (const char*)(X + (size_t)rho_to_tok(u.pm * 256 + r, u.g) * D);
        return (const char*)(WvT + ((size_t)u.g * 512 + u.pm * 256 + r) * D); }
    __device__ __forceinline__ const char* rowB(const U& u, int r) const {
        if (u.type == 0) return (const char*)(WqkT + ((size_t)u.g * 1024 + u.pn * 256 + r) * D);
        return (const char*)(X + (size_t)rho_to_tok(u.pn * 256 + r, u.g) * D); }
};
struct EpiQKV {
    bf16* QK; bf16* VT;
    __device__ __forceinline__ void operator()(const AccT& acc, const UnitQ& u, int wr, int wc, int fr, int fq) const {
        bf16* base; size_t ldc;
        if (u.type == 0) { base = QK + (size_t)u.g * M * 1024; ldc = 1024; } else { base = VT + (size_t)u.g * 512 * M; ldc = M; }
        ROWLOOP { bf16* rp = base + (size_t)(u.pm * 256 + UROW) * ldc + u.pn * 256;
#pragma unroll
            for (int bj = 0; bj < 2; ++bj)
#pragma unroll
                for (int n = 0; n < 2; ++n) { const f32x4 v = acc[ai][bj][m][n]; u32x2 w; w.x = pk2(v.x, v.y); w.y = pk2(v.z, v.w); *(u32x2*)(rp + UCOL(bj, n)) = w; } }
    }
};

__device__ __forceinline__ void tr_item(const float* src, int spitch, bf16* dst, int dpitch, LAS float* scr, int lane) {
#pragma unroll 4
    for (int i = 0; i < 16; ++i) { const int k = 4 * i + (lane >> 4), n4 = (lane & 15) * 4; const f32x4 v = *(const f32x4*)(src + (size_t)k * spitch + n4);
        LAS float* s = scr + k * 65 + n4; s[0] = v.x; s[1] = v.y; s[2] = v.z; s[3] = v.w; }
    LDS_WAIT(); asm volatile("" ::: "memory");
    const int c = lane & 7;
#pragma unroll
    for (int j = 0; j < 8; ++j) { const int n = 8 * j + (lane >> 3); const LAS float* s = scr + (8 * c) * 65 + n;
        u32x4 o; o.x = pk2(s[0], s[65]); o.y = pk2(s[2 * 65], s[3 * 65]); o.z = pk2(s[4 * 65], s[5 * 65]); o.w = pk2(s[6 * 65], s[7 * 65]);
        *(u32x4*)(dst + (size_t)n * dpitch + 8 * c) = o; }
    LDS_WAIT(); asm volatile("" ::: "memory");
}
template <class RowMap>
__device__ __forceinline__ void tr_matrix(Frame& F, const float* W, int K, int N, bf16* WT, int dpitch, RowMap drow) {
    LAS float* scr = (LAS float*)(F.lds + F.wave * 16640);
    const int nkb = K / 64, nnb = N / 64;
    for (int it = F.vcu * NWAVES + F.wave; it < nkb * nnb; it += NGW) { const int kb = it / nnb, nb = it % nnb;
        tr_item(W + (size_t)(kb * 64) * N + nb * 64, N, WT + (size_t)drow(nb * 64) * dpitch + kb * 64, dpitch, scr, F.lane); }
}
__device__ __forceinline__ void convert_experts(Frame& F, const float* w1, const float* w3, const float* w2, const float* s1, const float* s3, const float* s2) {
    LAS float* scr = (LAS float*)(F.lds + F.wave * 16640);
    bf16* W13T = WSP(bf16, WS_W13); bf16* W2T = WSP(bf16, WS_W2);
    for (int it = F.vcu * NWAVES + F.wave; it < 257 * 192; it += NGW) {
        const int e = it / 192, r = it % 192, which = r >> 6, tile = r & 63;
        if (which < 2) {
            const float* W = (e < 256) ? (which == 0 ? w1 : w3) + (size_t)e * (size_t)(D * DE) : (which == 0 ? s1 : s3);
            const int kb = tile >> 2, nb = tile & 3; const int drow = (nb >> 1) * 256 + which * 128 + (nb & 1) * 64;
            tr_item(W + (size_t)(kb * 64) * DE + nb * 64, DE, W13T + ((size_t)e * 512 + drow) * D + kb * 64, D, scr, F.lane);
        } else {
            const float* W = (e < 256) ? w2 + (size_t)e * (size_t)(DE * D) : s2;
            const int kb = tile >> 4, nb = tile & 15;
            tr_item(W + (size_t)(kb * 64) * D + nb * 64, D, W2T + ((size_t)e * D + nb * 64) * DE + kb * 64, DE, scr, F.lane);
        }
    }
}
struct MapId { __device__ int operator()(int n0) const { return n0; } };
struct MapGate { int which; __device__ int operator()(int n0) const { return (n0 >> 7) * 256 + which * 128 + (n0 & 127); } };
struct MapQ { __device__ int operator()(int n0) const { return (n0 >> 9) * 1024 + (n0 & 511); } };
struct MapKV { __device__ int operator()(int n0) const { return n0 < 1536 ? (n0 >> 9) * 1024 + 512 + (n0 & 511) : 3072 + (n0 - 1536); } };

__device__ __forceinline__ void p0_prologue(Frame& F, const Args& A) {
    { const float* x = A.in[0]; bf16* XB = WSP(bf16, WS_RA + RA_XB);
      for (size_t i = (size_t)F.vcu * NTHR + F.tid; i < (size_t)M * D / 8; i += NGT) { const f32x4 a = *(const f32x4*)(x + i * 8), b = *(const f32x4*)(x + i * 8 + 4);
          u32x4 o; o.x = pk2(a.x, a.y); o.y = pk2(a.z, a.w); o.z = pk2(b.x, b.y); o.w = pk2(b.z, b.w); *(u32x4*)(XB + i * 8) = o; } }
    tr_matrix(F, A.in[1], D, 2048, WSP(bf16, WS_WIN), D, MapId());
    for (int b = 0; b < 4; ++b) { tr_matrix(F, A.in[4] + b * 65536, 256, 256, WSP(bf16, WS_WG) + (size_t)b * 512 * 256, 256, MapGate{0});
                                  tr_matrix(F, A.in[6] + b * 65536, 256, 256, WSP(bf16, WS_WG) + (size_t)b * 512 * 256, 256, MapGate{1}); }
    tr_matrix(F, A.in[9], D, D, WSP(bf16, WS_WOUT), D, MapId());
    tr_matrix(F, A.in[11], D, QW, WSP(bf16, WS_WQK), D, MapQ());
    tr_matrix(F, A.in[10], D, 2 * QW, WSP(bf16, WS_WQK), D, MapKV());
    tr_matrix(F, A.in[12], OW, D, WSP(bf16, WS_WO), OW, MapId());
    for (int l = 0; l < 2; ++l) tr_matrix(F, A.in[13] + (size_t)l * D * NE, D, NE, WSP(bf16, WS_WR) + (size_t)l * NE * D, D, MapId());
    convert_experts(F, A.in[15], A.in[16], A.in[17], A.in[18], A.in[19], A.in[20]);
}
static_assert(WS_WV == WS_WQK + (size_t)3072 * 1024 * 2, "WvT must follow WqkT");

__device__ __forceinline__ void ln_store(f32x4 (&v)[4], const float* g, const float* b, float* of, bf16* ob, int lane) {
    float s = 0.f;
#pragma unroll
    for (int j = 0; j < 4; ++j) s += (v[j].x + v[j].y) + (v[j].z + v[j].w);
    const float mean = wave_sum(s) * (1.f / D); float s2 = 0.f;
#pragma unroll
    for (int j = 0; j < 4; ++j) { v[j] = v[j] - mean; s2 += (v[j].x * v[j].x + v[j].y * v[j].y) + (v[j].z * v[j].z + v[j].w * v[j].w); }
    const float rstd = 1.f / sqrtf(wave_sum(s2) * (1.f / D) + LN_EPS);
#pragma unroll
    for (int j = 0; j < 4; ++j) { const int c = 4 * lane + 256 * j; const f32x4 gg = *(const f32x4*)(g + c), bb = *(const f32x4*)(b + c); const f32x4 y = v[j] * rstd * gg + bb;
        if (of) *(f32x4*)(of + c) = y;
        if (ob) { u32x2 w; w.x = pk2(y.x, y.y); w.y = pk2(y.z, y.w); *(u32x2*)(ob + c) = w; } }
}

__device__ __forceinline__ void p_conv(Frame& F, const float* cw, const float* cb) {
    const bf16* XR = WSP(bf16, WS_RA + RA_XR); bf16* XC = WSP(bf16, WS_RA + RA_XC);
    for (int i = F.vcu * NTHR + F.tid; i < M * (D / 8); i += NGT) { const int t = i >> 7, c = (i & 127) * 8; const int ts = t & (SEQ - 1);
        float a[8];
#pragma unroll
        for (int q = 0; q < 8; ++q) a[q] = cb[c + q];
#pragma unroll
        for (int j = 0; j < 4; ++j) { if (ts - 3 + j >= 0) { const u32x4 w = *(const u32x4*)(XR + (size_t)(t - 3 + j) * D + c); const float* wj = cw + j * D + c;
            a[0] += wj[0] * bf_lo(w.x); a[1] += wj[1] * bf_hi(w.x); a[2] += wj[2] * bf_lo(w.y); a[3] += wj[3] * bf_hi(w.y);
            a[4] += wj[4] * bf_lo(w.z); a[5] += wj[5] * bf_hi(w.z); a[6] += wj[6] * bf_lo(w.w); a[7] += wj[7] * bf_hi(w.w); } }
        u32x4 o; o.x = pk2(a[0], a[1]); o.y = pk2(a[2], a[3]); o.z = pk2(a[4], a[5]); o.w = pk2(a[6], a[7]); *(u32x4*)(XC + (size_t)t * D + c) = o; }
}
constexpr int CH = 64, NCH = SEQ / CH;
__device__ __forceinline__ void p_scan1(Frame& F) {
    const float* LA = WSP(float, WS_RA + RA_LA); const float* UU = WSP(float, WS_RA + RA_U); float* CP = WSP(float, WS_CHP); float* CHh = WSP(float, WS_CHH);
    for (int i = F.vcu * NTHR + F.tid; i < BATCH * NCH * (D / 4); i += NGT) { const int c4 = (i & 255) * 4, ck = (i >> 8) & (NCH - 1), b = i >> 16;
        const size_t r0 = ((size_t)b * SEQ + (size_t)ck * CH) * D + c4; f32x4 h = {0.f, 0.f, 0.f, 0.f}, sl = {0.f, 0.f, 0.f, 0.f};
#pragma unroll 4
        for (int t = 0; t < CH; ++t) { const f32x4 la = *(const f32x4*)(LA + r0 + (size_t)t * D), u = *(const f32x4*)(UU + r0 + (size_t)t * D);
#pragma unroll
            for (int j = 0; j < 4; ++j) { h[j] = __expf(la[j]) * h[j] + u[j]; sl[j] += la[j]; } }
#pragma unroll
        for (int j = 0; j < 4; ++j) { const size_t o = ((size_t)b * D + c4 + j) * NCH + ck; CP[o] = __expf(sl[j]); CHh[o] = h[j]; } }
}
__device__ __forceinline__ void p_scan2(Frame& F) {
    const float* CP = WSP(float, WS_CHP); const float* CHh = WSP(float, WS_CHH); float* CIN = WSP(float, WS_CIN);
    for (int s = F.vcu * NWAVES + F.wave; s < BATCH * D; s += NGW) { const size_t o = (size_t)s * NCH + 4 * F.lane;
        const f32x4 p4 = *(const f32x4*)(CP + o), h4 = *(const f32x4*)(CHh + o);
        float p = p4.x, h = h4.x; h = p4.y * h + h4.y; p *= p4.y; h = p4.z * h + h4.z; p *= p4.z; h = p4.w * h + h4.w; p *= p4.w;
#pragma unroll
        for (int off = 1; off < 64; off <<= 1) { const float pp = __shfl_up(p, off), hp = __shfl_up(h, off); if (F.lane >= off) { h = p * hp + h; p = pp * p; } }
        float c0 = __shfl_up(h, 1); if (F.lane == 0) c0 = 0.f;
        f32x4 ci; ci.x = c0; ci.y = p4.x * ci.x + h4.x; ci.z = p4.y * ci.y + h4.y; ci.w = p4.z * ci.z + h4.z;
        *(f32x4*)(CIN + o) = ci; }
}
__device__ __forceinline__ void p_scan3(Frame& F) {
    const float* LA = WSP(float, WS_RA + RA_LA); const float* UU = WSP(float, WS_RA + RA_U); const float* CIN = WSP(float, WS_CIN);
    const bf16* GG = WSP(bf16, WS_RA + RA_GG); bf16* YB = WSP(bf16, WS_RA + RA_YB);
    for (int i = F.vcu * NTHR + F.tid; i < BATCH * NCH * (D / 4); i += NGT) { const int c4 = (i & 255) * 4, ck = (i >> 8) & (NCH - 1), b = i >> 16;
        const size_t r0 = ((size_t)b * SEQ + (size_t)ck * CH) * D + c4; f32x4 h;
#pragma unroll
        for (int j = 0; j < 4; ++j) h[j] = CIN[((size_t)b * D + c4 + j) * NCH + ck];
#pragma unroll 4
        for (int t = 0; t < CH; ++t) { const f32x4 la = *(const f32x4*)(LA + r0 + (size_t)t * D), u = *(const f32x4*)(UU + r0 + (size_t)t * D);
            const u32x2 gw = *(const u32x2*)(GG + r0 + (size_t)t * D);
#pragma unroll
            for (int j = 0; j < 4; ++j) h[j] = __expf(la[j]) * h[j] + u[j];
            u32x2 o; o.x = pk2(h.x * bf_lo(gw.x), h.y * bf_hi(gw.x)); o.y = pk2(h.z * bf_lo(gw.y), h.w * bf_hi(gw.y)); *(u32x2*)(YB + r0 + (size_t)t * D) = o; } }
}
__device__ __forceinline__ void p_ln(Frame& F, const float* V, const float* g, const float* b, float* Hf, bf16* Hb) {
    for (int r = F.vcu * NWAVES + F.wave; r < M; r += NGW) { const f32x4* xr = (const f32x4*)(V + (size_t)r * D) + F.lane; f32x4 v[4];
#pragma unroll
        for (int j = 0; j < 4; ++j) v[j] = xr[64 * j];
        ln_store(v, g, b, Hf + (size_t)r * D, Hb + (size_t)r * D, F.lane); }
}
__device__ __forceinline__ void p_route(Frame& F, const float* bias) {
    const float* LG = WSP(float, WS_LOGITS); int* TOPI = WSP(int, WS_TOPI); float* GATE = WSP(float, WS_GATE); int* HIST = WSP(int, WS_HIST);
    LAS int* hist = (LAS int*)F.lds; const int lane = F.lane;
    if (F.tid < 256) hist[F.tid] = 0;
    __syncthreads();
    const f32x4 bv = *(const f32x4*)(bias + 4 * lane);
    for (int j = 0; j < 16; ++j) { const int t = F.vcu * 128 + F.wave * 16 + j;
        const f32x4 z = *(const f32x4*)(LG + (size_t)t * NE + 4 * lane);
        const float s0 = sigmoidf_(z.x), s1 = sigmoidf_(z.y), s2 = sigmoidf_(z.z), s3 = sigmoidf_(z.w);
        float v0 = s0 + bv.x, v1 = s1 + bv.y, v2 = s2 + bv.z, v3 = s3 + bv.w;
        float m1, m2; { const float a = fmaxf(v0, v1), b = fminf(v0, v1), c = fmaxf(v2, v3), d = fminf(v2, v3); m1 = fmaxf(a, c); m2 = fmaxf(fminf(a, c), fmaxf(b, d)); }
#pragma unroll
        for (int off = 1; off < 8; off <<= 1) { const float o1 = __shfl_xor(m1, off), o2 = __shfl_xor(m2, off); const float n1 = fmaxf(m1, o1), n2 = fmaxf(fminf(m1, o1), fmaxf(m2, o2)); m1 = n1; m2 = n2; }
        const float gs = m1 + m2; const int g = lane >> 3; int rank = 0;
#pragma unroll
        for (int q = 0; q < 8; ++q) { const float o = __shfl(gs, 8 * q); rank += (o > gs || (o == gs && q < g)) ? 1 : 0; }
        if (rank >= 4) { v0 = -1e30f; v1 = -1e30f; v2 = -1e30f; v3 = -1e30f; }
        int myidx = 0; float mys = 0.f;
#pragma unroll
        for (int k = 0; k < TOPK; ++k) {
            float bvv = v0; int bi = 0; if (v1 > bvv) { bvv = v1; bi = 1; } if (v2 > bvv) { bvv = v2; bi = 2; } if (v3 > bvv) { bvv = v3; bi = 3; }
            int idx = 4 * lane + bi;
#pragma unroll
            for (int off = 32; off >= 1; off >>= 1) { const float ov = __shfl_xor(bvv, off); const int oi = __shfl_xor(idx, off); if (ov > bvv || (ov == bvv && oi < idx)) { bvv = ov; idx = oi; } }
            const int q = idx & 3; const float sq = q == 0 ? s0 : (q == 1 ? s1 : (q == 2 ? s2 : s3)); const float sw = __shfl(sq, idx >> 2);
            if ((idx >> 2) == lane) { if (q == 0) v0 = -3e38f; else if (q == 1) v1 = -3e38f; else if (q == 2) v2 = -3e38f; else v3 = -3e38f; }
            if (lane == k) { myidx = idx; mys = sw; }
        }
        const float tot = wave_sum(lane < TOPK ? mys : 0.f);
        if (lane < TOPK) { TOPI[t * TOPK + lane] = myidx; GATE[t * TOPK + lane] = mys / tot * 2.5f; atomicAdd((int*)&hist[myidx], 1); }
    }
    __syncthreads();
    if (F.tid < 256) HIST[F.vcu * 256 + F.tid] = hist[F.tid];
    __syncthreads();
}
__device__ __forceinline__ void p_sort(Frame& F) {
    const int* HIST = WSP(int, WS_HIST); const int* TOPI = WSP(int, WS_TOPI); int* ROWA = WSP(int, WS_ROWA); int* BLKE = WSP(int, WS_BLKE); int* META = WSP(int, WS_META);
    LAS int* cnt = (LAS int*)F.lds; LAS int* myoff = cnt + 256; LAS int* nb = cnt + 512; LAS int* blk0 = cnt + 768; LAS int* lcnt = cnt + 1024;
    if (F.tid < 256) { const int e = F.tid; int c = 0, mo = 0;
        for (int w = 0; w < NWG; ++w) { const int h = HIST[w * 256 + e]; c += h; mo += (w < F.vcu) ? h : 0; }
        cnt[e] = c; myoff[e] = mo; nb[e] = (c + 255) >> 8; lcnt[e] = 0; }
    __syncthreads();
    if (F.tid < 256) { int b = 0; for (int j = 0; j < F.tid; ++j) b += nb[j]; blk0[F.tid] = b; }
    __syncthreads();
    for (int al = F.tid; al < 1024; al += NTHR) { const int a = F.vcu * 1024 + al; const int e = TOPI[a]; const int pos = blk0[e] * 256 + myoff[e] + atomicAdd((int*)&lcnt[e], 1); ROWA[pos] = a; }
    const int nrb = blk0[255] + nb[255];
    { const int e = F.vcu; const int start = blk0[e] * 256 + cnt[e], end = (blk0[e] + nb[e]) * 256;
      for (int p = start + F.tid; p < end; p += NTHR) ROWA[p] = -1;
      for (int j = F.tid; j < nb[e]; j += NTHR) BLKE[blk0[e] + j] = e; }
    for (int tl = F.tid; tl < 128; tl += NTHR) { const int t = F.vcu * 128 + tl; ROWA[nrb * 256 + t] = 8 * M + t; }
    if (F.vcu == 0) { for (int j = F.tid; j < 128; j += NTHR) BLKE[nrb + j] = 256; if (F.tid == 0) META[0] = nrb + 128; }
    __syncthreads();
}
__device__ __forceinline__ void p_combine(Frame& F, const float* Hin, const float* g, const float* b, float* Hf, bf16* Hb) {
    const bf16* YA = WSP(bf16, WS_RA); const float* GATE = WSP(float, WS_GATE);
    for (int t = F.vcu * NWAVES + F.wave; t < M; t += NGW) { f32x4 v[4];
        const f32x4* hr = (const f32x4*)(Hin + (size_t)t * D) + F.lane;
#pragma unroll
        for (int j = 0; j < 4; ++j) v[j] = hr[64 * j] * ALPHA;
        f32x4 r[4];
#pragma unroll
        for (int j = 0; j < 4; ++j) r[j] = (f32x4){0.f, 0.f, 0.f, 0.f};
#pragma unroll
        for (int k = 0; k < TOPK; ++k) { const float gk = GATE[t * TOPK + k]; const u32x2* yr = (const u32x2*)(YA + ((size_t)t * TOPK + k) * D) + F.lane;
#pragma unroll
            for (int j = 0; j < 4; ++j) { const u32x2 w = yr[64 * j]; r[j].x += gk * bf_lo(w.x); r[j].y += gk * bf_hi(w.x); r[j].z += gk * bf_lo(w.y); r[j].w += gk * bf_hi(w.y); } }
        { const u32x2* yr = (const u32x2*)(YA + ((size_t)8 * M + t) * D) + F.lane;
#pragma unroll
            for (int j = 0; j < 4; ++j) { const u32x2 w = yr[64 * j]; v[j].x += r[j].x + bf_lo(w.x); v[j].y += r[j].y + bf_hi(w.x); v[j].z += r[j].z + bf_lo(w.y); v[j].w += r[j].w + bf_hi(w.y); } }
        ln_store(v, g, b, Hf + (size_t)t * D, Hb ? Hb + (size_t)t * D : nullptr, F.lane); }
}
__device__ __forceinline__ void p_attn(Frame& F) {
    const bf16* QKb = WSP(bf16, WS_RA + RA_QK); const bf16* VTb = WSP(bf16, WS_RA + RA_VT); bf16* OGb = WSP(bf16, WS_RA + RA_OG); float* LSE = WSP(float, WS_LSE);
    const int lane = F.lane, q = lane & 31, hh = lane >> 5;
#pragma unroll 1
    for (int it = F.vcu * NWAVES + F.wave; it < 3 * 8192; it += NGW) {
        const int g = it >> 13, rem = it & 8191, tile = rem >> 3, h = rem & 7;
        const int sh = 14 - 2 * g, rq0 = tile * 32, i0 = rq0 & ((1 << sh) - 1);
        const bf16* QK = QKb + (size_t)g * M * 1024; const bf16* VT = VTb + (size_t)g * 512 * M;
        bf16x8 Qf[4];
        { const bf16* qp = QK + (size_t)(rq0 + q) * 1024 + h * 64 + 8 * hh;
#pragma unroll
          for (int s = 0; s < 4; ++s) Qf[s] = *(const bf16x8*)(qp + 16 * s); }
        const float slope2 = exp2f(-(float)(h + 1)) * (float)(1 << (2 * g)) * 1.4426950408889634f, sc = 0.125f * 1.4426950408889634f;
        float m_run = -1e30f, l_run = 0.f; f32x16 O0, O1;
#pragma unroll
        for (int r = 0; r < 16; ++r) { O0[r] = 0.f; O1[r] = 0.f; }
#pragma unroll 1
        for (int kt = 0; kt < 5; ++kt) { const int ik0 = i0 - 128 + 32 * kt; if (ik0 < 0) continue; const int rk0 = rq0 - 128 + 32 * kt;
            bf16x8 Kf[4];
            { const bf16* kp = QK + (size_t)(rk0 + q) * 1024 + 512 + h * 64 + 8 * hh;
#pragma unroll
              for (int s = 0; s < 4; ++s) Kf[s] = *(const bf16x8*)(kp + 16 * s); }
            bf16x8 Vf[2][2];
#pragma unroll
            for (int dd = 0; dd < 2; ++dd)
#pragma unroll
                for (int s = 0; s < 2; ++s) { const bf16* vp = VT + (size_t)(h * 64 + 32 * dd + q) * M + rk0 + 16 * s + 4 * hh;
                    const u32x2 lo = *(const u32x2*)vp, hi = *(const u32x2*)(vp + 8); u32x4 w; w.x = lo.x; w.y = lo.y; w.z = hi.x; w.w = hi.y; Vf[dd][s] = __builtin_bit_cast(bf16x8, w); }
            f32x16 S;
#pragma unroll
            for (int r = 0; r < 16; ++r) S[r] = 0.f;
#pragma unroll
            for (int s = 0; s < 4; ++s) S = __builtin_amdgcn_mfma_f32_32x32x16_bf16(Kf[s], Qf[s], S, 0, 0, 0);
            float mx = -1e30f;
#pragma unroll
            for (int r = 0; r < 16; ++r) { const int krow = (r & 3) + 8 * (r >> 2) + 4 * hh; const int dist = 128 - 32 * kt + q - krow;
                const float sv = (dist >= 0 && dist <= 128) ? S[r] * sc - slope2 * (float)dist : -1e30f; S[r] = sv; mx = fmaxf(mx, sv); }
            mx = fmaxf(mx, __shfl_xor(mx, 32));
            const float m_new = fmaxf(m_run, mx), alpha = exp2f(m_run - m_new); float rs = 0.f;
#pragma unroll
            for (int r = 0; r < 16; ++r) { const float p = exp2f(S[r] - m_new); S[r] = p; rs += p; }
            rs += __shfl_xor(rs, 32);
            l_run = l_run * alpha + rs; m_run = m_new;
#pragma unroll
            for (int r = 0; r < 16; ++r) { O0[r] *= alpha; O1[r] *= alpha; }
            bf16x8 Pf[2];
#pragma unroll
            for (int s = 0; s < 2; ++s) { u32x4 w; w.x = pk2(S[8 * s + 0], S[8 * s + 1]); w.y = pk2(S[8 * s + 2], S[8 * s + 3]); w.z = pk2(S[8 * s + 4], S[8 * s + 5]); w.w = pk2(S[8 * s + 6], S[8 * s + 7]); Pf[s] = __builtin_bit_cast(bf16x8, w); }
#pragma unroll
            for (int s = 0; s < 2; ++s) { O0 = __builtin_amdgcn_mfma_f32_32x32x16_bf16(Vf[0][s], Pf[s], O0, 0, 0, 0); O1 = __builtin_amdgcn_mfma_f32_32x32x16_bf16(Vf[1][s], Pf[s], O1, 0, 0, 0); }
        }
        const float inv = 1.0f / l_run;
        bf16* op = OGb + ((size_t)g * M + rq0 + q) * 512 + h * 64 + 4 * hh;
#pragma unroll
        for (int rg = 0; rg < 4; ++rg) { u32x2 w; w.x = pk2(O0[4 * rg] * inv, O0[4 * rg + 1] * inv); w.y = pk2(O0[4 * rg + 2] * inv, O0[4 * rg + 3] * inv); *(u32x2*)(op + 8 * rg) = w;
            u32x2 w1; w1.x = pk2(O1[4 * rg] * inv, O1[4 * rg + 1] * inv); w1.y = pk2(O1[4 * rg + 2] * inv, O1[4 * rg + 3] * inv); *(u32x2*)(op + 32 + 8 * rg) = w1; }
        if (hh == 0) LSE[((size_t)g * M + rq0 + q) * 8 + h] = (m_run + log2f(l_run)) * 0.6931471805599453f;
    }
}
__device__ __forceinline__ void p_merge(Frame& F) {
    const bf16* OGb = WSP(bf16, WS_RA + RA_OG); const float* LSE = WSP(float, WS_LSE); bf16* OM = WSP(bf16, WS_RA + RA_OM);
    for (int t = F.vcu * NWAVES + F.wave; t < M; t += NGW) { const int hd = F.lane >> 3; float ls[3]; size_t ro[3];
#pragma unroll
        for (int g = 0; g < 3; ++g) { const int rho = tok_to_rho(t, g); ro[g] = ((size_t)g * M + rho); ls[g] = LSE[ro[g] * 8 + hd]; }
        const float mx = fmaxf(ls[0], fmaxf(ls[1], ls[2])); float w[3], ws = 0.f;
#pragma unroll
        for (int g = 0; g < 3; ++g) { w[g] = __expf(ls[g] - mx); ws += w[g]; }
        const float inv = 1.0f / ws; float o[8];
#pragma unroll
        for (int j = 0; j < 8; ++j) o[j] = 0.f;
#pragma unroll
        for (int g = 0; g < 3; ++g) { const u32x4 x = *(const u32x4*)(OGb + ro[g] * 512 + 8 * F.lane); const float wg = w[g] * inv;
            o[0] += wg * bf_lo(x.x); o[1] += wg * bf_hi(x.x); o[2] += wg * bf_lo(x.y); o[3] += wg * bf_hi(x.y); o[4] += wg * bf_lo(x.z); o[5] += wg * bf_hi(x.z); o[6] += wg * bf_lo(x.w); o[7] += wg * bf_hi(x.w); }
        u32x4 r; r.x = pk2(o[0], o[1]); r.y = pk2(o[2], o[3]); r.z = pk2(o[4], o[5]); r.w = pk2(o[6], o[7]); *(u32x4*)(OM + (size_t)t * OW + 8 * F.lane) = r; }
}

constexpr int NPHASE = 26;

__global__ void __launch_bounds__(NTHR, 2) yoco_fwd(Args args) {
    extern __shared__ __attribute__((aligned(16))) unsigned char lds[];
    Frame F;
    F.lds = (LAS unsigned char*)lds;
    F.tid = threadIdx.x; F.lane = F.tid & 63; F.wave = __builtin_amdgcn_readfirstlane(F.tid >> 6);
    { const int bx = blockIdx.x; F.vcu = (bx % 8) * (NWG / 8) + bx / 8; }
    F.ws = args.ws;
    volatile LAS unsigned* MISC = (volatile LAS unsigned*)(F.lds + LDS_BYTES - 64);
    if (F.tid < 16) MISC[F.tid] = 0u;
    __syncthreads();
    const int lo = args.ph_lo, hi = args.ph_hi;
    XcdBarrier bar; bar.bar = (unsigned*)(F.ws + WS_CTL) + 4096; bar.x = 0; bar.st = nullptr;
    if (hi - lo > 1) bar = xcd_barrier_post((unsigned*)(F.ws + WS_CTL) + 4096, MISC + 8);
#ifndef PH_MASK
#define PH_MASK 0xFFFFFFFFu
#endif
#define IN(k) (((PH_MASK >> (k)) & 1u) && lo <= (k) && (k) < hi)
#define SEAM(k) do { if (IN(k) && IN((k) + 1)) xcd_barrier(bar); } while (0)

    if (IN(0)) { p0_prologue(F, args); } SEAM(0);
    if (IN(1)) { SchedDense S{WSP(bf16, WS_RA + RA_XB), WSP(bf16, WS_WIN), D, D, D, M / 256, 8, F.vcu}; EpiXZ E{WSP(bf16, WS_RA + RA_XR), WSP(bf16, WS_RA + RA_GG)}; GEMM_PHASE(F.lds, S, E); } SEAM(1);
    if (IN(2)) { p_conv(F, args.in[2], args.in[3]); } SEAM(2);
    if (IN(3)) { SchedGate S{WSP(bf16, WS_RA + RA_XC), WSP(bf16, WS_WG), F.vcu}; EpiGate E{WSP(bf16, WS_RA + RA_XC), args.in[5], args.in[7], args.in[8], WSP(float, WS_RA + RA_LA), WSP(float, WS_RA + RA_U)}; GEMM_PHASE(F.lds, S, E); } SEAM(3);
    if (IN(4)) { p_scan1(F); } SEAM(4);
    if (IN(5)) { p_scan2(F); } SEAM(5);
    if (IN(6)) { p_scan3(F); } SEAM(6);
    if (IN(7)) { SchedDense S{WSP(bf16, WS_RA + RA_YB), WSP(bf16, WS_WOUT), D, D, D, M / 256, 4, F.vcu}; EpiResF32 E{args.in[0], WSP(float, WS_V), D}; GEMM_PHASE(F.lds, S, E); } SEAM(7);
    if (IN(8)) { p_ln(F, WSP(float, WS_V), args.in[21] + 0 * D, args.in[22] + 0 * D, WSP(float, WS_HA), WSP(bf16, WS_HAB)); } SEAM(8);
    if (IN(9)) { SchedDense S{WSP(bf16, WS_HAB), WSP(bf16, WS_WR), D, D, D, M / 256, 1, F.vcu}; EpiF32 E{WSP(float, WS_LOGITS), NE}; GEMM_PHASE(F.lds, S, E); } SEAM(9);
    if (IN(10)) { p_route(F, args.in[14]); } SEAM(10);
    if (IN(11)) { p_sort(F); } SEAM(11);
    if (IN(12)) { SchedG1 S{WSP(bf16, WS_HAB), WSP(bf16, WS_W13), WSP(int, WS_ROWA), WSP(int, WS_BLKE), *WSP(int, WS_META), F.vcu}; EpiSwiGLU E{WSP(bf16, WS_HID)}; GEMM_PHASE(F.lds, S, E); } SEAM(12);
    if (IN(13)) { SchedG2 S{WSP(bf16, WS_HID), WSP(bf16, WS_W2), WSP(int, WS_BLKE), *WSP(int, WS_META), F.vcu}; EpiScatter E{WSP(bf16, WS_RA), WSP(int, WS_ROWA)}; GEMM_PHASE(F.lds, S, E); } SEAM(13);
    if (IN(14)) { p_combine(F, WSP(float, WS_HA), args.in[21] + 1 * D, args.in[22] + 1 * D, WSP(float, WS_HB), WSP(bf16, WS_HBB)); convert_experts(F, args.in[15] + (size_t)NE * D * DE, args.in[16] + (size_t)NE * D * DE, args.in[17] + (size_t)NE * D * DE, args.in[18] + (size_t)D * DE, args.in[19] + (size_t)D * DE, args.in[20] + (size_t)D * DE); } SEAM(14);
    if (IN(15)) { SchedQKV S{WSP(bf16, WS_HBB), WSP(bf16, WS_WQK), WSP(bf16, WS_WV), F.vcu}; EpiQKV E{WSP(bf16, WS_RA + RA_QK), WSP(bf16, WS_RA + RA_VT)}; GEMM_PHASE(F.lds, S, E); } SEAM(15);
    if (IN(16)) { p_attn(F); } SEAM(16);
    if (IN(17)) { p_merge(F); } SEAM(17);
    if (IN(18)) { SchedDense S{WSP(bf16, WS_RA + RA_OM), WSP(bf16, WS_WO), OW, OW, OW, M / 256, 4, F.vcu}; EpiResF32 E{WSP(float, WS_HB), WSP(float, WS_V), D}; GEMM_PHASE(F.lds, S, E); } SEAM(18);
    if (IN(19)) { p_ln(F, WSP(float, WS_V), args.in[21] + 2 * D, args.in[22] + 2 * D, WSP(float, WS_HA), WSP(bf16, WS_HAB)); } SEAM(19);
    if (IN(20)) { SchedDense S{WSP(bf16, WS_HAB), WSP(bf16, WS_WR) + (size_t)NE * D, D, D, D, M / 256, 1, F.vcu}; EpiF32 E{WSP(float, WS_LOGITS), NE}; GEMM_PHASE(F.lds, S, E); } SEAM(20);
    if (IN(21)) { p_route(F, args.in[14] + NE); } SEAM(21);
    if (IN(22)) { p_sort(F); } SEAM(22);
    if (IN(23)) { SchedG1 S{WSP(bf16, WS_HAB), WSP(bf16, WS_W13), WSP(int, WS_ROWA), WSP(int, WS_BLKE), *WSP(int, WS_META), F.vcu}; EpiSwiGLU E{WSP(bf16, WS_HID)}; GEMM_PHASE(F.lds, S, E); } SEAM(23);
    if (IN(24)) { SchedG2 S{WSP(bf16, WS_HID), WSP(bf16, WS_W2), WSP(int, WS_BLKE), *WSP(int, WS_META), F.vcu}; EpiScatter E{WSP(bf16, WS_RA), WSP(int, WS_ROWA)}; GEMM_PHASE(F.lds, S, E); } SEAM(24);
    if (IN(25)) { p_combine(F, WSP(float, WS_HA), args.in[21] + 3 * D, args.in[22] + 3 * D, args.out, nullptr); }
#undef IN
#undef SEAM
}

extern "C" void kernel_launch(void* const* d_in, const int* in_sizes, int n_in, void* d_out, int out_size, void* d_ws, size_t ws_size, hipStream_t stream) {
    static int ok = 0;
    if (ok == 0) {
        if (n_in != 23 || in_sizes[0] != M * D || out_size != M * D || ws_size < WS_END) { fprintf(stderr, "kernel_launch: unexpected shapes (n_in %d, in0 %d, out %d, ws %zu < %zu)\n", n_in, n_in > 0 ? in_sizes[0] : -1, out_size, ws_size, (size_t)WS_END); ok = -1; return; }
        if (hipFuncSetAttribute((const void*)yoco_fwd, hipFuncAttributeMaxDynamicSharedMemorySize, LDS_BYTES) != hipSuccess) { fprintf(stderr, "kernel_launch: hipFuncSetAttribute failed\n"); ok = -1; return; }
        int per_cu = 0;
        if (hipOccupancyMaxActiveBlocksPerMultiprocessor(&per_cu, (const void*)yoco_fwd, NTHR, LDS_BYTES) != hipSuccess || per_cu < 1) fprintf(stderr, "kernel_launch: occupancy query says %d\n", per_cu);
        (void)hipGetLastError();
        ok = 1;
    }
    if (ok < 0) return;
    if (hipMemsetAsync((char*)d_ws + WS_CTL, 0, CTL_ZERO_BYTES, stream) != hipSuccess) return;
    Args a{};
    for (int i = 0; i < 23; ++i) a.in[i] = (const float*)d_in[i];
    a.out = (float*)d_out; a.ws = (unsigned char*)d_ws;
#if MK_ONE_LAUNCH
    a.ph_lo = 0; a.ph_hi = NPHASE;
    hipLaunchKernelGGL(yoco_fwd, dim3(NWG), dim3(NTHR), LDS_BYTES, stream, a);
#else
    for (int p = 0; p < NPHASE; ++p) { a.ph_lo = p; a.ph_hi = p + 1; hipLaunchKernelGGL(yoco_fwd, dim3(NWG), dim3(NTHR), LDS_BYTES, stream, a); }
#endif
}
```

```cpp
#include <hip/hip_runtime.h>
#include <cstdio>
#include <cstdint>

#ifndef MK_ONE_LAUNCH
#define MK_ONE_LAUNCH 1
#endif

constexpr int D = 1024, BATCH = 2, SEQ = 16384, M = BATCH * SEQ;
constexpr int NE = 256, TOPK = 8, DE = 256;
constexpr int HEADS = 8, HD = 64, QW = 1536, OW = 512;
constexpr float LN_EPS = 1e-5f, ALPHA = 1.41421356237f;
constexpr int RBMAX = 1024 + 256 + 128;
constexpr int NWG = 256, NTHR = 512, NWAVES = 8;
constexpr int NGW = NWG * NWAVES, NGT = NWG * NTHR;

constexpr size_t MiB = 1u << 20;
constexpr size_t WS_CTL = 0, CTL_ZERO_BYTES = 1 * MiB;
constexpr size_t WS_HIST = 1 * MiB, WS_BLKE = 1 * MiB + 512 * 1024, WS_META = 1 * MiB + 768 * 1024;
constexpr size_t WS_ROWA = 2 * MiB, WS_TOPI = 4 * MiB, WS_GATE = 5 * MiB, WS_CHP = 6 * MiB, WS_CHH = 8 * MiB, WS_CIN = 10 * MiB, WS_LSE = 12 * MiB;
constexpr size_t WS_WIN = 16 * MiB, WS_WG = 20 * MiB, WS_WOUT = 21 * MiB, WS_WQK = 23 * MiB, WS_WV = 29 * MiB, WS_WO = 32 * MiB, WS_WR = 33 * MiB;
constexpr size_t WS_LOGITS = 34 * MiB;
constexpr size_t WS_W13 = 66 * MiB, WS_W2 = 323 * MiB;
constexpr size_t WS_V = 452 * MiB, WS_HA = 580 * MiB, WS_HAB = 708 * MiB, WS_HB = 772 * MiB, WS_HBB = 900 * MiB, WS_HID = 964 * MiB;
constexpr size_t WS_RA = 1140 * MiB;
constexpr size_t RA_XB = 0, RA_XR = 64 * MiB, RA_GG = 128 * MiB, RA_XC = 192 * MiB, RA_LA = 256 * MiB, RA_U = 384 * MiB, RA_YB = 512 * MiB;
constexpr size_t RA_QK = 0, RA_VT = 192 * MiB, RA_OG = 288 * MiB, RA_OM = 384 * MiB;
constexpr size_t WS_POS = 15 * MiB;
constexpr size_t WS_END = 1844 * MiB;

constexpr int LDS_BYTES = 147456;

#define GAS __attribute__((address_space(1)))
#define LAS __attribute__((address_space(3)))
typedef unsigned short bf16;
typedef unsigned u32x4 __attribute__((ext_vector_type(4)));
typedef unsigned u32x2 __attribute__((ext_vector_type(2)));
typedef float f32x4 __attribute__((ext_vector_type(4)));
typedef float f32x16 __attribute__((ext_vector_type(16)));
typedef short bf16x8 __attribute__((ext_vector_type(8)));
typedef GAS unsigned gu32;
#define RLX_AGENT __ATOMIC_RELAXED, __HIP_MEMORY_SCOPE_AGENT
#define LDS_WAIT() asm volatile("s_waitcnt lgkmcnt(0)" ::: "memory")
#define VM_WAIT() asm volatile("s_waitcnt vmcnt(0)" ::: "memory")

__device__ __forceinline__ unsigned pk2(float lo, float hi) { unsigned r; asm("v_cvt_pk_bf16_f32 %0, %1, %2" : "=v"(r) : "v"(lo), "v"(hi)); return r; }
__device__ __forceinline__ float bf_lo(unsigned w) { return __uint_as_float(w << 16); }
__device__ __forceinline__ float bf_hi(unsigned w) { return __uint_as_float(w & 0xffff0000u); }
__device__ __forceinline__ float wave_sum(float v) {
#pragma unroll
    for (int o = 1; o < 64; o <<= 1) v += __shfl_xor(v, o);
    return v;
}
__device__ __forceinline__ float gelu_tanh(float x) {
    const float u = 0.7978845608028654f * (x + 0.044715f * x * x * x);
    const float e = __expf(2.0f * u);
    const float t = 1.0f - 2.0f / (e + 1.0f);
    return 0.5f * x * (1.0f + t);
}
__device__ __forceinline__ float sigmoidf_(float x) { return 1.0f / (1.0f + __expf(-x)); }

#define XB_TMO      128
#define XB_XCNT(j)  (256  + 64 * (j))
#define XB_XSUB(j)  (1280 + 64 * (j))
#define XB_XGEN(j)  (2304 + 64 * (j))
#define XB_TOP      3328
#define XB_TOPGEN   3392
#define XCD_BAR_WORDS 3456
#define XB_SPIN_CAP (1u << 18)
__device__ __forceinline__ unsigned xb_ld(unsigned* p)              { return __hip_atomic_load(p, __ATOMIC_RELAXED, __HIP_MEMORY_SCOPE_AGENT); }
__device__ __forceinline__ unsigned xb_add(unsigned* p, unsigned v) { return __hip_atomic_fetch_add(p, v, __ATOMIC_RELAXED, __HIP_MEMORY_SCOPE_AGENT); }
__device__ __forceinline__ unsigned xb_xcc_id() { return (unsigned)__builtin_amdgcn_s_getreg((3 << 11) | 20) & 0xFu; }
#define XB_SPIN(cond, bar) do { unsigned _sp = 0; while (cond) { __builtin_amdgcn_s_sleep(1); \
    if ((++_sp & 255u) == 0u) { if (xb_ld(&(bar)[XB_TMO])) break; if (_sp > XB_SPIN_CAP) { atomicAdd(&(bar)[XB_TMO], 1u); break; } } } } while (0)
struct XcdBarrier { unsigned* bar; unsigned x; volatile LAS unsigned* st; };
__device__ __forceinline__ XcdBarrier xcd_barrier_post(unsigned* bar, volatile LAS unsigned* st) {
    XcdBarrier b; b.bar = bar; b.x = xb_xcc_id(); b.st = st;
    if (threadIdx.x == 0) (void)xb_add(&bar[XB_XCNT(b.x)], 1u);
    return b;
}
__device__ __forceinline__ void xcd_barrier_complete(unsigned* bar, unsigned x, unsigned& nloc, unsigned& nx) {
    const unsigned G = gridDim.x * gridDim.y * gridDim.z;
    unsigned sum, cnt, mine, sp = 0u;
    for (;;) {
        sum = 0u; cnt = 0u; mine = 0u;
#pragma unroll
        for (unsigned j = 0; j < 16; ++j) { const unsigned c = xb_ld(&bar[XB_XCNT(j)]); sum += c; cnt += (c > 0u) ? 1u : 0u; mine = (j == x) ? c : mine; }
        if (sum == G) break;
        __builtin_amdgcn_s_sleep(1);
        if ((++sp & 255u) == 0u) { if (xb_ld(&bar[XB_TMO])) break; if (sp > XB_SPIN_CAP) { atomicAdd(&bar[XB_TMO], 1u); break; } }
    }
    nloc = mine > 0u ? mine : 1u; nx = cnt > 0u ? cnt : 1u;
}
__device__ __forceinline__ void xcd_barrier(const XcdBarrier& b) {
    asm volatile("s_waitcnt vmcnt(0)" ::: "memory");
    __syncthreads();
    if (threadIdx.x == 0) {
        unsigned* bar = b.bar;
        __builtin_amdgcn_s_waitcnt(0);
        unsigned nloc = b.st[0], nx = b.st[1];
        if (nloc == 0u) { xcd_barrier_complete(bar, b.x, nloc, nx); b.st[0] = nloc; b.st[1] = nx; }
        const unsigned old = xb_add(&bar[XB_XSUB(b.x)], 1u);
        const unsigned gen = old / nloc;
        if (old + 1u == (gen + 1u) * nloc) {
            __builtin_amdgcn_fence(__ATOMIC_RELEASE, "agent");
            asm volatile("s_waitcnt vmcnt(0)" ::: "memory");
            const unsigned og = xb_add(&bar[XB_TOP], 1u);
            const unsigned tg = og / nx;
            if (og + 1u == (tg + 1u) * nx) xb_add(&bar[XB_TOPGEN], 1u);
            else XB_SPIN(xb_ld(&bar[XB_TOPGEN]) == tg, bar);
            __builtin_amdgcn_fence(__ATOMIC_ACQUIRE, "agent");
            xb_add(&bar[XB_XGEN(b.x)], 1u);
            asm volatile("s_waitcnt vmcnt(0)" ::: "memory");
        } else {
            XB_SPIN(xb_ld(&bar[XB_XGEN(b.x)]) == gen, bar);
            __builtin_amdgcn_fence(__ATOMIC_ACQUIRE, "agent");
            asm volatile("s_waitcnt vmcnt(0)" ::: "memory");
        }
    }
    __syncthreads();
}

struct Args { const float* in[23]; float* out; unsigned char* ws; int ph_lo, ph_hi; unsigned dup; int dry; };
static_assert(sizeof(Args) == 23 * 8 + 8 + 8 + 16, "Args has no padding");
struct Frame {
    LAS unsigned char* lds;
    int tid, lane, wave, vcu;
    unsigned char* ws;
};
#define WSP(T, off) ((T*)(F.ws + (off)))

template <class S, class E>
__device__ __forceinline__ void gemm_simple(LAS unsigned char* lds, const S& sch, const E& epi) {
    const int tid = threadIdx.x, wid = tid >> 6, lane = tid & 63, wr = wid >> 2, wc = wid & 3, fr = lane & 15, fq = lane >> 4;
    constexpr int PITCH = 144;
    LAS unsigned char* As = lds; LAS unsigned char* Bs = lds + 256 * PITCH;
    typename S::U u;
    for (int i = 0; sch.next(i, u); ++i) {
        f32x4 acc[2][2][4][2];
#pragma unroll
        for (int a = 0; a < 2; ++a)
#pragma unroll
            for (int b = 0; b < 2; ++b)
#pragma unroll
                for (int m = 0; m < 4; ++m)
#pragma unroll
                    for (int n = 0; n < 2; ++n) acc[a][b][m][n] = (f32x4){0.f, 0.f, 0.f, 0.f};
        const int nt = sch.K(u) / 64;
        const char* pa[4]; const char* pb[4];
#pragma unroll
        for (int j = 0; j < 4; ++j) { const int row = (tid >> 3) + 64 * j; const int rb = S::PERM ? ((row & ~31) + 8 * ((row & 15) >> 2) + 4 * ((row >> 4) & 1) + (row & 3)) : row; pa[j] = sch.rowA(u, row) + (tid & 7) * 16; pb[j] = sch.rowB(u, rb) + (tid & 7) * 16; }
        for (int kt = 0; kt < nt; ++kt) {
            u32x4 va[4], vb[4];
#pragma unroll
            for (int j = 0; j < 4; ++j) { va[j] = *(const u32x4*)(pa[j] + kt * 128); vb[j] = *(const u32x4*)(pb[j] + kt * 128); }
            __syncthreads();
#pragma unroll
            for (int j = 0; j < 4; ++j) { const int row = (tid >> 3) + 64 * j;
                *(LAS u32x4*)(As + row * PITCH + (tid & 7) * 16) = va[j]; *(LAS u32x4*)(Bs + row * PITCH + (tid & 7) * 16) = vb[j]; }
            __syncthreads();
#pragma unroll
            for (int kk = 0; kk < 2; ++kk) {
                bf16x8 Bf[2][2];
#pragma unroll
                for (int b = 0; b < 2; ++b)
#pragma unroll
                    for (int n = 0; n < 2; ++n) Bf[b][n] = *(const LAS bf16x8*)(Bs + (b * 128 + wc * 32 + n * 16 + fr) * PITCH + kk * 64 + fq * 16);
#pragma unroll
                for (int a = 0; a < 2; ++a) {
                    bf16x8 Af[4];
#pragma unroll
                    for (int m = 0; m < 4; ++m) Af[m] = *(const LAS bf16x8*)(As + (a * 128 + wr * 64 + m * 16 + fr) * PITCH + kk * 64 + fq * 16);
#pragma unroll
                    for (int b = 0; b < 2; ++b)
#pragma unroll
                        for (int m = 0; m < 4; ++m)
#pragma unroll
                            for (int n = 0; n < 2; ++n) acc[a][b][m][n] = __builtin_amdgcn_mfma_f32_16x16x32_bf16(Bf[b][n], Af[m], acc[a][b][m][n], 0, 0, 0);
                }
            }
        }
        epi(acc, u, wr, wc, fr, fq);
    }
    __syncthreads();
}

namespace pg8 {
constexpr int HTB = 128 * 64 * 2;
__device__ __forceinline__ int lds_byte(int r, int c) { const int st = (r >> 4) * 2 + (c >> 5), rr = r & 15, cc = c & 31, ob = rr * 64 + cc * 2; return st * 1024 + (ob ^ (((ob >> 9) & 1) << 5)); }
__device__ __forceinline__ int perm32(int rho) { const int n = rho >> 4, i = rho & 15; return 8 * (i >> 2) + 4 * n + (i & 3); }
__device__ __forceinline__ int prow(int r) { return (r & ~31) + perm32(r & 31); }
__device__ __forceinline__ void stage_rc(int b, int& R, int& C) { const int st = b / 1024, sb = b % 1024, swz = sb ^ (((sb >> 9) & 1) << 5); R = (st >> 1) * 16 + swz / 64; C = (st & 1) * 32 + (swz % 64) / 2; }
}
template <class S, class E>
__device__ __forceinline__ void gemm_fast(LAS unsigned char* lds, const S& sch, const E& epi) {
    using namespace pg8;
    const int tid = threadIdx.x, wid = __builtin_amdgcn_readfirstlane(tid >> 6), lane = tid & 63, wr = wid >> 2, wc = wid & 3, fr = lane & 15, fq = lane >> 4;
    const int nt = sch.Kk / 64;
    int R0, C0; stage_rc(tid * 16, R0, C0);
    unsigned voffA[2], voffB[2]; unsigned cofA[4], nofA[4], cofB[4], nofB[4];
    size_t hstepA = 0, hstepB = 0;
    if constexpr (!S::GA) { voffA[0] = (unsigned)(R0 * sch.lda + C0) * 2u; voffA[1] = (unsigned)((R0 + 64) * sch.lda + C0) * 2u; hstepA = (size_t)128 * sch.lda * 2; }
    const int RB0 = S::PERM ? prow(R0) : R0;
    if constexpr (!S::GB) { voffB[0] = (unsigned)(RB0 * sch.ldb + C0) * 2u; voffB[1] = (unsigned)((RB0 + 64) * sch.ldb + C0) * 2u; hstepB = (size_t)128 * sch.ldb * 2; }
    const size_t kstep = 128;
    const unsigned ldsw = (unsigned)wid * 1024u;
    const int aoff = lds_byte(wr * 64 + fr, fq * 8), boff = lds_byte(wc * 32 + fr, fq * 8);
#define G_SA(b, h) (((b) * 2 + (h)) * HTB)
#define G_SB(b, h) ((4 + (b) * 2 + (h)) * HTB)
#define G_GLDS(src, dst) __builtin_amdgcn_global_load_lds((const unsigned*)(src), (LAS unsigned*)(dst), 16, 0, 0)
#define G_STAGE_A(bufoff, gp, h, nx) do { if constexpr (S::GA) { _Pragma("unroll") for (int _i = 0; _i < 2; ++_i) { const unsigned _o = (nx) ? nofA[2 * (h) + _i] : cofA[2 * (h) + _i]; G_GLDS((gp) + _o, lds + (bufoff) + ldsw + _i * 8192); } } \
        else { _Pragma("unroll") for (int _i = 0; _i < 2; ++_i) G_GLDS((gp) + (size_t)(h) * hstepA + voffA[_i], lds + (bufoff) + ldsw + _i * 8192); } } while (0)
#define G_STAGE_B(bufoff, gp, h, nx) do { if constexpr (S::GB) { _Pragma("unroll") for (int _i = 0; _i < 2; ++_i) { const unsigned _o = (nx) ? nofB[2 * (h) + _i] : cofB[2 * (h) + _i]; G_GLDS((gp) + _o, lds + (bufoff) + ldsw + _i * 8192); } } \
        else { _Pragma("unroll") for (int _i = 0; _i < 2; ++_i) G_GLDS((gp) + (size_t)(h) * hstepB + voffB[_i], lds + (bufoff) + ldsw + _i * 8192); } } while (0)
#define G_LDA(dst, b, h) do { _Pragma("unroll") for (int m = 0; m < 4; ++m) _Pragma("unroll") for (int k = 0; k < 2; ++k) dst[m][k] = *(const LAS bf16x8*)(lds + G_SA(b, h) + aoff + m * 2048 + k * 1024); } while (0)
#define G_LDB(dst, b, h) do { _Pragma("unroll") for (int n = 0; n < 2; ++n) _Pragma("unroll") for (int k = 0; k < 2; ++k) dst[n][k] = *(const LAS bf16x8*)(lds + G_SB(b, h) + boff + n * 2048 + k * 1024); } while (0)
#define G_MMA(ai, bj, At, Bt) do { __builtin_amdgcn_s_setprio(1); _Pragma("unroll") for (int m = 0; m < 4; ++m) _Pragma("unroll") for (int n = 0; n < 2; ++n) _Pragma("unroll") for (int k = 0; k < 2; ++k) \
        acc[ai][bj][m][n] = __builtin_amdgcn_mfma_f32_16x16x32_bf16(Bt[n][k], At[m][k], acc[ai][bj][m][n], 0, 0, 0); __builtin_amdgcn_s_setprio(0); } while (0)
#define G_WAIT_V(n) asm volatile("s_waitcnt vmcnt(" #n ")" ::: "memory")
#define G_WAIT_L(n) asm volatile("s_waitcnt lgkmcnt(" #n ")" ::: "memory")
#define G_BAR __builtin_amdgcn_s_barrier()
#define G_SCHED __builtin_amdgcn_sched_barrier(0)
    typename S::U cur, nxt; int ui = 0;
    if (!sch.next(0, cur)) return;
    f32x4 acc[2][2][4][2];
#pragma unroll
    for (int a = 0; a < 2; ++a)
#pragma unroll
        for (int b = 0; b < 2; ++b)
#pragma unroll
            for (int m = 0; m < 4; ++m)
#pragma unroll
                for (int n = 0; n < 2; ++n) acc[a][b][m][n] = (f32x4){0.f, 0.f, 0.f, 0.f};
    bf16x8 At[4][2], B0[2][2], B1[2][2];
    const char* cA = sch.baseA(cur); const char* cB = sch.baseB(cur);
    if constexpr (S::GA) {
#pragma unroll
        for (int j = 0; j < 4; ++j) { cofA[j] = sch.goffA(cur, (j >> 1) * 128 + R0 + (j & 1) * 64, C0); nofA[j] = cofA[j]; } }
    if constexpr (S::GB) {
#pragma unroll
        for (int j = 0; j < 4; ++j) { cofB[j] = sch.goffB(cur, (j >> 1) * 128 + RB0 + (j & 1) * 64, C0); nofB[j] = cofB[j]; } }
    G_STAGE_B(G_SB(0, 0), cB, 0, false); G_STAGE_B(G_SB(0, 1), cB, 1, false); G_STAGE_A(G_SA(0, 0), cA, 0, false); G_STAGE_A(G_SA(0, 1), cA, 1, false);
    if (wr == 1) G_BAR;
    G_WAIT_V(2); G_BAR;
    G_STAGE_B(G_SB(1, 0), cB + kstep, 0, false); G_STAGE_A(G_SA(1, 0), cA + kstep, 0, false); G_STAGE_B(G_SB(1, 1), cB + kstep, 1, false);
    G_WAIT_V(6); G_BAR;
    for (;;) {
        const bool has_next = sch.next(ui + 1, nxt);
        const char* nA = has_next ? sch.baseA(nxt) : cA; const char* nB = has_next ? sch.baseB(nxt) : cB;
        if constexpr (S::GA) { if (has_next) {
#pragma unroll
            for (int j = 0; j < 4; ++j) nofA[j] = sch.goffA(nxt, (j >> 1) * 128 + R0 + (j & 1) * 64, C0); } }
        if constexpr (S::GB) { if (has_next) {
#pragma unroll
            for (int j = 0; j < 4; ++j) nofB[j] = sch.goffB(nxt, (j >> 1) * 128 + RB0 + (j & 1) * 64, C0); } }
#pragma unroll 1
        for (int t = 0; t < nt; t += 2) {
            const bool last = (t == nt - 2);
            const char* a1 = cA + (size_t)(t + 1) * kstep;
            const char* a2 = last ? nA : cA + (size_t)(t + 2) * kstep; const char* b2 = last ? nB : cB + (size_t)(t + 2) * kstep;
            const char* a3 = a2 + kstep; const char* b3 = b2 + kstep;
            asm volatile("" : "+s"(a1), "+s"(a2), "+s"(a3), "+s"(b2), "+s"(b3));
            G_LDB(B0, 0, 0); G_LDB(B1, 0, 1); G_SCHED; G_LDA(At, 0, 0); G_STAGE_A(G_SA(1, 1), a1, 1, false);
            if (t == 0 && ui > 0) { if constexpr (E::NVM == 8) G_WAIT_V(16); else if constexpr (E::NVM == 16) G_WAIT_V(24); else if constexpr (E::NVM == 32) G_WAIT_V(40); else G_WAIT_V(8); } else G_WAIT_V(8);
            G_WAIT_L(0); G_BAR; G_MMA(0, 0, At, B0); G_MMA(0, 1, At, B1); G_BAR; G_SCHED;
            G_LDA(At, 0, 1); G_STAGE_B(G_SB(0, 0), b2, 0, last); G_STAGE_B(G_SB(0, 1), b2, 1, last); G_STAGE_A(G_SA(0, 0), a2, 0, last);
            G_WAIT_V(8); G_WAIT_L(0); G_BAR; G_MMA(1, 0, At, B0); G_MMA(1, 1, At, B1); G_BAR; G_SCHED;
            G_LDB(B0, 1, 0); G_LDB(B1, 1, 1); G_SCHED; G_LDA(At, 1, 0); G_STAGE_A(G_SA(0, 1), a2, 1, last);
            G_WAIT_V(8); G_WAIT_L(0); G_BAR; G_MMA(0, 0, At, B0); G_MMA(0, 1, At, B1); G_BAR; G_SCHED;
            G_LDA(At, 1, 1); G_STAGE_B(G_SB(1, 0), b3, 0, last); G_STAGE_B(G_SB(1, 1), b3, 1, last); G_STAGE_A(G_SA(1, 0), a3, 0, last);
            G_WAIT_V(8); G_WAIT_L(0); G_BAR; G_MMA(1, 0, At, B0); G_MMA(1, 1, At, B1); G_BAR; G_SCHED;
        }
        if (wr == 0) G_BAR;
        epi(acc, cur, wr, wc, fr, fq);
        if (!has_next) break;
#pragma unroll
        for (int a = 0; a < 2; ++a)
#pragma unroll
            for (int b = 0; b < 2; ++b)
#pragma unroll
                for (int m = 0; m < 4; ++m)
#pragma unroll
                    for (int n = 0; n < 2; ++n) acc[a][b][m][n] = (f32x4){0.f, 0.f, 0.f, 0.f};
        cur = nxt; cA = nA; cB = nB; ++ui;
        if constexpr (S::GA) {
#pragma unroll
            for (int j = 0; j < 4; ++j) cofA[j] = nofA[j]; }
        if constexpr (S::GB) {
#pragma unroll
            for (int j = 0; j < 4; ++j) cofB[j] = nofB[j]; }
        if (wr == 1) G_BAR;
    }
    G_WAIT_V(0);
    G_BAR;
#undef G_SA
#undef G_SB
#undef G_GLDS
#undef G_STAGE_A
#undef G_STAGE_B
#undef G_LDA
#undef G_LDB
#undef G_MMA
#undef G_WAIT_V
#undef G_WAIT_L
#undef G_BAR
#undef G_SCHED
}
#ifndef MK_FAST
#define MK_FAST 1
#endif
#if MK_FAST
#define GEMM_PHASE(lds, S, E) gemm_fast(lds, S, E)
#else
#define GEMM_PHASE(lds, S, E) gemm_simple(lds, S, E)
#endif

#define ROWLOOP _Pragma("unroll") for (int ai = 0; ai < 2; ++ai) _Pragma("unroll") for (int m = 0; m < 4; ++m)
#define UROW (ai * 128 + wr * 64 + m * 16 + fr)
#define UCOL(bj, n) ((bj) * 128 + wc * 32 + (n) * 16 + 4 * fq)
#define UCOLP(bj) ((bj) * 128 + wc * 32 + 8 * fq)
__device__ __forceinline__ u32x4 pk8(const f32x4 a, const f32x4 b) { u32x4 w; w.x = pk2(a.x, a.y); w.y = pk2(a.z, a.w); w.z = pk2(b.x, b.y); w.w = pk2(b.z, b.w); return w; }
typedef f32x4 AccT[2][2][4][2];

struct UnitD { int pm, pn; };
template <bool PERM_> struct SchedDenseT {
    typedef UnitD U;
    static constexpr bool GA = false, GB = false, PERM = PERM_;
    const bf16* A; const bf16* Bt; int lda, ldb, Kk, nM, nN, vcu;
    __device__ __forceinline__ const char* baseA(const U& u) const { return (const char*)(A + (size_t)u.pm * 256 * lda); }
    __device__ __forceinline__ const char* baseB(const U& u) const { return (const char*)(Bt + (size_t)u.pn * 256 * ldb); }
    __device__ __forceinline__ bool next(int i, U& u) const { const int L = i * NWG + vcu; if (L >= nM * nN) return false; u.pm = L / nN; u.pn = L % nN; return true; }
    __device__ __forceinline__ int K(const U&) const { return Kk; }
    __device__ __forceinline__ const char* rowA(const U& u, int r) const { return (const char*)(A + (size_t)(u.pm * 256 + r) * lda); }
    __device__ __forceinline__ const char* rowB(const U& u, int r) const { return (const char*)(Bt + (size_t)(u.pn * 256 + r) * ldb); }
};
typedef SchedDenseT<false> SchedDense; typedef SchedDenseT<true> SchedDenseP;
struct EpiXZ {
    static constexpr int NVM = 16;
    bf16* XR; bf16* GG;
    __device__ __forceinline__ void operator()(const AccT& acc, const UnitD& u, int wr, int wc, int fr, int fq) const {
        const bool isg = u.pn >= 4; bf16* base = isg ? GG : XR; const int c0 = (u.pn & 3) * 256;
        ROWLOOP { bf16* rp = base + (size_t)(u.pm * 256 + UROW) * D + c0;
#pragma unroll
            for (int bj = 0; bj < 2; ++bj) { f32x4 v0 = acc[ai][bj][m][0], v1 = acc[ai][bj][m][1];
                if (isg) {
#pragma unroll
                    for (int j = 0; j < 4; ++j) { v0[j] = gelu_tanh(v0[j]); v1[j] = gelu_tanh(v1[j]); } }
                *(u32x4*)(rp + UCOLP(bj)) = pk8(v0, v1); } }
    }
};
struct EpiResF32 {
    static constexpr int NVM = 0;
    const float* R; float* O; int ldc;
    __device__ __forceinline__ void operator()(const AccT& acc, const UnitD& u, int wr, int wc, int fr, int fq) const {
        ROWLOOP { const size_t ro = (size_t)(u.pm * 256 + UROW) * ldc + u.pn * 256;
#pragma unroll
            for (int bj = 0; bj < 2; ++bj)
#pragma unroll
                for (int n = 0; n < 2; ++n) { const f32x4 r = *(const f32x4*)(R + ro + UCOL(bj, n)); *(f32x4*)(O + ro + UCOL(bj, n)) = r * ALPHA + acc[ai][bj][m][n]; } }
    }
};
struct EpiF32 {
    static constexpr int NVM = 32;
    float* O; int ldc;
    __device__ __forceinline__ void operator()(const AccT& acc, const UnitD& u, int wr, int wc, int fr, int fq) const {
        ROWLOOP { const size_t ro = (size_t)(u.pm * 256 + UROW) * ldc + u.pn * 256;
#pragma unroll
            for (int bj = 0; bj < 2; ++bj)
#pragma unroll
                for (int n = 0; n < 2; ++n) *(f32x4*)(O + ro + UCOL(bj, n)) = acc[ai][bj][m][n]; }
    }
};

struct UnitG { int pm, blk, pn; };
struct SchedGate {
    typedef UnitG U;
    static constexpr bool GA = false, GB = false, PERM = true; static constexpr int Kk = 256, lda = D, ldb = 256;
    const bf16* XC; const bf16* WgT; int vcu;
    __device__ __forceinline__ const char* baseA(const U& u) const { return (const char*)(XC + (size_t)u.pm * 256 * D + u.blk * 256); }
    __device__ __forceinline__ const char* baseB(const U& u) const { return (const char*)(WgT + (size_t)(u.blk * 512 + u.pn * 256) * 256); }
    __device__ __forceinline__ bool next(int i, U& u) const { const int L = i * NWG + vcu; if (L >= 128 * 8) return false; u.pm = L >> 3; u.blk = (L >> 1) & 3; u.pn = L & 1; return true; }
    __device__ __forceinline__ int K(const U&) const { return 256; }
    __device__ __forceinline__ const char* rowA(const U& u, int r) const { return (const char*)(XC + (size_t)(u.pm * 256 + r) * D + u.blk * 256); }
    __device__ __forceinline__ const char* rowB(const U& u, int r) const { return (const char*)(WgT + (size_t)(u.blk * 512 + u.pn * 256 + r) * 256); }
};
struct EpiGate {
    static constexpr int NVM = 0;
    const bf16* XC; const float *ba, *bx, *lam; bf16* LA; bf16* UU;
    __device__ __forceinline__ void operator()(const AccT& acc, const UnitG& u, int wr, int wc, int fr, int fq) const {
        const int c0 = u.blk * 256 + u.pn * 128 + wc * 32 + 8 * fq;
        f32x4 vba[2], vbx[2], sp[2];
#pragma unroll
        for (int n = 0; n < 2; ++n) { vba[n] = *(const f32x4*)(ba + c0 + 4 * n); vbx[n] = *(const f32x4*)(bx + c0 + 4 * n); const f32x4 vl = *(const f32x4*)(lam + c0 + 4 * n);
#pragma unroll
            for (int j = 0; j < 4; ++j) { const float x = __expf(-vl[j]); sp[n][j] = 8.0f * x * (1.0f - x * (0.5f - x * (1.0f / 3.0f))); } }
        ROWLOOP { const size_t ro = (size_t)(u.pm * 256 + UROW) * D + c0;
            const u32x4 xw = *(const u32x4*)(XC + ro); const float xc[8] = {bf_lo(xw.x), bf_hi(xw.x), bf_lo(xw.y), bf_hi(xw.y), bf_lo(xw.z), bf_hi(xw.z), bf_lo(xw.w), bf_hi(xw.w)};
            f32x4 la[2], uu[2];
#pragma unroll
            for (int n = 0; n < 2; ++n) { const f32x4 ga = acc[ai][0][m][n] + vba[n], gx = acc[ai][1][m][n] + vbx[n];
#pragma unroll
                for (int j = 0; j < 4; ++j) { const float r = sigmoidf_(ga[j]), ig = sigmoidf_(gx[j]); const float l = -r * sp[n][j]; la[n][j] = l;
                    const float mult = sqrtf(fmaxf(1.0f - __expf(2.0f * l), 0.f)); uu[n][j] = mult * ig * xc[4 * n + j]; } }
            *(u32x4*)(LA + ro) = pk8(la[0], la[1]); *(u32x4*)(UU + ro) = pk8(uu[0], uu[1]); asm volatile("" ::: "memory"); }
    }
};

struct UnitE { int rb, pn, e; };
struct SchedG1 {
    typedef UnitE U;
    static constexpr bool GA = true, GB = false, PERM = true; static constexpr int Kk = D, lda = D, ldb = D;
    const bf16* X; const bf16* W13T; const int* ROWA; const int* BLKE; int nrbt, vcu;
    __device__ __forceinline__ const char* baseA(const U&) const { return (const char*)X; }
    __device__ __forceinline__ const char* baseB(const U& u) const { return (const char*)(W13T + ((size_t)u.e * 512 + u.pn * 256) * D); }
    __device__ __forceinline__ unsigned goffA(const U& u, int r, int C) const { const int a = ROWA[u.rb * 256 + r]; const int tok = a < 0 ? 0 : (a < 8 * M ? (a >> 3) : a - 8 * M); return (unsigned)(tok * D + C) * 2u; }
    __device__ __forceinline__ unsigned goffB(const U&, int, int) const { return 0u; }
    __device__ __forceinline__ bool next(int i, U& u) const { const int rb = (i >> 1) * NWG + vcu; if (rb >= nrbt) return false; u.rb = rb; u.pn = i & 1; u.e = BLKE[rb]; return true; }
    __device__ __forceinline__ int K(const U&) const { return D; }
    __device__ __forceinline__ const char* rowA(const U& u, int r) const { const int a = ROWA[u.rb * 256 + r]; const int tok = a < 0 ? 0 : (a < 8 * M ? (a >> 3) : a - 8 * M); return (const char*)(X + (size_t)tok * D); }
    __device__ __forceinline__ const char* rowB(const U& u, int r) const { return (const char*)(W13T + ((size_t)u.e * 512 + u.pn * 256 + r) * D); }
};
struct EpiSwiGLU {
    static constexpr int NVM = 8;
    bf16* HID;
    __device__ __forceinline__ void operator()(const AccT& acc, const UnitE& u, int wr, int wc, int fr, int fq) const {
        ROWLOOP { bf16* rp = HID + (size_t)(u.rb * 256 + UROW) * DE + u.pn * 128;
            f32x4 h0, h1;
#pragma unroll
            for (int j = 0; j < 4; ++j) { const float a0 = acc[ai][0][m][0][j], a1 = acc[ai][0][m][1][j]; h0[j] = a0 * sigmoidf_(a0) * acc[ai][1][m][0][j]; h1[j] = a1 * sigmoidf_(a1) * acc[ai][1][m][1][j]; }
            *(u32x4*)(rp + wc * 32 + 8 * fq) = pk8(h0, h1); }
    }
};
struct SchedG2 {
    typedef UnitE U;
    static constexpr bool GA = false, GB = false, PERM = true; static constexpr int Kk = DE, lda = DE, ldb = DE;
    const bf16* HID; const bf16* W2T; const int* BLKE; int nrbt, vcu;
    __device__ __forceinline__ const char* baseA(const U& u) const { return (const char*)(HID + (size_t)u.rb * 256 * DE); }
    __device__ __forceinline__ const char* baseB(const U& u) const { return (const char*)(W2T + ((size_t)u.e * D + u.pn * 256) * DE); }
    __device__ __forceinline__ bool next(int i, U& u) const { const int rb = (i >> 2) * NWG + vcu; if (rb >= nrbt) return false; u.rb = rb; u.pn = i & 3; u.e = BLKE[rb]; return true; }
    __device__ __forceinline__ int K(const U&) const { return DE; }
    __device__ __forceinline__ const char* rowA(const U& u, int r) const { return (const char*)(HID + (size_t)(u.rb * 256 + r) * DE); }
    __device__ __forceinline__ const char* rowB(const U& u, int r) const { return (const char*)(W2T + ((size_t)u.e * D + u.pn * 256 + r) * DE); }
};
struct EpiScatter {
    static constexpr int NVM = 16;
    bf16* YA; int dry;
    __device__ __forceinline__ void operator()(const AccT& acc, const UnitE& u, int wr, int wc, int fr, int fq) const {
        if (dry == 1) return;
        const size_t rbase = dry == 2 ? (size_t)(blockIdx.x * 256) : (size_t)u.rb * 256;
        if (dry == 4) { bf16* sp = YA + (size_t)blockIdx.x * 262144 + (threadIdx.x >> 6) * 512 + (threadIdx.x & 63) * 8;
            ROWLOOP {
#pragma unroll
                for (int bj = 0; bj < 2; ++bj) *(u32x4*)(sp + (((ai * 4 + m) * 2 + bj) * 8) * 512) = pk8(acc[ai][bj][m][0], acc[ai][bj][m][1]); }
            return; }
        ROWLOOP { bf16* rp = YA + (rbase + UROW) * D + u.pn * 256;
#pragma unroll
            for (int bj = 0; bj < 2; ++bj) *(u32x4*)(rp + UCOLP(bj)) = pk8(acc[ai][bj][m][0], acc[ai][bj][m][1]); }
    }
};

__device__ __forceinline__ int rho_to_tok(int rho, int g) { const int sh = 14 - 2 * g; const int rp = rho & 16383; return (rho & ~16383) + (rp >> sh) + ((rp & ((1 << sh) - 1)) << (2 * g)); }
__device__ __forceinline__ int tok_to_rho(int t, int g) { const int sh = 14 - 2 * g; const int tp = t & 16383; return (t & ~16383) + ((tp & ((1 << (2 * g)) - 1)) << sh) + (tp >> (2 * g)); }
struct UnitQ { int type, g, pm, pn; };
struct SchedQK {
    typedef UnitQ U;
    static constexpr bool GA = false, GB = false, PERM = true; static constexpr int Kk = D, ldb = D;
    const bf16* X; const bf16* WqkT; int g, lda, vcu;
    __device__ __forceinline__ bool next(int i, U& u) const { const int L = i * NWG + vcu; if (L >= 512) return false; u.type = 0; u.g = g; u.pm = L >> 2; u.pn = L & 3; return true; }
    __device__ __forceinline__ int K(const U&) const { return D; }
    __device__ __forceinline__ const char* baseA(const U& u) const { return (const char*)(X + (size_t)rho_to_tok(u.pm * 256, g) * D); }
    __device__ __forceinline__ const char* baseB(const U& u) const { return (const char*)(WqkT + ((size_t)g * 1024 + u.pn * 256) * D); }
    __device__ __forceinline__ const char* rowA(const U& u, int r) const { return (const char*)(X + (size_t)rho_to_tok(u.pm * 256 + r, g) * D); }
    __device__ __forceinline__ const char* rowB(const U& u, int r) const { return (const char*)(WqkT + ((size_t)g * 1024 + u.pn * 256 + r) * D); }
};
struct SchedVT {
    typedef UnitQ U;
    static constexpr bool GA = false, GB = false, PERM = true; static constexpr int Kk = D, lda = D;
    const bf16* X; const bf16* WvT; int g, ldb, vcu;
    __device__ __forceinline__ bool next(int i, U& u) const { const int L = i * NWG + vcu; if (L >= 256) return false; u.type = 1; u.g = g; u.pn = L >> 1; u.pm = L & 1; return true; }
    __device__ __forceinline__ int K(const U&) const { return D; }
    __device__ __forceinline__ const char* baseA(const U& u) const { return (const char*)(WvT + ((size_t)g * 512 + u.pm * 256) * D); }
    __device__ __forceinline__ const char* baseB(const U& u) const { return (const char*)(X + (size_t)rho_to_tok(u.pn * 256, g) * D); }
    __device__ __forceinline__ const char* rowA(const U& u, int r) const { return (const char*)(WvT + ((size_t)g * 512 + u.pm * 256 + r) * D); }
    __device__ __forceinline__ const char* rowB(const U& u, int r) const { return (const char*)(X + (size_t)rho_to_tok(u.pn * 256 + r, g) * D); }
};
struct EpiQKV {
    static constexpr int NVM = 16;
    bf16* QK; bf16* VT;
    __device__ __forceinline__ void operator()(const AccT& acc, const UnitQ& u, int wr, int wc, int fr, int fq) const {
        bf16* base; size_t ldc;
        if (u.type == 0) { base = QK + (size_t)u.g * M * 1024; ldc = 1024; } else { base = VT + (size_t)u.g * 512 * M; ldc = M; }
        ROWLOOP { bf16* rp = base + (size_t)(u.pm * 256 + UROW) * ldc + u.pn * 256;
#pragma unroll
            for (int bj = 0; bj < 2; ++bj) *(u32x4*)(rp + UCOLP(bj)) = pk8(acc[ai][bj][m][0], acc[ai][bj][m][1]); }
    }
};

__device__ __forceinline__ void tr_item(const float* src, int spitch, bf16* dst, int dpitch, LAS float* scr, int lane) {
#pragma unroll 4
    for (int i = 0; i < 16; ++i) { const int k = 4 * i + (lane >> 4), n4 = (lane & 15) * 4; const f32x4 v = *(const f32x4*)(src + (size_t)k * spitch + n4);
        LAS float* s = scr + k * 65 + n4; s[0] = v.x; s[1] = v.y; s[2] = v.z; s[3] = v.w; }
    LDS_WAIT(); asm volatile("" ::: "memory");
    const int c = lane & 7;
#pragma unroll
    for (int j = 0; j < 8; ++j) { const int n = 8 * j + (lane >> 3); const LAS float* s = scr + (8 * c) * 65 + n;
        u32x4 o; o.x = pk2(s[0], s[65]); o.y = pk2(s[2 * 65], s[3 * 65]); o.z = pk2(s[4 * 65], s[5 * 65]); o.w = pk2(s[6 * 65], s[7 * 65]);
        *(u32x4*)(dst + (size_t)n * dpitch + 8 * c) = o; }
    LDS_WAIT(); asm volatile("" ::: "memory");
}
template <class RowMap>
__device__ __forceinline__ void tr_matrix(Frame& F, const float* W, int K, int N, bf16* WT, int dpitch, RowMap drow) {
    LAS float* scr = (LAS float*)(F.lds + F.wave * 16640);
    const int nkb = K / 64, nnb = N / 64;
    for (int it = F.vcu * NWAVES + F.wave; it < nkb * nnb; it += NGW) { const int kb = it / nnb, nb = it % nnb;
        tr_item(W + (size_t)(kb * 64) * N + nb * 64, N, WT + (size_t)drow(nb * 64) * dpitch + kb * 64, dpitch, scr, F.lane); }
}
__device__ __forceinline__ void convert_experts(Frame& F, const float* w1, const float* w3, const float* w2, const float* s1, const float* s3, const float* s2) {
    LAS float* scr = (LAS float*)(F.lds + F.wave * 16640);
    bf16* W13T = WSP(bf16, WS_W13); bf16* W2T = WSP(bf16, WS_W2);
    for (int it = F.vcu * NWAVES + F.wave; it < 257 * 192; it += NGW) {
        const int e = it / 192, r = it % 192, which = r >> 6, tile = r & 63;
        if (which < 2) {
            const float* W = (e < 256) ? (which == 0 ? w1 : w3) + (size_t)e * (size_t)(D * DE) : (which == 0 ? s1 : s3);
            const int kb = tile >> 2, nb = tile & 3; const int drow = (nb >> 1) * 256 + which * 128 + (nb & 1) * 64;
            tr_item(W + (size_t)(kb * 64) * DE + nb * 64, DE, W13T + ((size_t)e * 512 + drow) * D + kb * 64, D, scr, F.lane);
        } else {
            const float* W = (e < 256) ? w2 + (size_t)e * (size_t)(DE * D) : s2;
            const int kb = tile >> 4, nb = tile & 15;
            tr_item(W + (size_t)(kb * 64) * D + nb * 64, D, W2T + ((size_t)e * D + nb * 64) * DE + kb * 64, DE, scr, F.lane);
        }
    }
}
struct MapId { __device__ int operator()(int n0) const { return n0; } };
struct MapGate { int which; __device__ int operator()(int n0) const { return (n0 >> 7) * 256 + which * 128 + (n0 & 127); } };
struct MapQ { __device__ int operator()(int n0) const { return (n0 >> 9) * 1024 + (n0 & 511); } };
struct MapKV { __device__ int operator()(int n0) const { return n0 < 1536 ? (n0 >> 9) * 1024 + 512 + (n0 & 511) : 3072 + (n0 - 1536); } };

__device__ __forceinline__ void p0_prologue(Frame& F, const Args& A) {
    { const float* x = A.in[0]; bf16* XB = WSP(bf16, WS_RA + RA_XB);
      for (size_t i = (size_t)F.vcu * NTHR + F.tid; i < (size_t)M * D / 8; i += NGT) { const f32x4 a = *(const f32x4*)(x + i * 8), b = *(const f32x4*)(x + i * 8 + 4);
          u32x4 o; o.x = pk2(a.x, a.y); o.y = pk2(a.z, a.w); o.z = pk2(b.x, b.y); o.w = pk2(b.z, b.w); *(u32x4*)(XB + i * 8) = o; } }
    tr_matrix(F, A.in[1], D, 2048, WSP(bf16, WS_WIN), D, MapId());
    for (int b = 0; b < 4; ++b) { tr_matrix(F, A.in[4] + b * 65536, 256, 256, WSP(bf16, WS_WG) + (size_t)b * 512 * 256, 256, MapGate{0});
                                  tr_matrix(F, A.in[6] + b * 65536, 256, 256, WSP(bf16, WS_WG) + (size_t)b * 512 * 256, 256, MapGate{1}); }
    tr_matrix(F, A.in[9], D, D, WSP(bf16, WS_WOUT), D, MapId());
    tr_matrix(F, A.in[11], D, QW, WSP(bf16, WS_WQK), D, MapQ());
    tr_matrix(F, A.in[10], D, 2 * QW, WSP(bf16, WS_WQK), D, MapKV());
    tr_matrix(F, A.in[12], OW, D, WSP(bf16, WS_WO), OW, MapId());
    for (int l = 0; l < 2; ++l) tr_matrix(F, A.in[13] + (size_t)l * D * NE, D, NE, WSP(bf16, WS_WR) + (size_t)l * NE * D, D, MapId());
    convert_experts(F, A.in[15], A.in[16], A.in[17], A.in[18], A.in[19], A.in[20]);
}
static_assert(WS_WV == WS_WQK + (size_t)3072 * 1024 * 2, "WvT must follow WqkT");

__device__ __forceinline__ void ln_store(f32x4 (&v)[4], const float* g, const float* b, float* of, bf16* ob, int lane) {
    float s = 0.f;
#pragma unroll
    for (int j = 0; j < 4; ++j) s += (v[j].x + v[j].y) + (v[j].z + v[j].w);
    const float mean = wave_sum(s) * (1.f / D); float s2 = 0.f;
#pragma unroll
    for (int j = 0; j < 4; ++j) { v[j] = v[j] - mean; s2 += (v[j].x * v[j].x + v[j].y * v[j].y) + (v[j].z * v[j].z + v[j].w * v[j].w); }
    const float rstd = 1.f / sqrtf(wave_sum(s2) * (1.f / D) + LN_EPS);
#pragma unroll
    for (int j = 0; j < 4; ++j) { const int c = 4 * lane + 256 * j; const f32x4 gg = *(const f32x4*)(g + c), bb = *(const f32x4*)(b + c); const f32x4 y = v[j] * rstd * gg + bb;
        if (of) *(f32x4*)(of + c) = y;
        if (ob) { u32x2 w; w.x = pk2(y.x, y.y); w.y = pk2(y.z, y.w); *(u32x2*)(ob + c) = w; } }
}

__device__ __forceinline__ void p_conv(Frame& F, const float* cw, const float* cb) {
    const bf16* XR = WSP(bf16, WS_RA + RA_XR); bf16* XC = WSP(bf16, WS_RA + RA_XC);
    for (int i = F.vcu * NTHR + F.tid; i < M * (D / 8); i += NGT) { const int t = i >> 7, c = (i & 127) * 8; const int ts = t & (SEQ - 1);
        float a[8];
#pragma unroll
        for (int q = 0; q < 8; ++q) a[q] = cb[c + q];
#pragma unroll
        for (int j = 0; j < 4; ++j) { if (ts - 3 + j >= 0) { const u32x4 w = *(const u32x4*)(XR + (size_t)(t - 3 + j) * D + c); const float* wj = cw + j * D + c;
            a[0] += wj[0] * bf_lo(w.x); a[1] += wj[1] * bf_hi(w.x); a[2] += wj[2] * bf_lo(w.y); a[3] += wj[3] * bf_hi(w.y);
            a[4] += wj[4] * bf_lo(w.z); a[5] += wj[5] * bf_hi(w.z); a[6] += wj[6] * bf_lo(w.w); a[7] += wj[7] * bf_hi(w.w); } }
        u32x4 o; o.x = pk2(a[0], a[1]); o.y = pk2(a[2], a[3]); o.z = pk2(a[4], a[5]); o.w = pk2(a[6], a[7]); *(u32x4*)(XC + (size_t)t * D + c) = o; }
}
constexpr int CH = 64, NCH = SEQ / CH;
__device__ __forceinline__ void p_scan1(Frame& F) {
    const bf16* LA = WSP(bf16, WS_RA + RA_LA); const bf16* UU = WSP(bf16, WS_RA + RA_U); float* CP = WSP(float, WS_CHP); float* CHh = WSP(float, WS_CHH);
    for (int i = F.vcu * NTHR + F.tid; i < BATCH * NCH * (D / 4); i += NGT) { const int c4 = (i & 255) * 4, ck = (i >> 8) & (NCH - 1), b = i >> 16;
        const size_t r0 = ((size_t)b * SEQ + (size_t)ck * CH) * D + c4; f32x4 h = {0.f, 0.f, 0.f, 0.f}, sl = {0.f, 0.f, 0.f, 0.f};
#pragma unroll 4
        for (int t = 0; t < CH; ++t) { const u32x2 lw = *(const u32x2*)(LA + r0 + (size_t)t * D), uw = *(const u32x2*)(UU + r0 + (size_t)t * D);
            const f32x4 la = {bf_lo(lw.x), bf_hi(lw.x), bf_lo(lw.y), bf_hi(lw.y)}, u = {bf_lo(uw.x), bf_hi(uw.x), bf_lo(uw.y), bf_hi(uw.y)};
#pragma unroll
            for (int j = 0; j < 4; ++j) { h[j] = __expf(la[j]) * h[j] + u[j]; sl[j] += la[j]; } }
#pragma unroll
        for (int j = 0; j < 4; ++j) { const size_t o = ((size_t)b * D + c4 + j) * NCH + ck; CP[o] = __expf(sl[j]); CHh[o] = h[j]; } }
}
__device__ __forceinline__ void p_scan2(Frame& F) {
    const float* CP = WSP(float, WS_CHP); const float* CHh = WSP(float, WS_CHH); float* CIN = WSP(float, WS_CIN);
    for (int s = F.vcu * NWAVES + F.wave; s < BATCH * D; s += NGW) { const size_t o = (size_t)s * NCH + 4 * F.lane;
        const f32x4 p4 = *(const f32x4*)(CP + o), h4 = *(const f32x4*)(CHh + o);
        float p = p4.x, h = h4.x; h = p4.y * h + h4.y; p *= p4.y; h = p4.z * h + h4.z; p *= p4.z; h = p4.w * h + h4.w; p *= p4.w;
#pragma unroll
        for (int off = 1; off < 64; off <<= 1) { const float pp = __shfl_up(p, off), hp = __shfl_up(h, off); if (F.lane >= off) { h = p * hp + h; p = pp * p; } }
        float c0 = __shfl_up(h, 1); if (F.lane == 0) c0 = 0.f;
        f32x4 ci; ci.x = c0; ci.y = p4.x * ci.x + h4.x; ci.z = p4.y * ci.y + h4.y; ci.w = p4.z * ci.z + h4.z;
        *(f32x4*)(CIN + o) = ci; }
}
__device__ __forceinline__ void p_scan3(Frame& F) {
    const bf16* LA = WSP(bf16, WS_RA + RA_LA); const bf16* UU = WSP(bf16, WS_RA + RA_U); const float* CIN = WSP(float, WS_CIN);
    const bf16* GG = WSP(bf16, WS_RA + RA_GG); bf16* YB = WSP(bf16, WS_RA + RA_YB);
    for (int i = F.vcu * NTHR + F.tid; i < BATCH * NCH * (D / 4); i += NGT) { const int c4 = (i & 255) * 4, ck = (i >> 8) & (NCH - 1), b = i >> 16;
        const size_t r0 = ((size_t)b * SEQ + (size_t)ck * CH) * D + c4; f32x4 h;
#pragma unroll
        for (int j = 0; j < 4; ++j) h[j] = CIN[((size_t)b * D + c4 + j) * NCH + ck];
#pragma unroll 4
        for (int t = 0; t < CH; ++t) { const u32x2 lw = *(const u32x2*)(LA + r0 + (size_t)t * D), uw = *(const u32x2*)(UU + r0 + (size_t)t * D);
            const f32x4 la = {bf_lo(lw.x), bf_hi(lw.x), bf_lo(lw.y), bf_hi(lw.y)}, u = {bf_lo(uw.x), bf_hi(uw.x), bf_lo(uw.y), bf_hi(uw.y)};
            const u32x2 gw = *(const u32x2*)(GG + r0 + (size_t)t * D);
#pragma unroll
            for (int j = 0; j < 4; ++j) h[j] = __expf(la[j]) * h[j] + u[j];
            u32x2 o; o.x = pk2(h.x * bf_lo(gw.x), h.y * bf_hi(gw.x)); o.y = pk2(h.z * bf_lo(gw.y), h.w * bf_hi(gw.y)); *(u32x2*)(YB + r0 + (size_t)t * D) = o; } }
}
__device__ __forceinline__ void p_ln(Frame& F, const float* V, const float* g, const float* b, float* Hf, bf16* Hb) {
    for (int r = F.vcu * NWAVES + F.wave; r < M; r += NGW) { const f32x4* xr = (const f32x4*)(V + (size_t)r * D) + F.lane; f32x4 v[4];
#pragma unroll
        for (int j = 0; j < 4; ++j) v[j] = xr[64 * j];
        ln_store(v, g, b, Hf + (size_t)r * D, Hb + (size_t)r * D, F.lane); }
}
__device__ __forceinline__ void p_route(Frame& F, const float* bias) {
    const float* LG = WSP(float, WS_LOGITS); int* TOPI = WSP(int, WS_TOPI); float* GATE = WSP(float, WS_GATE); int* HIST = WSP(int, WS_HIST);
    LAS int* hist = (LAS int*)F.lds; const int lane = F.lane;
    if (F.tid < 256) hist[F.tid] = 0;
    __syncthreads();
    const f32x4 bv = *(const f32x4*)(bias + 4 * lane);
#pragma unroll 4
    for (int j = 0; j < 16; ++j) { const int t = F.vcu * 128 + F.wave * 16 + j;
        const f32x4 z = *(const f32x4*)(LG + (size_t)t * NE + 4 * lane);
        const float s0 = sigmoidf_(z.x), s1 = sigmoidf_(z.y), s2 = sigmoidf_(z.z), s3 = sigmoidf_(z.w);
        float v0 = s0 + bv.x, v1 = s1 + bv.y, v2 = s2 + bv.z, v3 = s3 + bv.w;
        float m1, m2; { const float a = fmaxf(v0, v1), b = fminf(v0, v1), c = fmaxf(v2, v3), d = fminf(v2, v3); m1 = fmaxf(a, c); m2 = fmaxf(fminf(a, c), fmaxf(b, d)); }
#pragma unroll
        for (int off = 1; off < 8; off <<= 1) { const float o1 = __shfl_xor(m1, off), o2 = __shfl_xor(m2, off); const float n1 = fmaxf(m1, o1), n2 = fmaxf(fminf(m1, o1), fmaxf(m2, o2)); m1 = n1; m2 = n2; }
        const float gs = m1 + m2; const int g = lane >> 3; int rank = 0;
#pragma unroll
        for (int q = 0; q < 8; ++q) { const float o = __shfl(gs, 8 * q); rank += (o > gs || (o == gs && q < g)) ? 1 : 0; }
        if (rank >= 4) { v0 = -1e30f; v1 = -1e30f; v2 = -1e30f; v3 = -1e30f; }
        int myidx = 0; float mys = 0.f;
#pragma unroll
        for (int k = 0; k < TOPK; ++k) {
            float bvv = v0; int bi = 0; if (v1 > bvv) { bvv = v1; bi = 1; } if (v2 > bvv) { bvv = v2; bi = 2; } if (v3 > bvv) { bvv = v3; bi = 3; }
            int idx = 4 * lane + bi;
#pragma unroll
            for (int off = 32; off >= 1; off >>= 1) { const float ov = __shfl_xor(bvv, off); const int oi = __shfl_xor(idx, off); if (ov > bvv || (ov == bvv && oi < idx)) { bvv = ov; idx = oi; } }
            const int q = idx & 3; const float sq = q == 0 ? s0 : (q == 1 ? s1 : (q == 2 ? s2 : s3)); const float sw = __shfl(sq, idx >> 2);
            if ((idx >> 2) == lane) { if (q == 0) v0 = -3e38f; else if (q == 1) v1 = -3e38f; else if (q == 2) v2 = -3e38f; else v3 = -3e38f; }
            if (lane == k) { myidx = idx; mys = sw; }
        }
        const float tot = wave_sum(lane < TOPK ? mys : 0.f);
        if (lane < TOPK) { TOPI[t * TOPK + lane] = myidx; GATE[t * TOPK + lane] = mys / tot * 2.5f; atomicAdd((int*)&hist[myidx], 1); }
    }
    __syncthreads();
    if (F.tid < 256) HIST[F.vcu * 256 + F.tid] = hist[F.tid];
    __syncthreads();
}
__device__ __forceinline__ void p_sort(Frame& F) {
    const int* HIST = WSP(int, WS_HIST); const int* TOPI = WSP(int, WS_TOPI); int* ROWA = WSP(int, WS_ROWA); int* POS = WSP(int, WS_POS); int* BLKE = WSP(int, WS_BLKE); int* META = WSP(int, WS_META);
    LAS int* cnt = (LAS int*)F.lds; LAS int* myoff = cnt + 256; LAS int* nb = cnt + 512; LAS int* blk0 = cnt + 768; LAS int* lcnt = cnt + 1024;
    { typedef int i32x4 __attribute__((ext_vector_type(4)));
      const int q = F.tid >> 6, l = F.tid & 63; i32x4 c = {0, 0, 0, 0}, mo = {0, 0, 0, 0};
#pragma unroll 8
      for (int w = q; w < NWG; w += 8) { const i32x4 h = *(const i32x4*)(HIST + w * 256 + 4 * l); c += h; if (w < F.vcu) mo += h; }
      LAS int* redc = cnt + 1280; LAS int* redm = redc + 2048;
#pragma unroll
      for (int j = 0; j < 4; ++j) { redc[q * 256 + 4 * l + j] = c[j]; redm[q * 256 + 4 * l + j] = mo[j]; }
      __syncthreads();
      if (F.tid < 256) { const int e = F.tid; int cc = 0, mm = 0;
#pragma unroll
          for (int k = 0; k < 8; ++k) { cc += redc[k * 256 + e]; mm += redm[k * 256 + e]; }
          cnt[e] = cc; myoff[e] = mm; nb[e] = (cc + 255) >> 8; lcnt[e] = 0; } }
    __syncthreads();
    if (F.tid < 256) { int b = 0; for (int j = 0; j < F.tid; ++j) b += nb[j]; blk0[F.tid] = b; }
    __syncthreads();
    for (int al = F.tid; al < 1024; al += NTHR) { const int a = F.vcu * 1024 + al; const int e = TOPI[a]; const int pos = blk0[e] * 256 + myoff[e] + atomicAdd((int*)&lcnt[e], 1); ROWA[pos] = a; POS[a] = pos; }
    const int nrb = blk0[255] + nb[255];
    { const int e = F.vcu; const int start = blk0[e] * 256 + cnt[e], end = (blk0[e] + nb[e]) * 256;
      for (int p = start + F.tid; p < end; p += NTHR) ROWA[p] = -1;
      for (int j = F.tid; j < nb[e]; j += NTHR) BLKE[blk0[e] + j] = e; }
    for (int tl = F.tid; tl < 128; tl += NTHR) { const int t = F.vcu * 128 + tl; ROWA[nrb * 256 + t] = 8 * M + t; }
    if (F.vcu == 0) { for (int j = F.tid; j < 128; j += NTHR) BLKE[nrb + j] = 256; if (F.tid == 0) META[0] = nrb + 128; }
    __syncthreads();
}
__device__ __forceinline__ void p_combine(Frame& F, const float* Hin, const float* g, const float* b, float* Hf, bf16* Hb) {
    const bf16* YA = WSP(bf16, WS_RA); const float* GATE = WSP(float, WS_GATE); const int* POS = WSP(int, WS_POS); const int shrow0 = (*WSP(int, WS_META) - 128) * 256;
    for (int t = F.vcu * NWAVES + F.wave; t < M; t += NGW) { f32x4 v[4];
        const f32x4* hr = (const f32x4*)(Hin + (size_t)t * D) + F.lane;
#pragma unroll
        for (int j = 0; j < 4; ++j) v[j] = hr[64 * j] * ALPHA;
        f32x4 r[4];
#pragma unroll
        for (int j = 0; j < 4; ++j) r[j] = (f32x4){0.f, 0.f, 0.f, 0.f};
#pragma unroll
        for (int k = 0; k < TOPK; ++k) { const float gk = GATE[t * TOPK + k]; const u32x2* yr = (const u32x2*)(YA + (size_t)POS[t * TOPK + k] * D) + F.lane;
#pragma unroll
            for (int j = 0; j < 4; ++j) { const u32x2 w = yr[64 * j]; r[j].x += gk * bf_lo(w.x); r[j].y += gk * bf_hi(w.x); r[j].z += gk * bf_lo(w.y); r[j].w += gk * bf_hi(w.y); } }
        { const u32x2* yr = (const u32x2*)(YA + (size_t)(shrow0 + t) * D) + F.lane;
#pragma unroll
            for (int j = 0; j < 4; ++j) { const u32x2 w = yr[64 * j]; v[j].x += r[j].x + bf_lo(w.x); v[j].y += r[j].y + bf_hi(w.x); v[j].z += r[j].z + bf_lo(w.y); v[j].w += r[j].w + bf_hi(w.y); } }
        ln_store(v, g, b, Hf + (size_t)t * D, Hb ? Hb + (size_t)t * D : nullptr, F.lane); }
}
__device__ __forceinline__ void p_attn(Frame& F) {
    const bf16* QKb = WSP(bf16, WS_RA + RA_QK); const bf16* VTb = WSP(bf16, WS_RA + RA_VT); bf16* OGb = WSP(bf16, WS_RA + RA_OG); float* LSE = WSP(float, WS_LSE);
    const int lane = F.lane, q = lane & 31, hh = lane >> 5;
#pragma unroll 1
    for (int it = F.vcu * NWAVES + F.wave; it < 3 * 8192; it += NGW) {
        const int g = it >> 13, rem = it & 8191, tile = rem >> 3, h = rem & 7;
        const int sh = 14 - 2 * g, rq0 = tile * 32, i0 = rq0 & ((1 << sh) - 1);
        const bf16* QK = QKb + (size_t)g * M * 1024; const bf16* VT = VTb + (size_t)g * 512 * M;
        bf16x8 Qf[4];
        { const bf16* qp = QK + (size_t)(rq0 + q) * 1024 + h * 64 + 8 * hh;
#pragma unroll
          for (int s = 0; s < 4; ++s) Qf[s] = *(const bf16x8*)(qp + 16 * s); }
        const float slope2 = exp2f(-(float)(h + 1)) * (float)(1 << (2 * g)) * 1.4426950408889634f, sc = 0.125f * 1.4426950408889634f;
        float m_run = -1e30f, l_run = 0.f; f32x16 O0, O1;
#pragma unroll
        for (int r = 0; r < 16; ++r) { O0[r] = 0.f; O1[r] = 0.f; }
#pragma unroll 1
        for (int kt = 0; kt < 5; ++kt) { const int ik0 = i0 - 128 + 32 * kt; if (ik0 < 0) continue; const int rk0 = rq0 - 128 + 32 * kt;
            bf16x8 Kf[4];
            { const bf16* kp = QK + (size_t)(rk0 + q) * 1024 + 512 + h * 64 + 8 * hh;
#pragma unroll
              for (int s = 0; s < 4; ++s) Kf[s] = *(const bf16x8*)(kp + 16 * s); }
            bf16x8 Vf[2][2];
#pragma unroll
            for (int dd = 0; dd < 2; ++dd)
#pragma unroll
                for (int s = 0; s < 2; ++s) { const bf16* vp = VT + (size_t)(h * 64 + 32 * dd + q) * M + rk0 + 16 * s + 4 * hh;
                    const u32x2 lo = *(const u32x2*)vp, hi = *(const u32x2*)(vp + 8); u32x4 w; w.x = lo.x; w.y = lo.y; w.z = hi.x; w.w = hi.y; Vf[dd][s] = __builtin_bit_cast(bf16x8, w); }
            f32x16 S;
#pragma unroll
            for (int r = 0; r < 16; ++r) S[r] = 0.f;
#pragma unroll
            for (int s = 0; s < 4; ++s) S = __builtin_amdgcn_mfma_f32_32x32x16_bf16(Kf[s], Qf[s], S, 0, 0, 0);
            float mx = -1e30f;
#pragma unroll
            for (int r = 0; r < 16; ++r) { const int krow = (r & 3) + 8 * (r >> 2) + 4 * hh; const int dist = 128 - 32 * kt + q - krow;
                const float sv = (dist >= 0 && dist <= 128) ? S[r] * sc - slope2 * (float)dist : -1e30f; S[r] = sv; mx = fmaxf(mx, sv); }
            mx = fmaxf(mx, __shfl_xor(mx, 32));
            const float m_new = fmaxf(m_run, mx), alpha = exp2f(m_run - m_new); float rs = 0.f;
#pragma unroll
            for (int r = 0; r < 16; ++r) { const float p = exp2f(S[r] - m_new); S[r] = p; rs += p; }
            rs += __shfl_xor(rs, 32);
            l_run = l_run * alpha + rs; m_run = m_new;
#pragma unroll
            for (int r = 0; r < 16; ++r) { O0[r] *= alpha; O1[r] *= alpha; }
            bf16x8 Pf[2];
#pragma unroll
            for (int s = 0; s < 2; ++s) { u32x4 w; w.x = pk2(S[8 * s + 0], S[8 * s + 1]); w.y = pk2(S[8 * s + 2], S[8 * s + 3]); w.z = pk2(S[8 * s + 4], S[8 * s + 5]); w.w = pk2(S[8 * s + 6], S[8 * s + 7]); Pf[s] = __builtin_bit_cast(bf16x8, w); }
#pragma unroll
            for (int s = 0; s < 2; ++s) { O0 = __builtin_amdgcn_mfma_f32_32x32x16_bf16(Vf[0][s], Pf[s], O0, 0, 0, 0); O1 = __builtin_amdgcn_mfma_f32_32x32x16_bf16(Vf[1][s], Pf[s], O1, 0, 0, 0); }
        }
        const float inv = 1.0f / l_run;
        bf16* op = OGb + ((size_t)g * M + rq0 + q) * 512 + h * 64 + 4 * hh;
#pragma unroll
        for (int rg = 0; rg < 4; ++rg) { u32x2 w; w.x = pk2(O0[4 * rg] * inv, O0[4 * rg + 1] * inv); w.y = pk2(O0[4 * rg + 2] * inv, O0[4 * rg + 3] * inv); *(u32x2*)(op + 8 * rg) = w;
            u32x2 w1; w1.x = pk2(O1[4 * rg] * inv, O1[4 * rg + 1] * inv); w1.y = pk2(O1[4 * rg + 2] * inv, O1[4 * rg + 3] * inv); *(u32x2*)(op + 32 + 8 * rg) = w1; }
        if (hh == 0) LSE[((size_t)g * M + rq0 + q) * 8 + h] = (m_run + log2f(l_run)) * 0.6931471805599453f;
    }
}
__device__ __forceinline__ void p_merge(Frame& F) {
    const bf16* OGb = WSP(bf16, WS_RA + RA_OG); const float* LSE = WSP(float, WS_LSE); bf16* OM = WSP(bf16, WS_RA + RA_OM);
    for (int t = F.vcu * NWAVES + F.wave; t < M; t += NGW) { const int hd = F.lane >> 3; float ls[3]; size_t ro[3];
#pragma unroll
        for (int g = 0; g < 3; ++g) { const int rho = tok_to_rho(t, g); ro[g] = ((size_t)g * M + rho); ls[g] = LSE[ro[g] * 8 + hd]; }
        const float mx = fmaxf(ls[0], fmaxf(ls[1], ls[2])); float w[3], ws = 0.f;
#pragma unroll
        for (int g = 0; g < 3; ++g) { w[g] = __expf(ls[g] - mx); ws += w[g]; }
        const float inv = 1.0f / ws; float o[8];
#pragma unroll
        for (int j = 0; j < 8; ++j) o[j] = 0.f;
#pragma unroll
        for (int g = 0; g < 3; ++g) { const u32x4 x = *(const u32x4*)(OGb + ro[g] * 512 + 8 * F.lane); const float wg = w[g] * inv;
            o[0] += wg * bf_lo(x.x); o[1] += wg * bf_hi(x.x); o[2] += wg * bf_lo(x.y); o[3] += wg * bf_hi(x.y); o[4] += wg * bf_lo(x.z); o[5] += wg * bf_hi(x.z); o[6] += wg * bf_lo(x.w); o[7] += wg * bf_hi(x.w); }
        u32x4 r; r.x = pk2(o[0], o[1]); r.y = pk2(o[2], o[3]); r.z = pk2(o[4], o[5]); r.w = pk2(o[6], o[7]); *(u32x4*)(OM + (size_t)t * OW + 8 * F.lane) = r; }
}

constexpr int NPHASE = 26;

__global__ void __launch_bounds__(NTHR, 2) yoco_fwd(Args args) {
    extern __shared__ __attribute__((aligned(16))) unsigned char lds[];
    Frame F;
    F.lds = (LAS unsigned char*)lds;
    F.tid = threadIdx.x; F.lane = F.tid & 63; F.wave = __builtin_amdgcn_readfirstlane(F.tid >> 6);
    { const int bx = blockIdx.x; F.vcu = (bx % 8) * (NWG / 8) + bx / 8; }
    F.ws = args.ws;
    volatile LAS unsigned* MISC = (volatile LAS unsigned*)(F.lds + LDS_BYTES - 64);
    if (F.tid < 16) MISC[F.tid] = 0u;
    __syncthreads();
    const int lo = args.ph_lo, hi = args.ph_hi;
    XcdBarrier bar; bar.bar = (unsigned*)(F.ws + WS_CTL) + 4096; bar.x = 0; bar.st = nullptr;
    if (hi - lo > 1) bar = xcd_barrier_post((unsigned*)(F.ws + WS_CTL) + 4096, MISC + 8);
#ifndef PROBE_G2
#define PROBE_G2 0
#endif
#ifndef DUP_MASK
#define DUP_MASK 0u
#endif
#ifndef PH_MASK
#define PH_MASK 0xFFFFFFFFu
#endif
#define IN(k) (((PH_MASK >> (k)) & 1u) && lo <= (k) && (k) < hi)
#define REP(k) for (int rep = 0, nrep = 1 + (int)((args.dup >> (k)) & 1u); rep < nrep; ++rep)
#define SEAM(k) do { if (IN(k) && IN((k) + 1)) xcd_barrier(bar); } while (0)

    if (IN(0)) { p0_prologue(F, args); } SEAM(0);
    if (IN(1)) { SchedDenseP S{WSP(bf16, WS_RA + RA_XB), WSP(bf16, WS_WIN), D, D, D, M / 256, 8, F.vcu}; EpiXZ E{WSP(bf16, WS_RA + RA_XR), WSP(bf16, WS_RA + RA_GG)}; GEMM_PHASE(F.lds, S, E); } SEAM(1);
    if (IN(2)) { p_conv(F, args.in[2], args.in[3]); } SEAM(2);
    if (IN(3)) { SchedGate S{WSP(bf16, WS_RA + RA_XC), WSP(bf16, WS_WG), F.vcu}; EpiGate E{WSP(bf16, WS_RA + RA_XC), args.in[5], args.in[7], args.in[8], WSP(bf16, WS_RA + RA_LA), WSP(bf16, WS_RA + RA_U)}; GEMM_PHASE(F.lds, S, E); } SEAM(3);
    if (IN(4)) { p_scan1(F); } SEAM(4);
    if (IN(5)) { p_scan2(F); } SEAM(5);
    if (IN(6)) { p_scan3(F); } SEAM(6);
    if (IN(7)) { SchedDense S{WSP(bf16, WS_RA + RA_YB), WSP(bf16, WS_WOUT), D, D, D, M / 256, 4, F.vcu}; EpiResF32 E{args.in[0], WSP(float, WS_V), D}; GEMM_PHASE(F.lds, S, E); } SEAM(7);
    if (IN(8)) { p_ln(F, WSP(float, WS_V), args.in[21] + 0 * D, args.in[22] + 0 * D, WSP(float, WS_HA), WSP(bf16, WS_HAB)); } SEAM(8);
    if (IN(9)) { SchedDense S{WSP(bf16, WS_HAB), WSP(bf16, WS_WR), D, D, D, M / 256, 1, F.vcu}; EpiF32 E{WSP(float, WS_LOGITS), NE}; GEMM_PHASE(F.lds, S, E); } SEAM(9);
    if (IN(10)) { p_route(F, args.in[14]); } SEAM(10);
    if (IN(11)) { p_sort(F); } SEAM(11);
    if (IN(12)) { SchedG1 S{WSP(bf16, WS_HAB), WSP(bf16, WS_W13), WSP(int, WS_ROWA), WSP(int, WS_BLKE), *WSP(int, WS_META), F.vcu}; EpiSwiGLU E{WSP(bf16, WS_HID)}; GEMM_PHASE(F.lds, S, E); } SEAM(12);
    if (IN(13)) { SchedG2 S{WSP(bf16, WS_HID), WSP(bf16, WS_W2), WSP(int, WS_BLKE), *WSP(int, WS_META), F.vcu}; EpiScatter E{WSP(bf16, WS_RA), 0}; GEMM_PHASE(F.lds, S, E); if (PROBE_G2) { __syncthreads(); EpiScatter E2{(PROBE_G2 == 2 || PROBE_G2 == 4) ? WSP(bf16, WS_V) : WSP(bf16, WS_RA), PROBE_G2 == 3 ? 0 : PROBE_G2}; GEMM_PHASE(F.lds, S, E2); } } SEAM(13);
    if (IN(14)) { p_combine(F, WSP(float, WS_HA), args.in[21] + 1 * D, args.in[22] + 1 * D, WSP(float, WS_HB), WSP(bf16, WS_HBB)); convert_experts(F, args.in[15] + (size_t)NE * D * DE, args.in[16] + (size_t)NE * D * DE, args.in[17] + (size_t)NE * D * DE, args.in[18] + (size_t)D * DE, args.in[19] + (size_t)D * DE, args.in[20] + (size_t)D * DE); } SEAM(14);
    if (IN(15)) { EpiQKV E{WSP(bf16, WS_RA + RA_QK), WSP(bf16, WS_RA + RA_VT)}; for (int g = 0; g < 3; ++g) { SchedQK S{WSP(bf16, WS_HBB), WSP(bf16, WS_WQK), g, D << (2 * g), F.vcu}; GEMM_PHASE(F.lds, S, E); } for (int g = 0; g < 3; ++g) { SchedVT S{WSP(bf16, WS_HBB), WSP(bf16, WS_WV), g, D << (2 * g), F.vcu}; GEMM_PHASE(F.lds, S, E); } } SEAM(15);
    if (IN(16)) { p_attn(F); } SEAM(16);
    if (IN(17)) { p_merge(F); } SEAM(17);
    if (IN(18)) { SchedDense S{WSP(bf16, WS_RA + RA_OM), WSP(bf16, WS_WO), OW, OW, OW, M / 256, 4, F.vcu}; EpiResF32 E{WSP(float, WS_HB), WSP(float, WS_V), D}; GEMM_PHASE(F.lds, S, E); } SEAM(18);
    if (IN(19)) { p_ln(F, WSP(float, WS_V), args.in[21] + 2 * D, args.in[22] + 2 * D, WSP(float, WS_HA), WSP(bf16, WS_HAB)); } SEAM(19);
    if (IN(20)) { SchedDense S{WSP(bf16, WS_HAB), WSP(bf16, WS_WR) + (size_t)NE * D, D, D, D, M / 256, 1, F.vcu}; EpiF32 E{WSP(float, WS_LOGITS), NE}; GEMM_PHASE(F.lds, S, E); } SEAM(20);
    if (IN(21)) { p_route(F, args.in[14] + NE); } SEAM(21);
    if (IN(22)) { p_sort(F); } SEAM(22);
    if (IN(23)) { SchedG1 S{WSP(bf16, WS_HAB), WSP(bf16, WS_W13), WSP(int, WS_ROWA), WSP(int, WS_BLKE), *WSP(int, WS_META), F.vcu}; EpiSwiGLU E{WSP(bf16, WS_HID)}; GEMM_PHASE(F.lds, S, E); } SEAM(23);
    if (IN(24)) { SchedG2 S{WSP(bf16, WS_HID), WSP(bf16, WS_W2), WSP(int, WS_BLKE), *WSP(int, WS_META), F.vcu}; EpiScatter E{WSP(bf16, WS_RA), 0}; GEMM_PHASE(F.lds, S, E); if (PROBE_G2) { __syncthreads(); EpiScatter E2{(PROBE_G2 == 2 || PROBE_G2 == 4) ? WSP(bf16, WS_V) : WSP(bf16, WS_RA), PROBE_G2 == 3 ? 0 : PROBE_G2}; GEMM_PHASE(F.lds, S, E2); } } SEAM(24);
    if (IN(25)) { p_combine(F, WSP(float, WS_HA), args.in[21] + 3 * D, args.in[22] + 3 * D, args.out, nullptr); }
#undef IN
#undef SEAM
}

extern "C" void kernel_launch(void* const* d_in, const int* in_sizes, int n_in, void* d_out, int out_size, void* d_ws, size_t ws_size, hipStream_t stream) {
    static int ok = 0;
    if (ok == 0) {
        if (n_in != 23 || in_sizes[0] != M * D || out_size != M * D || ws_size < WS_END) { fprintf(stderr, "kernel_launch: unexpected shapes (n_in %d, in0 %d, out %d, ws %zu < %zu)\n", n_in, n_in > 0 ? in_sizes[0] : -1, out_size, ws_size, (size_t)WS_END); ok = -1; return; }
        if (hipFuncSetAttribute((const void*)yoco_fwd, hipFuncAttributeMaxDynamicSharedMemorySize, LDS_BYTES) != hipSuccess) { fprintf(stderr, "kernel_launch: hipFuncSetAttribute failed\n"); ok = -1; return; }
        int per_cu = 0;
        if (hipOccupancyMaxActiveBlocksPerMultiprocessor(&per_cu, (const void*)yoco_fwd, NTHR, LDS_BYTES) != hipSuccess || per_cu < 1) fprintf(stderr, "kernel_launch: occupancy query says %d\n", per_cu);
        (void)hipGetLastError();
        ok = 1;
    }
    if (ok < 0) return;
    if (hipMemsetAsync((char*)d_ws + WS_CTL, 0, CTL_ZERO_BYTES, stream) != hipSuccess) return;
    Args a{};
    for (int i = 0; i < 23; ++i) a.in[i] = (const float*)d_in[i];
    a.out = (float*)d_out; a.ws = (unsigned char*)d_ws; a.dup = 0u; a.dry = 0;
#if MK_ONE_LAUNCH
    a.ph_lo = 0; a.ph_hi = NPHASE;
    hipLaunchKernelGGL(yoco_fwd, dim3(NWG), dim3(NTHR), LDS_BYTES, stream, a);
#else
    for (int p = 0; p < NPHASE; ++p) { a.ph_lo = p; a.ph_hi = p + 1; hipLaunchKernelGGL(yoco_fwd, dim3(NWG), dim3(NTHR), LDS_BYTES, stream, a); }
#endif
}
```

```cpp
#include <hip/hip_runtime.h>
#include <cstdio>
#include <cstdint>

#ifndef MK_ONE_LAUNCH
#define MK_ONE_LAUNCH 1
#endif

constexpr int D = 1024, BATCH = 2, SEQ = 16384, M = BATCH * SEQ;
constexpr int NE = 256, TOPK = 8, DE = 256;
constexpr int HEADS = 8, HD = 64, QW = 1536, OW = 512;
constexpr float LN_EPS = 1e-5f, ALPHA = 1.41421356237f;
constexpr int RBMAX = 1024 + 256 + 128;
constexpr int NWG = 256, NTHR = 512, NWAVES = 8;
constexpr int NGW = NWG * NWAVES, NGT = NWG * NTHR;

constexpr size_t MiB = 1u << 20;
constexpr size_t WS_CTL = 0, CTL_ZERO_BYTES = 1 * MiB;
constexpr size_t WS_HIST = 1 * MiB, WS_BLKE = 1 * MiB + 512 * 1024, WS_META = 1 * MiB + 768 * 1024;
constexpr size_t WS_ROWA = 2 * MiB, WS_TOPI = 4 * MiB, WS_GATE = 5 * MiB, WS_CHP = 6 * MiB, WS_CHH = 8 * MiB, WS_CIN = 10 * MiB, WS_LSE = 12 * MiB;
constexpr size_t WS_WIN = 16 * MiB, WS_WG = 20 * MiB, WS_WOUT = 21 * MiB, WS_WQK = 23 * MiB, WS_WV = 29 * MiB, WS_WO = 32 * MiB, WS_WR = 33 * MiB;
constexpr size_t WS_LOGITS = 34 * MiB;
constexpr size_t WS_W13 = 66 * MiB, WS_W2 = 323 * MiB;
constexpr size_t WS_V = 452 * MiB, WS_HA = 580 * MiB, WS_HAB = 708 * MiB, WS_HB = 772 * MiB, WS_HBB = 900 * MiB, WS_HID = 964 * MiB;
constexpr size_t WS_RA = 1140 * MiB;
constexpr size_t RA_XB = 0, RA_XR = 64 * MiB, RA_GG = 128 * MiB, RA_XC = 192 * MiB, RA_LA = 256 * MiB, RA_U = 384 * MiB, RA_YB = 512 * MiB;
constexpr size_t RA_QK = 0, RA_VT = 192 * MiB, RA_OG = 288 * MiB, RA_OM = 384 * MiB;
constexpr size_t WS_POS = 15 * MiB;
constexpr size_t WS_END = 1844 * MiB;

constexpr int LDS_BYTES = 147456;

#define GAS __attribute__((address_space(1)))
#define LAS __attribute__((address_space(3)))
typedef unsigned short bf16;
typedef unsigned u32x4 __attribute__((ext_vector_type(4)));
typedef unsigned u32x2 __attribute__((ext_vector_type(2)));
typedef float f32x4 __attribute__((ext_vector_type(4)));
typedef float f32x2 __attribute__((ext_vector_type(2)));
typedef float f32x16 __attribute__((ext_vector_type(16)));
typedef short bf16x8 __attribute__((ext_vector_type(8)));
typedef GAS unsigned gu32;
#define RLX_AGENT __ATOMIC_RELAXED, __HIP_MEMORY_SCOPE_AGENT
#define LDS_WAIT() asm volatile("s_waitcnt lgkmcnt(0)" ::: "memory")
#define VM_WAIT() asm volatile("s_waitcnt vmcnt(0)" ::: "memory")

__device__ __forceinline__ unsigned pk2(float lo, float hi) { unsigned r; asm("v_cvt_pk_bf16_f32 %0, %1, %2" : "=v"(r) : "v"(lo), "v"(hi)); return r; }
__device__ __forceinline__ float bf_lo(unsigned w) { return __uint_as_float(w << 16); }
__device__ __forceinline__ float bf_hi(unsigned w) { return __uint_as_float(w & 0xffff0000u); }
__device__ __forceinline__ float wave_sum(float v) {
#pragma unroll
    for (int o = 1; o < 64; o <<= 1) v += __shfl_xor(v, o);
    return v;
}
__device__ __forceinline__ float gelu_tanh(float x) {
    const float u = 0.7978845608028654f * (x + 0.044715f * x * x * x);
    const float e = __expf(2.0f * u);
    const float t = 1.0f - 2.0f / (e + 1.0f);
    return 0.5f * x * (1.0f + t);
}
__device__ __forceinline__ float sigmoidf_(float x) { return 1.0f / (1.0f + __expf(-x)); }

#define XB_TMO      128
#define XB_XCNT(j)  (256  + 64 * (j))
#define XB_XSUB(j)  (1280 + 64 * (j))
#define XB_XGEN(j)  (2304 + 64 * (j))
#define XB_TOP      3328
#define XB_TOPGEN   3392
#define XCD_BAR_WORDS 3456
#define XB_SPIN_CAP (1u << 18)
__device__ __forceinline__ unsigned xb_ld(unsigned* p)              { return __hip_atomic_load(p, __ATOMIC_RELAXED, __HIP_MEMORY_SCOPE_AGENT); }
__device__ __forceinline__ unsigned xb_add(unsigned* p, unsigned v) { return __hip_atomic_fetch_add(p, v, __ATOMIC_RELAXED, __HIP_MEMORY_SCOPE_AGENT); }
__device__ __forceinline__ unsigned xb_xcc_id() { return (unsigned)__builtin_amdgcn_s_getreg((3 << 11) | 20) & 0xFu; }
#define XB_SPIN(cond, bar) do { unsigned _sp = 0; while (cond) { __builtin_amdgcn_s_sleep(1); \
    if ((++_sp & 255u) == 0u) { if (xb_ld(&(bar)[XB_TMO])) break; if (_sp > XB_SPIN_CAP) { atomicAdd(&(bar)[XB_TMO], 1u); break; } } } } while (0)
struct XcdBarrier { unsigned* bar; unsigned x; volatile LAS unsigned* st; };
__device__ __forceinline__ XcdBarrier xcd_barrier_post(unsigned* bar, volatile LAS unsigned* st) {
    XcdBarrier b; b.bar = bar; b.x = xb_xcc_id(); b.st = st;
    if (threadIdx.x == 0) (void)xb_add(&bar[XB_XCNT(b.x)], 1u);
    return b;
}
__device__ __forceinline__ void xcd_barrier_complete(unsigned* bar, unsigned x, unsigned& nloc, unsigned& nx) {
    const unsigned G = gridDim.x * gridDim.y * gridDim.z;
    unsigned sum, cnt, mine, sp = 0u;
    for (;;) {
        sum = 0u; cnt = 0u; mine = 0u;
#pragma unroll
        for (unsigned j = 0; j < 16; ++j) { const unsigned c = xb_ld(&bar[XB_XCNT(j)]); sum += c; cnt += (c > 0u) ? 1u : 0u; mine = (j == x) ? c : mine; }
        if (sum == G) break;
        __builtin_amdgcn_s_sleep(1);
        if ((++sp & 255u) == 0u) { if (xb_ld(&bar[XB_TMO])) break; if (sp > XB_SPIN_CAP) { atomicAdd(&bar[XB_TMO], 1u); break; } }
    }
    nloc = mine > 0u ? mine : 1u; nx = cnt > 0u ? cnt : 1u;
}
__device__ __forceinline__ void xcd_barrier(const XcdBarrier& b) {
    asm volatile("s_waitcnt vmcnt(0)" ::: "memory");
    __syncthreads();
    if (threadIdx.x == 0) {
        unsigned* bar = b.bar;
        __builtin_amdgcn_s_waitcnt(0);
        unsigned nloc = b.st[0], nx = b.st[1];
        if (nloc == 0u) { xcd_barrier_complete(bar, b.x, nloc, nx); b.st[0] = nloc; b.st[1] = nx; }
        const unsigned old = xb_add(&bar[XB_XSUB(b.x)], 1u);
        const unsigned gen = old / nloc;
        if (old + 1u == (gen + 1u) * nloc) {
            __builtin_amdgcn_fence(__ATOMIC_RELEASE, "agent");
            asm volatile("s_waitcnt vmcnt(0)" ::: "memory");
            const unsigned og = xb_add(&bar[XB_TOP], 1u);
            const unsigned tg = og / nx;
            if (og + 1u == (tg + 1u) * nx) xb_add(&bar[XB_TOPGEN], 1u);
            else XB_SPIN(xb_ld(&bar[XB_TOPGEN]) == tg, bar);
            __builtin_amdgcn_fence(__ATOMIC_ACQUIRE, "agent");
            xb_add(&bar[XB_XGEN(b.x)], 1u);
            asm volatile("s_waitcnt vmcnt(0)" ::: "memory");
        } else {
            XB_SPIN(xb_ld(&bar[XB_XGEN(b.x)]) == gen, bar);
            __builtin_amdgcn_fence(__ATOMIC_ACQUIRE, "agent");
            asm volatile("s_waitcnt vmcnt(0)" ::: "memory");
        }
    }
    __syncthreads();
}

struct Args { const float* in[23]; float* out; unsigned char* ws; int ph_lo, ph_hi; unsigned dup; int dry; };
static_assert(sizeof(Args) == 23 * 8 + 8 + 8 + 16, "Args has no padding");
struct Frame {
    LAS unsigned char* lds;
    int tid, lane, wave, vcu;
    unsigned char* ws;
};
#define WSP(T, off) ((T*)(F.ws + (off)))

template <class S, class E>
__device__ __forceinline__ void gemm_simple(LAS unsigned char* lds, const S& sch, const E& epi) {
    const int tid = threadIdx.x, wid = tid >> 6, lane = tid & 63, wr = wid >> 2, wc = wid & 3, fr = lane & 15, fq = lane >> 4;
    constexpr int PITCH = 144;
    LAS unsigned char* As = lds; LAS unsigned char* Bs = lds + 256 * PITCH;
    typename S::U u;
    for (int i = 0; sch.next(i, u); ++i) {
        f32x4 acc[2][2][4][2];
#pragma unroll
        for (int a = 0; a < 2; ++a)
#pragma unroll
            for (int b = 0; b < 2; ++b)
#pragma unroll
                for (int m = 0; m < 4; ++m)
#pragma unroll
                    for (int n = 0; n < 2; ++n) acc[a][b][m][n] = (f32x4){0.f, 0.f, 0.f, 0.f};
        const int nt = sch.K(u) / 64;
        const char* pa[4]; const char* pb[4];
#pragma unroll
        for (int j = 0; j < 4; ++j) { const int row = (tid >> 3) + 64 * j; const int rb = S::PERM ? ((row & ~31) + 8 * ((row & 15) >> 2) + 4 * ((row >> 4) & 1) + (row & 3)) : row; pa[j] = sch.rowA(u, row) + (tid & 7) * 16; pb[j] = sch.rowB(u, rb) + (tid & 7) * 16; }
        for (int kt = 0; kt < nt; ++kt) {
            u32x4 va[4], vb[4];
#pragma unroll
            for (int j = 0; j < 4; ++j) { va[j] = *(const u32x4*)(pa[j] + kt * 128); vb[j] = *(const u32x4*)(pb[j] + kt * 128); }
            __syncthreads();
#pragma unroll
            for (int j = 0; j < 4; ++j) { const int row = (tid >> 3) + 64 * j;
                *(LAS u32x4*)(As + row * PITCH + (tid & 7) * 16) = va[j]; *(LAS u32x4*)(Bs + row * PITCH + (tid & 7) * 16) = vb[j]; }
            __syncthreads();
#pragma unroll
            for (int kk = 0; kk < 2; ++kk) {
                bf16x8 Bf[2][2];
#pragma unroll
                for (int b = 0; b < 2; ++b)
#pragma unroll
                    for (int n = 0; n < 2; ++n) Bf[b][n] = *(const LAS bf16x8*)(Bs + (b * 128 + wc * 32 + n * 16 + fr) * PITCH + kk * 64 + fq * 16);
#pragma unroll
                for (int a = 0; a < 2; ++a) {
                    bf16x8 Af[4];
#pragma unroll
                    for (int m = 0; m < 4; ++m) Af[m] = *(const LAS bf16x8*)(As + (a * 128 + wr * 64 + m * 16 + fr) * PITCH + kk * 64 + fq * 16);
#pragma unroll
                    for (int b = 0; b < 2; ++b)
#pragma unroll
                        for (int m = 0; m < 4; ++m)
#pragma unroll
                            for (int n = 0; n < 2; ++n) acc[a][b][m][n] = __builtin_amdgcn_mfma_f32_16x16x32_bf16(Bf[b][n], Af[m], acc[a][b][m][n], 0, 0, 0);
                }
            }
        }
        epi(acc, u, wr, wc, fr, fq);
    }
    __syncthreads();
}

namespace pg8 {
constexpr int HTB = 128 * 64 * 2;
__device__ __forceinline__ int lds_byte(int r, int c) { const int st = (r >> 4) * 2 + (c >> 5), rr = r & 15, cc = c & 31, ob = rr * 64 + cc * 2; return st * 1024 + (ob ^ (((ob >> 9) & 1) << 5)); }
__device__ __forceinline__ int perm32(int rho) { const int n = rho >> 4, i = rho & 15; return 8 * (i >> 2) + 4 * n + (i & 3); }
__device__ __forceinline__ int prow(int r) { return (r & ~31) + perm32(r & 31); }
__device__ __forceinline__ void stage_rc(int b, int& R, int& C) { const int st = b / 1024, sb = b % 1024, swz = sb ^ (((sb >> 9) & 1) << 5); R = (st >> 1) * 16 + swz / 64; C = (st & 1) * 32 + (swz % 64) / 2; }
}
template <class S, class E>
__device__ __forceinline__ void gemm_fast(LAS unsigned char* lds, const S& sch, const E& epi) {
    using namespace pg8;
    const int tid = threadIdx.x, wid = __builtin_amdgcn_readfirstlane(tid >> 6), lane = tid & 63, wr = wid >> 2, wc = wid & 3, fr = lane & 15, fq = lane >> 4;
    const int nt = sch.Kk / 64;
    int R0, C0; stage_rc(tid * 16, R0, C0);
    unsigned voffA[2], voffB[2]; unsigned cofA[4], nofA[4], cofB[4], nofB[4];
    size_t hstepA = 0, hstepB = 0;
    if constexpr (!S::GA) { voffA[0] = (unsigned)(R0 * sch.lda + C0) * 2u; voffA[1] = (unsigned)((R0 + 64) * sch.lda + C0) * 2u; hstepA = (size_t)128 * sch.lda * 2; }
    const int RB0 = S::PERM ? prow(R0) : R0;
    if constexpr (!S::GB) { voffB[0] = (unsigned)(RB0 * sch.ldb + C0) * 2u; voffB[1] = (unsigned)((RB0 + 64) * sch.ldb + C0) * 2u; hstepB = (size_t)128 * sch.ldb * 2; }
    const size_t kstep = 128;
    const unsigned ldsw = (unsigned)wid * 1024u;
    const int aoff = lds_byte(wr * 64 + fr, fq * 8), boff = lds_byte(wc * 32 + fr, fq * 8);
#define G_SA(b, h) (((b) * 2 + (h)) * HTB)
#define G_SB(b, h) ((4 + (b) * 2 + (h)) * HTB)
#define G_GLDS(src, dst) __builtin_amdgcn_global_load_lds((const unsigned*)(src), (LAS unsigned*)(dst), 16, 0, 0)
#define G_STAGE_A(bufoff, gp, h, nx) do { if constexpr (S::GA) { _Pragma("unroll") for (int _i = 0; _i < 2; ++_i) { const unsigned _o = (nx) ? nofA[2 * (h) + _i] : cofA[2 * (h) + _i]; G_GLDS((gp) + _o, lds + (bufoff) + ldsw + _i * 8192); } } \
        else { _Pragma("unroll") for (int _i = 0; _i < 2; ++_i) G_GLDS((gp) + (size_t)(h) * hstepA + voffA[_i], lds + (bufoff) + ldsw + _i * 8192); } } while (0)
#define G_STAGE_B(bufoff, gp, h, nx) do { if constexpr (S::GB) { _Pragma("unroll") for (int _i = 0; _i < 2; ++_i) { const unsigned _o = (nx) ? nofB[2 * (h) + _i] : cofB[2 * (h) + _i]; G_GLDS((gp) + _o, lds + (bufoff) + ldsw + _i * 8192); } } \
        else { _Pragma("unroll") for (int _i = 0; _i < 2; ++_i) G_GLDS((gp) + (size_t)(h) * hstepB + voffB[_i], lds + (bufoff) + ldsw + _i * 8192); } } while (0)
#define G_LDA(dst, b, h) do { _Pragma("unroll") for (int m = 0; m < 4; ++m) _Pragma("unroll") for (int k = 0; k < 2; ++k) dst[m][k] = *(const LAS bf16x8*)(lds + G_SA(b, h) + aoff + m * 2048 + k * 1024); } while (0)
#define G_LDB(dst, b, h) do { _Pragma("unroll") for (int n = 0; n < 2; ++n) _Pragma("unroll") for (int k = 0; k < 2; ++k) dst[n][k] = *(const LAS bf16x8*)(lds + G_SB(b, h) + boff + n * 2048 + k * 1024); } while (0)
#define G_MMA(ai, bj, At, Bt) do { __builtin_amdgcn_s_setprio(1); _Pragma("unroll") for (int m = 0; m < 4; ++m) _Pragma("unroll") for (int n = 0; n < 2; ++n) _Pragma("unroll") for (int k = 0; k < 2; ++k) \
        acc[ai][bj][m][n] = __builtin_amdgcn_mfma_f32_16x16x32_bf16(Bt[n][k], At[m][k], acc[ai][bj][m][n], 0, 0, 0); __builtin_amdgcn_s_setprio(0); } while (0)
#define G_WAIT_V(n) asm volatile("s_waitcnt vmcnt(" #n ")" ::: "memory")
#define G_WAIT_L(n) asm volatile("s_waitcnt lgkmcnt(" #n ")" ::: "memory")
#define G_BAR __builtin_amdgcn_s_barrier()
#define G_SCHED __builtin_amdgcn_sched_barrier(0)
    typename S::U cur, nxt; int ui = 0;
    if (!sch.next(0, cur)) return;
    f32x4 acc[2][2][4][2];
#pragma unroll
    for (int a = 0; a < 2; ++a)
#pragma unroll
        for (int b = 0; b < 2; ++b)
#pragma unroll
            for (int m = 0; m < 4; ++m)
#pragma unroll
                for (int n = 0; n < 2; ++n) acc[a][b][m][n] = (f32x4){0.f, 0.f, 0.f, 0.f};
    bf16x8 At[4][2], B0[2][2], B1[2][2];
    const char* cA = sch.baseA(cur); const char* cB = sch.baseB(cur);
    if constexpr (S::GA) {
#pragma unroll
        for (int j = 0; j < 4; ++j) { cofA[j] = sch.goffA(cur, (j >> 1) * 128 + R0 + (j & 1) * 64, C0); nofA[j] = cofA[j]; } }
    if constexpr (S::GB) {
#pragma unroll
        for (int j = 0; j < 4; ++j) { cofB[j] = sch.goffB(cur, (j >> 1) * 128 + RB0 + (j & 1) * 64, C0); nofB[j] = cofB[j]; } }
    G_STAGE_B(G_SB(0, 0), cB, 0, false); G_STAGE_B(G_SB(0, 1), cB, 1, false); G_STAGE_A(G_SA(0, 0), cA, 0, false); G_STAGE_A(G_SA(0, 1), cA, 1, false);
    if (wr == 1) G_BAR;
    G_WAIT_V(2); G_BAR;
    G_STAGE_B(G_SB(1, 0), cB + kstep, 0, false); G_STAGE_A(G_SA(1, 0), cA + kstep, 0, false); G_STAGE_B(G_SB(1, 1), cB + kstep, 1, false);
    G_WAIT_V(6); G_BAR;
    for (;;) {
        const bool has_next = sch.next(ui + 1, nxt);
        const char* nA = has_next ? sch.baseA(nxt) : cA; const char* nB = has_next ? sch.baseB(nxt) : cB;
        if constexpr (S::GA) { if (has_next) {
#pragma unroll
            for (int j = 0; j < 4; ++j) nofA[j] = sch.goffA(nxt, (j >> 1) * 128 + R0 + (j & 1) * 64, C0); } }
        if constexpr (S::GB) { if (has_next) {
#pragma unroll
            for (int j = 0; j < 4; ++j) nofB[j] = sch.goffB(nxt, (j >> 1) * 128 + RB0 + (j & 1) * 64, C0); } }
#pragma unroll 1
        for (int t = 0; t < nt; t += 2) {
            const bool last = (t == nt - 2);
            const char* a1 = cA + (size_t)(t + 1) * kstep;
            const char* a2 = last ? nA : cA + (size_t)(t + 2) * kstep; const char* b2 = last ? nB : cB + (size_t)(t + 2) * kstep;
            const char* a3 = a2 + kstep; const char* b3 = b2 + kstep;
            asm volatile("" : "+s"(a1), "+s"(a2), "+s"(a3), "+s"(b2), "+s"(b3));
            G_LDB(B0, 0, 0); G_LDB(B1, 0, 1); G_SCHED; G_LDA(At, 0, 0); G_STAGE_A(G_SA(1, 1), a1, 1, false);
            if (t == 0 && ui > 0) { if constexpr (E::NVM == 8) G_WAIT_V(16); else if constexpr (E::NVM == 16) G_WAIT_V(24); else if constexpr (E::NVM == 32) G_WAIT_V(40); else G_WAIT_V(8); } else G_WAIT_V(8);
            G_WAIT_L(0); G_BAR; G_MMA(0, 0, At, B0); G_MMA(0, 1, At, B1); G_BAR; G_SCHED;
            G_LDA(At, 0, 1); G_STAGE_B(G_SB(0, 0), b2, 0, last); G_STAGE_B(G_SB(0, 1), b2, 1, last); G_STAGE_A(G_SA(0, 0), a2, 0, last);
            G_WAIT_V(8); G_WAIT_L(0); G_BAR; G_MMA(1, 0, At, B0); G_MMA(1, 1, At, B1); G_BAR; G_SCHED;
            G_LDB(B0, 1, 0); G_LDB(B1, 1, 1); G_SCHED; G_LDA(At, 1, 0); G_STAGE_A(G_SA(0, 1), a2, 1, last);
            G_WAIT_V(8); G_WAIT_L(0); G_BAR; G_MMA(0, 0, At, B0); G_MMA(0, 1, At, B1); G_BAR; G_SCHED;
            G_LDA(At, 1, 1); G_STAGE_B(G_SB(1, 0), b3, 0, last); G_STAGE_B(G_SB(1, 1), b3, 1, last); G_STAGE_A(G_SA(1, 0), a3, 0, last);
            G_WAIT_V(8); G_WAIT_L(0); G_BAR; G_MMA(1, 0, At, B0); G_MMA(1, 1, At, B1); G_BAR; G_SCHED;
        }
        if (wr == 0) G_BAR;
        epi(acc, cur, wr, wc, fr, fq);
        if (!has_next) break;
#pragma unroll
        for (int a = 0; a < 2; ++a)
#pragma unroll
            for (int b = 0; b < 2; ++b)
#pragma unroll
                for (int m = 0; m < 4; ++m)
#pragma unroll
                    for (int n = 0; n < 2; ++n) acc[a][b][m][n] = (f32x4){0.f, 0.f, 0.f, 0.f};
        cur = nxt; cA = nA; cB = nB; ++ui;
        if constexpr (S::GA) {
#pragma unroll
            for (int j = 0; j < 4; ++j) cofA[j] = nofA[j]; }
        if constexpr (S::GB) {
#pragma unroll
            for (int j = 0; j < 4; ++j) cofB[j] = nofB[j]; }
        if (wr == 1) G_BAR;
    }
    G_WAIT_V(0);
    G_BAR;
#undef G_SA
#undef G_SB
#undef G_GLDS
#undef G_STAGE_A
#undef G_STAGE_B
#undef G_LDA
#undef G_LDB
#undef G_MMA
#undef G_WAIT_V
#undef G_WAIT_L
#undef G_BAR
#undef G_SCHED
}
#ifndef MK_FAST
#define MK_FAST 1
#endif
#if MK_FAST
#define GEMM_PHASE(lds, S, E) gemm_fast(lds, S, E)
#else
#define GEMM_PHASE(lds, S, E) gemm_simple(lds, S, E)
#endif

#define ROWLOOP _Pragma("unroll") for (int ai = 0; ai < 2; ++ai) _Pragma("unroll") for (int m = 0; m < 4; ++m)
#define UROW (ai * 128 + wr * 64 + m * 16 + fr)
#define UCOL(bj, n) ((bj) * 128 + wc * 32 + (n) * 16 + 4 * fq)
#define UCOLP(bj) ((bj) * 128 + wc * 32 + 8 * fq)
__device__ __forceinline__ u32x4 pk8(const f32x4 a, const f32x4 b) { u32x4 w; w.x = pk2(a.x, a.y); w.y = pk2(a.z, a.w); w.z = pk2(b.x, b.y); w.w = pk2(b.z, b.w); return w; }
typedef f32x4 AccT[2][2][4][2];

struct UnitD { int pm, pn; };
template <bool PERM_> struct SchedDenseT {
    typedef UnitD U;
    static constexpr bool GA = false, GB = false, PERM = PERM_;
    const bf16* A; const bf16* Bt; int lda, ldb, Kk, nM, nN, vcu;
    __device__ __forceinline__ const char* baseA(const U& u) const { return (const char*)(A + (size_t)u.pm * 256 * lda); }
    __device__ __forceinline__ const char* baseB(const U& u) const { return (const char*)(Bt + (size_t)u.pn * 256 * ldb); }
    __device__ __forceinline__ bool next(int i, U& u) const { const int L = i * NWG + vcu; if (L >= nM * nN) return false; u.pm = L / nN; u.pn = L % nN; return true; }
    __device__ __forceinline__ int K(const U&) const { return Kk; }
    __device__ __forceinline__ const char* rowA(const U& u, int r) const { return (const char*)(A + (size_t)(u.pm * 256 + r) * lda); }
    __device__ __forceinline__ const char* rowB(const U& u, int r) const { return (const char*)(Bt + (size_t)(u.pn * 256 + r) * ldb); }
};
typedef SchedDenseT<false> SchedDense; typedef SchedDenseT<true> SchedDenseP;
struct EpiXZ {
    static constexpr int NVM = 16;
    bf16* XR; bf16* GG;
    __device__ __forceinline__ void operator()(const AccT& acc, const UnitD& u, int wr, int wc, int fr, int fq) const {
        const bool isg = u.pn >= 4; bf16* base = isg ? GG : XR; const int c0 = (u.pn & 3) * 256;
        ROWLOOP { bf16* rp = base + (size_t)(u.pm * 256 + UROW) * D + c0;
#pragma unroll
            for (int bj = 0; bj < 2; ++bj) { f32x4 v0 = acc[ai][bj][m][0], v1 = acc[ai][bj][m][1];
                if (isg) {
#pragma unroll
                    for (int j = 0; j < 4; ++j) { v0[j] = gelu_tanh(v0[j]); v1[j] = gelu_tanh(v1[j]); } }
                *(u32x4*)(rp + UCOLP(bj)) = pk8(v0, v1); } }
    }
};
struct EpiResF32 {
    static constexpr int NVM = 0;
    const float* R; float* O; int ldc;
    __device__ __forceinline__ void operator()(const AccT& acc, const UnitD& u, int wr, int wc, int fr, int fq) const {
        ROWLOOP { const size_t ro = (size_t)(u.pm * 256 + UROW) * ldc + u.pn * 256;
#pragma unroll
            for (int bj = 0; bj < 2; ++bj)
#pragma unroll
                for (int n = 0; n < 2; ++n) { const f32x4 r = *(const f32x4*)(R + ro + UCOL(bj, n)); *(f32x4*)(O + ro + UCOL(bj, n)) = r * ALPHA + acc[ai][bj][m][n]; } }
    }
};
struct EpiF32 {
    static constexpr int NVM = 32;
    float* O; int ldc;
    __device__ __forceinline__ void operator()(const AccT& acc, const UnitD& u, int wr, int wc, int fr, int fq) const {
        ROWLOOP { const size_t ro = (size_t)(u.pm * 256 + UROW) * ldc + u.pn * 256;
#pragma unroll
            for (int bj = 0; bj < 2; ++bj)
#pragma unroll
                for (int n = 0; n < 2; ++n) *(f32x4*)(O + ro + UCOL(bj, n)) = acc[ai][bj][m][n]; }
    }
};

struct UnitG { int pm, blk, pn; };
struct SchedGate {
    typedef UnitG U;
    static constexpr bool GA = false, GB = false, PERM = true; static constexpr int Kk = 256, lda = D, ldb = 256;
    const bf16* XC; const bf16* WgT; int vcu;
    __device__ __forceinline__ const char* baseA(const U& u) const { return (const char*)(XC + (size_t)u.pm * 256 * D + u.blk * 256); }
    __device__ __forceinline__ const char* baseB(const U& u) const { return (const char*)(WgT + (size_t)(u.blk * 512 + u.pn * 256) * 256); }
    __device__ __forceinline__ bool next(int i, U& u) const { const int L = i * NWG + vcu; if (L >= 128 * 8) return false; u.pm = L >> 3; u.blk = (L >> 1) & 3; u.pn = L & 1; return true; }
    __device__ __forceinline__ int K(const U&) const { return 256; }
    __device__ __forceinline__ const char* rowA(const U& u, int r) const { return (const char*)(XC + (size_t)(u.pm * 256 + r) * D + u.blk * 256); }
    __device__ __forceinline__ const char* rowB(const U& u, int r) const { return (const char*)(WgT + (size_t)(u.blk * 512 + u.pn * 256 + r) * 256); }
};
struct EpiGate {
    static constexpr int NVM = 0;
    const bf16* XC; const float *ba, *bx, *lam; bf16* LA; bf16* UU;
    __device__ __forceinline__ void operator()(const AccT& acc, const UnitG& u, int wr, int wc, int fr, int fq) const {
        const int c0 = u.blk * 256 + u.pn * 128 + wc * 32 + 8 * fq;
        f32x4 vba[2], vbx[2], sp[2];
#pragma unroll
        for (int n = 0; n < 2; ++n) { vba[n] = *(const f32x4*)(ba + c0 + 4 * n); vbx[n] = *(const f32x4*)(bx + c0 + 4 * n); const f32x4 vl = *(const f32x4*)(lam + c0 + 4 * n);
#pragma unroll
            for (int j = 0; j < 4; ++j) { const float x = __expf(-vl[j]); sp[n][j] = 8.0f * x * (1.0f - x * (0.5f - x * (1.0f / 3.0f))); } }
        ROWLOOP { const size_t ro = (size_t)(u.pm * 256 + UROW) * D + c0;
            const u32x4 xw = *(const u32x4*)(XC + ro); const float xc[8] = {bf_lo(xw.x), bf_hi(xw.x), bf_lo(xw.y), bf_hi(xw.y), bf_lo(xw.z), bf_hi(xw.z), bf_lo(xw.w), bf_hi(xw.w)};
            f32x4 la[2], uu[2];
#pragma unroll
            for (int n = 0; n < 2; ++n) { const f32x4 ga = acc[ai][0][m][n] + vba[n], gx = acc[ai][1][m][n] + vbx[n];
#pragma unroll
                for (int j = 0; j < 4; ++j) { const float r = sigmoidf_(ga[j]), ig = sigmoidf_(gx[j]); const float l = -r * sp[n][j]; la[n][j] = l;
                    const float mult = sqrtf(fmaxf(1.0f - __expf(2.0f * l), 0.f)); uu[n][j] = mult * ig * xc[4 * n + j]; } }
            *(u32x4*)(LA + ro) = pk8(la[0], la[1]); *(u32x4*)(UU + ro) = pk8(uu[0], uu[1]); asm volatile("" ::: "memory"); }
    }
};

struct UnitE { int rb, pn, e; };
struct SchedG1 {
    typedef UnitE U;
    static constexpr bool GA = true, GB = false, PERM = true; static constexpr int Kk = D, lda = D, ldb = D;
    const bf16* X; const bf16* W13T; const int* ROWA; const int* BLKE; int nrbt, vcu;
    __device__ __forceinline__ const char* baseA(const U&) const { return (const char*)X; }
    __device__ __forceinline__ const char* baseB(const U& u) const { return (const char*)(W13T + ((size_t)u.e * 512 + u.pn * 256) * D); }
    __device__ __forceinline__ unsigned goffA(const U& u, int r, int C) const { const int a = ROWA[u.rb * 256 + r]; const int tok = a < 0 ? 0 : (a < 8 * M ? (a >> 3) : a - 8 * M); return (unsigned)(tok * D + C) * 2u; }
    __device__ __forceinline__ unsigned goffB(const U&, int, int) const { return 0u; }
    __device__ __forceinline__ bool next(int i, U& u) const { const int L = i * NWG + vcu; const int rb = L >> 1; if (rb >= nrbt) return false; u.rb = rb; u.pn = L & 1; u.e = BLKE[rb]; return true; }
    __device__ __forceinline__ int K(const U&) const { return D; }
    __device__ __forceinline__ const char* rowA(const U& u, int r) const { const int a = ROWA[u.rb * 256 + r]; const int tok = a < 0 ? 0 : (a < 8 * M ? (a >> 3) : a - 8 * M); return (const char*)(X + (size_t)tok * D); }
    __device__ __forceinline__ const char* rowB(const U& u, int r) const { return (const char*)(W13T + ((size_t)u.e * 512 + u.pn * 256 + r) * D); }
};
struct EpiSwiGLU {
    static constexpr int NVM = 8;
    bf16* HID;
    __device__ __forceinline__ void operator()(const AccT& acc, const UnitE& u, int wr, int wc, int fr, int fq) const {
        ROWLOOP { bf16* rp = HID + (size_t)(u.rb * 256 + UROW) * DE + u.pn * 128;
            f32x4 h0, h1;
#pragma unroll
            for (int j = 0; j < 4; ++j) { const float a0 = acc[ai][0][m][0][j], a1 = acc[ai][0][m][1][j]; h0[j] = a0 * sigmoidf_(a0) * acc[ai][1][m][0][j]; h1[j] = a1 * sigmoidf_(a1) * acc[ai][1][m][1][j]; }
            *(u32x4*)(rp + wc * 32 + 8 * fq) = pk8(h0, h1); }
    }
};
struct SchedG2 {
    typedef UnitE U;
    static constexpr bool GA = false, GB = false, PERM = true; static constexpr int Kk = DE, lda = DE, ldb = DE;
    const bf16* HID; const bf16* W2T; const int* BLKE; int nrbt, vcu;
    __device__ __forceinline__ const char* baseA(const U& u) const { return (const char*)(HID + (size_t)u.rb * 256 * DE); }
    __device__ __forceinline__ const char* baseB(const U& u) const { return (const char*)(W2T + ((size_t)u.e * D + u.pn * 256) * DE); }
    __device__ __forceinline__ bool next(int i, U& u) const { const int L = i * NWG + vcu; const int rb = L >> 2; if (rb >= nrbt) return false; u.rb = rb; u.pn = L & 3; u.e = BLKE[rb]; return true; }
    __device__ __forceinline__ int K(const U&) const { return DE; }
    __device__ __forceinline__ const char* rowA(const U& u, int r) const { return (const char*)(HID + (size_t)(u.rb * 256 + r) * DE); }
    __device__ __forceinline__ const char* rowB(const U& u, int r) const { return (const char*)(W2T + ((size_t)u.e * D + u.pn * 256 + r) * DE); }
};
struct EpiScatter {
    static constexpr int NVM = 16;
    bf16* YA; int dry;
    __device__ __forceinline__ void operator()(const AccT& acc, const UnitE& u, int wr, int wc, int fr, int fq) const {
        if (dry == 1) return;
        const size_t rbase = dry == 2 ? (size_t)(blockIdx.x * 256) : (size_t)u.rb * 256;
        ROWLOOP { unsigned char* rp = (unsigned char*)YA + (rbase + UROW) * D + u.pn * 256;
#pragma unroll
            for (int bj = 0; bj < 2; ++bj) { const f32x4 v0 = acc[ai][bj][m][0] * 16.0f, v1 = acc[ai][bj][m][1] * 16.0f; u32x2 w;
                int t0 = __builtin_amdgcn_cvt_pk_fp8_f32(v0.x, v0.y, 0, false); t0 = __builtin_amdgcn_cvt_pk_fp8_f32(v0.z, v0.w, t0, true);
                int t1 = __builtin_amdgcn_cvt_pk_fp8_f32(v1.x, v1.y, 0, false); t1 = __builtin_amdgcn_cvt_pk_fp8_f32(v1.z, v1.w, t1, true);
                w.x = (unsigned)t0; w.y = (unsigned)t1; *(u32x2*)(rp + UCOLP(bj)) = w; } }
    }
};

__device__ __forceinline__ int rho_to_tok(int rho, int g) { const int sh = 14 - 2 * g; const int rp = rho & 16383; return (rho & ~16383) + (rp >> sh) + ((rp & ((1 << sh) - 1)) << (2 * g)); }
__device__ __forceinline__ int tok_to_rho(int t, int g) { const int sh = 14 - 2 * g; const int tp = t & 16383; return (t & ~16383) + ((tp & ((1 << (2 * g)) - 1)) << sh) + (tp >> (2 * g)); }
struct UnitQ { int type, g, pm, pn; };
struct SchedQK {
    typedef UnitQ U;
    static constexpr bool GA = false, GB = false, PERM = true; static constexpr int Kk = D, ldb = D;
    const bf16* X; const bf16* WqkT; int g, lda, vcu;
    __device__ __forceinline__ bool next(int i, U& u) const { const int L = i * NWG + vcu; if (L >= 512) return false; u.type = 0; u.g = g; u.pm = L >> 2; u.pn = L & 3; return true; }
    __device__ __forceinline__ int K(const U&) const { return D; }
    __device__ __forceinline__ const char* baseA(const U& u) const { return (const char*)(X + (size_t)rho_to_tok(u.pm * 256, g) * D); }
    __device__ __forceinline__ const char* baseB(const U& u) const { return (const char*)(WqkT + ((size_t)g * 1024 + u.pn * 256) * D); }
    __device__ __forceinline__ const char* rowA(const U& u, int r) const { return (const char*)(X + (size_t)rho_to_tok(u.pm * 256 + r, g) * D); }
    __device__ __forceinline__ const char* rowB(const U& u, int r) const { return (const char*)(WqkT + ((size_t)g * 1024 + u.pn * 256 + r) * D); }
};
struct SchedVT {
    typedef UnitQ U;
    static constexpr bool GA = false, GB = false, PERM = true; static constexpr int Kk = D, lda = D;
    const bf16* X; const bf16* WvT; int g, ldb, vcu;
    __device__ __forceinline__ bool next(int i, U& u) const { const int L = i * NWG + vcu; if (L >= 256) return false; u.type = 1; u.g = g; u.pn = L >> 1; u.pm = L & 1; return true; }
    __device__ __forceinline__ int K(const U&) const { return D; }
    __device__ __forceinline__ const char* baseA(const U& u) const { return (const char*)(WvT + ((size_t)g * 512 + u.pm * 256) * D); }
    __device__ __forceinline__ const char* baseB(const U& u) const { return (const char*)(X + (size_t)rho_to_tok(u.pn * 256, g) * D); }
    __device__ __forceinline__ const char* rowA(const U& u, int r) const { return (const char*)(WvT + ((size_t)g * 512 + u.pm * 256 + r) * D); }
    __device__ __forceinline__ const char* rowB(const U& u, int r) const { return (const char*)(X + (size_t)rho_to_tok(u.pn * 256 + r, g) * D); }
};
struct EpiQKV {
    static constexpr int NVM = 16;
    bf16* QK; bf16* VT;
    __device__ __forceinline__ void operator()(const AccT& acc, const UnitQ& u, int wr, int wc, int fr, int fq) const {
        bf16* base; size_t ldc;
        if (u.type == 0) { base = QK + (size_t)u.g * M * 1024; ldc = 1024; } else { base = VT + (size_t)u.g * 512 * M; ldc = M; }
        ROWLOOP { bf16* rp = base + (size_t)(u.pm * 256 + UROW) * ldc + u.pn * 256;
#pragma unroll
            for (int bj = 0; bj < 2; ++bj) *(u32x4*)(rp + UCOLP(bj)) = pk8(acc[ai][bj][m][0], acc[ai][bj][m][1]); }
    }
};

__device__ __forceinline__ void tr_item(const float* src, int spitch, bf16* dst, int dpitch, LAS float* scr, int lane) {
#pragma unroll 4
    for (int i = 0; i < 16; ++i) { const int k = 4 * i + (lane >> 4), n4 = (lane & 15) * 4; const f32x4 v = *(const f32x4*)(src + (size_t)k * spitch + n4);
        LAS float* s = scr + k * 65 + n4; s[0] = v.x; s[1] = v.y; s[2] = v.z; s[3] = v.w; }
    LDS_WAIT(); asm volatile("" ::: "memory");
    const int c = lane & 7;
#pragma unroll
    for (int j = 0; j < 8; ++j) { const int n = 8 * j + (lane >> 3); const LAS float* s = scr + (8 * c) * 65 + n;
        u32x4 o; o.x = pk2(s[0], s[65]); o.y = pk2(s[2 * 65], s[3 * 65]); o.z = pk2(s[4 * 65], s[5 * 65]); o.w = pk2(s[6 * 65], s[7 * 65]);
        *(u32x4*)(dst + (size_t)n * dpitch + 8 * c) = o; }
    LDS_WAIT(); asm volatile("" ::: "memory");
}
template <class RowMap>
__device__ __forceinline__ void tr_matrix(Frame& F, const float* W, int K, int N, bf16* WT, int dpitch, RowMap drow) {
    LAS float* scr = (LAS float*)(F.lds + F.wave * 16640);
    const int nkb = K / 64, nnb = N / 64;
    for (int it = F.vcu * NWAVES + F.wave; it < nkb * nnb; it += NGW) { const int kb = it / nnb, nb = it % nnb;
        tr_item(W + (size_t)(kb * 64) * N + nb * 64, N, WT + (size_t)drow(nb * 64) * dpitch + kb * 64, dpitch, scr, F.lane); }
}
__device__ __forceinline__ void convert_experts(Frame& F, const float* w1, const float* w3, const float* w2, const float* s1, const float* s3, const float* s2) {
    LAS float* scr = (LAS float*)(F.lds + F.wave * 16640);
    bf16* W13T = WSP(bf16, WS_W13); bf16* W2T = WSP(bf16, WS_W2);
    for (int it = F.vcu * NWAVES + F.wave; it < 257 * 192; it += NGW) {
        const int e = it / 192, r = it % 192, which = r >> 6, tile = r & 63;
        if (which < 2) {
            const float* W = (e < 256) ? (which == 0 ? w1 : w3) + (size_t)e * (size_t)(D * DE) : (which == 0 ? s1 : s3);
            const int kb = tile >> 2, nb = tile & 3; const int drow = (nb >> 1) * 256 + which * 128 + (nb & 1) * 64;
            tr_item(W + (size_t)(kb * 64) * DE + nb * 64, DE, W13T + ((size_t)e * 512 + drow) * D + kb * 64, D, scr, F.lane);
        } else {
            const float* W = (e < 256) ? w2 + (size_t)e * (size_t)(DE * D) : s2;
            const int kb = tile >> 4, nb = tile & 15;
            tr_item(W + (size_t)(kb * 64) * D + nb * 64, D, W2T + ((size_t)e * D + nb * 64) * DE + kb * 64, DE, scr, F.lane);
        }
    }
}
struct MapId { __device__ int operator()(int n0) const { return n0; } };
struct MapGate { int which; __device__ int operator()(int n0) const { return (n0 >> 7) * 256 + which * 128 + (n0 & 127); } };
struct MapQ { __device__ int operator()(int n0) const { return (n0 >> 9) * 1024 + (n0 & 511); } };
struct MapKV { __device__ int operator()(int n0) const { return n0 < 1536 ? (n0 >> 9) * 1024 + 512 + (n0 & 511) : 3072 + (n0 - 1536); } };

__device__ __forceinline__ void p0_prologue(Frame& F, const Args& A) {
    { const float* x = A.in[0]; bf16* XB = WSP(bf16, WS_RA + RA_XB);
      for (size_t i = (size_t)F.vcu * NTHR + F.tid; i < (size_t)M * D / 8; i += NGT) { const f32x4 a = *(const f32x4*)(x + i * 8), b = *(const f32x4*)(x + i * 8 + 4);
          u32x4 o; o.x = pk2(a.x, a.y); o.y = pk2(a.z, a.w); o.z = pk2(b.x, b.y); o.w = pk2(b.z, b.w); *(u32x4*)(XB + i * 8) = o; } }
    tr_matrix(F, A.in[1], D, 2048, WSP(bf16, WS_WIN), D, MapId());
    for (int b = 0; b < 4; ++b) { tr_matrix(F, A.in[4] + b * 65536, 256, 256, WSP(bf16, WS_WG) + (size_t)b * 512 * 256, 256, MapGate{0});
                                  tr_matrix(F, A.in[6] + b * 65536, 256, 256, WSP(bf16, WS_WG) + (size_t)b * 512 * 256, 256, MapGate{1}); }
    tr_matrix(F, A.in[9], D, D, WSP(bf16, WS_WOUT), D, MapId());
    tr_matrix(F, A.in[11], D, QW, WSP(bf16, WS_WQK), D, MapQ());
    tr_matrix(F, A.in[10], D, 2 * QW, WSP(bf16, WS_WQK), D, MapKV());
    tr_matrix(F, A.in[12], OW, D, WSP(bf16, WS_WO), OW, MapId());
    for (int l = 0; l < 2; ++l) tr_matrix(F, A.in[13] + (size_t)l * D * NE, D, NE, WSP(bf16, WS_WR) + (size_t)l * NE * D, D, MapId());
    convert_experts(F, A.in[15], A.in[16], A.in[17], A.in[18], A.in[19], A.in[20]);
}
static_assert(WS_WV == WS_WQK + (size_t)3072 * 1024 * 2, "WvT must follow WqkT");

__device__ __forceinline__ void ln_store(f32x4 (&v)[4], const float* g, const float* b, float* of, bf16* ob, int lane) {
    float s = 0.f;
#pragma unroll
    for (int j = 0; j < 4; ++j) s += (v[j].x + v[j].y) + (v[j].z + v[j].w);
    const float mean = wave_sum(s) * (1.f / D); float s2 = 0.f;
#pragma unroll
    for (int j = 0; j < 4; ++j) { v[j] = v[j] - mean; s2 += (v[j].x * v[j].x + v[j].y * v[j].y) + (v[j].z * v[j].z + v[j].w * v[j].w); }
    const float rstd = 1.f / sqrtf(wave_sum(s2) * (1.f / D) + LN_EPS);
#pragma unroll
    for (int j = 0; j < 4; ++j) { const int c = 4 * lane + 256 * j; const f32x4 gg = *(const f32x4*)(g + c), bb = *(const f32x4*)(b + c); const f32x4 y = v[j] * rstd * gg + bb;
        if (of) *(f32x4*)(of + c) = y;
        if (ob) { u32x2 w; w.x = pk2(y.x, y.y); w.y = pk2(y.z, y.w); *(u32x2*)(ob + c) = w; } }
}

__device__ __forceinline__ void p_conv(Frame& F, const float* cw, const float* cb) {
    const bf16* XR = WSP(bf16, WS_RA + RA_XR); bf16* XC = WSP(bf16, WS_RA + RA_XC);
    for (int i = F.vcu * NTHR + F.tid; i < M * (D / 8); i += NGT) { const int t = i >> 7, c = (i & 127) * 8; const int ts = t & (SEQ - 1);
        float a[8];
#pragma unroll
        for (int q = 0; q < 8; ++q) a[q] = cb[c + q];
#pragma unroll
        for (int j = 0; j < 4; ++j) { if (ts - 3 + j >= 0) { const u32x4 w = *(const u32x4*)(XR + (size_t)(t - 3 + j) * D + c); const float* wj = cw + j * D + c;
            a[0] += wj[0] * bf_lo(w.x); a[1] += wj[1] * bf_hi(w.x); a[2] += wj[2] * bf_lo(w.y); a[3] += wj[3] * bf_hi(w.y);
            a[4] += wj[4] * bf_lo(w.z); a[5] += wj[5] * bf_hi(w.z); a[6] += wj[6] * bf_lo(w.w); a[7] += wj[7] * bf_hi(w.w); } }
        u32x4 o; o.x = pk2(a[0], a[1]); o.y = pk2(a[2], a[3]); o.z = pk2(a[4], a[5]); o.w = pk2(a[6], a[7]); *(u32x4*)(XC + (size_t)t * D + c) = o; }
}
constexpr int CH = 64, NCH = SEQ / CH;
__device__ __forceinline__ void p_scan1(Frame& F) {
    const bf16* LA = WSP(bf16, WS_RA + RA_LA); const bf16* UU = WSP(bf16, WS_RA + RA_U); float* CP = WSP(float, WS_CHP); float* CHh = WSP(float, WS_CHH);
    for (int i = F.vcu * NTHR + F.tid; i < BATCH * NCH * (D / 4); i += NGT) { const int c4 = (i & 255) * 4, ck = (i >> 8) & (NCH - 1), b = i >> 16;
        const size_t r0 = ((size_t)b * SEQ + (size_t)ck * CH) * D + c4; f32x4 h = {0.f, 0.f, 0.f, 0.f}, sl = {0.f, 0.f, 0.f, 0.f};
#pragma unroll 4
        for (int t = 0; t < CH; ++t) { const u32x2 lw = *(const u32x2*)(LA + r0 + (size_t)t * D), uw = *(const u32x2*)(UU + r0 + (size_t)t * D);
            const f32x4 la = {bf_lo(lw.x), bf_hi(lw.x), bf_lo(lw.y), bf_hi(lw.y)}, u = {bf_lo(uw.x), bf_hi(uw.x), bf_lo(uw.y), bf_hi(uw.y)};
#pragma unroll
            for (int j = 0; j < 4; ++j) { h[j] = __expf(la[j]) * h[j] + u[j]; sl[j] += la[j]; } }
#pragma unroll
        for (int j = 0; j < 4; ++j) { const size_t o = ((size_t)b * D + c4 + j) * NCH + ck; CP[o] = __expf(sl[j]); CHh[o] = h[j]; } }
}
__device__ __forceinline__ void p_scan2(Frame& F) {
    const float* CP = WSP(float, WS_CHP); const float* CHh = WSP(float, WS_CHH); float* CIN = WSP(float, WS_CIN);
    for (int s = F.vcu * NWAVES + F.wave; s < BATCH * D; s += NGW) { const size_t o = (size_t)s * NCH + 4 * F.lane;
        const f32x4 p4 = *(const f32x4*)(CP + o), h4 = *(const f32x4*)(CHh + o);
        float p = p4.x, h = h4.x; h = p4.y * h + h4.y; p *= p4.y; h = p4.z * h + h4.z; p *= p4.z; h = p4.w * h + h4.w; p *= p4.w;
#pragma unroll
        for (int off = 1; off < 64; off <<= 1) { const float pp = __shfl_up(p, off), hp = __shfl_up(h, off); if (F.lane >= off) { h = p * hp + h; p = pp * p; } }
        float c0 = __shfl_up(h, 1); if (F.lane == 0) c0 = 0.f;
        f32x4 ci; ci.x = c0; ci.y = p4.x * ci.x + h4.x; ci.z = p4.y * ci.y + h4.y; ci.w = p4.z * ci.z + h4.z;
        *(f32x4*)(CIN + o) = ci; }
}
__device__ __forceinline__ void p_scan3(Frame& F) {
    const bf16* LA = WSP(bf16, WS_RA + RA_LA); const bf16* UU = WSP(bf16, WS_RA + RA_U); const float* CIN = WSP(float, WS_CIN);
    const bf16* GG = WSP(bf16, WS_RA + RA_GG); bf16* YB = WSP(bf16, WS_RA + RA_YB);
    for (int i = F.vcu * NTHR + F.tid; i < BATCH * NCH * (D / 4); i += NGT) { const int c4 = (i & 255) * 4, ck = (i >> 8) & (NCH - 1), b = i >> 16;
        const size_t r0 = ((size_t)b * SEQ + (size_t)ck * CH) * D + c4; f32x4 h;
#pragma unroll
        for (int j = 0; j < 4; ++j) h[j] = CIN[((size_t)b * D + c4 + j) * NCH + ck];
#pragma unroll 4
        for (int t = 0; t < CH; ++t) { const u32x2 lw = *(const u32x2*)(LA + r0 + (size_t)t * D), uw = *(const u32x2*)(UU + r0 + (size_t)t * D);
            const f32x4 la = {bf_lo(lw.x), bf_hi(lw.x), bf_lo(lw.y), bf_hi(lw.y)}, u = {bf_lo(uw.x), bf_hi(uw.x), bf_lo(uw.y), bf_hi(uw.y)};
            const u32x2 gw = *(const u32x2*)(GG + r0 + (size_t)t * D);
#pragma unroll
            for (int j = 0; j < 4; ++j) h[j] = __expf(la[j]) * h[j] + u[j];
            u32x2 o; o.x = pk2(h.x * bf_lo(gw.x), h.y * bf_hi(gw.x)); o.y = pk2(h.z * bf_lo(gw.y), h.w * bf_hi(gw.y)); *(u32x2*)(YB + r0 + (size_t)t * D) = o; } }
}
__device__ __forceinline__ void p_ln(Frame& F, const float* V, const float* g, const float* b, float* Hf, bf16* Hb) {
    for (int r = F.vcu * NWAVES + F.wave; r < M; r += NGW) { const f32x4* xr = (const f32x4*)(V + (size_t)r * D) + F.lane; f32x4 v[4];
#pragma unroll
        for (int j = 0; j < 4; ++j) v[j] = xr[64 * j];
        ln_store(v, g, b, Hf + (size_t)r * D, Hb + (size_t)r * D, F.lane); }
}
__device__ __forceinline__ void p_route(Frame& F, const float* bias) {
    const float* LG = WSP(float, WS_LOGITS); int* TOPI = WSP(int, WS_TOPI); float* GATE = WSP(float, WS_GATE); int* HIST = WSP(int, WS_HIST);
    LAS int* hist = (LAS int*)F.lds; const int lane = F.lane;
    if (F.tid < 256) hist[F.tid] = 0;
    __syncthreads();
    const f32x4 bv = *(const f32x4*)(bias + 4 * lane);
#pragma unroll 4
    for (int j = 0; j < 16; ++j) { const int t = F.vcu * 128 + F.wave * 16 + j;
        const f32x4 z = *(const f32x4*)(LG + (size_t)t * NE + 4 * lane);
        const float s0 = sigmoidf_(z.x), s1 = sigmoidf_(z.y), s2 = sigmoidf_(z.z), s3 = sigmoidf_(z.w);
        float v0 = s0 + bv.x, v1 = s1 + bv.y, v2 = s2 + bv.z, v3 = s3 + bv.w;
        float m1, m2; { const float a = fmaxf(v0, v1), b = fminf(v0, v1), c = fmaxf(v2, v3), d = fminf(v2, v3); m1 = fmaxf(a, c); m2 = fmaxf(fminf(a, c), fmaxf(b, d)); }
#pragma unroll
        for (int off = 1; off < 8; off <<= 1) { const float o1 = __shfl_xor(m1, off), o2 = __shfl_xor(m2, off); const float n1 = fmaxf(m1, o1), n2 = fmaxf(fminf(m1, o1), fmaxf(m2, o2)); m1 = n1; m2 = n2; }
        const float gs = m1 + m2; const int g = lane >> 3; int rank = 0;
#pragma unroll
        for (int q = 0; q < 8; ++q) { const float o = __shfl(gs, 8 * q); rank += (o > gs || (o == gs && q < g)) ? 1 : 0; }
        if (rank >= 4) { v0 = -1e30f; v1 = -1e30f; v2 = -1e30f; v3 = -1e30f; }
        int myidx = 0; float mys = 0.f;
#pragma unroll
        for (int k = 0; k < TOPK; ++k) {
            float bvv = v0; int bi = 0; if (v1 > bvv) { bvv = v1; bi = 1; } if (v2 > bvv) { bvv = v2; bi = 2; } if (v3 > bvv) { bvv = v3; bi = 3; }
            int idx = 4 * lane + bi;
#pragma unroll
            for (int off = 32; off >= 1; off >>= 1) { const float ov = __shfl_xor(bvv, off); const int oi = __shfl_xor(idx, off); if (ov > bvv || (ov == bvv && oi < idx)) { bvv = ov; idx = oi; } }
            const int q = idx & 3; const float sq = q == 0 ? s0 : (q == 1 ? s1 : (q == 2 ? s2 : s3)); const float sw = __shfl(sq, idx >> 2);
            if ((idx >> 2) == lane) { if (q == 0) v0 = -3e38f; else if (q == 1) v1 = -3e38f; else if (q == 2) v2 = -3e38f; else v3 = -3e38f; }
            if (lane == k) { myidx = idx; mys = sw; }
        }
        const float tot = wave_sum(lane < TOPK ? mys : 0.f);
        if (lane < TOPK) { TOPI[t * TOPK + lane] = myidx; GATE[t * TOPK + lane] = mys / tot * 2.5f; atomicAdd((int*)&hist[myidx], 1); }
    }
    __syncthreads();
    if (F.tid < 256) HIST[F.vcu * 256 + F.tid] = hist[F.tid];
    __syncthreads();
}
__device__ __forceinline__ void p_sort(Frame& F) {
    const int* HIST = WSP(int, WS_HIST); const int* TOPI = WSP(int, WS_TOPI); int* ROWA = WSP(int, WS_ROWA); int* POS = WSP(int, WS_POS); int* BLKE = WSP(int, WS_BLKE); int* META = WSP(int, WS_META);
    LAS int* cnt = (LAS int*)F.lds; LAS int* myoff = cnt + 256; LAS int* nb = cnt + 512; LAS int* blk0 = cnt + 768; LAS int* lcnt = cnt + 1024;
    { typedef int i32x4 __attribute__((ext_vector_type(4)));
      const int q = F.tid >> 6, l = F.tid & 63; i32x4 c = {0, 0, 0, 0}, mo = {0, 0, 0, 0};
#pragma unroll 8
      for (int w = q; w < NWG; w += 8) { const i32x4 h = *(const i32x4*)(HIST + w * 256 + 4 * l); c += h; if (w < F.vcu) mo += h; }
      LAS int* redc = cnt + 1280; LAS int* redm = redc + 2048;
#pragma unroll
      for (int j = 0; j < 4; ++j) { redc[q * 256 + 4 * l + j] = c[j]; redm[q * 256 + 4 * l + j] = mo[j]; }
      __syncthreads();
      if (F.tid < 256) { const int e = F.tid; int cc = 0, mm = 0;
#pragma unroll
          for (int k = 0; k < 8; ++k) { cc += redc[k * 256 + e]; mm += redm[k * 256 + e]; }
          cnt[e] = cc; myoff[e] = mm; nb[e] = (cc + 255) >> 8; lcnt[e] = 0; } }
    __syncthreads();
    if (F.tid < 256) { int b = 0; for (int j = 0; j < F.tid; ++j) b += nb[j]; blk0[F.tid] = b; }
    __syncthreads();
    for (int al = F.tid; al < 1024; al += NTHR) { const int a = F.vcu * 1024 + al; const int e = TOPI[a]; const int pos = blk0[e] * 256 + myoff[e] + atomicAdd((int*)&lcnt[e], 1); ROWA[pos] = a; POS[a] = pos; }
    const int nrb = blk0[255] + nb[255];
    { const int e = F.vcu; const int start = blk0[e] * 256 + cnt[e], end = (blk0[e] + nb[e]) * 256;
      for (int p = start + F.tid; p < end; p += NTHR) ROWA[p] = -1;
      for (int j = F.tid; j < nb[e]; j += NTHR) BLKE[blk0[e] + j] = e; }
    for (int tl = F.tid; tl < 128; tl += NTHR) { const int t = F.vcu * 128 + tl; ROWA[nrb * 256 + t] = 8 * M + t; }
    if (F.vcu == 0) { for (int j = F.tid; j < 128; j += NTHR) BLKE[nrb + j] = 256; if (F.tid == 0) META[0] = nrb + 128; }
    __syncthreads();
}
__device__ __forceinline__ void p_combine(Frame& F, const float* Hin, const float* g, const float* b, float* Hf, bf16* Hb) {
    const bf16* YA = WSP(bf16, WS_RA); const float* GATE = WSP(float, WS_GATE); const int* POS = WSP(int, WS_POS); const int shrow0 = (*WSP(int, WS_META) - 128) * 256;
    for (int t = F.vcu * NWAVES + F.wave; t < M; t += NGW) { f32x4 v[4];
        const f32x4* hr = (const f32x4*)(Hin + (size_t)t * D) + F.lane;
#pragma unroll
        for (int j = 0; j < 4; ++j) v[j] = hr[64 * j] * ALPHA;
        f32x4 r[4];
#pragma unroll
        for (int j = 0; j < 4; ++j) r[j] = (f32x4){0.f, 0.f, 0.f, 0.f};
#pragma unroll
        for (int k = 0; k < TOPK; ++k) { const float gk = GATE[t * TOPK + k] * 0.0625f; const unsigned* yr = (const unsigned*)((const unsigned char*)YA + (size_t)POS[t * TOPK + k] * D) + F.lane;
#pragma unroll
            for (int j = 0; j < 4; ++j) { const unsigned w = yr[64 * j]; const f32x2 a = __builtin_amdgcn_cvt_pk_f32_fp8((int)w, false), c = __builtin_amdgcn_cvt_pk_f32_fp8((int)w, true);
                r[j].x += gk * a.x; r[j].y += gk * a.y; r[j].z += gk * c.x; r[j].w += gk * c.y; } }
        { const unsigned* yr = (const unsigned*)((const unsigned char*)YA + (size_t)(shrow0 + t) * D) + F.lane;
#pragma unroll
            for (int j = 0; j < 4; ++j) { const unsigned w = yr[64 * j]; const f32x2 a = __builtin_amdgcn_cvt_pk_f32_fp8((int)w, false), c = __builtin_amdgcn_cvt_pk_f32_fp8((int)w, true);
                v[j].x += r[j].x + 0.0625f * a.x; v[j].y += r[j].y + 0.0625f * a.y; v[j].z += r[j].z + 0.0625f * c.x; v[j].w += r[j].w + 0.0625f * c.y; } }
        ln_store(v, g, b, Hf + (size_t)t * D, Hb ? Hb + (size_t)t * D : nullptr, F.lane); }
}
constexpr int AT_KP = 144, AT_VP = 784, AT_KBYTES = 384 * AT_KP, AT_VOFF = AT_KBYTES;
__device__ __forceinline__ void p_attn(Frame& F) {
    const bf16* QKb = WSP(bf16, WS_RA + RA_QK); const bf16* VTb = WSP(bf16, WS_RA + RA_VT); bf16* OGb = WSP(bf16, WS_RA + RA_OG); float* LSE = WSP(float, WS_LSE);
    const int lane = F.lane, q = lane & 31, hh = lane >> 5, w = F.wave;
    LAS unsigned char* lk = F.lds; LAS unsigned char* lv = F.lds + AT_VOFF;
#pragma unroll 1
    for (int it = F.vcu; it < 3 * 128 * 8; it += NWG) {
        const int g = it >> 10, rem = it & 1023, chunk = rem >> 3, h = rem & 7;
        const int sh = 14 - 2 * g, rq0 = chunk * 256, i0 = rq0 & ((1 << sh) - 1), rk0 = rq0 - 128;
        const bf16* QK = QKb + (size_t)g * M * 1024; const bf16* VT = VTb + (size_t)g * 512 * M;
        { const char* kb = (const char*)(QK + 512 + h * 64);
#pragma unroll
          for (int j = 0; j < 7; ++j) { const int ins = w + 8 * j; if (ins < 54) { const int p = ins * 64 + lane, row = p / 9, cc = p - row * 9; const int gr = rk0 + row < 0 ? 0 : rk0 + row;
              __builtin_amdgcn_global_load_lds((const unsigned*)(kb + (size_t)gr * 2048 + (cc > 7 ? 7 : cc) * 16), (LAS unsigned*)(lk + ins * 1024), 16, 0, 0); } }
          const char* vb = (const char*)(VT + (size_t)(h * 64) * M);
#pragma unroll
          for (int j = 0; j < 7; ++j) { const int ins = w + 8 * j; if (ins < 49) { const int p = ins * 64 + lane, row = p / 49, cc = p - row * 49; int col = rk0 + (cc > 47 ? 47 : cc) * 8; col = col < 0 ? 0 : col;
              __builtin_amdgcn_global_load_lds((const unsigned*)(vb + ((size_t)row * M + col) * 2), (LAS unsigned*)(lv + ins * 1024), 16, 0, 0); } } }
        bf16x8 Qf[4];
        { const bf16* qp = QK + (size_t)(rq0 + 32 * w + q) * 1024 + h * 64 + 8 * hh;
#pragma unroll
          for (int s2 = 0; s2 < 4; ++s2) Qf[s2] = *(const bf16x8*)(qp + 16 * s2); }
        asm volatile("s_waitcnt vmcnt(0)" ::: "memory");
        __syncthreads();
        const float slope2 = exp2f(-(float)(h + 1)) * (float)(1 << (2 * g)) * 1.4426950408889634f, sc = 0.125f * 1.4426950408889634f;
        float m_run = -1e30f, l_run = 0.f; f32x16 O0, O1;
#pragma unroll
        for (int r = 0; r < 16; ++r) { O0[r] = 0.f; O1[r] = 0.f; }
#pragma unroll 1
        for (int kt = 0; kt < 5; ++kt) { const int kr0 = 32 * w + 32 * kt; if (i0 + kr0 - 128 < 0) continue;
            bf16x8 Kf[4];
            { const LAS unsigned char* kp = lk + (kr0 + q) * AT_KP + 16 * hh;
#pragma unroll
              for (int s2 = 0; s2 < 4; ++s2) Kf[s2] = *(const LAS bf16x8*)(kp + 32 * s2); }
            bf16x8 Vf[2][2];
#pragma unroll
            for (int dd = 0; dd < 2; ++dd)
#pragma unroll
                for (int s2 = 0; s2 < 2; ++s2) { const LAS unsigned char* vp = lv + (32 * dd + q) * AT_VP + (kr0 + 16 * s2 + 4 * hh) * 2;
                    const u32x2 lo = *(const LAS u32x2*)vp, hi = *(const LAS u32x2*)(vp + 16); u32x4 wv; wv.x = lo.x; wv.y = lo.y; wv.z = hi.x; wv.w = hi.y; Vf[dd][s2] = __builtin_bit_cast(bf16x8, wv); }
            f32x16 S;
#pragma unroll
            for (int r = 0; r < 16; ++r) S[r] = 0.f;
#pragma unroll
            for (int s2 = 0; s2 < 4; ++s2) S = __builtin_amdgcn_mfma_f32_32x32x16_bf16(Kf[s2], Qf[s2], S, 0, 0, 0);
            float mx = -1e30f;
#pragma unroll
            for (int r = 0; r < 16; ++r) { const int krow = (r & 3) + 8 * (r >> 2) + 4 * hh; const int dist = 128 - 32 * kt + q - krow;
                const float sv = (dist >= 0 && dist <= 128) ? S[r] * sc - slope2 * (float)dist : -1e30f; S[r] = sv; mx = fmaxf(mx, sv); }
            mx = fmaxf(mx, __shfl_xor(mx, 32));
            const float m_new = fmaxf(m_run, mx), alpha = exp2f(m_run - m_new); float rs = 0.f;
#pragma unroll
            for (int r = 0; r < 16; ++r) { const float p = exp2f(S[r] - m_new); S[r] = p; rs += p; }
            rs += __shfl_xor(rs, 32);
            l_run = l_run * alpha + rs; m_run = m_new;
#pragma unroll
            for (int r = 0; r < 16; ++r) { O0[r] *= alpha; O1[r] *= alpha; }
            bf16x8 Pf[2];
#pragma unroll
            for (int s2 = 0; s2 < 2; ++s2) { u32x4 wv; wv.x = pk2(S[8 * s2 + 0], S[8 * s2 + 1]); wv.y = pk2(S[8 * s2 + 2], S[8 * s2 + 3]); wv.z = pk2(S[8 * s2 + 4], S[8 * s2 + 5]); wv.w = pk2(S[8 * s2 + 6], S[8 * s2 + 7]); Pf[s2] = __builtin_bit_cast(bf16x8, wv); }
#pragma unroll
            for (int s2 = 0; s2 < 2; ++s2) { O0 = __builtin_amdgcn_mfma_f32_32x32x16_bf16(Vf[0][s2], Pf[s2], O0, 0, 0, 0); O1 = __builtin_amdgcn_mfma_f32_32x32x16_bf16(Vf[1][s2], Pf[s2], O1, 0, 0, 0); }
        }
        const float inv = 1.0f / l_run;
        bf16* op = OGb + ((size_t)g * M + rq0 + 32 * w + q) * 512 + h * 64 + 4 * hh;
#pragma unroll
        for (int rg = 0; rg < 4; ++rg) { u32x2 wv; wv.x = pk2(O0[4 * rg] * inv, O0[4 * rg + 1] * inv); wv.y = pk2(O0[4 * rg + 2] * inv, O0[4 * rg + 3] * inv); *(u32x2*)(op + 8 * rg) = wv;
            u32x2 w1; w1.x = pk2(O1[4 * rg] * inv, O1[4 * rg + 1] * inv); w1.y = pk2(O1[4 * rg + 2] * inv, O1[4 * rg + 3] * inv); *(u32x2*)(op + 32 + 8 * rg) = w1; }
        if (hh == 0) LSE[((size_t)g * M + rq0 + 32 * w + q) * 8 + h] = (m_run + log2f(l_run)) * 0.6931471805599453f;
        __syncthreads();
    }
}
__device__ __forceinline__ void p_merge(Frame& F) {
    const bf16* OGb = WSP(bf16, WS_RA + RA_OG); const float* LSE = WSP(float, WS_LSE); bf16* OM = WSP(bf16, WS_RA + RA_OM);
    for (int t = F.vcu * NWAVES + F.wave; t < M; t += NGW) { const int hd = F.lane >> 3; float ls[3]; size_t ro[3];
#pragma unroll
        for (int g = 0; g < 3; ++g) { const int rho = tok_to_rho(t, g); ro[g] = ((size_t)g * M + rho); ls[g] = LSE[ro[g] * 8 + hd]; }
        const float mx = fmaxf(ls[0], fmaxf(ls[1], ls[2])); float w[3], ws = 0.f;
#pragma unroll
        for (int g = 0; g < 3; ++g) { w[g] = __expf(ls[g] - mx); ws += w[g]; }
        const float inv = 1.0f / ws; float o[8];
#pragma unroll
        for (int j = 0; j < 8; ++j) o[j] = 0.f;
#pragma unroll
        for (int g = 0; g < 3; ++g) { const u32x4 x = *(const u32x4*)(OGb + ro[g] * 512 + 8 * F.lane); const float wg = w[g] * inv;
            o[0] += wg * bf_lo(x.x); o[1] += wg * bf_hi(x.x); o[2] += wg * bf_lo(x.y); o[3] += wg * bf_hi(x.y); o[4] += wg * bf_lo(x.z); o[5] += wg * bf_hi(x.z); o[6] += wg * bf_lo(x.w); o[7] += wg * bf_hi(x.w); }
        u32x4 r; r.x = pk2(o[0], o[1]); r.y = pk2(o[2], o[3]); r.z = pk2(o[4], o[5]); r.w = pk2(o[6], o[7]); *(u32x4*)(OM + (size_t)t * OW + 8 * F.lane) = r; }
}

constexpr int NPHASE = 26;

__global__ void __launch_bounds__(NTHR, 2) yoco_fwd(Args args) {
    extern __shared__ __attribute__((aligned(16))) unsigned char lds[];
    Frame F;
    F.lds = (LAS unsigned char*)lds;
    F.tid = threadIdx.x; F.lane = F.tid & 63; F.wave = __builtin_amdgcn_readfirstlane(F.tid >> 6);
    { const int bx = blockIdx.x; F.vcu = (bx % 8) * (NWG / 8) + bx / 8; }
    F.ws = args.ws;
    volatile LAS unsigned* MISC = (volatile LAS unsigned*)(F.lds + LDS_BYTES - 64);
    if (F.tid < 16) MISC[F.tid] = 0u;
    __syncthreads();
    const int lo = args.ph_lo, hi = args.ph_hi;
    XcdBarrier bar; bar.bar = (unsigned*)(F.ws + WS_CTL) + 4096; bar.x = 0; bar.st = nullptr;
    if (hi - lo > 1) bar = xcd_barrier_post((unsigned*)(F.ws + WS_CTL) + 4096, MISC + 8);
#ifndef PROBE_G2
#define PROBE_G2 0
#endif
#ifndef DUP_MASK
#define DUP_MASK 0u
#endif
#ifndef PH_MASK
#define PH_MASK 0xFFFFFFFFu
#endif
#define IN(k) (((PH_MASK >> (k)) & 1u) && lo <= (k) && (k) < hi)
#define REP(k) for (int rep = 0, nrep = 1 + (int)((args.dup >> (k)) & 1u); rep < nrep; ++rep)
#define SEAM(k) do { if (IN(k) && IN((k) + 1)) xcd_barrier(bar); } while (0)

    if (IN(0)) { p0_prologue(F, args); } SEAM(0);
    if (IN(1)) { SchedDenseP S{WSP(bf16, WS_RA + RA_XB), WSP(bf16, WS_WIN), D, D, D, M / 256, 8, F.vcu}; EpiXZ E{WSP(bf16, WS_RA + RA_XR), WSP(bf16, WS_RA + RA_GG)}; GEMM_PHASE(F.lds, S, E); } SEAM(1);
    if (IN(2)) { p_conv(F, args.in[2], args.in[3]); } SEAM(2);
    if (IN(3)) { SchedGate S{WSP(bf16, WS_RA + RA_XC), WSP(bf16, WS_WG), F.vcu}; EpiGate E{WSP(bf16, WS_RA + RA_XC), args.in[5], args.in[7], args.in[8], WSP(bf16, WS_RA + RA_LA), WSP(bf16, WS_RA + RA_U)}; GEMM_PHASE(F.lds, S, E); } SEAM(3);
    if (IN(4)) { p_scan1(F); } SEAM(4);
    if (IN(5)) { p_scan2(F); } SEAM(5);
    if (IN(6)) { p_scan3(F); } SEAM(6);
    if (IN(7)) { SchedDense S{WSP(bf16, WS_RA + RA_YB), WSP(bf16, WS_WOUT), D, D, D, M / 256, 4, F.vcu}; EpiResF32 E{args.in[0], WSP(float, WS_V), D}; GEMM_PHASE(F.lds, S, E); } SEAM(7);
    if (IN(8)) { p_ln(F, WSP(float, WS_V), args.in[21] + 0 * D, args.in[22] + 0 * D, WSP(float, WS_HA), WSP(bf16, WS_HAB)); } SEAM(8);
    if (IN(9)) { SchedDense S{WSP(bf16, WS_HAB), WSP(bf16, WS_WR), D, D, D, M / 256, 1, F.vcu}; EpiF32 E{WSP(float, WS_LOGITS), NE}; GEMM_PHASE(F.lds, S, E); } SEAM(9);
    if (IN(10)) { p_route(F, args.in[14]); } SEAM(10);
    if (IN(11)) { p_sort(F); } SEAM(11);
    if (IN(12)) { SchedG1 S{WSP(bf16, WS_HAB), WSP(bf16, WS_W13), WSP(int, WS_ROWA), WSP(int, WS_BLKE), *WSP(int, WS_META), F.vcu}; EpiSwiGLU E{WSP(bf16, WS_HID)}; GEMM_PHASE(F.lds, S, E); } SEAM(12);
    if (IN(13)) { SchedG2 S{WSP(bf16, WS_HID), WSP(bf16, WS_W2), WSP(int, WS_BLKE), *WSP(int, WS_META), F.vcu}; EpiScatter E{WSP(bf16, WS_RA), 0}; GEMM_PHASE(F.lds, S, E); if (PROBE_G2) { __syncthreads(); EpiScatter E2{(PROBE_G2 == 2 || PROBE_G2 == 4) ? WSP(bf16, WS_V) : WSP(bf16, WS_RA), PROBE_G2 == 3 ? 0 : PROBE_G2}; GEMM_PHASE(F.lds, S, E2); } } SEAM(13);
    if (IN(14)) { p_combine(F, WSP(float, WS_HA), args.in[21] + 1 * D, args.in[22] + 1 * D, WSP(float, WS_HB), WSP(bf16, WS_HBB)); convert_experts(F, args.in[15] + (size_t)NE * D * DE, args.in[16] + (size_t)NE * D * DE, args.in[17] + (size_t)NE * D * DE, args.in[18] + (size_t)D * DE, args.in[19] + (size_t)D * DE, args.in[20] + (size_t)D * DE); } SEAM(14);
    if (IN(15)) { EpiQKV E{WSP(bf16, WS_RA + RA_QK), WSP(bf16, WS_RA + RA_VT)}; for (int g = 0; g < 3; ++g) { SchedQK S{WSP(bf16, WS_HBB), WSP(bf16, WS_WQK), g, D << (2 * g), F.vcu}; GEMM_PHASE(F.lds, S, E); } for (int g = 0; g < 3; ++g) { SchedVT S{WSP(bf16, WS_HBB), WSP(bf16, WS_WV), g, D << (2 * g), F.vcu}; GEMM_PHASE(F.lds, S, E); } } SEAM(15);
    if (IN(16)) { p_attn(F); } SEAM(16);
    if (IN(17)) { p_merge(F); } SEAM(17);
    if (IN(18)) { SchedDense S{WSP(bf16, WS_RA + RA_OM), WSP(bf16, WS_WO), OW, OW, OW, M / 256, 4, F.vcu}; EpiResF32 E{WSP(float, WS_HB), WSP(float, WS_V), D}; GEMM_PHASE(F.lds, S, E); } SEAM(18);
    if (IN(19)) { p_ln(F, WSP(float, WS_V), args.in[21] + 2 * D, args.in[22] + 2 * D, WSP(float, WS_HA), WSP(bf16, WS_HAB)); } SEAM(19);
    if (IN(20)) { SchedDense S{WSP(bf16, WS_HAB), WSP(bf16, WS_WR) + (size_t)NE * D, D, D, D, M / 256, 1, F.vcu}; EpiF32 E{WSP(float, WS_LOGITS), NE}; GEMM_PHASE(F.lds, S, E); } SEAM(20);
    if (IN(21)) { p_route(F, args.in[14] + NE); } SEAM(21);
    if (IN(22)) { p_sort(F); } SEAM(22);
    if (IN(23)) { SchedG1 S{WSP(bf16, WS_HAB), WSP(bf16, WS_W13), WSP(int, WS_ROWA), WSP(int, WS_BLKE), *WSP(int, WS_META), F.vcu}; EpiSwiGLU E{WSP(bf16, WS_HID)}; GEMM_PHASE(F.lds, S, E); } SEAM(23);
    if (IN(24)) { SchedG2 S{WSP(bf16, WS_HID), WSP(bf16, WS_W2), WSP(int, WS_BLKE), *WSP(int, WS_META), F.vcu}; EpiScatter E{WSP(bf16, WS_RA), 0}; GEMM_PHASE(F.lds, S, E); if (PROBE_G2) { __syncthreads(); EpiScatter E2{(PROBE_G2 == 2 || PROBE_G2 == 4) ? WSP(bf16, WS_V) : WSP(bf16, WS_RA), PROBE_G2 == 3 ? 0 : PROBE_G2}; GEMM_PHASE(F.lds, S, E2); } } SEAM(24);
    if (IN(25)) { p_combine(F, WSP(float, WS_HA), args.in[21] + 3 * D, args.in[22] + 3 * D, args.out, nullptr); }
#undef IN
#undef SEAM
}

extern "C" void kernel_launch(void* const* d_in, const int* in_sizes, int n_in, void* d_out, int out_size, void* d_ws, size_t ws_size, hipStream_t stream) {
    static int ok = 0;
    if (ok == 0) {
        if (n_in != 23 || in_sizes[0] != M * D || out_size != M * D || ws_size < WS_END) { fprintf(stderr, "kernel_launch: unexpected shapes (n_in %d, in0 %d, out %d, ws %zu < %zu)\n", n_in, n_in > 0 ? in_sizes[0] : -1, out_size, ws_size, (size_t)WS_END); ok = -1; return; }
        if (hipFuncSetAttribute((const void*)yoco_fwd, hipFuncAttributeMaxDynamicSharedMemorySize, LDS_BYTES) != hipSuccess) { fprintf(stderr, "kernel_launch: hipFuncSetAttribute failed\n"); ok = -1; return; }
        int per_cu = 0;
        if (hipOccupancyMaxActiveBlocksPerMultiprocessor(&per_cu, (const void*)yoco_fwd, NTHR, LDS_BYTES) != hipSuccess || per_cu < 1) fprintf(stderr, "kernel_launch: occupancy query says %d\n", per_cu);
        (void)hipGetLastError();
        ok = 1;
    }
    if (ok < 0) return;
    if (hipMemsetAsync((char*)d_ws + WS_CTL, 0, CTL_ZERO_BYTES, stream) != hipSuccess) return;
    Args a{};
    for (int i = 0; i < 23; ++i) a.in[i] = (const float*)d_in[i];
    a.out = (float*)d_out; a.ws = (unsigned char*)d_ws; a.dup = 0u; a.dry = 0;
#if MK_ONE_LAUNCH
    a.ph_lo = 0; a.ph_hi = NPHASE;
    hipLaunchKernelGGL(yoco_fwd, dim3(NWG), dim3(NTHR), LDS_BYTES, stream, a);
#else
    for (int p = 0; p < NPHASE; ++p) { a.ph_lo = p; a.ph_hi = p + 1; hipLaunchKernelGGL(yoco_fwd, dim3(NWG), dim3(NTHR), LDS_BYTES, stream, a); }
#endif
}
```

```cpp
#include <hip/hip_runtime.h>
#include <cstdio>
#include <cstdint>

#ifndef MK_ONE_LAUNCH
#define MK_ONE_LAUNCH 1
#endif

constexpr int D = 1024, BATCH = 2, SEQ = 16384, M = BATCH * SEQ;
constexpr int NE = 256, TOPK = 8, DE = 256;
constexpr int HEADS = 8, HD = 64, QW = 1536, OW = 512;
constexpr float LN_EPS = 1e-5f, ALPHA = 1.41421356237f;
constexpr int RBMAX = 1024 + 256 + 128;
constexpr int NWG = 256, NTHR = 512, NWAVES = 8;
constexpr int NGW = NWG * NWAVES, NGT = NWG * NTHR;

constexpr size_t MiB = 1u << 20;
constexpr size_t WS_CTL = 0, CTL_ZERO_BYTES = 1 * MiB;
constexpr size_t WS_HIST = 1 * MiB, WS_BLKE = 1 * MiB + 512 * 1024, WS_META = 1 * MiB + 768 * 1024;
constexpr size_t WS_ROWA = 2 * MiB, WS_TOPI = 4 * MiB, WS_GATE = 5 * MiB, WS_CHP = 6 * MiB, WS_CHH = 8 * MiB, WS_CIN = 10 * MiB, WS_LSE = 12 * MiB;
constexpr size_t WS_WIN = 16 * MiB, WS_WG = 20 * MiB, WS_WOUT = 21 * MiB, WS_WQK = 23 * MiB, WS_WV = 29 * MiB, WS_WO = 32 * MiB, WS_WR = 33 * MiB;
constexpr size_t WS_LOGITS = 34 * MiB;
constexpr size_t WS_W13 = 66 * MiB, WS_W2 = 323 * MiB;
constexpr size_t WS_V = 452 * MiB, WS_HA = 580 * MiB, WS_HAB = 708 * MiB, WS_HB = 772 * MiB, WS_HBB = 900 * MiB, WS_HID = 964 * MiB;
constexpr size_t WS_RA = 1140 * MiB;
constexpr size_t RA_XB = 0, RA_XR = 64 * MiB, RA_GG = 128 * MiB, RA_XC = 192 * MiB, RA_LA = 256 * MiB, RA_U = 384 * MiB, RA_YB = 512 * MiB;
constexpr size_t RA_QK = 0, RA_VT = 192 * MiB, RA_OG = 288 * MiB, RA_OM = 384 * MiB;
constexpr size_t WS_POS = 15 * MiB;
constexpr size_t WS_HQ = 1844 * MiB;
constexpr size_t WS_END = 1876 * MiB;

constexpr int LDS_BYTES = 147456;

#define GAS __attribute__((address_space(1)))
#define LAS __attribute__((address_space(3)))
typedef unsigned short bf16;
typedef unsigned u32x4 __attribute__((ext_vector_type(4)));
typedef unsigned u32x2 __attribute__((ext_vector_type(2)));
typedef float f32x4 __attribute__((ext_vector_type(4)));
typedef float f32x2 __attribute__((ext_vector_type(2)));
typedef float f32x16 __attribute__((ext_vector_type(16)));
typedef short bf16x8 __attribute__((ext_vector_type(8)));
typedef int i32x8 __attribute__((ext_vector_type(8)));
typedef GAS unsigned gu32;
#define RLX_AGENT __ATOMIC_RELAXED, __HIP_MEMORY_SCOPE_AGENT
#define LDS_WAIT() asm volatile("s_waitcnt lgkmcnt(0)" ::: "memory")
#define VM_WAIT() asm volatile("s_waitcnt vmcnt(0)" ::: "memory")

__device__ __forceinline__ unsigned pk2(float lo, float hi) { unsigned r; asm("v_cvt_pk_bf16_f32 %0, %1, %2" : "=v"(r) : "v"(lo), "v"(hi)); return r; }
__device__ __forceinline__ float bf_lo(unsigned w) { return __uint_as_float(w << 16); }
__device__ __forceinline__ float bf_hi(unsigned w) { return __uint_as_float(w & 0xffff0000u); }
__device__ __forceinline__ float wave_sum(float v) {
#pragma unroll
    for (int o = 1; o < 64; o <<= 1) v += __shfl_xor(v, o);
    return v;
}
__device__ __forceinline__ float gelu_tanh(float x) {
    const float u = 0.7978845608028654f * (x + 0.044715f * x * x * x);
    const float e = __expf(2.0f * u);
    const float t = 1.0f - 2.0f / (e + 1.0f);
    return 0.5f * x * (1.0f + t);
}
__device__ __forceinline__ float sigmoidf_(float x) { return 1.0f / (1.0f + __expf(-x)); }

#define XB_TMO      128
#define XB_XCNT(j)  (256  + 64 * (j))
#define XB_XSUB(j)  (1280 + 64 * (j))
#define XB_XGEN(j)  (2304 + 64 * (j))
#define XB_TOP      3328
#define XB_TOPGEN   3392
#define XCD_BAR_WORDS 3456
#define XB_SPIN_CAP (1u << 18)
__device__ __forceinline__ unsigned xb_ld(unsigned* p)              { return __hip_atomic_load(p, __ATOMIC_RELAXED, __HIP_MEMORY_SCOPE_AGENT); }
__device__ __forceinline__ unsigned xb_add(unsigned* p, unsigned v) { return __hip_atomic_fetch_add(p, v, __ATOMIC_RELAXED, __HIP_MEMORY_SCOPE_AGENT); }
__device__ __forceinline__ unsigned xb_xcc_id() { return (unsigned)__builtin_amdgcn_s_getreg((3 << 11) | 20) & 0xFu; }
#define XB_SPIN(cond, bar) do { unsigned _sp = 0; while (cond) { __builtin_amdgcn_s_sleep(1); \
    if ((++_sp & 255u) == 0u) { if (xb_ld(&(bar)[XB_TMO])) break; if (_sp > XB_SPIN_CAP) { atomicAdd(&(bar)[XB_TMO], 1u); break; } } } } while (0)
struct XcdBarrier { unsigned* bar; unsigned x; volatile LAS unsigned* st; };
__device__ __forceinline__ XcdBarrier xcd_barrier_post(unsigned* bar, volatile LAS unsigned* st) {
    XcdBarrier b; b.bar = bar; b.x = xb_xcc_id(); b.st = st;
    if (threadIdx.x == 0) (void)xb_add(&bar[XB_XCNT(b.x)], 1u);
    return b;
}
__device__ __forceinline__ void xcd_barrier_complete(unsigned* bar, unsigned x, unsigned& nloc, unsigned& nx) {
    const unsigned G = gridDim.x * gridDim.y * gridDim.z;
    unsigned sum, cnt, mine, sp = 0u;
    for (;;) {
        sum = 0u; cnt = 0u; mine = 0u;
#pragma unroll
        for (unsigned j = 0; j < 16; ++j) { const unsigned c = xb_ld(&bar[XB_XCNT(j)]); sum += c; cnt += (c > 0u) ? 1u : 0u; mine = (j == x) ? c : mine; }
        if (sum == G) break;
        __builtin_amdgcn_s_sleep(1);
        if ((++sp & 255u) == 0u) { if (xb_ld(&bar[XB_TMO])) break; if (sp > XB_SPIN_CAP) { atomicAdd(&bar[XB_TMO], 1u); break; } }
    }
    nloc = mine > 0u ? mine : 1u; nx = cnt > 0u ? cnt : 1u;
}
__device__ __forceinline__ void xcd_barrier(const XcdBarrier& b) {
    asm volatile("s_waitcnt vmcnt(0)" ::: "memory");
    __syncthreads();
    if (threadIdx.x == 0) {
        unsigned* bar = b.bar;
        __builtin_amdgcn_s_waitcnt(0);
        unsigned nloc = b.st[0], nx = b.st[1];
        if (nloc == 0u) { xcd_barrier_complete(bar, b.x, nloc, nx); b.st[0] = nloc; b.st[1] = nx; }
        const unsigned old = xb_add(&bar[XB_XSUB(b.x)], 1u);
        const unsigned gen = old / nloc;
        if (old + 1u == (gen + 1u) * nloc) {
            __builtin_amdgcn_fence(__ATOMIC_RELEASE, "agent");
            asm volatile("s_waitcnt vmcnt(0)" ::: "memory");
            const unsigned og = xb_add(&bar[XB_TOP], 1u);
            const unsigned tg = og / nx;
            if (og + 1u == (tg + 1u) * nx) xb_add(&bar[XB_TOPGEN], 1u);
            else XB_SPIN(xb_ld(&bar[XB_TOPGEN]) == tg, bar);
            __builtin_amdgcn_fence(__ATOMIC_ACQUIRE, "agent");
            xb_add(&bar[XB_XGEN(b.x)], 1u);
            asm volatile("s_waitcnt vmcnt(0)" ::: "memory");
        } else {
            XB_SPIN(xb_ld(&bar[XB_XGEN(b.x)]) == gen, bar);
            __builtin_amdgcn_fence(__ATOMIC_ACQUIRE, "agent");
            asm volatile("s_waitcnt vmcnt(0)" ::: "memory");
        }
    }
    __syncthreads();
}

struct Args { const float* in[23]; float* out; unsigned char* ws; int ph_lo, ph_hi; unsigned dup; int dry; };
static_assert(sizeof(Args) == 23 * 8 + 8 + 8 + 16, "Args has no padding");
struct Frame {
    LAS unsigned char* lds;
    int tid, lane, wave, vcu;
    unsigned char* ws;
};
#define WSP(T, off) ((T*)(F.ws + (off)))

template <class S, class E>
__device__ __forceinline__ void gemm_simple(LAS unsigned char* lds, const S& sch, const E& epi) {
    const int tid = threadIdx.x, wid = tid >> 6, lane = tid & 63, wr = wid >> 2, wc = wid & 3, fr = lane & 15, fq = lane >> 4;
    constexpr int PITCH = 144;
    LAS unsigned char* As = lds; LAS unsigned char* Bs = lds + 256 * PITCH;
    typename S::U u;
    for (int i = 0; sch.next(i, u); ++i) {
        f32x4 acc[2][2][4][2];
#pragma unroll
        for (int a = 0; a < 2; ++a)
#pragma unroll
            for (int b = 0; b < 2; ++b)
#pragma unroll
                for (int m = 0; m < 4; ++m)
#pragma unroll
                    for (int n = 0; n < 2; ++n) acc[a][b][m][n] = (f32x4){0.f, 0.f, 0.f, 0.f};
        const int nt = sch.K(u) / 64;
        const char* pa[4]; const char* pb[4];
#pragma unroll
        for (int j = 0; j < 4; ++j) { const int row = (tid >> 3) + 64 * j; const int rb = S::PERM ? ((row & ~31) + 8 * ((row & 15) >> 2) + 4 * ((row >> 4) & 1) + (row & 3)) : row; pa[j] = sch.rowA(u, row) + (tid & 7) * 16; pb[j] = sch.rowB(u, rb) + (tid & 7) * 16; }
        for (int kt = 0; kt < nt; ++kt) {
            u32x4 va[4], vb[4];
#pragma unroll
            for (int j = 0; j < 4; ++j) { va[j] = *(const u32x4*)(pa[j] + kt * 128); vb[j] = *(const u32x4*)(pb[j] + kt * 128); }
            __syncthreads();
#pragma unroll
            for (int j = 0; j < 4; ++j) { const int row = (tid >> 3) + 64 * j;
                *(LAS u32x4*)(As + row * PITCH + (tid & 7) * 16) = va[j]; *(LAS u32x4*)(Bs + row * PITCH + (tid & 7) * 16) = vb[j]; }
            __syncthreads();
#pragma unroll
            for (int kk = 0; kk < 2; ++kk) {
                bf16x8 Bf[2][2];
#pragma unroll
                for (int b = 0; b < 2; ++b)
#pragma unroll
                    for (int n = 0; n < 2; ++n) Bf[b][n] = *(const LAS bf16x8*)(Bs + (b * 128 + wc * 32 + n * 16 + fr) * PITCH + kk * 64 + fq * 16);
#pragma unroll
                for (int a = 0; a < 2; ++a) {
                    bf16x8 Af[4];
#pragma unroll
                    for (int m = 0; m < 4; ++m) Af[m] = *(const LAS bf16x8*)(As + (a * 128 + wr * 64 + m * 16 + fr) * PITCH + kk * 64 + fq * 16);
#pragma unroll
                    for (int b = 0; b < 2; ++b)
#pragma unroll
                        for (int m = 0; m < 4; ++m)
#pragma unroll
                            for (int n = 0; n < 2; ++n) acc[a][b][m][n] = __builtin_amdgcn_mfma_f32_16x16x32_bf16(Bf[b][n], Af[m], acc[a][b][m][n], 0, 0, 0);
                }
            }
        }
        epi(acc, u, wr, wc, fr, fq);
    }
    __syncthreads();
}

namespace pg8 {
constexpr int HTB = 128 * 64 * 2;
__device__ __forceinline__ int lds_byte(int r, int c) { const int st = (r >> 4) * 2 + (c >> 5), rr = r & 15, cc = c & 31, ob = rr * 64 + cc * 2; return st * 1024 + (ob ^ (((ob >> 9) & 1) << 5)); }
__device__ __forceinline__ int perm32(int rho) { const int n = rho >> 4, i = rho & 15; return 8 * (i >> 2) + 4 * n + (i & 3); }
__device__ __forceinline__ int prow(int r) { return (r & ~31) + perm32(r & 31); }
__device__ __forceinline__ void stage_rc(int b, int& R, int& C) { const int st = b / 1024, sb = b % 1024, swz = sb ^ (((sb >> 9) & 1) << 5); R = (st >> 1) * 16 + swz / 64; C = (st & 1) * 32 + (swz % 64) / 2; }
}
template <class S, class E>
__device__ __forceinline__ void gemm_fast(LAS unsigned char* lds, const S& sch, const E& epi) {
    using namespace pg8;
    const int tid = threadIdx.x, wid = __builtin_amdgcn_readfirstlane(tid >> 6), lane = tid & 63, wr = wid >> 2, wc = wid & 3, fr = lane & 15, fq = lane >> 4;
    const int nt = sch.Kk / 64;
    int R0, C0; stage_rc(tid * 16, R0, C0);
    unsigned voffA[2], voffB[2]; unsigned cofA[4], nofA[4], cofB[4], nofB[4];
    size_t hstepA = 0, hstepB = 0;
    if constexpr (!S::GA) { voffA[0] = (unsigned)(R0 * sch.lda + C0) * 2u; voffA[1] = (unsigned)((R0 + 64) * sch.lda + C0) * 2u; hstepA = (size_t)128 * sch.lda * 2; }
    const int RB0 = S::PERM ? prow(R0) : R0;
    if constexpr (!S::GB) { voffB[0] = (unsigned)(RB0 * sch.ldb + C0) * 2u; voffB[1] = (unsigned)((RB0 + 64) * sch.ldb + C0) * 2u; hstepB = (size_t)128 * sch.ldb * 2; }
    const size_t kstep = 128;
    const unsigned ldsw = (unsigned)wid * 1024u;
    const int aoff = lds_byte(wr * 64 + fr, fq * 8), boff = lds_byte(wc * 32 + fr, fq * 8);
#define G_SA(b, h) (((b) * 2 + (h)) * HTB)
#define G_SB(b, h) ((4 + (b) * 2 + (h)) * HTB)
#define G_GLDS(src, dst) __builtin_amdgcn_global_load_lds((const unsigned*)(src), (LAS unsigned*)(dst), 16, 0, 0)
#define G_STAGE_A(bufoff, gp, h, nx) do { if constexpr (S::GA) { _Pragma("unroll") for (int _i = 0; _i < 2; ++_i) { const unsigned _o = (nx) ? nofA[2 * (h) + _i] : cofA[2 * (h) + _i]; G_GLDS((gp) + _o, lds + (bufoff) + ldsw + _i * 8192); } } \
        else { _Pragma("unroll") for (int _i = 0; _i < 2; ++_i) G_GLDS((gp) + (size_t)(h) * hstepA + voffA[_i], lds + (bufoff) + ldsw + _i * 8192); } } while (0)
#define G_STAGE_B(bufoff, gp, h, nx) do { if constexpr (S::GB) { _Pragma("unroll") for (int _i = 0; _i < 2; ++_i) { const unsigned _o = (nx) ? nofB[2 * (h) + _i] : cofB[2 * (h) + _i]; G_GLDS((gp) + _o, lds + (bufoff) + ldsw + _i * 8192); } } \
        else { _Pragma("unroll") for (int _i = 0; _i < 2; ++_i) G_GLDS((gp) + (size_t)(h) * hstepB + voffB[_i], lds + (bufoff) + ldsw + _i * 8192); } } while (0)
#define G_LDA(dst, b, h) do { _Pragma("unroll") for (int m = 0; m < 4; ++m) _Pragma("unroll") for (int k = 0; k < 2; ++k) dst[m][k] = *(const LAS bf16x8*)(lds + G_SA(b, h) + aoff + m * 2048 + k * 1024); } while (0)
#define G_LDB(dst, b, h) do { _Pragma("unroll") for (int n = 0; n < 2; ++n) _Pragma("unroll") for (int k = 0; k < 2; ++k) dst[n][k] = *(const LAS bf16x8*)(lds + G_SB(b, h) + boff + n * 2048 + k * 1024); } while (0)
#define G_MMA(ai, bj, At, Bt) do { __builtin_amdgcn_s_setprio(1); _Pragma("unroll") for (int m = 0; m < 4; ++m) _Pragma("unroll") for (int n = 0; n < 2; ++n) _Pragma("unroll") for (int k = 0; k < 2; ++k) \
        acc[ai][bj][m][n] = __builtin_amdgcn_mfma_f32_16x16x32_bf16(Bt[n][k], At[m][k], acc[ai][bj][m][n], 0, 0, 0); __builtin_amdgcn_s_setprio(0); } while (0)
#define G_WAIT_V(n) asm volatile("s_waitcnt vmcnt(" #n ")" ::: "memory")
#define G_WAIT_L(n) asm volatile("s_waitcnt lgkmcnt(" #n ")" ::: "memory")
#define G_BAR __builtin_amdgcn_s_barrier()
#define G_SCHED __builtin_amdgcn_sched_barrier(0)
    typename S::U cur, nxt; int ui = 0;
    if (!sch.next(0, cur)) return;
    f32x4 acc[2][2][4][2];
#pragma unroll
    for (int a = 0; a < 2; ++a)
#pragma unroll
        for (int b = 0; b < 2; ++b)
#pragma unroll
            for (int m = 0; m < 4; ++m)
#pragma unroll
                for (int n = 0; n < 2; ++n) acc[a][b][m][n] = (f32x4){0.f, 0.f, 0.f, 0.f};
    bf16x8 At[4][2], B0[2][2], B1[2][2];
    const char* cA = sch.baseA(cur); const char* cB = sch.baseB(cur);
    if constexpr (S::GA) {
#pragma unroll
        for (int j = 0; j < 4; ++j) { cofA[j] = sch.goffA(cur, (j >> 1) * 128 + R0 + (j & 1) * 64, C0); nofA[j] = cofA[j]; } }
    if constexpr (S::GB) {
#pragma unroll
        for (int j = 0; j < 4; ++j) { cofB[j] = sch.goffB(cur, (j >> 1) * 128 + RB0 + (j & 1) * 64, C0); nofB[j] = cofB[j]; } }
    G_STAGE_B(G_SB(0, 0), cB, 0, false); G_STAGE_B(G_SB(0, 1), cB, 1, false); G_STAGE_A(G_SA(0, 0), cA, 0, false); G_STAGE_A(G_SA(0, 1), cA, 1, false);
    if (wr == 1) G_BAR;
    G_WAIT_V(2); G_BAR;
    G_STAGE_B(G_SB(1, 0), cB + kstep, 0, false); G_STAGE_A(G_SA(1, 0), cA + kstep, 0, false); G_STAGE_B(G_SB(1, 1), cB + kstep, 1, false);
    G_WAIT_V(6); G_BAR;
    for (;;) {
        const bool has_next = sch.next(ui + 1, nxt);
        const char* nA = has_next ? sch.baseA(nxt) : cA; const char* nB = has_next ? sch.baseB(nxt) : cB;
        if constexpr (S::GA) { if (has_next) {
#pragma unroll
            for (int j = 0; j < 4; ++j) nofA[j] = sch.goffA(nxt, (j >> 1) * 128 + R0 + (j & 1) * 64, C0); } }
        if constexpr (S::GB) { if (has_next) {
#pragma unroll
            for (int j = 0; j < 4; ++j) nofB[j] = sch.goffB(nxt, (j >> 1) * 128 + RB0 + (j & 1) * 64, C0); } }
#pragma unroll 1
        for (int t = 0; t < nt; t += 2) {
            const bool last = (t == nt - 2);
            const char* a1 = cA + (size_t)(t + 1) * kstep;
            const char* a2 = last ? nA : cA + (size_t)(t + 2) * kstep; const char* b2 = last ? nB : cB + (size_t)(t + 2) * kstep;
            const char* a3 = a2 + kstep; const char* b3 = b2 + kstep;
            asm volatile("" : "+s"(a1), "+s"(a2), "+s"(a3), "+s"(b2), "+s"(b3));
            const bool post = (t == 0 && ui > 0);
#define G_WAIT_POST() do { if (post) { if constexpr (E::NVM == 8) G_WAIT_V(16); else if constexpr (E::NVM == 16) G_WAIT_V(24); else if constexpr (E::NVM == 32) G_WAIT_V(40); else G_WAIT_V(8); } else G_WAIT_V(8); } while (0)
            G_LDB(B0, 0, 0); G_LDB(B1, 0, 1); G_SCHED; G_LDA(At, 0, 0); if (!post) G_STAGE_A(G_SA(1, 1), a1, 1, false);
            G_WAIT_POST(); G_WAIT_L(0); G_BAR; G_MMA(0, 0, At, B0); G_MMA(0, 1, At, B1); G_BAR; G_SCHED;
            G_LDA(At, 0, 1); G_STAGE_B(G_SB(0, 0), b2, 0, last); G_STAGE_B(G_SB(0, 1), b2, 1, last); G_STAGE_A(G_SA(0, 0), a2, 0, last);
            G_WAIT_POST(); G_WAIT_L(0); G_BAR; G_MMA(1, 0, At, B0); G_MMA(1, 1, At, B1); G_BAR; G_SCHED;
            G_LDB(B0, 1, 0); G_LDB(B1, 1, 1); G_SCHED; G_LDA(At, 1, 0); G_STAGE_A(G_SA(0, 1), a2, 1, last);
            G_WAIT_POST(); G_WAIT_L(0); G_BAR; G_MMA(0, 0, At, B0); G_MMA(0, 1, At, B1); G_BAR; G_SCHED;
            G_LDA(At, 1, 1); G_STAGE_B(G_SB(1, 0), b3, 0, last); G_STAGE_B(G_SB(1, 1), b3, 1, last); G_STAGE_A(G_SA(1, 0), a3, 0, last);
            G_WAIT_V(8); G_WAIT_L(0); G_BAR; G_MMA(1, 0, At, B0); G_MMA(1, 1, At, B1); G_BAR; G_SCHED;
#undef G_WAIT_POST
        }
        if (wr == 0) G_BAR;
        if (has_next) { const char* n1 = nA + kstep; asm volatile("" : "+s"(n1)); G_STAGE_A(G_SA(1, 1), n1, 1, true); }
        epi(acc, cur, wr, wc, fr, fq);
        if (!has_next) break;
#pragma unroll
        for (int a = 0; a < 2; ++a)
#pragma unroll
            for (int b = 0; b < 2; ++b)
#pragma unroll
                for (int m = 0; m < 4; ++m)
#pragma unroll
                    for (int n = 0; n < 2; ++n) acc[a][b][m][n] = (f32x4){0.f, 0.f, 0.f, 0.f};
        cur = nxt; cA = nA; cB = nB; ++ui;
        if constexpr (S::GA) {
#pragma unroll
            for (int j = 0; j < 4; ++j) cofA[j] = nofA[j]; }
        if constexpr (S::GB) {
#pragma unroll
            for (int j = 0; j < 4; ++j) cofB[j] = nofB[j]; }
        if (wr == 1) G_BAR;
    }
    G_WAIT_V(0);
    G_BAR;
#undef G_SA
#undef G_SB
#undef G_GLDS
#undef G_STAGE_A
#undef G_STAGE_B
#undef G_LDA
#undef G_LDB
#undef G_MMA
#undef G_WAIT_V
#undef G_WAIT_L
#undef G_BAR
#undef G_SCHED
}
template <class S, class E>
__device__ __forceinline__ void gemm_fast8(LAS unsigned char* lds, const S& sch, const E& epi) {
    using namespace pg8;
    const int tid = threadIdx.x, wid = __builtin_amdgcn_readfirstlane(tid >> 6), lane = tid & 63, wr = wid >> 2, wc = wid & 3, fr = lane & 15, fq = lane >> 4;
    const int nt = sch.Kk / 128;
    int R0, C0; stage_rc(tid * 16, R0, C0);
    unsigned voffA[2], voffB[2]; unsigned cofA[4], nofA[4], cofB[4], nofB[4];
    size_t hstepA = 0, hstepB = 0;
    if constexpr (!S::GA) { voffA[0] = (unsigned)(R0 * sch.lda + C0 * 2); voffA[1] = (unsigned)((R0 + 64) * sch.lda + C0 * 2); hstepA = (size_t)128 * sch.lda; }
    const int RB0 = S::PERM ? prow(R0) : R0;
    if constexpr (!S::GB) { voffB[0] = (unsigned)(RB0 * sch.ldb + C0 * 2); voffB[1] = (unsigned)((RB0 + 64) * sch.ldb + C0 * 2); hstepB = (size_t)128 * sch.ldb; }
    const size_t kstep = 128;
    const unsigned ldsw = (unsigned)wid * 1024u;
    const int aoff = lds_byte(wr * 64 + fr, fq * 16), aoff1 = lds_byte(wr * 64 + fr, fq * 16 + 8), boff = lds_byte(wc * 32 + fr, fq * 16), boff1 = lds_byte(wc * 32 + fr, fq * 16 + 8);
#define G_SA(b, h) (((b) * 2 + (h)) * HTB)
#define G_SB(b, h) ((4 + (b) * 2 + (h)) * HTB)
#define G_GLDS(src, dst) __builtin_amdgcn_global_load_lds((const unsigned*)(src), (LAS unsigned*)(dst), 16, 0, 0)
#define G_STAGE_A(bufoff, gp, h, nx) do { if constexpr (S::GA) { _Pragma("unroll") for (int _i = 0; _i < 2; ++_i) { const unsigned _o = (nx) ? nofA[2 * (h) + _i] : cofA[2 * (h) + _i]; G_GLDS((gp) + _o, lds + (bufoff) + ldsw + _i * 8192); } } \
        else { _Pragma("unroll") for (int _i = 0; _i < 2; ++_i) G_GLDS((gp) + (size_t)(h) * hstepA + voffA[_i], lds + (bufoff) + ldsw + _i * 8192); } } while (0)
#define G_STAGE_B(bufoff, gp, h, nx) do { if constexpr (S::GB) { _Pragma("unroll") for (int _i = 0; _i < 2; ++_i) { const unsigned _o = (nx) ? nofB[2 * (h) + _i] : cofB[2 * (h) + _i]; G_GLDS((gp) + _o, lds + (bufoff) + ldsw + _i * 8192); } } \
        else { _Pragma("unroll") for (int _i = 0; _i < 2; ++_i) G_GLDS((gp) + (size_t)(h) * hstepB + voffB[_i], lds + (bufoff) + ldsw + _i * 8192); } } while (0)
#define G_LDA(dst, b, h) do { _Pragma("unroll") for (int m = 0; m < 4; ++m) { const u32x4 _lo = *(const LAS u32x4*)(lds + G_SA(b, h) + aoff + m * 2048), _hi = *(const LAS u32x4*)(lds + G_SA(b, h) + aoff1 + m * 2048); dst[m] = (i32x8){(int)_lo.x, (int)_lo.y, (int)_lo.z, (int)_lo.w, (int)_hi.x, (int)_hi.y, (int)_hi.z, (int)_hi.w}; } } while (0)
#define G_LDB(dst, b, h) do { _Pragma("unroll") for (int n = 0; n < 2; ++n) { const u32x4 _lo = *(const LAS u32x4*)(lds + G_SB(b, h) + boff + n * 2048), _hi = *(const LAS u32x4*)(lds + G_SB(b, h) + boff1 + n * 2048); dst[n] = (i32x8){(int)_lo.x, (int)_lo.y, (int)_lo.z, (int)_lo.w, (int)_hi.x, (int)_hi.y, (int)_hi.z, (int)_hi.w}; } } while (0)
#define G_MMA(ai, bj, At, Bt) do { __builtin_amdgcn_s_setprio(1); _Pragma("unroll") for (int m = 0; m < 4; ++m) _Pragma("unroll") for (int n = 0; n < 2; ++n) \
        acc[ai][bj][m][n] = __builtin_amdgcn_mfma_scale_f32_16x16x128_f8f6f4(Bt[n], At[m], acc[ai][bj][m][n], 0, 0, 0, 0, 0, 0); __builtin_amdgcn_s_setprio(0); } while (0)
#define G_WAIT_V(n) asm volatile("s_waitcnt vmcnt(" #n ")" ::: "memory")
#define G_WAIT_L(n) asm volatile("s_waitcnt lgkmcnt(" #n ")" ::: "memory")
#define G_BAR __builtin_amdgcn_s_barrier()
#define G_SCHED __builtin_amdgcn_sched_barrier(0)
    typename S::U cur, nxt; int ui = 0;
    if (!sch.next(0, cur)) return;
    f32x4 acc[2][2][4][2];
#pragma unroll
    for (int a = 0; a < 2; ++a)
#pragma unroll
        for (int b = 0; b < 2; ++b)
#pragma unroll
            for (int m = 0; m < 4; ++m)
#pragma unroll
                for (int n = 0; n < 2; ++n) acc[a][b][m][n] = (f32x4){0.f, 0.f, 0.f, 0.f};
    i32x8 At[4], B0[2], B1[2];
    const char* cA = sch.baseA(cur); const char* cB = sch.baseB(cur);
    if constexpr (S::GA) {
#pragma unroll
        for (int j = 0; j < 4; ++j) { cofA[j] = sch.goffA(cur, (j >> 1) * 128 + R0 + (j & 1) * 64, C0); nofA[j] = cofA[j]; } }
    if constexpr (S::GB) {
#pragma unroll
        for (int j = 0; j < 4; ++j) { cofB[j] = sch.goffB(cur, (j >> 1) * 128 + RB0 + (j & 1) * 64, C0); nofB[j] = cofB[j]; } }
    G_STAGE_B(G_SB(0, 0), cB, 0, false); G_STAGE_B(G_SB(0, 1), cB, 1, false); G_STAGE_A(G_SA(0, 0), cA, 0, false); G_STAGE_A(G_SA(0, 1), cA, 1, false);
    if (wr == 1) G_BAR;
    G_WAIT_V(2); G_BAR;
    G_STAGE_B(G_SB(1, 0), cB + kstep, 0, false); G_STAGE_A(G_SA(1, 0), cA + kstep, 0, false); G_STAGE_B(G_SB(1, 1), cB + kstep, 1, false);
    G_WAIT_V(6); G_BAR;
    for (;;) {
        const bool has_next = sch.next(ui + 1, nxt);
        const char* nA = has_next ? sch.baseA(nxt) : cA; const char* nB = has_next ? sch.baseB(nxt) : cB;
        if constexpr (S::GA) { if (has_next) {
#pragma unroll
            for (int j = 0; j < 4; ++j) nofA[j] = sch.goffA(nxt, (j >> 1) * 128 + R0 + (j & 1) * 64, C0); } }
        if constexpr (S::GB) { if (has_next) {
#pragma unroll
            for (int j = 0; j < 4; ++j) nofB[j] = sch.goffB(nxt, (j >> 1) * 128 + RB0 + (j & 1) * 64, C0); } }
#pragma unroll 1
        for (int t = 0; t < nt; t += 2) {
            const bool last = (t == nt - 2);
            const char* a1 = cA + (size_t)(t + 1) * kstep;
            const char* a2 = last ? nA : cA + (size_t)(t + 2) * kstep; const char* b2 = last ? nB : cB + (size_t)(t + 2) * kstep;
            const char* a3 = a2 + kstep; const char* b3 = b2 + kstep;
            asm volatile("" : "+s"(a1), "+s"(a2), "+s"(a3), "+s"(b2), "+s"(b3));
            const bool post = (t == 0 && ui > 0);
#define G_WAIT_POST() do { if (post) { if constexpr (E::NVM == 8) G_WAIT_V(16); else if constexpr (E::NVM == 16) G_WAIT_V(24); else if constexpr (E::NVM == 32) G_WAIT_V(40); else G_WAIT_V(8); } else G_WAIT_V(8); } while (0)
            G_LDB(B0, 0, 0); G_LDB(B1, 0, 1); G_SCHED; G_LDA(At, 0, 0); if (!post) G_STAGE_A(G_SA(1, 1), a1, 1, false);
            G_WAIT_POST(); G_WAIT_L(0); G_BAR; G_MMA(0, 0, At, B0); G_MMA(0, 1, At, B1); G_BAR; G_SCHED;
            G_LDA(At, 0, 1); G_STAGE_B(G_SB(0, 0), b2, 0, last); G_STAGE_B(G_SB(0, 1), b2, 1, last); G_STAGE_A(G_SA(0, 0), a2, 0, last);
            G_WAIT_POST(); G_WAIT_L(0); G_BAR; G_MMA(1, 0, At, B0); G_MMA(1, 1, At, B1); G_BAR; G_SCHED;
            G_LDB(B0, 1, 0); G_LDB(B1, 1, 1); G_SCHED; G_LDA(At, 1, 0); G_STAGE_A(G_SA(0, 1), a2, 1, last);
            G_WAIT_POST(); G_WAIT_L(0); G_BAR; G_MMA(0, 0, At, B0); G_MMA(0, 1, At, B1); G_BAR; G_SCHED;
            G_LDA(At, 1, 1); G_STAGE_B(G_SB(1, 0), b3, 0, last); G_STAGE_B(G_SB(1, 1), b3, 1, last); G_STAGE_A(G_SA(1, 0), a3, 0, last);
            G_WAIT_V(8); G_WAIT_L(0); G_BAR; G_MMA(1, 0, At, B0); G_MMA(1, 1, At, B1); G_BAR; G_SCHED;
#undef G_WAIT_POST
        }
        if (wr == 0) G_BAR;
        if (has_next) { const char* n1 = nA + kstep; asm volatile("" : "+s"(n1)); G_STAGE_A(G_SA(1, 1), n1, 1, true); }
        epi(acc, cur, wr, wc, fr, fq);
        if (!has_next) break;
#pragma unroll
        for (int a = 0; a < 2; ++a)
#pragma unroll
            for (int b = 0; b < 2; ++b)
#pragma unroll
                for (int m = 0; m < 4; ++m)
#pragma unroll
                    for (int n = 0; n < 2; ++n) acc[a][b][m][n] = (f32x4){0.f, 0.f, 0.f, 0.f};
        cur = nxt; cA = nA; cB = nB; ++ui;
        if constexpr (S::GA) {
#pragma unroll
            for (int j = 0; j < 4; ++j) cofA[j] = nofA[j]; }
        if constexpr (S::GB) {
#pragma unroll
            for (int j = 0; j < 4; ++j) cofB[j] = nofB[j]; }
        if (wr == 1) G_BAR;
    }
    G_WAIT_V(0);
    G_BAR;
#undef G_SA
#undef G_SB
#undef G_GLDS
#undef G_STAGE_A
#undef G_STAGE_B
#undef G_LDA
#undef G_LDB
#undef G_MMA
#undef G_WAIT_V
#undef G_WAIT_L
#undef G_BAR
#undef G_SCHED
}
#ifndef MK_FAST
#define MK_FAST 1
#endif
#if MK_FAST
#define GEMM_PHASE(lds, S, E) gemm_fast(lds, S, E)
#else
#define GEMM_PHASE(lds, S, E) gemm_simple(lds, S, E)
#endif

#define ROWLOOP _Pragma("unroll") for (int ai = 0; ai < 2; ++ai) _Pragma("unroll") for (int m = 0; m < 4; ++m)
#define UROW (ai * 128 + wr * 64 + m * 16 + fr)
#define UCOL(bj, n) ((bj) * 128 + wc * 32 + (n) * 16 + 4 * fq)
#define UCOLP(bj) ((bj) * 128 + wc * 32 + 8 * fq)
__device__ __forceinline__ u32x4 pk8(const f32x4 a, const f32x4 b) { u32x4 w; w.x = pk2(a.x, a.y); w.y = pk2(a.z, a.w); w.z = pk2(b.x, b.y); w.w = pk2(b.z, b.w); return w; }
typedef f32x4 AccT[2][2][4][2];

struct UnitD { int pm, pn; };
template <bool PERM_> struct SchedDenseT {
    typedef UnitD U;
    static constexpr bool GA = false, GB = false, PERM = PERM_;
    const bf16* A; const bf16* Bt; int lda, ldb, Kk, nM, nN, vcu;
    __device__ __forceinline__ const char* baseA(const U& u) const { return (const char*)(A + (size_t)u.pm * 256 * lda); }
    __device__ __forceinline__ const char* baseB(const U& u) const { return (const char*)(Bt + (size_t)u.pn * 256 * ldb); }
    __device__ __forceinline__ bool next(int i, U& u) const { const int L = i * NWG + vcu; if (L >= nM * nN) return false; u.pm = L / nN; u.pn = L % nN; return true; }
    __device__ __forceinline__ int K(const U&) const { return Kk; }
    __device__ __forceinline__ const char* rowA(const U& u, int r) const { return (const char*)(A + (size_t)(u.pm * 256 + r) * lda); }
    __device__ __forceinline__ const char* rowB(const U& u, int r) const { return (const char*)(Bt + (size_t)(u.pn * 256 + r) * ldb); }
};
typedef SchedDenseT<false> SchedDense; typedef SchedDenseT<true> SchedDenseP;
struct EpiXZ {
    static constexpr int NVM = 16;
    bf16* XR; bf16* GG;
    __device__ __forceinline__ void operator()(const AccT& acc, const UnitD& u, int wr, int wc, int fr, int fq) const {
        const bool isg = u.pn >= 4; bf16* base = isg ? GG : XR; const int c0 = (u.pn & 3) * 256;
        ROWLOOP { bf16* rp = base + (size_t)(u.pm * 256 + UROW) * D + c0;
#pragma unroll
            for (int bj = 0; bj < 2; ++bj) { f32x4 v0 = acc[ai][bj][m][0], v1 = acc[ai][bj][m][1];
                if (isg) {
#pragma unroll
                    for (int j = 0; j < 4; ++j) { v0[j] = gelu_tanh(v0[j]); v1[j] = gelu_tanh(v1[j]); } }
                *(u32x4*)(rp + UCOLP(bj)) = pk8(v0, v1); } }
    }
};
struct EpiResF32 {
    static constexpr int NVM = 0;
    const float* R; float* O; int ldc;
    __device__ __forceinline__ void operator()(const AccT& acc, const UnitD& u, int wr, int wc, int fr, int fq) const {
        const size_t base = (size_t)(u.pm * 256 + wr * 64 + fr) * ldc + u.pn * 256;
        f32x4 cur[4], nxt[4];
#pragma unroll
        for (int q = 0; q < 4; ++q) cur[q] = *(const f32x4*)(R + base + UCOL(q >> 1, q & 1));
#pragma unroll
        for (int g = 0; g < 8; ++g) { const int ai = g >> 2, m = g & 3; const size_t ro = base + (size_t)(ai * 128 + m * 16) * ldc;
            if (g < 7) { const size_t rn = base + (size_t)(((g + 1) >> 2) * 128 + ((g + 1) & 3) * 16) * ldc;
#pragma unroll
                for (int q = 0; q < 4; ++q) nxt[q] = *(const f32x4*)(R + rn + UCOL(q >> 1, q & 1)); }
#pragma unroll
            for (int q = 0; q < 4; ++q) *(f32x4*)(O + ro + UCOL(q >> 1, q & 1)) = cur[q] * ALPHA + acc[ai][q >> 1][m][q & 1];
#pragma unroll
            for (int q = 0; q < 4; ++q) cur[q] = nxt[q]; }
    }
};
struct EpiF32 {
    static constexpr int NVM = 32;
    float* O; int ldc;
    __device__ __forceinline__ void operator()(const AccT& acc, const UnitD& u, int wr, int wc, int fr, int fq) const {
        ROWLOOP { const size_t ro = (size_t)(u.pm * 256 + UROW) * ldc + u.pn * 256;
#pragma unroll
            for (int bj = 0; bj < 2; ++bj)
#pragma unroll
                for (int n = 0; n < 2; ++n) *(f32x4*)(O + ro + UCOL(bj, n)) = acc[ai][bj][m][n]; }
    }
};

struct UnitG { int pm, blk, pn; };
struct SchedGate {
    typedef UnitG U;
    static constexpr bool GA = false, GB = false, PERM = true; static constexpr int Kk = 256, lda = D, ldb = 256;
    const bf16* XC; const bf16* WgT; int vcu;
    __device__ __forceinline__ const char* baseA(const U& u) const { return (const char*)(XC + (size_t)u.pm * 256 * D + u.blk * 256); }
    __device__ __forceinline__ const char* baseB(const U& u) const { return (const char*)(WgT + (size_t)(u.blk * 512 + u.pn * 256) * 256); }
    __device__ __forceinline__ bool next(int i, U& u) const { const int L = i * NWG + vcu; if (L >= 128 * 8) return false; u.pm = L >> 3; u.blk = (L >> 1) & 3; u.pn = L & 1; return true; }
    __device__ __forceinline__ int K(const U&) const { return 256; }
    __device__ __forceinline__ const char* rowA(const U& u, int r) const { return (const char*)(XC + (size_t)(u.pm * 256 + r) * D + u.blk * 256); }
    __device__ __forceinline__ const char* rowB(const U& u, int r) const { return (const char*)(WgT + (size_t)(u.blk * 512 + u.pn * 256 + r) * 256); }
};
struct EpiGate {
    static constexpr int NVM = 0;
    const bf16* XC; const float *ba, *bx, *lam; bf16* LA; bf16* UU;
    __device__ __forceinline__ void operator()(const AccT& acc, const UnitG& u, int wr, int wc, int fr, int fq) const {
        const int c0 = u.blk * 256 + u.pn * 128 + wc * 32 + 8 * fq;
        f32x4 vba[2], vbx[2], sp[2];
#pragma unroll
        for (int n = 0; n < 2; ++n) { vba[n] = *(const f32x4*)(ba + c0 + 4 * n); vbx[n] = *(const f32x4*)(bx + c0 + 4 * n); const f32x4 vl = *(const f32x4*)(lam + c0 + 4 * n);
#pragma unroll
            for (int j = 0; j < 4; ++j) { const float x = __expf(-vl[j]); sp[n][j] = 8.0f * x * (1.0f - x * (0.5f - x * (1.0f / 3.0f))); } }
        const size_t base = (size_t)(u.pm * 256 + wr * 64 + fr) * D + c0;
        u32x4 xw = *(const u32x4*)(XC + base);
#pragma unroll
        for (int g = 0; g < 8; ++g) { const int ai = g >> 2, m = g & 3; const size_t ro = base + (size_t)(ai * 128 + m * 16) * D;
            u32x4 xn = xw; if (g < 7) xn = *(const u32x4*)(XC + base + (size_t)(((g + 1) >> 2) * 128 + ((g + 1) & 3) * 16) * D);
            const float xc[8] = {bf_lo(xw.x), bf_hi(xw.x), bf_lo(xw.y), bf_hi(xw.y), bf_lo(xw.z), bf_hi(xw.z), bf_lo(xw.w), bf_hi(xw.w)};
            f32x4 la[2], uu[2];
#pragma unroll
            for (int n = 0; n < 2; ++n) { const f32x4 ga = acc[ai][0][m][n] + vba[n], gx = acc[ai][1][m][n] + vbx[n];
#pragma unroll
                for (int j = 0; j < 4; ++j) { const float r = sigmoidf_(ga[j]), ig = sigmoidf_(gx[j]); const float l = -r * sp[n][j]; la[n][j] = l;
                    const float mult = sqrtf(fmaxf(1.0f - __expf(2.0f * l), 0.f)); uu[n][j] = mult * ig * xc[4 * n + j]; } }
            *(u32x4*)(LA + ro) = pk8(la[0], la[1]); *(u32x4*)(UU + ro) = pk8(uu[0], uu[1]); xw = xn; }
    }
};

struct UnitE { int rb, pn, e, ti; };
struct SchedG1 {
    typedef UnitE U;
    static constexpr bool GA = true, GB = false, PERM = true; static constexpr int Kk = D, lda = D, ldb = D;
    const unsigned char* X; const unsigned char* W13T; const int* ROWA; const int* BLKE; int nrbt, vcu; int ev; const LAS unsigned* tab;
    __device__ __forceinline__ const char* baseA(const U&) const { return (const char*)X; }
    __device__ __forceinline__ const char* baseB(const U& u) const { return (const char*)(W13T + ((size_t)u.e * 512 + u.pn * 256) * D); }
    __device__ __forceinline__ unsigned goffA(const U& u, int r, int C) const { return tab[u.ti * 256 + r] + (unsigned)C * 2u; }
    __device__ __forceinline__ unsigned goffB(const U&, int, int) const { return 0u; }
    __device__ __forceinline__ bool next(int i, U& u) const { const int L = i * NWG + vcu; const int rb = L >> 1; if (rb >= nrbt) return false; u.rb = rb; u.pn = L & 1; u.ti = i; u.e = __builtin_amdgcn_readlane(ev, i); return true; }
    __device__ __forceinline__ int K(const U&) const { return D; }
};
struct EpiSwiGLU {
    static constexpr int NVM = 8;
    bf16* HID;
    __device__ __forceinline__ void operator()(const AccT& acc, const UnitE& u, int wr, int wc, int fr, int fq) const {
        ROWLOOP { bf16* rp = HID + (size_t)(u.rb * 256 + UROW) * DE + u.pn * 128;
            f32x4 h0, h1;
#pragma unroll
            for (int j = 0; j < 4; ++j) { const float a0 = acc[ai][0][m][0][j] * 0.015625f, a1 = acc[ai][0][m][1][j] * 0.015625f; h0[j] = a0 * sigmoidf_(a0) * (acc[ai][1][m][0][j] * 0.015625f); h1[j] = a1 * sigmoidf_(a1) * (acc[ai][1][m][1][j] * 0.015625f); }
            *(u32x4*)(rp + wc * 32 + 8 * fq) = pk8(h0, h1); }
    }
};
struct SchedG2 {
    typedef UnitE U;
    static constexpr bool GA = false, GB = false, PERM = true; static constexpr int Kk = DE, lda = DE, ldb = DE;
    const bf16* HID; const bf16* W2T; const int* BLKE; int nrbt, vcu; int ev;
    __device__ __forceinline__ const char* baseA(const U& u) const { return (const char*)(HID + (size_t)u.rb * 256 * DE); }
    __device__ __forceinline__ const char* baseB(const U& u) const { return (const char*)(W2T + ((size_t)u.e * D + u.pn * 256) * DE); }
    __device__ __forceinline__ bool next(int i, U& u) const { const int L = i * NWG + vcu; const int rb = L >> 2; if (rb >= nrbt) return false; u.rb = rb; u.pn = L & 3; u.ti = i; u.e = __builtin_amdgcn_readlane(ev, i); return true; }
    __device__ __forceinline__ int K(const U&) const { return DE; }
    __device__ __forceinline__ const char* rowA(const U& u, int r) const { return (const char*)(HID + (size_t)(u.rb * 256 + r) * DE); }
    __device__ __forceinline__ const char* rowB(const U& u, int r) const { return (const char*)(W2T + ((size_t)u.e * D + u.pn * 256 + r) * DE); }
};
struct EpiScatter {
    static constexpr int NVM = 16;
    bf16* YA; int dry;
    __device__ __forceinline__ void operator()(const AccT& acc, const UnitE& u, int wr, int wc, int fr, int fq) const {
        if (dry == 1) return;
        const size_t rbase = dry == 2 ? (size_t)(blockIdx.x * 256) : (size_t)u.rb * 256;
        ROWLOOP { unsigned char* rp = (unsigned char*)YA + (rbase + UROW) * D + u.pn * 256;
#pragma unroll
            for (int bj = 0; bj < 2; ++bj) { const f32x4 v0 = acc[ai][bj][m][0] * 16.0f, v1 = acc[ai][bj][m][1] * 16.0f; u32x2 w;
                int t0 = __builtin_amdgcn_cvt_pk_fp8_f32(v0.x, v0.y, 0, false); t0 = __builtin_amdgcn_cvt_pk_fp8_f32(v0.z, v0.w, t0, true);
                int t1 = __builtin_amdgcn_cvt_pk_fp8_f32(v1.x, v1.y, 0, false); t1 = __builtin_amdgcn_cvt_pk_fp8_f32(v1.z, v1.w, t1, true);
                w.x = (unsigned)t0; w.y = (unsigned)t1; *(u32x2*)(rp + UCOLP(bj)) = w; } }
    }
};

__device__ __forceinline__ int rho_to_tok(int rho, int g) { const int sh = 14 - 2 * g; const int rp = rho & 16383; return (rho & ~16383) + (rp >> sh) + ((rp & ((1 << sh) - 1)) << (2 * g)); }
__device__ __forceinline__ int tok_to_rho(int t, int g) { const int sh = 14 - 2 * g; const int tp = t & 16383; return (t & ~16383) + ((tp & ((1 << (2 * g)) - 1)) << sh) + (tp >> (2 * g)); }
struct UnitQ { int type, g, pm, pn; };
struct SchedQK {
    typedef UnitQ U;
    static constexpr bool GA = false, GB = false, PERM = true; static constexpr int Kk = D, ldb = D;
    const bf16* X; const bf16* WqkT; int g, lda, vcu;
    __device__ __forceinline__ bool next(int i, U& u) const { const int L = i * NWG + vcu; if (L >= 512) return false; u.type = 0; u.g = g; u.pm = L >> 2; u.pn = L & 3; return true; }
    __device__ __forceinline__ int K(const U&) const { return D; }
    __device__ __forceinline__ const char* baseA(const U& u) const { return (const char*)(X + (size_t)rho_to_tok(u.pm * 256, g) * D); }
    __device__ __forceinline__ const char* baseB(const U& u) const { return (const char*)(WqkT + ((size_t)g * 1024 + u.pn * 256) * D); }
    __device__ __forceinline__ const char* rowA(const U& u, int r) const { return (const char*)(X + (size_t)rho_to_tok(u.pm * 256 + r, g) * D); }
    __device__ __forceinline__ const char* rowB(const U& u, int r) const { return (const char*)(WqkT + ((size_t)g * 1024 + u.pn * 256 + r) * D); }
};
struct SchedVT {
    typedef UnitQ U;
    static constexpr bool GA = false, GB = false, PERM = true; static constexpr int Kk = D, lda = D;
    const bf16* X; const bf16* WvT; int g, ldb, vcu;
    __device__ __forceinline__ bool next(int i, U& u) const { const int L = i * NWG + vcu; if (L >= 256) return false; u.type = 1; u.g = g; u.pn = L >> 1; u.pm = L & 1; return true; }
    __device__ __forceinline__ int K(const U&) const { return D; }
    __device__ __forceinline__ const char* baseA(const U& u) const { return (const char*)(WvT + ((size_t)g * 512 + u.pm * 256) * D); }
    __device__ __forceinline__ const char* baseB(const U& u) const { return (const char*)(X + (size_t)rho_to_tok(u.pn * 256, g) * D); }
    __device__ __forceinline__ const char* rowA(const U& u, int r) const { return (const char*)(WvT + ((size_t)g * 512 + u.pm * 256 + r) * D); }
    __device__ __forceinline__ const char* rowB(const U& u, int r) const { return (const char*)(X + (size_t)rho_to_tok(u.pn * 256 + r, g) * D); }
};
struct EpiQKV {
    static constexpr int NVM = 16;
    bf16* QK; bf16* VT;
    __device__ __forceinline__ void operator()(const AccT& acc, const UnitQ& u, int wr, int wc, int fr, int fq) const {
        bf16* base; size_t ldc;
        if (u.type == 0) { base = QK + (size_t)u.g * M * 1024; ldc = 1024; } else { base = VT + (size_t)u.g * 512 * M; ldc = M; }
        ROWLOOP { bf16* rp = base + (size_t)(u.pm * 256 + UROW) * ldc + u.pn * 256;
#pragma unroll
            for (int bj = 0; bj < 2; ++bj) *(u32x4*)(rp + UCOLP(bj)) = pk8(acc[ai][bj][m][0], acc[ai][bj][m][1]); }
    }
};

__device__ __forceinline__ void tr_item(const float* src, int spitch, bf16* dst, int dpitch, LAS float* scr, int lane) {
#pragma unroll 4
    for (int i = 0; i < 16; ++i) { const int k = 4 * i + (lane >> 4), n4 = (lane & 15) * 4; const f32x4 v = *(const f32x4*)(src + (size_t)k * spitch + n4);
        LAS float* s = scr + k * 65 + n4; s[0] = v.x; s[1] = v.y; s[2] = v.z; s[3] = v.w; }
    LDS_WAIT(); asm volatile("" ::: "memory");
    const int c = lane & 7;
#pragma unroll
    for (int j = 0; j < 8; ++j) { const int n = 8 * j + (lane >> 3); const LAS float* s = scr + (8 * c) * 65 + n;
        u32x4 o; o.x = pk2(s[0], s[65]); o.y = pk2(s[2 * 65], s[3 * 65]); o.z = pk2(s[4 * 65], s[5 * 65]); o.w = pk2(s[6 * 65], s[7 * 65]);
        *(u32x4*)(dst + (size_t)n * dpitch + 8 * c) = o; }
    LDS_WAIT(); asm volatile("" ::: "memory");
}
__device__ __forceinline__ void tr_item8(const float* src, int spitch, unsigned char* dst, int dpitch, LAS float* scr, int lane) {
#pragma unroll 4
    for (int i = 0; i < 16; ++i) { const int k = 4 * i + (lane >> 4), n4 = (lane & 15) * 4; const f32x4 v = *(const f32x4*)(src + (size_t)k * spitch + n4);
        LAS float* s = scr + k * 65 + n4; s[0] = v.x; s[1] = v.y; s[2] = v.z; s[3] = v.w; }
    LDS_WAIT(); asm volatile("" ::: "memory");
    const int c = lane & 7;
#pragma unroll
    for (int j = 0; j < 8; ++j) { const int n = 8 * j + (lane >> 3); const LAS float* s = scr + (8 * c) * 65 + n;
        int t0 = __builtin_amdgcn_cvt_pk_fp8_f32(s[0] * 64.f, s[65] * 64.f, 0, false); t0 = __builtin_amdgcn_cvt_pk_fp8_f32(s[2 * 65] * 64.f, s[3 * 65] * 64.f, t0, true);
        int t1 = __builtin_amdgcn_cvt_pk_fp8_f32(s[4 * 65] * 64.f, s[5 * 65] * 64.f, 0, false); t1 = __builtin_amdgcn_cvt_pk_fp8_f32(s[6 * 65] * 64.f, s[7 * 65] * 64.f, t1, true);
        u32x2 o; o.x = (unsigned)t0; o.y = (unsigned)t1; *(u32x2*)(dst + (size_t)n * dpitch + 8 * c) = o; }
    LDS_WAIT(); asm volatile("" ::: "memory");
}
template <class RowMap>
__device__ __forceinline__ void tr_matrix(Frame& F, const float* W, int K, int N, bf16* WT, int dpitch, RowMap drow) {
    LAS float* scr = (LAS float*)(F.lds + F.wave * 16640);
    const int nkb = K / 64, nnb = N / 64;
    for (int it = F.vcu * NWAVES + F.wave; it < nkb * nnb; it += NGW) { const int kb = it / nnb, nb = it % nnb;
        tr_item(W + (size_t)(kb * 64) * N + nb * 64, N, WT + (size_t)drow(nb * 64) * dpitch + kb * 64, dpitch, scr, F.lane); }
}
__device__ __forceinline__ void convert_experts(Frame& F, const float* w1, const float* w3, const float* w2, const float* s1, const float* s3, const float* s2) {
    LAS float* scr = (LAS float*)(F.lds + F.wave * 16640);
    unsigned char* W13T = WSP(unsigned char, WS_W13); bf16* W2T = WSP(bf16, WS_W2);
    for (int it = F.vcu * NWAVES + F.wave; it < 257 * 192; it += NGW) {
        const int e = it / 192, r = it % 192, which = r >> 6, tile = r & 63;
        if (which < 2) {
            const float* W = (e < 256) ? (which == 0 ? w1 : w3) + (size_t)e * (size_t)(D * DE) : (which == 0 ? s1 : s3);
            const int kb = tile >> 2, nb = tile & 3; const int drow = (nb >> 1) * 256 + which * 128 + (nb & 1) * 64;
            tr_item8(W + (size_t)(kb * 64) * DE + nb * 64, DE, W13T + ((size_t)e * 512 + drow) * D + kb * 64, D, scr, F.lane);
        } else {
            const float* W = (e < 256) ? w2 + (size_t)e * (size_t)(DE * D) : s2;
            const int kb = tile >> 4, nb = tile & 15;
            tr_item(W + (size_t)(kb * 64) * D + nb * 64, D, W2T + ((size_t)e * D + nb * 64) * DE + kb * 64, DE, scr, F.lane);
        }
    }
}
struct MapId { __device__ int operator()(int n0) const { return n0; } };
struct MapGate { int which; __device__ int operator()(int n0) const { return (n0 >> 7) * 256 + which * 128 + (n0 & 127); } };
struct MapQ { __device__ int operator()(int n0) const { return (n0 >> 9) * 1024 + (n0 & 511); } };
struct MapKV { __device__ int operator()(int n0) const { return n0 < 1536 ? (n0 >> 9) * 1024 + 512 + (n0 & 511) : 3072 + (n0 - 1536); } };

__device__ __forceinline__ void p0_prologue(Frame& F, const Args& A) {
    { const float* x = A.in[0]; bf16* XB = WSP(bf16, WS_RA + RA_XB);
      for (size_t i = (size_t)F.vcu * NTHR + F.tid; i < (size_t)M * D / 8; i += NGT) { const f32x4 a = *(const f32x4*)(x + i * 8), b = *(const f32x4*)(x + i * 8 + 4);
          u32x4 o; o.x = pk2(a.x, a.y); o.y = pk2(a.z, a.w); o.z = pk2(b.x, b.y); o.w = pk2(b.z, b.w); *(u32x4*)(XB + i * 8) = o; } }
    tr_matrix(F, A.in[1], D, 2048, WSP(bf16, WS_WIN), D, MapId());
    for (int b = 0; b < 4; ++b) { tr_matrix(F, A.in[4] + b * 65536, 256, 256, WSP(bf16, WS_WG) + (size_t)b * 512 * 256, 256, MapGate{0});
                                  tr_matrix(F, A.in[6] + b * 65536, 256, 256, WSP(bf16, WS_WG) + (size_t)b * 512 * 256, 256, MapGate{1}); }
    tr_matrix(F, A.in[9], D, D, WSP(bf16, WS_WOUT), D, MapId());
    tr_matrix(F, A.in[11], D, QW, WSP(bf16, WS_WQK), D, MapQ());
    tr_matrix(F, A.in[10], D, 2 * QW, WSP(bf16, WS_WQK), D, MapKV());
    tr_matrix(F, A.in[12], OW, D, WSP(bf16, WS_WO), OW, MapId());
    for (int l = 0; l < 2; ++l) tr_matrix(F, A.in[13] + (size_t)l * D * NE, D, NE, WSP(bf16, WS_WR) + (size_t)l * NE * D, D, MapId());
    convert_experts(F, A.in[15], A.in[16], A.in[17], A.in[18], A.in[19], A.in[20]);
}
static_assert(WS_WV == WS_WQK + (size_t)3072 * 1024 * 2, "WvT must follow WqkT");

__device__ __forceinline__ void ln_store(f32x4 (&v)[4], const float* g, const float* b, float* of, bf16* ob, int lane, unsigned char* oq = nullptr) {
    float s = 0.f;
#pragma unroll
    for (int j = 0; j < 4; ++j) s += (v[j].x + v[j].y) + (v[j].z + v[j].w);
    const float mean = wave_sum(s) * (1.f / D); float s2 = 0.f;
#pragma unroll
    for (int j = 0; j < 4; ++j) { v[j] = v[j] - mean; s2 += (v[j].x * v[j].x + v[j].y * v[j].y) + (v[j].z * v[j].z + v[j].w * v[j].w); }
    const float rstd = 1.f / sqrtf(wave_sum(s2) * (1.f / D) + LN_EPS);
#pragma unroll
    for (int j = 0; j < 4; ++j) { const int c = 4 * lane + 256 * j; const f32x4 gg = *(const f32x4*)(g + c), bb = *(const f32x4*)(b + c); const f32x4 y = v[j] * rstd * gg + bb;
        if (of) *(f32x4*)(of + c) = y;
        if (ob) { u32x2 w; w.x = pk2(y.x, y.y); w.y = pk2(y.z, y.w); *(u32x2*)(ob + c) = w; }
        if (oq) { int t = __builtin_amdgcn_cvt_pk_fp8_f32(y.x, y.y, 0, false); t = __builtin_amdgcn_cvt_pk_fp8_f32(y.z, y.w, t, true); *(unsigned*)(oq + c) = (unsigned)t; } }
}

__device__ __forceinline__ int moe_unit_experts(Frame& F, const int* BLKE, int nrbt, int shift) { const int L = F.lane * NWG + F.vcu; const int rb = L >> shift; return rb < nrbt ? BLKE[rb] : 0; }
__device__ __forceinline__ const LAS unsigned* moe_row_table(Frame& F, const int* ROWA, int nrbt) {
    LAS unsigned* tab = (LAS unsigned*)(F.lds + 131072);
    for (int i = 0; i < 15; ++i) { const int rb = (i * NWG + F.vcu) >> 1; if (rb >= nrbt) break;
        if (F.tid < 256) { const int a = ROWA[rb * 256 + F.tid]; const int tok = a < 0 ? 0 : (a < 8 * M ? (a >> 3) : a - 8 * M); tab[i * 256 + F.tid] = (unsigned)tok * (unsigned)D; } }
    __syncthreads();
    return tab;
}
__device__ __forceinline__ void p_conv(Frame& F, const float* cw, const float* cb) {
    const bf16* XR = WSP(bf16, WS_RA + RA_XR); bf16* XC = WSP(bf16, WS_RA + RA_XC);
    for (int i = F.vcu * NTHR + F.tid; i < M * (D / 8); i += NGT) { const int t = i >> 7, c = (i & 127) * 8; const int ts = t & (SEQ - 1);
        float a[8];
#pragma unroll
        for (int q = 0; q < 8; ++q) a[q] = cb[c + q];
#pragma unroll
        for (int j = 0; j < 4; ++j) { if (ts - 3 + j >= 0) { const u32x4 w = *(const u32x4*)(XR + (size_t)(t - 3 + j) * D + c); const float* wj = cw + j * D + c;
            a[0] += wj[0] * bf_lo(w.x); a[1] += wj[1] * bf_hi(w.x); a[2] += wj[2] * bf_lo(w.y); a[3] += wj[3] * bf_hi(w.y);
            a[4] += wj[4] * bf_lo(w.z); a[5] += wj[5] * bf_hi(w.z); a[6] += wj[6] * bf_lo(w.w); a[7] += wj[7] * bf_hi(w.w); } }
        u32x4 o; o.x = pk2(a[0], a[1]); o.y = pk2(a[2], a[3]); o.z = pk2(a[4], a[5]); o.w = pk2(a[6], a[7]); *(u32x4*)(XC + (size_t)t * D + c) = o; }
}
constexpr int CH = 64, NCH = SEQ / CH;
__device__ __forceinline__ void p_scan1(Frame& F) {
    const bf16* LA = WSP(bf16, WS_RA + RA_LA); const bf16* UU = WSP(bf16, WS_RA + RA_U); float* CP = WSP(float, WS_CHP); float* CHh = WSP(float, WS_CHH);
    for (int i = F.vcu * NTHR + F.tid; i < BATCH * NCH * (D / 4); i += NGT) { const int c4 = (i & 255) * 4, ck = (i >> 8) & (NCH - 1), b = i >> 16;
        const size_t r0 = ((size_t)b * SEQ + (size_t)ck * CH) * D + c4; f32x4 h = {0.f, 0.f, 0.f, 0.f}, sl = {0.f, 0.f, 0.f, 0.f};
#pragma unroll 8
        for (int t = 0; t < CH; ++t) { const u32x2 lw = *(const u32x2*)(LA + r0 + (size_t)t * D), uw = *(const u32x2*)(UU + r0 + (size_t)t * D);
            const f32x4 la = {bf_lo(lw.x), bf_hi(lw.x), bf_lo(lw.y), bf_hi(lw.y)}, u = {bf_lo(uw.x), bf_hi(uw.x), bf_lo(uw.y), bf_hi(uw.y)};
#pragma unroll
            for (int j = 0; j < 4; ++j) { h[j] = __expf(la[j]) * h[j] + u[j]; sl[j] += la[j]; } }
#pragma unroll
        for (int j = 0; j < 4; ++j) { const size_t o = ((size_t)b * D + c4 + j) * NCH + ck; CP[o] = __expf(sl[j]); CHh[o] = h[j]; } }
}
__device__ __forceinline__ void p_scan2(Frame& F) {
    const float* CP = WSP(float, WS_CHP); const float* CHh = WSP(float, WS_CHH); float* CIN = WSP(float, WS_CIN);
    for (int s = F.vcu * NWAVES + F.wave; s < BATCH * D; s += NGW) { const size_t o = (size_t)s * NCH + 4 * F.lane;
        const f32x4 p4 = *(const f32x4*)(CP + o), h4 = *(const f32x4*)(CHh + o);
        float p = p4.x, h = h4.x; h = p4.y * h + h4.y; p *= p4.y; h = p4.z * h + h4.z; p *= p4.z; h = p4.w * h + h4.w; p *= p4.w;
#pragma unroll
        for (int off = 1; off < 64; off <<= 1) { const float pp = __shfl_up(p, off), hp = __shfl_up(h, off); if (F.lane >= off) { h = p * hp + h; p = pp * p; } }
        float c0 = __shfl_up(h, 1); if (F.lane == 0) c0 = 0.f;
        f32x4 ci; ci.x = c0; ci.y = p4.x * ci.x + h4.x; ci.z = p4.y * ci.y + h4.y; ci.w = p4.z * ci.z + h4.z;
        *(f32x4*)(CIN + o) = ci; }
}
__device__ __forceinline__ void p_scan3(Frame& F) {
    const bf16* LA = WSP(bf16, WS_RA + RA_LA); const bf16* UU = WSP(bf16, WS_RA + RA_U); const float* CIN = WSP(float, WS_CIN);
    const bf16* GG = WSP(bf16, WS_RA + RA_GG); bf16* YB = WSP(bf16, WS_RA + RA_YB);
    for (int i = F.vcu * NTHR + F.tid; i < BATCH * NCH * (D / 4); i += NGT) { const int c4 = (i & 255) * 4, ck = (i >> 8) & (NCH - 1), b = i >> 16;
        const size_t r0 = ((size_t)b * SEQ + (size_t)ck * CH) * D + c4; f32x4 h;
#pragma unroll
        for (int j = 0; j < 4; ++j) h[j] = CIN[((size_t)b * D + c4 + j) * NCH + ck];
#pragma unroll 1
        for (int t0 = 0; t0 < CH; t0 += 8) { u32x2 lw[8], uw[8], gw[8];
#pragma unroll
            for (int k = 0; k < 8; ++k) { const size_t o = r0 + (size_t)(t0 + k) * D; lw[k] = *(const u32x2*)(LA + o); uw[k] = *(const u32x2*)(UU + o); gw[k] = *(const u32x2*)(GG + o); }
#pragma unroll
            for (int k = 0; k < 8; ++k) { const f32x4 la = {bf_lo(lw[k].x), bf_hi(lw[k].x), bf_lo(lw[k].y), bf_hi(lw[k].y)}, u = {bf_lo(uw[k].x), bf_hi(uw[k].x), bf_lo(uw[k].y), bf_hi(uw[k].y)};
#pragma unroll
                for (int j = 0; j < 4; ++j) h[j] = __expf(la[j]) * h[j] + u[j];
                u32x2 o; o.x = pk2(h.x * bf_lo(gw[k].x), h.y * bf_hi(gw[k].x)); o.y = pk2(h.z * bf_lo(gw[k].y), h.w * bf_hi(gw[k].y)); *(u32x2*)(YB + r0 + (size_t)(t0 + k) * D) = o; } } }
}
__device__ __forceinline__ void p_ln(Frame& F, const float* V, const float* g, const float* b, float* Hf, bf16* Hb) {
    unsigned char* Hq = WSP(unsigned char, WS_HQ);
    for (int r = F.vcu * NWAVES + F.wave; r < M; r += NGW) { const f32x4* xr = (const f32x4*)(V + (size_t)r * D) + F.lane; f32x4 v[4];
#pragma unroll
        for (int j = 0; j < 4; ++j) v[j] = xr[64 * j];
        ln_store(v, g, b, Hf + (size_t)r * D, Hb + (size_t)r * D, F.lane, Hq + (size_t)r * D); }
}
template <int CTRL> __device__ __forceinline__ float dppf(float x) { return __builtin_bit_cast(float, __builtin_amdgcn_mov_dpp(__builtin_bit_cast(int, x), CTRL, 0xF, 0xF, true)); }
template <int CTRL> __device__ __forceinline__ unsigned dppu(unsigned x) { return (unsigned)__builtin_amdgcn_mov_dpp((int)x, CTRL, 0xF, 0xF, true); }
__device__ __forceinline__ float rdlane_f(float x, int l) { return __builtin_bit_cast(float, __builtin_amdgcn_readlane(__builtin_bit_cast(int, x), l)); }
__device__ __forceinline__ void p_route(Frame& F, const float* bias) {
    const float* LG = WSP(float, WS_LOGITS); int* TOPI = WSP(int, WS_TOPI); float* GATE = WSP(float, WS_GATE); int* HIST = WSP(int, WS_HIST);
    LAS int* hist = (LAS int*)F.lds; const int lane = F.lane;
    if (F.tid < 256) hist[F.tid] = 0;
    __syncthreads();
    const f32x4 bv = *(const f32x4*)(bias + 4 * lane);
#pragma unroll 2
    for (int j = 0; j < 16; ++j) { const int t = F.vcu * 128 + F.wave * 16 + j;
        const f32x4 z = *(const f32x4*)(LG + (size_t)t * NE + 4 * lane);
        const float s0 = sigmoidf_(z.x), s1 = sigmoidf_(z.y), s2 = sigmoidf_(z.z), s3 = sigmoidf_(z.w);
        const float v0 = s0 + bv.x, v1 = s1 + bv.y, v2 = s2 + bv.z, v3 = s3 + bv.w;
        float m1, m2; { const float a = fmaxf(v0, v1), b = fminf(v0, v1), c = fmaxf(v2, v3), d = fminf(v2, v3); m1 = fmaxf(a, c); m2 = fmaxf(fminf(a, c), fmaxf(b, d)); }
        { float o1 = dppf<0xB1>(m1), o2 = dppf<0xB1>(m2); float n1 = fmaxf(m1, o1), n2 = fmaxf(fminf(m1, o1), fmaxf(m2, o2)); m1 = n1; m2 = n2;
          o1 = dppf<0x4E>(m1); o2 = dppf<0x4E>(m2); n1 = fmaxf(m1, o1); n2 = fmaxf(fminf(m1, o1), fmaxf(m2, o2)); m1 = n1; m2 = n2;
          o1 = dppf<0x141>(m1); o2 = dppf<0x141>(m2); n1 = fmaxf(m1, o1); n2 = fmaxf(fminf(m1, o1), fmaxf(m2, o2)); m1 = n1; m2 = n2; }
        const float gs = m1 + m2; const int g = lane >> 3; int rank = 0;
#pragma unroll
        for (int q = 0; q < 8; ++q) { const float o = rdlane_f(gs, 8 * q); rank += (o > gs || (o == gs && q < g)) ? 1 : 0; }
        const bool sel = rank < 4;
        const unsigned ib = 255u - 4u * (unsigned)lane;
        unsigned k0 = sel ? ((__float_as_uint(v0 + 1.0f) & ~255u) | ib) : 0u, k1 = sel ? ((__float_as_uint(v1 + 1.0f) & ~255u) | (ib - 1u)) : 0u;
        unsigned k2 = sel ? ((__float_as_uint(v2 + 1.0f) & ~255u) | (ib - 2u)) : 0u, k3 = sel ? ((__float_as_uint(v3 + 1.0f) & ~255u) | (ib - 3u)) : 0u;
        int myidx = 0; float mys = 0.f, tot = 0.f;
#pragma unroll
        for (int k = 0; k < TOPK; ++k) {
            unsigned mk = max(max(k0, k1), max(k2, k3));
            mk = max(mk, dppu<0xB1>(mk)); mk = max(mk, dppu<0x4E>(mk)); mk = max(mk, dppu<0x141>(mk)); mk = max(mk, dppu<0x140>(mk));
            const unsigned win = max(max((unsigned)__builtin_amdgcn_readlane((int)mk, 0), (unsigned)__builtin_amdgcn_readlane((int)mk, 16)), max((unsigned)__builtin_amdgcn_readlane((int)mk, 32), (unsigned)__builtin_amdgcn_readlane((int)mk, 48)));
            const int idx = 255 - (int)(win & 255u);
            k0 = (k0 == win) ? 0u : k0; k1 = (k1 == win) ? 0u : k1; k2 = (k2 == win) ? 0u : k2; k3 = (k3 == win) ? 0u : k3;
            const int qq = idx & 3; const float sq = qq == 0 ? s0 : (qq == 1 ? s1 : (qq == 2 ? s2 : s3)); const float sw = rdlane_f(sq, idx >> 2);
            tot += sw; if (lane == k) { myidx = idx; mys = sw; }
        }
        if (lane < TOPK) { TOPI[t * TOPK + lane] = myidx; GATE[t * TOPK + lane] = mys / tot * 2.5f; atomicAdd((int*)&hist[myidx], 1); }
    }
    __syncthreads();
    if (F.tid < 256) HIST[F.vcu * 256 + F.tid] = hist[F.tid];
    __syncthreads();
}
__device__ __forceinline__ void p_sort(Frame& F) {
    const int* HIST = WSP(int, WS_HIST); const int* TOPI = WSP(int, WS_TOPI); int* ROWA = WSP(int, WS_ROWA); int* POS = WSP(int, WS_POS); int* BLKE = WSP(int, WS_BLKE); int* META = WSP(int, WS_META);
    LAS int* cnt = (LAS int*)F.lds; LAS int* myoff = cnt + 256; LAS int* nb = cnt + 512; LAS int* blk0 = cnt + 768; LAS int* lcnt = cnt + 1024;
    { typedef int i32x4 __attribute__((ext_vector_type(4)));
      const int q = F.tid >> 6, l = F.tid & 63; i32x4 c = {0, 0, 0, 0}, mo = {0, 0, 0, 0};
#pragma unroll 8
      for (int w = q; w < NWG; w += 8) { const i32x4 h = *(const i32x4*)(HIST + w * 256 + 4 * l); c += h; if (w < F.vcu) mo += h; }
      LAS int* redc = cnt + 1280; LAS int* redm = redc + 2048;
#pragma unroll
      for (int j = 0; j < 4; ++j) { redc[q * 256 + 4 * l + j] = c[j]; redm[q * 256 + 4 * l + j] = mo[j]; }
      __syncthreads();
      if (F.tid < 256) { const int e = F.tid; int cc = 0, mm = 0;
#pragma unroll
          for (int k = 0; k < 8; ++k) { cc += redc[k * 256 + e]; mm += redm[k * 256 + e]; }
          cnt[e] = cc; myoff[e] = mm; nb[e] = (cc + 255) >> 8; lcnt[e] = 0; } }
    __syncthreads();
    if (F.tid < 256) { int b = 0; for (int j = 0; j < F.tid; ++j) b += nb[j]; blk0[F.tid] = b; }
    __syncthreads();
    for (int al = F.tid; al < 1024; al += NTHR) { const int a = F.vcu * 1024 + al; const int e = TOPI[a]; const int pos = blk0[e] * 256 + myoff[e] + atomicAdd((int*)&lcnt[e], 1); ROWA[pos] = a; POS[a] = pos; }
    const int nrb = blk0[255] + nb[255];
    { const int e = F.vcu; const int start = blk0[e] * 256 + cnt[e], end = (blk0[e] + nb[e]) * 256;
      for (int p = start + F.tid; p < end; p += NTHR) ROWA[p] = -1;
      for (int j = F.tid; j < nb[e]; j += NTHR) BLKE[blk0[e] + j] = e; }
    for (int tl = F.tid; tl < 128; tl += NTHR) { const int t = F.vcu * 128 + tl; ROWA[nrb * 256 + t] = 8 * M + t; }
    if (F.vcu == 0) { for (int j = F.tid; j < 128; j += NTHR) BLKE[nrb + j] = 256; if (F.tid == 0) META[0] = nrb + 128; }
    __syncthreads();
}
__device__ __forceinline__ void p_combine(Frame& F, const float* Hin, const float* g, const float* b, float* Hf, bf16* Hb) {
    const bf16* YA = WSP(bf16, WS_RA); const float* GATE = WSP(float, WS_GATE); const int* POS = WSP(int, WS_POS); const int shrow0 = (*WSP(int, WS_META) - 128) * 256;
    for (int t = F.vcu * NWAVES + F.wave; t < M; t += NGW) { f32x4 v[4];
        const f32x4* hr = (const f32x4*)(Hin + (size_t)t * D) + F.lane;
#pragma unroll
        for (int j = 0; j < 4; ++j) v[j] = hr[64 * j] * ALPHA;
        f32x4 r[4];
#pragma unroll
        for (int j = 0; j < 4; ++j) r[j] = (f32x4){0.f, 0.f, 0.f, 0.f};
#pragma unroll
        for (int k = 0; k < TOPK; ++k) { const float gk = GATE[t * TOPK + k] * 0.0625f; const unsigned* yr = (const unsigned*)((const unsigned char*)YA + (size_t)POS[t * TOPK + k] * D) + F.lane;
#pragma unroll
            for (int j = 0; j < 4; ++j) { const unsigned w = yr[64 * j]; const f32x2 a = __builtin_amdgcn_cvt_pk_f32_fp8((int)w, false), c = __builtin_amdgcn_cvt_pk_f32_fp8((int)w, true);
                r[j].x += gk * a.x; r[j].y += gk * a.y; r[j].z += gk * c.x; r[j].w += gk * c.y; } }
        { const unsigned* yr = (const unsigned*)((const unsigned char*)YA + (size_t)(shrow0 + t) * D) + F.lane;
#pragma unroll
            for (int j = 0; j < 4; ++j) { const unsigned w = yr[64 * j]; const f32x2 a = __builtin_amdgcn_cvt_pk_f32_fp8((int)w, false), c = __builtin_amdgcn_cvt_pk_f32_fp8((int)w, true);
                v[j].x += r[j].x + 0.0625f * a.x; v[j].y += r[j].y + 0.0625f * a.y; v[j].z += r[j].z + 0.0625f * c.x; v[j].w += r[j].w + 0.0625f * c.y; } }
        ln_store(v, g, b, Hf + (size_t)t * D, Hb ? Hb + (size_t)t * D : nullptr, F.lane); }
}
constexpr int AT_KP = 144, AT_VP = 784, AT_KBYTES = 384 * AT_KP, AT_VOFF = AT_KBYTES;
__device__ __forceinline__ void p_attn(Frame& F) {
    const bf16* QKb = WSP(bf16, WS_RA + RA_QK); const bf16* VTb = WSP(bf16, WS_RA + RA_VT); bf16* OGb = WSP(bf16, WS_RA + RA_OG); float* LSE = WSP(float, WS_LSE);
    const int lane = F.lane, q = lane & 31, hh = lane >> 5, w = F.wave;
    LAS unsigned char* lk = F.lds; LAS unsigned char* lv = F.lds + AT_VOFF;
#pragma unroll 1
    for (int it = F.vcu; it < 3 * 128 * 8; it += NWG) {
        const int g = it >> 10, rem = it & 1023, chunk = rem >> 3, h = rem & 7;
        const int sh = 14 - 2 * g, rq0 = chunk * 256, i0 = rq0 & ((1 << sh) - 1), rk0 = rq0 - 128;
        const bf16* QK = QKb + (size_t)g * M * 1024; const bf16* VT = VTb + (size_t)g * 512 * M;
        { const char* kb = (const char*)(QK + 512 + h * 64);
#pragma unroll
          for (int j = 0; j < 7; ++j) { const int ins = w + 8 * j; if (ins < 54) { const int p = ins * 64 + lane, row = p / 9, cc = p - row * 9; const int gr = rk0 + row < 0 ? 0 : rk0 + row;
              __builtin_amdgcn_global_load_lds((const unsigned*)(kb + (size_t)gr * 2048 + (cc > 7 ? 7 : cc) * 16), (LAS unsigned*)(lk + ins * 1024), 16, 0, 0); } }
          const char* vb = (const char*)(VT + (size_t)(h * 64) * M);
#pragma unroll
          for (int j = 0; j < 7; ++j) { const int ins = w + 8 * j; if (ins < 49) { const int p = ins * 64 + lane, row = p / 49, cc = p - row * 49; int col = rk0 + (cc > 47 ? 47 : cc) * 8; col = col < 0 ? 0 : col;
              __builtin_amdgcn_global_load_lds((const unsigned*)(vb + ((size_t)row * M + col) * 2), (LAS unsigned*)(lv + ins * 1024), 16, 0, 0); } } }
        bf16x8 Qf[4];
        { const bf16* qp = QK + (size_t)(rq0 + 32 * w + q) * 1024 + h * 64 + 8 * hh;
#pragma unroll
          for (int s2 = 0; s2 < 4; ++s2) Qf[s2] = *(const bf16x8*)(qp + 16 * s2); }
        asm volatile("s_waitcnt vmcnt(0)" ::: "memory");
        __syncthreads();
        const float slope2 = exp2f(-(float)(h + 1)) * (float)(1 << (2 * g)) * 1.4426950408889634f, sc = 0.125f * 1.4426950408889634f;
        float m_run = -1e30f, l_run = 0.f; f32x16 O0, O1;
#pragma unroll
        for (int r = 0; r < 16; ++r) { O0[r] = 0.f; O1[r] = 0.f; }
#pragma unroll 1
        for (int kt = 0; kt < 5; ++kt) { const int kr0 = 32 * w + 32 * kt; if (i0 + kr0 - 128 < 0) continue;
            bf16x8 Kf[4];
            { const LAS unsigned char* kp = lk + (kr0 + q) * AT_KP + 16 * hh;
#pragma unroll
              for (int s2 = 0; s2 < 4; ++s2) Kf[s2] = *(const LAS bf16x8*)(kp + 32 * s2); }
            bf16x8 Vf[2][2];
#pragma unroll
            for (int dd = 0; dd < 2; ++dd)
#pragma unroll
                for (int s2 = 0; s2 < 2; ++s2) { const LAS unsigned char* vp = lv + (32 * dd + q) * AT_VP + (kr0 + 16 * s2 + 4 * hh) * 2;
                    const u32x2 lo = *(const LAS u32x2*)vp, hi = *(const LAS u32x2*)(vp + 16); u32x4 wv; wv.x = lo.x; wv.y = lo.y; wv.z = hi.x; wv.w = hi.y; Vf[dd][s2] = __builtin_bit_cast(bf16x8, wv); }
            f32x16 S;
#pragma unroll
            for (int r = 0; r < 16; ++r) S[r] = 0.f;
#pragma unroll
            for (int s2 = 0; s2 < 4; ++s2) S = __builtin_amdgcn_mfma_f32_32x32x16_bf16(Kf[s2], Qf[s2], S, 0, 0, 0);
            float mx = -1e30f;
#pragma unroll
            for (int r = 0; r < 16; ++r) { const int krow = (r & 3) + 8 * (r >> 2) + 4 * hh; const int dist = 128 - 32 * kt + q - krow;
                const float sv = (dist >= 0 && dist <= 128) ? S[r] * sc - slope2 * (float)dist : -1e30f; S[r] = sv; mx = fmaxf(mx, sv); }
            mx = fmaxf(mx, __shfl_xor(mx, 32));
            const float m_new = fmaxf(m_run, mx), alpha = exp2f(m_run - m_new); float rs = 0.f;
#pragma unroll
            for (int r = 0; r < 16; ++r) { const float p = exp2f(S[r] - m_new); S[r] = p; rs += p; }
            rs += __shfl_xor(rs, 32);
            l_run = l_run * alpha + rs; m_run = m_new;
#pragma unroll
            for (int r = 0; r < 16; ++r) { O0[r] *= alpha; O1[r] *= alpha; }
            bf16x8 Pf[2];
#pragma unroll
            for (int s2 = 0; s2 < 2; ++s2) { u32x4 wv; wv.x = pk2(S[8 * s2 + 0], S[8 * s2 + 1]); wv.y = pk2(S[8 * s2 + 2], S[8 * s2 + 3]); wv.z = pk2(S[8 * s2 + 4], S[8 * s2 + 5]); wv.w = pk2(S[8 * s2 + 6], S[8 * s2 + 7]); Pf[s2] = __builtin_bit_cast(bf16x8, wv); }
#pragma unroll
            for (int s2 = 0; s2 < 2; ++s2) { O0 = __builtin_amdgcn_mfma_f32_32x32x16_bf16(Vf[0][s2], Pf[s2], O0, 0, 0, 0); O1 = __builtin_amdgcn_mfma_f32_32x32x16_bf16(Vf[1][s2], Pf[s2], O1, 0, 0, 0); }
        }
        const float inv = 1.0f / l_run;
        bf16* op = OGb + ((size_t)g * M + rq0 + 32 * w + q) * 512 + h * 64 + 4 * hh;
#pragma unroll
        for (int rg = 0; rg < 4; ++rg) { u32x2 wv; wv.x = pk2(O0[4 * rg] * inv, O0[4 * rg + 1] * inv); wv.y = pk2(O0[4 * rg + 2] * inv, O0[4 * rg + 3] * inv); *(u32x2*)(op + 8 * rg) = wv;
            u32x2 w1; w1.x = pk2(O1[4 * rg] * inv, O1[4 * rg + 1] * inv); w1.y = pk2(O1[4 * rg + 2] * inv, O1[4 * rg + 3] * inv); *(u32x2*)(op + 32 + 8 * rg) = w1; }
        if (hh == 0) LSE[((size_t)g * M + rq0 + 32 * w + q) * 8 + h] = (m_run + log2f(l_run)) * 0.6931471805599453f;
        __syncthreads();
    }
}
__device__ __forceinline__ void p_merge(Frame& F) {
    const bf16* OGb = WSP(bf16, WS_RA + RA_OG); const float* LSE = WSP(float, WS_LSE); bf16* OM = WSP(bf16, WS_RA + RA_OM);
    for (int t = F.vcu * NWAVES + F.wave; t < M; t += NGW) { const int hd = F.lane >> 3; float ls[3]; size_t ro[3];
#pragma unroll
        for (int g = 0; g < 3; ++g) { const int rho = tok_to_rho(t, g); ro[g] = ((size_t)g * M + rho); ls[g] = LSE[ro[g] * 8 + hd]; }
        const float mx = fmaxf(ls[0], fmaxf(ls[1], ls[2])); float w[3], ws = 0.f;
#pragma unroll
        for (int g = 0; g < 3; ++g) { w[g] = __expf(ls[g] - mx); ws += w[g]; }
        const float inv = 1.0f / ws; float o[8];
#pragma unroll
        for (int j = 0; j < 8; ++j) o[j] = 0.f;
#pragma unroll
        for (int g = 0; g < 3; ++g) { const u32x4 x = *(const u32x4*)(OGb + ro[g] * 512 + 8 * F.lane); const float wg = w[g] * inv;
            o[0] += wg * bf_lo(x.x); o[1] += wg * bf_hi(x.x); o[2] += wg * bf_lo(x.y); o[3] += wg * bf_hi(x.y); o[4] += wg * bf_lo(x.z); o[5] += wg * bf_hi(x.z); o[6] += wg * bf_lo(x.w); o[7] += wg * bf_hi(x.w); }
        u32x4 r; r.x = pk2(o[0], o[1]); r.y = pk2(o[2], o[3]); r.z = pk2(o[4], o[5]); r.w = pk2(o[6], o[7]); *(u32x4*)(OM + (size_t)t * OW + 8 * F.lane) = r; }
}

constexpr int NPHASE = 26;

__global__ void __launch_bounds__(NTHR, 2) yoco_fwd(Args args) {
    extern __shared__ __attribute__((aligned(16))) unsigned char lds[];
    Frame F;
    F.lds = (LAS unsigned char*)lds;
    F.tid = threadIdx.x; F.lane = F.tid & 63; F.wave = __builtin_amdgcn_readfirstlane(F.tid >> 6);
    { const int bx = blockIdx.x; F.vcu = (bx % 8) * (NWG / 8) + bx / 8; }
    F.ws = args.ws;
    volatile LAS unsigned* MISC = (volatile LAS unsigned*)(F.lds + LDS_BYTES - 64);
    if (F.tid < 16) MISC[F.tid] = 0u;
    __syncthreads();
    const int lo = args.ph_lo, hi = args.ph_hi;
    XcdBarrier bar; bar.bar = (unsigned*)(F.ws + WS_CTL) + 4096; bar.x = 0; bar.st = nullptr;
    if (hi - lo > 1) bar = xcd_barrier_post((unsigned*)(F.ws + WS_CTL) + 4096, MISC + 8);
#ifndef PROBE_G2
#define PROBE_G2 0
#endif
#ifndef DUP_MASK
#define DUP_MASK 0u
#endif
#ifndef PH_MASK
#define PH_MASK 0xFFFFFFFFu
#endif
#define IN(k) (((PH_MASK >> (k)) & 1u) && lo <= (k) && (k) < hi)
#define REP(k) for (int rep = 0, nrep = 1 + (int)((args.dup >> (k)) & 1u); rep < nrep; ++rep)
#define SEAM(k) do { if (IN(k) && IN((k) + 1)) xcd_barrier(bar); } while (0)

    if (IN(0)) { p0_prologue(F, args); } SEAM(0);
    if (IN(1)) { SchedDenseP S{WSP(bf16, WS_RA + RA_XB), WSP(bf16, WS_WIN), D, D, D, M / 256, 8, F.vcu}; EpiXZ E{WSP(bf16, WS_RA + RA_XR), WSP(bf16, WS_RA + RA_GG)}; GEMM_PHASE(F.lds, S, E); } SEAM(1);
    if (IN(2)) { p_conv(F, args.in[2], args.in[3]); } SEAM(2);
    if (IN(3)) { SchedGate S{WSP(bf16, WS_RA + RA_XC), WSP(bf16, WS_WG), F.vcu}; EpiGate E{WSP(bf16, WS_RA + RA_XC), args.in[5], args.in[7], args.in[8], WSP(bf16, WS_RA + RA_LA), WSP(bf16, WS_RA + RA_U)}; GEMM_PHASE(F.lds, S, E); } SEAM(3);
    if (IN(4)) { p_scan1(F); } SEAM(4);
    if (IN(5)) { p_scan2(F); } SEAM(5);
    if (IN(6)) { p_scan3(F); } SEAM(6);
    if (IN(7)) { SchedDense S{WSP(bf16, WS_RA + RA_YB), WSP(bf16, WS_WOUT), D, D, D, M / 256, 4, F.vcu}; EpiResF32 E{args.in[0], WSP(float, WS_V), D}; GEMM_PHASE(F.lds, S, E); } SEAM(7);
    if (IN(8)) { p_ln(F, WSP(float, WS_V), args.in[21] + 0 * D, args.in[22] + 0 * D, WSP(float, WS_HA), WSP(bf16, WS_HAB)); } SEAM(8);
    if (IN(9)) { SchedDense S{WSP(bf16, WS_HAB), WSP(bf16, WS_WR), D, D, D, M / 256, 1, F.vcu}; EpiF32 E{WSP(float, WS_LOGITS), NE}; GEMM_PHASE(F.lds, S, E); } SEAM(9);
    if (IN(10)) { p_route(F, args.in[14]); } SEAM(10);
    if (IN(11)) { p_sort(F); } SEAM(11);
    if (IN(12)) { const int nrbt = *WSP(int, WS_META); SchedG1 S{WSP(unsigned char, WS_HQ), WSP(unsigned char, WS_W13), WSP(int, WS_ROWA), WSP(int, WS_BLKE), nrbt, F.vcu, moe_unit_experts(F, WSP(int, WS_BLKE), nrbt, 1), moe_row_table(F, WSP(int, WS_ROWA), nrbt)}; EpiSwiGLU E{WSP(bf16, WS_HID)}; gemm_fast8(F.lds, S, E); } SEAM(12);
    if (IN(13)) { const int nrbt = *WSP(int, WS_META); SchedG2 S{WSP(bf16, WS_HID), WSP(bf16, WS_W2), WSP(int, WS_BLKE), nrbt, F.vcu, moe_unit_experts(F, WSP(int, WS_BLKE), nrbt, 2)}; EpiScatter E{WSP(bf16, WS_RA), 0}; GEMM_PHASE(F.lds, S, E); if (PROBE_G2) { __syncthreads(); EpiScatter E2{(PROBE_G2 == 2 || PROBE_G2 == 4) ? WSP(bf16, WS_V) : WSP(bf16, WS_RA), PROBE_G2 == 3 ? 0 : PROBE_G2}; GEMM_PHASE(F.lds, S, E2); } } SEAM(13);
    if (IN(14)) { p_combine(F, WSP(float, WS_HA), args.in[21] + 1 * D, args.in[22] + 1 * D, WSP(float, WS_HB), WSP(bf16, WS_HBB)); convert_experts(F, args.in[15] + (size_t)NE * D * DE, args.in[16] + (size_t)NE * D * DE, args.in[17] + (size_t)NE * D * DE, args.in[18] + (size_t)D * DE, args.in[19] + (size_t)D * DE, args.in[20] + (size_t)D * DE); } SEAM(14);
    if (IN(15)) { EpiQKV E{WSP(bf16, WS_RA + RA_QK), WSP(bf16, WS_RA + RA_VT)}; for (int g = 0; g < 3; ++g) { SchedQK S{WSP(bf16, WS_HBB), WSP(bf16, WS_WQK), g, D << (2 * g), F.vcu}; GEMM_PHASE(F.lds, S, E); } for (int g = 0; g < 3; ++g) { SchedVT S{WSP(bf16, WS_HBB), WSP(bf16, WS_WV), g, D << (2 * g), F.vcu}; GEMM_PHASE(F.lds, S, E); } } SEAM(15);
    if (IN(16)) { p_attn(F); } SEAM(16);
    if (IN(17)) { p_merge(F); } SEAM(17);
    if (IN(18)) { SchedDense S{WSP(bf16, WS_RA + RA_OM), WSP(bf16, WS_WO), OW, OW, OW, M / 256, 4, F.vcu}; EpiResF32 E{WSP(float, WS_HB), WSP(float, WS_V), D}; GEMM_PHASE(F.lds, S, E); } SEAM(18);
    if (IN(19)) { p_ln(F, WSP(float, WS_V), args.in[21] + 2 * D, args.in[22] + 2 * D, WSP(float, WS_HA), WSP(bf16, WS_HAB)); } SEAM(19);
    if (IN(20)) { SchedDense S{WSP(bf16, WS_HAB), WSP(bf16, WS_WR) + (size_t)NE * D, D, D, D, M / 256, 1, F.vcu}; EpiF32 E{WSP(float, WS_LOGITS), NE}; GEMM_PHASE(F.lds, S, E); } SEAM(20);
    if (IN(21)) { p_route(F, args.in[14] + NE); } SEAM(21);
    if (IN(22)) { p_sort(F); } SEAM(22);
    if (IN(23)) { const int nrbt = *WSP(int, WS_META); SchedG1 S{WSP(unsigned char, WS_HQ), WSP(unsigned char, WS_W13), WSP(int, WS_ROWA), WSP(int, WS_BLKE), nrbt, F.vcu, moe_unit_experts(F, WSP(int, WS_BLKE), nrbt, 1), moe_row_table(F, WSP(int, WS_ROWA), nrbt)}; EpiSwiGLU E{WSP(bf16, WS_HID)}; gemm_fast8(F.lds, S, E); } SEAM(23);
    if (IN(24)) { const int nrbt = *WSP(int, WS_META); SchedG2 S{WSP(bf16, WS_HID), WSP(bf16, WS_W2), WSP(int, WS_BLKE), nrbt, F.vcu, moe_unit_experts(F, WSP(int, WS_BLKE), nrbt, 2)}; EpiScatter E{WSP(bf16, WS_RA), 0}; GEMM_PHASE(F.lds, S, E); if (PROBE_G2) { __syncthreads(); EpiScatter E2{(PROBE_G2 == 2 || PROBE_G2 == 4) ? WSP(bf16, WS_V) : WSP(bf16, WS_RA), PROBE_G2 == 3 ? 0 : PROBE_G2}; GEMM_PHASE(F.lds, S, E2); } } SEAM(24);
    if (IN(25)) { p_combine(F, WSP(float, WS_HA), args.in[21] + 3 * D, args.in[22] + 3 * D, args.out, nullptr); }
#undef IN
#undef SEAM
}

extern "C" void kernel_launch(void* const* d_in, const int* in_sizes, int n_in, void* d_out, int out_size, void* d_ws, size_t ws_size, hipStream_t stream) {
    static int ok = 0;
    if (ok == 0) {
        if (n_in != 23 || in_sizes[0] != M * D || out_size != M * D || ws_size < WS_END) { fprintf(stderr, "kernel_launch: unexpected shapes (n_in %d, in0 %d, out %d, ws %zu < %zu)\n", n_in, n_in > 0 ? in_sizes[0] : -1, out_size, ws_size, (size_t)WS_END); ok = -1; return; }
        if (hipFuncSetAttribute((const void*)yoco_fwd, hipFuncAttributeMaxDynamicSharedMemorySize, LDS_BYTES) != hipSuccess) { fprintf(stderr, "kernel_launch: hipFuncSetAttribute failed\n"); ok = -1; return; }
        int per_cu = 0;
        if (hipOccupancyMaxActiveBlocksPerMultiprocessor(&per_cu, (const void*)yoco_fwd, NTHR, LDS_BYTES) != hipSuccess || per_cu < 1) fprintf(stderr, "kernel_launch: occupancy query says %d\n", per_cu);
        (void)hipGetLastError();
        ok = 1;
    }
    if (ok < 0) return;
    if (hipMemsetAsync((char*)d_ws + WS_CTL, 0, CTL_ZERO_BYTES, stream) != hipSuccess) return;
    Args a{};
    for (int i = 0; i < 23; ++i) a.in[i] = (const float*)d_in[i];
    a.out = (float*)d_out; a.ws = (unsigned char*)d_ws; a.dup = 0u; a.dry = 0;
#if MK_ONE_LAUNCH
    a.ph_lo = 0; a.ph_hi = NPHASE;
    hipLaunchKernelGGL(yoco_fwd, dim3(NWG), dim3(NTHR), LDS_BYTES, stream, a);
#else
    for (int p = 0; p < NPHASE; ++p) { a.ph_lo = p; a.ph_hi = p + 1; hipLaunchKernelGGL(yoco_fwd, dim3(NWG), dim3(NTHR), LDS_BYTES, stream, a); }
#endif
}
```

```cpp
#include <hip/hip_runtime.h>
#include <cstdio>
#include <cstdint>

#ifndef MK_ONE_LAUNCH
#define MK_ONE_LAUNCH 1
#endif

constexpr int D = 1024, BATCH = 2, SEQ = 16384, M = BATCH * SEQ;
constexpr int NE = 256, TOPK = 8, DE = 256;
constexpr int HEADS = 8, HD = 64, QW = 1536, OW = 512;
constexpr float LN_EPS = 1e-5f, ALPHA = 1.41421356237f;
constexpr int RBMAX = 1024 + 256 + 128;
constexpr int NWG = 256, NTHR = 512, NWAVES = 8;
constexpr int NGW = NWG * NWAVES, NGT = NWG * NTHR;

constexpr size_t MiB = 1u << 20;
constexpr size_t WS_CTL = 0, CTL_ZERO_BYTES = 1 * MiB;
constexpr size_t WS_HIST = 1 * MiB, WS_BLKE = 1 * MiB + 512 * 1024, WS_META = 1 * MiB + 768 * 1024;
constexpr size_t WS_ROWA = 2 * MiB, WS_TOPI = 4 * MiB, WS_GATE = 5 * MiB, WS_CHP = 6 * MiB, WS_CHH = 8 * MiB, WS_CIN = 10 * MiB, WS_LSE = 12 * MiB;
constexpr size_t WS_WIN = 16 * MiB, WS_WG = 20 * MiB, WS_WOUT = 21 * MiB, WS_WQK = 23 * MiB, WS_WV = 29 * MiB, WS_WO = 32 * MiB, WS_WR = 33 * MiB;
constexpr size_t WS_LOGITS = 34 * MiB;
constexpr size_t WS_W13 = 66 * MiB, WS_W2 = 323 * MiB;
constexpr size_t WS_V = 452 * MiB, WS_HA = 580 * MiB, WS_HAB = 708 * MiB, WS_HB = 772 * MiB, WS_HBB = 900 * MiB, WS_HID = 964 * MiB;
constexpr size_t WS_RA = 1140 * MiB;
constexpr size_t RA_XB = 0, RA_XR = 64 * MiB, RA_GG = 128 * MiB, RA_XC = 192 * MiB, RA_LA = 256 * MiB, RA_U = 384 * MiB, RA_YB = 512 * MiB;
constexpr size_t RA_QK = 0, RA_VT = 192 * MiB, RA_OG = 288 * MiB, RA_OM = 384 * MiB;
constexpr size_t WS_POS = 15 * MiB;
constexpr size_t WS_HQ = 1844 * MiB;
constexpr size_t WS_END = 1876 * MiB;

constexpr int LDS_BYTES = 147456;

#define GAS __attribute__((address_space(1)))
#define LAS __attribute__((address_space(3)))
typedef unsigned short bf16;
typedef unsigned u32x4 __attribute__((ext_vector_type(4)));
typedef unsigned u32x2 __attribute__((ext_vector_type(2)));
typedef float f32x4 __attribute__((ext_vector_type(4)));
typedef float f32x2 __attribute__((ext_vector_type(2)));
typedef float f32x16 __attribute__((ext_vector_type(16)));
typedef short bf16x8 __attribute__((ext_vector_type(8)));
typedef int i32x8 __attribute__((ext_vector_type(8)));
typedef GAS unsigned gu32;
#define RLX_AGENT __ATOMIC_RELAXED, __HIP_MEMORY_SCOPE_AGENT
#define LDS_WAIT() asm volatile("s_waitcnt lgkmcnt(0)" ::: "memory")
#define VM_WAIT() asm volatile("s_waitcnt vmcnt(0)" ::: "memory")

__device__ __forceinline__ unsigned pk2(float lo, float hi) { unsigned r; asm("v_cvt_pk_bf16_f32 %0, %1, %2" : "=v"(r) : "v"(lo), "v"(hi)); return r; }
__device__ __forceinline__ float bf_lo(unsigned w) { return __uint_as_float(w << 16); }
__device__ __forceinline__ float bf_hi(unsigned w) { return __uint_as_float(w & 0xffff0000u); }
__device__ __forceinline__ float wave_sum(float v) {
#pragma unroll
    for (int o = 1; o < 64; o <<= 1) v += __shfl_xor(v, o);
    return v;
}
__device__ __forceinline__ float gelu_tanh(float x) {
    const float u = 0.7978845608028654f * (x + 0.044715f * x * x * x);
    const float e = __expf(2.0f * u);
    const float t = 1.0f - 2.0f / (e + 1.0f);
    return 0.5f * x * (1.0f + t);
}
__device__ __forceinline__ float sigmoidf_(float x) { return 1.0f / (1.0f + __expf(-x)); }

#define XB_TMO      128
#define XB_XCNT(j)  (256  + 64 * (j))
#define XB_XSUB(j)  (1280 + 64 * (j))
#define XB_XGEN(j)  (2304 + 64 * (j))
#define XB_TOP      3328
#define XB_TOPGEN   3392
#define XCD_BAR_WORDS 3456
#define XB_SPIN_CAP (1u << 18)
__device__ __forceinline__ unsigned xb_ld(unsigned* p)              { return __hip_atomic_load(p, __ATOMIC_RELAXED, __HIP_MEMORY_SCOPE_AGENT); }
__device__ __forceinline__ unsigned xb_add(unsigned* p, unsigned v) { return __hip_atomic_fetch_add(p, v, __ATOMIC_RELAXED, __HIP_MEMORY_SCOPE_AGENT); }
__device__ __forceinline__ unsigned xb_xcc_id() { return (unsigned)__builtin_amdgcn_s_getreg((3 << 11) | 20) & 0xFu; }
#define XB_SPIN(cond, bar) do { unsigned _sp = 0; while (cond) { __builtin_amdgcn_s_sleep(1); \
    if ((++_sp & 255u) == 0u) { if (xb_ld(&(bar)[XB_TMO])) break; if (_sp > XB_SPIN_CAP) { atomicAdd(&(bar)[XB_TMO], 1u); break; } } } } while (0)
struct XcdBarrier { unsigned* bar; unsigned x; volatile LAS unsigned* st; };
__device__ __forceinline__ XcdBarrier xcd_barrier_post(unsigned* bar, volatile LAS unsigned* st) {
    XcdBarrier b; b.bar = bar; b.x = xb_xcc_id(); b.st = st;
    if (threadIdx.x == 0) (void)xb_add(&bar[XB_XCNT(b.x)], 1u);
    return b;
}
__device__ __forceinline__ void xcd_barrier_complete(unsigned* bar, unsigned x, unsigned& nloc, unsigned& nx) {
    const unsigned G = gridDim.x * gridDim.y * gridDim.z;
    unsigned sum, cnt, mine, sp = 0u;
    for (;;) {
        sum = 0u; cnt = 0u; mine = 0u;
#pragma unroll
        for (unsigned j = 0; j < 16; ++j) { const unsigned c = xb_ld(&bar[XB_XCNT(j)]); sum += c; cnt += (c > 0u) ? 1u : 0u; mine = (j == x) ? c : mine; }
        if (sum == G) break;
        __builtin_amdgcn_s_sleep(1);
        if ((++sp & 255u) == 0u) { if (xb_ld(&bar[XB_TMO])) break; if (sp > XB_SPIN_CAP) { atomicAdd(&bar[XB_TMO], 1u); break; } }
    }
    nloc = mine > 0u ? mine : 1u; nx = cnt > 0u ? cnt : 1u;
}
__device__ __forceinline__ void xcd_barrier(const XcdBarrier& b) {
    asm volatile("s_waitcnt vmcnt(0)" ::: "memory");
    __syncthreads();
    if (threadIdx.x == 0) {
        unsigned* bar = b.bar;
        __builtin_amdgcn_s_waitcnt(0);
        unsigned nloc = b.st[0], nx = b.st[1];
        if (nloc == 0u) { xcd_barrier_complete(bar, b.x, nloc, nx); b.st[0] = nloc; b.st[1] = nx; }
        const unsigned old = xb_add(&bar[XB_XSUB(b.x)], 1u);
        const unsigned gen = old / nloc;
        if (old + 1u == (gen + 1u) * nloc) {
            __builtin_amdgcn_fence(__ATOMIC_RELEASE, "agent");
            asm volatile("s_waitcnt vmcnt(0)" ::: "memory");
            const unsigned og = xb_add(&bar[XB_TOP], 1u);
            const unsigned tg = og / nx;
            if (og + 1u == (tg + 1u) * nx) xb_add(&bar[XB_TOPGEN], 1u);
            else XB_SPIN(xb_ld(&bar[XB_TOPGEN]) == tg, bar);
            __builtin_amdgcn_fence(__ATOMIC_ACQUIRE, "agent");
            xb_add(&bar[XB_XGEN(b.x)], 1u);
            asm volatile("s_waitcnt vmcnt(0)" ::: "memory");
        } else {
            XB_SPIN(xb_ld(&bar[XB_XGEN(b.x)]) == gen, bar);
            __builtin_amdgcn_fence(__ATOMIC_ACQUIRE, "agent");
            asm volatile("s_waitcnt vmcnt(0)" ::: "memory");
        }
    }
    __syncthreads();
}

struct Args { const float* in[23]; float* out; unsigned char* ws; int ph_lo, ph_hi; unsigned dup; int dry; };
static_assert(sizeof(Args) == 23 * 8 + 8 + 8 + 16, "Args has no padding");
struct Frame {
    LAS unsigned char* lds;
    int tid, lane, wave, vcu;
    unsigned char* ws;
};
#define WSP(T, off) ((T*)(F.ws + (off)))

template <class S, class E>
__device__ __forceinline__ void gemm_simple(LAS unsigned char* lds, const S& sch, const E& epi) {
    const int tid = threadIdx.x, wid = tid >> 6, lane = tid & 63, wr = wid >> 2, wc = wid & 3, fr = lane & 15, fq = lane >> 4;
    constexpr int PITCH = 144;
    LAS unsigned char* As = lds; LAS unsigned char* Bs = lds + 256 * PITCH;
    typename S::U u;
    for (int i = 0; sch.next(i, u); ++i) {
        f32x4 acc[2][2][4][2];
#pragma unroll
        for (int a = 0; a < 2; ++a)
#pragma unroll
            for (int b = 0; b < 2; ++b)
#pragma unroll
                for (int m = 0; m < 4; ++m)
#pragma unroll
                    for (int n = 0; n < 2; ++n) acc[a][b][m][n] = (f32x4){0.f, 0.f, 0.f, 0.f};
        const int nt = sch.K(u) / 64;
        const char* pa[4]; const char* pb[4];
#pragma unroll
        for (int j = 0; j < 4; ++j) { const int row = (tid >> 3) + 64 * j; const int rb = S::PERM ? ((row & ~31) + 8 * ((row & 15) >> 2) + 4 * ((row >> 4) & 1) + (row & 3)) : row; pa[j] = sch.rowA(u, row) + (tid & 7) * 16; pb[j] = sch.rowB(u, rb) + (tid & 7) * 16; }
        for (int kt = 0; kt < nt; ++kt) {
            u32x4 va[4], vb[4];
#pragma unroll
            for (int j = 0; j < 4; ++j) { va[j] = *(const u32x4*)(pa[j] + kt * 128); vb[j] = *(const u32x4*)(pb[j] + kt * 128); }
            __syncthreads();
#pragma unroll
            for (int j = 0; j < 4; ++j) { const int row = (tid >> 3) + 64 * j;
                *(LAS u32x4*)(As + row * PITCH + (tid & 7) * 16) = va[j]; *(LAS u32x4*)(Bs + row * PITCH + (tid & 7) * 16) = vb[j]; }
            __syncthreads();
#pragma unroll
            for (int kk = 0; kk < 2; ++kk) {
                bf16x8 Bf[2][2];
#pragma unroll
                for (int b = 0; b < 2; ++b)
#pragma unroll
                    for (int n = 0; n < 2; ++n) Bf[b][n] = *(const LAS bf16x8*)(Bs + (b * 128 + wc * 32 + n * 16 + fr) * PITCH + kk * 64 + fq * 16);
#pragma unroll
                for (int a = 0; a < 2; ++a) {
                    bf16x8 Af[4];
#pragma unroll
                    for (int m = 0; m < 4; ++m) Af[m] = *(const LAS bf16x8*)(As + (a * 128 + wr * 64 + m * 16 + fr) * PITCH + kk * 64 + fq * 16);
#pragma unroll
                    for (int b = 0; b < 2; ++b)
#pragma unroll
                        for (int m = 0; m < 4; ++m)
#pragma unroll
                            for (int n = 0; n < 2; ++n) acc[a][b][m][n] = __builtin_amdgcn_mfma_f32_16x16x32_bf16(Bf[b][n], Af[m], acc[a][b][m][n], 0, 0, 0);
                }
            }
        }
        epi(acc, u, wr, wc, fr, fq);
    }
    __syncthreads();
}

namespace pg8 {
constexpr int HTB = 128 * 64 * 2;
__device__ __forceinline__ int lds_byte(int r, int c) { const int st = (r >> 4) * 2 + (c >> 5), rr = r & 15, cc = c & 31, ob = rr * 64 + cc * 2; return st * 1024 + (ob ^ (((ob >> 9) & 1) << 5)); }
__device__ __forceinline__ int perm32(int rho) { const int n = rho >> 4, i = rho & 15; return 8 * (i >> 2) + 4 * n + (i & 3); }
__device__ __forceinline__ int prow(int r) { return (r & ~31) + perm32(r & 31); }
__device__ __forceinline__ void stage_rc(int b, int& R, int& C) { const int st = b / 1024, sb = b % 1024, swz = sb ^ (((sb >> 9) & 1) << 5); R = (st >> 1) * 16 + swz / 64; C = (st & 1) * 32 + (swz % 64) / 2; }
}
template <class S, class E>
__device__ __forceinline__ void gemm_fast(LAS unsigned char* lds, const S& sch, const E& epi) {
    using namespace pg8;
    const int tid = threadIdx.x, wid = __builtin_amdgcn_readfirstlane(tid >> 6), lane = tid & 63, wr = wid >> 2, wc = wid & 3, fr = lane & 15, fq = lane >> 4;
    const int nt = sch.Kk / 64;
    int R0, C0; stage_rc(tid * 16, R0, C0);
    unsigned voffA[2], voffB[2]; unsigned cofA[4], nofA[4], cofB[4], nofB[4];
    size_t hstepA = 0, hstepB = 0;
    if constexpr (!S::GA) { voffA[0] = (unsigned)(R0 * sch.lda + C0) * 2u; voffA[1] = (unsigned)((R0 + 64) * sch.lda + C0) * 2u; hstepA = (size_t)128 * sch.lda * 2; }
    const int RB0 = S::PERM ? prow(R0) : R0;
    if constexpr (!S::GB) { voffB[0] = (unsigned)(RB0 * sch.ldb + C0) * 2u; voffB[1] = (unsigned)((RB0 + 64) * sch.ldb + C0) * 2u; hstepB = (size_t)128 * sch.ldb * 2; }
    const size_t kstep = 128;
    const unsigned ldsw = (unsigned)wid * 1024u;
    const int aoff = lds_byte(wr * 64 + fr, fq * 8), boff = lds_byte(wc * 32 + fr, fq * 8);
#define G_SA(b, h) (((b) * 2 + (h)) * HTB)
#define G_SB(b, h) ((4 + (b) * 2 + (h)) * HTB)
#define G_GLDS(src, dst) __builtin_amdgcn_global_load_lds((const unsigned*)(src), (LAS unsigned*)(dst), 16, 0, 0)
#define G_STAGE_A(bufoff, gp, h, nx) do { if constexpr (S::GA) { _Pragma("unroll") for (int _i = 0; _i < 2; ++_i) { const unsigned _o = (nx) ? nofA[2 * (h) + _i] : cofA[2 * (h) + _i]; G_GLDS((gp) + _o, lds + (bufoff) + ldsw + _i * 8192); } } \
        else { _Pragma("unroll") for (int _i = 0; _i < 2; ++_i) G_GLDS((gp) + (size_t)(h) * hstepA + voffA[_i], lds + (bufoff) + ldsw + _i * 8192); } } while (0)
#define G_STAGE_B(bufoff, gp, h, nx) do { if constexpr (S::GB) { _Pragma("unroll") for (int _i = 0; _i < 2; ++_i) { const unsigned _o = (nx) ? nofB[2 * (h) + _i] : cofB[2 * (h) + _i]; G_GLDS((gp) + _o, lds + (bufoff) + ldsw + _i * 8192); } } \
        else { _Pragma("unroll") for (int _i = 0; _i < 2; ++_i) G_GLDS((gp) + (size_t)(h) * hstepB + voffB[_i], lds + (bufoff) + ldsw + _i * 8192); } } while (0)
#define G_LDA(dst, b, h) do { _Pragma("unroll") for (int m = 0; m < 4; ++m) _Pragma("unroll") for (int k = 0; k < 2; ++k) dst[m][k] = *(const LAS bf16x8*)(lds + G_SA(b, h) + aoff + m * 2048 + k * 1024); } while (0)
#define G_LDB(dst, b, h) do { _Pragma("unroll") for (int n = 0; n < 2; ++n) _Pragma("unroll") for (int k = 0; k < 2; ++k) dst[n][k] = *(const LAS bf16x8*)(lds + G_SB(b, h) + boff + n * 2048 + k * 1024); } while (0)
#define G_MMA(ai, bj, At, Bt) do { __builtin_amdgcn_s_setprio(1); _Pragma("unroll") for (int m = 0; m < 4; ++m) _Pragma("unroll") for (int n = 0; n < 2; ++n) _Pragma("unroll") for (int k = 0; k < 2; ++k) \
        acc[ai][bj][m][n] = __builtin_amdgcn_mfma_f32_16x16x32_bf16(Bt[n][k], At[m][k], acc[ai][bj][m][n], 0, 0, 0); __builtin_amdgcn_s_setprio(0); } while (0)
#define G_WAIT_V(n) asm volatile("s_waitcnt vmcnt(" #n ")" ::: "memory")
#define G_WAIT_L(n) asm volatile("s_waitcnt lgkmcnt(" #n ")" ::: "memory")
#define G_BAR __builtin_amdgcn_s_barrier()
#define G_SCHED __builtin_amdgcn_sched_barrier(0)
    typename S::U cur, nxt; int ui = 0;
    if (!sch.next(0, cur)) return;
    f32x4 acc[2][2][4][2];
#pragma unroll
    for (int a = 0; a < 2; ++a)
#pragma unroll
        for (int b = 0; b < 2; ++b)
#pragma unroll
            for (int m = 0; m < 4; ++m)
#pragma unroll
                for (int n = 0; n < 2; ++n) acc[a][b][m][n] = (f32x4){0.f, 0.f, 0.f, 0.f};
    bf16x8 At[4][2], B0[2][2], B1[2][2];
    const char* cA = sch.baseA(cur); const char* cB = sch.baseB(cur);
    if constexpr (S::GA) {
#pragma unroll
        for (int j = 0; j < 4; ++j) { cofA[j] = sch.goffA(cur, (j >> 1) * 128 + R0 + (j & 1) * 64, C0); nofA[j] = cofA[j]; } }
    if constexpr (S::GB) {
#pragma unroll
        for (int j = 0; j < 4; ++j) { cofB[j] = sch.goffB(cur, (j >> 1) * 128 + RB0 + (j & 1) * 64, C0); nofB[j] = cofB[j]; } }
    G_STAGE_B(G_SB(0, 0), cB, 0, false); G_STAGE_B(G_SB(0, 1), cB, 1, false); G_STAGE_A(G_SA(0, 0), cA, 0, false); G_STAGE_A(G_SA(0, 1), cA, 1, false);
    if (wr == 1) G_BAR;
    G_WAIT_V(2); G_BAR;
    G_STAGE_B(G_SB(1, 0), cB + kstep, 0, false); G_STAGE_A(G_SA(1, 0), cA + kstep, 0, false); G_STAGE_B(G_SB(1, 1), cB + kstep, 1, false);
    G_WAIT_V(6); G_BAR;
    for (;;) {
        const bool has_next = sch.next(ui + 1, nxt);
        const char* nA = has_next ? sch.baseA(nxt) : cA; const char* nB = has_next ? sch.baseB(nxt) : cB;
        if constexpr (S::GA) { if (has_next) {
#pragma unroll
            for (int j = 0; j < 4; ++j) nofA[j] = sch.goffA(nxt, (j >> 1) * 128 + R0 + (j & 1) * 64, C0); } }
        if constexpr (S::GB) { if (has_next) {
#pragma unroll
            for (int j = 0; j < 4; ++j) nofB[j] = sch.goffB(nxt, (j >> 1) * 128 + RB0 + (j & 1) * 64, C0); } }
#pragma unroll 1
        for (int t = 0; t < nt; t += 2) {
            const bool last = (t == nt - 2);
            const char* a1 = cA + (size_t)(t + 1) * kstep;
            const char* a2 = last ? nA : cA + (size_t)(t + 2) * kstep; const char* b2 = last ? nB : cB + (size_t)(t + 2) * kstep;
            const char* a3 = a2 + kstep; const char* b3 = b2 + kstep;
            asm volatile("" : "+s"(a1), "+s"(a2), "+s"(a3), "+s"(b2), "+s"(b3));
            const bool post = (t == 0 && ui > 0);
#define G_WAIT_POST() do { if (post) { if constexpr (E::NVM == 8) G_WAIT_V(16); else if constexpr (E::NVM == 16) G_WAIT_V(24); else if constexpr (E::NVM == 32) G_WAIT_V(40); else G_WAIT_V(8); } else G_WAIT_V(8); } while (0)
            G_LDB(B0, 0, 0); G_LDB(B1, 0, 1); G_SCHED; G_LDA(At, 0, 0); if (!post) G_STAGE_A(G_SA(1, 1), a1, 1, false);
            G_WAIT_POST(); G_WAIT_L(0); G_BAR; G_MMA(0, 0, At, B0); G_MMA(0, 1, At, B1); G_BAR; G_SCHED;
            G_LDA(At, 0, 1); G_STAGE_B(G_SB(0, 0), b2, 0, last); G_STAGE_B(G_SB(0, 1), b2, 1, last); G_STAGE_A(G_SA(0, 0), a2, 0, last);
            G_WAIT_POST(); G_WAIT_L(0); G_BAR; G_MMA(1, 0, At, B0); G_MMA(1, 1, At, B1); G_BAR; G_SCHED;
            G_LDB(B0, 1, 0); G_LDB(B1, 1, 1); G_SCHED; G_LDA(At, 1, 0); G_STAGE_A(G_SA(0, 1), a2, 1, last);
            G_WAIT_POST(); G_WAIT_L(0); G_BAR; G_MMA(0, 0, At, B0); G_MMA(0, 1, At, B1); G_BAR; G_SCHED;
            G_LDA(At, 1, 1); G_STAGE_B(G_SB(1, 0), b3, 0, last); G_STAGE_B(G_SB(1, 1), b3, 1, last); G_STAGE_A(G_SA(1, 0), a3, 0, last);
            G_WAIT_V(8); G_WAIT_L(0); G_BAR; G_MMA(1, 0, At, B0); G_MMA(1, 1, At, B1); G_BAR; G_SCHED;
#undef G_WAIT_POST
        }
        if (wr == 0) G_BAR;
        if (has_next) { const char* n1 = nA + kstep; asm volatile("" : "+s"(n1)); G_STAGE_A(G_SA(1, 1), n1, 1, true); }
        epi(acc, cur, wr, wc, fr, fq);
        if (!has_next) break;
#pragma unroll
        for (int a = 0; a < 2; ++a)
#pragma unroll
            for (int b = 0; b < 2; ++b)
#pragma unroll
                for (int m = 0; m < 4; ++m)
#pragma unroll
                    for (int n = 0; n < 2; ++n) acc[a][b][m][n] = (f32x4){0.f, 0.f, 0.f, 0.f};
        cur = nxt; cA = nA; cB = nB; ++ui;
        if constexpr (S::GA) {
#pragma unroll
            for (int j = 0; j < 4; ++j) cofA[j] = nofA[j]; }
        if constexpr (S::GB) {
#pragma unroll
            for (int j = 0; j < 4; ++j) cofB[j] = nofB[j]; }
        if (wr == 1) G_BAR;
    }
    G_WAIT_V(0);
    G_BAR;
#undef G_SA
#undef G_SB
#undef G_GLDS
#undef G_STAGE_A
#undef G_STAGE_B
#undef G_LDA
#undef G_LDB
#undef G_MMA
#undef G_WAIT_V
#undef G_WAIT_L
#undef G_BAR
#undef G_SCHED
}
template <class S, class E>
__device__ __forceinline__ void gemm_fast8(LAS unsigned char* lds, const S& sch, const E& epi) {
    using namespace pg8;
    const int tid = threadIdx.x, wid = __builtin_amdgcn_readfirstlane(tid >> 6), lane = tid & 63, wr = wid >> 2, wc = wid & 3, fr = lane & 15, fq = lane >> 4;
    const int nt = sch.Kk / 128;
    int R0, C0; stage_rc(tid * 16, R0, C0);
    unsigned voffA[2], voffB[2]; unsigned cofA[4], nofA[4], cofB[4], nofB[4];
    size_t hstepA = 0, hstepB = 0;
    if constexpr (!S::GA) { voffA[0] = (unsigned)(R0 * sch.lda + C0 * 2); voffA[1] = (unsigned)((R0 + 64) * sch.lda + C0 * 2); hstepA = (size_t)128 * sch.lda; }
    const int RB0 = S::PERM ? prow(R0) : R0;
    if constexpr (!S::GB) { voffB[0] = (unsigned)(RB0 * sch.ldb + C0 * 2); voffB[1] = (unsigned)((RB0 + 64) * sch.ldb + C0 * 2); hstepB = (size_t)128 * sch.ldb; }
    const size_t kstep = 128;
    const unsigned ldsw = (unsigned)wid * 1024u;
    const int aoff = lds_byte(wr * 64 + fr, fq * 16), aoff1 = lds_byte(wr * 64 + fr, fq * 16 + 8), boff = lds_byte(wc * 32 + fr, fq * 16), boff1 = lds_byte(wc * 32 + fr, fq * 16 + 8);
#define G_SA(b, h) (((b) * 2 + (h)) * HTB)
#define G_SB(b, h) ((4 + (b) * 2 + (h)) * HTB)
#define G_GLDS(src, dst) __builtin_amdgcn_global_load_lds((const unsigned*)(src), (LAS unsigned*)(dst), 16, 0, 0)
#define G_STAGE_A(bufoff, gp, h, nx) do { if constexpr (S::GA) { _Pragma("unroll") for (int _i = 0; _i < 2; ++_i) { const unsigned _o = (nx) ? nofA[2 * (h) + _i] : cofA[2 * (h) + _i]; G_GLDS((gp) + _o, lds + (bufoff) + ldsw + _i * 8192); } } \
        else { _Pragma("unroll") for (int _i = 0; _i < 2; ++_i) G_GLDS((gp) + (size_t)(h) * hstepA + voffA[_i], lds + (bufoff) + ldsw + _i * 8192); } } while (0)
#define G_STAGE_B(bufoff, gp, h, nx) do { if constexpr (S::GB) { _Pragma("unroll") for (int _i = 0; _i < 2; ++_i) { const unsigned _o = (nx) ? nofB[2 * (h) + _i] : cofB[2 * (h) + _i]; G_GLDS((gp) + _o, lds + (bufoff) + ldsw + _i * 8192); } } \
        else { _Pragma("unroll") for (int _i = 0; _i < 2; ++_i) G_GLDS((gp) + (size_t)(h) * hstepB + voffB[_i], lds + (bufoff) + ldsw + _i * 8192); } } while (0)
#define G_LDA(dst, b, h) do { _Pragma("unroll") for (int m = 0; m < 4; ++m) { const u32x4 _lo = *(const LAS u32x4*)(lds + G_SA(b, h) + aoff + m * 2048), _hi = *(const LAS u32x4*)(lds + G_SA(b, h) + aoff1 + m * 2048); dst[m] = (i32x8){(int)_lo.x, (int)_lo.y, (int)_lo.z, (int)_lo.w, (int)_hi.x, (int)_hi.y, (int)_hi.z, (int)_hi.w}; } } while (0)
#define G_LDB(dst, b, h) do { _Pragma("unroll") for (int n = 0; n < 2; ++n) { const u32x4 _lo = *(const LAS u32x4*)(lds + G_SB(b, h) + boff + n * 2048), _hi = *(const LAS u32x4*)(lds + G_SB(b, h) + boff1 + n * 2048); dst[n] = (i32x8){(int)_lo.x, (int)_lo.y, (int)_lo.z, (int)_lo.w, (int)_hi.x, (int)_hi.y, (int)_hi.z, (int)_hi.w}; } } while (0)
#define G_MMA(ai, bj, At, Bt) do { __builtin_amdgcn_s_setprio(1); _Pragma("unroll") for (int m = 0; m < 4; ++m) _Pragma("unroll") for (int n = 0; n < 2; ++n) \
        acc[ai][bj][m][n] = __builtin_amdgcn_mfma_scale_f32_16x16x128_f8f6f4(Bt[n], At[m], acc[ai][bj][m][n], 0, 0, 0, 0, 0, 0); __builtin_amdgcn_s_setprio(0); } while (0)
#define G_WAIT_V(n) asm volatile("s_waitcnt vmcnt(" #n ")" ::: "memory")
#define G_WAIT_L(n) asm volatile("s_waitcnt lgkmcnt(" #n ")" ::: "memory")
#define G_BAR __builtin_amdgcn_s_barrier()
#define G_SCHED __builtin_amdgcn_sched_barrier(0)
    typename S::U cur, nxt; int ui = 0;
    if (!sch.next(0, cur)) return;
    f32x4 acc[2][2][4][2];
#pragma unroll
    for (int a = 0; a < 2; ++a)
#pragma unroll
        for (int b = 0; b < 2; ++b)
#pragma unroll
            for (int m = 0; m < 4; ++m)
#pragma unroll
                for (int n = 0; n < 2; ++n) acc[a][b][m][n] = (f32x4){0.f, 0.f, 0.f, 0.f};
    i32x8 At[4], B0[2], B1[2];
    const char* cA = sch.baseA(cur); const char* cB = sch.baseB(cur);
    if constexpr (S::GA) {
#pragma unroll
        for (int j = 0; j < 4; ++j) { cofA[j] = sch.goffA(cur, (j >> 1) * 128 + R0 + (j & 1) * 64, C0); nofA[j] = cofA[j]; } }
    if constexpr (S::GB) {
#pragma unroll
        for (int j = 0; j < 4; ++j) { cofB[j] = sch.goffB(cur, (j >> 1) * 128 + RB0 + (j & 1) * 64, C0); nofB[j] = cofB[j]; } }
    G_STAGE_B(G_SB(0, 0), cB, 0, false); G_STAGE_B(G_SB(0, 1), cB, 1, false); G_STAGE_A(G_SA(0, 0), cA, 0, false); G_STAGE_A(G_SA(0, 1), cA, 1, false);
    if (wr == 1) G_BAR;
    G_WAIT_V(2); G_BAR;
    G_STAGE_B(G_SB(1, 0), cB + kstep, 0, false); G_STAGE_A(G_SA(1, 0), cA + kstep, 0, false); G_STAGE_B(G_SB(1, 1), cB + kstep, 1, false);
    G_WAIT_V(6); G_BAR;
    for (;;) {
        const bool has_next = sch.next(ui + 1, nxt);
        const char* nA = has_next ? sch.baseA(nxt) : cA; const char* nB = has_next ? sch.baseB(nxt) : cB;
        if constexpr (S::GA) { if (has_next) {
#pragma unroll
            for (int j = 0; j < 4; ++j) nofA[j] = sch.goffA(nxt, (j >> 1) * 128 + R0 + (j & 1) * 64, C0); } }
        if constexpr (S::GB) { if (has_next) {
#pragma unroll
            for (int j = 0; j < 4; ++j) nofB[j] = sch.goffB(nxt, (j >> 1) * 128 + RB0 + (j & 1) * 64, C0); } }
#pragma unroll 1
        for (int t = 0; t < nt; t += 2) {
            const bool last = (t == nt - 2);
            const char* a1 = cA + (size_t)(t + 1) * kstep;
            const char* a2 = last ? nA : cA + (size_t)(t + 2) * kstep; const char* b2 = last ? nB : cB + (size_t)(t + 2) * kstep;
            const char* a3 = a2 + kstep; const char* b3 = b2 + kstep;
            asm volatile("" : "+s"(a1), "+s"(a2), "+s"(a3), "+s"(b2), "+s"(b3));
            const bool post = (t == 0 && ui > 0);
#define G_WAIT_POST() do { if (post) { if constexpr (E::NVM == 8) G_WAIT_V(16); else if constexpr (E::NVM == 16) G_WAIT_V(24); else if constexpr (E::NVM == 32) G_WAIT_V(40); else G_WAIT_V(8); } else G_WAIT_V(8); } while (0)
            G_LDB(B0, 0, 0); G_LDB(B1, 0, 1); G_SCHED; G_LDA(At, 0, 0); if (!post) G_STAGE_A(G_SA(1, 1), a1, 1, false);
            G_WAIT_POST(); G_WAIT_L(0); G_BAR; G_MMA(0, 0, At, B0); G_MMA(0, 1, At, B1); G_BAR; G_SCHED;
            G_LDA(At, 0, 1); G_STAGE_B(G_SB(0, 0), b2, 0, last); G_STAGE_B(G_SB(0, 1), b2, 1, last); G_STAGE_A(G_SA(0, 0), a2, 0, last);
            G_WAIT_POST(); G_WAIT_L(0); G_BAR; G_MMA(1, 0, At, B0); G_MMA(1, 1, At, B1); G_BAR; G_SCHED;
            G_LDB(B0, 1, 0); G_LDB(B1, 1, 1); G_SCHED; G_LDA(At, 1, 0); G_STAGE_A(G_SA(0, 1), a2, 1, last);
            G_WAIT_POST(); G_WAIT_L(0); G_BAR; G_MMA(0, 0, At, B0); G_MMA(0, 1, At, B1); G_BAR; G_SCHED;
            G_LDA(At, 1, 1); G_STAGE_B(G_SB(1, 0), b3, 0, last); G_STAGE_B(G_SB(1, 1), b3, 1, last); G_STAGE_A(G_SA(1, 0), a3, 0, last);
            G_WAIT_V(8); G_WAIT_L(0); G_BAR; G_MMA(1, 0, At, B0); G_MMA(1, 1, At, B1); G_BAR; G_SCHED;
#undef G_WAIT_POST
        }
        if (wr == 0) G_BAR;
        if (has_next) { const char* n1 = nA + kstep; asm volatile("" : "+s"(n1)); G_STAGE_A(G_SA(1, 1), n1, 1, true); }
        epi(acc, cur, wr, wc, fr, fq);
        if (!has_next) break;
#pragma unroll
        for (int a = 0; a < 2; ++a)
#pragma unroll
            for (int b = 0; b < 2; ++b)
#pragma unroll
                for (int m = 0; m < 4; ++m)
#pragma unroll
                    for (int n = 0; n < 2; ++n) acc[a][b][m][n] = (f32x4){0.f, 0.f, 0.f, 0.f};
        cur = nxt; cA = nA; cB = nB; ++ui;
        if constexpr (S::GA) {
#pragma unroll
            for (int j = 0; j < 4; ++j) cofA[j] = nofA[j]; }
        if constexpr (S::GB) {
#pragma unroll
            for (int j = 0; j < 4; ++j) cofB[j] = nofB[j]; }
        if (wr == 1) G_BAR;
    }
    G_WAIT_V(0);
    G_BAR;
#undef G_SA
#undef G_SB
#undef G_GLDS
#undef G_STAGE_A
#undef G_STAGE_B
#undef G_LDA
#undef G_LDB
#undef G_MMA
#undef G_WAIT_V
#undef G_WAIT_L
#undef G_BAR
#undef G_SCHED
}
#ifndef MK_FAST
#define MK_FAST 1
#endif
#if MK_FAST
#define GEMM_PHASE(lds, S, E) gemm_fast(lds, S, E)
#else
#define GEMM_PHASE(lds, S, E) gemm_simple(lds, S, E)
#endif

#define ROWLOOP _Pragma("unroll") for (int ai = 0; ai < 2; ++ai) _Pragma("unroll") for (int m = 0; m < 4; ++m)
#define UROW (ai * 128 + wr * 64 + m * 16 + fr)
#define UCOL(bj, n) ((bj) * 128 + wc * 32 + (n) * 16 + 4 * fq)
#define UCOLP(bj) ((bj) * 128 + wc * 32 + 8 * fq)
__device__ __forceinline__ u32x4 pk8(const f32x4 a, const f32x4 b) { u32x4 w; w.x = pk2(a.x, a.y); w.y = pk2(a.z, a.w); w.z = pk2(b.x, b.y); w.w = pk2(b.z, b.w); return w; }
typedef f32x4 AccT[2][2][4][2];

struct UnitD { int pm, pn; };
template <bool PERM_> struct SchedDenseT {
    typedef UnitD U;
    static constexpr bool GA = false, GB = false, PERM = PERM_;
    const bf16* A; const bf16* Bt; int lda, ldb, Kk, nM, nN, vcu;
    __device__ __forceinline__ const char* baseA(const U& u) const { return (const char*)(A + (size_t)u.pm * 256 * lda); }
    __device__ __forceinline__ const char* baseB(const U& u) const { return (const char*)(Bt + (size_t)u.pn * 256 * ldb); }
    __device__ __forceinline__ bool next(int i, U& u) const { const int L = i * NWG + vcu; if (L >= nM * nN) return false; u.pm = L / nN; u.pn = L % nN; return true; }
    __device__ __forceinline__ int K(const U&) const { return Kk; }
    __device__ __forceinline__ const char* rowA(const U& u, int r) const { return (const char*)(A + (size_t)(u.pm * 256 + r) * lda); }
    __device__ __forceinline__ const char* rowB(const U& u, int r) const { return (const char*)(Bt + (size_t)(u.pn * 256 + r) * ldb); }
};
typedef SchedDenseT<false> SchedDense; typedef SchedDenseT<true> SchedDenseP;
struct SchedDense8 {
    typedef UnitD U;
    static constexpr bool GA = false, GB = false, PERM = true;
    const unsigned char* A; const unsigned char* Bt; int lda, ldb, Kk, nM, nN, vcu;
    __device__ __forceinline__ const char* baseA(const U& u) const { return (const char*)(A + (size_t)u.pm * 256 * lda); }
    __device__ __forceinline__ const char* baseB(const U& u) const { return (const char*)(Bt + (size_t)u.pn * 256 * ldb); }
    __device__ __forceinline__ bool next(int i, U& u) const { const int L = i * NWG + vcu; if (L >= nM * nN) return false; u.pm = L / nN; u.pn = L % nN; return true; }
};
struct EpiXZ {
    static constexpr int NVM = 16;
    bf16* XR; bf16* GG;
    __device__ __forceinline__ void operator()(const AccT& acc, const UnitD& u, int wr, int wc, int fr, int fq) const {
        const bool isg = u.pn >= 4; bf16* base = isg ? GG : XR; const int c0 = (u.pn & 3) * 256;
        ROWLOOP { bf16* rp = base + (size_t)(u.pm * 256 + UROW) * D + c0;
#pragma unroll
            for (int bj = 0; bj < 2; ++bj) { f32x4 v0 = acc[ai][bj][m][0] * 0.015625f, v1 = acc[ai][bj][m][1] * 0.015625f;
                if (isg) {
#pragma unroll
                    for (int j = 0; j < 4; ++j) { v0[j] = gelu_tanh(v0[j]); v1[j] = gelu_tanh(v1[j]); } }
                *(u32x4*)(rp + UCOLP(bj)) = pk8(v0, v1); } }
    }
};
struct EpiResF32 {
    static constexpr int NVM = 0;
    const float* R; float* O; int ldc;
    __device__ __forceinline__ void operator()(const AccT& acc, const UnitD& u, int wr, int wc, int fr, int fq) const {
        const size_t base = (size_t)(u.pm * 256 + wr * 64 + fr) * ldc + u.pn * 256;
        f32x4 cur[4], nxt[4];
#pragma unroll
        for (int q = 0; q < 4; ++q) cur[q] = *(const f32x4*)(R + base + UCOL(q >> 1, q & 1));
#pragma unroll
        for (int g = 0; g < 8; ++g) { const int ai = g >> 2, m = g & 3; const size_t ro = base + (size_t)(ai * 128 + m * 16) * ldc;
            if (g < 7) { const size_t rn = base + (size_t)(((g + 1) >> 2) * 128 + ((g + 1) & 3) * 16) * ldc;
#pragma unroll
                for (int q = 0; q < 4; ++q) nxt[q] = *(const f32x4*)(R + rn + UCOL(q >> 1, q & 1)); }
#pragma unroll
            for (int q = 0; q < 4; ++q) *(f32x4*)(O + ro + UCOL(q >> 1, q & 1)) = cur[q] * ALPHA + acc[ai][q >> 1][m][q & 1];
#pragma unroll
            for (int q = 0; q < 4; ++q) cur[q] = nxt[q]; }
    }
};
struct EpiF32 {
    static constexpr int NVM = 32;
    float* O; int ldc;
    __device__ __forceinline__ void operator()(const AccT& acc, const UnitD& u, int wr, int wc, int fr, int fq) const {
        ROWLOOP { const size_t ro = (size_t)(u.pm * 256 + UROW) * ldc + u.pn * 256;
#pragma unroll
            for (int bj = 0; bj < 2; ++bj)
#pragma unroll
                for (int n = 0; n < 2; ++n) *(f32x4*)(O + ro + UCOL(bj, n)) = acc[ai][bj][m][n]; }
    }
};

struct UnitG { int pm, blk, pn; };
struct SchedGate {
    typedef UnitG U;
    static constexpr bool GA = false, GB = false, PERM = true; static constexpr int Kk = 256, lda = D, ldb = 256;
    const bf16* XC; const bf16* WgT; int vcu;
    __device__ __forceinline__ const char* baseA(const U& u) const { return (const char*)(XC + (size_t)u.pm * 256 * D + u.blk * 256); }
    __device__ __forceinline__ const char* baseB(const U& u) const { return (const char*)(WgT + (size_t)(u.blk * 512 + u.pn * 256) * 256); }
    __device__ __forceinline__ bool next(int i, U& u) const { const int L = i * NWG + vcu; if (L >= 128 * 8) return false; u.pm = L >> 3; u.blk = (L >> 1) & 3; u.pn = L & 1; return true; }
    __device__ __forceinline__ int K(const U&) const { return 256; }
    __device__ __forceinline__ const char* rowA(const U& u, int r) const { return (const char*)(XC + (size_t)(u.pm * 256 + r) * D + u.blk * 256); }
    __device__ __forceinline__ const char* rowB(const U& u, int r) const { return (const char*)(WgT + (size_t)(u.blk * 512 + u.pn * 256 + r) * 256); }
};
struct EpiGate {
    static constexpr int NVM = 0;
    const bf16* XC; const float *ba, *bx, *lam; bf16* LA; bf16* UU;
    __device__ __forceinline__ void operator()(const AccT& acc, const UnitG& u, int wr, int wc, int fr, int fq) const {
        const int c0 = u.blk * 256 + u.pn * 128 + wc * 32 + 8 * fq;
        f32x4 vba[2], vbx[2], sp[2];
#pragma unroll
        for (int n = 0; n < 2; ++n) { vba[n] = *(const f32x4*)(ba + c0 + 4 * n); vbx[n] = *(const f32x4*)(bx + c0 + 4 * n); const f32x4 vl = *(const f32x4*)(lam + c0 + 4 * n);
#pragma unroll
            for (int j = 0; j < 4; ++j) { const float x = __expf(-vl[j]); sp[n][j] = 8.0f * x * (1.0f - x * (0.5f - x * (1.0f / 3.0f))); } }
        const size_t base = (size_t)(u.pm * 256 + wr * 64 + fr) * D + c0;
        u32x4 xw = *(const u32x4*)(XC + base);
#pragma unroll
        for (int g = 0; g < 8; ++g) { const int ai = g >> 2, m = g & 3; const size_t ro = base + (size_t)(ai * 128 + m * 16) * D;
            u32x4 xn = xw; if (g < 7) xn = *(const u32x4*)(XC + base + (size_t)(((g + 1) >> 2) * 128 + ((g + 1) & 3) * 16) * D);
            const float xc[8] = {bf_lo(xw.x), bf_hi(xw.x), bf_lo(xw.y), bf_hi(xw.y), bf_lo(xw.z), bf_hi(xw.z), bf_lo(xw.w), bf_hi(xw.w)};
            f32x4 la[2], uu[2];
#pragma unroll
            for (int n = 0; n < 2; ++n) { const f32x4 ga = acc[ai][0][m][n] + vba[n], gx = acc[ai][1][m][n] + vbx[n];
#pragma unroll
                for (int j = 0; j < 4; ++j) { const float r = sigmoidf_(ga[j]), ig = sigmoidf_(gx[j]); const float l = -r * sp[n][j]; la[n][j] = l;
                    const float mult = sqrtf(fmaxf(1.0f - __expf(2.0f * l), 0.f)); uu[n][j] = mult * ig * xc[4 * n + j]; } }
            *(u32x4*)(LA + ro) = pk8(la[0], la[1]); *(u32x4*)(UU + ro) = pk8(uu[0], uu[1]); xw = xn; }
    }
};

struct UnitE { int rb, pn, e, ti; };
struct SchedG1 {
    typedef UnitE U;
    static constexpr bool GA = true, GB = false, PERM = true; static constexpr int Kk = D, lda = D, ldb = D;
    const unsigned char* X; const unsigned char* W13T; const int* ROWA; const int* BLKE; int nrbt, vcu; int ev; const LAS unsigned* tab;
    __device__ __forceinline__ const char* baseA(const U&) const { return (const char*)X; }
    __device__ __forceinline__ const char* baseB(const U& u) const { return (const char*)(W13T + ((size_t)u.e * 512 + u.pn * 256) * D); }
    __device__ __forceinline__ unsigned goffA(const U& u, int r, int C) const { return tab[u.ti * 256 + r] + (unsigned)C * 2u; }
    __device__ __forceinline__ unsigned goffB(const U&, int, int) const { return 0u; }
    __device__ __forceinline__ bool next(int i, U& u) const { const int L = i * NWG + vcu; const int rb = L >> 1; if (rb >= nrbt) return false; u.rb = rb; u.pn = L & 1; u.ti = i; u.e = __builtin_amdgcn_readlane(ev, i); return true; }
    __device__ __forceinline__ int K(const U&) const { return D; }
};
struct EpiSwiGLU {
    static constexpr int NVM = 8;
    bf16* HID;
    __device__ __forceinline__ void operator()(const AccT& acc, const UnitE& u, int wr, int wc, int fr, int fq) const {
        ROWLOOP { bf16* rp = HID + (size_t)(u.rb * 256 + UROW) * DE + u.pn * 128;
            f32x4 h0, h1;
#pragma unroll
            for (int j = 0; j < 4; ++j) { const float a0 = acc[ai][0][m][0][j] * 0.015625f, a1 = acc[ai][0][m][1][j] * 0.015625f; h0[j] = a0 * sigmoidf_(a0) * (acc[ai][1][m][0][j] * 0.015625f); h1[j] = a1 * sigmoidf_(a1) * (acc[ai][1][m][1][j] * 0.015625f); }
            *(u32x4*)(rp + wc * 32 + 8 * fq) = pk8(h0, h1); }
    }
};
struct SchedG2 {
    typedef UnitE U;
    static constexpr bool GA = false, GB = false, PERM = true; static constexpr int Kk = DE, lda = DE, ldb = DE;
    const bf16* HID; const bf16* W2T; const int* BLKE; int nrbt, vcu; int ev;
    __device__ __forceinline__ const char* baseA(const U& u) const { return (const char*)(HID + (size_t)u.rb * 256 * DE); }
    __device__ __forceinline__ const char* baseB(const U& u) const { return (const char*)(W2T + ((size_t)u.e * D + u.pn * 256) * DE); }
    __device__ __forceinline__ bool next(int i, U& u) const { const int L = i * NWG + vcu; const int rb = L >> 2; if (rb >= nrbt) return false; u.rb = rb; u.pn = L & 3; u.ti = i; u.e = __builtin_amdgcn_readlane(ev, i); return true; }
    __device__ __forceinline__ int K(const U&) const { return DE; }
    __device__ __forceinline__ const char* rowA(const U& u, int r) const { return (const char*)(HID + (size_t)(u.rb * 256 + r) * DE); }
    __device__ __forceinline__ const char* rowB(const U& u, int r) const { return (const char*)(W2T + ((size_t)u.e * D + u.pn * 256 + r) * DE); }
};
struct EpiScatter {
    static constexpr int NVM = 16;
    bf16* YA; int dry;
    __device__ __forceinline__ void operator()(const AccT& acc, const UnitE& u, int wr, int wc, int fr, int fq) const {
        if (dry == 1) return;
        const size_t rbase = dry == 2 ? (size_t)(blockIdx.x * 256) : (size_t)u.rb * 256;
        ROWLOOP { unsigned char* rp = (unsigned char*)YA + (rbase + UROW) * D + u.pn * 256;
#pragma unroll
            for (int bj = 0; bj < 2; ++bj) { const f32x4 v0 = acc[ai][bj][m][0] * 16.0f, v1 = acc[ai][bj][m][1] * 16.0f; u32x2 w;
                int t0 = __builtin_amdgcn_cvt_pk_fp8_f32(v0.x, v0.y, 0, false); t0 = __builtin_amdgcn_cvt_pk_fp8_f32(v0.z, v0.w, t0, true);
                int t1 = __builtin_amdgcn_cvt_pk_fp8_f32(v1.x, v1.y, 0, false); t1 = __builtin_amdgcn_cvt_pk_fp8_f32(v1.z, v1.w, t1, true);
                w.x = (unsigned)t0; w.y = (unsigned)t1; *(u32x2*)(rp + UCOLP(bj)) = w; } }
    }
};

__device__ __forceinline__ int rho_to_tok(int rho, int g) { const int sh = 14 - 2 * g; const int rp = rho & 16383; return (rho & ~16383) + (rp >> sh) + ((rp & ((1 << sh) - 1)) << (2 * g)); }
__device__ __forceinline__ int tok_to_rho(int t, int g) { const int sh = 14 - 2 * g; const int tp = t & 16383; return (t & ~16383) + ((tp & ((1 << (2 * g)) - 1)) << sh) + (tp >> (2 * g)); }
struct UnitQ { int type, g, pm, pn; };
struct SchedQK {
    typedef UnitQ U;
    static constexpr bool GA = false, GB = false, PERM = true; static constexpr int Kk = D, ldb = D;
    const unsigned char* X; const unsigned char* WqkT; int g, lda, vcu;
    __device__ __forceinline__ bool next(int i, U& u) const { const int L = i * NWG + vcu; if (L >= 512) return false; u.type = 0; u.g = g; u.pm = L >> 2; u.pn = L & 3; return true; }
    __device__ __forceinline__ int K(const U&) const { return D; }
    __device__ __forceinline__ const char* baseA(const U& u) const { return (const char*)(X + (size_t)rho_to_tok(u.pm * 256, g) * D); }
    __device__ __forceinline__ const char* baseB(const U& u) const { return (const char*)(WqkT + ((size_t)g * 1024 + u.pn * 256) * D); }
    __device__ __forceinline__ const char* rowA(const U& u, int r) const { return (const char*)(X + (size_t)rho_to_tok(u.pm * 256 + r, g) * D); }
    __device__ __forceinline__ const char* rowB(const U& u, int r) const { return (const char*)(WqkT + ((size_t)g * 1024 + u.pn * 256 + r) * D); }
};
struct SchedVT {
    typedef UnitQ U;
    static constexpr bool GA = false, GB = false, PERM = true; static constexpr int Kk = D, lda = D;
    const unsigned char* X; const unsigned char* WvT; int g, ldb, vcu;
    __device__ __forceinline__ bool next(int i, U& u) const { const int L = i * NWG + vcu; if (L >= 256) return false; u.type = 1; u.g = g; u.pn = L >> 1; u.pm = L & 1; return true; }
    __device__ __forceinline__ int K(const U&) const { return D; }
    __device__ __forceinline__ const char* baseA(const U& u) const { return (const char*)(WvT + ((size_t)g * 512 + u.pm * 256) * D); }
    __device__ __forceinline__ const char* baseB(const U& u) const { return (const char*)(X + (size_t)rho_to_tok(u.pn * 256, g) * D); }
    __device__ __forceinline__ const char* rowA(const U& u, int r) const { return (const char*)(WvT + ((size_t)g * 512 + u.pm * 256 + r) * D); }
    __device__ __forceinline__ const char* rowB(const U& u, int r) const { return (const char*)(X + (size_t)rho_to_tok(u.pn * 256 + r, g) * D); }
};
struct EpiQKV {
    static constexpr int NVM = 16;
    bf16* QK; bf16* VT;
    __device__ __forceinline__ void operator()(const AccT& acc, const UnitQ& u, int wr, int wc, int fr, int fq) const {
        bf16* base; size_t ldc;
        if (u.type == 0) { base = QK + (size_t)u.g * M * 1024; ldc = 1024; } else { base = VT + (size_t)u.g * 512 * M; ldc = M; }
        ROWLOOP { bf16* rp = base + (size_t)(u.pm * 256 + UROW) * ldc + u.pn * 256;
#pragma unroll
            for (int bj = 0; bj < 2; ++bj) *(u32x4*)(rp + UCOLP(bj)) = pk8(acc[ai][bj][m][0] * 0.015625f, acc[ai][bj][m][1] * 0.015625f); }
    }
};

__device__ __forceinline__ void tr_item(const float* src, int spitch, bf16* dst, int dpitch, LAS float* scr, int lane) {
#pragma unroll 4
    for (int i = 0; i < 16; ++i) { const int k = 4 * i + (lane >> 4), n4 = (lane & 15) * 4; const f32x4 v = *(const f32x4*)(src + (size_t)k * spitch + n4);
        LAS float* s = scr + k * 65 + n4; s[0] = v.x; s[1] = v.y; s[2] = v.z; s[3] = v.w; }
    LDS_WAIT(); asm volatile("" ::: "memory");
    const int c = lane & 7;
#pragma unroll
    for (int j = 0; j < 8; ++j) { const int n = 8 * j + (lane >> 3); const LAS float* s = scr + (8 * c) * 65 + n;
        u32x4 o; o.x = pk2(s[0], s[65]); o.y = pk2(s[2 * 65], s[3 * 65]); o.z = pk2(s[4 * 65], s[5 * 65]); o.w = pk2(s[6 * 65], s[7 * 65]);
        *(u32x4*)(dst + (size_t)n * dpitch + 8 * c) = o; }
    LDS_WAIT(); asm volatile("" ::: "memory");
}
__device__ __forceinline__ void tr_item8(const float* src, int spitch, unsigned char* dst, int dpitch, LAS float* scr, int lane) {
#pragma unroll 4
    for (int i = 0; i < 16; ++i) { const int k = 4 * i + (lane >> 4), n4 = (lane & 15) * 4; const f32x4 v = *(const f32x4*)(src + (size_t)k * spitch + n4);
        LAS float* s = scr + k * 65 + n4; s[0] = v.x; s[1] = v.y; s[2] = v.z; s[3] = v.w; }
    LDS_WAIT(); asm volatile("" ::: "memory");
    const int c = lane & 7;
#pragma unroll
    for (int j = 0; j < 8; ++j) { const int n = 8 * j + (lane >> 3); const LAS float* s = scr + (8 * c) * 65 + n;
        int t0 = __builtin_amdgcn_cvt_pk_fp8_f32(s[0] * 64.f, s[65] * 64.f, 0, false); t0 = __builtin_amdgcn_cvt_pk_fp8_f32(s[2 * 65] * 64.f, s[3 * 65] * 64.f, t0, true);
        int t1 = __builtin_amdgcn_cvt_pk_fp8_f32(s[4 * 65] * 64.f, s[5 * 65] * 64.f, 0, false); t1 = __builtin_amdgcn_cvt_pk_fp8_f32(s[6 * 65] * 64.f, s[7 * 65] * 64.f, t1, true);
        u32x2 o; o.x = (unsigned)t0; o.y = (unsigned)t1; *(u32x2*)(dst + (size_t)n * dpitch + 8 * c) = o; }
    LDS_WAIT(); asm volatile("" ::: "memory");
}
template <class RowMap>
__device__ __forceinline__ void tr_matrix(Frame& F, const float* W, int K, int N, bf16* WT, int dpitch, RowMap drow) {
    LAS float* scr = (LAS float*)(F.lds + F.wave * 16640);
    const int nkb = K / 64, nnb = N / 64;
    for (int it = F.vcu * NWAVES + F.wave; it < nkb * nnb; it += NGW) { const int kb = it / nnb, nb = it % nnb;
        tr_item(W + (size_t)(kb * 64) * N + nb * 64, N, WT + (size_t)drow(nb * 64) * dpitch + kb * 64, dpitch, scr, F.lane); }
}
template <class RowMap>
__device__ __forceinline__ void tr_matrix8(Frame& F, const float* W, int K, int N, unsigned char* WT, int dpitch, RowMap drow) {
    LAS float* scr = (LAS float*)(F.lds + F.wave * 16640);
    const int nkb = K / 64, nnb = N / 64;
    for (int it = F.vcu * NWAVES + F.wave; it < nkb * nnb; it += NGW) { const int kb = it / nnb, nb = it % nnb;
        tr_item8(W + (size_t)(kb * 64) * N + nb * 64, N, WT + (size_t)drow(nb * 64) * dpitch + kb * 64, dpitch, scr, F.lane); }
}
__device__ __forceinline__ void convert_experts(Frame& F, const float* w1, const float* w3, const float* w2, const float* s1, const float* s3, const float* s2) {
    LAS float* scr = (LAS float*)(F.lds + F.wave * 16640);
    unsigned char* W13T = WSP(unsigned char, WS_W13); bf16* W2T = WSP(bf16, WS_W2);
    for (int it = F.vcu * NWAVES + F.wave; it < 257 * 192; it += NGW) {
        const int e = it / 192, r = it % 192, which = r >> 6, tile = r & 63;
        if (which < 2) {
            const float* W = (e < 256) ? (which == 0 ? w1 : w3) + (size_t)e * (size_t)(D * DE) : (which == 0 ? s1 : s3);
            const int kb = tile >> 2, nb = tile & 3; const int drow = (nb >> 1) * 256 + which * 128 + (nb & 1) * 64;
            tr_item8(W + (size_t)(kb * 64) * DE + nb * 64, DE, W13T + ((size_t)e * 512 + drow) * D + kb * 64, D, scr, F.lane);
        } else {
            const float* W = (e < 256) ? w2 + (size_t)e * (size_t)(DE * D) : s2;
            const int kb = tile >> 4, nb = tile & 15;
            tr_item(W + (size_t)(kb * 64) * D + nb * 64, D, W2T + ((size_t)e * D + nb * 64) * DE + kb * 64, DE, scr, F.lane);
        }
    }
}
struct MapId { __device__ int operator()(int n0) const { return n0; } };
struct MapGate { int which; __device__ int operator()(int n0) const { return (n0 >> 7) * 256 + which * 128 + (n0 & 127); } };
struct MapQ { __device__ int operator()(int n0) const { return (n0 >> 9) * 1024 + (n0 & 511); } };
struct MapKV { __device__ int operator()(int n0) const { return n0 < 1536 ? (n0 >> 9) * 1024 + 512 + (n0 & 511) : 3072 + (n0 - 1536); } };

__device__ __forceinline__ void p0_prologue(Frame& F, const Args& A) {
    { const float* x = A.in[0]; unsigned char* XQ = WSP(unsigned char, WS_RA + RA_XB);
      for (size_t i = (size_t)F.vcu * NTHR + F.tid; i < (size_t)M * D / 8; i += NGT) { const f32x4 a = *(const f32x4*)(x + i * 8), b = *(const f32x4*)(x + i * 8 + 4);
          int t0 = __builtin_amdgcn_cvt_pk_fp8_f32(a.x, a.y, 0, false); t0 = __builtin_amdgcn_cvt_pk_fp8_f32(a.z, a.w, t0, true);
          int t1 = __builtin_amdgcn_cvt_pk_fp8_f32(b.x, b.y, 0, false); t1 = __builtin_amdgcn_cvt_pk_fp8_f32(b.z, b.w, t1, true);
          u32x2 o; o.x = (unsigned)t0; o.y = (unsigned)t1; *(u32x2*)(XQ + i * 8) = o; } }
    tr_matrix8(F, A.in[1], D, 2048, WSP(unsigned char, WS_WIN), D, MapId());
    for (int b = 0; b < 4; ++b) { tr_matrix(F, A.in[4] + b * 65536, 256, 256, WSP(bf16, WS_WG) + (size_t)b * 512 * 256, 256, MapGate{0});
                                  tr_matrix(F, A.in[6] + b * 65536, 256, 256, WSP(bf16, WS_WG) + (size_t)b * 512 * 256, 256, MapGate{1}); }
    tr_matrix(F, A.in[9], D, D, WSP(bf16, WS_WOUT), D, MapId());
    tr_matrix8(F, A.in[11], D, QW, WSP(unsigned char, WS_WQK), D, MapQ());
    tr_matrix8(F, A.in[10], D, 2 * QW, WSP(unsigned char, WS_WQK), D, MapKV());
    tr_matrix(F, A.in[12], OW, D, WSP(bf16, WS_WO), OW, MapId());
    for (int l = 0; l < 2; ++l) tr_matrix(F, A.in[13] + (size_t)l * D * NE, D, NE, WSP(bf16, WS_WR) + (size_t)l * NE * D, D, MapId());
    convert_experts(F, A.in[15], A.in[16], A.in[17], A.in[18], A.in[19], A.in[20]);
}
static_assert(WS_WV == WS_WQK + (size_t)3072 * 1024 * 2, "WvT must follow WqkT");

__device__ __forceinline__ void ln_store(f32x4 (&v)[4], const float* g, const float* b, float* of, bf16* ob, int lane, unsigned char* oq = nullptr) {
    float s = 0.f;
#pragma unroll
    for (int j = 0; j < 4; ++j) s += (v[j].x + v[j].y) + (v[j].z + v[j].w);
    const float mean = wave_sum(s) * (1.f / D); float s2 = 0.f;
#pragma unroll
    for (int j = 0; j < 4; ++j) { v[j] = v[j] - mean; s2 += (v[j].x * v[j].x + v[j].y * v[j].y) + (v[j].z * v[j].z + v[j].w * v[j].w); }
    const float rstd = 1.f / sqrtf(wave_sum(s2) * (1.f / D) + LN_EPS);
#pragma unroll
    for (int j = 0; j < 4; ++j) { const int c = 4 * lane + 256 * j; const f32x4 gg = *(const f32x4*)(g + c), bb = *(const f32x4*)(b + c); const f32x4 y = v[j] * rstd * gg + bb;
        if (of) *(f32x4*)(of + c) = y;
        if (ob) { u32x2 w; w.x = pk2(y.x, y.y); w.y = pk2(y.z, y.w); *(u32x2*)(ob + c) = w; }
        if (oq) { int t = __builtin_amdgcn_cvt_pk_fp8_f32(y.x, y.y, 0, false); t = __builtin_amdgcn_cvt_pk_fp8_f32(y.z, y.w, t, true); *(unsigned*)(oq + c) = (unsigned)t; } }
}

__device__ __forceinline__ int moe_unit_experts(Frame& F, const int* BLKE, int nrbt, int shift) { const int L = F.lane * NWG + F.vcu; const int rb = L >> shift; return rb < nrbt ? BLKE[rb] : 0; }
__device__ __forceinline__ const LAS unsigned* moe_row_table(Frame& F, const int* ROWA, int nrbt) {
    LAS unsigned* tab = (LAS unsigned*)(F.lds + 131072);
    for (int i = 0; i < 15; ++i) { const int rb = (i * NWG + F.vcu) >> 1; if (rb >= nrbt) break;
        if (F.tid < 256) { const int a = ROWA[rb * 256 + F.tid]; const int tok = a < 0 ? 0 : (a < 8 * M ? (a >> 3) : a - 8 * M); tab[i * 256 + F.tid] = (unsigned)tok * (unsigned)D; } }
    __syncthreads();
    return tab;
}
__device__ __forceinline__ void p_conv(Frame& F, const float* cw, const float* cb) {
    const bf16* XR = WSP(bf16, WS_RA + RA_XR); bf16* XC = WSP(bf16, WS_RA + RA_XC);
    for (int i = F.vcu * NTHR + F.tid; i < M * (D / 8); i += NGT) { const int t = i >> 7, c = (i & 127) * 8; const int ts = t & (SEQ - 1);
        float a[8];
#pragma unroll
        for (int q = 0; q < 8; ++q) a[q] = cb[c + q];
#pragma unroll
        for (int j = 0; j < 4; ++j) { if (ts - 3 + j >= 0) { const u32x4 w = *(const u32x4*)(XR + (size_t)(t - 3 + j) * D + c); const float* wj = cw + j * D + c;
            a[0] += wj[0] * bf_lo(w.x); a[1] += wj[1] * bf_hi(w.x); a[2] += wj[2] * bf_lo(w.y); a[3] += wj[3] * bf_hi(w.y);
            a[4] += wj[4] * bf_lo(w.z); a[5] += wj[5] * bf_hi(w.z); a[6] += wj[6] * bf_lo(w.w); a[7] += wj[7] * bf_hi(w.w); } }
        u32x4 o; o.x = pk2(a[0], a[1]); o.y = pk2(a[2], a[3]); o.z = pk2(a[4], a[5]); o.w = pk2(a[6], a[7]); *(u32x4*)(XC + (size_t)t * D + c) = o; }
}
constexpr int CH = 64, NCH = SEQ / CH;
__device__ __forceinline__ void p_scan1(Frame& F) {
    const bf16* LA = WSP(bf16, WS_RA + RA_LA); const bf16* UU = WSP(bf16, WS_RA + RA_U); float* CP = WSP(float, WS_CHP); float* CHh = WSP(float, WS_CHH);
    for (int i = F.vcu * NTHR + F.tid; i < BATCH * NCH * (D / 4); i += NGT) { const int c4 = (i & 255) * 4, ck = (i >> 8) & (NCH - 1), b = i >> 16;
        const size_t r0 = ((size_t)b * SEQ + (size_t)ck * CH) * D + c4; f32x4 h = {0.f, 0.f, 0.f, 0.f}, sl = {0.f, 0.f, 0.f, 0.f};
#pragma unroll 8
        for (int t = 0; t < CH; ++t) { const u32x2 lw = *(const u32x2*)(LA + r0 + (size_t)t * D), uw = *(const u32x2*)(UU + r0 + (size_t)t * D);
            const f32x4 la = {bf_lo(lw.x), bf_hi(lw.x), bf_lo(lw.y), bf_hi(lw.y)}, u = {bf_lo(uw.x), bf_hi(uw.x), bf_lo(uw.y), bf_hi(uw.y)};
#pragma unroll
            for (int j = 0; j < 4; ++j) { h[j] = __expf(la[j]) * h[j] + u[j]; sl[j] += la[j]; } }
#pragma unroll
        for (int j = 0; j < 4; ++j) { const size_t o = ((size_t)b * D + c4 + j) * NCH + ck; CP[o] = __expf(sl[j]); CHh[o] = h[j]; } }
}
__device__ __forceinline__ void p_scan2(Frame& F) {
    const float* CP = WSP(float, WS_CHP); const float* CHh = WSP(float, WS_CHH); float* CIN = WSP(float, WS_CIN);
    for (int s = F.vcu * NWAVES + F.wave; s < BATCH * D; s += NGW) { const size_t o = (size_t)s * NCH + 4 * F.lane;
        const f32x4 p4 = *(const f32x4*)(CP + o), h4 = *(const f32x4*)(CHh + o);
        float p = p4.x, h = h4.x; h = p4.y * h + h4.y; p *= p4.y; h = p4.z * h + h4.z; p *= p4.z; h = p4.w * h + h4.w; p *= p4.w;
#pragma unroll
        for (int off = 1; off < 64; off <<= 1) { const float pp = __shfl_up(p, off), hp = __shfl_up(h, off); if (F.lane >= off) { h = p * hp + h; p = pp * p; } }
        float c0 = __shfl_up(h, 1); if (F.lane == 0) c0 = 0.f;
        f32x4 ci; ci.x = c0; ci.y = p4.x * ci.x + h4.x; ci.z = p4.y * ci.y + h4.y; ci.w = p4.z * ci.z + h4.z;
        *(f32x4*)(CIN + o) = ci; }
}
__device__ __forceinline__ void p_scan3(Frame& F) {
    const bf16* LA = WSP(bf16, WS_RA + RA_LA); const bf16* UU = WSP(bf16, WS_RA + RA_U); const float* CIN = WSP(float, WS_CIN);
    const bf16* GG = WSP(bf16, WS_RA + RA_GG); bf16* YB = WSP(bf16, WS_RA + RA_YB);
    for (int i = F.vcu * NTHR + F.tid; i < BATCH * NCH * (D / 4); i += NGT) { const int c4 = (i & 255) * 4, ck = (i >> 8) & (NCH - 1), b = i >> 16;
        const size_t r0 = ((size_t)b * SEQ + (size_t)ck * CH) * D + c4; f32x4 h;
#pragma unroll
        for (int j = 0; j < 4; ++j) h[j] = CIN[((size_t)b * D + c4 + j) * NCH + ck];
#pragma unroll 1
        for (int t0 = 0; t0 < CH; t0 += 8) { u32x2 lw[8], uw[8], gw[8];
#pragma unroll
            for (int k = 0; k < 8; ++k) { const size_t o = r0 + (size_t)(t0 + k) * D; lw[k] = *(const u32x2*)(LA + o); uw[k] = *(const u32x2*)(UU + o); gw[k] = *(const u32x2*)(GG + o); }
#pragma unroll
            for (int k = 0; k < 8; ++k) { const f32x4 la = {bf_lo(lw[k].x), bf_hi(lw[k].x), bf_lo(lw[k].y), bf_hi(lw[k].y)}, u = {bf_lo(uw[k].x), bf_hi(uw[k].x), bf_lo(uw[k].y), bf_hi(uw[k].y)};
#pragma unroll
                for (int j = 0; j < 4; ++j) h[j] = __expf(la[j]) * h[j] + u[j];
                u32x2 o; o.x = pk2(h.x * bf_lo(gw[k].x), h.y * bf_hi(gw[k].x)); o.y = pk2(h.z * bf_lo(gw[k].y), h.w * bf_hi(gw[k].y)); *(u32x2*)(YB + r0 + (size_t)(t0 + k) * D) = o; } } }
}
__device__ __forceinline__ void p_ln(Frame& F, const float* V, const float* g, const float* b, float* Hf, bf16* Hb) {
    unsigned char* Hq = WSP(unsigned char, WS_HQ);
    for (int r = F.vcu * NWAVES + F.wave; r < M; r += NGW) { const f32x4* xr = (const f32x4*)(V + (size_t)r * D) + F.lane; f32x4 v[4];
#pragma unroll
        for (int j = 0; j < 4; ++j) v[j] = xr[64 * j];
        ln_store(v, g, b, Hf + (size_t)r * D, Hb + (size_t)r * D, F.lane, Hq + (size_t)r * D); }
}
template <int CTRL> __device__ __forceinline__ float dppf(float x) { return __builtin_bit_cast(float, __builtin_amdgcn_mov_dpp(__builtin_bit_cast(int, x), CTRL, 0xF, 0xF, true)); }
template <int CTRL> __device__ __forceinline__ unsigned dppu(unsigned x) { return (unsigned)__builtin_amdgcn_mov_dpp((int)x, CTRL, 0xF, 0xF, true); }
__device__ __forceinline__ float rdlane_f(float x, int l) { return __builtin_bit_cast(float, __builtin_amdgcn_readlane(__builtin_bit_cast(int, x), l)); }
__device__ __forceinline__ void p_route(Frame& F, const float* bias) {
    const float* LG = WSP(float, WS_LOGITS); int* TOPI = WSP(int, WS_TOPI); float* GATE = WSP(float, WS_GATE); int* HIST = WSP(int, WS_HIST);
    LAS int* hist = (LAS int*)F.lds; const int lane = F.lane;
    if (F.tid < 256) hist[F.tid] = 0;
    __syncthreads();
    const f32x4 bv = *(const f32x4*)(bias + 4 * lane);
#pragma unroll 2
    for (int j = 0; j < 16; ++j) { const int t = F.vcu * 128 + F.wave * 16 + j;
        const f32x4 z = *(const f32x4*)(LG + (size_t)t * NE + 4 * lane);
        const float s0 = sigmoidf_(z.x), s1 = sigmoidf_(z.y), s2 = sigmoidf_(z.z), s3 = sigmoidf_(z.w);
        const float v0 = s0 + bv.x, v1 = s1 + bv.y, v2 = s2 + bv.z, v3 = s3 + bv.w;
        float m1, m2; { const float a = fmaxf(v0, v1), b = fminf(v0, v1), c = fmaxf(v2, v3), d = fminf(v2, v3); m1 = fmaxf(a, c); m2 = fmaxf(fminf(a, c), fmaxf(b, d)); }
        { float o1 = dppf<0xB1>(m1), o2 = dppf<0xB1>(m2); float n1 = fmaxf(m1, o1), n2 = fmaxf(fminf(m1, o1), fmaxf(m2, o2)); m1 = n1; m2 = n2;
          o1 = dppf<0x4E>(m1); o2 = dppf<0x4E>(m2); n1 = fmaxf(m1, o1); n2 = fmaxf(fminf(m1, o1), fmaxf(m2, o2)); m1 = n1; m2 = n2;
          o1 = dppf<0x141>(m1); o2 = dppf<0x141>(m2); n1 = fmaxf(m1, o1); n2 = fmaxf(fminf(m1, o1), fmaxf(m2, o2)); m1 = n1; m2 = n2; }
        const float gs = m1 + m2; const int g = lane >> 3; int rank = 0;
#pragma unroll
        for (int q = 0; q < 8; ++q) { const float o = rdlane_f(gs, 8 * q); rank += (o > gs || (o == gs && q < g)) ? 1 : 0; }
        const bool sel = rank < 4;
        const unsigned ib = 255u - 4u * (unsigned)lane;
        unsigned k0 = sel ? ((__float_as_uint(v0 + 1.0f) & ~255u) | ib) : 0u, k1 = sel ? ((__float_as_uint(v1 + 1.0f) & ~255u) | (ib - 1u)) : 0u;
        unsigned k2 = sel ? ((__float_as_uint(v2 + 1.0f) & ~255u) | (ib - 2u)) : 0u, k3 = sel ? ((__float_as_uint(v3 + 1.0f) & ~255u) | (ib - 3u)) : 0u;
        int myidx = 0; float mys = 0.f, tot = 0.f;
#pragma unroll
        for (int k = 0; k < TOPK; ++k) {
            unsigned mk = max(max(k0, k1), max(k2, k3));
            mk = max(mk, dppu<0xB1>(mk)); mk = max(mk, dppu<0x4E>(mk)); mk = max(mk, dppu<0x141>(mk)); mk = max(mk, dppu<0x140>(mk));
            const unsigned win = max(max((unsigned)__builtin_amdgcn_readlane((int)mk, 0), (unsigned)__builtin_amdgcn_readlane((int)mk, 16)), max((unsigned)__builtin_amdgcn_readlane((int)mk, 32), (unsigned)__builtin_amdgcn_readlane((int)mk, 48)));
            const int idx = 255 - (int)(win & 255u);
            k0 = (k0 == win) ? 0u : k0; k1 = (k1 == win) ? 0u : k1; k2 = (k2 == win) ? 0u : k2; k3 = (k3 == win) ? 0u : k3;
            const int qq = idx & 3; const float sq = qq == 0 ? s0 : (qq == 1 ? s1 : (qq == 2 ? s2 : s3)); const float sw = rdlane_f(sq, idx >> 2);
            tot += sw; if (lane == k) { myidx = idx; mys = sw; }
        }
        if (lane < TOPK) { TOPI[t * TOPK + lane] = myidx; GATE[t * TOPK + lane] = mys / tot * 2.5f; atomicAdd((int*)&hist[myidx], 1); }
    }
    __syncthreads();
    if (F.tid < 256) HIST[F.vcu * 256 + F.tid] = hist[F.tid];
    __syncthreads();
}
__device__ __forceinline__ void p_sort(Frame& F) {
    const int* HIST = WSP(int, WS_HIST); const int* TOPI = WSP(int, WS_TOPI); int* ROWA = WSP(int, WS_ROWA); int* POS = WSP(int, WS_POS); int* BLKE = WSP(int, WS_BLKE); int* META = WSP(int, WS_META);
    LAS int* cnt = (LAS int*)F.lds; LAS int* myoff = cnt + 256; LAS int* nb = cnt + 512; LAS int* blk0 = cnt + 768; LAS int* lcnt = cnt + 1024;
    { typedef int i32x4 __attribute__((ext_vector_type(4)));
      const int q = F.tid >> 6, l = F.tid & 63; i32x4 c = {0, 0, 0, 0}, mo = {0, 0, 0, 0};
#pragma unroll 8
      for (int w = q; w < NWG; w += 8) { const i32x4 h = *(const i32x4*)(HIST + w * 256 + 4 * l); c += h; if (w < F.vcu) mo += h; }
      LAS int* redc = cnt + 1280; LAS int* redm = redc + 2048;
#pragma unroll
      for (int j = 0; j < 4; ++j) { redc[q * 256 + 4 * l + j] = c[j]; redm[q * 256 + 4 * l + j] = mo[j]; }
      __syncthreads();
      if (F.tid < 256) { const int e = F.tid; int cc = 0, mm = 0;
#pragma unroll
          for (int k = 0; k < 8; ++k) { cc += redc[k * 256 + e]; mm += redm[k * 256 + e]; }
          cnt[e] = cc; myoff[e] = mm; nb[e] = (cc + 255) >> 8; lcnt[e] = 0; } }
    __syncthreads();
    if (F.tid < 256) { int b = 0; for (int j = 0; j < F.tid; ++j) b += nb[j]; blk0[F.tid] = b; }
    __syncthreads();
    for (int al = F.tid; al < 1024; al += NTHR) { const int a = F.vcu * 1024 + al; const int e = TOPI[a]; const int pos = blk0[e] * 256 + myoff[e] + atomicAdd((int*)&lcnt[e], 1); ROWA[pos] = a; POS[a] = pos; }
    const int nrb = blk0[255] + nb[255];
    { const int e = F.vcu; const int start = blk0[e] * 256 + cnt[e], end = (blk0[e] + nb[e]) * 256;
      for (int p = start + F.tid; p < end; p += NTHR) ROWA[p] = -1;
      for (int j = F.tid; j < nb[e]; j += NTHR) BLKE[blk0[e] + j] = e; }
    for (int tl = F.tid; tl < 128; tl += NTHR) { const int t = F.vcu * 128 + tl; ROWA[nrb * 256 + t] = 8 * M + t; }
    if (F.vcu == 0) { for (int j = F.tid; j < 128; j += NTHR) BLKE[nrb + j] = 256; if (F.tid == 0) META[0] = nrb + 128; }
    __syncthreads();
}
__device__ __forceinline__ void p_combine(Frame& F, const float* Hin, const float* g, const float* b, float* Hf, unsigned char* Hq) {
    const bf16* YA = WSP(bf16, WS_RA); const float* GATE = WSP(float, WS_GATE); const int* POS = WSP(int, WS_POS); const int shrow0 = (*WSP(int, WS_META) - 128) * 256;
    for (int t = F.vcu * NWAVES + F.wave; t < M; t += NGW) { f32x4 v[4];
        const f32x4* hr = (const f32x4*)(Hin + (size_t)t * D) + F.lane;
#pragma unroll
        for (int j = 0; j < 4; ++j) v[j] = hr[64 * j] * ALPHA;
        f32x4 r[4];
#pragma unroll
        for (int j = 0; j < 4; ++j) r[j] = (f32x4){0.f, 0.f, 0.f, 0.f};
#pragma unroll
        for (int k = 0; k < TOPK; ++k) { const float gk = GATE[t * TOPK + k] * 0.0625f; const unsigned* yr = (const unsigned*)((const unsigned char*)YA + (size_t)POS[t * TOPK + k] * D) + F.lane;
#pragma unroll
            for (int j = 0; j < 4; ++j) { const unsigned w = yr[64 * j]; const f32x2 a = __builtin_amdgcn_cvt_pk_f32_fp8((int)w, false), c = __builtin_amdgcn_cvt_pk_f32_fp8((int)w, true);
                r[j].x += gk * a.x; r[j].y += gk * a.y; r[j].z += gk * c.x; r[j].w += gk * c.y; } }
        { const unsigned* yr = (const unsigned*)((const unsigned char*)YA + (size_t)(shrow0 + t) * D) + F.lane;
#pragma unroll
            for (int j = 0; j < 4; ++j) { const unsigned w = yr[64 * j]; const f32x2 a = __builtin_amdgcn_cvt_pk_f32_fp8((int)w, false), c = __builtin_amdgcn_cvt_pk_f32_fp8((int)w, true);
                v[j].x += r[j].x + 0.0625f * a.x; v[j].y += r[j].y + 0.0625f * a.y; v[j].z += r[j].z + 0.0625f * c.x; v[j].w += r[j].w + 0.0625f * c.y; } }
        ln_store(v, g, b, Hf + (size_t)t * D, nullptr, F.lane, Hq ? Hq + (size_t)t * D : nullptr); }
}
constexpr int AT_KP = 144, AT_VP = 784, AT_KBYTES = 384 * AT_KP, AT_VOFF = AT_KBYTES;
__device__ __forceinline__ void p_attn(Frame& F) {
    const bf16* QKb = WSP(bf16, WS_RA + RA_QK); const bf16* VTb = WSP(bf16, WS_RA + RA_VT); bf16* OGb = WSP(bf16, WS_RA + RA_OG); float* LSE = WSP(float, WS_LSE);
    const int lane = F.lane, q = lane & 31, hh = lane >> 5, w = F.wave;
    LAS unsigned char* lk = F.lds; LAS unsigned char* lv = F.lds + AT_VOFF;
#pragma unroll 1
    for (int it = F.vcu; it < 3 * 128 * 8; it += NWG) {
        const int g = it >> 10, rem = it & 1023, chunk = rem >> 3, h = rem & 7;
        const int sh = 14 - 2 * g, rq0 = chunk * 256, i0 = rq0 & ((1 << sh) - 1), rk0 = rq0 - 128;
        const bf16* QK = QKb + (size_t)g * M * 1024; const bf16* VT = VTb + (size_t)g * 512 * M;
        { const char* kb = (const char*)(QK + 512 + h * 64);
#pragma unroll
          for (int j = 0; j < 7; ++j) { const int ins = w + 8 * j; if (ins < 54) { const int p = ins * 64 + lane, row = p / 9, cc = p - row * 9; const int gr = rk0 + row < 0 ? 0 : rk0 + row;
              __builtin_amdgcn_global_load_lds((const unsigned*)(kb + (size_t)gr * 2048 + (cc > 7 ? 7 : cc) * 16), (LAS unsigned*)(lk + ins * 1024), 16, 0, 0); } }
          const char* vb = (const char*)(VT + (size_t)(h * 64) * M);
#pragma unroll
          for (int j = 0; j < 7; ++j) { const int ins = w + 8 * j; if (ins < 49) { const int p = ins * 64 + lane, row = p / 49, cc = p - row * 49; int col = rk0 + (cc > 47 ? 47 : cc) * 8; col = col < 0 ? 0 : col;
              __builtin_amdgcn_global_load_lds((const unsigned*)(vb + ((size_t)row * M + col) * 2), (LAS unsigned*)(lv + ins * 1024), 16, 0, 0); } } }
        bf16x8 Qf[4];
        { const bf16* qp = QK + (size_t)(rq0 + 32 * w + q) * 1024 + h * 64 + 8 * hh;
#pragma unroll
          for (int s2 = 0; s2 < 4; ++s2) Qf[s2] = *(const bf16x8*)(qp + 16 * s2); }
        asm volatile("s_waitcnt vmcnt(0)" ::: "memory");
        __syncthreads();
        const float slope2 = exp2f(-(float)(h + 1)) * (float)(1 << (2 * g)) * 1.4426950408889634f, sc = 0.125f * 1.4426950408889634f;
        float m_run = -1e30f, l_run = 0.f; f32x16 O0, O1;
#pragma unroll
        for (int r = 0; r < 16; ++r) { O0[r] = 0.f; O1[r] = 0.f; }
#pragma unroll 1
        for (int kt = 0; kt < 5; ++kt) { const int kr0 = 32 * w + 32 * kt; if (i0 + kr0 - 128 < 0) continue;
            bf16x8 Kf[4];
            { const LAS unsigned char* kp = lk + (kr0 + q) * AT_KP + 16 * hh;
#pragma unroll
              for (int s2 = 0; s2 < 4; ++s2) Kf[s2] = *(const LAS bf16x8*)(kp + 32 * s2); }
            bf16x8 Vf[2][2];
#pragma unroll
            for (int dd = 0; dd < 2; ++dd)
#pragma unroll
                for (int s2 = 0; s2 < 2; ++s2) { const LAS unsigned char* vp = lv + (32 * dd + q) * AT_VP + (kr0 + 16 * s2 + 4 * hh) * 2;
                    const u32x2 lo = *(const LAS u32x2*)vp, hi = *(const LAS u32x2*)(vp + 16); u32x4 wv; wv.x = lo.x; wv.y = lo.y; wv.z = hi.x; wv.w = hi.y; Vf[dd][s2] = __builtin_bit_cast(bf16x8, wv); }
            f32x16 S;
#pragma unroll
            for (int r = 0; r < 16; ++r) S[r] = 0.f;
#pragma unroll
            for (int s2 = 0; s2 < 4; ++s2) S = __builtin_amdgcn_mfma_f32_32x32x16_bf16(Kf[s2], Qf[s2], S, 0, 0, 0);
            float mx = -1e30f;
#pragma unroll
            for (int r = 0; r < 16; ++r) { const int krow = (r & 3) + 8 * (r >> 2) + 4 * hh; const int dist = 128 - 32 * kt + q - krow;
                const float sv = (dist >= 0 && dist <= 128) ? S[r] * sc - slope2 * (float)dist : -1e30f; S[r] = sv; mx = fmaxf(mx, sv); }
            mx = fmaxf(mx, __shfl_xor(mx, 32));
            const float m_new = fmaxf(m_run, mx), alpha = exp2f(m_run - m_new); float rs = 0.f;
#pragma unroll
            for (int r = 0; r < 16; ++r) { const float p = exp2f(S[r] - m_new); S[r] = p; rs += p; }
            rs += __shfl_xor(rs, 32);
            l_run = l_run * alpha + rs; m_run = m_new;
#pragma unroll
            for (int r = 0; r < 16; ++r) { O0[r] *= alpha; O1[r] *= alpha; }
            bf16x8 Pf[2];
#pragma unroll
            for (int s2 = 0; s2 < 2; ++s2) { u32x4 wv; wv.x = pk2(S[8 * s2 + 0], S[8 * s2 + 1]); wv.y = pk2(S[8 * s2 + 2], S[8 * s2 + 3]); wv.z = pk2(S[8 * s2 + 4], S[8 * s2 + 5]); wv.w = pk2(S[8 * s2 + 6], S[8 * s2 + 7]); Pf[s2] = __builtin_bit_cast(bf16x8, wv); }
#pragma unroll
            for (int s2 = 0; s2 < 2; ++s2) { O0 = __builtin_amdgcn_mfma_f32_32x32x16_bf16(Vf[0][s2], Pf[s2], O0, 0, 0, 0); O1 = __builtin_amdgcn_mfma_f32_32x32x16_bf16(Vf[1][s2], Pf[s2], O1, 0, 0, 0); }
        }
        const float inv = 1.0f / l_run;
        bf16* op = OGb + ((size_t)g * M + rq0 + 32 * w + q) * 512 + h * 64 + 4 * hh;
#pragma unroll
        for (int rg = 0; rg < 4; ++rg) { u32x2 wv; wv.x = pk2(O0[4 * rg] * inv, O0[4 * rg + 1] * inv); wv.y = pk2(O0[4 * rg + 2] * inv, O0[4 * rg + 3] * inv); *(u32x2*)(op + 8 * rg) = wv;
            u32x2 w1; w1.x = pk2(O1[4 * rg] * inv, O1[4 * rg + 1] * inv); w1.y = pk2(O1[4 * rg + 2] * inv, O1[4 * rg + 3] * inv); *(u32x2*)(op + 32 + 8 * rg) = w1; }
        if (hh == 0) LSE[((size_t)g * M + rq0 + 32 * w + q) * 8 + h] = (m_run + log2f(l_run)) * 0.6931471805599453f;
        __syncthreads();
    }
}
__device__ __forceinline__ void p_merge(Frame& F) {
    const bf16* OGb = WSP(bf16, WS_RA + RA_OG); const float* LSE = WSP(float, WS_LSE); bf16* OM = WSP(bf16, WS_RA + RA_OM);
    for (int t = F.vcu * NWAVES + F.wave; t < M; t += NGW) { const int hd = F.lane >> 3; float ls[3]; size_t ro[3];
#pragma unroll
        for (int g = 0; g < 3; ++g) { const int rho = tok_to_rho(t, g); ro[g] = ((size_t)g * M + rho); ls[g] = LSE[ro[g] * 8 + hd]; }
        const float mx = fmaxf(ls[0], fmaxf(ls[1], ls[2])); float w[3], ws = 0.f;
#pragma unroll
        for (int g = 0; g < 3; ++g) { w[g] = __expf(ls[g] - mx); ws += w[g]; }
        const float inv = 1.0f / ws; float o[8];
#pragma unroll
        for (int j = 0; j < 8; ++j) o[j] = 0.f;
#pragma unroll
        for (int g = 0; g < 3; ++g) { const u32x4 x = *(const u32x4*)(OGb + ro[g] * 512 + 8 * F.lane); const float wg = w[g] * inv;
            o[0] += wg * bf_lo(x.x); o[1] += wg * bf_hi(x.x); o[2] += wg * bf_lo(x.y); o[3] += wg * bf_hi(x.y); o[4] += wg * bf_lo(x.z); o[5] += wg * bf_hi(x.z); o[6] += wg * bf_lo(x.w); o[7] += wg * bf_hi(x.w); }
        u32x4 r; r.x = pk2(o[0], o[1]); r.y = pk2(o[2], o[3]); r.z = pk2(o[4], o[5]); r.w = pk2(o[6], o[7]); *(u32x4*)(OM + (size_t)t * OW + 8 * F.lane) = r; }
}

constexpr int NPHASE = 26;

__global__ void __launch_bounds__(NTHR, 2) yoco_fwd(Args args) {
    extern __shared__ __attribute__((aligned(16))) unsigned char lds[];
    Frame F;
    F.lds = (LAS unsigned char*)lds;
    F.tid = threadIdx.x; F.lane = F.tid & 63; F.wave = __builtin_amdgcn_readfirstlane(F.tid >> 6);
    { const int bx = blockIdx.x; F.vcu = (bx % 8) * (NWG / 8) + bx / 8; }
    F.ws = args.ws;
    volatile LAS unsigned* MISC = (volatile LAS unsigned*)(F.lds + LDS_BYTES - 64);
    if (F.tid < 16) MISC[F.tid] = 0u;
    __syncthreads();
    const int lo = args.ph_lo, hi = args.ph_hi;
    XcdBarrier bar; bar.bar = (unsigned*)(F.ws + WS_CTL) + 4096; bar.x = 0; bar.st = nullptr;
    if (hi - lo > 1) bar = xcd_barrier_post((unsigned*)(F.ws + WS_CTL) + 4096, MISC + 8);
#ifndef PROBE_G2
#define PROBE_G2 0
#endif
#ifndef DUP_MASK
#define DUP_MASK 0u
#endif
#ifndef PH_MASK
#define PH_MASK 0xFFFFFFFFu
#endif
#define IN(k) (((PH_MASK >> (k)) & 1u) && lo <= (k) && (k) < hi)
#define REP(k) for (int rep = 0, nrep = 1 + (int)((args.dup >> (k)) & 1u); rep < nrep; ++rep)
#define SEAM(k) do { if (IN(k) && IN((k) + 1)) xcd_barrier(bar); } while (0)

    if (IN(0)) { p0_prologue(F, args); } SEAM(0);
    if (IN(1)) { SchedDense8 S{WSP(unsigned char, WS_RA + RA_XB), WSP(unsigned char, WS_WIN), D, D, D, M / 256, 8, F.vcu}; EpiXZ E{WSP(bf16, WS_RA + RA_XR), WSP(bf16, WS_RA + RA_GG)}; gemm_fast8(F.lds, S, E); } SEAM(1);
    if (IN(2)) { p_conv(F, args.in[2], args.in[3]); } SEAM(2);
    if (IN(3)) { SchedGate S{WSP(bf16, WS_RA + RA_XC), WSP(bf16, WS_WG), F.vcu}; EpiGate E{WSP(bf16, WS_RA + RA_XC), args.in[5], args.in[7], args.in[8], WSP(bf16, WS_RA + RA_LA), WSP(bf16, WS_RA + RA_U)}; GEMM_PHASE(F.lds, S, E); } SEAM(3);
    if (IN(4)) { p_scan1(F); } SEAM(4);
    if (IN(5)) { p_scan2(F); } SEAM(5);
    if (IN(6)) { p_scan3(F); } SEAM(6);
    if (IN(7)) { SchedDense S{WSP(bf16, WS_RA + RA_YB), WSP(bf16, WS_WOUT), D, D, D, M / 256, 4, F.vcu}; EpiResF32 E{args.in[0], WSP(float, WS_V), D}; GEMM_PHASE(F.lds, S, E); } SEAM(7);
    if (IN(8)) { p_ln(F, WSP(float, WS_V), args.in[21] + 0 * D, args.in[22] + 0 * D, WSP(float, WS_HA), WSP(bf16, WS_HAB)); } SEAM(8);
    if (IN(9)) { SchedDense S{WSP(bf16, WS_HAB), WSP(bf16, WS_WR), D, D, D, M / 256, 1, F.vcu}; EpiF32 E{WSP(float, WS_LOGITS), NE}; GEMM_PHASE(F.lds, S, E); } SEAM(9);
    if (IN(10)) { p_route(F, args.in[14]); } SEAM(10);
    if (IN(11)) { p_sort(F); } SEAM(11);
    if (IN(12)) { const int nrbt = *WSP(int, WS_META); SchedG1 S{WSP(unsigned char, WS_HQ), WSP(unsigned char, WS_W13), WSP(int, WS_ROWA), WSP(int, WS_BLKE), nrbt, F.vcu, moe_unit_experts(F, WSP(int, WS_BLKE), nrbt, 1), moe_row_table(F, WSP(int, WS_ROWA), nrbt)}; EpiSwiGLU E{WSP(bf16, WS_HID)}; gemm_fast8(F.lds, S, E); } SEAM(12);
    if (IN(13)) { const int nrbt = *WSP(int, WS_META); SchedG2 S{WSP(bf16, WS_HID), WSP(bf16, WS_W2), WSP(int, WS_BLKE), nrbt, F.vcu, moe_unit_experts(F, WSP(int, WS_BLKE), nrbt, 2)}; EpiScatter E{WSP(bf16, WS_RA), 0}; GEMM_PHASE(F.lds, S, E); if (PROBE_G2) { __syncthreads(); EpiScatter E2{(PROBE_G2 == 2 || PROBE_G2 == 4) ? WSP(bf16, WS_V) : WSP(bf16, WS_RA), PROBE_G2 == 3 ? 0 : PROBE_G2}; GEMM_PHASE(F.lds, S, E2); } } SEAM(13);
    if (IN(14)) { p_combine(F, WSP(float, WS_HA), args.in[21] + 1 * D, args.in[22] + 1 * D, WSP(float, WS_HB), WSP(unsigned char, WS_HQ)); convert_experts(F, args.in[15] + (size_t)NE * D * DE, args.in[16] + (size_t)NE * D * DE, args.in[17] + (size_t)NE * D * DE, args.in[18] + (size_t)D * DE, args.in[19] + (size_t)D * DE, args.in[20] + (size_t)D * DE); } SEAM(14);
    if (IN(15)) { EpiQKV E{WSP(bf16, WS_RA + RA_QK), WSP(bf16, WS_RA + RA_VT)}; for (int g = 0; g < 3; ++g) { SchedQK S{WSP(unsigned char, WS_HQ), WSP(unsigned char, WS_WQK), g, D << (2 * g), F.vcu}; gemm_fast8(F.lds, S, E); } for (int g = 0; g < 3; ++g) { SchedVT S{WSP(unsigned char, WS_HQ), WSP(unsigned char, WS_WQK) + (size_t)3072 * D, g, D << (2 * g), F.vcu}; gemm_fast8(F.lds, S, E); } } SEAM(15);
    if (IN(16)) { p_attn(F); } SEAM(16);
    if (IN(17)) { p_merge(F); } SEAM(17);
    if (IN(18)) { SchedDense S{WSP(bf16, WS_RA + RA_OM), WSP(bf16, WS_WO), OW, OW, OW, M / 256, 4, F.vcu}; EpiResF32 E{WSP(float, WS_HB), WSP(float, WS_V), D}; GEMM_PHASE(F.lds, S, E); } SEAM(18);
    if (IN(19)) { p_ln(F, WSP(float, WS_V), args.in[21] + 2 * D, args.in[22] + 2 * D, WSP(float, WS_HA), WSP(bf16, WS_HAB)); } SEAM(19);
    if (IN(20)) { SchedDense S{WSP(bf16, WS_HAB), WSP(bf16, WS_WR) + (size_t)NE * D, D, D, D, M / 256, 1, F.vcu}; EpiF32 E{WSP(float, WS_LOGITS), NE}; GEMM_PHASE(F.lds, S, E); } SEAM(20);
    if (IN(21)) { p_route(F, args.in[14] + NE); } SEAM(21);
    if (IN(22)) { p_sort(F); } SEAM(22);
    if (IN(23)) { const int nrbt = *WSP(int, WS_META); SchedG1 S{WSP(unsigned char, WS_HQ), WSP(unsigned char, WS_W13), WSP(int, WS_ROWA), WSP(int, WS_BLKE), nrbt, F.vcu, moe_unit_experts(F, WSP(int, WS_BLKE), nrbt, 1), moe_row_table(F, WSP(int, WS_ROWA), nrbt)}; EpiSwiGLU E{WSP(bf16, WS_HID)}; gemm_fast8(F.lds, S, E); } SEAM(23);
    if (IN(24)) { const int nrbt = *WSP(int, WS_META); SchedG2 S{WSP(bf16, WS_HID), WSP(bf16, WS_W2), WSP(int, WS_BLKE), nrbt, F.vcu, moe_unit_experts(F, WSP(int, WS_BLKE), nrbt, 2)}; EpiScatter E{WSP(bf16, WS_RA), 0}; GEMM_PHASE(F.lds, S, E); if (PROBE_G2) { __syncthreads(); EpiScatter E2{(PROBE_G2 == 2 || PROBE_G2 == 4) ? WSP(bf16, WS_V) : WSP(bf16, WS_RA), PROBE_G2 == 3 ? 0 : PROBE_G2}; GEMM_PHASE(F.lds, S, E2); } } SEAM(24);
    if (IN(25)) { p_combine(F, WSP(float, WS_HA), args.in[21] + 3 * D, args.in[22] + 3 * D, args.out, nullptr); }
#undef IN
#undef SEAM
}

extern "C" void kernel_launch(void* const* d_in, const int* in_sizes, int n_in, void* d_out, int out_size, void* d_ws, size_t ws_size, hipStream_t stream) {
    static int ok = 0;
    if (ok == 0) {
        if (n_in != 23 || in_sizes[0] != M * D || out_size != M * D || ws_size < WS_END) { fprintf(stderr, "kernel_launch: unexpected shapes (n_in %d, in0 %d, out %d, ws %zu < %zu)\n", n_in, n_in > 0 ? in_sizes[0] : -1, out_size, ws_size, (size_t)WS_END); ok = -1; return; }
        if (hipFuncSetAttribute((const void*)yoco_fwd, hipFuncAttributeMaxDynamicSharedMemorySize, LDS_BYTES) != hipSuccess) { fprintf(stderr, "kernel_launch: hipFuncSetAttribute failed\n"); ok = -1; return; }
        int per_cu = 0;
        if (hipOccupancyMaxActiveBlocksPerMultiprocessor(&per_cu, (const void*)yoco_fwd, NTHR, LDS_BYTES) != hipSuccess || per_cu < 1) fprintf(stderr, "kernel_launch: occupancy query says %d\n", per_cu);
        (void)hipGetLastError();
        ok = 1;
    }
    if (ok < 0) return;
    if (hipMemsetAsync((char*)d_ws + WS_CTL, 0, CTL_ZERO_BYTES, stream) != hipSuccess) return;
    Args a{};
    for (int i = 0; i < 23; ++i) a.in[i] = (const float*)d_in[i];
    a.out = (float*)d_out; a.ws = (unsigned char*)d_ws; a.dup = 0u; a.dry = 0;
#if MK_ONE_LAUNCH
    a.ph_lo = 0; a.ph_hi = NPHASE;
    hipLaunchKernelGGL(yoco_fwd, dim3(NWG), dim3(NTHR), LDS_BYTES, stream, a);
#else
    for (int p = 0; p < NPHASE; ++p) { a.ph_lo = p; a.ph_hi = p + 1; hipLaunchKernelGGL(yoco_fwd, dim3(NWG), dim3(NTHR), LDS_BYTES, stream, a); }
#endif
}
```

```cpp
#include <hip/hip_runtime.h>
#include <cstdio>
#include <cstdint>

#ifndef MK_ONE_LAUNCH
#define MK_ONE_LAUNCH 1
#endif

constexpr int D = 1024, BATCH = 2, SEQ = 16384, M = BATCH * SEQ;
constexpr int NE = 256, TOPK = 8, DE = 256;
constexpr int HEADS = 8, HD = 64, QW = 1536, OW = 512;
constexpr float LN_EPS = 1e-5f, ALPHA = 1.41421356237f;
constexpr int RBMAX = 1024 + 256 + 128;
constexpr int NWG = 256, NTHR = 512, NWAVES = 8;
constexpr int NGW = NWG * NWAVES, NGT = NWG * NTHR;

constexpr size_t MiB = 1u << 20;
constexpr size_t WS_CTL = 0, CTL_ZERO_BYTES = 1 * MiB;
constexpr size_t WS_HIST = 1 * MiB, WS_BLKE = 1 * MiB + 512 * 1024, WS_META = 1 * MiB + 768 * 1024;
constexpr size_t WS_ROWA = 2 * MiB, WS_TOPI = 4 * MiB, WS_GATE = 5 * MiB, WS_CHP = 6 * MiB, WS_CHH = 8 * MiB, WS_CIN = 10 * MiB, WS_LSE = 12 * MiB;
constexpr size_t WS_WIN = 16 * MiB, WS_WG = 20 * MiB, WS_WOUT = 21 * MiB, WS_WQK = 23 * MiB, WS_WV = 29 * MiB, WS_WO = 32 * MiB, WS_WR = 33 * MiB;
constexpr size_t WS_LOGITS = 34 * MiB;
constexpr size_t WS_W13 = 66 * MiB, WS_W2 = 323 * MiB;
constexpr size_t WS_V = 452 * MiB, WS_HA = 580 * MiB, WS_HAB = 708 * MiB, WS_HB = 772 * MiB, WS_HBB = 900 * MiB, WS_HID = 964 * MiB;
constexpr size_t WS_RA = 1140 * MiB;
constexpr size_t RA_XB = 0, RA_XR = 64 * MiB, RA_GG = 128 * MiB, RA_XC = 192 * MiB, RA_LA = 256 * MiB, RA_U = 384 * MiB, RA_YB = 512 * MiB;
constexpr size_t RA_QK = 0, RA_VT = 192 * MiB, RA_OG = 288 * MiB, RA_OM = 384 * MiB;
constexpr size_t WS_POS = 15 * MiB;
constexpr size_t WS_HQ = 1844 * MiB;
constexpr size_t WS_END = 1876 * MiB;

constexpr int LDS_BYTES = 147456;

#define GAS __attribute__((address_space(1)))
#define LAS __attribute__((address_space(3)))
typedef unsigned short bf16;
typedef unsigned u32x4 __attribute__((ext_vector_type(4)));
typedef unsigned u32x2 __attribute__((ext_vector_type(2)));
typedef float f32x4 __attribute__((ext_vector_type(4)));
typedef float f32x2 __attribute__((ext_vector_type(2)));
typedef float f32x16 __attribute__((ext_vector_type(16)));
typedef short bf16x8 __attribute__((ext_vector_type(8)));
typedef int i32x8 __attribute__((ext_vector_type(8)));
typedef GAS unsigned gu32;
#define RLX_AGENT __ATOMIC_RELAXED, __HIP_MEMORY_SCOPE_AGENT
#define LDS_WAIT() asm volatile("s_waitcnt lgkmcnt(0)" ::: "memory")
#define VM_WAIT() asm volatile("s_waitcnt vmcnt(0)" ::: "memory")

__device__ __forceinline__ unsigned pk2(float lo, float hi) { unsigned r; asm("v_cvt_pk_bf16_f32 %0, %1, %2" : "=v"(r) : "v"(lo), "v"(hi)); return r; }
__device__ __forceinline__ float bf_lo(unsigned w) { return __uint_as_float(w << 16); }
__device__ __forceinline__ float bf_hi(unsigned w) { return __uint_as_float(w & 0xffff0000u); }
__device__ __forceinline__ float wave_sum(float v) {
#pragma unroll
    for (int o = 1; o < 64; o <<= 1) v += __shfl_xor(v, o);
    return v;
}
__device__ __forceinline__ float gelu_tanh(float x) {
    const float u = 0.7978845608028654f * (x + 0.044715f * x * x * x);
    const float e = __expf(2.0f * u);
    const float t = 1.0f - 2.0f / (e + 1.0f);
    return 0.5f * x * (1.0f + t);
}
__device__ __forceinline__ float sigmoidf_(float x) { return 1.0f / (1.0f + __expf(-x)); }

#define XB_TMO      128
#define XB_XCNT(j)  (256  + 64 * (j))
#define XB_XSUB(j)  (1280 + 64 * (j))
#define XB_XGEN(j)  (2304 + 64 * (j))
#define XB_TOP      3328
#define XB_TOPGEN   3392
#define XCD_BAR_WORDS 3456
#define XB_SPIN_CAP (1u << 18)
__device__ __forceinline__ unsigned xb_ld(unsigned* p)              { return __hip_atomic_load(p, __ATOMIC_RELAXED, __HIP_MEMORY_SCOPE_AGENT); }
__device__ __forceinline__ unsigned xb_add(unsigned* p, unsigned v) { return __hip_atomic_fetch_add(p, v, __ATOMIC_RELAXED, __HIP_MEMORY_SCOPE_AGENT); }
__device__ __forceinline__ unsigned xb_xcc_id() { return (unsigned)__builtin_amdgcn_s_getreg((3 << 11) | 20) & 0xFu; }
#define XB_SPIN(cond, bar) do { unsigned _sp = 0; while (cond) { __builtin_amdgcn_s_sleep(1); \
    if ((++_sp & 255u) == 0u) { if (xb_ld(&(bar)[XB_TMO])) break; if (_sp > XB_SPIN_CAP) { atomicAdd(&(bar)[XB_TMO], 1u); break; } } } } while (0)
struct XcdBarrier { unsigned* bar; unsigned x; volatile LAS unsigned* st; };
__device__ __forceinline__ XcdBarrier xcd_barrier_post(unsigned* bar, volatile LAS unsigned* st) {
    XcdBarrier b; b.bar = bar; b.x = xb_xcc_id(); b.st = st;
    if (threadIdx.x == 0) (void)xb_add(&bar[XB_XCNT(b.x)], 1u);
    return b;
}
__device__ __forceinline__ void xcd_barrier_complete(unsigned* bar, unsigned x, unsigned& nloc, unsigned& nx) {
    const unsigned G = gridDim.x * gridDim.y * gridDim.z;
    unsigned sum, cnt, mine, sp = 0u;
    for (;;) {
        sum = 0u; cnt = 0u; mine = 0u;
#pragma unroll
        for (unsigned j = 0; j < 16; ++j) { const unsigned c = xb_ld(&bar[XB_XCNT(j)]); sum += c; cnt += (c > 0u) ? 1u : 0u; mine = (j == x) ? c : mine; }
        if (sum == G) break;
        __builtin_amdgcn_s_sleep(1);
        if ((++sp & 255u) == 0u) { if (xb_ld(&bar[XB_TMO])) break; if (sp > XB_SPIN_CAP) { atomicAdd(&bar[XB_TMO], 1u); break; } }
    }
    nloc = mine > 0u ? mine : 1u; nx = cnt > 0u ? cnt : 1u;
}
__device__ __forceinline__ void xcd_barrier(const XcdBarrier& b) {
    asm volatile("s_waitcnt vmcnt(0)" ::: "memory");
    __syncthreads();
    if (threadIdx.x == 0) {
        unsigned* bar = b.bar;
        __builtin_amdgcn_s_waitcnt(0);
        unsigned nloc = b.st[0], nx = b.st[1];
        if (nloc == 0u) { xcd_barrier_complete(bar, b.x, nloc, nx); b.st[0] = nloc; b.st[1] = nx; }
        const unsigned old = xb_add(&bar[XB_XSUB(b.x)], 1u);
        const unsigned gen = old / nloc;
        if (old + 1u == (gen + 1u) * nloc) {
            __builtin_amdgcn_fence(__ATOMIC_RELEASE, "agent");
            asm volatile("s_waitcnt vmcnt(0)" ::: "memory");
            const unsigned og = xb_add(&bar[XB_TOP], 1u);
            const unsigned tg = og / nx;
            if (og + 1u == (tg + 1u) * nx) xb_add(&bar[XB_TOPGEN], 1u);
            else XB_SPIN(xb_ld(&bar[XB_TOPGEN]) == tg, bar);
            __builtin_amdgcn_fence(__ATOMIC_ACQUIRE, "agent");
            xb_add(&bar[XB_XGEN(b.x)], 1u);
            asm volatile("s_waitcnt vmcnt(0)" ::: "memory");
        } else {
            XB_SPIN(xb_ld(&bar[XB_XGEN(b.x)]) == gen, bar);
            __builtin_amdgcn_fence(__ATOMIC_ACQUIRE, "agent");
            asm volatile("s_waitcnt vmcnt(0)" ::: "memory");
        }
    }
    __syncthreads();
}

struct Args { const float* in[23]; float* out; unsigned char* ws; int ph_lo, ph_hi; unsigned dup; int rt256; };
static_assert(sizeof(Args) == 23 * 8 + 8 + 8 + 16, "Args has no padding");
struct Frame {
    LAS unsigned char* lds;
    int tid, lane, wave, vcu;
    unsigned char* ws;
};
#define WSP(T, off) ((T*)(F.ws + (off)))

template <class S, class E>
__device__ __forceinline__ void gemm_simple(LAS unsigned char* lds, const S& sch, const E& epi) {
    const int tid = threadIdx.x, wid = tid >> 6, lane = tid & 63, wr = wid >> 2, wc = wid & 3, fr = lane & 15, fq = lane >> 4;
    constexpr int PITCH = 144;
    LAS unsigned char* As = lds; LAS unsigned char* Bs = lds + 256 * PITCH;
    typename S::U u;
    for (int i = 0; sch.next(i, u); ++i) {
        f32x4 acc[2][2][4][2];
#pragma unroll
        for (int a = 0; a < 2; ++a)
#pragma unroll
            for (int b = 0; b < 2; ++b)
#pragma unroll
                for (int m = 0; m < 4; ++m)
#pragma unroll
                    for (int n = 0; n < 2; ++n) acc[a][b][m][n] = (f32x4){0.f, 0.f, 0.f, 0.f};
        const int nt = sch.K(u) / 64;
        const char* pa[4]; const char* pb[4];
#pragma unroll
        for (int j = 0; j < 4; ++j) { const int row = (tid >> 3) + 64 * j; const int rb = S::PERM ? ((row & ~31) + 8 * ((row & 15) >> 2) + 4 * ((row >> 4) & 1) + (row & 3)) : row; pa[j] = sch.rowA(u, row) + (tid & 7) * 16; pb[j] = sch.rowB(u, rb) + (tid & 7) * 16; }
        for (int kt = 0; kt < nt; ++kt) {
            u32x4 va[4], vb[4];
#pragma unroll
            for (int j = 0; j < 4; ++j) { va[j] = *(const u32x4*)(pa[j] + kt * 128); vb[j] = *(const u32x4*)(pb[j] + kt * 128); }
            __syncthreads();
#pragma unroll
            for (int j = 0; j < 4; ++j) { const int row = (tid >> 3) + 64 * j;
                *(LAS u32x4*)(As + row * PITCH + (tid & 7) * 16) = va[j]; *(LAS u32x4*)(Bs + row * PITCH + (tid & 7) * 16) = vb[j]; }
            __syncthreads();
#pragma unroll
            for (int kk = 0; kk < 2; ++kk) {
                bf16x8 Bf[2][2];
#pragma unroll
                for (int b = 0; b < 2; ++b)
#pragma unroll
                    for (int n = 0; n < 2; ++n) Bf[b][n] = *(const LAS bf16x8*)(Bs + (b * 128 + wc * 32 + n * 16 + fr) * PITCH + kk * 64 + fq * 16);
#pragma unroll
                for (int a = 0; a < 2; ++a) {
                    bf16x8 Af[4];
#pragma unroll
                    for (int m = 0; m < 4; ++m) Af[m] = *(const LAS bf16x8*)(As + (a * 128 + wr * 64 + m * 16 + fr) * PITCH + kk * 64 + fq * 16);
#pragma unroll
                    for (int b = 0; b < 2; ++b)
#pragma unroll
                        for (int m = 0; m < 4; ++m)
#pragma unroll
                            for (int n = 0; n < 2; ++n) acc[a][b][m][n] = __builtin_amdgcn_mfma_f32_16x16x32_bf16(Bf[b][n], Af[m], acc[a][b][m][n], 0, 0, 0);
                }
            }
        }
        epi(acc, u, wr, wc, fr, fq);
    }
    __syncthreads();
}

namespace pg8 {
constexpr int HTB = 128 * 64 * 2;
__device__ __forceinline__ int lds_byte(int r, int c) { const int st = (r >> 4) * 2 + (c >> 5), rr = r & 15, cc = c & 31, ob = rr * 64 + cc * 2; return st * 1024 + (ob ^ (((ob >> 9) & 1) << 5)); }
__device__ __forceinline__ int perm32(int rho) { const int n = rho >> 4, i = rho & 15; return 8 * (i >> 2) + 4 * n + (i & 3); }
__device__ __forceinline__ int prow(int r) { return (r & ~31) + perm32(r & 31); }
__device__ __forceinline__ void stage_rc(int b, int& R, int& C) { const int st = b / 1024, sb = b % 1024, swz = sb ^ (((sb >> 9) & 1) << 5); R = (st >> 1) * 16 + swz / 64; C = (st & 1) * 32 + (swz % 64) / 2; }
}
template <class S, class E>
__device__ __forceinline__ void gemm_fast(LAS unsigned char* lds, const S& sch, const E& epi) {
    using namespace pg8;
    const int tid = threadIdx.x, wid = __builtin_amdgcn_readfirstlane(tid >> 6), lane = tid & 63, wr = wid >> 2, wc = wid & 3, fr = lane & 15, fq = lane >> 4;
    const int nt = sch.Kk / 64;
    int R0, C0; stage_rc(tid * 16, R0, C0);
    unsigned voffA[2], voffB[2]; unsigned cofA[4], nofA[4], cofB[4], nofB[4];
    size_t hstepA = 0, hstepB = 0;
    if constexpr (!S::GA) { voffA[0] = (unsigned)(R0 * sch.lda + C0) * 2u; voffA[1] = (unsigned)((R0 + 64) * sch.lda + C0) * 2u; hstepA = (size_t)128 * sch.lda * 2; }
    const int RB0 = S::PERM ? prow(R0) : R0;
    if constexpr (!S::GB) { voffB[0] = (unsigned)(RB0 * sch.ldb + C0) * 2u; voffB[1] = (unsigned)((RB0 + 64) * sch.ldb + C0) * 2u; hstepB = (size_t)128 * sch.ldb * 2; }
    const size_t kstep = 128;
    const unsigned ldsw = (unsigned)wid * 1024u;
    const int aoff = lds_byte(wr * 64 + fr, fq * 8), boff = lds_byte(wc * 32 + fr, fq * 8);
#define G_SA(b, h) (((b) * 2 + (h)) * HTB)
#define G_SB(b, h) ((4 + (b) * 2 + (h)) * HTB)
#define G_GLDS(src, dst) __builtin_amdgcn_global_load_lds((const unsigned*)(src), (LAS unsigned*)(dst), 16, 0, 0)
#define G_STAGE_A(bufoff, gp, h, nx) do { if constexpr (S::GA) { _Pragma("unroll") for (int _i = 0; _i < 2; ++_i) { const unsigned _o = (nx) ? nofA[2 * (h) + _i] : cofA[2 * (h) + _i]; G_GLDS((gp) + _o, lds + (bufoff) + ldsw + _i * 8192); } } \
        else { _Pragma("unroll") for (int _i = 0; _i < 2; ++_i) G_GLDS((gp) + (size_t)(h) * hstepA + voffA[_i], lds + (bufoff) + ldsw + _i * 8192); } } while (0)
#define G_STAGE_B(bufoff, gp, h, nx) do { if constexpr (S::GB) { _Pragma("unroll") for (int _i = 0; _i < 2; ++_i) { const unsigned _o = (nx) ? nofB[2 * (h) + _i] : cofB[2 * (h) + _i]; G_GLDS((gp) + _o, lds + (bufoff) + ldsw + _i * 8192); } } \
        else { _Pragma("unroll") for (int _i = 0; _i < 2; ++_i) G_GLDS((gp) + (size_t)(h) * hstepB + voffB[_i], lds + (bufoff) + ldsw + _i * 8192); } } while (0)
#define G_LDA(dst, b, h) do { _Pragma("unroll") for (int m = 0; m < 4; ++m) _Pragma("unroll") for (int k = 0; k < 2; ++k) dst[m][k] = *(const LAS bf16x8*)(lds + G_SA(b, h) + aoff + m * 2048 + k * 1024); } while (0)
#define G_LDB(dst, b, h) do { _Pragma("unroll") for (int n = 0; n < 2; ++n) _Pragma("unroll") for (int k = 0; k < 2; ++k) dst[n][k] = *(const LAS bf16x8*)(lds + G_SB(b, h) + boff + n * 2048 + k * 1024); } while (0)
#define G_MMA(ai, bj, At, Bt) do { __builtin_amdgcn_s_setprio(1); _Pragma("unroll") for (int m = 0; m < 4; ++m) _Pragma("unroll") for (int n = 0; n < 2; ++n) _Pragma("unroll") for (int k = 0; k < 2; ++k) \
        acc[ai][bj][m][n] = __builtin_amdgcn_mfma_f32_16x16x32_bf16(Bt[n][k], At[m][k], acc[ai][bj][m][n], 0, 0, 0); __builtin_amdgcn_s_setprio(0); } while (0)
#define G_WAIT_V(n) asm volatile("s_waitcnt vmcnt(" #n ")" ::: "memory")
#define G_WAIT_L(n) asm volatile("s_waitcnt lgkmcnt(" #n ")" ::: "memory")
#define G_BAR __builtin_amdgcn_s_barrier()
#define G_SCHED __builtin_amdgcn_sched_barrier(0)
    typename S::U cur, nxt; int ui = 0;
    if (!sch.next(0, cur)) return;
    f32x4 acc[2][2][4][2];
#pragma unroll
    for (int a = 0; a < 2; ++a)
#pragma unroll
        for (int b = 0; b < 2; ++b)
#pragma unroll
            for (int m = 0; m < 4; ++m)
#pragma unroll
                for (int n = 0; n < 2; ++n) acc[a][b][m][n] = (f32x4){0.f, 0.f, 0.f, 0.f};
    bf16x8 At[4][2], B0[2][2], B1[2][2];
    const char* cA = sch.baseA(cur); const char* cB = sch.baseB(cur);
    if constexpr (S::GA) {
#pragma unroll
        for (int j = 0; j < 4; ++j) { cofA[j] = sch.goffA(cur, (j >> 1) * 128 + R0 + (j & 1) * 64, C0); nofA[j] = cofA[j]; } }
    if constexpr (S::GB) {
#pragma unroll
        for (int j = 0; j < 4; ++j) { cofB[j] = sch.goffB(cur, (j >> 1) * 128 + RB0 + (j & 1) * 64, C0); nofB[j] = cofB[j]; } }
    G_STAGE_B(G_SB(0, 0), cB, 0, false); G_STAGE_B(G_SB(0, 1), cB, 1, false); G_STAGE_A(G_SA(0, 0), cA, 0, false); G_STAGE_A(G_SA(0, 1), cA, 1, false);
    if (wr == 1) G_BAR;
    G_WAIT_V(2); G_BAR;
    G_STAGE_B(G_SB(1, 0), cB + kstep, 0, false); G_STAGE_A(G_SA(1, 0), cA + kstep, 0, false); G_STAGE_B(G_SB(1, 1), cB + kstep, 1, false);
    G_WAIT_V(6); G_BAR;
    for (;;) {
        const bool has_next = sch.next(ui + 1, nxt);
        const char* nA = has_next ? sch.baseA(nxt) : cA; const char* nB = has_next ? sch.baseB(nxt) : cB;
        if constexpr (S::GA) { if (has_next) {
#pragma unroll
            for (int j = 0; j < 4; ++j) nofA[j] = sch.goffA(nxt, (j >> 1) * 128 + R0 + (j & 1) * 64, C0); } }
        if constexpr (S::GB) { if (has_next) {
#pragma unroll
            for (int j = 0; j < 4; ++j) nofB[j] = sch.goffB(nxt, (j >> 1) * 128 + RB0 + (j & 1) * 64, C0); } }
#pragma unroll 1
        for (int t = 0; t < nt; t += 2) {
            const bool last = (t == nt - 2);
            const char* a1 = cA + (size_t)(t + 1) * kstep;
            const char* a2 = last ? nA : cA + (size_t)(t + 2) * kstep; const char* b2 = last ? nB : cB + (size_t)(t + 2) * kstep;
            const char* a3 = a2 + kstep; const char* b3 = b2 + kstep;
            asm volatile("" : "+s"(a1), "+s"(a2), "+s"(a3), "+s"(b2), "+s"(b3));
            const bool post = (t == 0 && ui > 0);
#define G_WAIT_POST() do { if (post) { if constexpr (E::NVM == 8) G_WAIT_V(16); else if constexpr (E::NVM == 16) G_WAIT_V(24); else if constexpr (E::NVM == 32) G_WAIT_V(40); else G_WAIT_V(8); } else G_WAIT_V(8); } while (0)
            G_LDB(B0, 0, 0); G_LDB(B1, 0, 1); G_SCHED; G_LDA(At, 0, 0); if (!post) G_STAGE_A(G_SA(1, 1), a1, 1, false);
            G_WAIT_POST(); G_WAIT_L(0); G_BAR; G_MMA(0, 0, At, B0); G_MMA(0, 1, At, B1); G_BAR; G_SCHED;
            G_LDA(At, 0, 1); G_STAGE_B(G_SB(0, 0), b2, 0, last); G_STAGE_B(G_SB(0, 1), b2, 1, last); G_STAGE_A(G_SA(0, 0), a2, 0, last);
            G_WAIT_POST(); G_WAIT_L(0); G_BAR; G_MMA(1, 0, At, B0); G_MMA(1, 1, At, B1); G_BAR; G_SCHED;
            G_LDB(B0, 1, 0); G_LDB(B1, 1, 1); G_SCHED; G_LDA(At, 1, 0); G_STAGE_A(G_SA(0, 1), a2, 1, last);
            G_WAIT_POST(); G_WAIT_L(0); G_BAR; G_MMA(0, 0, At, B0); G_MMA(0, 1, At, B1); G_BAR; G_SCHED;
            G_LDA(At, 1, 1); G_STAGE_B(G_SB(1, 0), b3, 0, last); G_STAGE_B(G_SB(1, 1), b3, 1, last); G_STAGE_A(G_SA(1, 0), a3, 0, last);
            G_WAIT_V(8); G_WAIT_L(0); G_BAR; G_MMA(1, 0, At, B0); G_MMA(1, 1, At, B1); G_BAR; G_SCHED;
#undef G_WAIT_POST
        }
        if (wr == 0) G_BAR;
        if (has_next) { const char* n1 = nA + kstep; asm volatile("" : "+s"(n1)); G_STAGE_A(G_SA(1, 1), n1, 1, true); }
        { int tz = threadIdx.x; asm volatile("" : "+v"(tz));
          const int ewid = tz >> 6, el = tz & 63; epi(acc, cur, ewid >> 2, ewid & 3, el & 15, el >> 4); }
        if (!has_next) break;
#pragma unroll
        for (int a = 0; a < 2; ++a)
#pragma unroll
            for (int b = 0; b < 2; ++b)
#pragma unroll
                for (int m = 0; m < 4; ++m)
#pragma unroll
                    for (int n = 0; n < 2; ++n) acc[a][b][m][n] = (f32x4){0.f, 0.f, 0.f, 0.f};
        cur = nxt; cA = nA; cB = nB; ++ui;
        if constexpr (S::GA) {
#pragma unroll
            for (int j = 0; j < 4; ++j) cofA[j] = nofA[j]; }
        if constexpr (S::GB) {
#pragma unroll
            for (int j = 0; j < 4; ++j) cofB[j] = nofB[j]; }
        if (wr == 1) G_BAR;
    }
    G_WAIT_V(0);
    G_BAR;
#undef G_SA
#undef G_SB
#undef G_GLDS
#undef G_STAGE_A
#undef G_STAGE_B
#undef G_LDA
#undef G_LDB
#undef G_MMA
#undef G_WAIT_V
#undef G_WAIT_L
#undef G_BAR
#undef G_SCHED
}
template <class S, class E>
__device__ __forceinline__ void gemm_fast8(LAS unsigned char* lds, const S& sch, const E& epi) {
    using namespace pg8;
    const int tid = threadIdx.x, wid = __builtin_amdgcn_readfirstlane(tid >> 6), lane = tid & 63, wr = wid >> 2, wc = wid & 3, fr = lane & 15, fq = lane >> 4;
    const int nt = sch.Kk / 128;
    int R0, C0; stage_rc(tid * 16, R0, C0);
    unsigned voffA[2], voffB[2]; unsigned cofA[4], nofA[4], cofB[4], nofB[4];
    size_t hstepA = 0, hstepB = 0;
    if constexpr (!S::GA) { voffA[0] = (unsigned)(R0 * sch.lda + C0 * 2); voffA[1] = (unsigned)((R0 + 64) * sch.lda + C0 * 2); hstepA = (size_t)128 * sch.lda; }
    const int RB0 = S::PERM ? prow(R0) : R0;
    if constexpr (!S::GB) { voffB[0] = (unsigned)(RB0 * sch.ldb + C0 * 2); voffB[1] = (unsigned)((RB0 + 64) * sch.ldb + C0 * 2); hstepB = (size_t)128 * sch.ldb; }
    const size_t kstep = 128;
    const unsigned ldsw = (unsigned)wid * 1024u;
    const int aoff = lds_byte(wr * 64 + fr, fq * 16), aoff1 = lds_byte(wr * 64 + fr, fq * 16 + 8), boff = lds_byte(wc * 32 + fr, fq * 16), boff1 = lds_byte(wc * 32 + fr, fq * 16 + 8);
#define G_SA(b, h) (((b) * 2 + (h)) * HTB)
#define G_SB(b, h) ((4 + (b) * 2 + (h)) * HTB)
#define G_GLDS(src, dst) __builtin_amdgcn_global_load_lds((const unsigned*)(src), (LAS unsigned*)(dst), 16, 0, 0)
#define G_STAGE_A(bufoff, gp, h, nx) do { if constexpr (S::GA) { _Pragma("unroll") for (int _i = 0; _i < 2; ++_i) { const unsigned _o = (nx) ? nofA[2 * (h) + _i] : cofA[2 * (h) + _i]; G_GLDS((gp) + _o, lds + (bufoff) + ldsw + _i * 8192); } } \
        else { _Pragma("unroll") for (int _i = 0; _i < 2; ++_i) G_GLDS((gp) + (size_t)(h) * hstepA + voffA[_i], lds + (bufoff) + ldsw + _i * 8192); } } while (0)
#define G_STAGE_B(bufoff, gp, h, nx) do { if constexpr (S::GB) { _Pragma("unroll") for (int _i = 0; _i < 2; ++_i) { const unsigned _o = (nx) ? nofB[2 * (h) + _i] : cofB[2 * (h) + _i]; G_GLDS((gp) + _o, lds + (bufoff) + ldsw + _i * 8192); } } \
        else { _Pragma("unroll") for (int _i = 0; _i < 2; ++_i) G_GLDS((gp) + (size_t)(h) * hstepB + voffB[_i], lds + (bufoff) + ldsw + _i * 8192); } } while (0)
#define G_LDA(dst, b, h) do { _Pragma("unroll") for (int m = 0; m < 4; ++m) { const u32x4 _lo = *(const LAS u32x4*)(lds + G_SA(b, h) + aoff + m * 2048), _hi = *(const LAS u32x4*)(lds + G_SA(b, h) + aoff1 + m * 2048); dst[m] = (i32x8){(int)_lo.x, (int)_lo.y, (int)_lo.z, (int)_lo.w, (int)_hi.x, (int)_hi.y, (int)_hi.z, (int)_hi.w}; } } while (0)
#define G_LDB(dst, b, h) do { _Pragma("unroll") for (int n = 0; n < 2; ++n) { const u32x4 _lo = *(const LAS u32x4*)(lds + G_SB(b, h) + boff + n * 2048), _hi = *(const LAS u32x4*)(lds + G_SB(b, h) + boff1 + n * 2048); dst[n] = (i32x8){(int)_lo.x, (int)_lo.y, (int)_lo.z, (int)_lo.w, (int)_hi.x, (int)_hi.y, (int)_hi.z, (int)_hi.w}; } } while (0)
#define G_MMA(ai, bj, At, Bt) do { __builtin_amdgcn_s_setprio(1); _Pragma("unroll") for (int m = 0; m < 4; ++m) _Pragma("unroll") for (int n = 0; n < 2; ++n) \
        acc[ai][bj][m][n] = __builtin_amdgcn_mfma_scale_f32_16x16x128_f8f6f4(Bt[n], At[m], acc[ai][bj][m][n], 0, 0, 0, 0, 0, 0); __builtin_amdgcn_s_setprio(0); } while (0)
#define G_WAIT_V(n) asm volatile("s_waitcnt vmcnt(" #n ")" ::: "memory")
#define G_WAIT_L(n) asm volatile("s_waitcnt lgkmcnt(" #n ")" ::: "memory")
#define G_BAR __builtin_amdgcn_s_barrier()
#define G_SCHED __builtin_amdgcn_sched_barrier(0)
    typename S::U cur, nxt; int ui = 0;
    if (!sch.next(0, cur)) return;
    f32x4 acc[2][2][4][2];
#pragma unroll
    for (int a = 0; a < 2; ++a)
#pragma unroll
        for (int b = 0; b < 2; ++b)
#pragma unroll
            for (int m = 0; m < 4; ++m)
#pragma unroll
                for (int n = 0; n < 2; ++n) acc[a][b][m][n] = (f32x4){0.f, 0.f, 0.f, 0.f};
    i32x8 At[4], B0[2], B1[2];
    const char* cA = sch.baseA(cur); const char* cB = sch.baseB(cur);
    if constexpr (S::GA) {
#pragma unroll
        for (int j = 0; j < 4; ++j) { cofA[j] = sch.goffA(cur, (j >> 1) * 128 + R0 + (j & 1) * 64, C0); nofA[j] = cofA[j]; } }
    if constexpr (S::GB) {
#pragma unroll
        for (int j = 0; j < 4; ++j) { cofB[j] = sch.goffB(cur, (j >> 1) * 128 + RB0 + (j & 1) * 64, C0); nofB[j] = cofB[j]; } }
    G_STAGE_B(G_SB(0, 0), cB, 0, false); G_STAGE_B(G_SB(0, 1), cB, 1, false); G_STAGE_A(G_SA(0, 0), cA, 0, false); G_STAGE_A(G_SA(0, 1), cA, 1, false);
    if (wr == 1) G_BAR;
    G_WAIT_V(2); G_BAR;
    G_STAGE_B(G_SB(1, 0), cB + kstep, 0, false); G_STAGE_A(G_SA(1, 0), cA + kstep, 0, false); G_STAGE_B(G_SB(1, 1), cB + kstep, 1, false);
    G_WAIT_V(6); G_BAR;
    for (;;) {
        const bool has_next = sch.next(ui + 1, nxt);
        const char* nA = has_next ? sch.baseA(nxt) : cA; const char* nB = has_next ? sch.baseB(nxt) : cB;
        if constexpr (S::GA) { if (has_next) {
#pragma unroll
            for (int j = 0; j < 4; ++j) nofA[j] = sch.goffA(nxt, (j >> 1) * 128 + R0 + (j & 1) * 64, C0); } }
        if constexpr (S::GB) { if (has_next) {
#pragma unroll
            for (int j = 0; j < 4; ++j) nofB[j] = sch.goffB(nxt, (j >> 1) * 128 + RB0 + (j & 1) * 64, C0); } }
#pragma unroll 1
        for (int t = 0; t < nt; t += 2) {
            const bool last = (t == nt - 2);
            const char* a1 = cA + (size_t)(t + 1) * kstep;
            const char* a2 = last ? nA : cA + (size_t)(t + 2) * kstep; const char* b2 = last ? nB : cB + (size_t)(t + 2) * kstep;
            const char* a3 = a2 + kstep; const char* b3 = b2 + kstep;
            asm volatile("" : "+s"(a1), "+s"(a2), "+s"(a3), "+s"(b2), "+s"(b3));
            const bool post = (t == 0 && ui > 0);
#define G_WAIT_POST() do { if (post) { if constexpr (E::NVM == 8) G_WAIT_V(16); else if constexpr (E::NVM == 16) G_WAIT_V(24); else if constexpr (E::NVM == 32) G_WAIT_V(40); else G_WAIT_V(8); } else G_WAIT_V(8); } while (0)
            G_LDB(B0, 0, 0); G_LDB(B1, 0, 1); G_SCHED; G_LDA(At, 0, 0); if (!post) G_STAGE_A(G_SA(1, 1), a1, 1, false);
            G_WAIT_POST(); G_WAIT_L(0); G_BAR; G_MMA(0, 0, At, B0); G_MMA(0, 1, At, B1); G_BAR; G_SCHED;
            G_LDA(At, 0, 1); G_STAGE_B(G_SB(0, 0), b2, 0, last); G_STAGE_B(G_SB(0, 1), b2, 1, last); G_STAGE_A(G_SA(0, 0), a2, 0, last);
            G_WAIT_POST(); G_WAIT_L(0); G_BAR; G_MMA(1, 0, At, B0); G_MMA(1, 1, At, B1); G_BAR; G_SCHED;
            G_LDB(B0, 1, 0); G_LDB(B1, 1, 1); G_SCHED; G_LDA(At, 1, 0); G_STAGE_A(G_SA(0, 1), a2, 1, last);
            G_WAIT_POST(); G_WAIT_L(0); G_BAR; G_MMA(0, 0, At, B0); G_MMA(0, 1, At, B1); G_BAR; G_SCHED;
            G_LDA(At, 1, 1); G_STAGE_B(G_SB(1, 0), b3, 0, last); G_STAGE_B(G_SB(1, 1), b3, 1, last); G_STAGE_A(G_SA(1, 0), a3, 0, last);
            G_WAIT_V(8); G_WAIT_L(0); G_BAR; G_MMA(1, 0, At, B0); G_MMA(1, 1, At, B1); G_BAR; G_SCHED;
#undef G_WAIT_POST
        }
        if (wr == 0) G_BAR;
        if (has_next) { const char* n1 = nA + kstep; asm volatile("" : "+s"(n1)); G_STAGE_A(G_SA(1, 1), n1, 1, true); }
        { int tz = threadIdx.x; asm volatile("" : "+v"(tz));
          const int ewid = tz >> 6, el = tz & 63; epi(acc, cur, ewid >> 2, ewid & 3, el & 15, el >> 4); }
        if (!has_next) break;
#pragma unroll
        for (int a = 0; a < 2; ++a)
#pragma unroll
            for (int b = 0; b < 2; ++b)
#pragma unroll
                for (int m = 0; m < 4; ++m)
#pragma unroll
                    for (int n = 0; n < 2; ++n) acc[a][b][m][n] = (f32x4){0.f, 0.f, 0.f, 0.f};
        cur = nxt; cA = nA; cB = nB; ++ui;
        if constexpr (S::GA) {
#pragma unroll
            for (int j = 0; j < 4; ++j) cofA[j] = nofA[j]; }
        if constexpr (S::GB) {
#pragma unroll
            for (int j = 0; j < 4; ++j) cofB[j] = nofB[j]; }
        if (wr == 1) G_BAR;
    }
    G_WAIT_V(0);
    G_BAR;
#undef G_SA
#undef G_SB
#undef G_GLDS
#undef G_STAGE_A
#undef G_STAGE_B
#undef G_LDA
#undef G_LDB
#undef G_MMA
#undef G_WAIT_V
#undef G_WAIT_L
#undef G_BAR
#undef G_SCHED
}
#ifndef MK_FAST
#define MK_FAST 1
#endif
#if MK_FAST
#define GEMM_PHASE(lds, S, E) gemm_fast(lds, S, E)
#else
#define GEMM_PHASE(lds, S, E) gemm_simple(lds, S, E)
#endif

#define ROWLOOP _Pragma("unroll") for (int ai = 0; ai < 2; ++ai) _Pragma("unroll") for (int m = 0; m < 4; ++m)
#define UROW (ai * 128 + wr * 64 + m * 16 + fr)
#define UCOL(bj, n) ((bj) * 128 + wc * 32 + (n) * 16 + 4 * fq)
#define UCOLP(bj) ((bj) * 128 + wc * 32 + 8 * fq)
__device__ __forceinline__ u32x4 pk8(const f32x4 a, const f32x4 b) { u32x4 w; w.x = pk2(a.x, a.y); w.y = pk2(a.z, a.w); w.z = pk2(b.x, b.y); w.w = pk2(b.z, b.w); return w; }
typedef f32x4 AccT[2][2][4][2];

struct UnitD { int pm, pn; };
template <bool PERM_> struct SchedDenseT {
    typedef UnitD U;
    static constexpr bool GA = false, GB = false, PERM = PERM_;
    const bf16* A; const bf16* Bt; int lda, ldb, Kk, nM, nN, vcu;
    __device__ __forceinline__ const char* baseA(const U& u) const { return (const char*)(A + (size_t)u.pm * 256 * lda); }
    __device__ __forceinline__ const char* baseB(const U& u) const { return (const char*)(Bt + (size_t)u.pn * 256 * ldb); }
    __device__ __forceinline__ bool next(int i, U& u) const { const int L = i * NWG + vcu; if (L >= nM * nN) return false; u.pm = L / nN; u.pn = L % nN; return true; }
    __device__ __forceinline__ int K(const U&) const { return Kk; }
    __device__ __forceinline__ const char* rowA(const U& u, int r) const { return (const char*)(A + (size_t)(u.pm * 256 + r) * lda); }
    __device__ __forceinline__ const char* rowB(const U& u, int r) const { return (const char*)(Bt + (size_t)(u.pn * 256 + r) * ldb); }
};
typedef SchedDenseT<false> SchedDense; typedef SchedDenseT<true> SchedDenseP;
struct SchedDense8 {
    typedef UnitD U;
    static constexpr bool GA = false, GB = false, PERM = true;
    const unsigned char* A; const unsigned char* Bt; int lda, ldb, Kk, nM, nN, vcu;
    __device__ __forceinline__ const char* baseA(const U& u) const { return (const char*)(A + (size_t)u.pm * 256 * lda); }
    __device__ __forceinline__ const char* baseB(const U& u) const { return (const char*)(Bt + (size_t)u.pn * 256 * ldb); }
    __device__ __forceinline__ bool next(int i, U& u) const { const int L = i * NWG + vcu; if (L >= nM * nN) return false; u.pm = L / nN; u.pn = L % nN; return true; }
};
struct EpiXZ {
    static constexpr int NVM = 16;
    bf16* XR; bf16* GG;
    __device__ __forceinline__ void operator()(const AccT& acc, const UnitD& u, int wr, int wc, int fr, int fq) const {
        const bool isg = u.pn >= 4; bf16* base = isg ? GG : XR; const int c0 = (u.pn & 3) * 256;
        ROWLOOP { bf16* rp = base + (size_t)(u.pm * 256 + UROW) * D + c0;
#pragma unroll
            for (int bj = 0; bj < 2; ++bj) { f32x4 v0 = acc[ai][bj][m][0] * 0.015625f, v1 = acc[ai][bj][m][1] * 0.015625f;
                if (isg) {
#pragma unroll
                    for (int j = 0; j < 4; ++j) { v0[j] = gelu_tanh(v0[j]); v1[j] = gelu_tanh(v1[j]); } }
                *(u32x4*)(rp + UCOLP(bj)) = pk8(v0, v1); } }
    }
};
struct EpiResF32 {
    static constexpr int NVM = 0;
    const float* R; float* O; int ldc;
    __device__ __forceinline__ void operator()(const AccT& acc, const UnitD& u, int wr, int wc, int fr, int fq) const {
        const size_t base = (size_t)(u.pm * 256 + wr * 64 + fr) * ldc + u.pn * 256;
        f32x4 cur[4], nxt[4];
#pragma unroll
        for (int q = 0; q < 4; ++q) cur[q] = *(const f32x4*)(R + base + UCOL(q >> 1, q & 1));
#pragma unroll
        for (int g = 0; g < 8; ++g) { const int ai = g >> 2, m = g & 3; const size_t ro = base + (size_t)(ai * 128 + m * 16) * ldc;
            if (g < 7) { const size_t rn = base + (size_t)(((g + 1) >> 2) * 128 + ((g + 1) & 3) * 16) * ldc;
#pragma unroll
                for (int q = 0; q < 4; ++q) nxt[q] = *(const f32x4*)(R + rn + UCOL(q >> 1, q & 1)); }
#pragma unroll
            for (int q = 0; q < 4; ++q) *(f32x4*)(O + ro + UCOL(q >> 1, q & 1)) = cur[q] * ALPHA + acc[ai][q >> 1][m][q & 1];
#pragma unroll
            for (int q = 0; q < 4; ++q) cur[q] = nxt[q]; }
    }
};
struct EpiF32 {
    static constexpr int NVM = 32;
    float* O; int ldc;
    __device__ __forceinline__ void operator()(const AccT& acc, const UnitD& u, int wr, int wc, int fr, int fq) const {
        ROWLOOP { const size_t ro = (size_t)(u.pm * 256 + UROW) * ldc + u.pn * 256;
#pragma unroll
            for (int bj = 0; bj < 2; ++bj)
#pragma unroll
                for (int n = 0; n < 2; ++n) *(f32x4*)(O + ro + UCOL(bj, n)) = acc[ai][bj][m][n]; }
    }
};

struct UnitG { int pm, blk, pn; };
struct SchedGate {
    typedef UnitG U;
    static constexpr bool GA = false, GB = false, PERM = true; static constexpr int Kk = 256, lda = D, ldb = 256;
    const bf16* XC; const bf16* WgT; int vcu;
    __device__ __forceinline__ const char* baseA(const U& u) const { return (const char*)(XC + (size_t)u.pm * 256 * D + u.blk * 256); }
    __device__ __forceinline__ const char* baseB(const U& u) const { return (const char*)(WgT + (size_t)(u.blk * 512 + u.pn * 256) * 256); }
    __device__ __forceinline__ bool next(int i, U& u) const { const int L = i * NWG + vcu; if (L >= 128 * 8) return false; u.pm = L >> 3; u.blk = (L >> 1) & 3; u.pn = L & 1; return true; }
    __device__ __forceinline__ int K(const U&) const { return 256; }
    __device__ __forceinline__ const char* rowA(const U& u, int r) const { return (const char*)(XC + (size_t)(u.pm * 256 + r) * D + u.blk * 256); }
    __device__ __forceinline__ const char* rowB(const U& u, int r) const { return (const char*)(WgT + (size_t)(u.blk * 512 + u.pn * 256 + r) * 256); }
};
struct EpiGate {
    static constexpr int NVM = 0;
    const bf16* XC; const float *ba, *bx, *lam; bf16* LA; bf16* UU;
    __device__ __forceinline__ void operator()(const AccT& acc, const UnitG& u, int wr, int wc, int fr, int fq) const {
        const int c0 = u.blk * 256 + u.pn * 128 + wc * 32 + 8 * fq;
        f32x4 vba[2], vbx[2], sp[2];
#pragma unroll
        for (int n = 0; n < 2; ++n) { vba[n] = *(const f32x4*)(ba + c0 + 4 * n); vbx[n] = *(const f32x4*)(bx + c0 + 4 * n); const f32x4 vl = *(const f32x4*)(lam + c0 + 4 * n);
#pragma unroll
            for (int j = 0; j < 4; ++j) { const float x = __expf(-vl[j]); sp[n][j] = 8.0f * x * (1.0f - x * (0.5f - x * (1.0f / 3.0f))); } }
        const size_t base = (size_t)(u.pm * 256 + wr * 64 + fr) * D + c0;
        u32x4 xw = *(const u32x4*)(XC + base);
#pragma unroll
        for (int g = 0; g < 8; ++g) { const int ai = g >> 2, m = g & 3; const size_t ro = base + (size_t)(ai * 128 + m * 16) * D;
            u32x4 xn = xw; if (g < 7) xn = *(const u32x4*)(XC + base + (size_t)(((g + 1) >> 2) * 128 + ((g + 1) & 3) * 16) * D);
            const float xc[8] = {bf_lo(xw.x), bf_hi(xw.x), bf_lo(xw.y), bf_hi(xw.y), bf_lo(xw.z), bf_hi(xw.z), bf_lo(xw.w), bf_hi(xw.w)};
            f32x4 la[2], uu[2];
#pragma unroll
            for (int n = 0; n < 2; ++n) { const f32x4 ga = acc[ai][0][m][n] + vba[n], gx = acc[ai][1][m][n] + vbx[n];
#pragma unroll
                for (int j = 0; j < 4; ++j) { const float r = sigmoidf_(ga[j]), ig = sigmoidf_(gx[j]); const float l = -r * sp[n][j]; la[n][j] = l;
                    const float mult = sqrtf(fmaxf(1.0f - __expf(2.0f * l), 0.f)); uu[n][j] = mult * ig * xc[4 * n + j]; } }
            *(u32x4*)(LA + ro) = pk8(la[0], la[1]); *(u32x4*)(UU + ro) = pk8(uu[0], uu[1]); xw = xn; }
    }
};

struct UnitE { int rb, pn, e, ti; };
struct SchedG1 {
    typedef UnitE U;
    static constexpr bool GA = true, GB = false, PERM = true; static constexpr int Kk = D, lda = D, ldb = D;
    const unsigned char* X; const unsigned char* W13T; const int* ROWA; const int* BLKE; int nrbt, vcu; int ev; const LAS unsigned* tab;
    __device__ __forceinline__ const char* baseA(const U&) const { return (const char*)X; }
    __device__ __forceinline__ const char* baseB(const U& u) const { return (const char*)(W13T + ((size_t)u.e * 512 + u.pn * 256) * D); }
    __device__ __forceinline__ unsigned goffA(const U& u, int r, int C) const { return tab[u.ti * 256 + r] + (unsigned)C * 2u; }
    __device__ __forceinline__ unsigned goffB(const U&, int, int) const { return 0u; }
    __device__ __forceinline__ bool next(int i, U& u) const { const int L = i * NWG + vcu; const int rb = L >> 1; if (rb >= nrbt) return false; u.rb = rb; u.pn = L & 1; u.ti = i; u.e = __builtin_amdgcn_readlane(ev, i); return true; }
    __device__ __forceinline__ int K(const U&) const { return D; }
};
struct EpiSwiGLU {
    static constexpr int NVM = 8;
    unsigned char* HID;
    __device__ __forceinline__ void operator()(const AccT& acc, const UnitE& u, int wr, int wc, int fr, int fq) const {
        ROWLOOP { unsigned char* rp = HID + (size_t)(u.rb * 256 + UROW) * DE + u.pn * 128;
            f32x4 h0, h1;
#pragma unroll
            for (int j = 0; j < 4; ++j) { const float a0 = acc[ai][0][m][0][j] * 0.015625f, a1 = acc[ai][0][m][1][j] * 0.015625f; h0[j] = a0 * sigmoidf_(a0) * (acc[ai][1][m][0][j] * 0.015625f); h1[j] = a1 * sigmoidf_(a1) * (acc[ai][1][m][1][j] * 0.015625f); }
            int t0 = __builtin_amdgcn_cvt_pk_fp8_f32(h0.x, h0.y, 0, false); t0 = __builtin_amdgcn_cvt_pk_fp8_f32(h0.z, h0.w, t0, true);
            int t1 = __builtin_amdgcn_cvt_pk_fp8_f32(h1.x, h1.y, 0, false); t1 = __builtin_amdgcn_cvt_pk_fp8_f32(h1.z, h1.w, t1, true);
            u32x2 w; w.x = (unsigned)t0; w.y = (unsigned)t1; *(u32x2*)(rp + wc * 32 + 8 * fq) = w; }
    }
};
struct SchedG2 {
    typedef UnitE U;
    static constexpr bool GA = false, GB = false, PERM = true;
    const unsigned char* HID; const unsigned char* W2T; const int* BLKE; int nrbt, vcu; int ev; int Kk, lda, ldb;
    __device__ __forceinline__ const char* baseA(const U& u) const { return (const char*)(HID + (size_t)u.rb * 256 * DE); }
    __device__ __forceinline__ const char* baseB(const U& u) const { return (const char*)(W2T + ((size_t)u.e * D + u.pn * 256) * DE); }
    __device__ __forceinline__ bool next(int i, U& u) const { const int L = i * NWG + vcu; const int rb = L >> 2; if (rb >= nrbt) return false; u.rb = rb; u.pn = L & 3; u.ti = i; u.e = __builtin_amdgcn_readlane(ev, i); return true; }
    __device__ __forceinline__ int K(const U&) const { return DE; }
};
struct EpiScatter {
    static constexpr int NVM = 16;
    bf16* YA; int dry;
    __device__ __forceinline__ void operator()(const AccT& acc, const UnitE& u, int wr, int wc, int fr, int fq) const {
        const size_t rbase = (size_t)u.rb * 256;
        ROWLOOP { unsigned char* rp = (unsigned char*)YA + (rbase + UROW) * D + u.pn * 256;
#pragma unroll
            for (int bj = 0; bj < 2; ++bj) { const f32x4 v0 = acc[ai][bj][m][0] * 0.25f, v1 = acc[ai][bj][m][1] * 0.25f; u32x2 w;
                int t0 = __builtin_amdgcn_cvt_pk_fp8_f32(v0.x, v0.y, 0, false); t0 = __builtin_amdgcn_cvt_pk_fp8_f32(v0.z, v0.w, t0, true);
                int t1 = __builtin_amdgcn_cvt_pk_fp8_f32(v1.x, v1.y, 0, false); t1 = __builtin_amdgcn_cvt_pk_fp8_f32(v1.z, v1.w, t1, true);
                w.x = (unsigned)t0; w.y = (unsigned)t1; *(u32x2*)(rp + UCOLP(bj)) = w; } }
    }
};

__device__ __forceinline__ int rho_to_tok(int rho, int g) { const int sh = 14 - 2 * g; const int rp = rho & 16383; return (rho & ~16383) + (rp >> sh) + ((rp & ((1 << sh) - 1)) << (2 * g)); }
__device__ __forceinline__ int tok_to_rho(int t, int g) { const int sh = 14 - 2 * g; const int tp = t & 16383; return (t & ~16383) + ((tp & ((1 << (2 * g)) - 1)) << sh) + (tp >> (2 * g)); }
struct UnitQ { int type, g, pm, pn; };
struct SchedQK {
    typedef UnitQ U;
    static constexpr bool GA = false, GB = false, PERM = true; static constexpr int Kk = D, ldb = D;
    const unsigned char* X; const unsigned char* WqkT; int g, lda, vcu;
    __device__ __forceinline__ bool next(int i, U& u) const { const int L = i * NWG + vcu; if (L >= 512) return false; u.type = 0; u.g = g; u.pm = L >> 2; u.pn = L & 3; return true; }
    __device__ __forceinline__ int K(const U&) const { return D; }
    __device__ __forceinline__ const char* baseA(const U& u) const { return (const char*)(X + (size_t)rho_to_tok(u.pm * 256, g) * D); }
    __device__ __forceinline__ const char* baseB(const U& u) const { return (const char*)(WqkT + ((size_t)g * 1024 + u.pn * 256) * D); }
    __device__ __forceinline__ const char* rowA(const U& u, int r) const { return (const char*)(X + (size_t)rho_to_tok(u.pm * 256 + r, g) * D); }
    __device__ __forceinline__ const char* rowB(const U& u, int r) const { return (const char*)(WqkT + ((size_t)g * 1024 + u.pn * 256 + r) * D); }
};
struct SchedVT {
    typedef UnitQ U;
    static constexpr bool GA = false, GB = false, PERM = true; static constexpr int Kk = D, lda = D;
    const unsigned char* X; const unsigned char* WvT; int g, ldb, vcu;
    __device__ __forceinline__ bool next(int i, U& u) const { const int L = i * NWG + vcu; if (L >= 256) return false; u.type = 1; u.g = g; u.pn = L >> 1; u.pm = L & 1; return true; }
    __device__ __forceinline__ int K(const U&) const { return D; }
    __device__ __forceinline__ const char* baseA(const U& u) const { return (const char*)(WvT + ((size_t)g * 512 + u.pm * 256) * D); }
    __device__ __forceinline__ const char* baseB(const U& u) const { return (const char*)(X + (size_t)rho_to_tok(u.pn * 256, g) * D); }
    __device__ __forceinline__ const char* rowA(const U& u, int r) const { return (const char*)(WvT + ((size_t)g * 512 + u.pm * 256 + r) * D); }
    __device__ __forceinline__ const char* rowB(const U& u, int r) const { return (const char*)(X + (size_t)rho_to_tok(u.pn * 256 + r, g) * D); }
};
struct EpiQKV {
    static constexpr int NVM = 16;
    bf16* QK; bf16* VT;
    __device__ __forceinline__ void operator()(const AccT& acc, const UnitQ& u, int wr, int wc, int fr, int fq) const {
        bf16* base; size_t ldc;
        if (u.type == 0) { base = QK + (size_t)u.g * M * 1024; ldc = 1024; } else { base = VT + (size_t)u.g * 512 * M; ldc = M; }
        ROWLOOP { bf16* rp = base + (size_t)(u.pm * 256 + UROW) * ldc + u.pn * 256;
#pragma unroll
            for (int bj = 0; bj < 2; ++bj) *(u32x4*)(rp + UCOLP(bj)) = pk8(acc[ai][bj][m][0] * 0.015625f, acc[ai][bj][m][1] * 0.015625f); }
    }
};

__device__ __forceinline__ void tr_item(const float* src, int spitch, bf16* dst, int dpitch, LAS float* scr, int lane) {
#pragma unroll 4
    for (int i = 0; i < 16; ++i) { const int k = 4 * i + (lane >> 4), n4 = (lane & 15) * 4; const f32x4 v = *(const f32x4*)(src + (size_t)k * spitch + n4);
        LAS float* s = scr + k * 65 + n4; s[0] = v.x; s[1] = v.y; s[2] = v.z; s[3] = v.w; }
    LDS_WAIT(); asm volatile("" ::: "memory");
    const int c = lane & 7;
#pragma unroll
    for (int j = 0; j < 8; ++j) { const int n = 8 * j + (lane >> 3); const LAS float* s = scr + (8 * c) * 65 + n;
        u32x4 o; o.x = pk2(s[0], s[65]); o.y = pk2(s[2 * 65], s[3 * 65]); o.z = pk2(s[4 * 65], s[5 * 65]); o.w = pk2(s[6 * 65], s[7 * 65]);
        *(u32x4*)(dst + (size_t)n * dpitch + 8 * c) = o; }
    LDS_WAIT(); asm volatile("" ::: "memory");
}
__device__ __forceinline__ void tr_item8(const float* src, int spitch, unsigned char* dst, int dpitch, LAS float* scr, int lane) {
#pragma unroll 4
    for (int i = 0; i < 16; ++i) { const int k = 4 * i + (lane >> 4), n4 = (lane & 15) * 4; const f32x4 v = *(const f32x4*)(src + (size_t)k * spitch + n4);
        LAS float* s = scr + k * 65 + n4; s[0] = v.x; s[1] = v.y; s[2] = v.z; s[3] = v.w; }
    LDS_WAIT(); asm volatile("" ::: "memory");
    const int c = lane & 7;
#pragma unroll
    for (int j = 0; j < 8; ++j) { const int n = 8 * j + (lane >> 3); const LAS float* s = scr + (8 * c) * 65 + n;
        int t0 = __builtin_amdgcn_cvt_pk_fp8_f32(s[0] * 64.f, s[65] * 64.f, 0, false); t0 = __builtin_amdgcn_cvt_pk_fp8_f32(s[2 * 65] * 64.f, s[3 * 65] * 64.f, t0, true);
        int t1 = __builtin_amdgcn_cvt_pk_fp8_f32(s[4 * 65] * 64.f, s[5 * 65] * 64.f, 0, false); t1 = __builtin_amdgcn_cvt_pk_fp8_f32(s[6 * 65] * 64.f, s[7 * 65] * 64.f, t1, true);
        u32x2 o; o.x = (unsigned)t0; o.y = (unsigned)t1; *(u32x2*)(dst + (size_t)n * dpitch + 8 * c) = o; }
    LDS_WAIT(); asm volatile("" ::: "memory");
}
template <class RowMap>
__device__ __forceinline__ void tr_matrix(Frame& F, const float* W, int K, int N, bf16* WT, int dpitch, RowMap drow) {
    LAS float* scr = (LAS float*)(F.lds + F.wave * 16640);
    const int nkb = K / 64, nnb = N / 64;
    for (int it = F.vcu * NWAVES + F.wave; it < nkb * nnb; it += NGW) { const int kb = it / nnb, nb = it % nnb;
        tr_item(W + (size_t)(kb * 64) * N + nb * 64, N, WT + (size_t)drow(nb * 64) * dpitch + kb * 64, dpitch, scr, F.lane); }
}
template <class RowMap>
__device__ __forceinline__ void tr_matrix8(Frame& F, const float* W, int K, int N, unsigned char* WT, int dpitch, RowMap drow) {
    LAS float* scr = (LAS float*)(F.lds + F.wave * 16640);
    const int nkb = K / 64, nnb = N / 64;
    for (int it = F.vcu * NWAVES + F.wave; it < nkb * nnb; it += NGW) { const int kb = it / nnb, nb = it % nnb;
        tr_item8(W + (size_t)(kb * 64) * N + nb * 64, N, WT + (size_t)drow(nb * 64) * dpitch + kb * 64, dpitch, scr, F.lane); }
}
__device__ __forceinline__ void cv_src(int it, const float* w1, const float* w3, const float* w2, const float* s1, const float* s3, const float* s2, const float*& src, int& spitch) {
    const int e = it / 192, r = it % 192, which = r >> 6, tile = r & 63;
    if (which < 2) { const float* W = (e < 256) ? (which == 0 ? w1 : w3) + (size_t)e * (size_t)(D * DE) : (which == 0 ? s1 : s3); src = W + (size_t)((tile >> 2) * 64) * DE + (tile & 3) * 64; spitch = DE; }
    else { const float* W = (e < 256) ? w2 + (size_t)e * (size_t)(DE * D) : s2; src = W + (size_t)((tile >> 4) * 64) * D + (tile & 15) * 64; spitch = D; }
}
__device__ __forceinline__ void convert_experts(Frame& F, const float* w1, const float* w3, const float* w2, const float* s1, const float* s3, const float* s2) {
    LAS float* scr = (LAS float*)(F.lds + F.wave * 16640);
    unsigned char* W13T = WSP(unsigned char, WS_W13); unsigned char* W2T = WSP(unsigned char, WS_W2);
    const int lane = F.lane; const int NIT = 257 * 192;
    f32x4 cur[16], nxt[16];
    int it = F.vcu * NWAVES + F.wave;
    if (it < NIT) { const float* src; int sp; cv_src(it, w1, w3, w2, s1, s3, s2, src, sp);
#pragma unroll
        for (int i = 0; i < 16; ++i) cur[i] = __builtin_nontemporal_load((const f32x4*)(src + (size_t)(4 * i + (lane >> 4)) * sp + (lane & 15) * 4)); }
#pragma unroll 1
    for (; it < NIT; it += NGW) {
        const int itn = it + NGW;
        if (itn < NIT) { const float* src; int sp; cv_src(itn, w1, w3, w2, s1, s3, s2, src, sp);
#pragma unroll
            for (int i = 0; i < 16; ++i) nxt[i] = __builtin_nontemporal_load((const f32x4*)(src + (size_t)(4 * i + (lane >> 4)) * sp + (lane & 15) * 4)); }
#pragma unroll
        for (int i = 0; i < 16; ++i) { const int k = 4 * i + (lane >> 4), n4 = (lane & 15) * 4; LAS float* s = scr + k * 65 + n4; s[0] = cur[i].x; s[1] = cur[i].y; s[2] = cur[i].z; s[3] = cur[i].w; }
        LDS_WAIT(); asm volatile("" ::: "memory");
        const int e = it / 192, r = it % 192, which = r >> 6, tile = r & 63, c = lane & 7;
        if (which < 2) { const int kb = tile >> 2, nb = tile & 3; const int drow = (nb >> 1) * 256 + which * 128 + (nb & 1) * 64; unsigned char* dst = W13T + ((size_t)e * 512 + drow) * D + kb * 64;
#pragma unroll
            for (int j = 0; j < 8; ++j) { const int n = 8 * j + (lane >> 3); const LAS float* s = scr + (8 * c) * 65 + n;
                int t0 = __builtin_amdgcn_cvt_pk_fp8_f32(s[0] * 64.f, s[65] * 64.f, 0, false); t0 = __builtin_amdgcn_cvt_pk_fp8_f32(s[2 * 65] * 64.f, s[3 * 65] * 64.f, t0, true);
                int t1 = __builtin_amdgcn_cvt_pk_fp8_f32(s[4 * 65] * 64.f, s[5 * 65] * 64.f, 0, false); t1 = __builtin_amdgcn_cvt_pk_fp8_f32(s[6 * 65] * 64.f, s[7 * 65] * 64.f, t1, true);
                u32x2 o; o.x = (unsigned)t0; o.y = (unsigned)t1; *(u32x2*)(dst + (size_t)n * D + 8 * c) = o; } }
        else { const int kb = tile >> 4, nb = tile & 15; unsigned char* dst = W2T + ((size_t)e * D + nb * 64) * DE + kb * 64;
#pragma unroll
            for (int j = 0; j < 8; ++j) { const int n = 8 * j + (lane >> 3); const LAS float* s = scr + (8 * c) * 65 + n;
                int t0 = __builtin_amdgcn_cvt_pk_fp8_f32(s[0] * 64.f, s[65] * 64.f, 0, false); t0 = __builtin_amdgcn_cvt_pk_fp8_f32(s[2 * 65] * 64.f, s[3 * 65] * 64.f, t0, true);
                int t1 = __builtin_amdgcn_cvt_pk_fp8_f32(s[4 * 65] * 64.f, s[5 * 65] * 64.f, 0, false); t1 = __builtin_amdgcn_cvt_pk_fp8_f32(s[6 * 65] * 64.f, s[7 * 65] * 64.f, t1, true);
                u32x2 o; o.x = (unsigned)t0; o.y = (unsigned)t1; *(u32x2*)(dst + (size_t)n * DE + 8 * c) = o; } }
        LDS_WAIT(); asm volatile("" ::: "memory");
#pragma unroll
        for (int i = 0; i < 16; ++i) cur[i] = nxt[i];
    }
}
struct MapId { __device__ int operator()(int n0) const { return n0; } };
struct MapGate { int which; __device__ int operator()(int n0) const { return (n0 >> 7) * 256 + which * 128 + (n0 & 127); } };
struct MapQ { __device__ int operator()(int n0) const { return (n0 >> 9) * 1024 + (n0 & 511); } };
struct MapKV { __device__ int operator()(int n0) const { return n0 < 1536 ? (n0 >> 9) * 1024 + 512 + (n0 & 511) : 3072 + (n0 - 1536); } };

__device__ __forceinline__ void p0_prologue(Frame& F, const Args& A) {
    { const float* x = A.in[0]; unsigned char* XQ = WSP(unsigned char, WS_RA + RA_XB);
      for (size_t i = (size_t)F.vcu * NTHR + F.tid; i < (size_t)M * D / 8; i += NGT) { const f32x4 a = *(const f32x4*)(x + i * 8), b = *(const f32x4*)(x + i * 8 + 4);
          int t0 = __builtin_amdgcn_cvt_pk_fp8_f32(a.x, a.y, 0, false); t0 = __builtin_amdgcn_cvt_pk_fp8_f32(a.z, a.w, t0, true);
          int t1 = __builtin_amdgcn_cvt_pk_fp8_f32(b.x, b.y, 0, false); t1 = __builtin_amdgcn_cvt_pk_fp8_f32(b.z, b.w, t1, true);
          u32x2 o; o.x = (unsigned)t0; o.y = (unsigned)t1; *(u32x2*)(XQ + i * 8) = o; } }
    tr_matrix8(F, A.in[1], D, 2048, WSP(unsigned char, WS_WIN), D, MapId());
    for (int b = 0; b < 4; ++b) { tr_matrix(F, A.in[4] + b * 65536, 256, 256, WSP(bf16, WS_WG) + (size_t)b * 512 * 256, 256, MapGate{0});
                                  tr_matrix(F, A.in[6] + b * 65536, 256, 256, WSP(bf16, WS_WG) + (size_t)b * 512 * 256, 256, MapGate{1}); }
    tr_matrix(F, A.in[9], D, D, WSP(bf16, WS_WOUT), D, MapId());
    tr_matrix8(F, A.in[11], D, QW, WSP(unsigned char, WS_WQK), D, MapQ());
    tr_matrix8(F, A.in[10], D, 2 * QW, WSP(unsigned char, WS_WQK), D, MapKV());
    tr_matrix(F, A.in[12], OW, D, WSP(bf16, WS_WO), OW, MapId());
    for (int l = 0; l < 2; ++l) tr_matrix(F, A.in[13] + (size_t)l * D * NE, D, NE, WSP(bf16, WS_WR) + (size_t)l * NE * D, D, MapId());
    convert_experts(F, A.in[15], A.in[16], A.in[17], A.in[18], A.in[19], A.in[20]);
}
static_assert(WS_WV == WS_WQK + (size_t)3072 * 1024 * 2, "WvT must follow WqkT");

__device__ __forceinline__ void ln_store(f32x4 (&v)[4], const float* g, const float* b, float* of, bf16* ob, int lane, unsigned char* oq = nullptr) {
    float s = 0.f;
#pragma unroll
    for (int j = 0; j < 4; ++j) s += (v[j].x + v[j].y) + (v[j].z + v[j].w);
    const float mean = wave_sum(s) * (1.f / D); float s2 = 0.f;
#pragma unroll
    for (int j = 0; j < 4; ++j) { v[j] = v[j] - mean; s2 += (v[j].x * v[j].x + v[j].y * v[j].y) + (v[j].z * v[j].z + v[j].w * v[j].w); }
    const float rstd = 1.f / sqrtf(wave_sum(s2) * (1.f / D) + LN_EPS);
#pragma unroll
    for (int j = 0; j < 4; ++j) { const int c = 4 * lane + 256 * j; const f32x4 gg = *(const f32x4*)(g + c), bb = *(const f32x4*)(b + c); const f32x4 y = v[j] * rstd * gg + bb;
        if (of) *(f32x4*)(of + c) = y;
        if (ob) { u32x2 w; w.x = pk2(y.x, y.y); w.y = pk2(y.z, y.w); *(u32x2*)(ob + c) = w; }
        if (oq) { int t = __builtin_amdgcn_cvt_pk_fp8_f32(y.x, y.y, 0, false); t = __builtin_amdgcn_cvt_pk_fp8_f32(y.z, y.w, t, true); *(unsigned*)(oq + c) = (unsigned)t; } }
}

__device__ __forceinline__ int moe_unit_experts(Frame& F, const int* BLKE, int nrbt, int shift) { const int L = F.lane * NWG + F.vcu; const int rb = L >> shift; return rb < nrbt ? BLKE[rb] : 0; }
__device__ __forceinline__ const LAS unsigned* moe_row_table(Frame& F, const int* ROWA, int nrbt) {
    LAS unsigned* tab = (LAS unsigned*)(F.lds + 131072);
    for (int i = 0; i < 15; ++i) { const int rb = (i * NWG + F.vcu) >> 1; if (rb >= nrbt) break;
        if (F.tid < 256) { const int a = ROWA[rb * 256 + F.tid]; const int tok = a < 0 ? 0 : (a < 8 * M ? (a >> 3) : a - 8 * M); tab[i * 256 + F.tid] = (unsigned)tok * (unsigned)D; } }
    __syncthreads();
    return tab;
}
__device__ __forceinline__ void p_conv(Frame& F, const float* cw, const float* cb) {
    const bf16* XR = WSP(bf16, WS_RA + RA_XR); bf16* XC = WSP(bf16, WS_RA + RA_XC);
    for (int i = F.vcu * NTHR + F.tid; i < M * (D / 8); i += NGT) { const int t = i >> 7, c = (i & 127) * 8; const int ts = t & (SEQ - 1);
        float a[8];
#pragma unroll
        for (int q = 0; q < 8; ++q) a[q] = cb[c + q];
#pragma unroll
        for (int j = 0; j < 4; ++j) { if (ts - 3 + j >= 0) { const u32x4 w = *(const u32x4*)(XR + (size_t)(t - 3 + j) * D + c); const float* wj = cw + j * D + c;
            a[0] += wj[0] * bf_lo(w.x); a[1] += wj[1] * bf_hi(w.x); a[2] += wj[2] * bf_lo(w.y); a[3] += wj[3] * bf_hi(w.y);
            a[4] += wj[4] * bf_lo(w.z); a[5] += wj[5] * bf_hi(w.z); a[6] += wj[6] * bf_lo(w.w); a[7] += wj[7] * bf_hi(w.w); } }
        u32x4 o; o.x = pk2(a[0], a[1]); o.y = pk2(a[2], a[3]); o.z = pk2(a[4], a[5]); o.w = pk2(a[6], a[7]); *(u32x4*)(XC + (size_t)t * D + c) = o; }
}
constexpr int CH = 64, NCH = SEQ / CH;
__device__ __forceinline__ void p_scan1(Frame& F) {
    const bf16* LA = WSP(bf16, WS_RA + RA_LA); const bf16* UU = WSP(bf16, WS_RA + RA_U); float* CP = WSP(float, WS_CHP); float* CHh = WSP(float, WS_CHH);
    for (int i = F.vcu * NTHR + F.tid; i < BATCH * NCH * (D / 4); i += NGT) { const int c4 = (i & 255) * 4, ck = (i >> 8) & (NCH - 1), b = i >> 16;
        const size_t r0 = ((size_t)b * SEQ + (size_t)ck * CH) * D + c4; f32x4 h = {0.f, 0.f, 0.f, 0.f}, sl = {0.f, 0.f, 0.f, 0.f};
#pragma unroll 8
        for (int t = 0; t < CH; ++t) { const u32x2 lw = *(const u32x2*)(LA + r0 + (size_t)t * D), uw = *(const u32x2*)(UU + r0 + (size_t)t * D);
            const f32x4 la = {bf_lo(lw.x), bf_hi(lw.x), bf_lo(lw.y), bf_hi(lw.y)}, u = {bf_lo(uw.x), bf_hi(uw.x), bf_lo(uw.y), bf_hi(uw.y)};
#pragma unroll
            for (int j = 0; j < 4; ++j) { h[j] = __expf(la[j]) * h[j] + u[j]; sl[j] += la[j]; } }
#pragma unroll
        for (int j = 0; j < 4; ++j) { const size_t o = ((size_t)b * D + c4 + j) * NCH + ck; CP[o] = __expf(sl[j]); CHh[o] = h[j]; } }
}
__device__ __forceinline__ void p_scan2(Frame& F) {
    const float* CP = WSP(float, WS_CHP); const float* CHh = WSP(float, WS_CHH); float* CIN = WSP(float, WS_CIN);
    for (int s = F.vcu * NWAVES + F.wave; s < BATCH * D; s += NGW) { const size_t o = (size_t)s * NCH + 4 * F.lane;
        const f32x4 p4 = *(const f32x4*)(CP + o), h4 = *(const f32x4*)(CHh + o);
        float p = p4.x, h = h4.x; h = p4.y * h + h4.y; p *= p4.y; h = p4.z * h + h4.z; p *= p4.z; h = p4.w * h + h4.w; p *= p4.w;
#pragma unroll
        for (int off = 1; off < 64; off <<= 1) { const float pp = __shfl_up(p, off), hp = __shfl_up(h, off); if (F.lane >= off) { h = p * hp + h; p = pp * p; } }
        float c0 = __shfl_up(h, 1); if (F.lane == 0) c0 = 0.f;
        f32x4 ci; ci.x = c0; ci.y = p4.x * ci.x + h4.x; ci.z = p4.y * ci.y + h4.y; ci.w = p4.z * ci.z + h4.z;
        *(f32x4*)(CIN + o) = ci; }
}
__device__ __forceinline__ void p_scan3(Frame& F) {
    const bf16* LA = WSP(bf16, WS_RA + RA_LA); const bf16* UU = WSP(bf16, WS_RA + RA_U); const float* CIN = WSP(float, WS_CIN);
    const bf16* GG = WSP(bf16, WS_RA + RA_GG); bf16* YB = WSP(bf16, WS_RA + RA_YB);
    for (int i = F.vcu * NTHR + F.tid; i < BATCH * NCH * (D / 4); i += NGT) { const int c4 = (i & 255) * 4, ck = (i >> 8) & (NCH - 1), b = i >> 16;
        const size_t r0 = ((size_t)b * SEQ + (size_t)ck * CH) * D + c4; f32x4 h;
#pragma unroll
        for (int j = 0; j < 4; ++j) h[j] = CIN[((size_t)b * D + c4 + j) * NCH + ck];
#pragma unroll 1
        for (int t0 = 0; t0 < CH; t0 += 8) { u32x2 lw[8], uw[8], gw[8];
#pragma unroll
            for (int k = 0; k < 8; ++k) { const size_t o = r0 + (size_t)(t0 + k) * D; lw[k] = *(const u32x2*)(LA + o); uw[k] = *(const u32x2*)(UU + o); gw[k] = *(const u32x2*)(GG + o); }
#pragma unroll
            for (int k = 0; k < 8; ++k) { const f32x4 la = {bf_lo(lw[k].x), bf_hi(lw[k].x), bf_lo(lw[k].y), bf_hi(lw[k].y)}, u = {bf_lo(uw[k].x), bf_hi(uw[k].x), bf_lo(uw[k].y), bf_hi(uw[k].y)};
#pragma unroll
                for (int j = 0; j < 4; ++j) h[j] = __expf(la[j]) * h[j] + u[j];
                u32x2 o; o.x = pk2(h.x * bf_lo(gw[k].x), h.y * bf_hi(gw[k].x)); o.y = pk2(h.z * bf_lo(gw[k].y), h.w * bf_hi(gw[k].y)); *(u32x2*)(YB + r0 + (size_t)(t0 + k) * D) = o; } } }
}
__device__ __forceinline__ void p_ln(Frame& F, const float* V, const float* g, const float* b, float* Hf, bf16* Hb) {
    unsigned char* Hq = WSP(unsigned char, WS_HQ);
    for (int r = F.vcu * NWAVES + F.wave; r < M; r += NGW) { const f32x4* xr = (const f32x4*)(V + (size_t)r * D) + F.lane; f32x4 v[4];
#pragma unroll
        for (int j = 0; j < 4; ++j) v[j] = xr[64 * j];
        ln_store(v, g, b, Hf + (size_t)r * D, Hb + (size_t)r * D, F.lane, Hq + (size_t)r * D); }
}
template <int CTRL> __device__ __forceinline__ float dppf(float x) { return __builtin_bit_cast(float, __builtin_amdgcn_mov_dpp(__builtin_bit_cast(int, x), CTRL, 0xF, 0xF, true)); }
template <int CTRL> __device__ __forceinline__ unsigned dppu(unsigned x) { return (unsigned)__builtin_amdgcn_mov_dpp((int)x, CTRL, 0xF, 0xF, true); }
__device__ __forceinline__ float rdlane_f(float x, int l) { return __builtin_bit_cast(float, __builtin_amdgcn_readlane(__builtin_bit_cast(int, x), l)); }
__device__ __forceinline__ void p_route(Frame& F, const float* bias) {
    const float* LG = WSP(float, WS_LOGITS); int* TOPI = WSP(int, WS_TOPI); float* GATE = WSP(float, WS_GATE); int* HIST = WSP(int, WS_HIST);
    LAS int* hist = (LAS int*)F.lds; const int lane = F.lane;
    if (F.tid < 256) hist[F.tid] = 0;
    __syncthreads();
    const f32x4 bv = *(const f32x4*)(bias + 4 * lane);
#pragma unroll 2
    for (int j = 0; j < 16; ++j) { const int t = F.vcu * 128 + F.wave * 16 + j;
        const f32x4 z = *(const f32x4*)(LG + (size_t)t * NE + 4 * lane);
        const float s0 = sigmoidf_(z.x), s1 = sigmoidf_(z.y), s2 = sigmoidf_(z.z), s3 = sigmoidf_(z.w);
        const float v0 = s0 + bv.x, v1 = s1 + bv.y, v2 = s2 + bv.z, v3 = s3 + bv.w;
        float m1, m2; { const float a = fmaxf(v0, v1), b = fminf(v0, v1), c = fmaxf(v2, v3), d = fminf(v2, v3); m1 = fmaxf(a, c); m2 = fmaxf(fminf(a, c), fmaxf(b, d)); }
        { float o1 = dppf<0xB1>(m1), o2 = dppf<0xB1>(m2); float n1 = fmaxf(m1, o1), n2 = fmaxf(fminf(m1, o1), fmaxf(m2, o2)); m1 = n1; m2 = n2;
          o1 = dppf<0x4E>(m1); o2 = dppf<0x4E>(m2); n1 = fmaxf(m1, o1); n2 = fmaxf(fminf(m1, o1), fmaxf(m2, o2)); m1 = n1; m2 = n2;
          o1 = dppf<0x141>(m1); o2 = dppf<0x141>(m2); n1 = fmaxf(m1, o1); n2 = fmaxf(fminf(m1, o1), fmaxf(m2, o2)); m1 = n1; m2 = n2; }
        const float gs = m1 + m2; const int g = lane >> 3; int rank = 0;
#pragma unroll
        for (int q = 0; q < 8; ++q) { const float o = rdlane_f(gs, 8 * q); rank += (o > gs || (o == gs && q < g)) ? 1 : 0; }
        const bool sel = rank < 4;
        const unsigned ib = 255u - 4u * (unsigned)lane;
        unsigned k0 = sel ? ((__float_as_uint(v0 + 1.0f) & ~255u) | ib) : 0u, k1 = sel ? ((__float_as_uint(v1 + 1.0f) & ~255u) | (ib - 1u)) : 0u;
        unsigned k2 = sel ? ((__float_as_uint(v2 + 1.0f) & ~255u) | (ib - 2u)) : 0u, k3 = sel ? ((__float_as_uint(v3 + 1.0f) & ~255u) | (ib - 3u)) : 0u;
        int myidx = 0; float mys = 0.f, tot = 0.f;
#pragma unroll
        for (int k = 0; k < TOPK; ++k) {
            unsigned mk = max(max(k0, k1), max(k2, k3));
            mk = max(mk, dppu<0xB1>(mk)); mk = max(mk, dppu<0x4E>(mk)); mk = max(mk, dppu<0x141>(mk)); mk = max(mk, dppu<0x140>(mk));
            const unsigned win = max(max((unsigned)__builtin_amdgcn_readlane((int)mk, 0), (unsigned)__builtin_amdgcn_readlane((int)mk, 16)), max((unsigned)__builtin_amdgcn_readlane((int)mk, 32), (unsigned)__builtin_amdgcn_readlane((int)mk, 48)));
            const int idx = 255 - (int)(win & 255u);
            k0 = (k0 == win) ? 0u : k0; k1 = (k1 == win) ? 0u : k1; k2 = (k2 == win) ? 0u : k2; k3 = (k3 == win) ? 0u : k3;
            const int qq = idx & 3; const float sq = qq == 0 ? s0 : (qq == 1 ? s1 : (qq == 2 ? s2 : s3)); const float sw = rdlane_f(sq, idx >> 2);
            tot += sw; if (lane == k) { myidx = idx; mys = sw; }
        }
        if (lane < TOPK) { TOPI[t * TOPK + lane] = myidx; GATE[t * TOPK + lane] = mys / tot * 2.5f; atomicAdd((int*)&hist[myidx], 1); }
    }
    __syncthreads();
    if (F.tid < 256) HIST[F.vcu * 256 + F.tid] = hist[F.tid];
    __syncthreads();
}
__device__ __forceinline__ void p_sort(Frame& F) {
    const int* HIST = WSP(int, WS_HIST); const int* TOPI = WSP(int, WS_TOPI); int* ROWA = WSP(int, WS_ROWA); int* POS = WSP(int, WS_POS); int* BLKE = WSP(int, WS_BLKE); int* META = WSP(int, WS_META);
    LAS int* cnt = (LAS int*)F.lds; LAS int* myoff = cnt + 256; LAS int* nb = cnt + 512; LAS int* blk0 = cnt + 768; LAS int* lcnt = cnt + 1024;
    { typedef int i32x4 __attribute__((ext_vector_type(4)));
      const int q = F.tid >> 6, l = F.tid & 63; i32x4 c = {0, 0, 0, 0}, mo = {0, 0, 0, 0};
#pragma unroll 8
      for (int w = q; w < NWG; w += 8) { const i32x4 h = *(const i32x4*)(HIST + w * 256 + 4 * l); c += h; if (w < F.vcu) mo += h; }
      LAS int* redc = cnt + 1280; LAS int* redm = redc + 2048;
#pragma unroll
      for (int j = 0; j < 4; ++j) { redc[q * 256 + 4 * l + j] = c[j]; redm[q * 256 + 4 * l + j] = mo[j]; }
      __syncthreads();
      if (F.tid < 256) { const int e = F.tid; int cc = 0, mm = 0;
#pragma unroll
          for (int k = 0; k < 8; ++k) { cc += redc[k * 256 + e]; mm += redm[k * 256 + e]; }
          cnt[e] = cc; myoff[e] = mm; nb[e] = (cc + 255) >> 8; lcnt[e] = 0; } }
    __syncthreads();
    if (F.tid < 256) { int b = 0; for (int j = 0; j < F.tid; ++j) b += nb[j]; blk0[F.tid] = b; }
    __syncthreads();
    for (int al = F.tid; al < 1024; al += NTHR) { const int a = F.vcu * 1024 + al; const int e = TOPI[a]; const int pos = blk0[e] * 256 + myoff[e] + atomicAdd((int*)&lcnt[e], 1); ROWA[pos] = a; POS[a] = pos; }
    const int nrb = blk0[255] + nb[255];
    { const int e = F.vcu; const int start = blk0[e] * 256 + cnt[e], end = (blk0[e] + nb[e]) * 256;
      for (int p = start + F.tid; p < end; p += NTHR) ROWA[p] = -1;
      for (int j = F.tid; j < nb[e]; j += NTHR) BLKE[blk0[e] + j] = e; }
    for (int tl = F.tid; tl < 128; tl += NTHR) { const int t = F.vcu * 128 + tl; ROWA[nrb * 256 + t] = 8 * M + t; }
    if (F.vcu == 0) { for (int j = F.tid; j < 128; j += NTHR) BLKE[nrb + j] = 256; if (F.tid == 0) META[0] = nrb + 128; }
    __syncthreads();
}
__device__ __forceinline__ void p_combine(Frame& F, const float* Hin, const float* g, const float* b, float* Hf, unsigned char* Hq) {
    const bf16* YA = WSP(bf16, WS_RA); const float* GATE = WSP(float, WS_GATE); const int* POS = WSP(int, WS_POS); const int shrow0 = (*WSP(int, WS_META) - 128) * 256;
    for (int t = F.vcu * NWAVES + F.wave; t < M; t += NGW) { f32x4 v[4];
        const f32x4* hr = (const f32x4*)(Hin + (size_t)t * D) + F.lane;
#pragma unroll
        for (int j = 0; j < 4; ++j) v[j] = hr[64 * j] * ALPHA;
        f32x4 r[4];
#pragma unroll
        for (int j = 0; j < 4; ++j) r[j] = (f32x4){0.f, 0.f, 0.f, 0.f};
#pragma unroll
        for (int k = 0; k < TOPK; ++k) { const float gk = GATE[t * TOPK + k] * 0.0625f; const unsigned* yr = (const unsigned*)((const unsigned char*)YA + (size_t)POS[t * TOPK + k] * D) + F.lane;
#pragma unroll
            for (int j = 0; j < 4; ++j) { const unsigned w = yr[64 * j]; const f32x2 a = __builtin_amdgcn_cvt_pk_f32_fp8((int)w, false), c = __builtin_amdgcn_cvt_pk_f32_fp8((int)w, true);
                r[j].x += gk * a.x; r[j].y += gk * a.y; r[j].z += gk * c.x; r[j].w += gk * c.y; } }
        { const unsigned* yr = (const unsigned*)((const unsigned char*)YA + (size_t)(shrow0 + t) * D) + F.lane;
#pragma unroll
            for (int j = 0; j < 4; ++j) { const unsigned w = yr[64 * j]; const f32x2 a = __builtin_amdgcn_cvt_pk_f32_fp8((int)w, false), c = __builtin_amdgcn_cvt_pk_f32_fp8((int)w, true);
                v[j].x += r[j].x + 0.0625f * a.x; v[j].y += r[j].y + 0.0625f * a.y; v[j].z += r[j].z + 0.0625f * c.x; v[j].w += r[j].w + 0.0625f * c.y; } }
        ln_store(v, g, b, Hf + (size_t)t * D, nullptr, F.lane, Hq ? Hq + (size_t)t * D : nullptr); }
}
constexpr int AT_KP = 144, AT_VP = 784, AT_KBYTES = 384 * AT_KP, AT_VOFF = AT_KBYTES;
__device__ __forceinline__ void p_attn(Frame& F) {
    const bf16* QKb = WSP(bf16, WS_RA + RA_QK); const bf16* VTb = WSP(bf16, WS_RA + RA_VT); bf16* OGb = WSP(bf16, WS_RA + RA_OG); float* LSE = WSP(float, WS_LSE);
    const int lane = F.lane, q = lane & 31, hh = lane >> 5, w = F.wave;
    LAS unsigned char* lk = F.lds; LAS unsigned char* lv = F.lds + AT_VOFF;
#pragma unroll 1
    for (int it = F.vcu; it < 3 * 128 * 8; it += NWG) {
        const int g = it >> 10, rem = it & 1023, chunk = rem >> 3, h = rem & 7;
        const int sh = 14 - 2 * g, rq0 = chunk * 256, i0 = rq0 & ((1 << sh) - 1), rk0 = rq0 - 128;
        const bf16* QK = QKb + (size_t)g * M * 1024; const bf16* VT = VTb + (size_t)g * 512 * M;
        { const char* kb = (const char*)(QK + 512 + h * 64);
#pragma unroll
          for (int j = 0; j < 7; ++j) { const int ins = w + 8 * j; if (ins < 54) { const int p = ins * 64 + lane, row = p / 9, cc = p - row * 9; const int gr = rk0 + row < 0 ? 0 : rk0 + row;
              __builtin_amdgcn_global_load_lds((const unsigned*)(kb + (size_t)gr * 2048 + (cc > 7 ? 7 : cc) * 16), (LAS unsigned*)(lk + ins * 1024), 16, 0, 0); } }
          const char* vb = (const char*)(VT + (size_t)(h * 64) * M);
#pragma unroll
          for (int j = 0; j < 7; ++j) { const int ins = w + 8 * j; if (ins < 49) { const int p = ins * 64 + lane, row = p / 49, cc = p - row * 49; int col = rk0 + (cc > 47 ? 47 : cc) * 8; col = col < 0 ? 0 : col;
              __builtin_amdgcn_global_load_lds((const unsigned*)(vb + ((size_t)row * M + col) * 2), (LAS unsigned*)(lv + ins * 1024), 16, 0, 0); } } }
        bf16x8 Qf[4];
        { const bf16* qp = QK + (size_t)(rq0 + 32 * w + q) * 1024 + h * 64 + 8 * hh;
#pragma unroll
          for (int s2 = 0; s2 < 4; ++s2) Qf[s2] = *(const bf16x8*)(qp + 16 * s2); }
        asm volatile("s_waitcnt vmcnt(0)" ::: "memory");
        __syncthreads();
        const float slope2 = exp2f(-(float)(h + 1)) * (float)(1 << (2 * g)) * 1.4426950408889634f, sc = 0.125f * 1.4426950408889634f;
        float m_run = -1e30f, l_run = 0.f; f32x16 O0, O1;
#pragma unroll
        for (int r = 0; r < 16; ++r) { O0[r] = 0.f; O1[r] = 0.f; }
#pragma unroll 1
        for (int kt = 0; kt < 5; ++kt) { const int kr0 = 32 * w + 32 * kt; if (i0 + kr0 - 128 < 0) continue;
            bf16x8 Kf[4];
            { const LAS unsigned char* kp = lk + (kr0 + q) * AT_KP + 16 * hh;
#pragma unroll
              for (int s2 = 0; s2 < 4; ++s2) Kf[s2] = *(const LAS bf16x8*)(kp + 32 * s2); }
            bf16x8 Vf[2][2];
#pragma unroll
            for (int dd = 0; dd < 2; ++dd)
#pragma unroll
                for (int s2 = 0; s2 < 2; ++s2) { const LAS unsigned char* vp = lv + (32 * dd + q) * AT_VP + (kr0 + 16 * s2 + 4 * hh) * 2;
                    const u32x2 lo = *(const LAS u32x2*)vp, hi = *(const LAS u32x2*)(vp + 16); u32x4 wv; wv.x = lo.x; wv.y = lo.y; wv.z = hi.x; wv.w = hi.y; Vf[dd][s2] = __builtin_bit_cast(bf16x8, wv); }
            f32x16 S;
#pragma unroll
            for (int r = 0; r < 16; ++r) S[r] = 0.f;
#pragma unroll
            for (int s2 = 0; s2 < 4; ++s2) S = __builtin_amdgcn_mfma_f32_32x32x16_bf16(Kf[s2], Qf[s2], S, 0, 0, 0);
            float mx = -1e30f;
#pragma unroll
            for (int r = 0; r < 16; ++r) { const int krow = (r & 3) + 8 * (r >> 2) + 4 * hh; const int dist = 128 - 32 * kt + q - krow;
                const float sv = (dist >= 0 && dist <= 128) ? S[r] * sc - slope2 * (float)dist : -1e30f; S[r] = sv; mx = fmaxf(mx, sv); }
            mx = fmaxf(mx, __shfl_xor(mx, 32));
            const float m_new = fmaxf(m_run, mx), alpha = exp2f(m_run - m_new); float rs = 0.f;
#pragma unroll
            for (int r = 0; r < 16; ++r) { const float p = exp2f(S[r] - m_new); S[r] = p; rs += p; }
            rs += __shfl_xor(rs, 32);
            l_run = l_run * alpha + rs; m_run = m_new;
#pragma unroll
            for (int r = 0; r < 16; ++r) { O0[r] *= alpha; O1[r] *= alpha; }
            bf16x8 Pf[2];
#pragma unroll
            for (int s2 = 0; s2 < 2; ++s2) { u32x4 wv; wv.x = pk2(S[8 * s2 + 0], S[8 * s2 + 1]); wv.y = pk2(S[8 * s2 + 2], S[8 * s2 + 3]); wv.z = pk2(S[8 * s2 + 4], S[8 * s2 + 5]); wv.w = pk2(S[8 * s2 + 6], S[8 * s2 + 7]); Pf[s2] = __builtin_bit_cast(bf16x8, wv); }
#pragma unroll
            for (int s2 = 0; s2 < 2; ++s2) { O0 = __builtin_amdgcn_mfma_f32_32x32x16_bf16(Vf[0][s2], Pf[s2], O0, 0, 0, 0); O1 = __builtin_amdgcn_mfma_f32_32x32x16_bf16(Vf[1][s2], Pf[s2], O1, 0, 0, 0); }
        }
        const float inv = 1.0f / l_run;
        bf16* op = OGb + ((size_t)g * M + rq0 + 32 * w + q) * 512 + h * 64 + 4 * hh;
#pragma unroll
        for (int rg = 0; rg < 4; ++rg) { u32x2 wv; wv.x = pk2(O0[4 * rg] * inv, O0[4 * rg + 1] * inv); wv.y = pk2(O0[4 * rg + 2] * inv, O0[4 * rg + 3] * inv); *(u32x2*)(op + 8 * rg) = wv;
            u32x2 w1; w1.x = pk2(O1[4 * rg] * inv, O1[4 * rg + 1] * inv); w1.y = pk2(O1[4 * rg + 2] * inv, O1[4 * rg + 3] * inv); *(u32x2*)(op + 32 + 8 * rg) = w1; }
        if (hh == 0) LSE[((size_t)g * M + rq0 + 32 * w + q) * 8 + h] = (m_run + log2f(l_run)) * 0.6931471805599453f;
        __syncthreads();
    }
}
__device__ __forceinline__ void p_merge(Frame& F) {
    const bf16* OGb = WSP(bf16, WS_RA + RA_OG); const float* LSE = WSP(float, WS_LSE); bf16* OM = WSP(bf16, WS_RA + RA_OM);
    for (int t = F.vcu * NWAVES + F.wave; t < M; t += NGW) { const int hd = F.lane >> 3; float ls[3]; size_t ro[3];
#pragma unroll
        for (int g = 0; g < 3; ++g) { const int rho = tok_to_rho(t, g); ro[g] = ((size_t)g * M + rho); ls[g] = LSE[ro[g] * 8 + hd]; }
        const float mx = fmaxf(ls[0], fmaxf(ls[1], ls[2])); float w[3], ws = 0.f;
#pragma unroll
        for (int g = 0; g < 3; ++g) { w[g] = __expf(ls[g] - mx); ws += w[g]; }
        const float inv = 1.0f / ws; float o[8];
#pragma unroll
        for (int j = 0; j < 8; ++j) o[j] = 0.f;
#pragma unroll
        for (int g = 0; g < 3; ++g) { const u32x4 x = *(const u32x4*)(OGb + ro[g] * 512 + 8 * F.lane); const float wg = w[g] * inv;
            o[0] += wg * bf_lo(x.x); o[1] += wg * bf_hi(x.x); o[2] += wg * bf_lo(x.y); o[3] += wg * bf_hi(x.y); o[4] += wg * bf_lo(x.z); o[5] += wg * bf_hi(x.z); o[6] += wg * bf_lo(x.w); o[7] += wg * bf_hi(x.w); }
        u32x4 r; r.x = pk2(o[0], o[1]); r.y = pk2(o[2], o[3]); r.z = pk2(o[4], o[5]); r.w = pk2(o[6], o[7]); *(u32x4*)(OM + (size_t)t * OW + 8 * F.lane) = r; }
}

constexpr int NPHASE = 26;

__global__ void __launch_bounds__(NTHR, 2) yoco_fwd(Args args) {
    extern __shared__ __attribute__((aligned(16))) unsigned char lds[];
    Frame F;
    F.lds = (LAS unsigned char*)lds;
    F.tid = threadIdx.x; F.lane = F.tid & 63; F.wave = __builtin_amdgcn_readfirstlane(F.tid >> 6);
    { const int bx = blockIdx.x; F.vcu = (bx % 8) * (NWG / 8) + bx / 8; }
    F.ws = args.ws;
    volatile LAS unsigned* MISC = (volatile LAS unsigned*)(F.lds + LDS_BYTES - 64);
    if (F.tid < 16) MISC[F.tid] = 0u;
    __syncthreads();
    const int lo = args.ph_lo, hi = args.ph_hi;
    XcdBarrier bar; bar.bar = (unsigned*)(F.ws + WS_CTL) + 4096; bar.x = 0; bar.st = nullptr;
    if (hi - lo > 1) bar = xcd_barrier_post((unsigned*)(F.ws + WS_CTL) + 4096, MISC + 8);
#ifndef PROBE_G2
#define PROBE_G2 0
#endif
#ifndef DUP_MASK
#define DUP_MASK 0u
#endif
#ifndef PH_MASK
#define PH_MASK 0xFFFFFFFFu
#endif
#define IN(k) (((PH_MASK >> (k)) & 1u) && lo <= (k) && (k) < hi)
#define REP(k) for (int rep = 0, nrep = 1 + (int)((args.dup >> (k)) & 1u); rep < nrep; ++rep)
#define SEAM(k) do { if (IN(k) && IN((k) + 1)) xcd_barrier(bar); } while (0)

    if (IN(0)) { p0_prologue(F, args); } SEAM(0);
    if (IN(1)) { SchedDense8 S{WSP(unsigned char, WS_RA + RA_XB), WSP(unsigned char, WS_WIN), D, D, D, M / 256, 8, F.vcu}; EpiXZ E{WSP(bf16, WS_RA + RA_XR), WSP(bf16, WS_RA + RA_GG)}; gemm_fast8(F.lds, S, E); } SEAM(1);
    if (IN(2)) { p_conv(F, args.in[2], args.in[3]); } SEAM(2);
    if (IN(3)) { SchedGate S{WSP(bf16, WS_RA + RA_XC), WSP(bf16, WS_WG), F.vcu}; EpiGate E{WSP(bf16, WS_RA + RA_XC), args.in[5], args.in[7], args.in[8], WSP(bf16, WS_RA + RA_LA), WSP(bf16, WS_RA + RA_U)}; GEMM_PHASE(F.lds, S, E); } SEAM(3);
    if (IN(4)) { p_scan1(F); } SEAM(4);
    if (IN(5)) { p_scan2(F); } SEAM(5);
    if (IN(6)) { p_scan3(F); } SEAM(6);
    if (IN(7)) { SchedDense S{WSP(bf16, WS_RA + RA_YB), WSP(bf16, WS_WOUT), D, D, D, M / 256, 4, F.vcu}; EpiResF32 E{args.in[0], WSP(float, WS_V), D}; GEMM_PHASE(F.lds, S, E); } SEAM(7);
    if (IN(8)) { p_ln(F, WSP(float, WS_V), args.in[21] + 0 * D, args.in[22] + 0 * D, WSP(float, WS_HA), WSP(bf16, WS_HAB)); } SEAM(8);
    if (IN(9)) { SchedDense S{WSP(bf16, WS_HAB), WSP(bf16, WS_WR), D, D, D, M / 256, 1, F.vcu}; EpiF32 E{WSP(float, WS_LOGITS), NE}; GEMM_PHASE(F.lds, S, E); } SEAM(9);
    if (IN(10)) { p_route(F, args.in[14]); } SEAM(10);
    if (IN(11)) { p_sort(F); } SEAM(11);
    if (IN(12)) { const int nrbt = *WSP(int, WS_META); SchedG1 S{WSP(unsigned char, WS_HQ), WSP(unsigned char, WS_W13), WSP(int, WS_ROWA), WSP(int, WS_BLKE), nrbt, F.vcu, moe_unit_experts(F, WSP(int, WS_BLKE), nrbt, 1), moe_row_table(F, WSP(int, WS_ROWA), nrbt)}; EpiSwiGLU E{WSP(unsigned char, WS_HID)}; gemm_fast8(F.lds, S, E); } SEAM(12);
    if (IN(13)) { const int nrbt = *WSP(int, WS_META); SchedG2 S{WSP(unsigned char, WS_HID), WSP(unsigned char, WS_W2), WSP(int, WS_BLKE), nrbt, F.vcu, moe_unit_experts(F, WSP(int, WS_BLKE), nrbt, 2), args.rt256, args.rt256, args.rt256}; EpiScatter E{WSP(bf16, WS_RA), 0}; gemm_fast8(F.lds, S, E); if (PROBE_G2) { __syncthreads(); EpiScatter E2{(PROBE_G2 == 2 || PROBE_G2 == 4) ? WSP(bf16, WS_V) : WSP(bf16, WS_RA), PROBE_G2 == 3 ? 0 : PROBE_G2}; gemm_fast8(F.lds, S, E2); } } SEAM(13);
    if (IN(14)) { p_combine(F, WSP(float, WS_HA), args.in[21] + 1 * D, args.in[22] + 1 * D, WSP(float, WS_HB), WSP(unsigned char, WS_HQ)); convert_experts(F, args.in[15] + (size_t)NE * D * DE, args.in[16] + (size_t)NE * D * DE, args.in[17] + (size_t)NE * D * DE, args.in[18] + (size_t)D * DE, args.in[19] + (size_t)D * DE, args.in[20] + (size_t)D * DE); } SEAM(14);
    if (IN(15)) { EpiQKV E{WSP(bf16, WS_RA + RA_QK), WSP(bf16, WS_RA + RA_VT)}; for (int g = 0; g < 3; ++g) { SchedQK S{WSP(unsigned char, WS_HQ), WSP(unsigned char, WS_WQK), g, D << (2 * g), F.vcu}; gemm_fast8(F.lds, S, E); } for (int g = 0; g < 3; ++g) { SchedVT S{WSP(unsigned char, WS_HQ), WSP(unsigned char, WS_WQK) + (size_t)3072 * D, g, D << (2 * g), F.vcu}; gemm_fast8(F.lds, S, E); } } SEAM(15);
    if (IN(16)) { p_attn(F); } SEAM(16);
    if (IN(17)) { p_merge(F); } SEAM(17);
    if (IN(18)) { SchedDense S{WSP(bf16, WS_RA + RA_OM), WSP(bf16, WS_WO), OW, OW, OW, M / 256, 4, F.vcu}; EpiResF32 E{WSP(float, WS_HB), WSP(float, WS_V), D}; GEMM_PHASE(F.lds, S, E); } SEAM(18);
    if (IN(19)) { p_ln(F, WSP(float, WS_V), args.in[21] + 2 * D, args.in[22] + 2 * D, WSP(float, WS_HA), WSP(bf16, WS_HAB)); } SEAM(19);
    if (IN(20)) { SchedDense S{WSP(bf16, WS_HAB), WSP(bf16, WS_WR) + (size_t)NE * D, D, D, D, M / 256, 1, F.vcu}; EpiF32 E{WSP(float, WS_LOGITS), NE}; GEMM_PHASE(F.lds, S, E); } SEAM(20);
    if (IN(21)) { p_route(F, args.in[14] + NE); } SEAM(21);
    if (IN(22)) { p_sort(F); } SEAM(22);
    if (IN(23)) { const int nrbt = *WSP(int, WS_META); SchedG1 S{WSP(unsigned char, WS_HQ), WSP(unsigned char, WS_W13), WSP(int, WS_ROWA), WSP(int, WS_BLKE), nrbt, F.vcu, moe_unit_experts(F, WSP(int, WS_BLKE), nrbt, 1), moe_row_table(F, WSP(int, WS_ROWA), nrbt)}; EpiSwiGLU E{WSP(unsigned char, WS_HID)}; gemm_fast8(F.lds, S, E); } SEAM(23);
    if (IN(24)) { const int nrbt = *WSP(int, WS_META); SchedG2 S{WSP(unsigned char, WS_HID), WSP(unsigned char, WS_W2), WSP(int, WS_BLKE), nrbt, F.vcu, moe_unit_experts(F, WSP(int, WS_BLKE), nrbt, 2), args.rt256, args.rt256, args.rt256}; EpiScatter E{WSP(bf16, WS_RA), 0}; gemm_fast8(F.lds, S, E); if (PROBE_G2) { __syncthreads(); EpiScatter E2{(PROBE_G2 == 2 || PROBE_G2 == 4) ? WSP(bf16, WS_V) : WSP(bf16, WS_RA), PROBE_G2 == 3 ? 0 : PROBE_G2}; gemm_fast8(F.lds, S, E2); } } SEAM(24);
    if (IN(25)) { p_combine(F, WSP(float, WS_HA), args.in[21] + 3 * D, args.in[22] + 3 * D, args.out, nullptr); }
#undef IN
#undef SEAM
}

extern "C" void kernel_launch(void* const* d_in, const int* in_sizes, int n_in, void* d_out, int out_size, void* d_ws, size_t ws_size, hipStream_t stream) {
    static int ok = 0;
    if (ok == 0) {
        if (n_in != 23 || in_sizes[0] != M * D || out_size != M * D || ws_size < WS_END) { fprintf(stderr, "kernel_launch: unexpected shapes (n_in %d, in0 %d, out %d, ws %zu < %zu)\n", n_in, n_in > 0 ? in_sizes[0] : -1, out_size, ws_size, (size_t)WS_END); ok = -1; return; }
        if (hipFuncSetAttribute((const void*)yoco_fwd, hipFuncAttributeMaxDynamicSharedMemorySize, LDS_BYTES) != hipSuccess) { fprintf(stderr, "kernel_launch: hipFuncSetAttribute failed\n"); ok = -1; return; }
        int per_cu = 0;
        if (hipOccupancyMaxActiveBlocksPerMultiprocessor(&per_cu, (const void*)yoco_fwd, NTHR, LDS_BYTES) != hipSuccess || per_cu < 1) fprintf(stderr, "kernel_launch: occupancy query says %d\n", per_cu);
        (void)hipGetLastError();
        ok = 1;
    }
    if (ok < 0) return;
    if (hipMemsetAsync((char*)d_ws + WS_CTL, 0, CTL_ZERO_BYTES, stream) != hipSuccess) return;
    Args a{};
    for (int i = 0; i < 23; ++i) a.in[i] = (const float*)d_in[i];
    a.out = (float*)d_out; a.ws = (unsigned char*)d_ws; a.dup = 0u; a.rt256 = 256;
#if MK_ONE_LAUNCH
    a.ph_lo = 0; a.ph_hi = NPHASE;
    hipLaunchKernelGGL(yoco_fwd, dim3(NWG), dim3(NTHR), LDS_BYTES, stream, a);
#else
    for (int p = 0; p < NPHASE; ++p) { a.ph_lo = p; a.ph_hi = p + 1; hipLaunchKernelGGL(yoco_fwd, dim3(NWG), dim3(NTHR), LDS_BYTES, stream, a); }
#endif
}
```

```cpp
#include <hip/hip_runtime.h>
#include <cstdio>
#include <cstdint>

#ifndef MK_ONE_LAUNCH
#define MK_ONE_LAUNCH 1
#endif

constexpr int D = 1024, BATCH = 2, SEQ = 16384, M = BATCH * SEQ;
constexpr int NE = 256, TOPK = 8, DE = 256;
constexpr int HEADS = 8, HD = 64, QW = 1536, OW = 512;
constexpr float LN_EPS = 1e-5f, ALPHA = 1.41421356237f;
constexpr int RBMAX = 1024 + 256 + 128;
constexpr int NWG = 256, NTHR = 512, NWAVES = 8;
constexpr int NGW = NWG * NWAVES, NGT = NWG * NTHR;

constexpr size_t MiB = 1u << 20;
constexpr size_t WS_CTL = 0, CTL_ZERO_BYTES = 1 * MiB;
constexpr size_t WS_HIST = 1 * MiB, WS_BLKE = 1 * MiB + 512 * 1024, WS_META = 1 * MiB + 768 * 1024;
constexpr size_t WS_ROWA = 2 * MiB, WS_TOPI = 4 * MiB, WS_GATE = 5 * MiB, WS_CHP = 6 * MiB, WS_CHH = 8 * MiB, WS_CIN = 10 * MiB, WS_LSE = 12 * MiB;
constexpr size_t WS_WIN = 16 * MiB, WS_WG = 20 * MiB, WS_WOUT = 21 * MiB, WS_WQK = 23 * MiB, WS_WV = 29 * MiB, WS_WO = 32 * MiB, WS_WR = 33 * MiB;
constexpr size_t WS_LOGITS = 34 * MiB;
constexpr size_t WS_W13 = 66 * MiB, WS_W2 = 323 * MiB;
constexpr size_t WS_V = 452 * MiB, WS_HA = 580 * MiB, WS_HAB = 708 * MiB, WS_HB = 772 * MiB, WS_HBB = 900 * MiB, WS_HID = 964 * MiB;
constexpr size_t WS_RA = 1140 * MiB;
constexpr size_t RA_XB = 0, RA_XR = 64 * MiB, RA_GG = 128 * MiB, RA_XC = 192 * MiB, RA_LA = 256 * MiB, RA_U = 384 * MiB, RA_YB = 512 * MiB;
constexpr size_t RA_QK = 0, RA_VT = 192 * MiB, RA_OG = 288 * MiB, RA_OM = 384 * MiB;
constexpr size_t WS_POS = 15 * MiB;
constexpr size_t WS_HQ = 1844 * MiB;
constexpr size_t WS_END = 1876 * MiB;

constexpr int LDS_BYTES = 147456;

#define GAS __attribute__((address_space(1)))
#define LAS __attribute__((address_space(3)))
typedef unsigned short bf16;
typedef unsigned u32x4 __attribute__((ext_vector_type(4)));
typedef unsigned u32x2 __attribute__((ext_vector_type(2)));
typedef float f32x4 __attribute__((ext_vector_type(4)));
typedef float f32x2 __attribute__((ext_vector_type(2)));
typedef float f32x16 __attribute__((ext_vector_type(16)));
typedef short bf16x8 __attribute__((ext_vector_type(8)));
typedef int i32x8 __attribute__((ext_vector_type(8)));
typedef GAS unsigned gu32;
#define RLX_AGENT __ATOMIC_RELAXED, __HIP_MEMORY_SCOPE_AGENT
#define LDS_WAIT() asm volatile("s_waitcnt lgkmcnt(0)" ::: "memory")
#define VM_WAIT() asm volatile("s_waitcnt vmcnt(0)" ::: "memory")

__device__ __forceinline__ unsigned pk2(float lo, float hi) { unsigned r; asm("v_cvt_pk_bf16_f32 %0, %1, %2" : "=v"(r) : "v"(lo), "v"(hi)); return r; }
__device__ __forceinline__ float bf_lo(unsigned w) { return __uint_as_float(w << 16); }
__device__ __forceinline__ float bf_hi(unsigned w) { return __uint_as_float(w & 0xffff0000u); }
__device__ __forceinline__ float wave_sum(float v) {
#pragma unroll
    for (int o = 1; o < 64; o <<= 1) v += __shfl_xor(v, o);
    return v;
}
__device__ __forceinline__ float gelu_tanh(float x) {
    const float u = 0.7978845608028654f * (x + 0.044715f * x * x * x);
    const float e = __expf(2.0f * u);
    const float t = 1.0f - 2.0f / (e + 1.0f);
    return 0.5f * x * (1.0f + t);
}
__device__ __forceinline__ float sigmoidf_(float x) { return 1.0f / (1.0f + __expf(-x)); }

#define XB_TMO      128
#define XB_XCNT(j)  (256  + 64 * (j))
#define XB_XSUB(j)  (1280 + 64 * (j))
#define XB_XGEN(j)  (2304 + 64 * (j))
#define XB_TOP      3328
#define XB_TOPGEN   3392
#define XCD_BAR_WORDS 3456
#define XB_SPIN_CAP (1u << 18)
__device__ __forceinline__ unsigned xb_ld(unsigned* p)              { return __hip_atomic_load(p, __ATOMIC_RELAXED, __HIP_MEMORY_SCOPE_AGENT); }
__device__ __forceinline__ unsigned xb_add(unsigned* p, unsigned v) { return __hip_atomic_fetch_add(p, v, __ATOMIC_RELAXED, __HIP_MEMORY_SCOPE_AGENT); }
__device__ __forceinline__ unsigned xb_xcc_id() { return (unsigned)__builtin_amdgcn_s_getreg((3 << 11) | 20) & 0xFu; }
#define XB_SPIN(cond, bar) do { unsigned _sp = 0; while (cond) { __builtin_amdgcn_s_sleep(1); \
    if ((++_sp & 255u) == 0u) { if (xb_ld(&(bar)[XB_TMO])) break; if (_sp > XB_SPIN_CAP) { atomicAdd(&(bar)[XB_TMO], 1u); break; } } } } while (0)
struct XcdBarrier { unsigned* bar; unsigned x; volatile LAS unsigned* st; };
__device__ __forceinline__ XcdBarrier xcd_barrier_post(unsigned* bar, volatile LAS unsigned* st) {
    XcdBarrier b; b.bar = bar; b.x = xb_xcc_id(); b.st = st;
    if (threadIdx.x == 0) (void)xb_add(&bar[XB_XCNT(b.x)], 1u);
    return b;
}
__device__ __forceinline__ void xcd_barrier_complete(unsigned* bar, unsigned x, unsigned& nloc, unsigned& nx) {
    const unsigned G = gridDim.x * gridDim.y * gridDim.z;
    unsigned sum, cnt, mine, sp = 0u;
    for (;;) {
        sum = 0u; cnt = 0u; mine = 0u;
#pragma unroll
        for (unsigned j = 0; j < 16; ++j) { const unsigned c = xb_ld(&bar[XB_XCNT(j)]); sum += c; cnt += (c > 0u) ? 1u : 0u; mine = (j == x) ? c : mine; }
        if (sum == G) break;
        __builtin_amdgcn_s_sleep(1);
        if ((++sp & 255u) == 0u) { if (xb_ld(&bar[XB_TMO])) break; if (sp > XB_SPIN_CAP) { atomicAdd(&bar[XB_TMO], 1u); break; } }
    }
    nloc = mine > 0u ? mine : 1u; nx = cnt > 0u ? cnt : 1u;
}
__device__ __forceinline__ void xcd_barrier(const XcdBarrier& b) {
    asm volatile("s_waitcnt vmcnt(0)" ::: "memory");
    __syncthreads();
    if (threadIdx.x == 0) {
        unsigned* bar = b.bar;
        __builtin_amdgcn_s_waitcnt(0);
        unsigned nloc = b.st[0], nx = b.st[1];
        if (nloc == 0u) { xcd_barrier_complete(bar, b.x, nloc, nx); b.st[0] = nloc; b.st[1] = nx; }
        const unsigned old = xb_add(&bar[XB_XSUB(b.x)], 1u);
        const unsigned gen = old / nloc;
        if (old + 1u == (gen + 1u) * nloc) {
            __builtin_amdgcn_fence(__ATOMIC_RELEASE, "agent");
            asm volatile("s_waitcnt vmcnt(0)" ::: "memory");
            const unsigned og = xb_add(&bar[XB_TOP], 1u);
            const unsigned tg = og / nx;
            if (og + 1u == (tg + 1u) * nx) xb_add(&bar[XB_TOPGEN], 1u);
            else XB_SPIN(xb_ld(&bar[XB_TOPGEN]) == tg, bar);
            __builtin_amdgcn_fence(__ATOMIC_ACQUIRE, "agent");
            xb_add(&bar[XB_XGEN(b.x)], 1u);
            asm volatile("s_waitcnt vmcnt(0)" ::: "memory");
        } else {
            XB_SPIN(xb_ld(&bar[XB_XGEN(b.x)]) == gen, bar);
            __builtin_amdgcn_fence(__ATOMIC_ACQUIRE, "agent");
            asm volatile("s_waitcnt vmcnt(0)" ::: "memory");
        }
    }
    __syncthreads();
}

struct Args { const float* in[23]; float* out; unsigned char* ws; int ph_lo, ph_hi; unsigned dup; int rt256; };
static_assert(sizeof(Args) == 23 * 8 + 8 + 8 + 16, "Args has no padding");
struct Frame {
    LAS unsigned char* lds;
    int tid, lane, wave, vcu;
    unsigned char* ws;
};
#define WSP(T, off) ((T*)(F.ws + (off)))

template <class S, class E>
__device__ __forceinline__ void gemm_simple(LAS unsigned char* lds, const S& sch, const E& epi) {
    const int tid = threadIdx.x, wid = tid >> 6, lane = tid & 63, wr = wid >> 2, wc = wid & 3, fr = lane & 15, fq = lane >> 4;
    constexpr int PITCH = 144;
    LAS unsigned char* As = lds; LAS unsigned char* Bs = lds + 256 * PITCH;
    typename S::U u;
    for (int i = 0; sch.next(i, u); ++i) {
        f32x4 acc[2][2][4][2];
#pragma unroll
        for (int a = 0; a < 2; ++a)
#pragma unroll
            for (int b = 0; b < 2; ++b)
#pragma unroll
                for (int m = 0; m < 4; ++m)
#pragma unroll
                    for (int n = 0; n < 2; ++n) acc[a][b][m][n] = (f32x4){0.f, 0.f, 0.f, 0.f};
        const int nt = sch.K(u) / 64;
        const char* pa[4]; const char* pb[4];
#pragma unroll
        for (int j = 0; j < 4; ++j) { const int row = (tid >> 3) + 64 * j; const int rb = S::PERM ? ((row & ~31) + 8 * ((row & 15) >> 2) + 4 * ((row >> 4) & 1) + (row & 3)) : row; pa[j] = sch.rowA(u, row) + (tid & 7) * 16; pb[j] = sch.rowB(u, rb) + (tid & 7) * 16; }
        for (int kt = 0; kt < nt; ++kt) {
            u32x4 va[4], vb[4];
#pragma unroll
            for (int j = 0; j < 4; ++j) { va[j] = *(const u32x4*)(pa[j] + kt * 128); vb[j] = *(const u32x4*)(pb[j] + kt * 128); }
            __syncthreads();
#pragma unroll
            for (int j = 0; j < 4; ++j) { const int row = (tid >> 3) + 64 * j;
                *(LAS u32x4*)(As + row * PITCH + (tid & 7) * 16) = va[j]; *(LAS u32x4*)(Bs + row * PITCH + (tid & 7) * 16) = vb[j]; }
            __syncthreads();
#pragma unroll
            for (int kk = 0; kk < 2; ++kk) {
                bf16x8 Bf[2][2];
#pragma unroll
                for (int b = 0; b < 2; ++b)
#pragma unroll
                    for (int n = 0; n < 2; ++n) Bf[b][n] = *(const LAS bf16x8*)(Bs + (b * 128 + wc * 32 + n * 16 + fr) * PITCH + kk * 64 + fq * 16);
#pragma unroll
                for (int a = 0; a < 2; ++a) {
                    bf16x8 Af[4];
#pragma unroll
                    for (int m = 0; m < 4; ++m) Af[m] = *(const LAS bf16x8*)(As + (a * 128 + wr * 64 + m * 16 + fr) * PITCH + kk * 64 + fq * 16);
#pragma unroll
                    for (int b = 0; b < 2; ++b)
#pragma unroll
                        for (int m = 0; m < 4; ++m)
#pragma unroll
                            for (int n = 0; n < 2; ++n) acc[a][b][m][n] = __builtin_amdgcn_mfma_f32_16x16x32_bf16(Bf[b][n], Af[m], acc[a][b][m][n], 0, 0, 0);
                }
            }
        }
        epi(acc, u, wr, wc, fr, fq);
    }
    __syncthreads();
}

namespace pg8 {
constexpr int HTB = 128 * 64 * 2;
__device__ __forceinline__ int lds_byte(int r, int c) { const int st = (r >> 4) * 2 + (c >> 5), rr = r & 15, cc = c & 31, ob = rr * 64 + cc * 2; return st * 1024 + (ob ^ (((ob >> 9) & 1) << 5)); }
__device__ __forceinline__ int perm32(int rho) { const int n = rho >> 4, i = rho & 15; return 8 * (i >> 2) + 4 * n + (i & 3); }
__device__ __forceinline__ int prow(int r) { return (r & ~31) + perm32(r & 31); }
__device__ __forceinline__ void stage_rc(int b, int& R, int& C) { const int st = b / 1024, sb = b % 1024, swz = sb ^ (((sb >> 9) & 1) << 5); R = (st >> 1) * 16 + swz / 64; C = (st & 1) * 32 + (swz % 64) / 2; }
}
template <class S, class E>
__device__ __forceinline__ void gemm_fast(LAS unsigned char* lds, const S& sch, const E& epi) {
    using namespace pg8;
    const int tid = threadIdx.x, wid = __builtin_amdgcn_readfirstlane(tid >> 6), lane = tid & 63, wr = wid >> 2, wc = wid & 3, fr = lane & 15, fq = lane >> 4;
    const int nt = sch.Kk / 64;
    int R0, C0; stage_rc(tid * 16, R0, C0);
    unsigned voffA[2], voffB[2]; unsigned cofA[4], nofA[4], cofB[4], nofB[4];
    size_t hstepA = 0, hstepB = 0;
    if constexpr (!S::GA) { voffA[0] = (unsigned)(R0 * sch.lda + C0) * 2u; voffA[1] = (unsigned)((R0 + 64) * sch.lda + C0) * 2u; hstepA = (size_t)128 * sch.lda * 2; }
    const int RB0 = S::PERM ? prow(R0) : R0;
    if constexpr (!S::GB) { voffB[0] = (unsigned)(RB0 * sch.ldb + C0) * 2u; voffB[1] = (unsigned)((RB0 + 64) * sch.ldb + C0) * 2u; hstepB = (size_t)128 * sch.ldb * 2; }
    const size_t kstep = 128;
    const unsigned ldsw = (unsigned)wid * 1024u;
    const int aoff = lds_byte(wr * 64 + fr, fq * 8), boff = lds_byte(wc * 32 + fr, fq * 8);
#define G_SA(b, h) (((b) * 2 + (h)) * HTB)
#define G_SB(b, h) ((4 + (b) * 2 + (h)) * HTB)
#define G_GLDS(src, dst) __builtin_amdgcn_global_load_lds((const unsigned*)(src), (LAS unsigned*)(dst), 16, 0, 0)
#define G_STAGE_A(bufoff, gp, h, nx) do { if constexpr (S::GA) { _Pragma("unroll") for (int _i = 0; _i < 2; ++_i) { const unsigned _o = (nx) ? nofA[2 * (h) + _i] : cofA[2 * (h) + _i]; G_GLDS((gp) + _o, lds + (bufoff) + ldsw + _i * 8192); } } \
        else { _Pragma("unroll") for (int _i = 0; _i < 2; ++_i) G_GLDS((gp) + (size_t)(h) * hstepA + voffA[_i], lds + (bufoff) + ldsw + _i * 8192); } } while (0)
#define G_STAGE_B(bufoff, gp, h, nx) do { if constexpr (S::GB) { _Pragma("unroll") for (int _i = 0; _i < 2; ++_i) { const unsigned _o = (nx) ? nofB[2 * (h) + _i] : cofB[2 * (h) + _i]; G_GLDS((gp) + _o, lds + (bufoff) + ldsw + _i * 8192); } } \
        else { _Pragma("unroll") for (int _i = 0; _i < 2; ++_i) G_GLDS((gp) + (size_t)(h) * hstepB + voffB[_i], lds + (bufoff) + ldsw + _i * 8192); } } while (0)
#define G_LDA(dst, b, h) do { _Pragma("unroll") for (int m = 0; m < 4; ++m) _Pragma("unroll") for (int k = 0; k < 2; ++k) dst[m][k] = *(const LAS bf16x8*)(lds + G_SA(b, h) + aoff + m * 2048 + k * 1024); } while (0)
#define G_LDB(dst, b, h) do { _Pragma("unroll") for (int n = 0; n < 2; ++n) _Pragma("unroll") for (int k = 0; k < 2; ++k) dst[n][k] = *(const LAS bf16x8*)(lds + G_SB(b, h) + boff + n * 2048 + k * 1024); } while (0)
#define G_MMA(ai, bj, At, Bt) do { __builtin_amdgcn_s_setprio(1); _Pragma("unroll") for (int m = 0; m < 4; ++m) _Pragma("unroll") for (int n = 0; n < 2; ++n) _Pragma("unroll") for (int k = 0; k < 2; ++k) \
        acc[ai][bj][m][n] = __builtin_amdgcn_mfma_f32_16x16x32_bf16(Bt[n][k], At[m][k], acc[ai][bj][m][n], 0, 0, 0); __builtin_amdgcn_s_setprio(0); } while (0)
#define G_WAIT_V(n) asm volatile("s_waitcnt vmcnt(" #n ")" ::: "memory")
#define G_WAIT_L(n) asm volatile("s_waitcnt lgkmcnt(" #n ")" ::: "memory")
#define G_BAR __builtin_amdgcn_s_barrier()
#define G_SCHED __builtin_amdgcn_sched_barrier(0)
    typename S::U cur, nxt; int ui = 0;
    if (!sch.next(0, cur)) return;
    f32x4 acc[2][2][4][2];
#pragma unroll
    for (int a = 0; a < 2; ++a)
#pragma unroll
        for (int b = 0; b < 2; ++b)
#pragma unroll
            for (int m = 0; m < 4; ++m)
#pragma unroll
                for (int n = 0; n < 2; ++n) acc[a][b][m][n] = (f32x4){0.f, 0.f, 0.f, 0.f};
    bf16x8 At[4][2], B0[2][2], B1[2][2];
    const char* cA = sch.baseA(cur); const char* cB = sch.baseB(cur);
    if constexpr (S::GA) {
#pragma unroll
        for (int j = 0; j < 4; ++j) { cofA[j] = sch.goffA(cur, (j >> 1) * 128 + R0 + (j & 1) * 64, C0); nofA[j] = cofA[j]; } }
    if constexpr (S::GB) {
#pragma unroll
        for (int j = 0; j < 4; ++j) { cofB[j] = sch.goffB(cur, (j >> 1) * 128 + RB0 + (j & 1) * 64, C0); nofB[j] = cofB[j]; } }
    G_STAGE_B(G_SB(0, 0), cB, 0, false); G_STAGE_B(G_SB(0, 1), cB, 1, false); G_STAGE_A(G_SA(0, 0), cA, 0, false); G_STAGE_A(G_SA(0, 1), cA, 1, false);
    if (wr == 1) G_BAR;
    G_WAIT_V(2); G_BAR;
    G_STAGE_B(G_SB(1, 0), cB + kstep, 0, false); G_STAGE_A(G_SA(1, 0), cA + kstep, 0, false); G_STAGE_B(G_SB(1, 1), cB + kstep, 1, false);
    G_WAIT_V(6); G_BAR;
    for (;;) {
        const bool has_next = sch.next(ui + 1, nxt);
        const char* nA = has_next ? sch.baseA(nxt) : cA; const char* nB = has_next ? sch.baseB(nxt) : cB;
        if constexpr (S::GA) { if (has_next) {
#pragma unroll
            for (int j = 0; j < 4; ++j) nofA[j] = sch.goffA(nxt, (j >> 1) * 128 + R0 + (j & 1) * 64, C0); } }
        if constexpr (S::GB) { if (has_next) {
#pragma unroll
            for (int j = 0; j < 4; ++j) nofB[j] = sch.goffB(nxt, (j >> 1) * 128 + RB0 + (j & 1) * 64, C0); } }
#pragma unroll 1
        for (int t = 0; t < nt; t += 2) {
            const bool last = (t == nt - 2);
            const char* a1 = cA + (size_t)(t + 1) * kstep;
            const char* a2 = last ? nA : cA + (size_t)(t + 2) * kstep; const char* b2 = last ? nB : cB + (size_t)(t + 2) * kstep;
            const char* a3 = a2 + kstep; const char* b3 = b2 + kstep;
            asm volatile("" : "+s"(a1), "+s"(a2), "+s"(a3), "+s"(b2), "+s"(b3));
            const bool post = (t == 0 && ui > 0);
#define G_WAIT_POST() do { if (post) { if constexpr (E::NVM == 8) G_WAIT_V(16); else if constexpr (E::NVM == 16) G_WAIT_V(24); else if constexpr (E::NVM == 32) G_WAIT_V(40); else G_WAIT_V(8); } else G_WAIT_V(8); } while (0)
            G_LDB(B0, 0, 0); G_LDB(B1, 0, 1); G_SCHED; G_LDA(At, 0, 0); if (!post) G_STAGE_A(G_SA(1, 1), a1, 1, false);
            G_WAIT_POST(); G_WAIT_L(0); G_BAR; G_MMA(0, 0, At, B0); G_MMA(0, 1, At, B1); G_BAR; G_SCHED;
            G_LDA(At, 0, 1); G_STAGE_B(G_SB(0, 0), b2, 0, last); G_STAGE_B(G_SB(0, 1), b2, 1, last); G_STAGE_A(G_SA(0, 0), a2, 0, last);
            G_WAIT_POST(); G_WAIT_L(0); G_BAR; G_MMA(1, 0, At, B0); G_MMA(1, 1, At, B1); G_BAR; G_SCHED;
            G_LDB(B0, 1, 0); G_LDB(B1, 1, 1); G_SCHED; G_LDA(At, 1, 0); G_STAGE_A(G_SA(0, 1), a2, 1, last);
            G_WAIT_POST(); G_WAIT_L(0); G_BAR; G_MMA(0, 0, At, B0); G_MMA(0, 1, At, B1); G_BAR; G_SCHED;
            G_LDA(At, 1, 1); G_STAGE_B(G_SB(1, 0), b3, 0, last); G_STAGE_B(G_SB(1, 1), b3, 1, last); G_STAGE_A(G_SA(1, 0), a3, 0, last);
            G_WAIT_V(8); G_WAIT_L(0); G_BAR; G_MMA(1, 0, At, B0); G_MMA(1, 1, At, B1); G_BAR; G_SCHED;
#undef G_WAIT_POST
        }
        if (wr == 0) G_BAR;
        if (has_next) { const char* n1 = nA + kstep; asm volatile("" : "+s"(n1)); G_STAGE_A(G_SA(1, 1), n1, 1, true); }
        { int tz = threadIdx.x; asm volatile("" : "+v"(tz));
          const int ewid = tz >> 6, el = tz & 63; epi(acc, cur, ewid >> 2, ewid & 3, el & 15, el >> 4); }
        if (!has_next) break;
#pragma unroll
        for (int a = 0; a < 2; ++a)
#pragma unroll
            for (int b = 0; b < 2; ++b)
#pragma unroll
                for (int m = 0; m < 4; ++m)
#pragma unroll
                    for (int n = 0; n < 2; ++n) acc[a][b][m][n] = (f32x4){0.f, 0.f, 0.f, 0.f};
        cur = nxt; cA = nA; cB = nB; ++ui;
        if constexpr (S::GA) {
#pragma unroll
            for (int j = 0; j < 4; ++j) cofA[j] = nofA[j]; }
        if constexpr (S::GB) {
#pragma unroll
            for (int j = 0; j < 4; ++j) cofB[j] = nofB[j]; }
        if (wr == 1) G_BAR;
    }
    G_WAIT_V(0);
    G_BAR;
#undef G_SA
#undef G_SB
#undef G_GLDS
#undef G_STAGE_A
#undef G_STAGE_B
#undef G_LDA
#undef G_LDB
#undef G_MMA
#undef G_WAIT_V
#undef G_WAIT_L
#undef G_BAR
#undef G_SCHED
}
template <class S, class E>
__device__ __forceinline__ void gemm_fast8(LAS unsigned char* lds, const S& sch, const E& epi) {
    using namespace pg8;
    const int tid = threadIdx.x, wid = __builtin_amdgcn_readfirstlane(tid >> 6), lane = tid & 63, wr = wid >> 2, wc = wid & 3, fr = lane & 15, fq = lane >> 4;
    const int nt = sch.Kk / 128;
    const int R0 = tid >> 3, C0 = ((tid & 7) ^ (((R0 >> 1) & 1) | (((R0 >> 2) & 1) << 2))) * 8;
    unsigned voffA[2], voffB[2]; unsigned cofA[4], nofA[4], cofB[4], nofB[4];
    size_t hstepA = 0, hstepB = 0;
    if constexpr (!S::GA) { voffA[0] = (unsigned)(R0 * sch.lda + C0 * 2); voffA[1] = (unsigned)((R0 + 64) * sch.lda + C0 * 2); hstepA = (size_t)128 * sch.lda; }
    const int RB0 = S::PERM ? prow(R0) : R0;
    if constexpr (!S::GB) { voffB[0] = (unsigned)(RB0 * sch.ldb + C0 * 2); voffB[1] = (unsigned)((RB0 + 64) * sch.ldb + C0 * 2); hstepB = (size_t)128 * sch.ldb; }
    const size_t kstep = 128;
    const unsigned ldsw = (unsigned)wid * 1024u;
    const int fsw = ((fr >> 1) & 1) | (((fr >> 2) & 1) << 2);
    const int aoff = ((wr * 64 + fr) * 8 + ((2 * fq) ^ fsw)) * 16, aoff1 = ((wr * 64 + fr) * 8 + ((2 * fq + 1) ^ fsw)) * 16, boff = ((wc * 32 + fr) * 8 + ((2 * fq) ^ fsw)) * 16, boff1 = ((wc * 32 + fr) * 8 + ((2 * fq + 1) ^ fsw)) * 16;
#define G_SA(b, h) (((b) * 2 + (h)) * HTB)
#define G_SB(b, h) ((4 + (b) * 2 + (h)) * HTB)
#define G_GLDS(src, dst) __builtin_amdgcn_global_load_lds((const unsigned*)(src), (LAS unsigned*)(dst), 16, 0, 0)
#define G_STAGE_A(bufoff, gp, h, nx) do { if constexpr (S::GA) { _Pragma("unroll") for (int _i = 0; _i < 2; ++_i) { const unsigned _o = (nx) ? nofA[2 * (h) + _i] : cofA[2 * (h) + _i]; G_GLDS((gp) + _o, lds + (bufoff) + ldsw + _i * 8192); } } \
        else { _Pragma("unroll") for (int _i = 0; _i < 2; ++_i) G_GLDS((gp) + (size_t)(h) * hstepA + voffA[_i], lds + (bufoff) + ldsw + _i * 8192); } } while (0)
#define G_STAGE_B(bufoff, gp, h, nx) do { if constexpr (S::GB) { _Pragma("unroll") for (int _i = 0; _i < 2; ++_i) { const unsigned _o = (nx) ? nofB[2 * (h) + _i] : cofB[2 * (h) + _i]; G_GLDS((gp) + _o, lds + (bufoff) + ldsw + _i * 8192); } } \
        else { _Pragma("unroll") for (int _i = 0; _i < 2; ++_i) G_GLDS((gp) + (size_t)(h) * hstepB + voffB[_i], lds + (bufoff) + ldsw + _i * 8192); } } while (0)
#define G_LDA(dst, b, h) do { _Pragma("unroll") for (int m = 0; m < 4; ++m) { const u32x4 _lo = *(const LAS u32x4*)(lds + G_SA(b, h) + aoff + m * 2048), _hi = *(const LAS u32x4*)(lds + G_SA(b, h) + aoff1 + m * 2048); dst[m] = (i32x8){(int)_lo.x, (int)_lo.y, (int)_lo.z, (int)_lo.w, (int)_hi.x, (int)_hi.y, (int)_hi.z, (int)_hi.w}; } } while (0)
#define G_LDB(dst, b, h) do { _Pragma("unroll") for (int n = 0; n < 2; ++n) { const u32x4 _lo = *(const LAS u32x4*)(lds + G_SB(b, h) + boff + n * 2048), _hi = *(const LAS u32x4*)(lds + G_SB(b, h) + boff1 + n * 2048); dst[n] = (i32x8){(int)_lo.x, (int)_lo.y, (int)_lo.z, (int)_lo.w, (int)_hi.x, (int)_hi.y, (int)_hi.z, (int)_hi.w}; } } while (0)
#define G_MMA(ai, bj, At, Bt) do { __builtin_amdgcn_s_setprio(1); _Pragma("unroll") for (int m = 0; m < 4; ++m) _Pragma("unroll") for (int n = 0; n < 2; ++n) \
        acc[ai][bj][m][n] = __builtin_amdgcn_mfma_scale_f32_16x16x128_f8f6f4(Bt[n], At[m], acc[ai][bj][m][n], 0, 0, 0, 0, 0, 0); __builtin_amdgcn_s_setprio(0); } while (0)
#define G_WAIT_V(n) asm volatile("s_waitcnt vmcnt(" #n ")" ::: "memory")
#define G_WAIT_L(n) asm volatile("s_waitcnt lgkmcnt(" #n ")" ::: "memory")
#define G_BAR __builtin_amdgcn_s_barrier()
#define G_SCHED __builtin_amdgcn_sched_barrier(0)
    typename S::U cur, nxt; int ui = 0;
    if (!sch.next(0, cur)) return;
    f32x4 acc[2][2][4][2];
#pragma unroll
    for (int a = 0; a < 2; ++a)
#pragma unroll
        for (int b = 0; b < 2; ++b)
#pragma unroll
            for (int m = 0; m < 4; ++m)
#pragma unroll
                for (int n = 0; n < 2; ++n) acc[a][b][m][n] = (f32x4){0.f, 0.f, 0.f, 0.f};
    i32x8 At[4], B0[2], B1[2];
    const char* cA = sch.baseA(cur); const char* cB = sch.baseB(cur);
    if constexpr (S::GA) {
#pragma unroll
        for (int j = 0; j < 4; ++j) { cofA[j] = sch.goffA(cur, (j >> 1) * 128 + R0 + (j & 1) * 64, C0); nofA[j] = cofA[j]; } }
    if constexpr (S::GB) {
#pragma unroll
        for (int j = 0; j < 4; ++j) { cofB[j] = sch.goffB(cur, (j >> 1) * 128 + RB0 + (j & 1) * 64, C0); nofB[j] = cofB[j]; } }
    G_STAGE_B(G_SB(0, 0), cB, 0, false); G_STAGE_B(G_SB(0, 1), cB, 1, false); G_STAGE_A(G_SA(0, 0), cA, 0, false); G_STAGE_A(G_SA(0, 1), cA, 1, false);
    if (wr == 1) G_BAR;
    G_WAIT_V(2); G_BAR;
    G_STAGE_B(G_SB(1, 0), cB + kstep, 0, false); G_STAGE_A(G_SA(1, 0), cA + kstep, 0, false); G_STAGE_B(G_SB(1, 1), cB + kstep, 1, false);
    G_WAIT_V(6); G_BAR;
    for (;;) {
        const bool has_next = sch.next(ui + 1, nxt);
        const char* nA = has_next ? sch.baseA(nxt) : cA; const char* nB = has_next ? sch.baseB(nxt) : cB;
        if constexpr (S::GA) { if (has_next) {
#pragma unroll
            for (int j = 0; j < 4; ++j) nofA[j] = sch.goffA(nxt, (j >> 1) * 128 + R0 + (j & 1) * 64, C0); } }
        if constexpr (S::GB) { if (has_next) {
#pragma unroll
            for (int j = 0; j < 4; ++j) nofB[j] = sch.goffB(nxt, (j >> 1) * 128 + RB0 + (j & 1) * 64, C0); } }
#pragma unroll 1
        for (int t = 0; t < nt; t += 2) {
            const bool last = (t == nt - 2);
            const char* a1 = cA + (size_t)(t + 1) * kstep;
            const char* a2 = last ? nA : cA + (size_t)(t + 2) * kstep; const char* b2 = last ? nB : cB + (size_t)(t + 2) * kstep;
            const char* a3 = a2 + kstep; const char* b3 = b2 + kstep;
            asm volatile("" : "+s"(a1), "+s"(a2), "+s"(a3), "+s"(b2), "+s"(b3));
            const bool post = (t == 0 && ui > 0);
#define G_WAIT_POST() do { if (post) { if constexpr (E::NVM == 8) G_WAIT_V(16); else if constexpr (E::NVM == 16) G_WAIT_V(24); else if constexpr (E::NVM == 32) G_WAIT_V(40); else G_WAIT_V(8); } else G_WAIT_V(8); } while (0)
            G_LDB(B0, 0, 0); G_LDB(B1, 0, 1); G_SCHED; G_LDA(At, 0, 0); if (!post) G_STAGE_A(G_SA(1, 1), a1, 1, false);
            G_WAIT_POST(); G_WAIT_L(0); G_BAR; G_MMA(0, 0, At, B0); G_MMA(0, 1, At, B1); G_BAR; G_SCHED;
            G_LDA(At, 0, 1); G_STAGE_B(G_SB(0, 0), b2, 0, last); G_STAGE_B(G_SB(0, 1), b2, 1, last); G_STAGE_A(G_SA(0, 0), a2, 0, last);
            G_WAIT_POST(); G_WAIT_L(0); G_BAR; G_MMA(1, 0, At, B0); G_MMA(1, 1, At, B1); G_BAR; G_SCHED;
            G_LDB(B0, 1, 0); G_LDB(B1, 1, 1); G_SCHED; G_LDA(At, 1, 0); G_STAGE_A(G_SA(0, 1), a2, 1, last);
            G_WAIT_POST(); G_WAIT_L(0); G_BAR; G_MMA(0, 0, At, B0); G_MMA(0, 1, At, B1); G_BAR; G_SCHED;
            G_LDA(At, 1, 1); G_STAGE_B(G_SB(1, 0), b3, 0, last); G_STAGE_B(G_SB(1, 1), b3, 1, last); G_STAGE_A(G_SA(1, 0), a3, 0, last);
            G_WAIT_V(8); G_WAIT_L(0); G_BAR; G_MMA(1, 0, At, B0); G_MMA(1, 1, At, B1); G_BAR; G_SCHED;
#undef G_WAIT_POST
        }
        if (wr == 0) G_BAR;
        if (has_next) { const char* n1 = nA + kstep; asm volatile("" : "+s"(n1)); G_STAGE_A(G_SA(1, 1), n1, 1, true); }
        { int tz = threadIdx.x; asm volatile("" : "+v"(tz));
          const int ewid = tz >> 6, el = tz & 63; epi(acc, cur, ewid >> 2, ewid & 3, el & 15, el >> 4); }
        if (!has_next) break;
#pragma unroll
        for (int a = 0; a < 2; ++a)
#pragma unroll
            for (int b = 0; b < 2; ++b)
#pragma unroll
                for (int m = 0; m < 4; ++m)
#pragma unroll
                    for (int n = 0; n < 2; ++n) acc[a][b][m][n] = (f32x4){0.f, 0.f, 0.f, 0.f};
        cur = nxt; cA = nA; cB = nB; ++ui;
        if constexpr (S::GA) {
#pragma unroll
            for (int j = 0; j < 4; ++j) cofA[j] = nofA[j]; }
        if constexpr (S::GB) {
#pragma unroll
            for (int j = 0; j < 4; ++j) cofB[j] = nofB[j]; }
        if (wr == 1) G_BAR;
    }
    G_WAIT_V(0);
    G_BAR;
#undef G_SA
#undef G_SB
#undef G_GLDS
#undef G_STAGE_A
#undef G_STAGE_B
#undef G_LDA
#undef G_LDB
#undef G_MMA
#undef G_WAIT_V
#undef G_WAIT_L
#undef G_BAR
#undef G_SCHED
}
#ifndef MK_FAST
#define MK_FAST 1
#endif
#if MK_FAST
#define GEMM_PHASE(lds, S, E) gemm_fast(lds, S, E)
#else
#define GEMM_PHASE(lds, S, E) gemm_simple(lds, S, E)
#endif

#define ROWLOOP _Pragma("unroll") for (int ai = 0; ai < 2; ++ai) _Pragma("unroll") for (int m = 0; m < 4; ++m)
#define UROW (ai * 128 + wr * 64 + m * 16 + fr)
#define UCOL(bj, n) ((bj) * 128 + wc * 32 + (n) * 16 + 4 * fq)
#define UCOLP(bj) ((bj) * 128 + wc * 32 + 8 * fq)
__device__ __forceinline__ u32x4 pk8(const f32x4 a, const f32x4 b) { u32x4 w; w.x = pk2(a.x, a.y); w.y = pk2(a.z, a.w); w.z = pk2(b.x, b.y); w.w = pk2(b.z, b.w); return w; }
typedef f32x4 AccT[2][2][4][2];

struct UnitD { int pm, pn; };
template <bool PERM_> struct SchedDenseT {
    typedef UnitD U;
    static constexpr bool GA = false, GB = false, PERM = PERM_;
    const bf16* A; const bf16* Bt; int lda, ldb, Kk, nM, nN, vcu;
    __device__ __forceinline__ const char* baseA(const U& u) const { return (const char*)(A + (size_t)u.pm * 256 * lda); }
    __device__ __forceinline__ const char* baseB(const U& u) const { return (const char*)(Bt + (size_t)u.pn * 256 * ldb); }
    __device__ __forceinline__ bool next(int i, U& u) const { const int L = i * NWG + vcu; if (L >= nM * nN) return false; u.pm = L / nN; u.pn = L % nN; return true; }
    __device__ __forceinline__ int K(const U&) const { return Kk; }
    __device__ __forceinline__ const char* rowA(const U& u, int r) const { return (const char*)(A + (size_t)(u.pm * 256 + r) * lda); }
    __device__ __forceinline__ const char* rowB(const U& u, int r) const { return (const char*)(Bt + (size_t)(u.pn * 256 + r) * ldb); }
};
typedef SchedDenseT<false> SchedDense; typedef SchedDenseT<true> SchedDenseP;
struct SchedDense8 {
    typedef UnitD U;
    static constexpr bool GA = false, GB = false, PERM = true;
    const unsigned char* A; const unsigned char* Bt; int lda, ldb, Kk, nM, nN, vcu;
    __device__ __forceinline__ const char* baseA(const U& u) const { return (const char*)(A + (size_t)u.pm * 256 * lda); }
    __device__ __forceinline__ const char* baseB(const U& u) const { return (const char*)(Bt + (size_t)u.pn * 256 * ldb); }
    __device__ __forceinline__ bool next(int i, U& u) const { const int L = i * NWG + vcu; if (L >= nM * nN) return false; u.pm = L / nN; u.pn = L % nN; return true; }
};
struct EpiXZ {
    static constexpr int NVM = 16;
    bf16* XR; bf16* GG;
    __device__ __forceinline__ void operator()(const AccT& acc, const UnitD& u, int wr, int wc, int fr, int fq) const {
        const bool isg = u.pn >= 4; bf16* base = isg ? GG : XR; const int c0 = (u.pn & 3) * 256;
        ROWLOOP { bf16* rp = base + (size_t)(u.pm * 256 + UROW) * D + c0;
#pragma unroll
            for (int bj = 0; bj < 2; ++bj) { f32x4 v0 = acc[ai][bj][m][0] * 0.015625f, v1 = acc[ai][bj][m][1] * 0.015625f;
                if (isg) {
#pragma unroll
                    for (int j = 0; j < 4; ++j) { v0[j] = gelu_tanh(v0[j]); v1[j] = gelu_tanh(v1[j]); } }
                *(u32x4*)(rp + UCOLP(bj)) = pk8(v0, v1); } }
    }
};
struct EpiResF32 {
    static constexpr int NVM = 0;
    const float* R; float* O; int ldc;
    __device__ __forceinline__ void operator()(const AccT& acc, const UnitD& u, int wr, int wc, int fr, int fq) const {
        const size_t base = (size_t)(u.pm * 256 + wr * 64 + fr) * ldc + u.pn * 256;
        f32x4 cur[4], nxt[4];
#pragma unroll
        for (int q = 0; q < 4; ++q) cur[q] = *(const f32x4*)(R + base + UCOL(q >> 1, q & 1));
#pragma unroll
        for (int g = 0; g < 8; ++g) { const int ai = g >> 2, m = g & 3; const size_t ro = base + (size_t)(ai * 128 + m * 16) * ldc;
            if (g < 7) { const size_t rn = base + (size_t)(((g + 1) >> 2) * 128 + ((g + 1) & 3) * 16) * ldc;
#pragma unroll
                for (int q = 0; q < 4; ++q) nxt[q] = *(const f32x4*)(R + rn + UCOL(q >> 1, q & 1)); }
#pragma unroll
            for (int q = 0; q < 4; ++q) *(f32x4*)(O + ro + UCOL(q >> 1, q & 1)) = cur[q] * ALPHA + acc[ai][q >> 1][m][q & 1];
#pragma unroll
            for (int q = 0; q < 4; ++q) cur[q] = nxt[q]; }
    }
};
struct EpiF32 {
    static constexpr int NVM = 32;
    float* O; int ldc;
    __device__ __forceinline__ void operator()(const AccT& acc, const UnitD& u, int wr, int wc, int fr, int fq) const {
        ROWLOOP { const size_t ro = (size_t)(u.pm * 256 + UROW) * ldc + u.pn * 256;
#pragma unroll
            for (int bj = 0; bj < 2; ++bj)
#pragma unroll
                for (int n = 0; n < 2; ++n) *(f32x4*)(O + ro + UCOL(bj, n)) = acc[ai][bj][m][n]; }
    }
};

struct UnitG { int pm, blk, pn; };
struct SchedGate {
    typedef UnitG U;
    static constexpr bool GA = false, GB = false, PERM = true; static constexpr int Kk = 256, lda = D, ldb = 256;
    const bf16* XC; const bf16* WgT; int vcu;
    __device__ __forceinline__ const char* baseA(const U& u) const { return (const char*)(XC + (size_t)u.pm * 256 * D + u.blk * 256); }
    __device__ __forceinline__ const char* baseB(const U& u) const { return (const char*)(WgT + (size_t)(u.blk * 512 + u.pn * 256) * 256); }
    __device__ __forceinline__ bool next(int i, U& u) const { const int L = i * NWG + vcu; if (L >= 128 * 8) return false; u.pm = L >> 3; u.blk = (L >> 1) & 3; u.pn = L & 1; return true; }
    __device__ __forceinline__ int K(const U&) const { return 256; }
    __device__ __forceinline__ const char* rowA(const U& u, int r) const { return (const char*)(XC + (size_t)(u.pm * 256 + r) * D + u.blk * 256); }
    __device__ __forceinline__ const char* rowB(const U& u, int r) const { return (const char*)(WgT + (size_t)(u.blk * 512 + u.pn * 256 + r) * 256); }
};
struct EpiGate {
    static constexpr int NVM = 0;
    const bf16* XC; const float *ba, *bx, *lam; bf16* LA; bf16* UU;
    __device__ __forceinline__ void operator()(const AccT& acc, const UnitG& u, int wr, int wc, int fr, int fq) const {
        const int c0 = u.blk * 256 + u.pn * 128 + wc * 32 + 8 * fq;
        f32x4 vba[2], vbx[2], sp[2];
#pragma unroll
        for (int n = 0; n < 2; ++n) { vba[n] = *(const f32x4*)(ba + c0 + 4 * n); vbx[n] = *(const f32x4*)(bx + c0 + 4 * n); const f32x4 vl = *(const f32x4*)(lam + c0 + 4 * n);
#pragma unroll
            for (int j = 0; j < 4; ++j) { const float x = __expf(-vl[j]); sp[n][j] = 8.0f * x * (1.0f - x * (0.5f - x * (1.0f / 3.0f))); } }
        const size_t base = (size_t)(u.pm * 256 + wr * 64 + fr) * D + c0;
        u32x4 xw = *(const u32x4*)(XC + base);
#pragma unroll
        for (int g = 0; g < 8; ++g) { const int ai = g >> 2, m = g & 3; const size_t ro = base + (size_t)(ai * 128 + m * 16) * D;
            u32x4 xn = xw; if (g < 7) xn = *(const u32x4*)(XC + base + (size_t)(((g + 1) >> 2) * 128 + ((g + 1) & 3) * 16) * D);
            const float xc[8] = {bf_lo(xw.x), bf_hi(xw.x), bf_lo(xw.y), bf_hi(xw.y), bf_lo(xw.z), bf_hi(xw.z), bf_lo(xw.w), bf_hi(xw.w)};
            f32x4 la[2], uu[2];
#pragma unroll
            for (int n = 0; n < 2; ++n) { const f32x4 ga = acc[ai][0][m][n] + vba[n], gx = acc[ai][1][m][n] + vbx[n];
#pragma unroll
                for (int j = 0; j < 4; ++j) { const float r = sigmoidf_(ga[j]), ig = sigmoidf_(gx[j]); const float l = -r * sp[n][j]; la[n][j] = l;
                    const float mult = sqrtf(fmaxf(1.0f - __expf(2.0f * l), 0.f)); uu[n][j] = mult * ig * xc[4 * n + j]; } }
            *(u32x4*)(LA + ro) = pk8(la[0], la[1]); *(u32x4*)(UU + ro) = pk8(uu[0], uu[1]); xw = xn; }
    }
};

struct UnitE { int rb, pn, e, ti; };
struct SchedG1 {
    typedef UnitE U;
    static constexpr bool GA = true, GB = false, PERM = true; static constexpr int Kk = D, lda = D, ldb = D;
    const unsigned char* X; const unsigned char* W13T; const int* ROWA; const int* BLKE; int nrbt, vcu; int ev; const LAS unsigned* tab;
    __device__ __forceinline__ const char* baseA(const U&) const { return (const char*)X; }
    __device__ __forceinline__ const char* baseB(const U& u) const { return (const char*)(W13T + ((size_t)u.e * 512 + u.pn * 256) * D); }
    __device__ __forceinline__ unsigned goffA(const U& u, int r, int C) const { return tab[u.ti * 256 + r] + (unsigned)C * 2u; }
    __device__ __forceinline__ unsigned goffB(const U&, int, int) const { return 0u; }
    __device__ __forceinline__ bool next(int i, U& u) const { const int L = i * NWG + vcu; const int rb = L >> 1; if (rb >= nrbt) return false; u.rb = rb; u.pn = L & 1; u.ti = i; u.e = __builtin_amdgcn_readlane(ev, i); return true; }
    __device__ __forceinline__ int K(const U&) const { return D; }
};
struct EpiSwiGLU {
    static constexpr int NVM = 8;
    unsigned char* HID;
    __device__ __forceinline__ void operator()(const AccT& acc, const UnitE& u, int wr, int wc, int fr, int fq) const {
        ROWLOOP { unsigned char* rp = HID + (size_t)(u.rb * 256 + UROW) * DE + u.pn * 128;
            f32x4 h0, h1;
#pragma unroll
            for (int j = 0; j < 4; ++j) { const float a0 = acc[ai][0][m][0][j] * 0.015625f, a1 = acc[ai][0][m][1][j] * 0.015625f; h0[j] = a0 * sigmoidf_(a0) * (acc[ai][1][m][0][j] * 0.015625f); h1[j] = a1 * sigmoidf_(a1) * (acc[ai][1][m][1][j] * 0.015625f); }
            int t0 = __builtin_amdgcn_cvt_pk_fp8_f32(h0.x, h0.y, 0, false); t0 = __builtin_amdgcn_cvt_pk_fp8_f32(h0.z, h0.w, t0, true);
            int t1 = __builtin_amdgcn_cvt_pk_fp8_f32(h1.x, h1.y, 0, false); t1 = __builtin_amdgcn_cvt_pk_fp8_f32(h1.z, h1.w, t1, true);
            u32x2 w; w.x = (unsigned)t0; w.y = (unsigned)t1; *(u32x2*)(rp + wc * 32 + 8 * fq) = w; }
    }
};
struct SchedG2 {
    typedef UnitE U;
    static constexpr bool GA = false, GB = false, PERM = true;
    const unsigned char* HID; const unsigned char* W2T; const int* BLKE; int nrbt, vcu; int ev; int Kk, lda, ldb;
    __device__ __forceinline__ const char* baseA(const U& u) const { return (const char*)(HID + (size_t)u.rb * 256 * DE); }
    __device__ __forceinline__ const char* baseB(const U& u) const { return (const char*)(W2T + ((size_t)u.e * D + u.pn * 256) * DE); }
    __device__ __forceinline__ bool next(int i, U& u) const { const int L = i * NWG + vcu; const int rb = L >> 2; if (rb >= nrbt) return false; u.rb = rb; u.pn = L & 3; u.ti = i; u.e = __builtin_amdgcn_readlane(ev, i); return true; }
    __device__ __forceinline__ int K(const U&) const { return DE; }
};
struct EpiScatter {
    static constexpr int NVM = 16;
    bf16* YA; int dry;
    __device__ __forceinline__ void operator()(const AccT& acc, const UnitE& u, int wr, int wc, int fr, int fq) const {
        const size_t rbase = (size_t)u.rb * 256;
        ROWLOOP { unsigned char* rp = (unsigned char*)YA + (rbase + UROW) * D + u.pn * 256;
#pragma unroll
            for (int bj = 0; bj < 2; ++bj) { const f32x4 v0 = acc[ai][bj][m][0] * 0.25f, v1 = acc[ai][bj][m][1] * 0.25f; u32x2 w;
                int t0 = __builtin_amdgcn_cvt_pk_fp8_f32(v0.x, v0.y, 0, false); t0 = __builtin_amdgcn_cvt_pk_fp8_f32(v0.z, v0.w, t0, true);
                int t1 = __builtin_amdgcn_cvt_pk_fp8_f32(v1.x, v1.y, 0, false); t1 = __builtin_amdgcn_cvt_pk_fp8_f32(v1.z, v1.w, t1, true);
                w.x = (unsigned)t0; w.y = (unsigned)t1; *(u32x2*)(rp + UCOLP(bj)) = w; } }
    }
};

__device__ __forceinline__ int rho_to_tok(int rho, int g) { const int sh = 14 - 2 * g; const int rp = rho & 16383; return (rho & ~16383) + (rp >> sh) + ((rp & ((1 << sh) - 1)) << (2 * g)); }
__device__ __forceinline__ int tok_to_rho(int t, int g) { const int sh = 14 - 2 * g; const int tp = t & 16383; return (t & ~16383) + ((tp & ((1 << (2 * g)) - 1)) << sh) + (tp >> (2 * g)); }
struct UnitQ { int type, g, pm, pn; };
struct SchedQK {
    typedef UnitQ U;
    static constexpr bool GA = false, GB = false, PERM = true; static constexpr int Kk = D, ldb = D;
    const unsigned char* X; const unsigned char* WqkT; int g, lda, vcu;
    __device__ __forceinline__ bool next(int i, U& u) const { const int L = i * NWG + vcu; if (L >= 512) return false; u.type = 0; u.g = g; u.pm = L >> 2; u.pn = L & 3; return true; }
    __device__ __forceinline__ int K(const U&) const { return D; }
    __device__ __forceinline__ const char* baseA(const U& u) const { return (const char*)(X + (size_t)rho_to_tok(u.pm * 256, g) * D); }
    __device__ __forceinline__ const char* baseB(const U& u) const { return (const char*)(WqkT + ((size_t)g * 1024 + u.pn * 256) * D); }
    __device__ __forceinline__ const char* rowA(const U& u, int r) const { return (const char*)(X + (size_t)rho_to_tok(u.pm * 256 + r, g) * D); }
    __device__ __forceinline__ const char* rowB(const U& u, int r) const { return (const char*)(WqkT + ((size_t)g * 1024 + u.pn * 256 + r) * D); }
};
struct SchedVT {
    typedef UnitQ U;
    static constexpr bool GA = false, GB = false, PERM = true; static constexpr int Kk = D, lda = D;
    const unsigned char* X; const unsigned char* WvT; int g, ldb, vcu;
    __device__ __forceinline__ bool next(int i, U& u) const { const int L = i * NWG + vcu; if (L >= 256) return false; u.type = 1; u.g = g; u.pn = L >> 1; u.pm = L & 1; return true; }
    __device__ __forceinline__ int K(const U&) const { return D; }
    __device__ __forceinline__ const char* baseA(const U& u) const { return (const char*)(WvT + ((size_t)g * 512 + u.pm * 256) * D); }
    __device__ __forceinline__ const char* baseB(const U& u) const { return (const char*)(X + (size_t)rho_to_tok(u.pn * 256, g) * D); }
    __device__ __forceinline__ const char* rowA(const U& u, int r) const { return (const char*)(WvT + ((size_t)g * 512 + u.pm * 256 + r) * D); }
    __device__ __forceinline__ const char* rowB(const U& u, int r) const { return (const char*)(X + (size_t)rho_to_tok(u.pn * 256 + r, g) * D); }
};
struct EpiQKV {
    static constexpr int NVM = 16;
    bf16* QK; bf16* VT;
    __device__ __forceinline__ void operator()(const AccT& acc, const UnitQ& u, int wr, int wc, int fr, int fq) const {
        bf16* base; size_t ldc;
        if (u.type == 0) { base = QK + (size_t)u.g * M * 1024; ldc = 1024; } else { base = VT + (size_t)u.g * 512 * M; ldc = M; }
        ROWLOOP { bf16* rp = base + (size_t)(u.pm * 256 + UROW) * ldc + u.pn * 256;
#pragma unroll
            for (int bj = 0; bj < 2; ++bj) *(u32x4*)(rp + UCOLP(bj)) = pk8(acc[ai][bj][m][0] * 0.015625f, acc[ai][bj][m][1] * 0.015625f); }
    }
};

__device__ __forceinline__ void tr_item(const float* src, int spitch, bf16* dst, int dpitch, LAS float* scr, int lane) {
#pragma unroll 4
    for (int i = 0; i < 16; ++i) { const int k = 4 * i + (lane >> 4), n4 = (lane & 15) * 4; const f32x4 v = *(const f32x4*)(src + (size_t)k * spitch + n4);
        LAS float* s = scr + k * 65 + n4; s[0] = v.x; s[1] = v.y; s[2] = v.z; s[3] = v.w; }
    LDS_WAIT(); asm volatile("" ::: "memory");
    const int c = lane & 7;
#pragma unroll
    for (int j = 0; j < 8; ++j) { const int n = 8 * j + (lane >> 3); const LAS float* s = scr + (8 * c) * 65 + n;
        u32x4 o; o.x = pk2(s[0], s[65]); o.y = pk2(s[2 * 65], s[3 * 65]); o.z = pk2(s[4 * 65], s[5 * 65]); o.w = pk2(s[6 * 65], s[7 * 65]);
        *(u32x4*)(dst + (size_t)n * dpitch + 8 * c) = o; }
    LDS_WAIT(); asm volatile("" ::: "memory");
}
__device__ __forceinline__ void tr_item8(const float* src, int spitch, unsigned char* dst, int dpitch, LAS float* scr, int lane) {
#pragma unroll 4
    for (int i = 0; i < 16; ++i) { const int k = 4 * i + (lane >> 4), n4 = (lane & 15) * 4; const f32x4 v = *(const f32x4*)(src + (size_t)k * spitch + n4);
        LAS float* s = scr + k * 65 + n4; s[0] = v.x; s[1] = v.y; s[2] = v.z; s[3] = v.w; }
    LDS_WAIT(); asm volatile("" ::: "memory");
    const int c = lane & 7;
#pragma unroll
    for (int j = 0; j < 8; ++j) { const int n = 8 * j + (lane >> 3); const LAS float* s = scr + (8 * c) * 65 + n;
        int t0 = __builtin_amdgcn_cvt_pk_fp8_f32(s[0] * 64.f, s[65] * 64.f, 0, false); t0 = __builtin_amdgcn_cvt_pk_fp8_f32(s[2 * 65] * 64.f, s[3 * 65] * 64.f, t0, true);
        int t1 = __builtin_amdgcn_cvt_pk_fp8_f32(s[4 * 65] * 64.f, s[5 * 65] * 64.f, 0, false); t1 = __builtin_amdgcn_cvt_pk_fp8_f32(s[6 * 65] * 64.f, s[7 * 65] * 64.f, t1, true);
        u32x2 o; o.x = (unsigned)t0; o.y = (unsigned)t1; *(u32x2*)(dst + (size_t)n * dpitch + 8 * c) = o; }
    LDS_WAIT(); asm volatile("" ::: "memory");
}
template <class RowMap>
__device__ __forceinline__ void tr_matrix(Frame& F, const float* W, int K, int N, bf16* WT, int dpitch, RowMap drow) {
    LAS float* scr = (LAS float*)(F.lds + F.wave * 16640);
    const int nkb = K / 64, nnb = N / 64;
    for (int it = F.vcu * NWAVES + F.wave; it < nkb * nnb; it += NGW) { const int kb = it / nnb, nb = it % nnb;
        tr_item(W + (size_t)(kb * 64) * N + nb * 64, N, WT + (size_t)drow(nb * 64) * dpitch + kb * 64, dpitch, scr, F.lane); }
}
template <class RowMap>
__device__ __forceinline__ void tr_matrix8(Frame& F, const float* W, int K, int N, unsigned char* WT, int dpitch, RowMap drow) {
    LAS float* scr = (LAS float*)(F.lds + F.wave * 16640);
    const int nkb = K / 64, nnb = N / 64;
    for (int it = F.vcu * NWAVES + F.wave; it < nkb * nnb; it += NGW) { const int kb = it / nnb, nb = it % nnb;
        tr_item8(W + (size_t)(kb * 64) * N + nb * 64, N, WT + (size_t)drow(nb * 64) * dpitch + kb * 64, dpitch, scr, F.lane); }
}
__device__ __forceinline__ void cv_src(int it, const float* w1, const float* w3, const float* w2, const float* s1, const float* s3, const float* s2, const float*& src, int& spitch) {
    const int e = it / 192, r = it % 192, which = r >> 6, tile = r & 63;
    if (which < 2) { const float* W = (e < 256) ? (which == 0 ? w1 : w3) + (size_t)e * (size_t)(D * DE) : (which == 0 ? s1 : s3); src = W + (size_t)((tile >> 2) * 64) * DE + (tile & 3) * 64; spitch = DE; }
    else { const float* W = (e < 256) ? w2 + (size_t)e * (size_t)(DE * D) : s2; src = W + (size_t)((tile >> 4) * 64) * D + (tile & 15) * 64; spitch = D; }
}
__device__ __forceinline__ void convert_experts(Frame& F, const float* w1, const float* w3, const float* w2, const float* s1, const float* s3, const float* s2) {
    LAS float* scr = (LAS float*)(F.lds + F.wave * 16640);
    unsigned char* W13T = WSP(unsigned char, WS_W13); unsigned char* W2T = WSP(unsigned char, WS_W2);
    const int lane = F.lane; const int NIT = 257 * 192;
    f32x4 cur[16], nxt[16];
    int it = F.vcu * NWAVES + F.wave;
    if (it < NIT) { const float* src; int sp; cv_src(it, w1, w3, w2, s1, s3, s2, src, sp);
#pragma unroll
        for (int i = 0; i < 16; ++i) cur[i] = __builtin_nontemporal_load((const f32x4*)(src + (size_t)(4 * i + (lane >> 4)) * sp + (lane & 15) * 4)); }
#pragma unroll 1
    for (; it < NIT; it += NGW) {
        const int itn = it + NGW;
        if (itn < NIT) { const float* src; int sp; cv_src(itn, w1, w3, w2, s1, s3, s2, src, sp);
#pragma unroll
            for (int i = 0; i < 16; ++i) nxt[i] = __builtin_nontemporal_load((const f32x4*)(src + (size_t)(4 * i + (lane >> 4)) * sp + (lane & 15) * 4)); }
#pragma unroll
        for (int i = 0; i < 16; ++i) { const int k = 4 * i + (lane >> 4), n4 = (lane & 15) * 4; LAS float* s = scr + k * 65 + n4; s[0] = cur[i].x; s[1] = cur[i].y; s[2] = cur[i].z; s[3] = cur[i].w; }
        LDS_WAIT(); asm volatile("" ::: "memory");
        const int e = it / 192, r = it % 192, which = r >> 6, tile = r & 63, c = lane & 7;
        if (which < 2) { const int kb = tile >> 2, nb = tile & 3; const int drow = (nb >> 1) * 256 + which * 128 + (nb & 1) * 64; unsigned char* dst = W13T + ((size_t)e * 512 + drow) * D + kb * 64;
#pragma unroll
            for (int j = 0; j < 8; ++j) { const int n = 8 * j + (lane >> 3); const LAS float* s = scr + (8 * c) * 65 + n;
                int t0 = __builtin_amdgcn_cvt_pk_fp8_f32(s[0] * 64.f, s[65] * 64.f, 0, false); t0 = __builtin_amdgcn_cvt_pk_fp8_f32(s[2 * 65] * 64.f, s[3 * 65] * 64.f, t0, true);
                int t1 = __builtin_amdgcn_cvt_pk_fp8_f32(s[4 * 65] * 64.f, s[5 * 65] * 64.f, 0, false); t1 = __builtin_amdgcn_cvt_pk_fp8_f32(s[6 * 65] * 64.f, s[7 * 65] * 64.f, t1, true);
                u32x2 o; o.x = (unsigned)t0; o.y = (unsigned)t1; *(u32x2*)(dst + (size_t)n * D + 8 * c) = o; } }
        else { const int kb = tile >> 4, nb = tile & 15; unsigned char* dst = W2T + ((size_t)e * D + nb * 64) * DE + kb * 64;
#pragma unroll
            for (int j = 0; j < 8; ++j) { const int n = 8 * j + (lane >> 3); const LAS float* s = scr + (8 * c) * 65 + n;
                int t0 = __builtin_amdgcn_cvt_pk_fp8_f32(s[0] * 64.f, s[65] * 64.f, 0, false); t0 = __builtin_amdgcn_cvt_pk_fp8_f32(s[2 * 65] * 64.f, s[3 * 65] * 64.f, t0, true);
                int t1 = __builtin_amdgcn_cvt_pk_fp8_f32(s[4 * 65] * 64.f, s[5 * 65] * 64.f, 0, false); t1 = __builtin_amdgcn_cvt_pk_fp8_f32(s[6 * 65] * 64.f, s[7 * 65] * 64.f, t1, true);
                u32x2 o; o.x = (unsigned)t0; o.y = (unsigned)t1; *(u32x2*)(dst + (size_t)n * DE + 8 * c) = o; } }
        LDS_WAIT(); asm volatile("" ::: "memory");
#pragma unroll
        for (int i = 0; i < 16; ++i) cur[i] = nxt[i];
    }
}
struct MapId { __device__ int operator()(int n0) const { return n0; } };
struct MapGate { int which; __device__ int operator()(int n0) const { return (n0 >> 7) * 256 + which * 128 + (n0 & 127); } };
struct MapQ { __device__ int operator()(int n0) const { return (n0 >> 9) * 1024 + (n0 & 511); } };
struct MapKV { __device__ int operator()(int n0) const { return n0 < 1536 ? (n0 >> 9) * 1024 + 512 + (n0 & 511) : 3072 + (n0 - 1536); } };

__device__ __forceinline__ void p0_prologue(Frame& F, const Args& A) {
    { const float* x = A.in[0]; unsigned char* XQ = WSP(unsigned char, WS_RA + RA_XB);
      for (size_t i = (size_t)F.vcu * NTHR + F.tid; i < (size_t)M * D / 8; i += NGT) { const f32x4 a = *(const f32x4*)(x + i * 8), b = *(const f32x4*)(x + i * 8 + 4);
          int t0 = __builtin_amdgcn_cvt_pk_fp8_f32(a.x, a.y, 0, false); t0 = __builtin_amdgcn_cvt_pk_fp8_f32(a.z, a.w, t0, true);
          int t1 = __builtin_amdgcn_cvt_pk_fp8_f32(b.x, b.y, 0, false); t1 = __builtin_amdgcn_cvt_pk_fp8_f32(b.z, b.w, t1, true);
          u32x2 o; o.x = (unsigned)t0; o.y = (unsigned)t1; *(u32x2*)(XQ + i * 8) = o; } }
    tr_matrix8(F, A.in[1], D, 2048, WSP(unsigned char, WS_WIN), D, MapId());
    for (int b = 0; b < 4; ++b) { tr_matrix(F, A.in[4] + b * 65536, 256, 256, WSP(bf16, WS_WG) + (size_t)b * 512 * 256, 256, MapGate{0});
                                  tr_matrix(F, A.in[6] + b * 65536, 256, 256, WSP(bf16, WS_WG) + (size_t)b * 512 * 256, 256, MapGate{1}); }
    tr_matrix(F, A.in[9], D, D, WSP(bf16, WS_WOUT), D, MapId());
    tr_matrix8(F, A.in[11], D, QW, WSP(unsigned char, WS_WQK), D, MapQ());
    tr_matrix8(F, A.in[10], D, 2 * QW, WSP(unsigned char, WS_WQK), D, MapKV());
    tr_matrix(F, A.in[12], OW, D, WSP(bf16, WS_WO), OW, MapId());
    for (int l = 0; l < 2; ++l) tr_matrix(F, A.in[13] + (size_t)l * D * NE, D, NE, WSP(bf16, WS_WR) + (size_t)l * NE * D, D, MapId());
    convert_experts(F, A.in[15], A.in[16], A.in[17], A.in[18], A.in[19], A.in[20]);
}
static_assert(WS_WV == WS_WQK + (size_t)3072 * 1024 * 2, "WvT must follow WqkT");

__device__ __forceinline__ void ln_store(f32x4 (&v)[4], const float* g, const float* b, float* of, bf16* ob, int lane, unsigned char* oq = nullptr) {
    float s = 0.f;
#pragma unroll
    for (int j = 0; j < 4; ++j) s += (v[j].x + v[j].y) + (v[j].z + v[j].w);
    const float mean = wave_sum(s) * (1.f / D); float s2 = 0.f;
#pragma unroll
    for (int j = 0; j < 4; ++j) { v[j] = v[j] - mean; s2 += (v[j].x * v[j].x + v[j].y * v[j].y) + (v[j].z * v[j].z + v[j].w * v[j].w); }
    const float rstd = 1.f / sqrtf(wave_sum(s2) * (1.f / D) + LN_EPS);
#pragma unroll
    for (int j = 0; j < 4; ++j) { const int c = 4 * lane + 256 * j; const f32x4 gg = *(const f32x4*)(g + c), bb = *(const f32x4*)(b + c); const f32x4 y = v[j] * rstd * gg + bb;
        if (of) *(f32x4*)(of + c) = y;
        if (ob) { u32x2 w; w.x = pk2(y.x, y.y); w.y = pk2(y.z, y.w); *(u32x2*)(ob + c) = w; }
        if (oq) { int t = __builtin_amdgcn_cvt_pk_fp8_f32(y.x, y.y, 0, false); t = __builtin_amdgcn_cvt_pk_fp8_f32(y.z, y.w, t, true); *(unsigned*)(oq + c) = (unsigned)t; } }
}

__device__ __forceinline__ int moe_unit_experts(Frame& F, const int* BLKE, int nrbt, int shift) { const int L = F.lane * NWG + F.vcu; const int rb = L >> shift; return rb < nrbt ? BLKE[rb] : 0; }
__device__ __forceinline__ const LAS unsigned* moe_row_table(Frame& F, const int* ROWA, int nrbt) {
    LAS unsigned* tab = (LAS unsigned*)(F.lds + 131072);
    for (int i = 0; i < 15; ++i) { const int rb = (i * NWG + F.vcu) >> 1; if (rb >= nrbt) break;
        if (F.tid < 256) { const int a = ROWA[rb * 256 + F.tid]; const int tok = a < 0 ? 0 : (a < 8 * M ? (a >> 3) : a - 8 * M); tab[i * 256 + F.tid] = (unsigned)tok * (unsigned)D; } }
    __syncthreads();
    return tab;
}
__device__ __forceinline__ void p_conv(Frame& F, const float* cw, const float* cb) {
    const bf16* XR = WSP(bf16, WS_RA + RA_XR); bf16* XC = WSP(bf16, WS_RA + RA_XC);
    for (int i = F.vcu * NTHR + F.tid; i < M * (D / 8); i += NGT) { const int t = i >> 7, c = (i & 127) * 8; const int ts = t & (SEQ - 1);
        float a[8];
#pragma unroll
        for (int q = 0; q < 8; ++q) a[q] = cb[c + q];
#pragma unroll
        for (int j = 0; j < 4; ++j) { if (ts - 3 + j >= 0) { const u32x4 w = *(const u32x4*)(XR + (size_t)(t - 3 + j) * D + c); const float* wj = cw + j * D + c;
            a[0] += wj[0] * bf_lo(w.x); a[1] += wj[1] * bf_hi(w.x); a[2] += wj[2] * bf_lo(w.y); a[3] += wj[3] * bf_hi(w.y);
            a[4] += wj[4] * bf_lo(w.z); a[5] += wj[5] * bf_hi(w.z); a[6] += wj[6] * bf_lo(w.w); a[7] += wj[7] * bf_hi(w.w); } }
        u32x4 o; o.x = pk2(a[0], a[1]); o.y = pk2(a[2], a[3]); o.z = pk2(a[4], a[5]); o.w = pk2(a[6], a[7]); *(u32x4*)(XC + (size_t)t * D + c) = o; }
}
constexpr int CH = 64, NCH = SEQ / CH;
__device__ __forceinline__ void p_scan1(Frame& F) {
    const bf16* LA = WSP(bf16, WS_RA + RA_LA); const bf16* UU = WSP(bf16, WS_RA + RA_U); float* CP = WSP(float, WS_CHP); float* CHh = WSP(float, WS_CHH);
    for (int i = F.vcu * NTHR + F.tid; i < BATCH * NCH * (D / 4); i += NGT) { const int c4 = (i & 255) * 4, ck = (i >> 8) & (NCH - 1), b = i >> 16;
        const size_t r0 = ((size_t)b * SEQ + (size_t)ck * CH) * D + c4; f32x4 h = {0.f, 0.f, 0.f, 0.f}, sl = {0.f, 0.f, 0.f, 0.f};
#pragma unroll 8
        for (int t = 0; t < CH; ++t) { const u32x2 lw = *(const u32x2*)(LA + r0 + (size_t)t * D), uw = *(const u32x2*)(UU + r0 + (size_t)t * D);
            const f32x4 la = {bf_lo(lw.x), bf_hi(lw.x), bf_lo(lw.y), bf_hi(lw.y)}, u = {bf_lo(uw.x), bf_hi(uw.x), bf_lo(uw.y), bf_hi(uw.y)};
#pragma unroll
            for (int j = 0; j < 4; ++j) { h[j] = __expf(la[j]) * h[j] + u[j]; sl[j] += la[j]; } }
#pragma unroll
        for (int j = 0; j < 4; ++j) { const size_t o = ((size_t)b * D + c4 + j) * NCH + ck; CP[o] = __expf(sl[j]); CHh[o] = h[j]; } }
}
__device__ __forceinline__ void p_scan2(Frame& F) {
    const float* CP = WSP(float, WS_CHP); const float* CHh = WSP(float, WS_CHH); float* CIN = WSP(float, WS_CIN);
    for (int s = F.vcu * NWAVES + F.wave; s < BATCH * D; s += NGW) { const size_t o = (size_t)s * NCH + 4 * F.lane;
        const f32x4 p4 = *(const f32x4*)(CP + o), h4 = *(const f32x4*)(CHh + o);
        float p = p4.x, h = h4.x; h = p4.y * h + h4.y; p *= p4.y; h = p4.z * h + h4.z; p *= p4.z; h = p4.w * h + h4.w; p *= p4.w;
#pragma unroll
        for (int off = 1; off < 64; off <<= 1) { const float pp = __shfl_up(p, off), hp = __shfl_up(h, off); if (F.lane >= off) { h = p * hp + h; p = pp * p; } }
        float c0 = __shfl_up(h, 1); if (F.lane == 0) c0 = 0.f;
        f32x4 ci; ci.x = c0; ci.y = p4.x * ci.x + h4.x; ci.z = p4.y * ci.y + h4.y; ci.w = p4.z * ci.z + h4.z;
        *(f32x4*)(CIN + o) = ci; }
}
__device__ __forceinline__ void p_scan3(Frame& F) {
    const bf16* LA = WSP(bf16, WS_RA + RA_LA); const bf16* UU = WSP(bf16, WS_RA + RA_U); const float* CIN = WSP(float, WS_CIN);
    const bf16* GG = WSP(bf16, WS_RA + RA_GG); bf16* YB = WSP(bf16, WS_RA + RA_YB);
    for (int i = F.vcu * NTHR + F.tid; i < BATCH * NCH * (D / 4); i += NGT) { const int c4 = (i & 255) * 4, ck = (i >> 8) & (NCH - 1), b = i >> 16;
        const size_t r0 = ((size_t)b * SEQ + (size_t)ck * CH) * D + c4; f32x4 h;
#pragma unroll
        for (int j = 0; j < 4; ++j) h[j] = CIN[((size_t)b * D + c4 + j) * NCH + ck];
#pragma unroll 1
        for (int t0 = 0; t0 < CH; t0 += 8) { u32x2 lw[8], uw[8], gw[8];
#pragma unroll
            for (int k = 0; k < 8; ++k) { const size_t o = r0 + (size_t)(t0 + k) * D; lw[k] = *(const u32x2*)(LA + o); uw[k] = *(const u32x2*)(UU + o); gw[k] = *(const u32x2*)(GG + o); }
#pragma unroll
            for (int k = 0; k < 8; ++k) { const f32x4 la = {bf_lo(lw[k].x), bf_hi(lw[k].x), bf_lo(lw[k].y), bf_hi(lw[k].y)}, u = {bf_lo(uw[k].x), bf_hi(uw[k].x), bf_lo(uw[k].y), bf_hi(uw[k].y)};
#pragma unroll
                for (int j = 0; j < 4; ++j) h[j] = __expf(la[j]) * h[j] + u[j];
                u32x2 o; o.x = pk2(h.x * bf_lo(gw[k].x), h.y * bf_hi(gw[k].x)); o.y = pk2(h.z * bf_lo(gw[k].y), h.w * bf_hi(gw[k].y)); *(u32x2*)(YB + r0 + (size_t)(t0 + k) * D) = o; } } }
}
__device__ __forceinline__ void p_ln(Frame& F, const float* V, const float* g, const float* b, float* Hf, bf16* Hb) {
    unsigned char* Hq = WSP(unsigned char, WS_HQ);
    for (int r = F.vcu * NWAVES + F.wave; r < M; r += NGW) { const f32x4* xr = (const f32x4*)(V + (size_t)r * D) + F.lane; f32x4 v[4];
#pragma unroll
        for (int j = 0; j < 4; ++j) v[j] = xr[64 * j];
        ln_store(v, g, b, Hf + (size_t)r * D, Hb + (size_t)r * D, F.lane, Hq + (size_t)r * D); }
}
template <int CTRL> __device__ __forceinline__ float dppf(float x) { return __builtin_bit_cast(float, __builtin_amdgcn_mov_dpp(__builtin_bit_cast(int, x), CTRL, 0xF, 0xF, true)); }
template <int CTRL> __device__ __forceinline__ unsigned dppu(unsigned x) { return (unsigned)__builtin_amdgcn_mov_dpp((int)x, CTRL, 0xF, 0xF, true); }
__device__ __forceinline__ float rdlane_f(float x, int l) { return __builtin_bit_cast(float, __builtin_amdgcn_readlane(__builtin_bit_cast(int, x), l)); }
__device__ __forceinline__ void p_route(Frame& F, const float* bias) {
    const float* LG = WSP(float, WS_LOGITS); int* TOPI = WSP(int, WS_TOPI); float* GATE = WSP(float, WS_GATE); int* HIST = WSP(int, WS_HIST);
    LAS int* hist = (LAS int*)F.lds; const int lane = F.lane;
    if (F.tid < 256) hist[F.tid] = 0;
    __syncthreads();
    const f32x4 bv = *(const f32x4*)(bias + 4 * lane);
#pragma unroll 2
    for (int j = 0; j < 16; ++j) { const int t = F.vcu * 128 + F.wave * 16 + j;
        const f32x4 z = *(const f32x4*)(LG + (size_t)t * NE + 4 * lane);
        const float s0 = sigmoidf_(z.x), s1 = sigmoidf_(z.y), s2 = sigmoidf_(z.z), s3 = sigmoidf_(z.w);
        const float v0 = s0 + bv.x, v1 = s1 + bv.y, v2 = s2 + bv.z, v3 = s3 + bv.w;
        float m1, m2; { const float a = fmaxf(v0, v1), b = fminf(v0, v1), c = fmaxf(v2, v3), d = fminf(v2, v3); m1 = fmaxf(a, c); m2 = fmaxf(fminf(a, c), fmaxf(b, d)); }
        { float o1 = dppf<0xB1>(m1), o2 = dppf<0xB1>(m2); float n1 = fmaxf(m1, o1), n2 = fmaxf(fminf(m1, o1), fmaxf(m2, o2)); m1 = n1; m2 = n2;
          o1 = dppf<0x4E>(m1); o2 = dppf<0x4E>(m2); n1 = fmaxf(m1, o1); n2 = fmaxf(fminf(m1, o1), fmaxf(m2, o2)); m1 = n1; m2 = n2;
          o1 = dppf<0x141>(m1); o2 = dppf<0x141>(m2); n1 = fmaxf(m1, o1); n2 = fmaxf(fminf(m1, o1), fmaxf(m2, o2)); m1 = n1; m2 = n2; }
        const float gs = m1 + m2; const int g = lane >> 3; int rank = 0;
#pragma unroll
        for (int q = 0; q < 8; ++q) { const float o = rdlane_f(gs, 8 * q); rank += (o > gs || (o == gs && q < g)) ? 1 : 0; }
        const bool sel = rank < 4;
        const unsigned ib = 255u - 4u * (unsigned)lane;
        unsigned k0 = sel ? ((__float_as_uint(v0 + 1.0f) & ~255u) | ib) : 0u, k1 = sel ? ((__float_as_uint(v1 + 1.0f) & ~255u) | (ib - 1u)) : 0u;
        unsigned k2 = sel ? ((__float_as_uint(v2 + 1.0f) & ~255u) | (ib - 2u)) : 0u, k3 = sel ? ((__float_as_uint(v3 + 1.0f) & ~255u) | (ib - 3u)) : 0u;
        int myidx = 0; float mys = 0.f, tot = 0.f;
#pragma unroll
        for (int k = 0; k < TOPK; ++k) {
            unsigned mk = max(max(k0, k1), max(k2, k3));
            mk = max(mk, dppu<0xB1>(mk)); mk = max(mk, dppu<0x4E>(mk)); mk = max(mk, dppu<0x141>(mk)); mk = max(mk, dppu<0x140>(mk));
            const unsigned win = max(max((unsigned)__builtin_amdgcn_readlane((int)mk, 0), (unsigned)__builtin_amdgcn_readlane((int)mk, 16)), max((unsigned)__builtin_amdgcn_readlane((int)mk, 32), (unsigned)__builtin_amdgcn_readlane((int)mk, 48)));
            const int idx = 255 - (int)(win & 255u);
            k0 = (k0 == win) ? 0u : k0; k1 = (k1 == win) ? 0u : k1; k2 = (k2 == win) ? 0u : k2; k3 = (k3 == win) ? 0u : k3;
            const int qq = idx & 3; const float sq = qq == 0 ? s0 : (qq == 1 ? s1 : (qq == 2 ? s2 : s3)); const float sw = rdlane_f(sq, idx >> 2);
            tot += sw; if (lane == k) { myidx = idx; mys = sw; }
        }
        if (lane < TOPK) { TOPI[t * TOPK + lane] = myidx; GATE[t * TOPK + lane] = mys / tot * 2.5f; atomicAdd((int*)&hist[myidx], 1); }
    }
    __syncthreads();
    if (F.tid < 256) HIST[F.vcu * 256 + F.tid] = hist[F.tid];
    __syncthreads();
}
__device__ __forceinline__ void p_sort(Frame& F) {
    const int* HIST = WSP(int, WS_HIST); const int* TOPI = WSP(int, WS_TOPI); int* ROWA = WSP(int, WS_ROWA); int* POS = WSP(int, WS_POS); int* BLKE = WSP(int, WS_BLKE); int* META = WSP(int, WS_META);
    LAS int* cnt = (LAS int*)F.lds; LAS int* myoff = cnt + 256; LAS int* nb = cnt + 512; LAS int* blk0 = cnt + 768; LAS int* lcnt = cnt + 1024;
    { typedef int i32x4 __attribute__((ext_vector_type(4)));
      const int q = F.tid >> 6, l = F.tid & 63; i32x4 c = {0, 0, 0, 0}, mo = {0, 0, 0, 0};
#pragma unroll 8
      for (int w = q; w < NWG; w += 8) { const i32x4 h = *(const i32x4*)(HIST + w * 256 + 4 * l); c += h; if (w < F.vcu) mo += h; }
      LAS int* redc = cnt + 1280; LAS int* redm = redc + 2048;
#pragma unroll
      for (int j = 0; j < 4; ++j) { redc[q * 256 + 4 * l + j] = c[j]; redm[q * 256 + 4 * l + j] = mo[j]; }
      __syncthreads();
      if (F.tid < 256) { const int e = F.tid; int cc = 0, mm = 0;
#pragma unroll
          for (int k = 0; k < 8; ++k) { cc += redc[k * 256 + e]; mm += redm[k * 256 + e]; }
          cnt[e] = cc; myoff[e] = mm; nb[e] = (cc + 255) >> 8; lcnt[e] = 0; } }
    __syncthreads();
    if (F.tid < 256) { int b = 0; for (int j = 0; j < F.tid; ++j) b += nb[j]; blk0[F.tid] = b; }
    __syncthreads();
    for (int al = F.tid; al < 1024; al += NTHR) { const int a = F.vcu * 1024 + al; const int e = TOPI[a]; const int pos = blk0[e] * 256 + myoff[e] + atomicAdd((int*)&lcnt[e], 1); ROWA[pos] = a; POS[a] = pos; }
    const int nrb = blk0[255] + nb[255];
    { const int e = F.vcu; const int start = blk0[e] * 256 + cnt[e], end = (blk0[e] + nb[e]) * 256;
      for (int p = start + F.tid; p < end; p += NTHR) ROWA[p] = -1;
      for (int j = F.tid; j < nb[e]; j += NTHR) BLKE[blk0[e] + j] = e; }
    for (int tl = F.tid; tl < 128; tl += NTHR) { const int t = F.vcu * 128 + tl; ROWA[nrb * 256 + t] = 8 * M + t; }
    if (F.vcu == 0) { for (int j = F.tid; j < 128; j += NTHR) BLKE[nrb + j] = 256; if (F.tid == 0) META[0] = nrb + 128; }
    __syncthreads();
}
__device__ __forceinline__ void p_combine(Frame& F, const float* Hin, const float* g, const float* b, float* Hf, unsigned char* Hq) {
    const bf16* YA = WSP(bf16, WS_RA); const float* GATE = WSP(float, WS_GATE); const int* POS = WSP(int, WS_POS); const int shrow0 = (*WSP(int, WS_META) - 128) * 256;
    for (int t = F.vcu * NWAVES + F.wave; t < M; t += NGW) { f32x4 v[4];
        const f32x4* hr = (const f32x4*)(Hin + (size_t)t * D) + F.lane;
#pragma unroll
        for (int j = 0; j < 4; ++j) v[j] = hr[64 * j] * ALPHA;
        f32x4 r[4];
#pragma unroll
        for (int j = 0; j < 4; ++j) r[j] = (f32x4){0.f, 0.f, 0.f, 0.f};
#pragma unroll
        for (int k = 0; k < TOPK; ++k) { const float gk = GATE[t * TOPK + k] * 0.0625f; const unsigned* yr = (const unsigned*)((const unsigned char*)YA + (size_t)POS[t * TOPK + k] * D) + F.lane;
#pragma unroll
            for (int j = 0; j < 4; ++j) { const unsigned w = yr[64 * j]; const f32x2 a = __builtin_amdgcn_cvt_pk_f32_fp8((int)w, false), c = __builtin_amdgcn_cvt_pk_f32_fp8((int)w, true);
                r[j].x += gk * a.x; r[j].y += gk * a.y; r[j].z += gk * c.x; r[j].w += gk * c.y; } }
        { const unsigned* yr = (const unsigned*)((const unsigned char*)YA + (size_t)(shrow0 + t) * D) + F.lane;
#pragma unroll
            for (int j = 0; j < 4; ++j) { const unsigned w = yr[64 * j]; const f32x2 a = __builtin_amdgcn_cvt_pk_f32_fp8((int)w, false), c = __builtin_amdgcn_cvt_pk_f32_fp8((int)w, true);
                v[j].x += r[j].x + 0.0625f * a.x; v[j].y += r[j].y + 0.0625f * a.y; v[j].z += r[j].z + 0.0625f * c.x; v[j].w += r[j].w + 0.0625f * c.y; } }
        ln_store(v, g, b, Hf + (size_t)t * D, nullptr, F.lane, Hq ? Hq + (size_t)t * D : nullptr); }
}
constexpr int AT_KP = 144, AT_VP = 784, AT_KBYTES = 384 * AT_KP, AT_VOFF = AT_KBYTES;
__device__ __forceinline__ void p_attn(Frame& F) {
    const bf16* QKb = WSP(bf16, WS_RA + RA_QK); const bf16* VTb = WSP(bf16, WS_RA + RA_VT); bf16* OGb = WSP(bf16, WS_RA + RA_OG); float* LSE = WSP(float, WS_LSE);
    const int lane = F.lane, q = lane & 31, hh = lane >> 5, w = F.wave;
    LAS unsigned char* lk = F.lds; LAS unsigned char* lv = F.lds + AT_VOFF;
#pragma unroll 1
    for (int it = F.vcu; it < 3 * 128 * 8; it += NWG) {
        const int g = it >> 10, rem = it & 1023, chunk = rem >> 3, h = rem & 7;
        const int sh = 14 - 2 * g, rq0 = chunk * 256, i0 = rq0 & ((1 << sh) - 1), rk0 = rq0 - 128;
        const bf16* QK = QKb + (size_t)g * M * 1024; const bf16* VT = VTb + (size_t)g * 512 * M;
        { const char* kb = (const char*)(QK + 512 + h * 64);
#pragma unroll
          for (int j = 0; j < 7; ++j) { const int ins = w + 8 * j; if (ins < 54) { const int p = ins * 64 + lane, row = p / 9, cc = p - row * 9; const int gr = rk0 + row < 0 ? 0 : rk0 + row;
              __builtin_amdgcn_global_load_lds((const unsigned*)(kb + (size_t)gr * 2048 + (cc > 7 ? 7 : cc) * 16), (LAS unsigned*)(lk + ins * 1024), 16, 0, 0); } }
          const char* vb = (const char*)(VT + (size_t)(h * 64) * M);
#pragma unroll
          for (int j = 0; j < 7; ++j) { const int ins = w + 8 * j; if (ins < 49) { const int p = ins * 64 + lane, row = p / 49, cc = p - row * 49; int col = rk0 + (cc > 47 ? 47 : cc) * 8; col = col < 0 ? 0 : col;
              __builtin_amdgcn_global_load_lds((const unsigned*)(vb + ((size_t)row * M + col) * 2), (LAS unsigned*)(lv + ins * 1024), 16, 0, 0); } } }
        bf16x8 Qf[4];
        { const bf16* qp = QK + (size_t)(rq0 + 32 * w + q) * 1024 + h * 64 + 8 * hh;
#pragma unroll
          for (int s2 = 0; s2 < 4; ++s2) Qf[s2] = *(const bf16x8*)(qp + 16 * s2); }
        asm volatile("s_waitcnt vmcnt(0)" ::: "memory");
        __syncthreads();
        const float slope2 = exp2f(-(float)(h + 1)) * (float)(1 << (2 * g)) * 1.4426950408889634f, sc = 0.125f * 1.4426950408889634f;
        float m_run = -1e30f, l_run = 0.f; f32x16 O0, O1;
#pragma unroll
        for (int r = 0; r < 16; ++r) { O0[r] = 0.f; O1[r] = 0.f; }
#pragma unroll 1
        for (int kt = 0; kt < 5; ++kt) { const int kr0 = 32 * w + 32 * kt; if (i0 + kr0 - 128 < 0) continue;
            bf16x8 Kf[4];
            { const LAS unsigned char* kp = lk + (kr0 + q) * AT_KP + 16 * hh;
#pragma unroll
              for (int s2 = 0; s2 < 4; ++s2) Kf[s2] = *(const LAS bf16x8*)(kp + 32 * s2); }
            bf16x8 Vf[2][2];
#pragma unroll
            for (int dd = 0; dd < 2; ++dd)
#pragma unroll
                for (int s2 = 0; s2 < 2; ++s2) { const LAS unsigned char* vp = lv + (32 * dd + q) * AT_VP + (kr0 + 16 * s2 + 4 * hh) * 2;
                    const u32x2 lo = *(const LAS u32x2*)vp, hi = *(const LAS u32x2*)(vp + 16); u32x4 wv; wv.x = lo.x; wv.y = lo.y; wv.z = hi.x; wv.w = hi.y; Vf[dd][s2] = __builtin_bit_cast(bf16x8, wv); }
            f32x16 S;
#pragma unroll
            for (int r = 0; r < 16; ++r) S[r] = 0.f;
#pragma unroll
            for (int s2 = 0; s2 < 4; ++s2) S = __builtin_amdgcn_mfma_f32_32x32x16_bf16(Kf[s2], Qf[s2], S, 0, 0, 0);
            float mx = -1e30f;
#pragma unroll
            for (int r = 0; r < 16; ++r) { const int krow = (r & 3) + 8 * (r >> 2) + 4 * hh; const int dist = 128 - 32 * kt + q - krow;
                const float sv = (dist >= 0 && dist <= 128) ? S[r] * sc - slope2 * (float)dist : -1e30f; S[r] = sv; mx = fmaxf(mx, sv); }
            mx = fmaxf(mx, __shfl_xor(mx, 32));
            const float m_new = fmaxf(m_run, mx), alpha = exp2f(m_run - m_new); float rs = 0.f;
#pragma unroll
            for (int r = 0; r < 16; ++r) { const float p = exp2f(S[r] - m_new); S[r] = p; rs += p; }
            rs += __shfl_xor(rs, 32);
            l_run = l_run * alpha + rs; m_run = m_new;
#pragma unroll
            for (int r = 0; r < 16; ++r) { O0[r] *= alpha; O1[r] *= alpha; }
            bf16x8 Pf[2];
#pragma unroll
            for (int s2 = 0; s2 < 2; ++s2) { u32x4 wv; wv.x = pk2(S[8 * s2 + 0], S[8 * s2 + 1]); wv.y = pk2(S[8 * s2 + 2], S[8 * s2 + 3]); wv.z = pk2(S[8 * s2 + 4], S[8 * s2 + 5]); wv.w = pk2(S[8 * s2 + 6], S[8 * s2 + 7]); Pf[s2] = __builtin_bit_cast(bf16x8, wv); }
#pragma unroll
            for (int s2 = 0; s2 < 2; ++s2) { O0 = __builtin_amdgcn_mfma_f32_32x32x16_bf16(Vf[0][s2], Pf[s2], O0, 0, 0, 0); O1 = __builtin_amdgcn_mfma_f32_32x32x16_bf16(Vf[1][s2], Pf[s2], O1, 0, 0, 0); }
        }
        const float inv = 1.0f / l_run;
        bf16* op = OGb + ((size_t)g * M + rq0 + 32 * w + q) * 512 + h * 64 + 4 * hh;
#pragma unroll
        for (int rg = 0; rg < 4; ++rg) { u32x2 wv; wv.x = pk2(O0[4 * rg] * inv, O0[4 * rg + 1] * inv); wv.y = pk2(O0[4 * rg + 2] * inv, O0[4 * rg + 3] * inv); *(u32x2*)(op + 8 * rg) = wv;
            u32x2 w1; w1.x = pk2(O1[4 * rg] * inv, O1[4 * rg + 1] * inv); w1.y = pk2(O1[4 * rg + 2] * inv, O1[4 * rg + 3] * inv); *(u32x2*)(op + 32 + 8 * rg) = w1; }
        if (hh == 0) LSE[((size_t)g * M + rq0 + 32 * w + q) * 8 + h] = (m_run + log2f(l_run)) * 0.6931471805599453f;
        __syncthreads();
    }
}
__device__ __forceinline__ void p_merge(Frame& F) {
    const bf16* OGb = WSP(bf16, WS_RA + RA_OG); const float* LSE = WSP(float, WS_LSE); bf16* OM = WSP(bf16, WS_RA + RA_OM);
    for (int t = F.vcu * NWAVES + F.wave; t < M; t += NGW) { const int hd = F.lane >> 3; float ls[3]; size_t ro[3];
#pragma unroll
        for (int g = 0; g < 3; ++g) { const int rho = tok_to_rho(t, g); ro[g] = ((size_t)g * M + rho); ls[g] = LSE[ro[g] * 8 + hd]; }
        const float mx = fmaxf(ls[0], fmaxf(ls[1], ls[2])); float w[3], ws = 0.f;
#pragma unroll
        for (int g = 0; g < 3; ++g) { w[g] = __expf(ls[g] - mx); ws += w[g]; }
        const float inv = 1.0f / ws; float o[8];
#pragma unroll
        for (int j = 0; j < 8; ++j) o[j] = 0.f;
#pragma unroll
        for (int g = 0; g < 3; ++g) { const u32x4 x = *(const u32x4*)(OGb + ro[g] * 512 + 8 * F.lane); const float wg = w[g] * inv;
            o[0] += wg * bf_lo(x.x); o[1] += wg * bf_hi(x.x); o[2] += wg * bf_lo(x.y); o[3] += wg * bf_hi(x.y); o[4] += wg * bf_lo(x.z); o[5] += wg * bf_hi(x.z); o[6] += wg * bf_lo(x.w); o[7] += wg * bf_hi(x.w); }
        u32x4 r; r.x = pk2(o[0], o[1]); r.y = pk2(o[2], o[3]); r.z = pk2(o[4], o[5]); r.w = pk2(o[6], o[7]); *(u32x4*)(OM + (size_t)t * OW + 8 * F.lane) = r; }
}

constexpr int NPHASE = 26;

__global__ void __launch_bounds__(NTHR, 2) yoco_fwd(Args args) {
    extern __shared__ __attribute__((aligned(16))) unsigned char lds[];
    Frame F;
    F.lds = (LAS unsigned char*)lds;
    F.tid = threadIdx.x; F.lane = F.tid & 63; F.wave = __builtin_amdgcn_readfirstlane(F.tid >> 6);
    { const int bx = blockIdx.x; F.vcu = (bx % 8) * (NWG / 8) + bx / 8; }
    F.ws = args.ws;
    volatile LAS unsigned* MISC = (volatile LAS unsigned*)(F.lds + LDS_BYTES - 64);
    if (F.tid < 16) MISC[F.tid] = 0u;
    __syncthreads();
    const int lo = args.ph_lo, hi = args.ph_hi;
    XcdBarrier bar; bar.bar = (unsigned*)(F.ws + WS_CTL) + 4096; bar.x = 0; bar.st = nullptr;
    if (hi - lo > 1) bar = xcd_barrier_post((unsigned*)(F.ws + WS_CTL) + 4096, MISC + 8);
#ifndef PROBE_G2
#define PROBE_G2 0
#endif
#ifndef DUP_MASK
#define DUP_MASK 0u
#endif
#ifndef PH_MASK
#define PH_MASK 0xFFFFFFFFu
#endif
#define IN(k) (((PH_MASK >> (k)) & 1u) && lo <= (k) && (k) < hi)
#define REP(k) for (int rep = 0, nrep = 1 + (int)((args.dup >> (k)) & 1u); rep < nrep; ++rep)
#define SEAM(k) do { if (IN(k) && IN((k) + 1)) xcd_barrier(bar); } while (0)

    if (IN(0)) { p0_prologue(F, args); } SEAM(0);
    if (IN(1)) { SchedDense8 S{WSP(unsigned char, WS_RA + RA_XB), WSP(unsigned char, WS_WIN), D, D, D, M / 256, 8, F.vcu}; EpiXZ E{WSP(bf16, WS_RA + RA_XR), WSP(bf16, WS_RA + RA_GG)}; gemm_fast8(F.lds, S, E); } SEAM(1);
    if (IN(2)) { p_conv(F, args.in[2], args.in[3]); } SEAM(2);
    if (IN(3)) { SchedGate S{WSP(bf16, WS_RA + RA_XC), WSP(bf16, WS_WG), F.vcu}; EpiGate E{WSP(bf16, WS_RA + RA_XC), args.in[5], args.in[7], args.in[8], WSP(bf16, WS_RA + RA_LA), WSP(bf16, WS_RA + RA_U)}; GEMM_PHASE(F.lds, S, E); } SEAM(3);
    if (IN(4)) { p_scan1(F); } SEAM(4);
    if (IN(5)) { p_scan2(F); } SEAM(5);
    if (IN(6)) { p_scan3(F); } SEAM(6);
    if (IN(7)) { SchedDense S{WSP(bf16, WS_RA + RA_YB), WSP(bf16, WS_WOUT), D, D, D, M / 256, 4, F.vcu}; EpiResF32 E{args.in[0], WSP(float, WS_V), D}; GEMM_PHASE(F.lds, S, E); } SEAM(7);
    if (IN(8)) { p_ln(F, WSP(float, WS_V), args.in[21] + 0 * D, args.in[22] + 0 * D, WSP(float, WS_HA), WSP(bf16, WS_HAB)); } SEAM(8);
    if (IN(9)) { SchedDense S{WSP(bf16, WS_HAB), WSP(bf16, WS_WR), D, D, D, M / 256, 1, F.vcu}; EpiF32 E{WSP(float, WS_LOGITS), NE}; GEMM_PHASE(F.lds, S, E); } SEAM(9);
    if (IN(10)) { p_route(F, args.in[14]); } SEAM(10);
    if (IN(11)) { p_sort(F); } SEAM(11);
    if (IN(12)) { const int nrbt = *WSP(int, WS_META); SchedG1 S{WSP(unsigned char, WS_HQ), WSP(unsigned char, WS_W13), WSP(int, WS_ROWA), WSP(int, WS_BLKE), nrbt, F.vcu, moe_unit_experts(F, WSP(int, WS_BLKE), nrbt, 1), moe_row_table(F, WSP(int, WS_ROWA), nrbt)}; EpiSwiGLU E{WSP(unsigned char, WS_HID)}; gemm_fast8(F.lds, S, E); } SEAM(12);
    if (IN(13)) { const int nrbt = *WSP(int, WS_META); SchedG2 S{WSP(unsigned char, WS_HID), WSP(unsigned char, WS_W2), WSP(int, WS_BLKE), nrbt, F.vcu, moe_unit_experts(F, WSP(int, WS_BLKE), nrbt, 2), args.rt256, args.rt256, args.rt256}; EpiScatter E{WSP(bf16, WS_RA), 0}; gemm_fast8(F.lds, S, E); if (PROBE_G2) { __syncthreads(); EpiScatter E2{(PROBE_G2 == 2 || PROBE_G2 == 4) ? WSP(bf16, WS_V) : WSP(bf16, WS_RA), PROBE_G2 == 3 ? 0 : PROBE_G2}; gemm_fast8(F.lds, S, E2); } } SEAM(13);
    if (IN(14)) { p_combine(F, WSP(float, WS_HA), args.in[21] + 1 * D, args.in[22] + 1 * D, WSP(float, WS_HB), WSP(unsigned char, WS_HQ)); convert_experts(F, args.in[15] + (size_t)NE * D * DE, args.in[16] + (size_t)NE * D * DE, args.in[17] + (size_t)NE * D * DE, args.in[18] + (size_t)D * DE, args.in[19] + (size_t)D * DE, args.in[20] + (size_t)D * DE); } SEAM(14);
    if (IN(15)) { EpiQKV E{WSP(bf16, WS_RA + RA_QK), WSP(bf16, WS_RA + RA_VT)}; for (int g = 0; g < 3; ++g) { SchedQK S{WSP(unsigned char, WS_HQ), WSP(unsigned char, WS_WQK), g, D << (2 * g), F.vcu}; gemm_fast8(F.lds, S, E); } for (int g = 0; g < 3; ++g) { SchedVT S{WSP(unsigned char, WS_HQ), WSP(unsigned char, WS_WQK) + (size_t)3072 * D, g, D << (2 * g), F.vcu}; gemm_fast8(F.lds, S, E); } } SEAM(15);
    if (IN(16)) { p_attn(F); } SEAM(16);
    if (IN(17)) { p_merge(F); } SEAM(17);
    if (IN(18)) { SchedDense S{WSP(bf16, WS_RA + RA_OM), WSP(bf16, WS_WO), OW, OW, OW, M / 256, 4, F.vcu}; EpiResF32 E{WSP(float, WS_HB), WSP(float, WS_V), D}; GEMM_PHASE(F.lds, S, E); } SEAM(18);
    if (IN(19)) { p_ln(F, WSP(float, WS_V), args.in[21] + 2 * D, args.in[22] + 2 * D, WSP(float, WS_HA), WSP(bf16, WS_HAB)); } SEAM(19);
    if (IN(20)) { SchedDense S{WSP(bf16, WS_HAB), WSP(bf16, WS_WR) + (size_t)NE * D, D, D, D, M / 256, 1, F.vcu}; EpiF32 E{WSP(float, WS_LOGITS), NE}; GEMM_PHASE(F.lds, S, E); } SEAM(20);
    if (IN(21)) { p_route(F, args.in[14] + NE); } SEAM(21);
    if (IN(22)) { p_sort(F); } SEAM(22);
    if (IN(23)) { const int nrbt = *WSP(int, WS_META); SchedG1 S{WSP(unsigned char, WS_HQ), WSP(unsigned char, WS_W13), WSP(int, WS_ROWA), WSP(int, WS_BLKE), nrbt, F.vcu, moe_unit_experts(F, WSP(int, WS_BLKE), nrbt, 1), moe_row_table(F, WSP(int, WS_ROWA), nrbt)}; EpiSwiGLU E{WSP(unsigned char, WS_HID)}; gemm_fast8(F.lds, S, E); } SEAM(23);
    if (IN(24)) { const int nrbt = *WSP(int, WS_META); SchedG2 S{WSP(unsigned char, WS_HID), WSP(unsigned char, WS_W2), WSP(int, WS_BLKE), nrbt, F.vcu, moe_unit_experts(F, WSP(int, WS_BLKE), nrbt, 2), args.rt256, args.rt256, args.rt256}; EpiScatter E{WSP(bf16, WS_RA), 0}; gemm_fast8(F.lds, S, E); if (PROBE_G2) { __syncthreads(); EpiScatter E2{(PROBE_G2 == 2 || PROBE_G2 == 4) ? WSP(bf16, WS_V) : WSP(bf16, WS_RA), PROBE_G2 == 3 ? 0 : PROBE_G2}; gemm_fast8(F.lds, S, E2); } } SEAM(24);
    if (IN(25)) { p_combine(F, WSP(float, WS_HA), args.in[21] + 3 * D, args.in[22] + 3 * D, args.out, nullptr); }
#undef IN
#undef SEAM
}

extern "C" void kernel_launch(void* const* d_in, const int* in_sizes, int n_in, void* d_out, int out_size, void* d_ws, size_t ws_size, hipStream_t stream) {
    static int ok = 0;
    if (ok == 0) {
        if (n_in != 23 || in_sizes[0] != M * D || out_size != M * D || ws_size < WS_END) { fprintf(stderr, "kernel_launch: unexpected shapes (n_in %d, in0 %d, out %d, ws %zu < %zu)\n", n_in, n_in > 0 ? in_sizes[0] : -1, out_size, ws_size, (size_t)WS_END); ok = -1; return; }
        if (hipFuncSetAttribute((const void*)yoco_fwd, hipFuncAttributeMaxDynamicSharedMemorySize, LDS_BYTES) != hipSuccess) { fprintf(stderr, "kernel_launch: hipFuncSetAttribute failed\n"); ok = -1; return; }
        int per_cu = 0;
        if (hipOccupancyMaxActiveBlocksPerMultiprocessor(&per_cu, (const void*)yoco_fwd, NTHR, LDS_BYTES) != hipSuccess || per_cu < 1) fprintf(stderr, "kernel_launch: occupancy query says %d\n", per_cu);
        (void)hipGetLastError();
        ok = 1;
    }
    if (ok < 0) return;
    if (hipMemsetAsync((char*)d_ws + WS_CTL, 0, CTL_ZERO_BYTES, stream) != hipSuccess) return;
    Args a{};
    for (int i = 0; i < 23; ++i) a.in[i] = (const float*)d_in[i];
    a.out = (float*)d_out; a.ws = (unsigned char*)d_ws; a.dup = 0u; a.rt256 = 256;
#if MK_ONE_LAUNCH
    a.ph_lo = 0; a.ph_hi = NPHASE;
    hipLaunchKernelGGL(yoco_fwd, dim3(NWG), dim3(NTHR), LDS_BYTES, stream, a);
#else
    for (int p = 0; p < NPHASE; ++p) { a.ph_lo = p; a.ph_hi = p + 1; hipLaunchKernelGGL(yoco_fwd, dim3(NWG), dim3(NTHR), LDS_BYTES, stream, a); }
#endif
}
```

```cpp
#include <hip/hip_runtime.h>
#include <cstdio>
#include <cstdint>

#ifndef MK_ONE_LAUNCH
#define MK_ONE_LAUNCH 1
#endif

constexpr int D = 1024, BATCH = 2, SEQ = 16384, M = BATCH * SEQ;
constexpr int NE = 256, TOPK = 8, DE = 256;
constexpr int HEADS = 8, HD = 64, QW = 1536, OW = 512;
constexpr float LN_EPS = 1e-5f, ALPHA = 1.41421356237f;
constexpr int RBMAX = 1024 + 256 + 128;
constexpr int NWG = 256, NTHR = 512, NWAVES = 8;
constexpr int NGW = NWG * NWAVES, NGT = NWG * NTHR;

constexpr size_t MiB = 1u << 20;
constexpr size_t WS_CTL = 0, CTL_ZERO_BYTES = 1 * MiB;
constexpr size_t WS_HIST = 1 * MiB, WS_BLKE = 1 * MiB + 512 * 1024, WS_META = 1 * MiB + 768 * 1024;
constexpr size_t WS_ROWA = 2 * MiB, WS_TOPI = 4 * MiB, WS_GATE = 5 * MiB, WS_CHP = 6 * MiB, WS_CHH = 8 * MiB, WS_CIN = 10 * MiB, WS_LSE = 12 * MiB;
constexpr size_t WS_WIN = 16 * MiB, WS_WG = 20 * MiB, WS_WOUT = 21 * MiB, WS_WQK = 23 * MiB, WS_WV = 29 * MiB, WS_WO = 32 * MiB, WS_WR = 33 * MiB;
constexpr size_t WS_LOGITS = 34 * MiB;
constexpr size_t WS_W13 = 66 * MiB, WS_W2 = 323 * MiB;
constexpr size_t WS_V = 452 * MiB, WS_HA = 580 * MiB, WS_HAB = 708 * MiB, WS_HB = 772 * MiB, WS_HBB = 900 * MiB, WS_HID = 964 * MiB;
constexpr size_t WS_RA = 1140 * MiB;
constexpr size_t RA_XB = 0, RA_XR = 64 * MiB, RA_GG = 128 * MiB, RA_XC = 192 * MiB, RA_LA = 256 * MiB, RA_U = 384 * MiB, RA_YB = 512 * MiB;
constexpr size_t RA_QK = 0, RA_VT = 192 * MiB, RA_OG = 288 * MiB, RA_OM = 384 * MiB;
constexpr size_t WS_POS = 15 * MiB;
constexpr size_t WS_HQ = 1844 * MiB;
constexpr size_t WS_END = 1876 * MiB;

constexpr int LDS_BYTES = 163840;
constexpr int LDS_EPI = 131072, LDS_TAB = 147456;

#define GAS __attribute__((address_space(1)))
#define LAS __attribute__((address_space(3)))
typedef unsigned short bf16;
typedef unsigned u32x4 __attribute__((ext_vector_type(4)));
typedef unsigned u32x2 __attribute__((ext_vector_type(2)));
typedef float f32x4 __attribute__((ext_vector_type(4)));
typedef float f32x2 __attribute__((ext_vector_type(2)));
typedef float f32x16 __attribute__((ext_vector_type(16)));
typedef short bf16x8 __attribute__((ext_vector_type(8)));
typedef int i32x8 __attribute__((ext_vector_type(8)));
typedef GAS unsigned gu32;
#define RLX_AGENT __ATOMIC_RELAXED, __HIP_MEMORY_SCOPE_AGENT
#define LDS_WAIT() asm volatile("s_waitcnt lgkmcnt(0)" ::: "memory")
#define VM_WAIT() asm volatile("s_waitcnt vmcnt(0)" ::: "memory")

__device__ __forceinline__ unsigned pk2(float lo, float hi) { unsigned r; asm("v_cvt_pk_bf16_f32 %0, %1, %2" : "=v"(r) : "v"(lo), "v"(hi)); return r; }
__device__ __forceinline__ float bf_lo(unsigned w) { return __uint_as_float(w << 16); }
__device__ __forceinline__ float bf_hi(unsigned w) { return __uint_as_float(w & 0xffff0000u); }
__device__ __forceinline__ float wave_sum(float v) {
#pragma unroll
    for (int o = 1; o < 64; o <<= 1) v += __shfl_xor(v, o);
    return v;
}
__device__ __forceinline__ float gelu_tanh(float x) {
    const float u = 0.7978845608028654f * (x + 0.044715f * x * x * x);
    const float e = __expf(2.0f * u);
    const float t = 1.0f - 2.0f / (e + 1.0f);
    return 0.5f * x * (1.0f + t);
}
__device__ __forceinline__ float sigmoidf_(float x) { return 1.0f / (1.0f + __expf(-x)); }

#define XB_TMO      128
#define XB_XCNT(j)  (256  + 64 * (j))
#define XB_XSUB(j)  (1280 + 64 * (j))
#define XB_XGEN(j)  (2304 + 64 * (j))
#define XB_TOP      3328
#define XB_TOPGEN   3392
#define XCD_BAR_WORDS 3456
#define XB_SPIN_CAP (1u << 18)
__device__ __forceinline__ unsigned xb_ld(unsigned* p)              { return __hip_atomic_load(p, __ATOMIC_RELAXED, __HIP_MEMORY_SCOPE_AGENT); }
__device__ __forceinline__ unsigned xb_add(unsigned* p, unsigned v) { return __hip_atomic_fetch_add(p, v, __ATOMIC_RELAXED, __HIP_MEMORY_SCOPE_AGENT); }
__device__ __forceinline__ unsigned xb_xcc_id() { return (unsigned)__builtin_amdgcn_s_getreg((3 << 11) | 20) & 0xFu; }
#define XB_SPIN(cond, bar) do { unsigned _sp = 0; while (cond) { __builtin_amdgcn_s_sleep(1); \
    if ((++_sp & 255u) == 0u) { if (xb_ld(&(bar)[XB_TMO])) break; if (_sp > XB_SPIN_CAP) { atomicAdd(&(bar)[XB_TMO], 1u); break; } } } } while (0)
struct XcdBarrier { unsigned* bar; unsigned x; volatile LAS unsigned* st; };
__device__ __forceinline__ XcdBarrier xcd_barrier_post(unsigned* bar, volatile LAS unsigned* st) {
    XcdBarrier b; b.bar = bar; b.x = xb_xcc_id(); b.st = st;
    if (threadIdx.x == 0) (void)xb_add(&bar[XB_XCNT(b.x)], 1u);
    return b;
}
__device__ __forceinline__ void xcd_barrier_complete(unsigned* bar, unsigned x, unsigned& nloc, unsigned& nx) {
    const unsigned G = gridDim.x * gridDim.y * gridDim.z;
    unsigned sum, cnt, mine, sp = 0u;
    for (;;) {
        sum = 0u; cnt = 0u; mine = 0u;
#pragma unroll
        for (unsigned j = 0; j < 16; ++j) { const unsigned c = xb_ld(&bar[XB_XCNT(j)]); sum += c; cnt += (c > 0u) ? 1u : 0u; mine = (j == x) ? c : mine; }
        if (sum == G) break;
        __builtin_amdgcn_s_sleep(1);
        if ((++sp & 255u) == 0u) { if (xb_ld(&bar[XB_TMO])) break; if (sp > XB_SPIN_CAP) { atomicAdd(&bar[XB_TMO], 1u); break; } }
    }
    nloc = mine > 0u ? mine : 1u; nx = cnt > 0u ? cnt : 1u;
}
__device__ __forceinline__ void xcd_barrier(const XcdBarrier& b) {
    asm volatile("s_waitcnt vmcnt(0)" ::: "memory");
    __syncthreads();
    if (threadIdx.x == 0) {
        unsigned* bar = b.bar;
        __builtin_amdgcn_s_waitcnt(0);
        unsigned nloc = b.st[0], nx = b.st[1];
        if (nloc == 0u) { xcd_barrier_complete(bar, b.x, nloc, nx); b.st[0] = nloc; b.st[1] = nx; }
        const unsigned old = xb_add(&bar[XB_XSUB(b.x)], 1u);
        const unsigned gen = old / nloc;
        if (old + 1u == (gen + 1u) * nloc) {
            __builtin_amdgcn_fence(__ATOMIC_RELEASE, "agent");
            asm volatile("s_waitcnt vmcnt(0)" ::: "memory");
            const unsigned og = xb_add(&bar[XB_TOP], 1u);
            const unsigned tg = og / nx;
            if (og + 1u == (tg + 1u) * nx) xb_add(&bar[XB_TOPGEN], 1u);
            else XB_SPIN(xb_ld(&bar[XB_TOPGEN]) == tg, bar);
            __builtin_amdgcn_fence(__ATOMIC_ACQUIRE, "agent");
            xb_add(&bar[XB_XGEN(b.x)], 1u);
            asm volatile("s_waitcnt vmcnt(0)" ::: "memory");
        } else {
            XB_SPIN(xb_ld(&bar[XB_XGEN(b.x)]) == gen, bar);
            __builtin_amdgcn_fence(__ATOMIC_ACQUIRE, "agent");
            asm volatile("s_waitcnt vmcnt(0)" ::: "memory");
        }
    }
    __syncthreads();
}

struct Args { const float* in[23]; float* out; unsigned char* ws; int ph_lo, ph_hi; unsigned dup; int rt256; };
static_assert(sizeof(Args) == 23 * 8 + 8 + 8 + 16, "Args has no padding");
struct Frame {
    LAS unsigned char* lds;
    int tid, lane, wave, vcu;
    unsigned char* ws;
};
#define WSP(T, off) ((T*)(F.ws + (off)))

template <class S, class E>
__device__ __forceinline__ void gemm_simple(LAS unsigned char* lds, const S& sch, const E& epi) {
    const int tid = threadIdx.x, wid = tid >> 6, lane = tid & 63, wr = wid >> 2, wc = wid & 3, fr = lane & 15, fq = lane >> 4;
    constexpr int PITCH = 144;
    LAS unsigned char* As = lds; LAS unsigned char* Bs = lds + 256 * PITCH;
    typename S::U u;
    for (int i = 0; sch.next(i, u); ++i) {
        f32x4 acc[2][2][4][2];
#pragma unroll
        for (int a = 0; a < 2; ++a)
#pragma unroll
            for (int b = 0; b < 2; ++b)
#pragma unroll
                for (int m = 0; m < 4; ++m)
#pragma unroll
                    for (int n = 0; n < 2; ++n) acc[a][b][m][n] = (f32x4){0.f, 0.f, 0.f, 0.f};
        const int nt = sch.K(u) / 64;
        const char* pa[4]; const char* pb[4];
#pragma unroll
        for (int j = 0; j < 4; ++j) { const int row = (tid >> 3) + 64 * j; const int rb = S::PERM ? ((row & ~31) + 8 * ((row & 15) >> 2) + 4 * ((row >> 4) & 1) + (row & 3)) : row; pa[j] = sch.rowA(u, row) + (tid & 7) * 16; pb[j] = sch.rowB(u, rb) + (tid & 7) * 16; }
        for (int kt = 0; kt < nt; ++kt) {
            u32x4 va[4], vb[4];
#pragma unroll
            for (int j = 0; j < 4; ++j) { va[j] = *(const u32x4*)(pa[j] + kt * 128); vb[j] = *(const u32x4*)(pb[j] + kt * 128); }
            __syncthreads();
#pragma unroll
            for (int j = 0; j < 4; ++j) { const int row = (tid >> 3) + 64 * j;
                *(LAS u32x4*)(As + row * PITCH + (tid & 7) * 16) = va[j]; *(LAS u32x4*)(Bs + row * PITCH + (tid & 7) * 16) = vb[j]; }
            __syncthreads();
#pragma unroll
            for (int kk = 0; kk < 2; ++kk) {
                bf16x8 Bf[2][2];
#pragma unroll
                for (int b = 0; b < 2; ++b)
#pragma unroll
                    for (int n = 0; n < 2; ++n) Bf[b][n] = *(const LAS bf16x8*)(Bs + (b * 128 + wc * 32 + n * 16 + fr) * PITCH + kk * 64 + fq * 16);
#pragma unroll
                for (int a = 0; a < 2; ++a) {
                    bf16x8 Af[4];
#pragma unroll
                    for (int m = 0; m < 4; ++m) Af[m] = *(const LAS bf16x8*)(As + (a * 128 + wr * 64 + m * 16 + fr) * PITCH + kk * 64 + fq * 16);
#pragma unroll
                    for (int b = 0; b < 2; ++b)
#pragma unroll
                        for (int m = 0; m < 4; ++m)
#pragma unroll
                            for (int n = 0; n < 2; ++n) acc[a][b][m][n] = __builtin_amdgcn_mfma_f32_16x16x32_bf16(Bf[b][n], Af[m], acc[a][b][m][n], 0, 0, 0);
                }
            }
        }
        epi(acc, u, wr, wc, fr, fq);
    }
    __syncthreads();
}

namespace pg8 {
constexpr int HTB = 128 * 64 * 2;
__device__ __forceinline__ int lds_byte(int r, int c) { const int st = (r >> 4) * 2 + (c >> 5), rr = r & 15, cc = c & 31, ob = rr * 64 + cc * 2; return st * 1024 + (ob ^ (((ob >> 9) & 1) << 5)); }
__device__ __forceinline__ int perm32(int rho) { const int n = rho >> 4, i = rho & 15; return 8 * (i >> 2) + 4 * n + (i & 3); }
__device__ __forceinline__ int prow(int r) { return (r & ~31) + perm32(r & 31); }
__device__ __forceinline__ void stage_rc(int b, int& R, int& C) { const int st = b / 1024, sb = b % 1024, swz = sb ^ (((sb >> 9) & 1) << 5); R = (st >> 1) * 16 + swz / 64; C = (st & 1) * 32 + (swz % 64) / 2; }
}
template <class S, class E>
__device__ __forceinline__ void gemm_fast(LAS unsigned char* lds, const S& sch, const E& epi) {
    using namespace pg8;
    const int tid = threadIdx.x, wid = __builtin_amdgcn_readfirstlane(tid >> 6), lane = tid & 63, wr = wid >> 2, wc = wid & 3, fr = lane & 15, fq = lane >> 4;
    const int nt = sch.Kk / 64;
    int R0, C0; stage_rc(tid * 16, R0, C0);
    unsigned voffA[2], voffB[2]; unsigned cofA[4], nofA[4], cofB[4], nofB[4];
    size_t hstepA = 0, hstepB = 0;
    if constexpr (!S::GA) { voffA[0] = (unsigned)(R0 * sch.lda + C0) * 2u; voffA[1] = (unsigned)((R0 + 64) * sch.lda + C0) * 2u; hstepA = (size_t)128 * sch.lda * 2; }
    const int RB0 = S::PERM ? prow(R0) : R0;
    if constexpr (!S::GB) { voffB[0] = (unsigned)(RB0 * sch.ldb + C0) * 2u; voffB[1] = (unsigned)((RB0 + 64) * sch.ldb + C0) * 2u; hstepB = (size_t)128 * sch.ldb * 2; }
    const size_t kstep = 128;
    const unsigned ldsw = (unsigned)wid * 1024u;
    const int aoff = lds_byte(wr * 64 + fr, fq * 8), boff = lds_byte(wc * 32 + fr, fq * 8);
#define G_SA(b, h) (((b) * 2 + (h)) * HTB)
#define G_SB(b, h) ((4 + (b) * 2 + (h)) * HTB)
#define G_GLDS(src, dst) __builtin_amdgcn_global_load_lds((const unsigned*)(src), (LAS unsigned*)(dst), 16, 0, 0)
#define G_STAGE_A(bufoff, gp, h, nx) do { if constexpr (S::GA) { _Pragma("unroll") for (int _i = 0; _i < 2; ++_i) { const unsigned _o = (nx) ? nofA[2 * (h) + _i] : cofA[2 * (h) + _i]; G_GLDS((gp) + _o, lds + (bufoff) + ldsw + _i * 8192); } } \
        else { _Pragma("unroll") for (int _i = 0; _i < 2; ++_i) G_GLDS((gp) + (size_t)(h) * hstepA + voffA[_i], lds + (bufoff) + ldsw + _i * 8192); } } while (0)
#define G_STAGE_B(bufoff, gp, h, nx) do { if constexpr (S::GB) { _Pragma("unroll") for (int _i = 0; _i < 2; ++_i) { const unsigned _o = (nx) ? nofB[2 * (h) + _i] : cofB[2 * (h) + _i]; G_GLDS((gp) + _o, lds + (bufoff) + ldsw + _i * 8192); } } \
        else { _Pragma("unroll") for (int _i = 0; _i < 2; ++_i) G_GLDS((gp) + (size_t)(h) * hstepB + voffB[_i], lds + (bufoff) + ldsw + _i * 8192); } } while (0)
#define G_LDA(dst, b, h) do { _Pragma("unroll") for (int m = 0; m < 4; ++m) _Pragma("unroll") for (int k = 0; k < 2; ++k) dst[m][k] = *(const LAS bf16x8*)(lds + G_SA(b, h) + aoff + m * 2048 + k * 1024); } while (0)
#define G_LDB(dst, b, h) do { _Pragma("unroll") for (int n = 0; n < 2; ++n) _Pragma("unroll") for (int k = 0; k < 2; ++k) dst[n][k] = *(const LAS bf16x8*)(lds + G_SB(b, h) + boff + n * 2048 + k * 1024); } while (0)
#define G_MMA(ai, bj, At, Bt) do { __builtin_amdgcn_s_setprio(1); _Pragma("unroll") for (int m = 0; m < 4; ++m) _Pragma("unroll") for (int n = 0; n < 2; ++n) _Pragma("unroll") for (int k = 0; k < 2; ++k) \
        acc[ai][bj][m][n] = __builtin_amdgcn_mfma_f32_16x16x32_bf16(Bt[n][k], At[m][k], acc[ai][bj][m][n], 0, 0, 0); __builtin_amdgcn_s_setprio(0); } while (0)
#define G_WAIT_V(n) asm volatile("s_waitcnt vmcnt(" #n ")" ::: "memory")
#define G_WAIT_L(n) asm volatile("s_waitcnt lgkmcnt(" #n ")" ::: "memory")
#define G_BAR __builtin_amdgcn_s_barrier()
#define G_SCHED __builtin_amdgcn_sched_barrier(0)
    typename S::U cur, nxt; int ui = 0;
    if (!sch.next(0, cur)) return;
    f32x4 acc[2][2][4][2];
#pragma unroll
    for (int a = 0; a < 2; ++a)
#pragma unroll
        for (int b = 0; b < 2; ++b)
#pragma unroll
            for (int m = 0; m < 4; ++m)
#pragma unroll
                for (int n = 0; n < 2; ++n) acc[a][b][m][n] = (f32x4){0.f, 0.f, 0.f, 0.f};
    bf16x8 At[4][2], B0[2][2], B1[2][2];
    const char* cA = sch.baseA(cur); const char* cB = sch.baseB(cur);
    if constexpr (S::GA) {
#pragma unroll
        for (int j = 0; j < 4; ++j) { cofA[j] = sch.goffA(cur, (j >> 1) * 128 + R0 + (j & 1) * 64, C0); nofA[j] = cofA[j]; } }
    if constexpr (S::GB) {
#pragma unroll
        for (int j = 0; j < 4; ++j) { cofB[j] = sch.goffB(cur, (j >> 1) * 128 + RB0 + (j & 1) * 64, C0); nofB[j] = cofB[j]; } }
    G_STAGE_B(G_SB(0, 0), cB, 0, false); G_STAGE_B(G_SB(0, 1), cB, 1, false); G_STAGE_A(G_SA(0, 0), cA, 0, false); G_STAGE_A(G_SA(0, 1), cA, 1, false);
    if (wr == 1) G_BAR;
    G_WAIT_V(2); G_BAR;
    G_STAGE_B(G_SB(1, 0), cB + kstep, 0, false); G_STAGE_A(G_SA(1, 0), cA + kstep, 0, false); G_STAGE_B(G_SB(1, 1), cB + kstep, 1, false);
    G_WAIT_V(6); G_BAR;
    for (;;) {
        const bool has_next = sch.next(ui + 1, nxt);
        const char* nA = has_next ? sch.baseA(nxt) : cA; const char* nB = has_next ? sch.baseB(nxt) : cB;
        if constexpr (S::GA) { if (has_next) {
#pragma unroll
            for (int j = 0; j < 4; ++j) nofA[j] = sch.goffA(nxt, (j >> 1) * 128 + R0 + (j & 1) * 64, C0); } }
        if constexpr (S::GB) { if (has_next) {
#pragma unroll
            for (int j = 0; j < 4; ++j) nofB[j] = sch.goffB(nxt, (j >> 1) * 128 + RB0 + (j & 1) * 64, C0); } }
#pragma unroll 1
        for (int t = 0; t < nt; t += 2) {
            const bool last = (t == nt - 2);
            const char* a1 = cA + (size_t)(t + 1) * kstep;
            const char* a2 = last ? nA : cA + (size_t)(t + 2) * kstep; const char* b2 = last ? nB : cB + (size_t)(t + 2) * kstep;
            const char* a3 = a2 + kstep; const char* b3 = b2 + kstep;
            asm volatile("" : "+s"(a1), "+s"(a2), "+s"(a3), "+s"(b2), "+s"(b3));
            const bool post = (t == 0 && ui > 0);
#define G_WAIT_POST() do { if (post) { if constexpr (E::NVM == 8) G_WAIT_V(16); else if constexpr (E::NVM == 16) G_WAIT_V(24); else if constexpr (E::NVM == 32) G_WAIT_V(40); else G_WAIT_V(8); } else G_WAIT_V(8); } while (0)
            G_LDB(B0, 0, 0); G_LDB(B1, 0, 1); G_SCHED; G_LDA(At, 0, 0); if (!post) G_STAGE_A(G_SA(1, 1), a1, 1, false);
            G_WAIT_POST(); G_WAIT_L(0); G_BAR; G_MMA(0, 0, At, B0); G_MMA(0, 1, At, B1); G_BAR; G_SCHED;
            G_LDA(At, 0, 1); G_STAGE_B(G_SB(0, 0), b2, 0, last); G_STAGE_B(G_SB(0, 1), b2, 1, last); G_STAGE_A(G_SA(0, 0), a2, 0, last);
            G_WAIT_POST(); G_WAIT_L(0); G_BAR; G_MMA(1, 0, At, B0); G_MMA(1, 1, At, B1); G_BAR; G_SCHED;
            G_LDB(B0, 1, 0); G_LDB(B1, 1, 1); G_SCHED; G_LDA(At, 1, 0); G_STAGE_A(G_SA(0, 1), a2, 1, last);
            G_WAIT_POST(); G_WAIT_L(0); G_BAR; G_MMA(0, 0, At, B0); G_MMA(0, 1, At, B1); G_BAR; G_SCHED;
            G_LDA(At, 1, 1); G_STAGE_B(G_SB(1, 0), b3, 0, last); G_STAGE_B(G_SB(1, 1), b3, 1, last); G_STAGE_A(G_SA(1, 0), a3, 0, last);
            G_WAIT_V(8); G_WAIT_L(0); G_BAR; G_MMA(1, 0, At, B0); G_MMA(1, 1, At, B1); G_BAR; G_SCHED;
#undef G_WAIT_POST
        }
        if (wr == 0) G_BAR;
        if (has_next) { const char* n1 = nA + kstep; asm volatile("" : "+s"(n1)); G_STAGE_A(G_SA(1, 1), n1, 1, true); }
        { int tz = threadIdx.x; asm volatile("" : "+v"(tz));
          const int ewid = tz >> 6, el = tz & 63; epi(acc, cur, ewid >> 2, ewid & 3, el & 15, el >> 4); }
        if (!has_next) break;
#pragma unroll
        for (int a = 0; a < 2; ++a)
#pragma unroll
            for (int b = 0; b < 2; ++b)
#pragma unroll
                for (int m = 0; m < 4; ++m)
#pragma unroll
                    for (int n = 0; n < 2; ++n) acc[a][b][m][n] = (f32x4){0.f, 0.f, 0.f, 0.f};
        cur = nxt; cA = nA; cB = nB; ++ui;
        if constexpr (S::GA) {
#pragma unroll
            for (int j = 0; j < 4; ++j) cofA[j] = nofA[j]; }
        if constexpr (S::GB) {
#pragma unroll
            for (int j = 0; j < 4; ++j) cofB[j] = nofB[j]; }
        if (wr == 1) G_BAR;
    }
    G_WAIT_V(0);
    G_BAR;
#undef G_SA
#undef G_SB
#undef G_GLDS
#undef G_STAGE_A
#undef G_STAGE_B
#undef G_LDA
#undef G_LDB
#undef G_MMA
#undef G_WAIT_V
#undef G_WAIT_L
#undef G_BAR
#undef G_SCHED
}
template <class S, class E>
__device__ __forceinline__ void gemm_fast8(LAS unsigned char* lds, const S& sch, const E& epi) {
    using namespace pg8;
    const int tid = threadIdx.x, wid = __builtin_amdgcn_readfirstlane(tid >> 6), lane = tid & 63, wr = wid >> 2, wc = wid & 3, fr = lane & 15, fq = lane >> 4;
    const int nt = sch.Kk / 128;
    const int R0 = tid >> 3, C0 = ((tid & 7) ^ (((R0 >> 1) & 1) | (((R0 >> 2) & 1) << 2))) * 8;
    unsigned voffA[2], voffB[2]; unsigned cofA[4], nofA[4], cofB[4], nofB[4];
    size_t hstepA = 0, hstepB = 0;
    if constexpr (!S::GA) { voffA[0] = (unsigned)(R0 * sch.lda + C0 * 2); voffA[1] = (unsigned)((R0 + 64) * sch.lda + C0 * 2); hstepA = (size_t)128 * sch.lda; }
    const int RB0 = S::PERM ? prow(R0) : R0;
    if constexpr (!S::GB) { voffB[0] = (unsigned)(RB0 * sch.ldb + C0 * 2); voffB[1] = (unsigned)((RB0 + 64) * sch.ldb + C0 * 2); hstepB = (size_t)128 * sch.ldb; }
    const size_t kstep = 128;
    const unsigned ldsw = (unsigned)wid * 1024u;
    const int fsw = ((fr >> 1) & 1) | (((fr >> 2) & 1) << 2);
    const int aoff = ((wr * 64 + fr) * 8 + ((2 * fq) ^ fsw)) * 16, aoff1 = ((wr * 64 + fr) * 8 + ((2 * fq + 1) ^ fsw)) * 16, boff = ((wc * 32 + fr) * 8 + ((2 * fq) ^ fsw)) * 16, boff1 = ((wc * 32 + fr) * 8 + ((2 * fq + 1) ^ fsw)) * 16;
#define G_SA(b, h) (((b) * 2 + (h)) * HTB)
#define G_SB(b, h) ((4 + (b) * 2 + (h)) * HTB)
#define G_GLDS(src, dst) __builtin_amdgcn_global_load_lds((const unsigned*)(src), (LAS unsigned*)(dst), 16, 0, 0)
#define G_STAGE_A(bufoff, gp, h, nx) do { if constexpr (S::GA) { _Pragma("unroll") for (int _i = 0; _i < 2; ++_i) { const unsigned _o = (nx) ? nofA[2 * (h) + _i] : cofA[2 * (h) + _i]; G_GLDS((gp) + _o, lds + (bufoff) + ldsw + _i * 8192); } } \
        else { _Pragma("unroll") for (int _i = 0; _i < 2; ++_i) G_GLDS((gp) + (size_t)(h) * hstepA + voffA[_i], lds + (bufoff) + ldsw + _i * 8192); } } while (0)
#define G_STAGE_B(bufoff, gp, h, nx) do { if constexpr (S::GB) { _Pragma("unroll") for (int _i = 0; _i < 2; ++_i) { const unsigned _o = (nx) ? nofB[2 * (h) + _i] : cofB[2 * (h) + _i]; G_GLDS((gp) + _o, lds + (bufoff) + ldsw + _i * 8192); } } \
        else { _Pragma("unroll") for (int _i = 0; _i < 2; ++_i) G_GLDS((gp) + (size_t)(h) * hstepB + voffB[_i], lds + (bufoff) + ldsw + _i * 8192); } } while (0)
#define G_LDA(dst, b, h) do { _Pragma("unroll") for (int m = 0; m < 4; ++m) { const u32x4 _lo = *(const LAS u32x4*)(lds + G_SA(b, h) + aoff + m * 2048), _hi = *(const LAS u32x4*)(lds + G_SA(b, h) + aoff1 + m * 2048); dst[m] = (i32x8){(int)_lo.x, (int)_lo.y, (int)_lo.z, (int)_lo.w, (int)_hi.x, (int)_hi.y, (int)_hi.z, (int)_hi.w}; } } while (0)
#define G_LDB(dst, b, h) do { _Pragma("unroll") for (int n = 0; n < 2; ++n) { const u32x4 _lo = *(const LAS u32x4*)(lds + G_SB(b, h) + boff + n * 2048), _hi = *(const LAS u32x4*)(lds + G_SB(b, h) + boff1 + n * 2048); dst[n] = (i32x8){(int)_lo.x, (int)_lo.y, (int)_lo.z, (int)_lo.w, (int)_hi.x, (int)_hi.y, (int)_hi.z, (int)_hi.w}; } } while (0)
#define G_MMA(ai, bj, At, Bt) do { __builtin_amdgcn_s_setprio(1); _Pragma("unroll") for (int m = 0; m < 4; ++m) _Pragma("unroll") for (int n = 0; n < 2; ++n) \
        acc[ai][bj][m][n] = __builtin_amdgcn_mfma_scale_f32_16x16x128_f8f6f4(Bt[n], At[m], acc[ai][bj][m][n], 0, 0, 0, 0, 0, 0); __builtin_amdgcn_s_setprio(0); } while (0)
#define G_WAIT_V(n) asm volatile("s_waitcnt vmcnt(" #n ")" ::: "memory")
#define G_WAIT_L(n) asm volatile("s_waitcnt lgkmcnt(" #n ")" ::: "memory")
#define G_BAR __builtin_amdgcn_s_barrier()
#define G_SCHED __builtin_amdgcn_sched_barrier(0)
    typename S::U cur, nxt; int ui = 0;
    if (!sch.next(0, cur)) return;
    f32x4 acc[2][2][4][2];
#pragma unroll
    for (int a = 0; a < 2; ++a)
#pragma unroll
        for (int b = 0; b < 2; ++b)
#pragma unroll
            for (int m = 0; m < 4; ++m)
#pragma unroll
                for (int n = 0; n < 2; ++n) acc[a][b][m][n] = (f32x4){0.f, 0.f, 0.f, 0.f};
    i32x8 At[4], B0[2], B1[2];
    const char* cA = sch.baseA(cur); const char* cB = sch.baseB(cur);
    if constexpr (S::GA) {
#pragma unroll
        for (int j = 0; j < 4; ++j) { cofA[j] = sch.goffA(cur, (j >> 1) * 128 + R0 + (j & 1) * 64, C0); nofA[j] = cofA[j]; } }
    if constexpr (S::GB) {
#pragma unroll
        for (int j = 0; j < 4; ++j) { cofB[j] = sch.goffB(cur, (j >> 1) * 128 + RB0 + (j & 1) * 64, C0); nofB[j] = cofB[j]; } }
    G_STAGE_B(G_SB(0, 0), cB, 0, false); G_STAGE_B(G_SB(0, 1), cB, 1, false); G_STAGE_A(G_SA(0, 0), cA, 0, false); G_STAGE_A(G_SA(0, 1), cA, 1, false);
    if (wr == 1) G_BAR;
    G_WAIT_V(2); G_BAR;
    G_STAGE_B(G_SB(1, 0), cB + kstep, 0, false); G_STAGE_A(G_SA(1, 0), cA + kstep, 0, false); G_STAGE_B(G_SB(1, 1), cB + kstep, 1, false);
    G_WAIT_V(6); G_BAR;
    for (;;) {
        const bool has_next = sch.next(ui + 1, nxt);
        const char* nA = has_next ? sch.baseA(nxt) : cA; const char* nB = has_next ? sch.baseB(nxt) : cB;
        if constexpr (S::GA) { if (has_next) {
#pragma unroll
            for (int j = 0; j < 4; ++j) nofA[j] = sch.goffA(nxt, (j >> 1) * 128 + R0 + (j & 1) * 64, C0); } }
        if constexpr (S::GB) { if (has_next) {
#pragma unroll
            for (int j = 0; j < 4; ++j) nofB[j] = sch.goffB(nxt, (j >> 1) * 128 + RB0 + (j & 1) * 64, C0); } }
#pragma unroll 1
        for (int t = 0; t < nt; t += 2) {
            const bool last = (t == nt - 2);
            const char* a1 = cA + (size_t)(t + 1) * kstep;
            const char* a2 = last ? nA : cA + (size_t)(t + 2) * kstep; const char* b2 = last ? nB : cB + (size_t)(t + 2) * kstep;
            const char* a3 = a2 + kstep; const char* b3 = b2 + kstep;
            asm volatile("" : "+s"(a1), "+s"(a2), "+s"(a3), "+s"(b2), "+s"(b3));
            const bool post = (t == 0 && ui > 0);
#define G_WAIT_POST() do { if (post) { if constexpr (E::NVM == 8) G_WAIT_V(16); else if constexpr (E::NVM == 16) G_WAIT_V(24); else if constexpr (E::NVM == 32) G_WAIT_V(40); else G_WAIT_V(8); } else G_WAIT_V(8); } while (0)
            G_LDB(B0, 0, 0); G_LDB(B1, 0, 1); G_SCHED; G_LDA(At, 0, 0); if (!post) G_STAGE_A(G_SA(1, 1), a1, 1, false);
            G_WAIT_POST(); G_WAIT_L(0); G_BAR; G_MMA(0, 0, At, B0); G_MMA(0, 1, At, B1); G_BAR; G_SCHED;
            G_LDA(At, 0, 1); G_STAGE_B(G_SB(0, 0), b2, 0, last); G_STAGE_B(G_SB(0, 1), b2, 1, last); G_STAGE_A(G_SA(0, 0), a2, 0, last);
            G_WAIT_POST(); G_WAIT_L(0); G_BAR; G_MMA(1, 0, At, B0); G_MMA(1, 1, At, B1); G_BAR; G_SCHED;
            G_LDB(B0, 1, 0); G_LDB(B1, 1, 1); G_SCHED; G_LDA(At, 1, 0); G_STAGE_A(G_SA(0, 1), a2, 1, last);
            G_WAIT_POST(); G_WAIT_L(0); G_BAR; G_MMA(0, 0, At, B0); G_MMA(0, 1, At, B1); G_BAR; G_SCHED;
            G_LDA(At, 1, 1); G_STAGE_B(G_SB(1, 0), b3, 0, last); G_STAGE_B(G_SB(1, 1), b3, 1, last); G_STAGE_A(G_SA(1, 0), a3, 0, last);
            G_WAIT_V(8); G_WAIT_L(0); G_BAR; G_MMA(1, 0, At, B0); G_MMA(1, 1, At, B1); G_BAR; G_SCHED;
#undef G_WAIT_POST
        }
        if (wr == 0) G_BAR;
        if (has_next) { const char* n1 = nA + kstep; asm volatile("" : "+s"(n1)); G_STAGE_A(G_SA(1, 1), n1, 1, true); }
        { int tz = threadIdx.x; asm volatile("" : "+v"(tz));
          const int ewid = tz >> 6, el = tz & 63; epi(acc, cur, ewid >> 2, ewid & 3, el & 15, el >> 4); }
        if (!has_next) break;
#pragma unroll
        for (int a = 0; a < 2; ++a)
#pragma unroll
            for (int b = 0; b < 2; ++b)
#pragma unroll
                for (int m = 0; m < 4; ++m)
#pragma unroll
                    for (int n = 0; n < 2; ++n) acc[a][b][m][n] = (f32x4){0.f, 0.f, 0.f, 0.f};
        cur = nxt; cA = nA; cB = nB; ++ui;
        if constexpr (S::GA) {
#pragma unroll
            for (int j = 0; j < 4; ++j) cofA[j] = nofA[j]; }
        if constexpr (S::GB) {
#pragma unroll
            for (int j = 0; j < 4; ++j) cofB[j] = nofB[j]; }
        if (wr == 1) G_BAR;
    }
    G_WAIT_V(0);
    G_BAR;
#undef G_SA
#undef G_SB
#undef G_GLDS
#undef G_STAGE_A
#undef G_STAGE_B
#undef G_LDA
#undef G_LDB
#undef G_MMA
#undef G_WAIT_V
#undef G_WAIT_L
#undef G_BAR
#undef G_SCHED
}
#ifndef MK_FAST
#define MK_FAST 1
#endif
#if MK_FAST
#define GEMM_PHASE(lds, S, E) gemm_fast(lds, S, E)
#else
#define GEMM_PHASE(lds, S, E) gemm_simple(lds, S, E)
#endif


template <int ES, int NBJ, class PF>
__device__ __forceinline__ void epi_coalesced(LAS unsigned char* el, const PF& pf, unsigned char* gbase, size_t pitch, int wr, int wc, int fr, int fq) {
    constexpr int RB = 128 * NBJ * ES, SL = RB / 16, MS = (16384 / (RB * 32)) > 4 ? 4 : (16384 / (RB * 32)), RP = 32 * MS, RI = 64 / SL, SM = SL < 16 ? SL - 1 : 15;
    const int wave = wr * 4 + wc, lane = fq * 16 + fr;
#pragma unroll
    for (int ai = 0; ai < 2; ++ai)
#pragma unroll
        for (int mp = 0; mp < 4 / MS; ++mp) {
#pragma unroll
            for (int mm = 0; mm < MS; ++mm) { const int m = mp * MS + mm, lr = wr * (16 * MS) + mm * 16 + fr;
#pragma unroll
                for (int bj = 0; bj < NBJ; ++bj) { const int cb = (bj * 128 + wc * 32 + 8 * fq) * ES; LAS unsigned char* p = el + lr * RB + ((((cb >> 4) ^ (lr & SM))) << 4) + (cb & 15);
                    if constexpr (ES == 1) *(LAS u32x2*)p = pf.p8(ai, m, bj); else *(LAS u32x4*)p = pf.p16(ai, m, bj); } }
            LDS_WAIT(); __builtin_amdgcn_s_barrier(); asm volatile("" ::: "memory"); __builtin_amdgcn_sched_barrier(0);
#pragma unroll
            for (int j = 0; j < 2; ++j) { const int lrr = wave * (RP / 8) + j * RI + lane / SL, c = lane % SL;
                const u32x4 v = *(const LAS u32x4*)(el + lrr * RB + ((c ^ (lrr & SM)) << 4));
                const int grow = ai * 128 + (lrr / (16 * MS)) * 64 + (mp * MS + ((lrr >> 4) % MS)) * 16 + (lrr & 15);
                *(u32x4*)(gbase + (size_t)grow * pitch + c * 16) = v; }
            LDS_WAIT(); __builtin_amdgcn_s_barrier(); asm volatile("" ::: "memory"); __builtin_amdgcn_sched_barrier(0);
        }
}
#define ROWLOOP _Pragma("unroll") for (int ai = 0; ai < 2; ++ai) _Pragma("unroll") for (int m = 0; m < 4; ++m)
#define UROW (ai * 128 + wr * 64 + m * 16 + fr)
#define UCOL(bj, n) ((bj) * 128 + wc * 32 + (n) * 16 + 4 * fq)
#define UCOLP(bj) ((bj) * 128 + wc * 32 + 8 * fq)
__device__ __forceinline__ u32x4 pk8(const f32x4 a, const f32x4 b) { u32x4 w; w.x = pk2(a.x, a.y); w.y = pk2(a.z, a.w); w.z = pk2(b.x, b.y); w.w = pk2(b.z, b.w); return w; }
typedef f32x4 AccT[2][2][4][2];

struct UnitD { int pm, pn; };
template <bool PERM_> struct SchedDenseT {
    typedef UnitD U;
    static constexpr bool GA = false, GB = false, PERM = PERM_;
    const bf16* A; const bf16* Bt; int lda, ldb, Kk, nM, nN, vcu;
    __device__ __forceinline__ const char* baseA(const U& u) const { return (const char*)(A + (size_t)u.pm * 256 * lda); }
    __device__ __forceinline__ const char* baseB(const U& u) const { return (const char*)(Bt + (size_t)u.pn * 256 * ldb); }
    __device__ __forceinline__ bool next(int i, U& u) const { const int L = i * NWG + vcu; if (L >= nM * nN) return false; u.pm = L / nN; u.pn = L % nN; return true; }
    __device__ __forceinline__ int K(const U&) const { return Kk; }
    __device__ __forceinline__ const char* rowA(const U& u, int r) const { return (const char*)(A + (size_t)(u.pm * 256 + r) * lda); }
    __device__ __forceinline__ const char* rowB(const U& u, int r) const { return (const char*)(Bt + (size_t)(u.pn * 256 + r) * ldb); }
};
typedef SchedDenseT<false> SchedDense; typedef SchedDenseT<true> SchedDenseP;
struct SchedDense8 {
    typedef UnitD U;
    static constexpr bool GA = false, GB = false, PERM = true;
    const unsigned char* A; const unsigned char* Bt; int lda, ldb, Kk, nM, nN, vcu;
    __device__ __forceinline__ const char* baseA(const U& u) const { return (const char*)(A + (size_t)u.pm * 256 * lda); }
    __device__ __forceinline__ const char* baseB(const U& u) const { return (const char*)(Bt + (size_t)u.pn * 256 * ldb); }
    __device__ __forceinline__ bool next(int i, U& u) const { const int L = i * NWG + vcu; if (L >= nM * nN) return false; u.pm = L / nN; u.pn = L % nN; return true; }
};
struct EpiXZ {
    static constexpr int NVM = 16;
    bf16* XR; bf16* GG;
    __device__ __forceinline__ void operator()(const AccT& acc, const UnitD& u, int wr, int wc, int fr, int fq) const {
        const bool isg = u.pn >= 4; bf16* base = isg ? GG : XR; const int c0 = (u.pn & 3) * 256;
        ROWLOOP { bf16* rp = base + (size_t)(u.pm * 256 + UROW) * D + c0;
#pragma unroll
            for (int bj = 0; bj < 2; ++bj) { f32x4 v0 = acc[ai][bj][m][0] * 0.015625f, v1 = acc[ai][bj][m][1] * 0.015625f;
                if (isg) {
#pragma unroll
                    for (int j = 0; j < 4; ++j) { v0[j] = gelu_tanh(v0[j]); v1[j] = gelu_tanh(v1[j]); } }
                *(u32x4*)(rp + UCOLP(bj)) = pk8(v0, v1); } }
    }
};
struct EpiResF32 {
    static constexpr int NVM = 0;
    const float* R; float* O; int ldc;
    __device__ __forceinline__ void operator()(const AccT& acc, const UnitD& u, int wr, int wc, int fr, int fq) const {
        const size_t base = (size_t)(u.pm * 256 + wr * 64 + fr) * ldc + u.pn * 256;
        f32x4 cur[4], nxt[4];
#pragma unroll
        for (int q = 0; q < 4; ++q) cur[q] = *(const f32x4*)(R + base + UCOL(q >> 1, q & 1));
#pragma unroll
        for (int g = 0; g < 8; ++g) { const int ai = g >> 2, m = g & 3; const size_t ro = base + (size_t)(ai * 128 + m * 16) * ldc;
            if (g < 7) { const size_t rn = base + (size_t)(((g + 1) >> 2) * 128 + ((g + 1) & 3) * 16) * ldc;
#pragma unroll
                for (int q = 0; q < 4; ++q) nxt[q] = *(const f32x4*)(R + rn + UCOL(q >> 1, q & 1)); }
#pragma unroll
            for (int q = 0; q < 4; ++q) *(f32x4*)(O + ro + UCOL(q >> 1, q & 1)) = cur[q] * ALPHA + acc[ai][q >> 1][m][q & 1];
#pragma unroll
            for (int q = 0; q < 4; ++q) cur[q] = nxt[q]; }
    }
};
struct EpiF32 {
    static constexpr int NVM = 32;
    float* O; int ldc;
    __device__ __forceinline__ void operator()(const AccT& acc, const UnitD& u, int wr, int wc, int fr, int fq) const {
        ROWLOOP { const size_t ro = (size_t)(u.pm * 256 + UROW) * ldc + u.pn * 256;
#pragma unroll
            for (int bj = 0; bj < 2; ++bj)
#pragma unroll
                for (int n = 0; n < 2; ++n) *(f32x4*)(O + ro + UCOL(bj, n)) = acc[ai][bj][m][n]; }
    }
};

struct UnitG { int pm, blk, pn; };
struct SchedGate {
    typedef UnitG U;
    static constexpr bool GA = false, GB = false, PERM = true; static constexpr int Kk = 256, lda = D, ldb = 256;
    const bf16* XC; const bf16* WgT; int vcu;
    __device__ __forceinline__ const char* baseA(const U& u) const { return (const char*)(XC + (size_t)u.pm * 256 * D + u.blk * 256); }
    __device__ __forceinline__ const char* baseB(const U& u) const { return (const char*)(WgT + (size_t)(u.blk * 512 + u.pn * 256) * 256); }
    __device__ __forceinline__ bool next(int i, U& u) const { const int L = i * NWG + vcu; if (L >= 128 * 8) return false; u.pm = L >> 3; u.blk = (L >> 1) & 3; u.pn = L & 1; return true; }
    __device__ __forceinline__ int K(const U&) const { return 256; }
    __device__ __forceinline__ const char* rowA(const U& u, int r) const { return (const char*)(XC + (size_t)(u.pm * 256 + r) * D + u.blk * 256); }
    __device__ __forceinline__ const char* rowB(const U& u, int r) const { return (const char*)(WgT + (size_t)(u.blk * 512 + u.pn * 256 + r) * 256); }
};
struct EpiGate {
    static constexpr int NVM = 0;
    const bf16* XC; const float *ba, *bx, *lam; bf16* LA; bf16* UU;
    __device__ __forceinline__ void operator()(const AccT& acc, const UnitG& u, int wr, int wc, int fr, int fq) const {
        const int c0 = u.blk * 256 + u.pn * 128 + wc * 32 + 8 * fq;
        f32x4 vba[2], vbx[2], sp[2];
#pragma unroll
        for (int n = 0; n < 2; ++n) { vba[n] = *(const f32x4*)(ba + c0 + 4 * n); vbx[n] = *(const f32x4*)(bx + c0 + 4 * n); const f32x4 vl = *(const f32x4*)(lam + c0 + 4 * n);
#pragma unroll
            for (int j = 0; j < 4; ++j) { const float x = __expf(-vl[j]); sp[n][j] = 8.0f * x * (1.0f - x * (0.5f - x * (1.0f / 3.0f))); } }
        const size_t base = (size_t)(u.pm * 256 + wr * 64 + fr) * D + c0;
        u32x4 xw = *(const u32x4*)(XC + base);
#pragma unroll
        for (int g = 0; g < 8; ++g) { const int ai = g >> 2, m = g & 3; const size_t ro = base + (size_t)(ai * 128 + m * 16) * D;
            u32x4 xn = xw; if (g < 7) xn = *(const u32x4*)(XC + base + (size_t)(((g + 1) >> 2) * 128 + ((g + 1) & 3) * 16) * D);
            const float xc[8] = {bf_lo(xw.x), bf_hi(xw.x), bf_lo(xw.y), bf_hi(xw.y), bf_lo(xw.z), bf_hi(xw.z), bf_lo(xw.w), bf_hi(xw.w)};
            f32x4 la[2], uu[2];
#pragma unroll
            for (int n = 0; n < 2; ++n) { const f32x4 ga = acc[ai][0][m][n] + vba[n], gx = acc[ai][1][m][n] + vbx[n];
#pragma unroll
                for (int j = 0; j < 4; ++j) { const float r = sigmoidf_(ga[j]), ig = sigmoidf_(gx[j]); const float l = -r * sp[n][j]; la[n][j] = l;
                    const float mult = sqrtf(fmaxf(1.0f - __expf(2.0f * l), 0.f)); uu[n][j] = mult * ig * xc[4 * n + j]; } }
            *(u32x4*)(LA + ro) = pk8(la[0], la[1]); *(u32x4*)(UU + ro) = pk8(uu[0], uu[1]); xw = xn; }
    }
};

struct UnitE { int rb, pn, e, ti; };
struct SchedG1 {
    typedef UnitE U;
    static constexpr bool GA = true, GB = false, PERM = true; static constexpr int Kk = D, lda = D, ldb = D;
    const unsigned char* X; const unsigned char* W13T; const int* ROWA; const int* BLKE; int nrbt, vcu; int ev; const LAS unsigned* tab;
    __device__ __forceinline__ const char* baseA(const U&) const { return (const char*)X; }
    __device__ __forceinline__ const char* baseB(const U& u) const { return (const char*)(W13T + ((size_t)u.e * 512 + u.pn * 256) * D); }
    __device__ __forceinline__ unsigned goffA(const U& u, int r, int C) const { return tab[u.ti * 256 + r] + (unsigned)C * 2u; }
    __device__ __forceinline__ unsigned goffB(const U&, int, int) const { return 0u; }
    __device__ __forceinline__ bool next(int i, U& u) const { const int L = i * NWG + vcu; const int rb = L >> 1; if (rb >= nrbt) return false; u.rb = rb; u.pn = L & 1; u.ti = i; u.e = __builtin_amdgcn_readlane(ev, i); return true; }
    __device__ __forceinline__ int K(const U&) const { return D; }
};
struct PFSwiGLU { const AccT& acc;
    __device__ __forceinline__ u32x2 p8(int ai, int m, int) const { f32x4 h0, h1;
#pragma unroll
        for (int j = 0; j < 4; ++j) { const float a0 = acc[ai][0][m][0][j] * 0.015625f, a1 = acc[ai][0][m][1][j] * 0.015625f; h0[j] = a0 * sigmoidf_(a0) * (acc[ai][1][m][0][j] * 0.015625f); h1[j] = a1 * sigmoidf_(a1) * (acc[ai][1][m][1][j] * 0.015625f); }
        int t0 = __builtin_amdgcn_cvt_pk_fp8_f32(h0.x, h0.y, 0, false); t0 = __builtin_amdgcn_cvt_pk_fp8_f32(h0.z, h0.w, t0, true);
        int t1 = __builtin_amdgcn_cvt_pk_fp8_f32(h1.x, h1.y, 0, false); t1 = __builtin_amdgcn_cvt_pk_fp8_f32(h1.z, h1.w, t1, true); u32x2 w; w.x = (unsigned)t0; w.y = (unsigned)t1; return w; }
    __device__ __forceinline__ u32x4 p16(int, int, int) const { return (u32x4){0u, 0u, 0u, 0u}; } };
struct EpiSwiGLU {
    static constexpr int NVM = 0; static constexpr bool DEFER = false; static constexpr int soff(int) { return 0; }
    unsigned char* HID; LAS unsigned char* el;
    __device__ __forceinline__ void operator()(const AccT& acc, const UnitE& u, int wr, int wc, int fr, int fq) const {
        epi_coalesced<1, 1>(el, PFSwiGLU{acc}, HID + ((size_t)u.rb * 256) * DE + u.pn * 128, DE, wr, wc, fr, fq);
    }
};
struct SchedG2 {
    typedef UnitE U;
    static constexpr bool GA = false, GB = false, PERM = true;
    const unsigned char* HID; const unsigned char* W2T; const int* BLKE; int nrbt, vcu; int ev; int Kk, lda, ldb;
    __device__ __forceinline__ const char* baseA(const U& u) const { return (const char*)(HID + (size_t)u.rb * 256 * DE); }
    __device__ __forceinline__ const char* baseB(const U& u) const { return (const char*)(W2T + ((size_t)u.e * D + u.pn * 256) * DE); }
    __device__ __forceinline__ bool next(int i, U& u) const { const int L = i * NWG + vcu; const int rb = L >> 2; if (rb >= nrbt) return false; u.rb = rb; u.pn = L & 3; u.ti = i; u.e = __builtin_amdgcn_readlane(ev, i); return true; }
    __device__ __forceinline__ int K(const U&) const { return DE; }
};
struct PFScatter { const AccT& acc;
    __device__ __forceinline__ u32x2 p8(int ai, int m, int bj) const { const f32x4 v0 = acc[ai][bj][m][0] * 0.25f, v1 = acc[ai][bj][m][1] * 0.25f;
        int t0 = __builtin_amdgcn_cvt_pk_fp8_f32(v0.x, v0.y, 0, false); t0 = __builtin_amdgcn_cvt_pk_fp8_f32(v0.z, v0.w, t0, true);
        int t1 = __builtin_amdgcn_cvt_pk_fp8_f32(v1.x, v1.y, 0, false); t1 = __builtin_amdgcn_cvt_pk_fp8_f32(v1.z, v1.w, t1, true); u32x2 w; w.x = (unsigned)t0; w.y = (unsigned)t1; return w; }
    __device__ __forceinline__ u32x4 p16(int, int, int) const { return (u32x4){0u, 0u, 0u, 0u}; } };
struct EpiScatter {
    static constexpr int NVM = 8; static constexpr bool DEFER = false; static constexpr int soff(int) { return 0; }
    bf16* YA; int dry; LAS unsigned char* el;
    __device__ __forceinline__ void operator()(const AccT& acc, const UnitE& u, int wr, int wc, int fr, int fq) const {
        epi_coalesced<1, 2>(el, PFScatter{acc}, (unsigned char*)YA + ((size_t)u.rb * 256) * D + u.pn * 256, D, wr, wc, fr, fq);
    }
};

__device__ __forceinline__ int rho_to_tok(int rho, int g) { const int sh = 14 - 2 * g; const int rp = rho & 16383; return (rho & ~16383) + (rp >> sh) + ((rp & ((1 << sh) - 1)) << (2 * g)); }
__device__ __forceinline__ int tok_to_rho(int t, int g) { const int sh = 14 - 2 * g; const int tp = t & 16383; return (t & ~16383) + ((tp & ((1 << (2 * g)) - 1)) << sh) + (tp >> (2 * g)); }
struct UnitQ { int type, g, pm, pn; };
struct SchedQK {
    typedef UnitQ U;
    static constexpr bool GA = false, GB = false, PERM = true; static constexpr int Kk = D, ldb = D;
    const unsigned char* X; const unsigned char* WqkT; int g, lda, vcu;
    __device__ __forceinline__ bool next(int i, U& u) const { const int L = i * NWG + vcu; if (L >= 512) return false; u.type = 0; u.g = g; u.pm = L >> 2; u.pn = L & 3; return true; }
    __device__ __forceinline__ int K(const U&) const { return D; }
    __device__ __forceinline__ const char* baseA(const U& u) const { return (const char*)(X + (size_t)rho_to_tok(u.pm * 256, g) * D); }
    __device__ __forceinline__ const char* baseB(const U& u) const { return (const char*)(WqkT + ((size_t)g * 1024 + u.pn * 256) * D); }
    __device__ __forceinline__ const char* rowA(const U& u, int r) const { return (const char*)(X + (size_t)rho_to_tok(u.pm * 256 + r, g) * D); }
    __device__ __forceinline__ const char* rowB(const U& u, int r) const { return (const char*)(WqkT + ((size_t)g * 1024 + u.pn * 256 + r) * D); }
};
struct SchedVT {
    typedef UnitQ U;
    static constexpr bool GA = false, GB = false, PERM = true; static constexpr int Kk = D, lda = D;
    const unsigned char* X; const unsigned char* WvT; int g, ldb, vcu;
    __device__ __forceinline__ bool next(int i, U& u) const { const int L = i * NWG + vcu; if (L >= 256) return false; u.type = 1; u.g = g; u.pn = L >> 1; u.pm = L & 1; return true; }
    __device__ __forceinline__ int K(const U&) const { return D; }
    __device__ __forceinline__ const char* baseA(const U& u) const { return (const char*)(WvT + ((size_t)g * 512 + u.pm * 256) * D); }
    __device__ __forceinline__ const char* baseB(const U& u) const { return (const char*)(X + (size_t)rho_to_tok(u.pn * 256, g) * D); }
    __device__ __forceinline__ const char* rowA(const U& u, int r) const { return (const char*)(WvT + ((size_t)g * 512 + u.pm * 256 + r) * D); }
    __device__ __forceinline__ const char* rowB(const U& u, int r) const { return (const char*)(X + (size_t)rho_to_tok(u.pn * 256 + r, g) * D); }
};
struct PFScaled { const AccT& acc; float sc;
    __device__ __forceinline__ u32x2 p8(int, int, int) const { return (u32x2){0u, 0u}; }
    __device__ __forceinline__ u32x4 p16(int ai, int m, int bj) const { return pk8(acc[ai][bj][m][0] * sc, acc[ai][bj][m][1] * sc); } };
struct EpiQKV {
    static constexpr int NVM = 16; static constexpr bool DEFER = false; static constexpr int soff(int) { return 0; }
    bf16* QK; bf16* VT; LAS unsigned char* el;
    __device__ __forceinline__ void operator()(const AccT& acc, const UnitQ& u, int wr, int wc, int fr, int fq) const {
        bf16* base; size_t ldc;
        if (u.type == 0) { base = QK + (size_t)u.g * M * 1024; ldc = 1024; } else { base = VT + (size_t)u.g * 512 * M; ldc = M; }
        epi_coalesced<2, 2>(el, PFScaled{acc, 0.015625f}, (unsigned char*)(base + (size_t)(u.pm * 256) * ldc + u.pn * 256), ldc * 2, wr, wc, fr, fq);
    }
};

__device__ __forceinline__ void tr_item(const float* src, int spitch, bf16* dst, int dpitch, LAS float* scr, int lane) {
#pragma unroll 4
    for (int i = 0; i < 16; ++i) { const int k = 4 * i + (lane >> 4), n4 = (lane & 15) * 4; const f32x4 v = *(const f32x4*)(src + (size_t)k * spitch + n4);
        LAS float* s = scr + k * 65 + n4; s[0] = v.x; s[1] = v.y; s[2] = v.z; s[3] = v.w; }
    LDS_WAIT(); asm volatile("" ::: "memory");
    const int c = lane & 7;
#pragma unroll
    for (int j = 0; j < 8; ++j) { const int n = 8 * j + (lane >> 3); const LAS float* s = scr + (8 * c) * 65 + n;
        u32x4 o; o.x = pk2(s[0], s[65]); o.y = pk2(s[2 * 65], s[3 * 65]); o.z = pk2(s[4 * 65], s[5 * 65]); o.w = pk2(s[6 * 65], s[7 * 65]);
        *(u32x4*)(dst + (size_t)n * dpitch + 8 * c) = o; }
    LDS_WAIT(); asm volatile("" ::: "memory");
}
__device__ __forceinline__ void tr_item8(const float* src, int spitch, unsigned char* dst, int dpitch, LAS float* scr, int lane) {
#pragma unroll 4
    for (int i = 0; i < 16; ++i) { const int k = 4 * i + (lane >> 4), n4 = (lane & 15) * 4; const f32x4 v = *(const f32x4*)(src + (size_t)k * spitch + n4);
        LAS float* s = scr + k * 65 + n4; s[0] = v.x; s[1] = v.y; s[2] = v.z; s[3] = v.w; }
    LDS_WAIT(); asm volatile("" ::: "memory");
    const int c = lane & 7;
#pragma unroll
    for (int j = 0; j < 8; ++j) { const int n = 8 * j + (lane >> 3); const LAS float* s = scr + (8 * c) * 65 + n;
        int t0 = __builtin_amdgcn_cvt_pk_fp8_f32(s[0] * 64.f, s[65] * 64.f, 0, false); t0 = __builtin_amdgcn_cvt_pk_fp8_f32(s[2 * 65] * 64.f, s[3 * 65] * 64.f, t0, true);
        int t1 = __builtin_amdgcn_cvt_pk_fp8_f32(s[4 * 65] * 64.f, s[5 * 65] * 64.f, 0, false); t1 = __builtin_amdgcn_cvt_pk_fp8_f32(s[6 * 65] * 64.f, s[7 * 65] * 64.f, t1, true);
        u32x2 o; o.x = (unsigned)t0; o.y = (unsigned)t1; *(u32x2*)(dst + (size_t)n * dpitch + 8 * c) = o; }
    LDS_WAIT(); asm volatile("" ::: "memory");
}
template <class RowMap>
__device__ __forceinline__ void tr_matrix(Frame& F, const float* W, int K, int N, bf16* WT, int dpitch, RowMap drow) {
    LAS float* scr = (LAS float*)(F.lds + F.wave * 16640);
    const int nkb = K / 64, nnb = N / 64;
    for (int it = F.vcu * NWAVES + F.wave; it < nkb * nnb; it += NGW) { const int kb = it / nnb, nb = it % nnb;
        tr_item(W + (size_t)(kb * 64) * N + nb * 64, N, WT + (size_t)drow(nb * 64) * dpitch + kb * 64, dpitch, scr, F.lane); }
}
template <class RowMap>
__device__ __forceinline__ void tr_matrix8(Frame& F, const float* W, int K, int N, unsigned char* WT, int dpitch, RowMap drow) {
    LAS float* scr = (LAS float*)(F.lds + F.wave * 16640);
    const int nkb = K / 64, nnb = N / 64;
    for (int it = F.vcu * NWAVES + F.wave; it < nkb * nnb; it += NGW) { const int kb = it / nnb, nb = it % nnb;
        tr_item8(W + (size_t)(kb * 64) * N + nb * 64, N, WT + (size_t)drow(nb * 64) * dpitch + kb * 64, dpitch, scr, F.lane); }
}
__device__ __forceinline__ void cv_src(int it, const float* w1, const float* w3, const float* w2, const float* s1, const float* s3, const float* s2, const float*& src, int& spitch) {
    const int e = it / 192, r = it % 192, which = r >> 6, tile = r & 63;
    if (which < 2) { const float* W = (e < 256) ? (which == 0 ? w1 : w3) + (size_t)e * (size_t)(D * DE) : (which == 0 ? s1 : s3); src = W + (size_t)((tile >> 2) * 64) * DE + (tile & 3) * 64; spitch = DE; }
    else { const float* W = (e < 256) ? w2 + (size_t)e * (size_t)(DE * D) : s2; src = W + (size_t)((tile >> 4) * 64) * D + (tile & 15) * 64; spitch = D; }
}
__device__ __forceinline__ void convert_experts(Frame& F, const float* w1, const float* w3, const float* w2, const float* s1, const float* s3, const float* s2) {
    LAS float* scr = (LAS float*)(F.lds + F.wave * 16640);
    unsigned char* W13T = WSP(unsigned char, WS_W13); unsigned char* W2T = WSP(unsigned char, WS_W2);
    const int lane = F.lane; const int NIT = 257 * 192;
    f32x4 cur[16], nxt[16];
    int it = F.vcu * NWAVES + F.wave;
    if (it < NIT) { const float* src; int sp; cv_src(it, w1, w3, w2, s1, s3, s2, src, sp);
#pragma unroll
        for (int i = 0; i < 16; ++i) cur[i] = __builtin_nontemporal_load((const f32x4*)(src + (size_t)(4 * i + (lane >> 4)) * sp + (lane & 15) * 4)); }
#pragma unroll 1
    for (; it < NIT; it += NGW) {
        const int itn = it + NGW;
        if (itn < NIT) { const float* src; int sp; cv_src(itn, w1, w3, w2, s1, s3, s2, src, sp);
#pragma unroll
            for (int i = 0; i < 16; ++i) nxt[i] = __builtin_nontemporal_load((const f32x4*)(src + (size_t)(4 * i + (lane >> 4)) * sp + (lane & 15) * 4)); }
#pragma unroll
        for (int i = 0; i < 16; ++i) { const int k = 4 * i + (lane >> 4), n4 = (lane & 15) * 4; LAS float* s = scr + k * 65 + n4; s[0] = cur[i].x; s[1] = cur[i].y; s[2] = cur[i].z; s[3] = cur[i].w; }
        LDS_WAIT(); asm volatile("" ::: "memory");
        const int e = it / 192, r = it % 192, which = r >> 6, tile = r & 63, c = lane & 7;
        if (which < 2) { const int kb = tile >> 2, nb = tile & 3; const int drow = (nb >> 1) * 256 + which * 128 + (nb & 1) * 64; unsigned char* dst = W13T + ((size_t)e * 512 + drow) * D + kb * 64;
#pragma unroll
            for (int j = 0; j < 8; ++j) { const int n = 8 * j + (lane >> 3); const LAS float* s = scr + (8 * c) * 65 + n;
                int t0 = __builtin_amdgcn_cvt_pk_fp8_f32(s[0] * 64.f, s[65] * 64.f, 0, false); t0 = __builtin_amdgcn_cvt_pk_fp8_f32(s[2 * 65] * 64.f, s[3 * 65] * 64.f, t0, true);
                int t1 = __builtin_amdgcn_cvt_pk_fp8_f32(s[4 * 65] * 64.f, s[5 * 65] * 64.f, 0, false); t1 = __builtin_amdgcn_cvt_pk_fp8_f32(s[6 * 65] * 64.f, s[7 * 65] * 64.f, t1, true);
                u32x2 o; o.x = (unsigned)t0; o.y = (unsigned)t1; *(u32x2*)(dst + (size_t)n * D + 8 * c) = o; } }
        else { const int kb = tile >> 4, nb = tile & 15; unsigned char* dst = W2T + ((size_t)e * D + nb * 64) * DE + kb * 64;
#pragma unroll
            for (int j = 0; j < 8; ++j) { const int n = 8 * j + (lane >> 3); const LAS float* s = scr + (8 * c) * 65 + n;
                int t0 = __builtin_amdgcn_cvt_pk_fp8_f32(s[0] * 64.f, s[65] * 64.f, 0, false); t0 = __builtin_amdgcn_cvt_pk_fp8_f32(s[2 * 65] * 64.f, s[3 * 65] * 64.f, t0, true);
                int t1 = __builtin_amdgcn_cvt_pk_fp8_f32(s[4 * 65] * 64.f, s[5 * 65] * 64.f, 0, false); t1 = __builtin_amdgcn_cvt_pk_fp8_f32(s[6 * 65] * 64.f, s[7 * 65] * 64.f, t1, true);
                u32x2 o; o.x = (unsigned)t0; o.y = (unsigned)t1; *(u32x2*)(dst + (size_t)n * DE + 8 * c) = o; } }
        LDS_WAIT(); asm volatile("" ::: "memory");
#pragma unroll
        for (int i = 0; i < 16; ++i) cur[i] = nxt[i];
    }
}
struct MapId { __device__ int operator()(int n0) const { return n0; } };
struct MapGate { int which; __device__ int operator()(int n0) const { return (n0 >> 7) * 256 + which * 128 + (n0 & 127); } };
struct MapQ { __device__ int operator()(int n0) const { return (n0 >> 9) * 1024 + (n0 & 511); } };
struct MapKV { __device__ int operator()(int n0) const { return n0 < 1536 ? (n0 >> 9) * 1024 + 512 + (n0 & 511) : 3072 + (n0 - 1536); } };

__device__ __forceinline__ void p0_prologue(Frame& F, const Args& A) {
    { const float* x = A.in[0]; unsigned char* XQ = WSP(unsigned char, WS_RA + RA_XB);
      for (size_t i = (size_t)F.vcu * NTHR + F.tid; i < (size_t)M * D / 8; i += NGT) { const f32x4 a = *(const f32x4*)(x + i * 8), b = *(const f32x4*)(x + i * 8 + 4);
          int t0 = __builtin_amdgcn_cvt_pk_fp8_f32(a.x, a.y, 0, false); t0 = __builtin_amdgcn_cvt_pk_fp8_f32(a.z, a.w, t0, true);
          int t1 = __builtin_amdgcn_cvt_pk_fp8_f32(b.x, b.y, 0, false); t1 = __builtin_amdgcn_cvt_pk_fp8_f32(b.z, b.w, t1, true);
          u32x2 o; o.x = (unsigned)t0; o.y = (unsigned)t1; *(u32x2*)(XQ + i * 8) = o; } }
    tr_matrix8(F, A.in[1], D, 2048, WSP(unsigned char, WS_WIN), D, MapId());
    for (int b = 0; b < 4; ++b) { tr_matrix(F, A.in[4] + b * 65536, 256, 256, WSP(bf16, WS_WG) + (size_t)b * 512 * 256, 256, MapGate{0});
                                  tr_matrix(F, A.in[6] + b * 65536, 256, 256, WSP(bf16, WS_WG) + (size_t)b * 512 * 256, 256, MapGate{1}); }
    tr_matrix(F, A.in[9], D, D, WSP(bf16, WS_WOUT), D, MapId());
    tr_matrix8(F, A.in[11], D, QW, WSP(unsigned char, WS_WQK), D, MapQ());
    tr_matrix8(F, A.in[10], D, 2 * QW, WSP(unsigned char, WS_WQK), D, MapKV());
    tr_matrix(F, A.in[12], OW, D, WSP(bf16, WS_WO), OW, MapId());
    for (int l = 0; l < 2; ++l) tr_matrix(F, A.in[13] + (size_t)l * D * NE, D, NE, WSP(bf16, WS_WR) + (size_t)l * NE * D, D, MapId());
    convert_experts(F, A.in[15], A.in[16], A.in[17], A.in[18], A.in[19], A.in[20]);
}
static_assert(WS_WV == WS_WQK + (size_t)3072 * 1024 * 2, "WvT must follow WqkT");

__device__ __forceinline__ void ln_store(f32x4 (&v)[4], const float* g, const float* b, float* of, bf16* ob, int lane, unsigned char* oq = nullptr) {
    float s = 0.f;
#pragma unroll
    for (int j = 0; j < 4; ++j) s += (v[j].x + v[j].y) + (v[j].z + v[j].w);
    const float mean = wave_sum(s) * (1.f / D); float s2 = 0.f;
#pragma unroll
    for (int j = 0; j < 4; ++j) { v[j] = v[j] - mean; s2 += (v[j].x * v[j].x + v[j].y * v[j].y) + (v[j].z * v[j].z + v[j].w * v[j].w); }
    const float rstd = 1.f / sqrtf(wave_sum(s2) * (1.f / D) + LN_EPS);
#pragma unroll
    for (int j = 0; j < 4; ++j) { const int c = 4 * lane + 256 * j; const f32x4 gg = *(const f32x4*)(g + c), bb = *(const f32x4*)(b + c); const f32x4 y = v[j] * rstd * gg + bb;
        if (of) *(f32x4*)(of + c) = y;
        if (ob) { u32x2 w; w.x = pk2(y.x, y.y); w.y = pk2(y.z, y.w); *(u32x2*)(ob + c) = w; }
        if (oq) { int t = __builtin_amdgcn_cvt_pk_fp8_f32(y.x, y.y, 0, false); t = __builtin_amdgcn_cvt_pk_fp8_f32(y.z, y.w, t, true); *(unsigned*)(oq + c) = (unsigned)t; } }
}

__device__ __forceinline__ int moe_unit_experts(Frame& F, const int* BLKE, int nrbt, int shift) { const int L = F.lane * NWG + F.vcu; const int rb = L >> shift; return rb < nrbt ? BLKE[rb] : 0; }
__device__ __forceinline__ const LAS unsigned* moe_row_table(Frame& F, const int* ROWA, int nrbt) {
    LAS unsigned* tab = (LAS unsigned*)(F.lds + LDS_TAB);
    if (F.tid < 256) { int a[15];
#pragma unroll
        for (int i = 0; i < 15; ++i) { const int rb = (i * NWG + F.vcu) >> 1; a[i] = rb < nrbt ? ROWA[rb * 256 + F.tid] : -1; }
#pragma unroll
        for (int i = 0; i < 15; ++i) { const int tok = a[i] < 0 ? 0 : (a[i] < 8 * M ? (a[i] >> 3) : a[i] - 8 * M); tab[i * 256 + F.tid] = (unsigned)tok * (unsigned)D; } }
    __syncthreads();
    return tab;
}
__device__ __forceinline__ void p_conv(Frame& F, const float* cw, const float* cb) {
    const bf16* XR = WSP(bf16, WS_RA + RA_XR); bf16* XC = WSP(bf16, WS_RA + RA_XC);
    for (int i = F.vcu * NTHR + F.tid; i < M * (D / 8); i += NGT) { const int t = i >> 7, c = (i & 127) * 8; const int ts = t & (SEQ - 1);
        float a[8];
#pragma unroll
        for (int q = 0; q < 8; ++q) a[q] = cb[c + q];
#pragma unroll
        for (int j = 0; j < 4; ++j) { if (ts - 3 + j >= 0) { const u32x4 w = *(const u32x4*)(XR + (size_t)(t - 3 + j) * D + c); const float* wj = cw + j * D + c;
            a[0] += wj[0] * bf_lo(w.x); a[1] += wj[1] * bf_hi(w.x); a[2] += wj[2] * bf_lo(w.y); a[3] += wj[3] * bf_hi(w.y);
            a[4] += wj[4] * bf_lo(w.z); a[5] += wj[5] * bf_hi(w.z); a[6] += wj[6] * bf_lo(w.w); a[7] += wj[7] * bf_hi(w.w); } }
        u32x4 o; o.x = pk2(a[0], a[1]); o.y = pk2(a[2], a[3]); o.z = pk2(a[4], a[5]); o.w = pk2(a[6], a[7]); *(u32x4*)(XC + (size_t)t * D + c) = o; }
}
constexpr int CH = 64, NCH = SEQ / CH;
__device__ __forceinline__ void p_scan1(Frame& F) {
    const bf16* LA = WSP(bf16, WS_RA + RA_LA); const bf16* UU = WSP(bf16, WS_RA + RA_U); float* CP = WSP(float, WS_CHP); float* CHh = WSP(float, WS_CHH);
    for (int i = F.vcu * NTHR + F.tid; i < BATCH * NCH * (D / 4); i += NGT) { const int c4 = (i & 255) * 4, ck = (i >> 8) & (NCH - 1), b = i >> 16;
        const size_t r0 = ((size_t)b * SEQ + (size_t)ck * CH) * D + c4; f32x4 h = {0.f, 0.f, 0.f, 0.f}, sl = {0.f, 0.f, 0.f, 0.f};
#pragma unroll 8
        for (int t = 0; t < CH; ++t) { const u32x2 lw = *(const u32x2*)(LA + r0 + (size_t)t * D), uw = *(const u32x2*)(UU + r0 + (size_t)t * D);
            const f32x4 la = {bf_lo(lw.x), bf_hi(lw.x), bf_lo(lw.y), bf_hi(lw.y)}, u = {bf_lo(uw.x), bf_hi(uw.x), bf_lo(uw.y), bf_hi(uw.y)};
#pragma unroll
            for (int j = 0; j < 4; ++j) { h[j] = __expf(la[j]) * h[j] + u[j]; sl[j] += la[j]; } }
#pragma unroll
        for (int j = 0; j < 4; ++j) { const size_t o = ((size_t)b * D + c4 + j) * NCH + ck; CP[o] = __expf(sl[j]); CHh[o] = h[j]; } }
}
__device__ __forceinline__ void p_scan2(Frame& F) {
    const float* CP = WSP(float, WS_CHP); const float* CHh = WSP(float, WS_CHH); float* CIN = WSP(float, WS_CIN);
    for (int s = F.vcu * NWAVES + F.wave; s < BATCH * D; s += NGW) { const size_t o = (size_t)s * NCH + 4 * F.lane;
        const f32x4 p4 = *(const f32x4*)(CP + o), h4 = *(const f32x4*)(CHh + o);
        float p = p4.x, h = h4.x; h = p4.y * h + h4.y; p *= p4.y; h = p4.z * h + h4.z; p *= p4.z; h = p4.w * h + h4.w; p *= p4.w;
#pragma unroll
        for (int off = 1; off < 64; off <<= 1) { const float pp = __shfl_up(p, off), hp = __shfl_up(h, off); if (F.lane >= off) { h = p * hp + h; p = pp * p; } }
        float c0 = __shfl_up(h, 1); if (F.lane == 0) c0 = 0.f;
        f32x4 ci; ci.x = c0; ci.y = p4.x * ci.x + h4.x; ci.z = p4.y * ci.y + h4.y; ci.w = p4.z * ci.z + h4.z;
        *(f32x4*)(CIN + o) = ci; }
}
__device__ __forceinline__ void p_scan3(Frame& F) {
    const bf16* LA = WSP(bf16, WS_RA + RA_LA); const bf16* UU = WSP(bf16, WS_RA + RA_U); const float* CIN = WSP(float, WS_CIN);
    const bf16* GG = WSP(bf16, WS_RA + RA_GG); bf16* YB = WSP(bf16, WS_RA + RA_YB);
    for (int i = F.vcu * NTHR + F.tid; i < BATCH * NCH * (D / 4); i += NGT) { const int c4 = (i & 255) * 4, ck = (i >> 8) & (NCH - 1), b = i >> 16;
        const size_t r0 = ((size_t)b * SEQ + (size_t)ck * CH) * D + c4; f32x4 h;
#pragma unroll
        for (int j = 0; j < 4; ++j) h[j] = CIN[((size_t)b * D + c4 + j) * NCH + ck];
#pragma unroll 1
        for (int t0 = 0; t0 < CH; t0 += 8) { u32x2 lw[8], uw[8], gw[8];
#pragma unroll
            for (int k = 0; k < 8; ++k) { const size_t o = r0 + (size_t)(t0 + k) * D; lw[k] = *(const u32x2*)(LA + o); uw[k] = *(const u32x2*)(UU + o); gw[k] = *(const u32x2*)(GG + o); }
#pragma unroll
            for (int k = 0; k < 8; ++k) { const f32x4 la = {bf_lo(lw[k].x), bf_hi(lw[k].x), bf_lo(lw[k].y), bf_hi(lw[k].y)}, u = {bf_lo(uw[k].x), bf_hi(uw[k].x), bf_lo(uw[k].y), bf_hi(uw[k].y)};
#pragma unroll
                for (int j = 0; j < 4; ++j) h[j] = __expf(la[j]) * h[j] + u[j];
                u32x2 o; o.x = pk2(h.x * bf_lo(gw[k].x), h.y * bf_hi(gw[k].x)); o.y = pk2(h.z * bf_lo(gw[k].y), h.w * bf_hi(gw[k].y)); *(u32x2*)(YB + r0 + (size_t)(t0 + k) * D) = o; } } }
}
__device__ __forceinline__ void p_ln(Frame& F, const float* V, const float* g, const float* b, float* Hf, bf16* Hb) {
    unsigned char* Hq = WSP(unsigned char, WS_HQ);
    for (int r = F.vcu * NWAVES + F.wave; r < M; r += NGW) { const f32x4* xr = (const f32x4*)(V + (size_t)r * D) + F.lane; f32x4 v[4];
#pragma unroll
        for (int j = 0; j < 4; ++j) v[j] = xr[64 * j];
        ln_store(v, g, b, Hf + (size_t)r * D, Hb + (size_t)r * D, F.lane, Hq + (size_t)r * D); }
}
template <int CTRL> __device__ __forceinline__ float dppf(float x) { return __builtin_bit_cast(float, __builtin_amdgcn_mov_dpp(__builtin_bit_cast(int, x), CTRL, 0xF, 0xF, true)); }
template <int CTRL> __device__ __forceinline__ unsigned dppu(unsigned x) { return (unsigned)__builtin_amdgcn_mov_dpp((int)x, CTRL, 0xF, 0xF, true); }
__device__ __forceinline__ float rdlane_f(float x, int l) { return __builtin_bit_cast(float, __builtin_amdgcn_readlane(__builtin_bit_cast(int, x), l)); }
__device__ __forceinline__ void p_route(Frame& F, const float* bias) {
    const float* LG = WSP(float, WS_LOGITS); int* TOPI = WSP(int, WS_TOPI); float* GATE = WSP(float, WS_GATE); int* HIST = WSP(int, WS_HIST);
    LAS int* hist = (LAS int*)F.lds; const int lane = F.lane;
    if (F.tid < 256) hist[F.tid] = 0;
    __syncthreads();
    const f32x4 bv = *(const f32x4*)(bias + 4 * lane);
#pragma unroll 2
    for (int j = 0; j < 16; ++j) { const int t = F.vcu * 128 + F.wave * 16 + j;
        const f32x4 z = *(const f32x4*)(LG + (size_t)t * NE + 4 * lane);
        const float s0 = sigmoidf_(z.x), s1 = sigmoidf_(z.y), s2 = sigmoidf_(z.z), s3 = sigmoidf_(z.w);
        const float v0 = s0 + bv.x, v1 = s1 + bv.y, v2 = s2 + bv.z, v3 = s3 + bv.w;
        float m1, m2; { const float a = fmaxf(v0, v1), b = fminf(v0, v1), c = fmaxf(v2, v3), d = fminf(v2, v3); m1 = fmaxf(a, c); m2 = fmaxf(fminf(a, c), fmaxf(b, d)); }
        { float o1 = dppf<0xB1>(m1), o2 = dppf<0xB1>(m2); float n1 = fmaxf(m1, o1), n2 = fmaxf(fminf(m1, o1), fmaxf(m2, o2)); m1 = n1; m2 = n2;
          o1 = dppf<0x4E>(m1); o2 = dppf<0x4E>(m2); n1 = fmaxf(m1, o1); n2 = fmaxf(fminf(m1, o1), fmaxf(m2, o2)); m1 = n1; m2 = n2;
          o1 = dppf<0x141>(m1); o2 = dppf<0x141>(m2); n1 = fmaxf(m1, o1); n2 = fmaxf(fminf(m1, o1), fmaxf(m2, o2)); m1 = n1; m2 = n2; }
        const float gs = m1 + m2; const int g = lane >> 3; int rank = 0;
#pragma unroll
        for (int q = 0; q < 8; ++q) { const float o = rdlane_f(gs, 8 * q); rank += (o > gs || (o == gs && q < g)) ? 1 : 0; }
        const bool sel = rank < 4;
        const unsigned ib = 255u - 4u * (unsigned)lane;
        unsigned k0 = sel ? ((__float_as_uint(v0 + 1.0f) & ~255u) | ib) : 0u, k1 = sel ? ((__float_as_uint(v1 + 1.0f) & ~255u) | (ib - 1u)) : 0u;
        unsigned k2 = sel ? ((__float_as_uint(v2 + 1.0f) & ~255u) | (ib - 2u)) : 0u, k3 = sel ? ((__float_as_uint(v3 + 1.0f) & ~255u) | (ib - 3u)) : 0u;
        int myidx = 0; float mys = 0.f, tot = 0.f;
#pragma unroll
        for (int k = 0; k < TOPK; ++k) {
            unsigned mk = max(max(k0, k1), max(k2, k3));
            mk = max(mk, dppu<0xB1>(mk)); mk = max(mk, dppu<0x4E>(mk)); mk = max(mk, dppu<0x141>(mk)); mk = max(mk, dppu<0x140>(mk));
            const unsigned win = max(max((unsigned)__builtin_amdgcn_readlane((int)mk, 0), (unsigned)__builtin_amdgcn_readlane((int)mk, 16)), max((unsigned)__builtin_amdgcn_readlane((int)mk, 32), (unsigned)__builtin_amdgcn_readlane((int)mk, 48)));
            const int idx = 255 - (int)(win & 255u);
            k0 = (k0 == win) ? 0u : k0; k1 = (k1 == win) ? 0u : k1; k2 = (k2 == win) ? 0u : k2; k3 = (k3 == win) ? 0u : k3;
            const int qq = idx & 3; const float sq = qq == 0 ? s0 : (qq == 1 ? s1 : (qq == 2 ? s2 : s3)); const float sw = rdlane_f(sq, idx >> 2);
            tot += sw; if (lane == k) { myidx = idx; mys = sw; }
        }
        if (lane < TOPK) { TOPI[t * TOPK + lane] = myidx; GATE[t * TOPK + lane] = mys / tot * 2.5f; atomicAdd((int*)&hist[myidx], 1); }
    }
    __syncthreads();
    if (F.tid < 256) HIST[F.vcu * 256 + F.tid] = hist[F.tid];
    __syncthreads();
}
__device__ __forceinline__ void p_sort(Frame& F) {
    const int* HIST = WSP(int, WS_HIST); const int* TOPI = WSP(int, WS_TOPI); int* ROWA = WSP(int, WS_ROWA); int* POS = WSP(int, WS_POS); int* BLKE = WSP(int, WS_BLKE); int* META = WSP(int, WS_META);
    LAS int* cnt = (LAS int*)F.lds; LAS int* myoff = cnt + 256; LAS int* nb = cnt + 512; LAS int* blk0 = cnt + 768; LAS int* lcnt = cnt + 1024;
    { typedef int i32x4 __attribute__((ext_vector_type(4)));
      const int q = F.tid >> 6, l = F.tid & 63; i32x4 c = {0, 0, 0, 0}, mo = {0, 0, 0, 0};
#pragma unroll 8
      for (int w = q; w < NWG; w += 8) { const i32x4 h = *(const i32x4*)(HIST + w * 256 + 4 * l); c += h; if (w < F.vcu) mo += h; }
      LAS int* redc = cnt + 1280; LAS int* redm = redc + 2048;
#pragma unroll
      for (int j = 0; j < 4; ++j) { redc[q * 256 + 4 * l + j] = c[j]; redm[q * 256 + 4 * l + j] = mo[j]; }
      __syncthreads();
      if (F.tid < 256) { const int e = F.tid; int cc = 0, mm = 0;
#pragma unroll
          for (int k = 0; k < 8; ++k) { cc += redc[k * 256 + e]; mm += redm[k * 256 + e]; }
          cnt[e] = cc; myoff[e] = mm; nb[e] = (cc + 255) >> 8; lcnt[e] = 0; } }
    __syncthreads();
    if (F.tid < 256) { int b = 0; for (int j = 0; j < F.tid; ++j) b += nb[j]; blk0[F.tid] = b; }
    __syncthreads();
    for (int al = F.tid; al < 1024; al += NTHR) { const int a = F.vcu * 1024 + al; const int e = TOPI[a]; const int pos = blk0[e] * 256 + myoff[e] + atomicAdd((int*)&lcnt[e], 1); ROWA[pos] = a; POS[a] = pos; }
    const int nrb = blk0[255] + nb[255];
    { const int e = F.vcu; const int start = blk0[e] * 256 + cnt[e], end = (blk0[e] + nb[e]) * 256;
      for (int p = start + F.tid; p < end; p += NTHR) ROWA[p] = -1;
      for (int j = F.tid; j < nb[e]; j += NTHR) BLKE[blk0[e] + j] = e; }
    for (int tl = F.tid; tl < 128; tl += NTHR) { const int t = F.vcu * 128 + tl; ROWA[nrb * 256 + t] = 8 * M + t; }
    if (F.vcu == 0) { for (int j = F.tid; j < 128; j += NTHR) BLKE[nrb + j] = 256; if (F.tid == 0) META[0] = nrb + 128; }
    __syncthreads();
}
__device__ __forceinline__ void p_combine(Frame& F, const float* Hin, const float* g, const float* b, float* Hf, unsigned char* Hq) {
    const bf16* YA = WSP(bf16, WS_RA); const float* GATE = WSP(float, WS_GATE); const int* POS = WSP(int, WS_POS); const int shrow0 = (*WSP(int, WS_META) - 128) * 256;
    for (int t = F.vcu * NWAVES + F.wave; t < M; t += NGW) { f32x4 v[4];
        const f32x4* hr = (const f32x4*)(Hin + (size_t)t * D) + F.lane;
#pragma unroll
        for (int j = 0; j < 4; ++j) v[j] = hr[64 * j] * ALPHA;
        f32x4 r[4];
#pragma unroll
        for (int j = 0; j < 4; ++j) r[j] = (f32x4){0.f, 0.f, 0.f, 0.f};
#pragma unroll
        for (int k = 0; k < TOPK; ++k) { const float gk = GATE[t * TOPK + k] * 0.0625f; const unsigned* yr = (const unsigned*)((const unsigned char*)YA + (size_t)POS[t * TOPK + k] * D) + F.lane;
#pragma unroll
            for (int j = 0; j < 4; ++j) { const unsigned w = yr[64 * j]; const f32x2 a = __builtin_amdgcn_cvt_pk_f32_fp8((int)w, false), c = __builtin_amdgcn_cvt_pk_f32_fp8((int)w, true);
                r[j].x += gk * a.x; r[j].y += gk * a.y; r[j].z += gk * c.x; r[j].w += gk * c.y; } }
        { const unsigned* yr = (const unsigned*)((const unsigned char*)YA + (size_t)(shrow0 + t) * D) + F.lane;
#pragma unroll
            for (int j = 0; j < 4; ++j) { const unsigned w = yr[64 * j]; const f32x2 a = __builtin_amdgcn_cvt_pk_f32_fp8((int)w, false), c = __builtin_amdgcn_cvt_pk_f32_fp8((int)w, true);
                v[j].x += r[j].x + 0.0625f * a.x; v[j].y += r[j].y + 0.0625f * a.y; v[j].z += r[j].z + 0.0625f * c.x; v[j].w += r[j].w + 0.0625f * c.y; } }
        ln_store(v, g, b, Hf + (size_t)t * D, nullptr, F.lane, Hq ? Hq + (size_t)t * D : nullptr); }
}
constexpr int AT_KP = 144, AT_VP = 784, AT_KBYTES = 384 * AT_KP, AT_VOFF = AT_KBYTES;
__device__ __forceinline__ void p_attn(Frame& F) {
    const bf16* QKb = WSP(bf16, WS_RA + RA_QK); const bf16* VTb = WSP(bf16, WS_RA + RA_VT); bf16* OGb = WSP(bf16, WS_RA + RA_OG); float* LSE = WSP(float, WS_LSE);
    const int lane = F.lane, q = lane & 31, hh = lane >> 5, w = F.wave;
    LAS unsigned char* lk = F.lds; LAS unsigned char* lv = F.lds + AT_VOFF;
#pragma unroll 1
    for (int it = F.vcu; it < 3 * 128 * 8; it += NWG) {
        const int g = it >> 10, rem = it & 1023, chunk = rem >> 3, h = rem & 7;
        const int sh = 14 - 2 * g, rq0 = chunk * 256, i0 = rq0 & ((1 << sh) - 1), rk0 = rq0 - 128;
        const bf16* QK = QKb + (size_t)g * M * 1024; const bf16* VT = VTb + (size_t)g * 512 * M;
        { const char* kb = (const char*)(QK + 512 + h * 64);
#pragma unroll
          for (int j = 0; j < 7; ++j) { const int ins = w + 8 * j; if (ins < 54) { const int p = ins * 64 + lane, row = p / 9, cc = p - row * 9; const int gr = rk0 + row < 0 ? 0 : rk0 + row;
              __builtin_amdgcn_global_load_lds((const unsigned*)(kb + (size_t)gr * 2048 + (cc > 7 ? 7 : cc) * 16), (LAS unsigned*)(lk + ins * 1024), 16, 0, 0); } }
          const char* vb = (const char*)(VT + (size_t)(h * 64) * M);
#pragma unroll
          for (int j = 0; j < 7; ++j) { const int ins = w + 8 * j; if (ins < 49) { const int p = ins * 64 + lane, row = p / 49, cc = p - row * 49; int col = rk0 + (cc > 47 ? 47 : cc) * 8; col = col < 0 ? 0 : col;
              __builtin_amdgcn_global_load_lds((const unsigned*)(vb + ((size_t)row * M + col) * 2), (LAS unsigned*)(lv + ins * 1024), 16, 0, 0); } } }
        bf16x8 Qf[4];
        { const bf16* qp = QK + (size_t)(rq0 + 32 * w + q) * 1024 + h * 64 + 8 * hh;
#pragma unroll
          for (int s2 = 0; s2 < 4; ++s2) Qf[s2] = *(const bf16x8*)(qp + 16 * s2); }
        asm volatile("s_waitcnt vmcnt(0)" ::: "memory");
        __syncthreads();
        const float slope2 = exp2f(-(float)(h + 1)) * (float)(1 << (2 * g)) * 1.4426950408889634f, sc = 0.125f * 1.4426950408889634f;
        float m_run = -1e30f, l_run = 0.f; f32x16 O0, O1;
#pragma unroll
        for (int r = 0; r < 16; ++r) { O0[r] = 0.f; O1[r] = 0.f; }
#pragma unroll 1
        for (int kt = 0; kt < 5; ++kt) { const int kr0 = 32 * w + 32 * kt; if (i0 + kr0 - 128 < 0) continue;
            bf16x8 Kf[4];
            { const LAS unsigned char* kp = lk + (kr0 + q) * AT_KP + 16 * hh;
#pragma unroll
              for (int s2 = 0; s2 < 4; ++s2) Kf[s2] = *(const LAS bf16x8*)(kp + 32 * s2); }
            bf16x8 Vf[2][2];
#pragma unroll
            for (int dd = 0; dd < 2; ++dd)
#pragma unroll
                for (int s2 = 0; s2 < 2; ++s2) { const LAS unsigned char* vp = lv + (32 * dd + q) * AT_VP + (kr0 + 16 * s2 + 4 * hh) * 2;
                    const u32x2 lo = *(const LAS u32x2*)vp, hi = *(const LAS u32x2*)(vp + 16); u32x4 wv; wv.x = lo.x; wv.y = lo.y; wv.z = hi.x; wv.w = hi.y; Vf[dd][s2] = __builtin_bit_cast(bf16x8, wv); }
            f32x16 S;
#pragma unroll
            for (int r = 0; r < 16; ++r) S[r] = 0.f;
#pragma unroll
            for (int s2 = 0; s2 < 4; ++s2) S = __builtin_amdgcn_mfma_f32_32x32x16_bf16(Kf[s2], Qf[s2], S, 0, 0, 0);
            float mx = -1e30f;
#pragma unroll
            for (int r = 0; r < 16; ++r) { const int krow = (r & 3) + 8 * (r >> 2) + 4 * hh; const int dist = 128 - 32 * kt + q - krow;
                const float sv = (dist >= 0 && dist <= 128) ? S[r] * sc - slope2 * (float)dist : -1e30f; S[r] = sv; mx = fmaxf(mx, sv); }
            mx = fmaxf(mx, __shfl_xor(mx, 32));
            const float m_new = fmaxf(m_run, mx), alpha = exp2f(m_run - m_new); float rs = 0.f;
#pragma unroll
            for (int r = 0; r < 16; ++r) { const float p = exp2f(S[r] - m_new); S[r] = p; rs += p; }
            rs += __shfl_xor(rs, 32);
            l_run = l_run * alpha + rs; m_run = m_new;
#pragma unroll
            for (int r = 0; r < 16; ++r) { O0[r] *= alpha; O1[r] *= alpha; }
            bf16x8 Pf[2];
#pragma unroll
            for (int s2 = 0; s2 < 2; ++s2) { u32x4 wv; wv.x = pk2(S[8 * s2 + 0], S[8 * s2 + 1]); wv.y = pk2(S[8 * s2 + 2], S[8 * s2 + 3]); wv.z = pk2(S[8 * s2 + 4], S[8 * s2 + 5]); wv.w = pk2(S[8 * s2 + 6], S[8 * s2 + 7]); Pf[s2] = __builtin_bit_cast(bf16x8, wv); }
#pragma unroll
            for (int s2 = 0; s2 < 2; ++s2) { O0 = __builtin_amdgcn_mfma_f32_32x32x16_bf16(Vf[0][s2], Pf[s2], O0, 0, 0, 0); O1 = __builtin_amdgcn_mfma_f32_32x32x16_bf16(Vf[1][s2], Pf[s2], O1, 0, 0, 0); }
        }
        const float inv = 1.0f / l_run;
        bf16* op = OGb + ((size_t)g * M + rq0 + 32 * w + q) * 512 + h * 64 + 4 * hh;
#pragma unroll
        for (int rg = 0; rg < 4; ++rg) { u32x2 wv; wv.x = pk2(O0[4 * rg] * inv, O0[4 * rg + 1] * inv); wv.y = pk2(O0[4 * rg + 2] * inv, O0[4 * rg + 3] * inv); *(u32x2*)(op + 8 * rg) = wv;
            u32x2 w1; w1.x = pk2(O1[4 * rg] * inv, O1[4 * rg + 1] * inv); w1.y = pk2(O1[4 * rg + 2] * inv, O1[4 * rg + 3] * inv); *(u32x2*)(op + 32 + 8 * rg) = w1; }
        if (hh == 0) LSE[((size_t)g * M + rq0 + 32 * w + q) * 8 + h] = (m_run + log2f(l_run)) * 0.6931471805599453f;
        __syncthreads();
    }
}
__device__ __forceinline__ void p_merge(Frame& F) {
    const bf16* OGb = WSP(bf16, WS_RA + RA_OG); const float* LSE = WSP(float, WS_LSE); bf16* OM = WSP(bf16, WS_RA + RA_OM);
    for (int t = F.vcu * NWAVES + F.wave; t < M; t += NGW) { const int hd = F.lane >> 3; float ls[3]; size_t ro[3];
#pragma unroll
        for (int g = 0; g < 3; ++g) { const int rho = tok_to_rho(t, g); ro[g] = ((size_t)g * M + rho); ls[g] = LSE[ro[g] * 8 + hd]; }
        const float mx = fmaxf(ls[0], fmaxf(ls[1], ls[2])); float w[3], ws = 0.f;
#pragma unroll
        for (int g = 0; g < 3; ++g) { w[g] = __expf(ls[g] - mx); ws += w[g]; }
        const float inv = 1.0f / ws; float o[8];
#pragma unroll
        for (int j = 0; j < 8; ++j) o[j] = 0.f;
#pragma unroll
        for (int g = 0; g < 3; ++g) { const u32x4 x = *(const u32x4*)(OGb + ro[g] * 512 + 8 * F.lane); const float wg = w[g] * inv;
            o[0] += wg * bf_lo(x.x); o[1] += wg * bf_hi(x.x); o[2] += wg * bf_lo(x.y); o[3] += wg * bf_hi(x.y); o[4] += wg * bf_lo(x.z); o[5] += wg * bf_hi(x.z); o[6] += wg * bf_lo(x.w); o[7] += wg * bf_hi(x.w); }
        u32x4 r; r.x = pk2(o[0], o[1]); r.y = pk2(o[2], o[3]); r.z = pk2(o[4], o[5]); r.w = pk2(o[6], o[7]); *(u32x4*)(OM + (size_t)t * OW + 8 * F.lane) = r; }
}

constexpr int NPHASE = 26;

__global__ void __launch_bounds__(NTHR, 2) yoco_fwd(Args args) {
    extern __shared__ __attribute__((aligned(16))) unsigned char lds[];
    Frame F;
    F.lds = (LAS unsigned char*)lds;
    F.tid = threadIdx.x; F.lane = F.tid & 63; F.wave = __builtin_amdgcn_readfirstlane(F.tid >> 6);
    { const int bx = blockIdx.x; F.vcu = (bx % 8) * (NWG / 8) + bx / 8; }
    F.ws = args.ws;
    volatile LAS unsigned* MISC = (volatile LAS unsigned*)(F.lds + LDS_BYTES - 64);
    if (F.tid < 16) MISC[F.tid] = 0u;
    __syncthreads();
    const int lo = args.ph_lo, hi = args.ph_hi;
    XcdBarrier bar; bar.bar = (unsigned*)(F.ws + WS_CTL) + 4096; bar.x = 0; bar.st = nullptr;
    if (hi - lo > 1) bar = xcd_barrier_post((unsigned*)(F.ws + WS_CTL) + 4096, MISC + 8);
#ifndef PROBE_G2
#define PROBE_G2 0
#endif
#ifndef DUP_MASK
#define DUP_MASK 0u
#endif
#ifndef PH_MASK
#define PH_MASK 0xFFFFFFFFu
#endif
#define IN(k) (((PH_MASK >> (k)) & 1u) && lo <= (k) && (k) < hi)
#define REP(k) for (int rep = 0, nrep = 1 + (int)((args.dup >> (k)) & 1u); rep < nrep; ++rep)
#define SEAM(k) do { if (IN(k) && IN((k) + 1)) xcd_barrier(bar); } while (0)

    if (IN(0)) { p0_prologue(F, args); } SEAM(0);
    if (IN(1)) { SchedDense8 S{WSP(unsigned char, WS_RA + RA_XB), WSP(unsigned char, WS_WIN), D, D, D, M / 256, 8, F.vcu}; EpiXZ E{WSP(bf16, WS_RA + RA_XR), WSP(bf16, WS_RA + RA_GG)}; gemm_fast8(F.lds, S, E); } SEAM(1);
    if (IN(2)) { p_conv(F, args.in[2], args.in[3]); } SEAM(2);
    if (IN(3)) { SchedGate S{WSP(bf16, WS_RA + RA_XC), WSP(bf16, WS_WG), F.vcu}; EpiGate E{WSP(bf16, WS_RA + RA_XC), args.in[5], args.in[7], args.in[8], WSP(bf16, WS_RA + RA_LA), WSP(bf16, WS_RA + RA_U)}; GEMM_PHASE(F.lds, S, E); } SEAM(3);
    if (IN(4)) { p_scan1(F); } SEAM(4);
    if (IN(5)) { p_scan2(F); } SEAM(5);
    if (IN(6)) { p_scan3(F); } SEAM(6);
    if (IN(7)) { SchedDense S{WSP(bf16, WS_RA + RA_YB), WSP(bf16, WS_WOUT), D, D, D, M / 256, 4, F.vcu}; EpiResF32 E{args.in[0], WSP(float, WS_V), D}; GEMM_PHASE(F.lds, S, E); } SEAM(7);
    if (IN(8)) { p_ln(F, WSP(float, WS_V), args.in[21] + 0 * D, args.in[22] + 0 * D, WSP(float, WS_HA), WSP(bf16, WS_HAB)); } SEAM(8);
    if (IN(9)) { SchedDense S{WSP(bf16, WS_HAB), WSP(bf16, WS_WR), D, D, D, M / 256, 1, F.vcu}; EpiF32 E{WSP(float, WS_LOGITS), NE}; GEMM_PHASE(F.lds, S, E); } SEAM(9);
    if (IN(10)) { p_route(F, args.in[14]); } SEAM(10);
    if (IN(11)) { p_sort(F); } SEAM(11);
    if (IN(12)) { const int nrbt = *WSP(int, WS_META); SchedG1 S{WSP(unsigned char, WS_HQ), WSP(unsigned char, WS_W13), WSP(int, WS_ROWA), WSP(int, WS_BLKE), nrbt, F.vcu, moe_unit_experts(F, WSP(int, WS_BLKE), nrbt, 1), moe_row_table(F, WSP(int, WS_ROWA), nrbt)}; EpiSwiGLU E{WSP(unsigned char, WS_HID), F.lds + LDS_EPI}; gemm_fast8(F.lds, S, E); } SEAM(12);
    if (IN(13)) { const int nrbt = *WSP(int, WS_META); SchedG2 S{WSP(unsigned char, WS_HID), WSP(unsigned char, WS_W2), WSP(int, WS_BLKE), nrbt, F.vcu, moe_unit_experts(F, WSP(int, WS_BLKE), nrbt, 2), args.rt256, args.rt256, args.rt256}; EpiScatter E{WSP(bf16, WS_RA), 0, F.lds + LDS_EPI}; gemm_fast8(F.lds, S, E); } SEAM(13);
    if (IN(14)) { p_combine(F, WSP(float, WS_HA), args.in[21] + 1 * D, args.in[22] + 1 * D, WSP(float, WS_HB), WSP(unsigned char, WS_HQ)); convert_experts(F, args.in[15] + (size_t)NE * D * DE, args.in[16] + (size_t)NE * D * DE, args.in[17] + (size_t)NE * D * DE, args.in[18] + (size_t)D * DE, args.in[19] + (size_t)D * DE, args.in[20] + (size_t)D * DE); } SEAM(14);
    if (IN(15)) { EpiQKV E{WSP(bf16, WS_RA + RA_QK), WSP(bf16, WS_RA + RA_VT), F.lds + LDS_EPI}; for (int g = 0; g < 3; ++g) { SchedQK S{WSP(unsigned char, WS_HQ), WSP(unsigned char, WS_WQK), g, D << (2 * g), F.vcu}; gemm_fast8(F.lds, S, E); } for (int g = 0; g < 3; ++g) { SchedVT S{WSP(unsigned char, WS_HQ), WSP(unsigned char, WS_WQK) + (size_t)3072 * D, g, D << (2 * g), F.vcu}; gemm_fast8(F.lds, S, E); } } SEAM(15);
    if (IN(16)) { p_attn(F); } SEAM(16);
    if (IN(17)) { p_merge(F); } SEAM(17);
    if (IN(18)) { SchedDense S{WSP(bf16, WS_RA + RA_OM), WSP(bf16, WS_WO), OW, OW, OW, M / 256, 4, F.vcu}; EpiResF32 E{WSP(float, WS_HB), WSP(float, WS_V), D}; GEMM_PHASE(F.lds, S, E); } SEAM(18);
    if (IN(19)) { p_ln(F, WSP(float, WS_V), args.in[21] + 2 * D, args.in[22] + 2 * D, WSP(float, WS_HA), WSP(bf16, WS_HAB)); } SEAM(19);
    if (IN(20)) { SchedDense S{WSP(bf16, WS_HAB), WSP(bf16, WS_WR) + (size_t)NE * D, D, D, D, M / 256, 1, F.vcu}; EpiF32 E{WSP(float, WS_LOGITS), NE}; GEMM_PHASE(F.lds, S, E); } SEAM(20);
    if (IN(21)) { p_route(F, args.in[14] + NE); } SEAM(21);
    if (IN(22)) { p_sort(F); } SEAM(22);
    if (IN(23)) { const int nrbt = *WSP(int, WS_META); SchedG1 S{WSP(unsigned char, WS_HQ), WSP(unsigned char, WS_W13), WSP(int, WS_ROWA), WSP(int, WS_BLKE), nrbt, F.vcu, moe_unit_experts(F, WSP(int, WS_BLKE), nrbt, 1), moe_row_table(F, WSP(int, WS_ROWA), nrbt)}; EpiSwiGLU E{WSP(unsigned char, WS_HID), F.lds + LDS_EPI}; gemm_fast8(F.lds, S, E); } SEAM(23);
    if (IN(24)) { const int nrbt = *WSP(int, WS_META); SchedG2 S{WSP(unsigned char, WS_HID), WSP(unsigned char, WS_W2), WSP(int, WS_BLKE), nrbt, F.vcu, moe_unit_experts(F, WSP(int, WS_BLKE), nrbt, 2), args.rt256, args.rt256, args.rt256}; EpiScatter E{WSP(bf16, WS_RA), 0, F.lds + LDS_EPI}; gemm_fast8(F.lds, S, E); } SEAM(24);
    if (IN(25)) { p_combine(F, WSP(float, WS_HA), args.in[21] + 3 * D, args.in[22] + 3 * D, args.out, nullptr); }
#undef IN
#undef SEAM
}

extern "C" void kernel_launch(void* const* d_in, const int* in_sizes, int n_in, void* d_out, int out_size, void* d_ws, size_t ws_size, hipStream_t stream) {
    static int ok = 0;
    if (ok == 0) {
        if (n_in != 23 || in_sizes[0] != M * D || out_size != M * D || ws_size < WS_END) { fprintf(stderr, "kernel_launch: unexpected shapes (n_in %d, in0 %d, out %d, ws %zu < %zu)\n", n_in, n_in > 0 ? in_sizes[0] : -1, out_size, ws_size, (size_t)WS_END); ok = -1; return; }
        if (hipFuncSetAttribute((const void*)yoco_fwd, hipFuncAttributeMaxDynamicSharedMemorySize, LDS_BYTES) != hipSuccess) { fprintf(stderr, "kernel_launch: hipFuncSetAttribute failed\n"); ok = -1; return; }
        int per_cu = 0;
        if (hipOccupancyMaxActiveBlocksPerMultiprocessor(&per_cu, (const void*)yoco_fwd, NTHR, LDS_BYTES) != hipSuccess || per_cu < 1) fprintf(stderr, "kernel_launch: occupancy query says %d\n", per_cu);
        (void)hipGetLastError();
        ok = 1;
    }
    if (ok < 0) return;
    if (hipMemsetAsync((char*)d_ws + WS_CTL, 0, CTL_ZERO_BYTES, stream) != hipSuccess) return;
    Args a{};
    for (int i = 0; i < 23; ++i) a.in[i] = (const float*)d_in[i];
    a.out = (float*)d_out; a.ws = (unsigned char*)d_ws; a.dup = 0u; a.rt256 = 256;
#if MK_ONE_LAUNCH
    a.ph_lo = 0; a.ph_hi = NPHASE;
    hipLaunchKernelGGL(yoco_fwd, dim3(NWG), dim3(NTHR), LDS_BYTES, stream, a);
#else
    for (int p = 0; p < NPHASE; ++p) { a.ph_lo = p; a.ph_hi = p + 1; hipLaunchKernelGGL(yoco_fwd, dim3(NWG), dim3(NTHR), LDS_BYTES, stream, a); }
#endif
}
```

```cpp
#include <hip/hip_runtime.h>
#include <cstdio>
#include <cstdint>

#ifndef MK_ONE_LAUNCH
#define MK_ONE_LAUNCH 1
#endif

constexpr int D = 1024, BATCH = 2, SEQ = 16384, M = BATCH * SEQ;
constexpr int NE = 256, TOPK = 8, DE = 256;
constexpr int HEADS = 8, HD = 64, QW = 1536, OW = 512;
constexpr float LN_EPS = 1e-5f, ALPHA = 1.41421356237f;
constexpr int RBMAX = 1024 + 256 + 128;
constexpr int NWG = 256, NTHR = 512, NWAVES = 8;
constexpr int NGW = NWG * NWAVES, NGT = NWG * NTHR;

constexpr size_t MiB = 1u << 20;
constexpr size_t WS_CTL = 0, CTL_ZERO_BYTES = 1 * MiB;
constexpr size_t WS_HIST = 1 * MiB, WS_BLKE = 1 * MiB + 512 * 1024, WS_META = 1 * MiB + 768 * 1024;
constexpr size_t WS_ROWA = 2 * MiB, WS_TOPI = 4 * MiB, WS_GATE = 5 * MiB, WS_CHP = 6 * MiB, WS_CHH = 8 * MiB, WS_CIN = 10 * MiB, WS_LSE = 12 * MiB;
constexpr size_t WS_WIN = 16 * MiB, WS_WG = 20 * MiB, WS_WOUT = 21 * MiB, WS_WQK = 23 * MiB, WS_WV = 29 * MiB, WS_WO = 32 * MiB, WS_WR = 33 * MiB;
constexpr size_t WS_LOGITS = 34 * MiB;
constexpr size_t WS_W13 = 66 * MiB, WS_W2 = 323 * MiB;
constexpr size_t W13_LB = (size_t)257 * 512 * 1024, W2_LB = (size_t)257 * 1024 * 256;
static_assert(WS_W13 + 2 * W13_LB <= WS_W2 && WS_W2 + 2 * W2_LB <= 452 * MiB, "both layers' fp8 expert weights fit");
constexpr size_t WS_V = 452 * MiB, WS_HA = 580 * MiB, WS_HAB = 708 * MiB, WS_HB = 772 * MiB, WS_HBB = 900 * MiB, WS_HID = 964 * MiB;
constexpr size_t WS_RA = 1140 * MiB;
constexpr size_t RA_XB = 0, RA_XR = 64 * MiB, RA_GG = 128 * MiB, RA_XC = 192 * MiB, RA_LA = 256 * MiB, RA_U = 384 * MiB, RA_YB = 512 * MiB;
constexpr size_t RA_QK = 0, RA_VT = 192 * MiB, RA_OG = 288 * MiB, RA_OM = 384 * MiB;
constexpr size_t WS_POS = 15 * MiB;
constexpr size_t WS_HQ = 1844 * MiB;
constexpr size_t WS_END = 1876 * MiB;

constexpr int LDS_BYTES = 163840;
constexpr int LDS_EPI = 131072, LDS_TAB = 147456;

#define GAS __attribute__((address_space(1)))
#define LAS __attribute__((address_space(3)))
typedef unsigned short bf16;
typedef unsigned u32x4 __attribute__((ext_vector_type(4)));
typedef unsigned u32x2 __attribute__((ext_vector_type(2)));
typedef float f32x4 __attribute__((ext_vector_type(4)));
typedef float f32x2 __attribute__((ext_vector_type(2)));
typedef float f32x16 __attribute__((ext_vector_type(16)));
typedef short bf16x8 __attribute__((ext_vector_type(8)));
typedef int i32x8 __attribute__((ext_vector_type(8)));
typedef GAS unsigned gu32;
#define RLX_AGENT __ATOMIC_RELAXED, __HIP_MEMORY_SCOPE_AGENT
#define LDS_WAIT() asm volatile("s_waitcnt lgkmcnt(0)" ::: "memory")
#define VM_WAIT() asm volatile("s_waitcnt vmcnt(0)" ::: "memory")

__device__ __forceinline__ unsigned pk2(float lo, float hi) { unsigned r; asm("v_cvt_pk_bf16_f32 %0, %1, %2" : "=v"(r) : "v"(lo), "v"(hi)); return r; }
__device__ __forceinline__ float bf_lo(unsigned w) { return __uint_as_float(w << 16); }
__device__ __forceinline__ float bf_hi(unsigned w) { return __uint_as_float(w & 0xffff0000u); }
__device__ __forceinline__ float wave_sum(float v) {
#pragma unroll
    for (int o = 1; o < 64; o <<= 1) v += __shfl_xor(v, o);
    return v;
}
__device__ __forceinline__ float gelu_tanh(float x) {
    const float u = 0.7978845608028654f * (x + 0.044715f * x * x * x);
    const float e = __expf(2.0f * u);
    const float t = 1.0f - 2.0f / (e + 1.0f);
    return 0.5f * x * (1.0f + t);
}
__device__ __forceinline__ float sigmoidf_(float x) { return 1.0f / (1.0f + __expf(-x)); }

#define XB_TMO      128
#define XB_XCNT(j)  (256  + 64 * (j))
#define XB_XSUB(j)  (1280 + 64 * (j))
#define XB_XGEN(j)  (2304 + 64 * (j))
#define XB_TOP      3328
#define XB_TOPGEN   3392
#define XCD_BAR_WORDS 3456
#define XB_SPIN_CAP (1u << 18)
__device__ __forceinline__ unsigned xb_ld(unsigned* p)              { return __hip_atomic_load(p, __ATOMIC_RELAXED, __HIP_MEMORY_SCOPE_AGENT); }
__device__ __forceinline__ unsigned xb_add(unsigned* p, unsigned v) { return __hip_atomic_fetch_add(p, v, __ATOMIC_RELAXED, __HIP_MEMORY_SCOPE_AGENT); }
__device__ __forceinline__ unsigned xb_xcc_id() { return (unsigned)__builtin_amdgcn_s_getreg((3 << 11) | 20) & 0xFu; }
#define XB_SPIN(cond, bar) do { unsigned _sp = 0; while (cond) { __builtin_amdgcn_s_sleep(1); \
    if ((++_sp & 255u) == 0u) { if (xb_ld(&(bar)[XB_TMO])) break; if (_sp > XB_SPIN_CAP) { atomicAdd(&(bar)[XB_TMO], 1u); break; } } } } while (0)
struct XcdBarrier { unsigned* bar; unsigned x; volatile LAS unsigned* st; };
__device__ __forceinline__ XcdBarrier xcd_barrier_post(unsigned* bar, volatile LAS unsigned* st) {
    XcdBarrier b; b.bar = bar; b.x = xb_xcc_id(); b.st = st;
    if (threadIdx.x == 0) (void)xb_add(&bar[XB_XCNT(b.x)], 1u);
    return b;
}
__device__ __forceinline__ void xcd_barrier_complete(unsigned* bar, unsigned x, unsigned& nloc, unsigned& nx) {
    const unsigned G = gridDim.x * gridDim.y * gridDim.z;
    unsigned sum, cnt, mine, sp = 0u;
    for (;;) {
        sum = 0u; cnt = 0u; mine = 0u;
#pragma unroll
        for (unsigned j = 0; j < 16; ++j) { const unsigned c = xb_ld(&bar[XB_XCNT(j)]); sum += c; cnt += (c > 0u) ? 1u : 0u; mine = (j == x) ? c : mine; }
        if (sum == G) break;
        __builtin_amdgcn_s_sleep(1);
        if ((++sp & 255u) == 0u) { if (xb_ld(&bar[XB_TMO])) break; if (sp > XB_SPIN_CAP) { atomicAdd(&bar[XB_TMO], 1u); break; } }
    }
    nloc = mine > 0u ? mine : 1u; nx = cnt > 0u ? cnt : 1u;
}
__device__ __forceinline__ void xcd_barrier(const XcdBarrier& b) {
    asm volatile("s_waitcnt vmcnt(0)" ::: "memory");
    __syncthreads();
    if (threadIdx.x == 0) {
        unsigned* bar = b.bar;
        __builtin_amdgcn_s_waitcnt(0);
        unsigned nloc = b.st[0], nx = b.st[1];
        if (nloc == 0u) { xcd_barrier_complete(bar, b.x, nloc, nx); b.st[0] = nloc; b.st[1] = nx; }
        const unsigned old = xb_add(&bar[XB_XSUB(b.x)], 1u);
        const unsigned gen = old / nloc;
        if (old + 1u == (gen + 1u) * nloc) {
            __builtin_amdgcn_fence(__ATOMIC_RELEASE, "agent");
            asm volatile("s_waitcnt vmcnt(0)" ::: "memory");
            const unsigned og = xb_add(&bar[XB_TOP], 1u);
            const unsigned tg = og / nx;
            if (og + 1u == (tg + 1u) * nx) xb_add(&bar[XB_TOPGEN], 1u);
            else XB_SPIN(xb_ld(&bar[XB_TOPGEN]) == tg, bar);
            __builtin_amdgcn_fence(__ATOMIC_ACQUIRE, "agent");
            xb_add(&bar[XB_XGEN(b.x)], 1u);
            asm volatile("s_waitcnt vmcnt(0)" ::: "memory");
        } else {
            XB_SPIN(xb_ld(&bar[XB_XGEN(b.x)]) == gen, bar);
            __builtin_amdgcn_fence(__ATOMIC_ACQUIRE, "agent");
            asm volatile("s_waitcnt vmcnt(0)" ::: "memory");
        }
    }
    __syncthreads();
}

struct Args { const float* in[23]; float* out; unsigned char* ws; int ph_lo, ph_hi; unsigned dup; int rt256; };
static_assert(sizeof(Args) == 23 * 8 + 8 + 8 + 16, "Args has no padding");
struct Frame {
    LAS unsigned char* lds;
    int tid, lane, wave, vcu;
    unsigned char* ws;
};
#define WSP(T, off) ((T*)(F.ws + (off)))

template <class S, class E>
__device__ __forceinline__ void gemm_simple(LAS unsigned char* lds, const S& sch, const E& epi) {
    const int tid = threadIdx.x, wid = tid >> 6, lane = tid & 63, wr = wid >> 2, wc = wid & 3, fr = lane & 15, fq = lane >> 4;
    constexpr int PITCH = 144;
    LAS unsigned char* As = lds; LAS unsigned char* Bs = lds + 256 * PITCH;
    typename S::U u;
    for (int i = 0; sch.next(i, u); ++i) {
        f32x4 acc[2][2][4][2];
#pragma unroll
        for (int a = 0; a < 2; ++a)
#pragma unroll
            for (int b = 0; b < 2; ++b)
#pragma unroll
                for (int m = 0; m < 4; ++m)
#pragma unroll
                    for (int n = 0; n < 2; ++n) acc[a][b][m][n] = (f32x4){0.f, 0.f, 0.f, 0.f};
        const int nt = sch.K(u) / 64;
        const char* pa[4]; const char* pb[4];
#pragma unroll
        for (int j = 0; j < 4; ++j) { const int row = (tid >> 3) + 64 * j; const int rb = S::PERM ? ((row & ~31) + 8 * ((row & 15) >> 2) + 4 * ((row >> 4) & 1) + (row & 3)) : row; pa[j] = sch.rowA(u, row) + (tid & 7) * 16; pb[j] = sch.rowB(u, rb) + (tid & 7) * 16; }
        for (int kt = 0; kt < nt; ++kt) {
            u32x4 va[4], vb[4];
#pragma unroll
            for (int j = 0; j < 4; ++j) { va[j] = *(const u32x4*)(pa[j] + kt * 128); vb[j] = *(const u32x4*)(pb[j] + kt * 128); }
            __syncthreads();
#pragma unroll
            for (int j = 0; j < 4; ++j) { const int row = (tid >> 3) + 64 * j;
                *(LAS u32x4*)(As + row * PITCH + (tid & 7) * 16) = va[j]; *(LAS u32x4*)(Bs + row * PITCH + (tid & 7) * 16) = vb[j]; }
            __syncthreads();
#pragma unroll
            for (int kk = 0; kk < 2; ++kk) {
                bf16x8 Bf[2][2];
#pragma unroll
                for (int b = 0; b < 2; ++b)
#pragma unroll
                    for (int n = 0; n < 2; ++n) Bf[b][n] = *(const LAS bf16x8*)(Bs + (b * 128 + wc * 32 + n * 16 + fr) * PITCH + kk * 64 + fq * 16);
#pragma unroll
                for (int a = 0; a < 2; ++a) {
                    bf16x8 Af[4];
#pragma unroll
                    for (int m = 0; m < 4; ++m) Af[m] = *(const LAS bf16x8*)(As + (a * 128 + wr * 64 + m * 16 + fr) * PITCH + kk * 64 + fq * 16);
#pragma unroll
                    for (int b = 0; b < 2; ++b)
#pragma unroll
                        for (int m = 0; m < 4; ++m)
#pragma unroll
                            for (int n = 0; n < 2; ++n) acc[a][b][m][n] = __builtin_amdgcn_mfma_f32_16x16x32_bf16(Bf[b][n], Af[m], acc[a][b][m][n], 0, 0, 0);
                }
            }
        }
        epi(acc, u, wr, wc, fr, fq);
    }
    __syncthreads();
}

namespace pg8 {
constexpr int HTB = 128 * 64 * 2;
__device__ __forceinline__ int lds_byte(int r, int c) { const int st = (r >> 4) * 2 + (c >> 5), rr = r & 15, cc = c & 31, ob = rr * 64 + cc * 2; return st * 1024 + (ob ^ (((ob >> 9) & 1) << 5)); }
__device__ __forceinline__ int perm32(int rho) { const int n = rho >> 4, i = rho & 15; return 8 * (i >> 2) + 4 * n + (i & 3); }
__device__ __forceinline__ int prow(int r) { return (r & ~31) + perm32(r & 31); }
__device__ __forceinline__ void stage_rc(int b, int& R, int& C) { const int st = b / 1024, sb = b % 1024, swz = sb ^ (((sb >> 9) & 1) << 5); R = (st >> 1) * 16 + swz / 64; C = (st & 1) * 32 + (swz % 64) / 2; }
}
template <class S, class E>
__device__ __forceinline__ void gemm_fast(LAS unsigned char* lds, const S& sch, const E& epi) {
    using namespace pg8;
    const int tid = threadIdx.x, wid = __builtin_amdgcn_readfirstlane(tid >> 6), lane = tid & 63, wr = wid >> 2, wc = wid & 3, fr = lane & 15, fq = lane >> 4;
    const int nt = sch.Kk / 64;
    int R0, C0; stage_rc(tid * 16, R0, C0);
    unsigned voffA[2], voffB[2]; unsigned cofA[4], nofA[4], cofB[4], nofB[4];
    size_t hstepA = 0, hstepB = 0;
    if constexpr (!S::GA) { voffA[0] = (unsigned)(R0 * sch.lda + C0) * 2u; voffA[1] = (unsigned)((R0 + 64) * sch.lda + C0) * 2u; hstepA = (size_t)128 * sch.lda * 2; }
    const int RB0 = S::PERM ? prow(R0) : R0;
    if constexpr (!S::GB) { voffB[0] = (unsigned)(RB0 * sch.ldb + C0) * 2u; voffB[1] = (unsigned)((RB0 + 64) * sch.ldb + C0) * 2u; hstepB = (size_t)128 * sch.ldb * 2; }
    const size_t kstep = 128;
    const unsigned ldsw = (unsigned)wid * 1024u;
    const int aoff = lds_byte(wr * 64 + fr, fq * 8), boff = lds_byte(wc * 32 + fr, fq * 8);
#define G_SA(b, h) (((b) * 2 + (h)) * HTB)
#define G_SB(b, h) ((4 + (b) * 2 + (h)) * HTB)
#define G_GLDS(src, dst) __builtin_amdgcn_global_load_lds((const unsigned*)(src), (LAS unsigned*)(dst), 16, 0, 0)
#define G_STAGE_A(bufoff, gp, h, nx) do { if constexpr (S::GA) { _Pragma("unroll") for (int _i = 0; _i < 2; ++_i) { const unsigned _o = (nx) ? nofA[2 * (h) + _i] : cofA[2 * (h) + _i]; G_GLDS((gp) + _o, lds + (bufoff) + ldsw + _i * 8192); } } \
        else { _Pragma("unroll") for (int _i = 0; _i < 2; ++_i) G_GLDS((gp) + (size_t)(h) * hstepA + voffA[_i], lds + (bufoff) + ldsw + _i * 8192); } } while (0)
#define G_STAGE_B(bufoff, gp, h, nx) do { if constexpr (S::GB) { _Pragma("unroll") for (int _i = 0; _i < 2; ++_i) { const unsigned _o = (nx) ? nofB[2 * (h) + _i] : cofB[2 * (h) + _i]; G_GLDS((gp) + _o, lds + (bufoff) + ldsw + _i * 8192); } } \
        else { _Pragma("unroll") for (int _i = 0; _i < 2; ++_i) G_GLDS((gp) + (size_t)(h) * hstepB + voffB[_i], lds + (bufoff) + ldsw + _i * 8192); } } while (0)
#define G_LDA(dst, b, h) do { _Pragma("unroll") for (int m = 0; m < 4; ++m) _Pragma("unroll") for (int k = 0; k < 2; ++k) dst[m][k] = *(const LAS bf16x8*)(lds + G_SA(b, h) + aoff + m * 2048 + k * 1024); } while (0)
#define G_LDB(dst, b, h) do { _Pragma("unroll") for (int n = 0; n < 2; ++n) _Pragma("unroll") for (int k = 0; k < 2; ++k) dst[n][k] = *(const LAS bf16x8*)(lds + G_SB(b, h) + boff + n * 2048 + k * 1024); } while (0)
#define G_MMA(ai, bj, At, Bt) do { __builtin_amdgcn_s_setprio(1); _Pragma("unroll") for (int m = 0; m < 4; ++m) _Pragma("unroll") for (int n = 0; n < 2; ++n) _Pragma("unroll") for (int k = 0; k < 2; ++k) \
        acc[ai][bj][m][n] = __builtin_amdgcn_mfma_f32_16x16x32_bf16(Bt[n][k], At[m][k], acc[ai][bj][m][n], 0, 0, 0); __builtin_amdgcn_s_setprio(0); } while (0)
#define G_WAIT_V(n) asm volatile("s_waitcnt vmcnt(" #n ")" ::: "memory")
#define G_WAIT_L(n) asm volatile("s_waitcnt lgkmcnt(" #n ")" ::: "memory")
#define G_BAR __builtin_amdgcn_s_barrier()
#define G_SCHED __builtin_amdgcn_sched_barrier(0)
    typename S::U cur, nxt; int ui = 0;
    if (!sch.next(0, cur)) return;
    f32x4 acc[2][2][4][2];
#pragma unroll
    for (int a = 0; a < 2; ++a)
#pragma unroll
        for (int b = 0; b < 2; ++b)
#pragma unroll
            for (int m = 0; m < 4; ++m)
#pragma unroll
                for (int n = 0; n < 2; ++n) acc[a][b][m][n] = (f32x4){0.f, 0.f, 0.f, 0.f};
    bf16x8 At[4][2], B0[2][2], B1[2][2];
    const char* cA = sch.baseA(cur); const char* cB = sch.baseB(cur);
    if constexpr (S::GA) {
#pragma unroll
        for (int j = 0; j < 4; ++j) { cofA[j] = sch.goffA(cur, (j >> 1) * 128 + R0 + (j & 1) * 64, C0); nofA[j] = cofA[j]; } }
    if constexpr (S::GB) {
#pragma unroll
        for (int j = 0; j < 4; ++j) { cofB[j] = sch.goffB(cur, (j >> 1) * 128 + RB0 + (j & 1) * 64, C0); nofB[j] = cofB[j]; } }
    G_STAGE_B(G_SB(0, 0), cB, 0, false); G_STAGE_B(G_SB(0, 1), cB, 1, false); G_STAGE_A(G_SA(0, 0), cA, 0, false); G_STAGE_A(G_SA(0, 1), cA, 1, false);
    if (wr == 1) G_BAR;
    G_WAIT_V(2); G_BAR;
    G_STAGE_B(G_SB(1, 0), cB + kstep, 0, false); G_STAGE_A(G_SA(1, 0), cA + kstep, 0, false); G_STAGE_B(G_SB(1, 1), cB + kstep, 1, false);
    G_WAIT_V(6); G_BAR;
    for (;;) {
        const bool has_next = sch.next(ui + 1, nxt);
        const char* nA = has_next ? sch.baseA(nxt) : cA; const char* nB = has_next ? sch.baseB(nxt) : cB;
        if constexpr (S::GA) { if (has_next) {
#pragma unroll
            for (int j = 0; j < 4; ++j) nofA[j] = sch.goffA(nxt, (j >> 1) * 128 + R0 + (j & 1) * 64, C0); } }
        if constexpr (S::GB) { if (has_next) {
#pragma unroll
            for (int j = 0; j < 4; ++j) nofB[j] = sch.goffB(nxt, (j >> 1) * 128 + RB0 + (j & 1) * 64, C0); } }
#pragma unroll 1
        for (int t = 0; t < nt; t += 2) {
            const bool last = (t == nt - 2);
            const char* a1 = cA + (size_t)(t + 1) * kstep;
            const char* a2 = last ? nA : cA + (size_t)(t + 2) * kstep; const char* b2 = last ? nB : cB + (size_t)(t + 2) * kstep;
            const char* a3 = a2 + kstep; const char* b3 = b2 + kstep;
            asm volatile("" : "+s"(a1), "+s"(a2), "+s"(a3), "+s"(b2), "+s"(b3));
            const bool post = (t == 0 && ui > 0);
#define G_WAIT_POST() do { if (post) { if constexpr (E::NVM == 8) G_WAIT_V(16); else if constexpr (E::NVM == 16) G_WAIT_V(24); else if constexpr (E::NVM == 32) G_WAIT_V(40); else G_WAIT_V(8); } else G_WAIT_V(8); } while (0)
            G_LDB(B0, 0, 0); G_LDB(B1, 0, 1); G_SCHED; G_LDA(At, 0, 0); if (!post) G_STAGE_A(G_SA(1, 1), a1, 1, false);
            G_WAIT_POST(); G_WAIT_L(0); G_BAR; G_MMA(0, 0, At, B0); G_MMA(0, 1, At, B1); G_BAR; G_SCHED;
            G_LDA(At, 0, 1); G_STAGE_B(G_SB(0, 0), b2, 0, last); G_STAGE_B(G_SB(0, 1), b2, 1, last); G_STAGE_A(G_SA(0, 0), a2, 0, last);
            G_WAIT_POST(); G_WAIT_L(0); G_BAR; G_MMA(1, 0, At, B0); G_MMA(1, 1, At, B1); G_BAR; G_SCHED;
            G_LDB(B0, 1, 0); G_LDB(B1, 1, 1); G_SCHED; G_LDA(At, 1, 0); G_STAGE_A(G_SA(0, 1), a2, 1, last);
            G_WAIT_POST(); G_WAIT_L(0); G_BAR; G_MMA(0, 0, At, B0); G_MMA(0, 1, At, B1); G_BAR; G_SCHED;
            G_LDA(At, 1, 1); G_STAGE_B(G_SB(1, 0), b3, 0, last); G_STAGE_B(G_SB(1, 1), b3, 1, last); G_STAGE_A(G_SA(1, 0), a3, 0, last);
            G_WAIT_V(8); G_WAIT_L(0); G_BAR; G_MMA(1, 0, At, B0); G_MMA(1, 1, At, B1); G_BAR; G_SCHED;
#undef G_WAIT_POST
        }
        if (wr == 0) G_BAR;
        if (has_next) { const char* n1 = nA + kstep; asm volatile("" : "+s"(n1)); G_STAGE_A(G_SA(1, 1), n1, 1, true); }
        { int tz = threadIdx.x; asm volatile("" : "+v"(tz));
          const int ewid = tz >> 6, el = tz & 63; epi(acc, cur, ewid >> 2, ewid & 3, el & 15, el >> 4); }
        if (!has_next) break;
#pragma unroll
        for (int a = 0; a < 2; ++a)
#pragma unroll
            for (int b = 0; b < 2; ++b)
#pragma unroll
                for (int m = 0; m < 4; ++m)
#pragma unroll
                    for (int n = 0; n < 2; ++n) acc[a][b][m][n] = (f32x4){0.f, 0.f, 0.f, 0.f};
        cur = nxt; cA = nA; cB = nB; ++ui;
        if constexpr (S::GA) {
#pragma unroll
            for (int j = 0; j < 4; ++j) cofA[j] = nofA[j]; }
        if constexpr (S::GB) {
#pragma unroll
            for (int j = 0; j < 4; ++j) cofB[j] = nofB[j]; }
        if (wr == 1) G_BAR;
    }
    G_WAIT_V(0);
    G_BAR;
#undef G_SA
#undef G_SB
#undef G_GLDS
#undef G_STAGE_A
#undef G_STAGE_B
#undef G_LDA
#undef G_LDB
#undef G_MMA
#undef G_WAIT_V
#undef G_WAIT_L
#undef G_BAR
#undef G_SCHED
}
template <class S, class E>
__device__ __forceinline__ void gemm_fast8(LAS unsigned char* lds, const S& sch, const E& epi) {
    using namespace pg8;
    const int tid = threadIdx.x, wid = __builtin_amdgcn_readfirstlane(tid >> 6), lane = tid & 63, wr = wid >> 2, wc = wid & 3, fr = lane & 15, fq = lane >> 4;
    const int nt = sch.Kk / 128;
    const int R0 = tid >> 3, C0 = ((tid & 7) ^ (((R0 >> 1) & 1) | (((R0 >> 2) & 1) << 2))) * 8;
    unsigned voffA[2], voffB[2]; unsigned cofA[4], nofA[4], cofB[4], nofB[4];
    size_t hstepA = 0, hstepB = 0;
    if constexpr (!S::GA) { voffA[0] = (unsigned)(R0 * sch.lda + C0 * 2); voffA[1] = (unsigned)((R0 + 64) * sch.lda + C0 * 2); hstepA = (size_t)128 * sch.lda; }
    const int RB0 = S::PERM ? prow(R0) : R0;
    if constexpr (!S::GB) { voffB[0] = (unsigned)(RB0 * sch.ldb + C0 * 2); voffB[1] = (unsigned)((RB0 + 64) * sch.ldb + C0 * 2); hstepB = (size_t)128 * sch.ldb; }
    const size_t kstep = 128;
    const unsigned ldsw = (unsigned)wid * 1024u;
    const int fsw = ((fr >> 1) & 1) | (((fr >> 2) & 1) << 2);
    const int aoff = ((wr * 64 + fr) * 8 + ((2 * fq) ^ fsw)) * 16, aoff1 = ((wr * 64 + fr) * 8 + ((2 * fq + 1) ^ fsw)) * 16, boff = ((wc * 32 + fr) * 8 + ((2 * fq) ^ fsw)) * 16, boff1 = ((wc * 32 + fr) * 8 + ((2 * fq + 1) ^ fsw)) * 16;
#define G_SA(b, h) (((b) * 2 + (h)) * HTB)
#define G_SB(b, h) ((4 + (b) * 2 + (h)) * HTB)
#define G_GLDS(src, dst) __builtin_amdgcn_global_load_lds((const unsigned*)(src), (LAS unsigned*)(dst), 16, 0, 0)
#define G_STAGE_A(bufoff, gp, h, nx) do { if constexpr (S::GA) { _Pragma("unroll") for (int _i = 0; _i < 2; ++_i) { const unsigned _o = (nx) ? nofA[2 * (h) + _i] : cofA[2 * (h) + _i]; G_GLDS((gp) + _o, lds + (bufoff) + ldsw + _i * 8192); } } \
        else { _Pragma("unroll") for (int _i = 0; _i < 2; ++_i) G_GLDS((gp) + (size_t)(h) * hstepA + voffA[_i], lds + (bufoff) + ldsw + _i * 8192); } } while (0)
#define G_STAGE_B(bufoff, gp, h, nx) do { if constexpr (S::GB) { _Pragma("unroll") for (int _i = 0; _i < 2; ++_i) { const unsigned _o = (nx) ? nofB[2 * (h) + _i] : cofB[2 * (h) + _i]; G_GLDS((gp) + _o, lds + (bufoff) + ldsw + _i * 8192); } } \
        else { _Pragma("unroll") for (int _i = 0; _i < 2; ++_i) G_GLDS((gp) + (size_t)(h) * hstepB + voffB[_i], lds + (bufoff) + ldsw + _i * 8192); } } while (0)
#define G_LDA(dst, b, h) do { _Pragma("unroll") for (int m = 0; m < 4; ++m) { const u32x4 _lo = *(const LAS u32x4*)(lds + G_SA(b, h) + aoff + m * 2048), _hi = *(const LAS u32x4*)(lds + G_SA(b, h) + aoff1 + m * 2048); dst[m] = (i32x8){(int)_lo.x, (int)_lo.y, (int)_lo.z, (int)_lo.w, (int)_hi.x, (int)_hi.y, (int)_hi.z, (int)_hi.w}; } } while (0)
#define G_LDB(dst, b, h) do { _Pragma("unroll") for (int n = 0; n < 2; ++n) { const u32x4 _lo = *(const LAS u32x4*)(lds + G_SB(b, h) + boff + n * 2048), _hi = *(const LAS u32x4*)(lds + G_SB(b, h) + boff1 + n * 2048); dst[n] = (i32x8){(int)_lo.x, (int)_lo.y, (int)_lo.z, (int)_lo.w, (int)_hi.x, (int)_hi.y, (int)_hi.z, (int)_hi.w}; } } while (0)
#define G_MMA(ai, bj, At, Bt) do { __builtin_amdgcn_s_setprio(1); _Pragma("unroll") for (int m = 0; m < 4; ++m) _Pragma("unroll") for (int n = 0; n < 2; ++n) \
        acc[ai][bj][m][n] = __builtin_amdgcn_mfma_scale_f32_16x16x128_f8f6f4(Bt[n], At[m], acc[ai][bj][m][n], 0, 0, 0, 0, 0, 0); __builtin_amdgcn_s_setprio(0); } while (0)
#define G_WAIT_V(n) asm volatile("s_waitcnt vmcnt(" #n ")" ::: "memory")
#define G_WAIT_L(n) asm volatile("s_waitcnt lgkmcnt(" #n ")" ::: "memory")
#define G_BAR __builtin_amdgcn_s_barrier()
#define G_SCHED __builtin_amdgcn_sched_barrier(0)
    typename S::U cur, nxt; int ui = 0;
    if (!sch.next(0, cur)) return;
    f32x4 acc[2][2][4][2];
#pragma unroll
    for (int a = 0; a < 2; ++a)
#pragma unroll
        for (int b = 0; b < 2; ++b)
#pragma unroll
            for (int m = 0; m < 4; ++m)
#pragma unroll
                for (int n = 0; n < 2; ++n) acc[a][b][m][n] = (f32x4){0.f, 0.f, 0.f, 0.f};
    i32x8 At[4], B0[2], B1[2];
    const char* cA = sch.baseA(cur); const char* cB = sch.baseB(cur);
    if constexpr (S::GA) {
#pragma unroll
        for (int j = 0; j < 4; ++j) { cofA[j] = sch.goffA(cur, (j >> 1) * 128 + R0 + (j & 1) * 64, C0); nofA[j] = cofA[j]; } }
    if constexpr (S::GB) {
#pragma unroll
        for (int j = 0; j < 4; ++j) { cofB[j] = sch.goffB(cur, (j >> 1) * 128 + RB0 + (j & 1) * 64, C0); nofB[j] = cofB[j]; } }
    G_STAGE_B(G_SB(0, 0), cB, 0, false); G_STAGE_B(G_SB(0, 1), cB, 1, false); G_STAGE_A(G_SA(0, 0), cA, 0, false); G_STAGE_A(G_SA(0, 1), cA, 1, false);
    if (wr == 1) G_BAR;
    G_WAIT_V(2); G_BAR;
    G_STAGE_B(G_SB(1, 0), cB + kstep, 0, false); G_STAGE_A(G_SA(1, 0), cA + kstep, 0, false); G_STAGE_B(G_SB(1, 1), cB + kstep, 1, false);
    G_WAIT_V(6); G_BAR;
    for (;;) {
        const bool has_next = sch.next(ui + 1, nxt);
        const char* nA = has_next ? sch.baseA(nxt) : cA; const char* nB = has_next ? sch.baseB(nxt) : cB;
        if constexpr (S::GA) { if (has_next) {
#pragma unroll
            for (int j = 0; j < 4; ++j) nofA[j] = sch.goffA(nxt, (j >> 1) * 128 + R0 + (j & 1) * 64, C0); } }
        if constexpr (S::GB) { if (has_next) {
#pragma unroll
            for (int j = 0; j < 4; ++j) nofB[j] = sch.goffB(nxt, (j >> 1) * 128 + RB0 + (j & 1) * 64, C0); } }
#pragma unroll 1
        for (int t = 0; t < nt; t += 2) {
            const bool last = (t == nt - 2);
            const char* a1 = cA + (size_t)(t + 1) * kstep;
            const char* a2 = last ? nA : cA + (size_t)(t + 2) * kstep; const char* b2 = last ? nB : cB + (size_t)(t + 2) * kstep;
            const char* a3 = a2 + kstep; const char* b3 = b2 + kstep;
            asm volatile("" : "+s"(a1), "+s"(a2), "+s"(a3), "+s"(b2), "+s"(b3));
            const bool post = (t == 0 && ui > 0);
#define G_WAIT_POST() do { if (post) { if constexpr (E::NVM == 8) G_WAIT_V(16); else if constexpr (E::NVM == 16) G_WAIT_V(24); else if constexpr (E::NVM == 32) G_WAIT_V(40); else G_WAIT_V(8); } else G_WAIT_V(8); } while (0)
            G_LDB(B0, 0, 0); G_LDB(B1, 0, 1); G_SCHED; G_LDA(At, 0, 0); if (!post) G_STAGE_A(G_SA(1, 1), a1, 1, false);
            G_WAIT_POST(); G_WAIT_L(0); G_BAR; G_MMA(0, 0, At, B0); G_MMA(0, 1, At, B1); G_BAR; G_SCHED;
            G_LDA(At, 0, 1); G_STAGE_B(G_SB(0, 0), b2, 0, last); G_STAGE_B(G_SB(0, 1), b2, 1, last); G_STAGE_A(G_SA(0, 0), a2, 0, last);
            G_WAIT_POST(); G_WAIT_L(0); G_BAR; G_MMA(1, 0, At, B0); G_MMA(1, 1, At, B1); G_BAR; G_SCHED;
            G_LDB(B0, 1, 0); G_LDB(B1, 1, 1); G_SCHED; G_LDA(At, 1, 0); G_STAGE_A(G_SA(0, 1), a2, 1, last);
            G_WAIT_POST(); G_WAIT_L(0); G_BAR; G_MMA(0, 0, At, B0); G_MMA(0, 1, At, B1); G_BAR; G_SCHED;
            G_LDA(At, 1, 1); G_STAGE_B(G_SB(1, 0), b3, 0, last); G_STAGE_B(G_SB(1, 1), b3, 1, last); G_STAGE_A(G_SA(1, 0), a3, 0, last);
            G_WAIT_V(8); G_WAIT_L(0); G_BAR; G_MMA(1, 0, At, B0); G_MMA(1, 1, At, B1); G_BAR; G_SCHED;
#undef G_WAIT_POST
        }
        if (wr == 0) G_BAR;
        if (has_next) { const char* n1 = nA + kstep; asm volatile("" : "+s"(n1)); G_STAGE_A(G_SA(1, 1), n1, 1, true); }
        { int tz = threadIdx.x; asm volatile("" : "+v"(tz));
          const int ewid = tz >> 6, el = tz & 63; epi(acc, cur, ewid >> 2, ewid & 3, el & 15, el >> 4); }
        if (!has_next) break;
#pragma unroll
        for (int a = 0; a < 2; ++a)
#pragma unroll
            for (int b = 0; b < 2; ++b)
#pragma unroll
                for (int m = 0; m < 4; ++m)
#pragma unroll
                    for (int n = 0; n < 2; ++n) acc[a][b][m][n] = (f32x4){0.f, 0.f, 0.f, 0.f};
        cur = nxt; cA = nA; cB = nB; ++ui;
        if constexpr (S::GA) {
#pragma unroll
            for (int j = 0; j < 4; ++j) cofA[j] = nofA[j]; }
        if constexpr (S::GB) {
#pragma unroll
            for (int j = 0; j < 4; ++j) cofB[j] = nofB[j]; }
        if (wr == 1) G_BAR;
    }
    G_WAIT_V(0);
    G_BAR;
#undef G_SA
#undef G_SB
#undef G_GLDS
#undef G_STAGE_A
#undef G_STAGE_B
#undef G_LDA
#undef G_LDB
#undef G_MMA
#undef G_WAIT_V
#undef G_WAIT_L
#undef G_BAR
#undef G_SCHED
}
#ifndef MK_FAST
#define MK_FAST 1
#endif
#if MK_FAST
#define GEMM_PHASE(lds, S, E) gemm_fast(lds, S, E)
#else
#define GEMM_PHASE(lds, S, E) gemm_simple(lds, S, E)
#endif


template <int ES, int NBJ, class PF>
__device__ __forceinline__ void epi_coalesced(LAS unsigned char* el, const PF& pf, unsigned char* gbase, size_t pitch, int wr, int wc, int fr, int fq) {
    constexpr int RB = 128 * NBJ * ES, SL = RB / 16, MS = (16384 / (RB * 32)) > 4 ? 4 : (16384 / (RB * 32)), RP = 32 * MS, RI = 64 / SL, SM = SL < 16 ? SL - 1 : 15;
    const int wave = wr * 4 + wc, lane = fq * 16 + fr;
#pragma unroll
    for (int ai = 0; ai < 2; ++ai)
#pragma unroll
        for (int mp = 0; mp < 4 / MS; ++mp) {
#pragma unroll
            for (int mm = 0; mm < MS; ++mm) { const int m = mp * MS + mm, lr = wr * (16 * MS) + mm * 16 + fr;
#pragma unroll
                for (int bj = 0; bj < NBJ; ++bj) { const int cb = (bj * 128 + wc * 32 + 8 * fq) * ES; LAS unsigned char* p = el + lr * RB + ((((cb >> 4) ^ (lr & SM))) << 4) + (cb & 15);
                    if constexpr (ES == 1) *(LAS u32x2*)p = pf.p8(ai, m, bj); else *(LAS u32x4*)p = pf.p16(ai, m, bj); } }
            LDS_WAIT(); __builtin_amdgcn_s_barrier(); asm volatile("" ::: "memory"); __builtin_amdgcn_sched_barrier(0);
#pragma unroll
            for (int j = 0; j < 2; ++j) { const int lrr = wave * (RP / 8) + j * RI + lane / SL, c = lane % SL;
                const u32x4 v = *(const LAS u32x4*)(el + lrr * RB + ((c ^ (lrr & SM)) << 4));
                const int grow = ai * 128 + (lrr / (16 * MS)) * 64 + (mp * MS + ((lrr >> 4) % MS)) * 16 + (lrr & 15);
                *(u32x4*)(gbase + (size_t)grow * pitch + c * 16) = v; }
            LDS_WAIT(); __builtin_amdgcn_s_barrier(); asm volatile("" ::: "memory"); __builtin_amdgcn_sched_barrier(0);
        }
}
#define ROWLOOP _Pragma("unroll") for (int ai = 0; ai < 2; ++ai) _Pragma("unroll") for (int m = 0; m < 4; ++m)
#define UROW (ai * 128 + wr * 64 + m * 16 + fr)
#define UCOL(bj, n) ((bj) * 128 + wc * 32 + (n) * 16 + 4 * fq)
#define UCOLP(bj) ((bj) * 128 + wc * 32 + 8 * fq)
__device__ __forceinline__ u32x4 pk8(const f32x4 a, const f32x4 b) { u32x4 w; w.x = pk2(a.x, a.y); w.y = pk2(a.z, a.w); w.z = pk2(b.x, b.y); w.w = pk2(b.z, b.w); return w; }
typedef f32x4 AccT[2][2][4][2];

struct UnitD { int pm, pn; };
template <bool PERM_> struct SchedDenseT {
    typedef UnitD U;
    static constexpr bool GA = false, GB = false, PERM = PERM_;
    const bf16* A; const bf16* Bt; int lda, ldb, Kk, nM, nN, vcu;
    __device__ __forceinline__ const char* baseA(const U& u) const { return (const char*)(A + (size_t)u.pm * 256 * lda); }
    __device__ __forceinline__ const char* baseB(const U& u) const { return (const char*)(Bt + (size_t)u.pn * 256 * ldb); }
    __device__ __forceinline__ bool next(int i, U& u) const { const int L = i * NWG + vcu; if (L >= nM * nN) return false; u.pm = L / nN; u.pn = L % nN; return true; }
    __device__ __forceinline__ int K(const U&) const { return Kk; }
    __device__ __forceinline__ const char* rowA(const U& u, int r) const { return (const char*)(A + (size_t)(u.pm * 256 + r) * lda); }
    __device__ __forceinline__ const char* rowB(const U& u, int r) const { return (const char*)(Bt + (size_t)(u.pn * 256 + r) * ldb); }
};
typedef SchedDenseT<false> SchedDense; typedef SchedDenseT<true> SchedDenseP;
struct SchedDense8 {
    typedef UnitD U;
    static constexpr bool GA = false, GB = false, PERM = true;
    const unsigned char* A; const unsigned char* Bt; int lda, ldb, Kk, nM, nN, vcu;
    __device__ __forceinline__ const char* baseA(const U& u) const { return (const char*)(A + (size_t)u.pm * 256 * lda); }
    __device__ __forceinline__ const char* baseB(const U& u) const { return (const char*)(Bt + (size_t)u.pn * 256 * ldb); }
    __device__ __forceinline__ bool next(int i, U& u) const { const int L = i * NWG + vcu; if (L >= nM * nN) return false; u.pm = L / nN; u.pn = L % nN; return true; }
};
struct EpiXZ {
    static constexpr int NVM = 16;
    bf16* XR; bf16* GG;
    __device__ __forceinline__ void operator()(const AccT& acc, const UnitD& u, int wr, int wc, int fr, int fq) const {
        const bool isg = u.pn >= 4; bf16* base = isg ? GG : XR; const int c0 = (u.pn & 3) * 256;
        ROWLOOP { bf16* rp = base + (size_t)(u.pm * 256 + UROW) * D + c0;
#pragma unroll
            for (int bj = 0; bj < 2; ++bj) { f32x4 v0 = acc[ai][bj][m][0] * 0.015625f, v1 = acc[ai][bj][m][1] * 0.015625f;
                if (isg) {
#pragma unroll
                    for (int j = 0; j < 4; ++j) { v0[j] = gelu_tanh(v0[j]); v1[j] = gelu_tanh(v1[j]); } }
                *(u32x4*)(rp + UCOLP(bj)) = pk8(v0, v1); } }
    }
};
struct EpiResF32 {
    static constexpr int NVM = 0;
    const float* R; float* O; int ldc;
    __device__ __forceinline__ void operator()(const AccT& acc, const UnitD& u, int wr, int wc, int fr, int fq) const {
        const size_t base = (size_t)(u.pm * 256 + wr * 64 + fr) * ldc + u.pn * 256;
        f32x4 cur[4], nxt[4];
#pragma unroll
        for (int q = 0; q < 4; ++q) cur[q] = *(const f32x4*)(R + base + UCOL(q >> 1, q & 1));
#pragma unroll
        for (int g = 0; g < 8; ++g) { const int ai = g >> 2, m = g & 3; const size_t ro = base + (size_t)(ai * 128 + m * 16) * ldc;
            if (g < 7) { const size_t rn = base + (size_t)(((g + 1) >> 2) * 128 + ((g + 1) & 3) * 16) * ldc;
#pragma unroll
                for (int q = 0; q < 4; ++q) nxt[q] = *(const f32x4*)(R + rn + UCOL(q >> 1, q & 1)); }
#pragma unroll
            for (int q = 0; q < 4; ++q) *(f32x4*)(O + ro + UCOL(q >> 1, q & 1)) = cur[q] * ALPHA + acc[ai][q >> 1][m][q & 1];
#pragma unroll
            for (int q = 0; q < 4; ++q) cur[q] = nxt[q]; }
    }
};
struct EpiF32 {
    static constexpr int NVM = 32;
    float* O; int ldc;
    __device__ __forceinline__ void operator()(const AccT& acc, const UnitD& u, int wr, int wc, int fr, int fq) const {
        ROWLOOP { const size_t ro = (size_t)(u.pm * 256 + UROW) * ldc + u.pn * 256;
#pragma unroll
            for (int bj = 0; bj < 2; ++bj)
#pragma unroll
                for (int n = 0; n < 2; ++n) *(f32x4*)(O + ro + UCOL(bj, n)) = acc[ai][bj][m][n]; }
    }
};

struct UnitG { int pm, blk, pn; };
struct SchedGate {
    typedef UnitG U;
    static constexpr bool GA = false, GB = false, PERM = true; static constexpr int Kk = 256, lda = D, ldb = 256;
    const bf16* XC; const bf16* WgT; int vcu;
    __device__ __forceinline__ const char* baseA(const U& u) const { return (const char*)(XC + (size_t)u.pm * 256 * D + u.blk * 256); }
    __device__ __forceinline__ const char* baseB(const U& u) const { return (const char*)(WgT + (size_t)(u.blk * 512 + u.pn * 256) * 256); }
    __device__ __forceinline__ bool next(int i, U& u) const { const int L = i * NWG + vcu; if (L >= 128 * 8) return false; u.pm = L >> 3; u.blk = (L >> 1) & 3; u.pn = L & 1; return true; }
    __device__ __forceinline__ int K(const U&) const { return 256; }
    __device__ __forceinline__ const char* rowA(const U& u, int r) const { return (const char*)(XC + (size_t)(u.pm * 256 + r) * D + u.blk * 256); }
    __device__ __forceinline__ const char* rowB(const U& u, int r) const { return (const char*)(WgT + (size_t)(u.blk * 512 + u.pn * 256 + r) * 256); }
};
struct EpiGate {
    static constexpr int NVM = 0;
    const bf16* XC; const float *ba, *bx, *lam; bf16* LA; bf16* UU;
    __device__ __forceinline__ void operator()(const AccT& acc, const UnitG& u, int wr, int wc, int fr, int fq) const {
        const int c0 = u.blk * 256 + u.pn * 128 + wc * 32 + 8 * fq;
        f32x4 vba[2], vbx[2], sp[2];
#pragma unroll
        for (int n = 0; n < 2; ++n) { vba[n] = *(const f32x4*)(ba + c0 + 4 * n); vbx[n] = *(const f32x4*)(bx + c0 + 4 * n); const f32x4 vl = *(const f32x4*)(lam + c0 + 4 * n);
#pragma unroll
            for (int j = 0; j < 4; ++j) { const float x = __expf(-vl[j]); sp[n][j] = 8.0f * x * (1.0f - x * (0.5f - x * (1.0f / 3.0f))); } }
        const size_t base = (size_t)(u.pm * 256 + wr * 64 + fr) * D + c0;
        u32x4 xw = *(const u32x4*)(XC + base);
#pragma unroll
        for (int g = 0; g < 8; ++g) { const int ai = g >> 2, m = g & 3; const size_t ro = base + (size_t)(ai * 128 + m * 16) * D;
            u32x4 xn = xw; if (g < 7) xn = *(const u32x4*)(XC + base + (size_t)(((g + 1) >> 2) * 128 + ((g + 1) & 3) * 16) * D);
            const float xc[8] = {bf_lo(xw.x), bf_hi(xw.x), bf_lo(xw.y), bf_hi(xw.y), bf_lo(xw.z), bf_hi(xw.z), bf_lo(xw.w), bf_hi(xw.w)};
            f32x4 la[2], uu[2];
#pragma unroll
            for (int n = 0; n < 2; ++n) { const f32x4 ga = acc[ai][0][m][n] + vba[n], gx = acc[ai][1][m][n] + vbx[n];
#pragma unroll
                for (int j = 0; j < 4; ++j) { const float r = sigmoidf_(ga[j]), ig = sigmoidf_(gx[j]); const float l = -r * sp[n][j]; la[n][j] = l;
                    const float mult = sqrtf(fmaxf(1.0f - __expf(2.0f * l), 0.f)); uu[n][j] = mult * ig * xc[4 * n + j]; } }
            *(u32x4*)(LA + ro) = pk8(la[0], la[1]); *(u32x4*)(UU + ro) = pk8(uu[0], uu[1]); xw = xn; }
    }
};

struct UnitE { int rb, pn, e, ti; };
struct SchedG1 {
    typedef UnitE U;
    static constexpr bool GA = true, GB = false, PERM = true; static constexpr int Kk = D, lda = D, ldb = D;
    const unsigned char* X; const unsigned char* W13T; const int* ROWA; const int* BLKE; int nrbt, vcu; int ev; const LAS unsigned* tab;
    __device__ __forceinline__ const char* baseA(const U&) const { return (const char*)X; }
    __device__ __forceinline__ const char* baseB(const U& u) const { return (const char*)(W13T + ((size_t)u.e * 512 + u.pn * 256) * D); }
    __device__ __forceinline__ unsigned goffA(const U& u, int r, int C) const { return tab[u.ti * 256 + r] + (unsigned)C * 2u; }
    __device__ __forceinline__ unsigned goffB(const U&, int, int) const { return 0u; }
    __device__ __forceinline__ bool next(int i, U& u) const { const int L = i * NWG + vcu; const int rb = L >> 1; if (rb >= nrbt) return false; u.rb = rb; u.pn = L & 1; u.ti = i; u.e = __builtin_amdgcn_readlane(ev, i); return true; }
    __device__ __forceinline__ int K(const U&) const { return D; }
};
struct PFSwiGLU { const AccT& acc;
    __device__ __forceinline__ u32x2 p8(int ai, int m, int) const { f32x4 h0, h1;
#pragma unroll
        for (int j = 0; j < 4; ++j) { const float a0 = acc[ai][0][m][0][j] * 0.015625f, a1 = acc[ai][0][m][1][j] * 0.015625f; h0[j] = a0 * sigmoidf_(a0) * (acc[ai][1][m][0][j] * 0.015625f); h1[j] = a1 * sigmoidf_(a1) * (acc[ai][1][m][1][j] * 0.015625f); }
        int t0 = __builtin_amdgcn_cvt_pk_fp8_f32(h0.x, h0.y, 0, false); t0 = __builtin_amdgcn_cvt_pk_fp8_f32(h0.z, h0.w, t0, true);
        int t1 = __builtin_amdgcn_cvt_pk_fp8_f32(h1.x, h1.y, 0, false); t1 = __builtin_amdgcn_cvt_pk_fp8_f32(h1.z, h1.w, t1, true); u32x2 w; w.x = (unsigned)t0; w.y = (unsigned)t1; return w; }
    __device__ __forceinline__ u32x4 p16(int, int, int) const { return (u32x4){0u, 0u, 0u, 0u}; } };
struct EpiSwiGLU {
    static constexpr int NVM = 0; static constexpr bool DEFER = false; static constexpr int soff(int) { return 0; }
    unsigned char* HID; LAS unsigned char* el;
    __device__ __forceinline__ void operator()(const AccT& acc, const UnitE& u, int wr, int wc, int fr, int fq) const {
        epi_coalesced<1, 1>(el, PFSwiGLU{acc}, HID + ((size_t)u.rb * 256) * DE + u.pn * 128, DE, wr, wc, fr, fq);
    }
};
struct SchedG2 {
    typedef UnitE U;
    static constexpr bool GA = false, GB = false, PERM = true;
    const unsigned char* HID; const unsigned char* W2T; const int* BLKE; int nrbt, vcu; int ev; int Kk, lda, ldb;
    __device__ __forceinline__ const char* baseA(const U& u) const { return (const char*)(HID + (size_t)u.rb * 256 * DE); }
    __device__ __forceinline__ const char* baseB(const U& u) const { return (const char*)(W2T + ((size_t)u.e * D + u.pn * 256) * DE); }
    __device__ __forceinline__ bool next(int i, U& u) const { const int L = i * NWG + vcu; const int rb = L >> 2; if (rb >= nrbt) return false; u.rb = rb; u.pn = L & 3; u.ti = i; u.e = __builtin_amdgcn_readlane(ev, i); return true; }
    __device__ __forceinline__ int K(const U&) const { return DE; }
};
struct PFScatter { const AccT& acc;
    __device__ __forceinline__ u32x2 p8(int ai, int m, int bj) const { const f32x4 v0 = acc[ai][bj][m][0] * 0.25f, v1 = acc[ai][bj][m][1] * 0.25f;
        int t0 = __builtin_amdgcn_cvt_pk_fp8_f32(v0.x, v0.y, 0, false); t0 = __builtin_amdgcn_cvt_pk_fp8_f32(v0.z, v0.w, t0, true);
        int t1 = __builtin_amdgcn_cvt_pk_fp8_f32(v1.x, v1.y, 0, false); t1 = __builtin_amdgcn_cvt_pk_fp8_f32(v1.z, v1.w, t1, true); u32x2 w; w.x = (unsigned)t0; w.y = (unsigned)t1; return w; }
    __device__ __forceinline__ u32x4 p16(int, int, int) const { return (u32x4){0u, 0u, 0u, 0u}; } };
struct EpiScatter {
    static constexpr int NVM = 8; static constexpr bool DEFER = false; static constexpr int soff(int) { return 0; }
    bf16* YA; int dry; LAS unsigned char* el;
    __device__ __forceinline__ void operator()(const AccT& acc, const UnitE& u, int wr, int wc, int fr, int fq) const {
        epi_coalesced<1, 2>(el, PFScatter{acc}, (unsigned char*)YA + ((size_t)u.rb * 256) * D + u.pn * 256, D, wr, wc, fr, fq);
    }
};

__device__ __forceinline__ int rho_to_tok(int rho, int g) { const int sh = 14 - 2 * g; const int rp = rho & 16383; return (rho & ~16383) + (rp >> sh) + ((rp & ((1 << sh) - 1)) << (2 * g)); }
__device__ __forceinline__ int tok_to_rho(int t, int g) { const int sh = 14 - 2 * g; const int tp = t & 16383; return (t & ~16383) + ((tp & ((1 << (2 * g)) - 1)) << sh) + (tp >> (2 * g)); }
struct UnitQ { int type, g, pm, pn; };
struct SchedQK {
    typedef UnitQ U;
    static constexpr bool GA = false, GB = false, PERM = true; static constexpr int Kk = D, ldb = D;
    const unsigned char* X; const unsigned char* WqkT; int g, lda, vcu;
    __device__ __forceinline__ bool next(int i, U& u) const { const int L = i * NWG + vcu; if (L >= 512) return false; u.type = 0; u.g = g; u.pm = L >> 2; u.pn = L & 3; return true; }
    __device__ __forceinline__ int K(const U&) const { return D; }
    __device__ __forceinline__ const char* baseA(const U& u) const { return (const char*)(X + (size_t)rho_to_tok(u.pm * 256, g) * D); }
    __device__ __forceinline__ const char* baseB(const U& u) const { return (const char*)(WqkT + ((size_t)g * 1024 + u.pn * 256) * D); }
    __device__ __forceinline__ const char* rowA(const U& u, int r) const { return (const char*)(X + (size_t)rho_to_tok(u.pm * 256 + r, g) * D); }
    __device__ __forceinline__ const char* rowB(const U& u, int r) const { return (const char*)(WqkT + ((size_t)g * 1024 + u.pn * 256 + r) * D); }
};
struct SchedVT {
    typedef UnitQ U;
    static constexpr bool GA = false, GB = false, PERM = true; static constexpr int Kk = D, lda = D;
    const unsigned char* X; const unsigned char* WvT; int g, ldb, vcu;
    __device__ __forceinline__ bool next(int i, U& u) const { const int L = i * NWG + vcu; if (L >= 256) return false; u.type = 1; u.g = g; u.pn = L >> 1; u.pm = L & 1; return true; }
    __device__ __forceinline__ int K(const U&) const { return D; }
    __device__ __forceinline__ const char* baseA(const U& u) const { return (const char*)(WvT + ((size_t)g * 512 + u.pm * 256) * D); }
    __device__ __forceinline__ const char* baseB(const U& u) const { return (const char*)(X + (size_t)rho_to_tok(u.pn * 256, g) * D); }
    __device__ __forceinline__ const char* rowA(const U& u, int r) const { return (const char*)(WvT + ((size_t)g * 512 + u.pm * 256 + r) * D); }
    __device__ __forceinline__ const char* rowB(const U& u, int r) const { return (const char*)(X + (size_t)rho_to_tok(u.pn * 256 + r, g) * D); }
};
struct PFScaled { const AccT& acc; float sc;
    __device__ __forceinline__ u32x2 p8(int, int, int) const { return (u32x2){0u, 0u}; }
    __device__ __forceinline__ u32x4 p16(int ai, int m, int bj) const { return pk8(acc[ai][bj][m][0] * sc, acc[ai][bj][m][1] * sc); } };
struct EpiQKV {
    static constexpr int NVM = 16; static constexpr bool DEFER = false; static constexpr int soff(int) { return 0; }
    bf16* QK; bf16* VT; LAS unsigned char* el;
    __device__ __forceinline__ void operator()(const AccT& acc, const UnitQ& u, int wr, int wc, int fr, int fq) const {
        bf16* base; size_t ldc;
        if (u.type == 0) { base = QK + (size_t)u.g * M * 1024; ldc = 1024; } else { base = VT + (size_t)u.g * 512 * M; ldc = M; }
        epi_coalesced<2, 2>(el, PFScaled{acc, 0.015625f}, (unsigned char*)(base + (size_t)(u.pm * 256) * ldc + u.pn * 256), ldc * 2, wr, wc, fr, fq);
    }
};

__device__ __forceinline__ void tr_item(const float* src, int spitch, bf16* dst, int dpitch, LAS float* scr, int lane) {
#pragma unroll 4
    for (int i = 0; i < 16; ++i) { const int k = 4 * i + (lane >> 4), n4 = (lane & 15) * 4; const f32x4 v = *(const f32x4*)(src + (size_t)k * spitch + n4);
        LAS float* s = scr + k * 65 + n4; s[0] = v.x; s[1] = v.y; s[2] = v.z; s[3] = v.w; }
    LDS_WAIT(); asm volatile("" ::: "memory");
    const int c = lane & 7;
#pragma unroll
    for (int j = 0; j < 8; ++j) { const int n = 8 * j + (lane >> 3); const LAS float* s = scr + (8 * c) * 65 + n;
        u32x4 o; o.x = pk2(s[0], s[65]); o.y = pk2(s[2 * 65], s[3 * 65]); o.z = pk2(s[4 * 65], s[5 * 65]); o.w = pk2(s[6 * 65], s[7 * 65]);
        *(u32x4*)(dst + (size_t)n * dpitch + 8 * c) = o; }
    LDS_WAIT(); asm volatile("" ::: "memory");
}
__device__ __forceinline__ void tr_item8(const float* src, int spitch, unsigned char* dst, int dpitch, LAS float* scr, int lane) {
#pragma unroll 4
    for (int i = 0; i < 16; ++i) { const int k = 4 * i + (lane >> 4), n4 = (lane & 15) * 4; const f32x4 v = *(const f32x4*)(src + (size_t)k * spitch + n4);
        LAS float* s = scr + k * 65 + n4; s[0] = v.x; s[1] = v.y; s[2] = v.z; s[3] = v.w; }
    LDS_WAIT(); asm volatile("" ::: "memory");
    const int c = lane & 7;
#pragma unroll
    for (int j = 0; j < 8; ++j) { const int n = 8 * j + (lane >> 3); const LAS float* s = scr + (8 * c) * 65 + n;
        int t0 = __builtin_amdgcn_cvt_pk_fp8_f32(s[0] * 64.f, s[65] * 64.f, 0, false); t0 = __builtin_amdgcn_cvt_pk_fp8_f32(s[2 * 65] * 64.f, s[3 * 65] * 64.f, t0, true);
        int t1 = __builtin_amdgcn_cvt_pk_fp8_f32(s[4 * 65] * 64.f, s[5 * 65] * 64.f, 0, false); t1 = __builtin_amdgcn_cvt_pk_fp8_f32(s[6 * 65] * 64.f, s[7 * 65] * 64.f, t1, true);
        u32x2 o; o.x = (unsigned)t0; o.y = (unsigned)t1; *(u32x2*)(dst + (size_t)n * dpitch + 8 * c) = o; }
    LDS_WAIT(); asm volatile("" ::: "memory");
}
template <class RowMap>
__device__ __forceinline__ void tr_matrix(Frame& F, const float* W, int K, int N, bf16* WT, int dpitch, RowMap drow) {
    LAS float* scr = (LAS float*)(F.lds + F.wave * 16640);
    const int nkb = K / 64, nnb = N / 64;
    for (int it = F.vcu * NWAVES + F.wave; it < nkb * nnb; it += NGW) { const int kb = it / nnb, nb = it % nnb;
        tr_item(W + (size_t)(kb * 64) * N + nb * 64, N, WT + (size_t)drow(nb * 64) * dpitch + kb * 64, dpitch, scr, F.lane); }
}
template <class RowMap>
__device__ __forceinline__ void tr_matrix8(Frame& F, const float* W, int K, int N, unsigned char* WT, int dpitch, RowMap drow) {
    LAS float* scr = (LAS float*)(F.lds + F.wave * 16640);
    const int nkb = K / 64, nnb = N / 64;
    for (int it = F.vcu * NWAVES + F.wave; it < nkb * nnb; it += NGW) { const int kb = it / nnb, nb = it % nnb;
        tr_item8(W + (size_t)(kb * 64) * N + nb * 64, N, WT + (size_t)drow(nb * 64) * dpitch + kb * 64, dpitch, scr, F.lane); }
}
__device__ __forceinline__ void cv_src(int it, const float* w1, const float* w3, const float* w2, const float* s1, const float* s3, const float* s2, const float*& src, int& spitch) {
    const int e = it / 192, r = it % 192, which = r >> 6, tile = r & 63;
    if (which < 2) { const float* W = (e < 256) ? (which == 0 ? w1 : w3) + (size_t)e * (size_t)(D * DE) : (which == 0 ? s1 : s3); src = W + (size_t)((tile >> 2) * 64) * DE + (tile & 3) * 64; spitch = DE; }
    else { const float* W = (e < 256) ? w2 + (size_t)e * (size_t)(DE * D) : s2; src = W + (size_t)((tile >> 4) * 64) * D + (tile & 15) * 64; spitch = D; }
}
__device__ __forceinline__ void convert_experts(Frame& F, const float* w1, const float* w3, const float* w2, const float* s1, const float* s3, const float* s2, int layer, int part, int nparts) {
    LAS float* scr = (LAS float*)(F.lds + F.wave * 16640);
    unsigned char* W13T = WSP(unsigned char, WS_W13) + (size_t)layer * W13_LB; unsigned char* W2T = WSP(unsigned char, WS_W2) + (size_t)layer * W2_LB;
    const int lane = F.lane; const int NTOT = 257 * 192; const int it0 = (int)((long)NTOT * part / nparts), NIT = (int)((long)NTOT * (part + 1) / nparts);
    f32x4 cur[16], nxt[16];
    int it = it0 + F.vcu * NWAVES + F.wave;
    if (it < NIT) { const float* src; int sp; cv_src(it, w1, w3, w2, s1, s3, s2, src, sp);
#pragma unroll
        for (int i = 0; i < 16; ++i) cur[i] = __builtin_nontemporal_load((const f32x4*)(src + (size_t)(4 * i + (lane >> 4)) * sp + (lane & 15) * 4)); }
#pragma unroll 1
    for (; it < NIT; it += NGW) {
        const int itn = it + NGW;
        if (itn < NIT) { const float* src; int sp; cv_src(itn, w1, w3, w2, s1, s3, s2, src, sp);
#pragma unroll
            for (int i = 0; i < 16; ++i) nxt[i] = __builtin_nontemporal_load((const f32x4*)(src + (size_t)(4 * i + (lane >> 4)) * sp + (lane & 15) * 4)); }
#pragma unroll
        for (int i = 0; i < 16; ++i) { const int k = 4 * i + (lane >> 4), n4 = (lane & 15) * 4; LAS float* s = scr + k * 65 + n4; s[0] = cur[i].x; s[1] = cur[i].y; s[2] = cur[i].z; s[3] = cur[i].w; }
        LDS_WAIT(); asm volatile("" ::: "memory");
        const int e = it / 192, r = it % 192, which = r >> 6, tile = r & 63, c = lane & 7;
        if (which < 2) { const int kb = tile >> 2, nb = tile & 3; const int drow = (nb >> 1) * 256 + which * 128 + (nb & 1) * 64; unsigned char* dst = W13T + ((size_t)e * 512 + drow) * D + kb * 64;
#pragma unroll
            for (int j = 0; j < 8; ++j) { const int n = 8 * j + (lane >> 3); const LAS float* s = scr + (8 * c) * 65 + n;
                int t0 = __builtin_amdgcn_cvt_pk_fp8_f32(s[0] * 64.f, s[65] * 64.f, 0, false); t0 = __builtin_amdgcn_cvt_pk_fp8_f32(s[2 * 65] * 64.f, s[3 * 65] * 64.f, t0, true);
                int t1 = __builtin_amdgcn_cvt_pk_fp8_f32(s[4 * 65] * 64.f, s[5 * 65] * 64.f, 0, false); t1 = __builtin_amdgcn_cvt_pk_fp8_f32(s[6 * 65] * 64.f, s[7 * 65] * 64.f, t1, true);
                u32x2 o; o.x = (unsigned)t0; o.y = (unsigned)t1; *(u32x2*)(dst + (size_t)n * D + 8 * c) = o; } }
        else { const int kb = tile >> 4, nb = tile & 15; unsigned char* dst = W2T + ((size_t)e * D + nb * 64) * DE + kb * 64;
#pragma unroll
            for (int j = 0; j < 8; ++j) { const int n = 8 * j + (lane >> 3); const LAS float* s = scr + (8 * c) * 65 + n;
                int t0 = __builtin_amdgcn_cvt_pk_fp8_f32(s[0] * 64.f, s[65] * 64.f, 0, false); t0 = __builtin_amdgcn_cvt_pk_fp8_f32(s[2 * 65] * 64.f, s[3 * 65] * 64.f, t0, true);
                int t1 = __builtin_amdgcn_cvt_pk_fp8_f32(s[4 * 65] * 64.f, s[5 * 65] * 64.f, 0, false); t1 = __builtin_amdgcn_cvt_pk_fp8_f32(s[6 * 65] * 64.f, s[7 * 65] * 64.f, t1, true);
                u32x2 o; o.x = (unsigned)t0; o.y = (unsigned)t1; *(u32x2*)(dst + (size_t)n * DE + 8 * c) = o; } }
        LDS_WAIT(); asm volatile("" ::: "memory");
#pragma unroll
        for (int i = 0; i < 16; ++i) cur[i] = nxt[i];
    }
}
struct MapId { __device__ int operator()(int n0) const { return n0; } };
struct MapGate { int which; __device__ int operator()(int n0) const { return (n0 >> 7) * 256 + which * 128 + (n0 & 127); } };
struct MapQ { __device__ int operator()(int n0) const { return (n0 >> 9) * 1024 + (n0 & 511); } };
struct MapKV { __device__ int operator()(int n0) const { return n0 < 1536 ? (n0 >> 9) * 1024 + 512 + (n0 & 511) : 3072 + (n0 - 1536); } };

__device__ __forceinline__ void p0_prologue(Frame& F, const Args& A) {
    { const float* x = A.in[0]; unsigned char* XQ = WSP(unsigned char, WS_RA + RA_XB);
      for (size_t i = (size_t)F.vcu * NTHR + F.tid; i < (size_t)M * D / 8; i += NGT) { const f32x4 a = *(const f32x4*)(x + i * 8), b = *(const f32x4*)(x + i * 8 + 4);
          int t0 = __builtin_amdgcn_cvt_pk_fp8_f32(a.x, a.y, 0, false); t0 = __builtin_amdgcn_cvt_pk_fp8_f32(a.z, a.w, t0, true);
          int t1 = __builtin_amdgcn_cvt_pk_fp8_f32(b.x, b.y, 0, false); t1 = __builtin_amdgcn_cvt_pk_fp8_f32(b.z, b.w, t1, true);
          u32x2 o; o.x = (unsigned)t0; o.y = (unsigned)t1; *(u32x2*)(XQ + i * 8) = o; } }
    tr_matrix8(F, A.in[1], D, 2048, WSP(unsigned char, WS_WIN), D, MapId());
    for (int b = 0; b < 4; ++b) { tr_matrix(F, A.in[4] + b * 65536, 256, 256, WSP(bf16, WS_WG) + (size_t)b * 512 * 256, 256, MapGate{0});
                                  tr_matrix(F, A.in[6] + b * 65536, 256, 256, WSP(bf16, WS_WG) + (size_t)b * 512 * 256, 256, MapGate{1}); }
    tr_matrix(F, A.in[9], D, D, WSP(bf16, WS_WOUT), D, MapId());
    tr_matrix8(F, A.in[11], D, QW, WSP(unsigned char, WS_WQK), D, MapQ());
    tr_matrix8(F, A.in[10], D, 2 * QW, WSP(unsigned char, WS_WQK), D, MapKV());
    tr_matrix(F, A.in[12], OW, D, WSP(bf16, WS_WO), OW, MapId());
    for (int l = 0; l < 2; ++l) tr_matrix(F, A.in[13] + (size_t)l * D * NE, D, NE, WSP(bf16, WS_WR) + (size_t)l * NE * D, D, MapId());
}
static_assert(WS_WV == WS_WQK + (size_t)3072 * 1024 * 2, "WvT must follow WqkT");

__device__ __forceinline__ void ln_store(f32x4 (&v)[4], const float* g, const float* b, float* of, bf16* ob, int lane, unsigned char* oq = nullptr) {
    float s = 0.f;
#pragma unroll
    for (int j = 0; j < 4; ++j) s += (v[j].x + v[j].y) + (v[j].z + v[j].w);
    const float mean = wave_sum(s) * (1.f / D); float s2 = 0.f;
#pragma unroll
    for (int j = 0; j < 4; ++j) { v[j] = v[j] - mean; s2 += (v[j].x * v[j].x + v[j].y * v[j].y) + (v[j].z * v[j].z + v[j].w * v[j].w); }
    const float rstd = 1.f / sqrtf(wave_sum(s2) * (1.f / D) + LN_EPS);
#pragma unroll
    for (int j = 0; j < 4; ++j) { const int c = 4 * lane + 256 * j; const f32x4 gg = *(const f32x4*)(g + c), bb = *(const f32x4*)(b + c); const f32x4 y = v[j] * rstd * gg + bb;
        if (of) *(f32x4*)(of + c) = y;
        if (ob) { u32x2 w; w.x = pk2(y.x, y.y); w.y = pk2(y.z, y.w); *(u32x2*)(ob + c) = w; }
        if (oq) { int t = __builtin_amdgcn_cvt_pk_fp8_f32(y.x, y.y, 0, false); t = __builtin_amdgcn_cvt_pk_fp8_f32(y.z, y.w, t, true); *(unsigned*)(oq + c) = (unsigned)t; } }
}

__device__ __forceinline__ int moe_unit_experts(Frame& F, const int* BLKE, int nrbt, int shift) { const int L = F.lane * NWG + F.vcu; const int rb = L >> shift; return rb < nrbt ? BLKE[rb] : 0; }
__device__ __forceinline__ const LAS unsigned* moe_row_table(Frame& F, const int* ROWA, int nrbt) {
    LAS unsigned* tab = (LAS unsigned*)(F.lds + LDS_TAB);
    if (F.tid < 256) { int a[15];
#pragma unroll
        for (int i = 0; i < 15; ++i) { const int rb = (i * NWG + F.vcu) >> 1; a[i] = rb < nrbt ? ROWA[rb * 256 + F.tid] : -1; }
#pragma unroll
        for (int i = 0; i < 15; ++i) { const int tok = a[i] < 0 ? 0 : (a[i] < 8 * M ? (a[i] >> 3) : a[i] - 8 * M); tab[i * 256 + F.tid] = (unsigned)tok * (unsigned)D; } }
    __syncthreads();
    return tab;
}
__device__ __forceinline__ void p_conv(Frame& F, const float* cw, const float* cb) {
    const bf16* XR = WSP(bf16, WS_RA + RA_XR); bf16* XC = WSP(bf16, WS_RA + RA_XC);
    for (int i = F.vcu * NTHR + F.tid; i < M * (D / 8); i += NGT) { const int t = i >> 7, c = (i & 127) * 8; const int ts = t & (SEQ - 1);
        float a[8];
#pragma unroll
        for (int q = 0; q < 8; ++q) a[q] = cb[c + q];
#pragma unroll
        for (int j = 0; j < 4; ++j) { if (ts - 3 + j >= 0) { const u32x4 w = *(const u32x4*)(XR + (size_t)(t - 3 + j) * D + c); const float* wj = cw + j * D + c;
            a[0] += wj[0] * bf_lo(w.x); a[1] += wj[1] * bf_hi(w.x); a[2] += wj[2] * bf_lo(w.y); a[3] += wj[3] * bf_hi(w.y);
            a[4] += wj[4] * bf_lo(w.z); a[5] += wj[5] * bf_hi(w.z); a[6] += wj[6] * bf_lo(w.w); a[7] += wj[7] * bf_hi(w.w); } }
        u32x4 o; o.x = pk2(a[0], a[1]); o.y = pk2(a[2], a[3]); o.z = pk2(a[4], a[5]); o.w = pk2(a[6], a[7]); *(u32x4*)(XC + (size_t)t * D + c) = o; }
}
constexpr int CH = 64, NCH = SEQ / CH;
__device__ __forceinline__ void p_scan1(Frame& F) {
    const bf16* LA = WSP(bf16, WS_RA + RA_LA); const bf16* UU = WSP(bf16, WS_RA + RA_U); float* CP = WSP(float, WS_CHP); float* CHh = WSP(float, WS_CHH);
    for (int i = F.vcu * NTHR + F.tid; i < BATCH * NCH * (D / 4); i += NGT) { const int c4 = (i & 255) * 4, ck = (i >> 8) & (NCH - 1), b = i >> 16;
        const size_t r0 = ((size_t)b * SEQ + (size_t)ck * CH) * D + c4; f32x4 h = {0.f, 0.f, 0.f, 0.f}, sl = {0.f, 0.f, 0.f, 0.f};
#pragma unroll 8
        for (int t = 0; t < CH; ++t) { const u32x2 lw = *(const u32x2*)(LA + r0 + (size_t)t * D), uw = *(const u32x2*)(UU + r0 + (size_t)t * D);
            const f32x4 la = {bf_lo(lw.x), bf_hi(lw.x), bf_lo(lw.y), bf_hi(lw.y)}, u = {bf_lo(uw.x), bf_hi(uw.x), bf_lo(uw.y), bf_hi(uw.y)};
#pragma unroll
            for (int j = 0; j < 4; ++j) { h[j] = __expf(la[j]) * h[j] + u[j]; sl[j] += la[j]; } }
#pragma unroll
        for (int j = 0; j < 4; ++j) { const size_t o = ((size_t)b * D + c4 + j) * NCH + ck; CP[o] = __expf(sl[j]); CHh[o] = h[j]; } }
}
__device__ __forceinline__ void p_scan2(Frame& F) {
    const float* CP = WSP(float, WS_CHP); const float* CHh = WSP(float, WS_CHH); float* CIN = WSP(float, WS_CIN);
    for (int s = F.vcu * NWAVES + F.wave; s < BATCH * D; s += NGW) { const size_t o = (size_t)s * NCH + 4 * F.lane;
        const f32x4 p4 = *(const f32x4*)(CP + o), h4 = *(const f32x4*)(CHh + o);
        float p = p4.x, h = h4.x; h = p4.y * h + h4.y; p *= p4.y; h = p4.z * h + h4.z; p *= p4.z; h = p4.w * h + h4.w; p *= p4.w;
#pragma unroll
        for (int off = 1; off < 64; off <<= 1) { const float pp = __shfl_up(p, off), hp = __shfl_up(h, off); if (F.lane >= off) { h = p * hp + h; p = pp * p; } }
        float c0 = __shfl_up(h, 1); if (F.lane == 0) c0 = 0.f;
        f32x4 ci; ci.x = c0; ci.y = p4.x * ci.x + h4.x; ci.z = p4.y * ci.y + h4.y; ci.w = p4.z * ci.z + h4.z;
        *(f32x4*)(CIN + o) = ci; }
}
__device__ __forceinline__ void p_scan3(Frame& F) {
    const bf16* LA = WSP(bf16, WS_RA + RA_LA); const bf16* UU = WSP(bf16, WS_RA + RA_U); const float* CIN = WSP(float, WS_CIN);
    const bf16* GG = WSP(bf16, WS_RA + RA_GG); bf16* YB = WSP(bf16, WS_RA + RA_YB);
    for (int i = F.vcu * NTHR + F.tid; i < BATCH * NCH * (D / 4); i += NGT) { const int c4 = (i & 255) * 4, ck = (i >> 8) & (NCH - 1), b = i >> 16;
        const size_t r0 = ((size_t)b * SEQ + (size_t)ck * CH) * D + c4; f32x4 h;
#pragma unroll
        for (int j = 0; j < 4; ++j) h[j] = CIN[((size_t)b * D + c4 + j) * NCH + ck];
#pragma unroll 1
        for (int t0 = 0; t0 < CH; t0 += 8) { u32x2 lw[8], uw[8], gw[8];
#pragma unroll
            for (int k = 0; k < 8; ++k) { const size_t o = r0 + (size_t)(t0 + k) * D; lw[k] = *(const u32x2*)(LA + o); uw[k] = *(const u32x2*)(UU + o); gw[k] = *(const u32x2*)(GG + o); }
#pragma unroll
            for (int k = 0; k < 8; ++k) { const f32x4 la = {bf_lo(lw[k].x), bf_hi(lw[k].x), bf_lo(lw[k].y), bf_hi(lw[k].y)}, u = {bf_lo(uw[k].x), bf_hi(uw[k].x), bf_lo(uw[k].y), bf_hi(uw[k].y)};
#pragma unroll
                for (int j = 0; j < 4; ++j) h[j] = __expf(la[j]) * h[j] + u[j];
                u32x2 o; o.x = pk2(h.x * bf_lo(gw[k].x), h.y * bf_hi(gw[k].x)); o.y = pk2(h.z * bf_lo(gw[k].y), h.w * bf_hi(gw[k].y)); *(u32x2*)(YB + r0 + (size_t)(t0 + k) * D) = o; } } }
}
__device__ __forceinline__ void p_ln(Frame& F, const float* V, const float* g, const float* b, float* Hf, bf16* Hb) {
    unsigned char* Hq = WSP(unsigned char, WS_HQ);
    for (int r = F.vcu * NWAVES + F.wave; r < M; r += NGW) { const f32x4* xr = (const f32x4*)(V + (size_t)r * D) + F.lane; f32x4 v[4];
#pragma unroll
        for (int j = 0; j < 4; ++j) v[j] = xr[64 * j];
        ln_store(v, g, b, Hf + (size_t)r * D, Hb + (size_t)r * D, F.lane, Hq + (size_t)r * D); }
}
template <int CTRL> __device__ __forceinline__ float dppf(float x) { return __builtin_bit_cast(float, __builtin_amdgcn_mov_dpp(__builtin_bit_cast(int, x), CTRL, 0xF, 0xF, true)); }
template <int CTRL> __device__ __forceinline__ unsigned dppu(unsigned x) { return (unsigned)__builtin_amdgcn_mov_dpp((int)x, CTRL, 0xF, 0xF, true); }
__device__ __forceinline__ float rdlane_f(float x, int l) { return __builtin_bit_cast(float, __builtin_amdgcn_readlane(__builtin_bit_cast(int, x), l)); }
__device__ __forceinline__ void p_route(Frame& F, const float* bias) {
    const float* LG = WSP(float, WS_LOGITS); int* TOPI = WSP(int, WS_TOPI); float* GATE = WSP(float, WS_GATE); int* HIST = WSP(int, WS_HIST);
    LAS int* hist = (LAS int*)F.lds; const int lane = F.lane;
    if (F.tid < 256) hist[F.tid] = 0;
    __syncthreads();
    const f32x4 bv = *(const f32x4*)(bias + 4 * lane);
#pragma unroll 2
    for (int j = 0; j < 16; ++j) { const int t = F.vcu * 128 + F.wave * 16 + j;
        const f32x4 z = *(const f32x4*)(LG + (size_t)t * NE + 4 * lane);
        const float s0 = sigmoidf_(z.x), s1 = sigmoidf_(z.y), s2 = sigmoidf_(z.z), s3 = sigmoidf_(z.w);
        const float v0 = s0 + bv.x, v1 = s1 + bv.y, v2 = s2 + bv.z, v3 = s3 + bv.w;
        float m1, m2; { const float a = fmaxf(v0, v1), b = fminf(v0, v1), c = fmaxf(v2, v3), d = fminf(v2, v3); m1 = fmaxf(a, c); m2 = fmaxf(fminf(a, c), fmaxf(b, d)); }
        { float o1 = dppf<0xB1>(m1), o2 = dppf<0xB1>(m2); float n1 = fmaxf(m1, o1), n2 = fmaxf(fminf(m1, o1), fmaxf(m2, o2)); m1 = n1; m2 = n2;
          o1 = dppf<0x4E>(m1); o2 = dppf<0x4E>(m2); n1 = fmaxf(m1, o1); n2 = fmaxf(fminf(m1, o1), fmaxf(m2, o2)); m1 = n1; m2 = n2;
          o1 = dppf<0x141>(m1); o2 = dppf<0x141>(m2); n1 = fmaxf(m1, o1); n2 = fmaxf(fminf(m1, o1), fmaxf(m2, o2)); m1 = n1; m2 = n2; }
        const float gs = m1 + m2; const int g = lane >> 3; int rank = 0;
#pragma unroll
        for (int q = 0; q < 8; ++q) { const float o = rdlane_f(gs, 8 * q); rank += (o > gs || (o == gs && q < g)) ? 1 : 0; }
        const bool sel = rank < 4;
        const unsigned ib = 255u - 4u * (unsigned)lane;
        unsigned k0 = sel ? ((__float_as_uint(v0 + 1.0f) & ~255u) | ib) : 0u, k1 = sel ? ((__float_as_uint(v1 + 1.0f) & ~255u) | (ib - 1u)) : 0u;
        unsigned k2 = sel ? ((__float_as_uint(v2 + 1.0f) & ~255u) | (ib - 2u)) : 0u, k3 = sel ? ((__float_as_uint(v3 + 1.0f) & ~255u) | (ib - 3u)) : 0u;
        int myidx = 0; float mys = 0.f, tot = 0.f;
#pragma unroll
        for (int k = 0; k < TOPK; ++k) {
            unsigned mk = max(max(k0, k1), max(k2, k3));
            mk = max(mk, dppu<0xB1>(mk)); mk = max(mk, dppu<0x4E>(mk)); mk = max(mk, dppu<0x141>(mk)); mk = max(mk, dppu<0x140>(mk));
            const unsigned win = max(max((unsigned)__builtin_amdgcn_readlane((int)mk, 0), (unsigned)__builtin_amdgcn_readlane((int)mk, 16)), max((unsigned)__builtin_amdgcn_readlane((int)mk, 32), (unsigned)__builtin_amdgcn_readlane((int)mk, 48)));
            const int idx = 255 - (int)(win & 255u);
            k0 = (k0 == win) ? 0u : k0; k1 = (k1 == win) ? 0u : k1; k2 = (k2 == win) ? 0u : k2; k3 = (k3 == win) ? 0u : k3;
            const int qq = idx & 3; const float sq = qq == 0 ? s0 : (qq == 1 ? s1 : (qq == 2 ? s2 : s3)); const float sw = rdlane_f(sq, idx >> 2);
            tot += sw; if (lane == k) { myidx = idx; mys = sw; }
        }
        if (lane < TOPK) { TOPI[t * TOPK + lane] = myidx; GATE[t * TOPK + lane] = mys / tot * 2.5f; atomicAdd((int*)&hist[myidx], 1); }
    }
    __syncthreads();
    if (F.tid < 256) HIST[F.vcu * 256 + F.tid] = hist[F.tid];
    __syncthreads();
}
__device__ __forceinline__ void p_sort(Frame& F) {
    const int* HIST = WSP(int, WS_HIST); const int* TOPI = WSP(int, WS_TOPI); int* ROWA = WSP(int, WS_ROWA); int* POS = WSP(int, WS_POS); int* BLKE = WSP(int, WS_BLKE); int* META = WSP(int, WS_META);
    LAS int* cnt = (LAS int*)F.lds; LAS int* myoff = cnt + 256; LAS int* nb = cnt + 512; LAS int* blk0 = cnt + 768; LAS int* lcnt = cnt + 1024;
    { typedef int i32x4 __attribute__((ext_vector_type(4)));
      const int q = F.tid >> 6, l = F.tid & 63; i32x4 c = {0, 0, 0, 0}, mo = {0, 0, 0, 0};
#pragma unroll 8
      for (int w = q; w < NWG; w += 8) { const i32x4 h = *(const i32x4*)(HIST + w * 256 + 4 * l); c += h; if (w < F.vcu) mo += h; }
      LAS int* redc = cnt + 1280; LAS int* redm = redc + 2048;
#pragma unroll
      for (int j = 0; j < 4; ++j) { redc[q * 256 + 4 * l + j] = c[j]; redm[q * 256 + 4 * l + j] = mo[j]; }
      __syncthreads();
      if (F.tid < 256) { const int e = F.tid; int cc = 0, mm = 0;
#pragma unroll
          for (int k = 0; k < 8; ++k) { cc += redc[k * 256 + e]; mm += redm[k * 256 + e]; }
          cnt[e] = cc; myoff[e] = mm; nb[e] = (cc + 255) >> 8; lcnt[e] = 0; } }
    __syncthreads();
    if (F.tid < 256) { int b = 0; for (int j = 0; j < F.tid; ++j) b += nb[j]; blk0[F.tid] = b; }
    __syncthreads();
    for (int al = F.tid; al < 1024; al += NTHR) { const int a = F.vcu * 1024 + al; const int e = TOPI[a]; const int pos = blk0[e] * 256 + myoff[e] + atomicAdd((int*)&lcnt[e], 1); ROWA[pos] = a; POS[a] = pos; }
    const int nrb = blk0[255] + nb[255];
    { const int e = F.vcu; const int start = blk0[e] * 256 + cnt[e], end = (blk0[e] + nb[e]) * 256;
      for (int p = start + F.tid; p < end; p += NTHR) ROWA[p] = -1;
      for (int j = F.tid; j < nb[e]; j += NTHR) BLKE[blk0[e] + j] = e; }
    for (int tl = F.tid; tl < 128; tl += NTHR) { const int t = F.vcu * 128 + tl; ROWA[nrb * 256 + t] = 8 * M + t; }
    if (F.vcu == 0) { for (int j = F.tid; j < 128; j += NTHR) BLKE[nrb + j] = 256; if (F.tid == 0) META[0] = nrb + 128; }
    __syncthreads();
}
__device__ __forceinline__ void p_combine(Frame& F, const float* Hin, const float* g, const float* b, float* Hf, unsigned char* Hq) {
    const bf16* YA = WSP(bf16, WS_RA); const float* GATE = WSP(float, WS_GATE); const int* POS = WSP(int, WS_POS); const int shrow0 = (*WSP(int, WS_META) - 128) * 256;
    for (int t = F.vcu * NWAVES + F.wave; t < M; t += NGW) { f32x4 v[4];
        const f32x4* hr = (const f32x4*)(Hin + (size_t)t * D) + F.lane;
#pragma unroll
        for (int j = 0; j < 4; ++j) v[j] = hr[64 * j] * ALPHA;
        f32x4 r[4];
#pragma unroll
        for (int j = 0; j < 4; ++j) r[j] = (f32x4){0.f, 0.f, 0.f, 0.f};
#pragma unroll
        for (int k = 0; k < TOPK; ++k) { const float gk = GATE[t * TOPK + k] * 0.0625f; const unsigned* yr = (const unsigned*)((const unsigned char*)YA + (size_t)POS[t * TOPK + k] * D) + F.lane;
#pragma unroll
            for (int j = 0; j < 4; ++j) { const unsigned w = yr[64 * j]; const f32x2 a = __builtin_amdgcn_cvt_pk_f32_fp8((int)w, false), c = __builtin_amdgcn_cvt_pk_f32_fp8((int)w, true);
                r[j].x += gk * a.x; r[j].y += gk * a.y; r[j].z += gk * c.x; r[j].w += gk * c.y; } }
        { const unsigned* yr = (const unsigned*)((const unsigned char*)YA + (size_t)(shrow0 + t) * D) + F.lane;
#pragma unroll
            for (int j = 0; j < 4; ++j) { const unsigned w = yr[64 * j]; const f32x2 a = __builtin_amdgcn_cvt_pk_f32_fp8((int)w, false), c = __builtin_amdgcn_cvt_pk_f32_fp8((int)w, true);
                v[j].x += r[j].x + 0.0625f * a.x; v[j].y += r[j].y + 0.0625f * a.y; v[j].z += r[j].z + 0.0625f * c.x; v[j].w += r[j].w + 0.0625f * c.y; } }
        ln_store(v, g, b, Hf + (size_t)t * D, nullptr, F.lane, Hq ? Hq + (size_t)t * D : nullptr); }
}
constexpr int AT_KP = 144, AT_VP = 784, AT_KBYTES = 384 * AT_KP, AT_VOFF = AT_KBYTES;
__device__ __forceinline__ void p_attn(Frame& F) {
    const bf16* QKb = WSP(bf16, WS_RA + RA_QK); const bf16* VTb = WSP(bf16, WS_RA + RA_VT); bf16* OGb = WSP(bf16, WS_RA + RA_OG); float* LSE = WSP(float, WS_LSE);
    const int lane = F.lane, q = lane & 31, hh = lane >> 5, w = F.wave;
    LAS unsigned char* lk = F.lds; LAS unsigned char* lv = F.lds + AT_VOFF;
#pragma unroll 1
    for (int it = F.vcu; it < 3 * 128 * 8; it += NWG) {
        const int g = it >> 10, rem = it & 1023, chunk = rem >> 3, h = rem & 7;
        const int sh = 14 - 2 * g, rq0 = chunk * 256, i0 = rq0 & ((1 << sh) - 1), rk0 = rq0 - 128;
        const bf16* QK = QKb + (size_t)g * M * 1024; const bf16* VT = VTb + (size_t)g * 512 * M;
        { const char* kb = (const char*)(QK + 512 + h * 64);
#pragma unroll
          for (int j = 0; j < 7; ++j) { const int ins = w + 8 * j; if (ins < 54) { const int p = ins * 64 + lane, row = p / 9, cc = p - row * 9; const int gr = rk0 + row < 0 ? 0 : rk0 + row;
              __builtin_amdgcn_global_load_lds((const unsigned*)(kb + (size_t)gr * 2048 + (cc > 7 ? 7 : cc) * 16), (LAS unsigned*)(lk + ins * 1024), 16, 0, 0); } }
          const char* vb = (const char*)(VT + (size_t)(h * 64) * M);
#pragma unroll
          for (int j = 0; j < 7; ++j) { const int ins = w + 8 * j; if (ins < 49) { const int p = ins * 64 + lane, row = p / 49, cc = p - row * 49; int col = rk0 + (cc > 47 ? 47 : cc) * 8; col = col < 0 ? 0 : col;
              __builtin_amdgcn_global_load_lds((const unsigned*)(vb + ((size_t)row * M + col) * 2), (LAS unsigned*)(lv + ins * 1024), 16, 0, 0); } } }
        bf16x8 Qf[4];
        { const bf16* qp = QK + (size_t)(rq0 + 32 * w + q) * 1024 + h * 64 + 8 * hh;
#pragma unroll
          for (int s2 = 0; s2 < 4; ++s2) Qf[s2] = *(const bf16x8*)(qp + 16 * s2); }
        asm volatile("s_waitcnt vmcnt(0)" ::: "memory");
        __syncthreads();
        const float slope2 = exp2f(-(float)(h + 1)) * (float)(1 << (2 * g)) * 1.4426950408889634f, sc = 0.125f * 1.4426950408889634f;
        float m_run = -1e30f, l_run = 0.f; f32x16 O0, O1;
#pragma unroll
        for (int r = 0; r < 16; ++r) { O0[r] = 0.f; O1[r] = 0.f; }
#pragma unroll 1
        for (int kt = 0; kt < 5; ++kt) { const int kr0 = 32 * w + 32 * kt; if (i0 + kr0 - 128 < 0) continue;
            bf16x8 Kf[4];
            { const LAS unsigned char* kp = lk + (kr0 + q) * AT_KP + 16 * hh;
#pragma unroll
              for (int s2 = 0; s2 < 4; ++s2) Kf[s2] = *(const LAS bf16x8*)(kp + 32 * s2); }
            bf16x8 Vf[2][2];
#pragma unroll
            for (int dd = 0; dd < 2; ++dd)
#pragma unroll
                for (int s2 = 0; s2 < 2; ++s2) { const LAS unsigned char* vp = lv + (32 * dd + q) * AT_VP + (kr0 + 16 * s2 + 4 * hh) * 2;
                    const u32x2 lo = *(const LAS u32x2*)vp, hi = *(const LAS u32x2*)(vp + 16); u32x4 wv; wv.x = lo.x; wv.y = lo.y; wv.z = hi.x; wv.w = hi.y; Vf[dd][s2] = __builtin_bit_cast(bf16x8, wv); }
            f32x16 S;
#pragma unroll
            for (int r = 0; r < 16; ++r) S[r] = 0.f;
#pragma unroll
            for (int s2 = 0; s2 < 4; ++s2) S = __builtin_amdgcn_mfma_f32_32x32x16_bf16(Kf[s2], Qf[s2], S, 0, 0, 0);
            float mx = -1e30f;
#pragma unroll
            for (int r = 0; r < 16; ++r) { const int krow = (r & 3) + 8 * (r >> 2) + 4 * hh; const int dist = 128 - 32 * kt + q - krow;
                const float sv = (dist >= 0 && dist <= 128) ? S[r] * sc - slope2 * (float)dist : -1e30f; S[r] = sv; mx = fmaxf(mx, sv); }
            mx = fmaxf(mx, __shfl_xor(mx, 32));
            const float m_new = fmaxf(m_run, mx), alpha = exp2f(m_run - m_new); float rs = 0.f;
#pragma unroll
            for (int r = 0; r < 16; ++r) { const float p = exp2f(S[r] - m_new); S[r] = p; rs += p; }
            rs += __shfl_xor(rs, 32);
            l_run = l_run * alpha + rs; m_run = m_new;
#pragma unroll
            for (int r = 0; r < 16; ++r) { O0[r] *= alpha; O1[r] *= alpha; }
            bf16x8 Pf[2];
#pragma unroll
            for (int s2 = 0; s2 < 2; ++s2) { u32x4 wv; wv.x = pk2(S[8 * s2 + 0], S[8 * s2 + 1]); wv.y = pk2(S[8 * s2 + 2], S[8 * s2 + 3]); wv.z = pk2(S[8 * s2 + 4], S[8 * s2 + 5]); wv.w = pk2(S[8 * s2 + 6], S[8 * s2 + 7]); Pf[s2] = __builtin_bit_cast(bf16x8, wv); }
#pragma unroll
            for (int s2 = 0; s2 < 2; ++s2) { O0 = __builtin_amdgcn_mfma_f32_32x32x16_bf16(Vf[0][s2], Pf[s2], O0, 0, 0, 0); O1 = __builtin_amdgcn_mfma_f32_32x32x16_bf16(Vf[1][s2], Pf[s2], O1, 0, 0, 0); }
        }
        const float inv = 1.0f / l_run;
        bf16* op = OGb + ((size_t)g * M + rq0 + 32 * w + q) * 512 + h * 64 + 4 * hh;
#pragma unroll
        for (int rg = 0; rg < 4; ++rg) { u32x2 wv; wv.x = pk2(O0[4 * rg] * inv, O0[4 * rg + 1] * inv); wv.y = pk2(O0[4 * rg + 2] * inv, O0[4 * rg + 3] * inv); *(u32x2*)(op + 8 * rg) = wv;
            u32x2 w1; w1.x = pk2(O1[4 * rg] * inv, O1[4 * rg + 1] * inv); w1.y = pk2(O1[4 * rg + 2] * inv, O1[4 * rg + 3] * inv); *(u32x2*)(op + 32 + 8 * rg) = w1; }
        if (hh == 0) LSE[((size_t)g * M + rq0 + 32 * w + q) * 8 + h] = (m_run + log2f(l_run)) * 0.6931471805599453f;
        __syncthreads();
    }
}
__device__ __forceinline__ void p_merge(Frame& F) {
    const bf16* OGb = WSP(bf16, WS_RA + RA_OG); const float* LSE = WSP(float, WS_LSE); bf16* OM = WSP(bf16, WS_RA + RA_OM);
    for (int t = F.vcu * NWAVES + F.wave; t < M; t += NGW) { const int hd = F.lane >> 3; float ls[3]; size_t ro[3];
#pragma unroll
        for (int g = 0; g < 3; ++g) { const int rho = tok_to_rho(t, g); ro[g] = ((size_t)g * M + rho); ls[g] = LSE[ro[g] * 8 + hd]; }
        const float mx = fmaxf(ls[0], fmaxf(ls[1], ls[2])); float w[3], ws = 0.f;
#pragma unroll
        for (int g = 0; g < 3; ++g) { w[g] = __expf(ls[g] - mx); ws += w[g]; }
        const float inv = 1.0f / ws; float o[8];
#pragma unroll
        for (int j = 0; j < 8; ++j) o[j] = 0.f;
#pragma unroll
        for (int g = 0; g < 3; ++g) { const u32x4 x = *(const u32x4*)(OGb + ro[g] * 512 + 8 * F.lane); const float wg = w[g] * inv;
            o[0] += wg * bf_lo(x.x); o[1] += wg * bf_hi(x.x); o[2] += wg * bf_lo(x.y); o[3] += wg * bf_hi(x.y); o[4] += wg * bf_lo(x.z); o[5] += wg * bf_hi(x.z); o[6] += wg * bf_lo(x.w); o[7] += wg * bf_hi(x.w); }
        u32x4 r; r.x = pk2(o[0], o[1]); r.y = pk2(o[2], o[3]); r.z = pk2(o[4], o[5]); r.w = pk2(o[6], o[7]); *(u32x4*)(OM + (size_t)t * OW + 8 * F.lane) = r; }
}

constexpr int NPHASE = 26;

__global__ void __launch_bounds__(NTHR, 2) yoco_fwd(Args args) {
    extern __shared__ __attribute__((aligned(16))) unsigned char lds[];
    Frame F;
    F.lds = (LAS unsigned char*)lds;
    F.tid = threadIdx.x; F.lane = F.tid & 63; F.wave = __builtin_amdgcn_readfirstlane(F.tid >> 6);
    { const int bx = blockIdx.x; F.vcu = (bx % 8) * (NWG / 8) + bx / 8; }
    F.ws = args.ws;
    volatile LAS unsigned* MISC = (volatile LAS unsigned*)(F.lds + LDS_BYTES - 64);
    if (F.tid < 16) MISC[F.tid] = 0u;
    __syncthreads();
    const int lo = args.ph_lo, hi = args.ph_hi;
    XcdBarrier bar; bar.bar = (unsigned*)(F.ws + WS_CTL) + 4096; bar.x = 0; bar.st = nullptr;
    if (hi - lo > 1) bar = xcd_barrier_post((unsigned*)(F.ws + WS_CTL) + 4096, MISC + 8);
#ifndef PROBE_G2
#define PROBE_G2 0
#endif
#ifndef DUP_MASK
#define DUP_MASK 0u
#endif
#ifndef PH_MASK
#define PH_MASK 0xFFFFFFFFu
#endif
#define IN(k) (((PH_MASK >> (k)) & 1u) && lo <= (k) && (k) < hi)
#define REP(k) for (int rep = 0, nrep = 1 + (int)((args.dup >> (k)) & 1u); rep < nrep; ++rep)
#define SEAM(k) do { if (IN(k) && IN((k) + 1)) xcd_barrier(bar); } while (0)

    const bool cv_first = ((F.vcu >> 5) & 1) == 0;
#define CONV_L0(part) convert_experts(F, args.in[15], args.in[16], args.in[17], args.in[18], args.in[19], args.in[20], 0, part, 3)
#define CONV_L1(part) convert_experts(F, args.in[15] + (size_t)NE * D * DE, args.in[16] + (size_t)NE * D * DE, args.in[17] + (size_t)NE * D * DE, args.in[18] + (size_t)D * DE, args.in[19] + (size_t)D * DE, args.in[20] + (size_t)D * DE, 1, part, 3)
    if (IN(0)) { p0_prologue(F, args); } SEAM(0);
    if (IN(1)) { if (cv_first) { CONV_L0(0); __syncthreads(); } SchedDense8 S{WSP(unsigned char, WS_RA + RA_XB), WSP(unsigned char, WS_WIN), D, D, D, M / 256, 8, F.vcu}; EpiXZ E{WSP(bf16, WS_RA + RA_XR), WSP(bf16, WS_RA + RA_GG)}; gemm_fast8(F.lds, S, E); if (!cv_first) { __syncthreads(); CONV_L0(0); } } SEAM(1);
    if (IN(2)) { p_conv(F, args.in[2], args.in[3]); } SEAM(2);
    if (IN(3)) { if (cv_first) { CONV_L0(1); __syncthreads(); } SchedGate S{WSP(bf16, WS_RA + RA_XC), WSP(bf16, WS_WG), F.vcu}; EpiGate E{WSP(bf16, WS_RA + RA_XC), args.in[5], args.in[7], args.in[8], WSP(bf16, WS_RA + RA_LA), WSP(bf16, WS_RA + RA_U)}; GEMM_PHASE(F.lds, S, E); if (!cv_first) { __syncthreads(); CONV_L0(1); } } SEAM(3);
    if (IN(4)) { p_scan1(F); } SEAM(4);
    if (IN(5)) { p_scan2(F); } SEAM(5);
    if (IN(6)) { p_scan3(F); } SEAM(6);
    if (IN(7)) { if (cv_first) { CONV_L0(2); __syncthreads(); } SchedDense S{WSP(bf16, WS_RA + RA_YB), WSP(bf16, WS_WOUT), D, D, D, M / 256, 4, F.vcu}; EpiResF32 E{args.in[0], WSP(float, WS_V), D}; GEMM_PHASE(F.lds, S, E); if (!cv_first) { __syncthreads(); CONV_L0(2); } } SEAM(7);
    if (IN(8)) { p_ln(F, WSP(float, WS_V), args.in[21] + 0 * D, args.in[22] + 0 * D, WSP(float, WS_HA), WSP(bf16, WS_HAB)); } SEAM(8);
    if (IN(9)) { SchedDense S{WSP(bf16, WS_HAB), WSP(bf16, WS_WR), D, D, D, M / 256, 1, F.vcu}; EpiF32 E{WSP(float, WS_LOGITS), NE}; GEMM_PHASE(F.lds, S, E); } SEAM(9);
    if (IN(10)) { p_route(F, args.in[14]); } SEAM(10);
    if (IN(11)) { p_sort(F); } SEAM(11);
    if (IN(12)) { if (cv_first) { CONV_L1(0); __syncthreads(); } const int nrbt = *WSP(int, WS_META); SchedG1 S{WSP(unsigned char, WS_HQ), WSP(unsigned char, WS_W13), WSP(int, WS_ROWA), WSP(int, WS_BLKE), nrbt, F.vcu, moe_unit_experts(F, WSP(int, WS_BLKE), nrbt, 1), moe_row_table(F, WSP(int, WS_ROWA), nrbt)}; EpiSwiGLU E{WSP(unsigned char, WS_HID), F.lds + LDS_EPI}; gemm_fast8(F.lds, S, E); if (!cv_first) { __syncthreads(); CONV_L1(0); } } SEAM(12);
    if (IN(13)) { if (cv_first) { CONV_L1(1); __syncthreads(); } const int nrbt = *WSP(int, WS_META); SchedG2 S{WSP(unsigned char, WS_HID), WSP(unsigned char, WS_W2), WSP(int, WS_BLKE), nrbt, F.vcu, moe_unit_experts(F, WSP(int, WS_BLKE), nrbt, 2), args.rt256, args.rt256, args.rt256}; EpiScatter E{WSP(bf16, WS_RA), 0, F.lds + LDS_EPI}; gemm_fast8(F.lds, S, E); if (!cv_first) { __syncthreads(); CONV_L1(1); } } SEAM(13);
    if (IN(14)) { p_combine(F, WSP(float, WS_HA), args.in[21] + 1 * D, args.in[22] + 1 * D, WSP(float, WS_HB), WSP(unsigned char, WS_HQ)); } SEAM(14);
    if (IN(15)) { if (cv_first) { CONV_L1(2); __syncthreads(); } EpiQKV E{WSP(bf16, WS_RA + RA_QK), WSP(bf16, WS_RA + RA_VT), F.lds + LDS_EPI}; for (int g = 0; g < 3; ++g) { SchedQK S{WSP(unsigned char, WS_HQ), WSP(unsigned char, WS_WQK), g, D << (2 * g), F.vcu}; gemm_fast8(F.lds, S, E); } for (int g = 0; g < 3; ++g) { SchedVT S{WSP(unsigned char, WS_HQ), WSP(unsigned char, WS_WQK) + (size_t)3072 * D, g, D << (2 * g), F.vcu}; gemm_fast8(F.lds, S, E); } if (!cv_first) { __syncthreads(); CONV_L1(2); } } SEAM(15);
    if (IN(16)) { p_attn(F); } SEAM(16);
    if (IN(17)) { p_merge(F); } SEAM(17);
    if (IN(18)) { SchedDense S{WSP(bf16, WS_RA + RA_OM), WSP(bf16, WS_WO), OW, OW, OW, M / 256, 4, F.vcu}; EpiResF32 E{WSP(float, WS_HB), WSP(float, WS_V), D}; GEMM_PHASE(F.lds, S, E); } SEAM(18);
    if (IN(19)) { p_ln(F, WSP(float, WS_V), args.in[21] + 2 * D, args.in[22] + 2 * D, WSP(float, WS_HA), WSP(bf16, WS_HAB)); } SEAM(19);
    if (IN(20)) { SchedDense S{WSP(bf16, WS_HAB), WSP(bf16, WS_WR) + (size_t)NE * D, D, D, D, M / 256, 1, F.vcu}; EpiF32 E{WSP(float, WS_LOGITS), NE}; GEMM_PHASE(F.lds, S, E); } SEAM(20);
    if (IN(21)) { p_route(F, args.in[14] + NE); } SEAM(21);
    if (IN(22)) { p_sort(F); } SEAM(22);
    if (IN(23)) { const int nrbt = *WSP(int, WS_META); SchedG1 S{WSP(unsigned char, WS_HQ), WSP(unsigned char, WS_W13) + W13_LB, WSP(int, WS_ROWA), WSP(int, WS_BLKE), nrbt, F.vcu, moe_unit_experts(F, WSP(int, WS_BLKE), nrbt, 1), moe_row_table(F, WSP(int, WS_ROWA), nrbt)}; EpiSwiGLU E{WSP(unsigned char, WS_HID), F.lds + LDS_EPI}; gemm_fast8(F.lds, S, E); } SEAM(23);
    if (IN(24)) { const int nrbt = *WSP(int, WS_META); SchedG2 S{WSP(unsigned char, WS_HID), WSP(unsigned char, WS_W2) + W2_LB, WSP(int, WS_BLKE), nrbt, F.vcu, moe_unit_experts(F, WSP(int, WS_BLKE), nrbt, 2), args.rt256, args.rt256, args.rt256}; EpiScatter E{WSP(bf16, WS_RA), 0, F.lds + LDS_EPI}; gemm_fast8(F.lds, S, E); } SEAM(24);
    if (IN(25)) { p_combine(F, WSP(float, WS_HA), args.in[21] + 3 * D, args.in[22] + 3 * D, args.out, nullptr); }
#undef IN
#undef SEAM
}

extern "C" void kernel_launch(void* const* d_in, const int* in_sizes, int n_in, void* d_out, int out_size, void* d_ws, size_t ws_size, hipStream_t stream) {
    static int ok = 0;
    if (ok == 0) {
        if (n_in != 23 || in_sizes[0] != M * D || out_size != M * D || ws_size < WS_END) { fprintf(stderr, "kernel_launch: unexpected shapes (n_in %d, in0 %d, out %d, ws %zu < %zu)\n", n_in, n_in > 0 ? in_sizes[0] : -1, out_size, ws_size, (size_t)WS_END); ok = -1; return; }
        if (hipFuncSetAttribute((const void*)yoco_fwd, hipFuncAttributeMaxDynamicSharedMemorySize, LDS_BYTES) != hipSuccess) { fprintf(stderr, "kernel_launch: hipFuncSetAttribute failed\n"); ok = -1; return; }
        int per_cu = 0;
        if (hipOccupancyMaxActiveBlocksPerMultiprocessor(&per_cu, (const void*)yoco_fwd, NTHR, LDS_BYTES) != hipSuccess || per_cu < 1) fprintf(stderr, "kernel_launch: occupancy query says %d\n", per_cu);
        (void)hipGetLastError();
        ok = 1;
    }
    if (ok < 0) return;
    if (hipMemsetAsync((char*)d_ws + WS_CTL, 0, CTL_ZERO_BYTES, stream) != hipSuccess) return;
    Args a{};
    for (int i = 0; i < 23; ++i) a.in[i] = (const float*)d_in[i];
    a.out = (float*)d_out; a.ws = (unsigned char*)d_ws; a.dup = 0u; a.rt256 = 256;
#if MK_ONE_LAUNCH
    a.ph_lo = 0; a.ph_hi = NPHASE;
    hipLaunchKernelGGL(yoco_fwd, dim3(NWG), dim3(NTHR), LDS_BYTES, stream, a);
#else
    for (int p = 0; p < NPHASE; ++p) { a.ph_lo = p; a.ph_hi = p + 1; hipLaunchKernelGGL(yoco_fwd, dim3(NWG), dim3(NTHR), LDS_BYTES, stream, a); }
#endif
}
```

```cpp
#include <hip/hip_runtime.h>
#include <cstdio>
#include <cstdint>

#ifndef MK_ONE_LAUNCH
#define MK_ONE_LAUNCH 1
#endif

constexpr int D = 1024, BATCH = 2, SEQ = 16384, M = BATCH * SEQ;
constexpr int NE = 256, TOPK = 8, DE = 256;
constexpr int HEADS = 8, HD = 64, QW = 1536, OW = 512;
constexpr float LN_EPS = 1e-5f, ALPHA = 1.41421356237f;
constexpr int RBMAX = 1024 + 256 + 128;
constexpr int NWG = 256, NTHR = 512, NWAVES = 8;
constexpr int NGW = NWG * NWAVES, NGT = NWG * NTHR;

constexpr size_t MiB = 1u << 20;
constexpr size_t WS_CTL = 0, CTL_ZERO_BYTES = 1 * MiB;
constexpr size_t WS_HIST = 1 * MiB, WS_BLKE = 1 * MiB + 512 * 1024, WS_META = 1 * MiB + 768 * 1024;
constexpr size_t WS_ROWA = 2 * MiB, WS_TOPI = 4 * MiB, WS_GATE = 5 * MiB, WS_CHP = 6 * MiB, WS_CHH = 8 * MiB, WS_CIN = 10 * MiB, WS_LSE = 12 * MiB;
constexpr size_t WS_WIN = 16 * MiB, WS_WG = 20 * MiB, WS_WOUT = 21 * MiB, WS_WQK = 23 * MiB, WS_WV = 29 * MiB, WS_WO = 32 * MiB, WS_WR = 33 * MiB;
constexpr size_t WS_LOGITS = 34 * MiB;
constexpr size_t WS_W13 = 66 * MiB, WS_W2 = 323 * MiB;
constexpr size_t W13_LB = (size_t)257 * 512 * 1024, W2_LB = (size_t)257 * 1024 * 256;
static_assert(WS_W13 + 2 * W13_LB <= WS_W2 && WS_W2 + 2 * W2_LB <= 452 * MiB, "both layers' fp8 expert weights fit");
constexpr size_t WS_V = 452 * MiB, WS_HA = 580 * MiB, WS_HAB = 708 * MiB, WS_HB = 772 * MiB, WS_HBB = 900 * MiB, WS_HID = 964 * MiB;
constexpr size_t WS_RA = 1140 * MiB;
constexpr size_t RA_XB = 0, RA_XR = 64 * MiB, RA_GG = 128 * MiB, RA_XC = 192 * MiB, RA_LA = 256 * MiB, RA_U = 384 * MiB, RA_YB = 512 * MiB;
constexpr size_t RA_QK = 0, RA_VT = 192 * MiB, RA_OG = 288 * MiB, RA_OM = 384 * MiB;
constexpr size_t WS_POS = 15 * MiB;
constexpr size_t WS_HQ = 1844 * MiB;
constexpr size_t WS_END = 1876 * MiB;

constexpr int LDS_BYTES = 163840;
constexpr int LDS_EPI = 131072, LDS_TAB = 147456;

#define GAS __attribute__((address_space(1)))
#define LAS __attribute__((address_space(3)))
typedef unsigned short bf16;
typedef unsigned u32x4 __attribute__((ext_vector_type(4)));
typedef unsigned u32x2 __attribute__((ext_vector_type(2)));
typedef float f32x4 __attribute__((ext_vector_type(4)));
typedef float f32x2 __attribute__((ext_vector_type(2)));
typedef float f32x16 __attribute__((ext_vector_type(16)));
typedef short bf16x8 __attribute__((ext_vector_type(8)));
typedef int i32x8 __attribute__((ext_vector_type(8)));
typedef GAS unsigned gu32;
#define RLX_AGENT __ATOMIC_RELAXED, __HIP_MEMORY_SCOPE_AGENT
#define LDS_WAIT() asm volatile("s_waitcnt lgkmcnt(0)" ::: "memory")
#define VM_WAIT() asm volatile("s_waitcnt vmcnt(0)" ::: "memory")

__device__ __forceinline__ unsigned pk2(float lo, float hi) { unsigned r; asm("v_cvt_pk_bf16_f32 %0, %1, %2" : "=v"(r) : "v"(lo), "v"(hi)); return r; }
__device__ __forceinline__ float bf_lo(unsigned w) { return __uint_as_float(w << 16); }
__device__ __forceinline__ float bf_hi(unsigned w) { return __uint_as_float(w & 0xffff0000u); }
__device__ __forceinline__ float wave_sum(float v) {
#pragma unroll
    for (int o = 1; o < 64; o <<= 1) v += __shfl_xor(v, o);
    return v;
}
__device__ __forceinline__ float gelu_tanh(float x) {
    const float u = 0.7978845608028654f * (x + 0.044715f * x * x * x);
    const float e = __expf(2.0f * u);
    const float t = 1.0f - 2.0f / (e + 1.0f);
    return 0.5f * x * (1.0f + t);
}
__device__ __forceinline__ float sigmoidf_(float x) { return 1.0f / (1.0f + __expf(-x)); }

#define XB_TMO      128
#define XB_XCNT(j)  (256  + 64 * (j))
#define XB_XSUB(j)  (1280 + 64 * (j))
#define XB_XGEN(j)  (2304 + 64 * (j))
#define XB_TOP      3328
#define XB_TOPGEN   3392
#define XCD_BAR_WORDS 3456
#define XB_SPIN_CAP (1u << 18)
__device__ __forceinline__ unsigned xb_ld(unsigned* p)              { return __hip_atomic_load(p, __ATOMIC_RELAXED, __HIP_MEMORY_SCOPE_AGENT); }
__device__ __forceinline__ unsigned xb_add(unsigned* p, unsigned v) { return __hip_atomic_fetch_add(p, v, __ATOMIC_RELAXED, __HIP_MEMORY_SCOPE_AGENT); }
__device__ __forceinline__ unsigned xb_xcc_id() { return (unsigned)__builtin_amdgcn_s_getreg((3 << 11) | 20) & 0xFu; }
#define XB_SPIN(cond, bar) do { unsigned _sp = 0; while (cond) { __builtin_amdgcn_s_sleep(1); \
    if ((++_sp & 255u) == 0u) { if (xb_ld(&(bar)[XB_TMO])) break; if (_sp > XB_SPIN_CAP) { atomicAdd(&(bar)[XB_TMO], 1u); break; } } } } while (0)
struct XcdBarrier { unsigned* bar; unsigned x; volatile LAS unsigned* st; };
__device__ __forceinline__ XcdBarrier xcd_barrier_post(unsigned* bar, volatile LAS unsigned* st) {
    XcdBarrier b; b.bar = bar; b.x = xb_xcc_id(); b.st = st;
    if (threadIdx.x == 0) (void)xb_add(&bar[XB_XCNT(b.x)], 1u);
    return b;
}
__device__ __forceinline__ void xcd_barrier_complete(unsigned* bar, unsigned x, unsigned& nloc, unsigned& nx) {
    const unsigned G = gridDim.x * gridDim.y * gridDim.z;
    unsigned sum, cnt, mine, sp = 0u;
    for (;;) {
        sum = 0u; cnt = 0u; mine = 0u;
#pragma unroll
        for (unsigned j = 0; j < 16; ++j) { const unsigned c = xb_ld(&bar[XB_XCNT(j)]); sum += c; cnt += (c > 0u) ? 1u : 0u; mine = (j == x) ? c : mine; }
        if (sum == G) break;
        __builtin_amdgcn_s_sleep(1);
        if ((++sp & 255u) == 0u) { if (xb_ld(&bar[XB_TMO])) break; if (sp > XB_SPIN_CAP) { atomicAdd(&bar[XB_TMO], 1u); break; } }
    }
    nloc = mine > 0u ? mine : 1u; nx = cnt > 0u ? cnt : 1u;
}
__device__ __forceinline__ void xcd_barrier(const XcdBarrier& b) {
    asm volatile("s_waitcnt vmcnt(0)" ::: "memory");
    __syncthreads();
    if (threadIdx.x == 0) {
        unsigned* bar = b.bar;
        __builtin_amdgcn_s_waitcnt(0);
        unsigned nloc = b.st[0], nx = b.st[1];
        if (nloc == 0u) { xcd_barrier_complete(bar, b.x, nloc, nx); b.st[0] = nloc; b.st[1] = nx; }
        const unsigned old = xb_add(&bar[XB_XSUB(b.x)], 1u);
        const unsigned gen = old / nloc;
        if (old + 1u == (gen + 1u) * nloc) {
            __builtin_amdgcn_fence(__ATOMIC_RELEASE, "agent");
            asm volatile("s_waitcnt vmcnt(0)" ::: "memory");
            const unsigned og = xb_add(&bar[XB_TOP], 1u);
            const unsigned tg = og / nx;
            if (og + 1u == (tg + 1u) * nx) xb_add(&bar[XB_TOPGEN], 1u);
            else XB_SPIN(xb_ld(&bar[XB_TOPGEN]) == tg, bar);
            __builtin_amdgcn_fence(__ATOMIC_ACQUIRE, "agent");
            xb_add(&bar[XB_XGEN(b.x)], 1u);
            asm volatile("s_waitcnt vmcnt(0)" ::: "memory");
        } else {
            XB_SPIN(xb_ld(&bar[XB_XGEN(b.x)]) == gen, bar);
            __builtin_amdgcn_fence(__ATOMIC_ACQUIRE, "agent");
            asm volatile("s_waitcnt vmcnt(0)" ::: "memory");
        }
    }
    __syncthreads();
}

struct Args { const float* in[23]; float* out; unsigned char* ws; int ph_lo, ph_hi; unsigned dup; int rt256; };
static_assert(sizeof(Args) == 23 * 8 + 8 + 8 + 16, "Args has no padding");
struct Frame {
    LAS unsigned char* lds;
    int tid, lane, wave, vcu;
    unsigned char* ws;
};
#define WSP(T, off) ((T*)(F.ws + (off)))

template <class S, class E>
__device__ __forceinline__ void gemm_simple(LAS unsigned char* lds, const S& sch, const E& epi) {
    const int tid = threadIdx.x, wid = tid >> 6, lane = tid & 63, wr = wid >> 2, wc = wid & 3, fr = lane & 15, fq = lane >> 4;
    constexpr int PITCH = 144;
    LAS unsigned char* As = lds; LAS unsigned char* Bs = lds + 256 * PITCH;
    typename S::U u;
    for (int i = 0; sch.next(i, u); ++i) {
        f32x4 acc[2][2][4][2];
#pragma unroll
        for (int a = 0; a < 2; ++a)
#pragma unroll
            for (int b = 0; b < 2; ++b)
#pragma unroll
                for (int m = 0; m < 4; ++m)
#pragma unroll
                    for (int n = 0; n < 2; ++n) acc[a][b][m][n] = (f32x4){0.f, 0.f, 0.f, 0.f};
        const int nt = sch.K(u) / 64;
        const char* pa[4]; const char* pb[4];
#pragma unroll
        for (int j = 0; j < 4; ++j) { const int row = (tid >> 3) + 64 * j; const int rb = S::PERM ? ((row & ~31) + 8 * ((row & 15) >> 2) + 4 * ((row >> 4) & 1) + (row & 3)) : row; pa[j] = sch.rowA(u, row) + (tid & 7) * 16; pb[j] = sch.rowB(u, rb) + (tid & 7) * 16; }
        for (int kt = 0; kt < nt; ++kt) {
            u32x4 va[4], vb[4];
#pragma unroll
            for (int j = 0; j < 4; ++j) { va[j] = *(const u32x4*)(pa[j] + kt * 128); vb[j] = *(const u32x4*)(pb[j] + kt * 128); }
            __syncthreads();
#pragma unroll
            for (int j = 0; j < 4; ++j) { const int row = (tid >> 3) + 64 * j;
                *(LAS u32x4*)(As + row * PITCH + (tid & 7) * 16) = va[j]; *(LAS u32x4*)(Bs + row * PITCH + (tid & 7) * 16) = vb[j]; }
            __syncthreads();
#pragma unroll
            for (int kk = 0; kk < 2; ++kk) {
                bf16x8 Bf[2][2];
#pragma unroll
                for (int b = 0; b < 2; ++b)
#pragma unroll
                    for (int n = 0; n < 2; ++n) Bf[b][n] = *(const LAS bf16x8*)(Bs + (b * 128 + wc * 32 + n * 16 + fr) * PITCH + kk * 64 + fq * 16);
#pragma unroll
                for (int a = 0; a < 2; ++a) {
                    bf16x8 Af[4];
#pragma unroll
                    for (int m = 0; m < 4; ++m) Af[m] = *(const LAS bf16x8*)(As + (a * 128 + wr * 64 + m * 16 + fr) * PITCH + kk * 64 + fq * 16);
#pragma unroll
                    for (int b = 0; b < 2; ++b)
#pragma unroll
                        for (int m = 0; m < 4; ++m)
#pragma unroll
                            for (int n = 0; n < 2; ++n) acc[a][b][m][n] = __builtin_amdgcn_mfma_f32_16x16x32_bf16(Bf[b][n], Af[m], acc[a][b][m][n], 0, 0, 0);
                }
            }
        }
        epi(acc, u, wr, wc, fr, fq);
    }
    __syncthreads();
}

namespace pg8 {
constexpr int HTB = 128 * 64 * 2;
__device__ __forceinline__ int lds_byte(int r, int c) { const int st = (r >> 4) * 2 + (c >> 5), rr = r & 15, cc = c & 31, ob = rr * 64 + cc * 2; return st * 1024 + (ob ^ (((ob >> 9) & 1) << 5)); }
__device__ __forceinline__ int perm32(int rho) { const int n = rho >> 4, i = rho & 15; return 8 * (i >> 2) + 4 * n + (i & 3); }
__device__ __forceinline__ int prow(int r) { return (r & ~31) + perm32(r & 31); }
__device__ __forceinline__ void stage_rc(int b, int& R, int& C) { const int st = b / 1024, sb = b % 1024, swz = sb ^ (((sb >> 9) & 1) << 5); R = (st >> 1) * 16 + swz / 64; C = (st & 1) * 32 + (swz % 64) / 2; }
}
template <class S, class E>
__device__ __forceinline__ void gemm_fast(LAS unsigned char* lds, const S& sch, const E& epi) {
    using namespace pg8;
    const int tid = threadIdx.x, wid = __builtin_amdgcn_readfirstlane(tid >> 6), lane = tid & 63, wr = wid >> 2, wc = wid & 3, fr = lane & 15, fq = lane >> 4;
    const int nt = sch.Kk / 64;
    int R0, C0; stage_rc(tid * 16, R0, C0);
    unsigned voffA[2], voffB[2]; unsigned cofA[4], nofA[4], cofB[4], nofB[4];
    size_t hstepA = 0, hstepB = 0;
    if constexpr (!S::GA) { voffA[0] = (unsigned)(R0 * sch.lda + C0) * 2u; voffA[1] = (unsigned)((R0 + 64) * sch.lda + C0) * 2u; hstepA = (size_t)128 * sch.lda * 2; }
    const int RB0 = S::PERM ? prow(R0) : R0;
    if constexpr (!S::GB) { voffB[0] = (unsigned)(RB0 * sch.ldb + C0) * 2u; voffB[1] = (unsigned)((RB0 + 64) * sch.ldb + C0) * 2u; hstepB = (size_t)128 * sch.ldb * 2; }
    const size_t kstep = 128;
    const unsigned ldsw = (unsigned)wid * 1024u;
    const int aoff = lds_byte(wr * 64 + fr, fq * 8), boff = lds_byte(wc * 32 + fr, fq * 8);
#define G_SA(b, h) (((b) * 2 + (h)) * HTB)
#define G_SB(b, h) ((4 + (b) * 2 + (h)) * HTB)
#define G_GLDS(src, dst) __builtin_amdgcn_global_load_lds((const unsigned*)(src), (LAS unsigned*)(dst), 16, 0, 0)
#define G_STAGE_A(bufoff, gp, h, nx) do { if constexpr (S::GA) { _Pragma("unroll") for (int _i = 0; _i < 2; ++_i) { const unsigned _o = (nx) ? nofA[2 * (h) + _i] : cofA[2 * (h) + _i]; G_GLDS((gp) + _o, lds + (bufoff) + ldsw + _i * 8192); } } \
        else { _Pragma("unroll") for (int _i = 0; _i < 2; ++_i) G_GLDS((gp) + (size_t)(h) * hstepA + voffA[_i], lds + (bufoff) + ldsw + _i * 8192); } } while (0)
#define G_STAGE_B(bufoff, gp, h, nx) do { if constexpr (S::GB) { _Pragma("unroll") for (int _i = 0; _i < 2; ++_i) { const unsigned _o = (nx) ? nofB[2 * (h) + _i] : cofB[2 * (h) + _i]; G_GLDS((gp) + _o, lds + (bufoff) + ldsw + _i * 8192); } } \
        else { _Pragma("unroll") for (int _i = 0; _i < 2; ++_i) G_GLDS((gp) + (size_t)(h) * hstepB + voffB[_i], lds + (bufoff) + ldsw + _i * 8192); } } while (0)
#define G_LDA(dst, b, h) do { _Pragma("unroll") for (int m = 0; m < 4; ++m) _Pragma("unroll") for (int k = 0; k < 2; ++k) dst[m][k] = *(const LAS bf16x8*)(lds + G_SA(b, h) + aoff + m * 2048 + k * 1024); } while (0)
#define G_LDB(dst, b, h) do { _Pragma("unroll") for (int n = 0; n < 2; ++n) _Pragma("unroll") for (int k = 0; k < 2; ++k) dst[n][k] = *(const LAS bf16x8*)(lds + G_SB(b, h) + boff + n * 2048 + k * 1024); } while (0)
#define G_MMA(ai, bj, At, Bt) do { __builtin_amdgcn_s_setprio(1); _Pragma("unroll") for (int m = 0; m < 4; ++m) _Pragma("unroll") for (int n = 0; n < 2; ++n) _Pragma("unroll") for (int k = 0; k < 2; ++k) \
        acc[ai][bj][m][n] = __builtin_amdgcn_mfma_f32_16x16x32_bf16(Bt[n][k], At[m][k], acc[ai][bj][m][n], 0, 0, 0); __builtin_amdgcn_s_setprio(0); } while (0)
#define G_WAIT_V(n) asm volatile("s_waitcnt vmcnt(" #n ")" ::: "memory")
#define G_WAIT_L(n) asm volatile("s_waitcnt lgkmcnt(" #n ")" ::: "memory")
#define G_BAR __builtin_amdgcn_s_barrier()
#define G_SCHED __builtin_amdgcn_sched_barrier(0)
    typename S::U cur, nxt; int ui = 0;
    if (!sch.next(0, cur)) return;
    f32x4 acc[2][2][4][2];
#pragma unroll
    for (int a = 0; a < 2; ++a)
#pragma unroll
        for (int b = 0; b < 2; ++b)
#pragma unroll
            for (int m = 0; m < 4; ++m)
#pragma unroll
                for (int n = 0; n < 2; ++n) acc[a][b][m][n] = (f32x4){0.f, 0.f, 0.f, 0.f};
    bf16x8 At[4][2], B0[2][2], B1[2][2];
    const char* cA = sch.baseA(cur); const char* cB = sch.baseB(cur);
    if constexpr (S::GA) {
#pragma unroll
        for (int j = 0; j < 4; ++j) { cofA[j] = sch.goffA(cur, (j >> 1) * 128 + R0 + (j & 1) * 64, C0); nofA[j] = cofA[j]; } }
    if constexpr (S::GB) {
#pragma unroll
        for (int j = 0; j < 4; ++j) { cofB[j] = sch.goffB(cur, (j >> 1) * 128 + RB0 + (j & 1) * 64, C0); nofB[j] = cofB[j]; } }
    G_STAGE_B(G_SB(0, 0), cB, 0, false); G_STAGE_B(G_SB(0, 1), cB, 1, false); G_STAGE_A(G_SA(0, 0), cA, 0, false); G_STAGE_A(G_SA(0, 1), cA, 1, false);
    if (wr == 1) G_BAR;
    G_WAIT_V(2); G_BAR;
    G_STAGE_B(G_SB(1, 0), cB + kstep, 0, false); G_STAGE_A(G_SA(1, 0), cA + kstep, 0, false); G_STAGE_B(G_SB(1, 1), cB + kstep, 1, false);
    G_WAIT_V(6); G_BAR;
    for (;;) {
        const bool has_next = sch.next(ui + 1, nxt);
        const char* nA = has_next ? sch.baseA(nxt) : cA; const char* nB = has_next ? sch.baseB(nxt) : cB;
        if constexpr (S::GA) { if (has_next) {
#pragma unroll
            for (int j = 0; j < 4; ++j) nofA[j] = sch.goffA(nxt, (j >> 1) * 128 + R0 + (j & 1) * 64, C0); } }
        if constexpr (S::GB) { if (has_next) {
#pragma unroll
            for (int j = 0; j < 4; ++j) nofB[j] = sch.goffB(nxt, (j >> 1) * 128 + RB0 + (j & 1) * 64, C0); } }
#pragma unroll 1
        for (int t = 0; t < nt; t += 2) {
            const bool last = (t == nt - 2);
            const char* a1 = cA + (size_t)(t + 1) * kstep;
            const char* a2 = last ? nA : cA + (size_t)(t + 2) * kstep; const char* b2 = last ? nB : cB + (size_t)(t + 2) * kstep;
            const char* a3 = a2 + kstep; const char* b3 = b2 + kstep;
            asm volatile("" : "+s"(a1), "+s"(a2), "+s"(a3), "+s"(b2), "+s"(b3));
            const bool post = (t == 0 && ui > 0);
#define G_WAIT_POST() do { if (post) { if constexpr (E::NVM == 8) G_WAIT_V(16); else if constexpr (E::NVM == 16) G_WAIT_V(24); else if constexpr (E::NVM == 32) G_WAIT_V(40); else G_WAIT_V(8); } else G_WAIT_V(8); } while (0)
            G_LDB(B0, 0, 0); G_LDB(B1, 0, 1); G_SCHED; G_LDA(At, 0, 0); if (!post) G_STAGE_A(G_SA(1, 1), a1, 1, false);
            G_WAIT_POST(); G_WAIT_L(0); G_BAR; G_MMA(0, 0, At, B0); G_MMA(0, 1, At, B1); G_BAR; G_SCHED;
            G_LDA(At, 0, 1); G_STAGE_B(G_SB(0, 0), b2, 0, last); G_STAGE_B(G_SB(0, 1), b2, 1, last); G_STAGE_A(G_SA(0, 0), a2, 0, last);
            G_WAIT_POST(); G_WAIT_L(0); G_BAR; G_MMA(1, 0, At, B0); G_MMA(1, 1, At, B1); G_BAR; G_SCHED;
            G_LDB(B0, 1, 0); G_LDB(B1, 1, 1); G_SCHED; G_LDA(At, 1, 0); G_STAGE_A(G_SA(0, 1), a2, 1, last);
            G_WAIT_POST(); G_WAIT_L(0); G_BAR; G_MMA(0, 0, At, B0); G_MMA(0, 1, At, B1); G_BAR; G_SCHED;
            G_LDA(At, 1, 1); G_STAGE_B(G_SB(1, 0), b3, 0, last); G_STAGE_B(G_SB(1, 1), b3, 1, last); G_STAGE_A(G_SA(1, 0), a3, 0, last);
            G_WAIT_V(8); G_WAIT_L(0); G_BAR; G_MMA(1, 0, At, B0); G_MMA(1, 1, At, B1); G_BAR; G_SCHED;
#undef G_WAIT_POST
        }
        if (wr == 0) G_BAR;
        if (has_next) { const char* n1 = nA + kstep; asm volatile("" : "+s"(n1)); G_STAGE_A(G_SA(1, 1), n1, 1, true); }
        { int tz = threadIdx.x; asm volatile("" : "+v"(tz));
          const int ewid = tz >> 6, el = tz & 63; epi(acc, cur, ewid >> 2, ewid & 3, el & 15, el >> 4); }
        if (!has_next) break;
#pragma unroll
        for (int a = 0; a < 2; ++a)
#pragma unroll
            for (int b = 0; b < 2; ++b)
#pragma unroll
                for (int m = 0; m < 4; ++m)
#pragma unroll
                    for (int n = 0; n < 2; ++n) acc[a][b][m][n] = (f32x4){0.f, 0.f, 0.f, 0.f};
        cur = nxt; cA = nA; cB = nB; ++ui;
        if constexpr (S::GA) {
#pragma unroll
            for (int j = 0; j < 4; ++j) cofA[j] = nofA[j]; }
        if constexpr (S::GB) {
#pragma unroll
            for (int j = 0; j < 4; ++j) cofB[j] = nofB[j]; }
        if (wr == 1) G_BAR;
    }
    G_WAIT_V(0);
    G_BAR;
#undef G_SA
#undef G_SB
#undef G_GLDS
#undef G_STAGE_A
#undef G_STAGE_B
#undef G_LDA
#undef G_LDB
#undef G_MMA
#undef G_WAIT_V
#undef G_WAIT_L
#undef G_BAR
#undef G_SCHED
}
template <class S, class E>
__device__ __forceinline__ void gemm_fast8(LAS unsigned char* lds, const S& sch, const E& epi) {
    using namespace pg8;
    const int tid = threadIdx.x, wid = __builtin_amdgcn_readfirstlane(tid >> 6), lane = tid & 63, wr = wid >> 2, wc = wid & 3, fr = lane & 15, fq = lane >> 4;
    const int nt = sch.Kk / 128;
    const int R0 = tid >> 3, C0 = ((tid & 7) ^ (((R0 >> 1) & 1) | (((R0 >> 2) & 1) << 2))) * 8;
    unsigned voffA[2], voffB[2]; unsigned cofA[4], nofA[4], cofB[4], nofB[4];
    size_t hstepA = 0, hstepB = 0;
    if constexpr (!S::GA) { voffA[0] = (unsigned)(R0 * sch.lda + C0 * 2); voffA[1] = (unsigned)((R0 + 64) * sch.lda + C0 * 2); hstepA = (size_t)128 * sch.lda; }
    const int RB0 = S::PERM ? prow(R0) : R0;
    if constexpr (!S::GB) { voffB[0] = (unsigned)(RB0 * sch.ldb + C0 * 2); voffB[1] = (unsigned)((RB0 + 64) * sch.ldb + C0 * 2); hstepB = (size_t)128 * sch.ldb; }
    const size_t kstep = 128;
    const unsigned ldsw = (unsigned)wid * 1024u;
    const int fsw = ((fr >> 1) & 1) | (((fr >> 2) & 1) << 2);
    const int aoff = ((wr * 64 + fr) * 8 + ((2 * fq) ^ fsw)) * 16, aoff1 = ((wr * 64 + fr) * 8 + ((2 * fq + 1) ^ fsw)) * 16, boff = ((wc * 32 + fr) * 8 + ((2 * fq) ^ fsw)) * 16, boff1 = ((wc * 32 + fr) * 8 + ((2 * fq + 1) ^ fsw)) * 16;
#define G_SA(b, h) (((b) * 2 + (h)) * HTB)
#define G_SB(b, h) ((4 + (b) * 2 + (h)) * HTB)
#define G_GLDS(src, dst) __builtin_amdgcn_global_load_lds((const unsigned*)(src), (LAS unsigned*)(dst), 16, 0, 0)
#define G_STAGE_A(bufoff, gp, h, nx) do { if constexpr (S::GA) { _Pragma("unroll") for (int _i = 0; _i < 2; ++_i) { const unsigned _o = (nx) ? nofA[2 * (h) + _i] : cofA[2 * (h) + _i]; G_GLDS((gp) + _o, lds + (bufoff) + ldsw + _i * 8192); } } \
        else { _Pragma("unroll") for (int _i = 0; _i < 2; ++_i) G_GLDS((gp) + (size_t)(h) * hstepA + voffA[_i], lds + (bufoff) + ldsw + _i * 8192); } } while (0)
#define G_STAGE_B(bufoff, gp, h, nx) do { if constexpr (S::GB) { _Pragma("unroll") for (int _i = 0; _i < 2; ++_i) { const unsigned _o = (nx) ? nofB[2 * (h) + _i] : cofB[2 * (h) + _i]; G_GLDS((gp) + _o, lds + (bufoff) + ldsw + _i * 8192); } } \
        else { _Pragma("unroll") for (int _i = 0; _i < 2; ++_i) G_GLDS((gp) + (size_t)(h) * hstepB + voffB[_i], lds + (bufoff) + ldsw + _i * 8192); } } while (0)
#define G_LDA(dst, b, h) do { _Pragma("unroll") for (int m = 0; m < 4; ++m) { const u32x4 _lo = *(const LAS u32x4*)(lds + G_SA(b, h) + aoff + m * 2048), _hi = *(const LAS u32x4*)(lds + G_SA(b, h) + aoff1 + m * 2048); dst[m] = (i32x8){(int)_lo.x, (int)_lo.y, (int)_lo.z, (int)_lo.w, (int)_hi.x, (int)_hi.y, (int)_hi.z, (int)_hi.w}; } } while (0)
#define G_LDB(dst, b, h) do { _Pragma("unroll") for (int n = 0; n < 2; ++n) { const u32x4 _lo = *(const LAS u32x4*)(lds + G_SB(b, h) + boff + n * 2048), _hi = *(const LAS u32x4*)(lds + G_SB(b, h) + boff1 + n * 2048); dst[n] = (i32x8){(int)_lo.x, (int)_lo.y, (int)_lo.z, (int)_lo.w, (int)_hi.x, (int)_hi.y, (int)_hi.z, (int)_hi.w}; } } while (0)
#define G_MMA(ai, bj, At, Bt) do { __builtin_amdgcn_s_setprio(1); _Pragma("unroll") for (int m = 0; m < 4; ++m) _Pragma("unroll") for (int n = 0; n < 2; ++n) \
        acc[ai][bj][m][n] = __builtin_amdgcn_mfma_scale_f32_16x16x128_f8f6f4(Bt[n], At[m], acc[ai][bj][m][n], 0, 0, 0, 0, 0, 0); __builtin_amdgcn_s_setprio(0); } while (0)
#define G_WAIT_V(n) asm volatile("s_waitcnt vmcnt(" #n ")" ::: "memory")
#define G_WAIT_L(n) asm volatile("s_waitcnt lgkmcnt(" #n ")" ::: "memory")
#define G_BAR __builtin_amdgcn_s_barrier()
#define G_SCHED __builtin_amdgcn_sched_barrier(0)
    typename S::U cur, nxt; int ui = 0;
    if (!sch.next(0, cur)) return;
    f32x4 acc[2][2][4][2];
#pragma unroll
    for (int a = 0; a < 2; ++a)
#pragma unroll
        for (int b = 0; b < 2; ++b)
#pragma unroll
            for (int m = 0; m < 4; ++m)
#pragma unroll
                for (int n = 0; n < 2; ++n) acc[a][b][m][n] = (f32x4){0.f, 0.f, 0.f, 0.f};
    i32x8 At[4], B0[2], B1[2];
    const char* cA = sch.baseA(cur); const char* cB = sch.baseB(cur);
    if constexpr (S::GA) {
#pragma unroll
        for (int j = 0; j < 4; ++j) { cofA[j] = sch.goffA(cur, (j >> 1) * 128 + R0 + (j & 1) * 64, C0); nofA[j] = cofA[j]; } }
    if constexpr (S::GB) {
#pragma unroll
        for (int j = 0; j < 4; ++j) { cofB[j] = sch.goffB(cur, (j >> 1) * 128 + RB0 + (j & 1) * 64, C0); nofB[j] = cofB[j]; } }
    G_STAGE_B(G_SB(0, 0), cB, 0, false); G_STAGE_B(G_SB(0, 1), cB, 1, false); G_STAGE_A(G_SA(0, 0), cA, 0, false); G_STAGE_A(G_SA(0, 1), cA, 1, false);
    if (wr == 1) G_BAR;
    G_WAIT_V(2); G_BAR;
    G_STAGE_B(G_SB(1, 0), cB + kstep, 0, false); G_STAGE_A(G_SA(1, 0), cA + kstep, 0, false); G_STAGE_B(G_SB(1, 1), cB + kstep, 1, false);
    G_WAIT_V(6); G_BAR;
    for (;;) {
        const bool has_next = sch.next(ui + 1, nxt);
        const char* nA = has_next ? sch.baseA(nxt) : cA; const char* nB = has_next ? sch.baseB(nxt) : cB;
        if constexpr (S::GA) { if (has_next) {
#pragma unroll
            for (int j = 0; j < 4; ++j) nofA[j] = sch.goffA(nxt, (j >> 1) * 128 + R0 + (j & 1) * 64, C0); } }
        if constexpr (S::GB) { if (has_next) {
#pragma unroll
            for (int j = 0; j < 4; ++j) nofB[j] = sch.goffB(nxt, (j >> 1) * 128 + RB0 + (j & 1) * 64, C0); } }
#pragma unroll 1
        for (int t = 0; t < nt; t += 2) {
            const bool last = (t == nt - 2);
            const char* a1 = cA + (size_t)(t + 1) * kstep;
            const char* a2 = last ? nA : cA + (size_t)(t + 2) * kstep; const char* b2 = last ? nB : cB + (size_t)(t + 2) * kstep;
            const char* a3 = a2 + kstep; const char* b3 = b2 + kstep;
            asm volatile("" : "+s"(a1), "+s"(a2), "+s"(a3), "+s"(b2), "+s"(b3));
            const bool post = (t == 0 && ui > 0);
#define G_WAIT_POST() do { if (post) { if constexpr (E::NVM == 8) G_WAIT_V(16); else if constexpr (E::NVM == 16) G_WAIT_V(24); else if constexpr (E::NVM == 32) G_WAIT_V(40); else G_WAIT_V(8); } else G_WAIT_V(8); } while (0)
            G_LDB(B0, 0, 0); G_LDB(B1, 0, 1); G_SCHED; G_LDA(At, 0, 0); if (!post) G_STAGE_A(G_SA(1, 1), a1, 1, false);
            G_WAIT_POST(); G_WAIT_L(0); G_BAR; G_MMA(0, 0, At, B0); G_MMA(0, 1, At, B1); G_BAR; G_SCHED;
            G_LDA(At, 0, 1); G_STAGE_B(G_SB(0, 0), b2, 0, last); G_STAGE_B(G_SB(0, 1), b2, 1, last); G_STAGE_A(G_SA(0, 0), a2, 0, last);
            G_WAIT_POST(); G_WAIT_L(0); G_BAR; G_MMA(1, 0, At, B0); G_MMA(1, 1, At, B1); G_BAR; G_SCHED;
            G_LDB(B0, 1, 0); G_LDB(B1, 1, 1); G_SCHED; G_LDA(At, 1, 0); G_STAGE_A(G_SA(0, 1), a2, 1, last);
            G_WAIT_POST(); G_WAIT_L(0); G_BAR; G_MMA(0, 0, At, B0); G_MMA(0, 1, At, B1); G_BAR; G_SCHED;
            G_LDA(At, 1, 1); G_STAGE_B(G_SB(1, 0), b3, 0, last); G_STAGE_B(G_SB(1, 1), b3, 1, last); G_STAGE_A(G_SA(1, 0), a3, 0, last);
            G_WAIT_V(8); G_WAIT_L(0); G_BAR; G_MMA(1, 0, At, B0); G_MMA(1, 1, At, B1); G_BAR; G_SCHED;
#undef G_WAIT_POST
        }
        if (wr == 0) G_BAR;
        if (has_next) { const char* n1 = nA + kstep; asm volatile("" : "+s"(n1)); G_STAGE_A(G_SA(1, 1), n1, 1, true); }
        { int tz = threadIdx.x; asm volatile("" : "+v"(tz));
          const int ewid = tz >> 6, el = tz & 63; epi(acc, cur, ewid >> 2, ewid & 3, el & 15, el >> 4); }
        if (!has_next) break;
#pragma unroll
        for (int a = 0; a < 2; ++a)
#pragma unroll
            for (int b = 0; b < 2; ++b)
#pragma unroll
                for (int m = 0; m < 4; ++m)
#pragma unroll
                    for (int n = 0; n < 2; ++n) acc[a][b][m][n] = (f32x4){0.f, 0.f, 0.f, 0.f};
        cur = nxt; cA = nA; cB = nB; ++ui;
        if constexpr (S::GA) {
#pragma unroll
            for (int j = 0; j < 4; ++j) cofA[j] = nofA[j]; }
        if constexpr (S::GB) {
#pragma unroll
            for (int j = 0; j < 4; ++j) cofB[j] = nofB[j]; }
        if (wr == 1) G_BAR;
    }
    G_WAIT_V(0);
    G_BAR;
#undef G_SA
#undef G_SB
#undef G_GLDS
#undef G_STAGE_A
#undef G_STAGE_B
#undef G_LDA
#undef G_LDB
#undef G_MMA
#undef G_WAIT_V
#undef G_WAIT_L
#undef G_BAR
#undef G_SCHED
}
#ifndef MK_FAST
#define MK_FAST 1
#endif
#if MK_FAST
#define GEMM_PHASE(lds, S, E) gemm_fast(lds, S, E)
#else
#define GEMM_PHASE(lds, S, E) gemm_simple(lds, S, E)
#endif


template <int ES, int NBJ, class PF, bool NT = true>
__device__ __forceinline__ void epi_coalesced(LAS unsigned char* el, const PF& pf, unsigned char* gbase, size_t pitch, int wr, int wc, int fr, int fq) {
    constexpr int RB = 128 * NBJ * ES, SL = RB / 16, MS = (16384 / (RB * 32)) > 4 ? 4 : (16384 / (RB * 32)), RP = 32 * MS, RI = 64 / SL, SM = SL < 16 ? SL - 1 : 15;
    const int wave = wr * 4 + wc, lane = fq * 16 + fr;
#pragma unroll
    for (int ai = 0; ai < 2; ++ai)
#pragma unroll
        for (int mp = 0; mp < 4 / MS; ++mp) {
#pragma unroll
            for (int mm = 0; mm < MS; ++mm) { const int m = mp * MS + mm, lr = wr * (16 * MS) + mm * 16 + fr;
#pragma unroll
                for (int bj = 0; bj < NBJ; ++bj) { const int cb = (bj * 128 + wc * 32 + 8 * fq) * ES; LAS unsigned char* p = el + lr * RB + ((((cb >> 4) ^ (lr & SM))) << 4) + (cb & 15);
                    if constexpr (ES == 1) *(LAS u32x2*)p = pf.p8(ai, m, bj); else *(LAS u32x4*)p = pf.p16(ai, m, bj); } }
            LDS_WAIT(); __builtin_amdgcn_s_barrier(); asm volatile("" ::: "memory"); __builtin_amdgcn_sched_barrier(0);
#pragma unroll
            for (int j = 0; j < 2; ++j) { const int lrr = wave * (RP / 8) + j * RI + lane / SL, c = lane % SL;
                const u32x4 v = *(const LAS u32x4*)(el + lrr * RB + ((c ^ (lrr & SM)) << 4));
                const int grow = ai * 128 + (lrr / (16 * MS)) * 64 + (mp * MS + ((lrr >> 4) % MS)) * 16 + (lrr & 15);
                if constexpr (NT) __builtin_nontemporal_store(v, (u32x4*)(gbase + (size_t)grow * pitch + c * 16)); else *(u32x4*)(gbase + (size_t)grow * pitch + c * 16) = v; }
            LDS_WAIT(); __builtin_amdgcn_s_barrier(); asm volatile("" ::: "memory"); __builtin_amdgcn_sched_barrier(0);
        }
}
#define ROWLOOP _Pragma("unroll") for (int ai = 0; ai < 2; ++ai) _Pragma("unroll") for (int m = 0; m < 4; ++m)
#define UROW (ai * 128 + wr * 64 + m * 16 + fr)
#define UCOL(bj, n) ((bj) * 128 + wc * 32 + (n) * 16 + 4 * fq)
#define UCOLP(bj) ((bj) * 128 + wc * 32 + 8 * fq)
__device__ __forceinline__ u32x4 pk8(const f32x4 a, const f32x4 b) { u32x4 w; w.x = pk2(a.x, a.y); w.y = pk2(a.z, a.w); w.z = pk2(b.x, b.y); w.w = pk2(b.z, b.w); return w; }
typedef f32x4 AccT[2][2][4][2];

struct UnitD { int pm, pn; };
template <bool PERM_> struct SchedDenseT {
    typedef UnitD U;
    static constexpr bool GA = false, GB = false, PERM = PERM_;
    const bf16* A; const bf16* Bt; int lda, ldb, Kk, nM, nN, vcu;
    __device__ __forceinline__ const char* baseA(const U& u) const { return (const char*)(A + (size_t)u.pm * 256 * lda); }
    __device__ __forceinline__ const char* baseB(const U& u) const { return (const char*)(Bt + (size_t)u.pn * 256 * ldb); }
    __device__ __forceinline__ bool next(int i, U& u) const { const int L = i * NWG + vcu; if (L >= nM * nN) return false; u.pm = L / nN; u.pn = L % nN; return true; }
    __device__ __forceinline__ int K(const U&) const { return Kk; }
    __device__ __forceinline__ const char* rowA(const U& u, int r) const { return (const char*)(A + (size_t)(u.pm * 256 + r) * lda); }
    __device__ __forceinline__ const char* rowB(const U& u, int r) const { return (const char*)(Bt + (size_t)(u.pn * 256 + r) * ldb); }
};
typedef SchedDenseT<false> SchedDense; typedef SchedDenseT<true> SchedDenseP;
struct SchedDense8 {
    typedef UnitD U;
    static constexpr bool GA = false, GB = false, PERM = true;
    const unsigned char* A; const unsigned char* Bt; int lda, ldb, Kk, nM, nN, vcu;
    __device__ __forceinline__ const char* baseA(const U& u) const { return (const char*)(A + (size_t)u.pm * 256 * lda); }
    __device__ __forceinline__ const char* baseB(const U& u) const { return (const char*)(Bt + (size_t)u.pn * 256 * ldb); }
    __device__ __forceinline__ bool next(int i, U& u) const { const int L = i * NWG + vcu; if (L >= nM * nN) return false; u.pm = L / nN; u.pn = L % nN; return true; }
};
struct EpiXZ {
    static constexpr int NVM = 16;
    bf16* XR; bf16* GG;
    __device__ __forceinline__ void operator()(const AccT& acc, const UnitD& u, int wr, int wc, int fr, int fq) const {
        const bool isg = u.pn >= 4; bf16* base = isg ? GG : XR; const int c0 = (u.pn & 3) * 256;
        ROWLOOP { bf16* rp = base + (size_t)(u.pm * 256 + UROW) * D + c0;
#pragma unroll
            for (int bj = 0; bj < 2; ++bj) { f32x4 v0 = acc[ai][bj][m][0] * 0.015625f, v1 = acc[ai][bj][m][1] * 0.015625f;
                if (isg) {
#pragma unroll
                    for (int j = 0; j < 4; ++j) { v0[j] = gelu_tanh(v0[j]); v1[j] = gelu_tanh(v1[j]); } }
                *(u32x4*)(rp + UCOLP(bj)) = pk8(v0, v1); } }
    }
};
struct EpiResF32 {
    static constexpr int NVM = 0;
    const float* R; float* O; int ldc;
    __device__ __forceinline__ void operator()(const AccT& acc, const UnitD& u, int wr, int wc, int fr, int fq) const {
        const size_t base = (size_t)(u.pm * 256 + wr * 64 + fr) * ldc + u.pn * 256;
        f32x4 cur[4], nxt[4];
#pragma unroll
        for (int q = 0; q < 4; ++q) cur[q] = *(const f32x4*)(R + base + UCOL(q >> 1, q & 1));
#pragma unroll
        for (int g = 0; g < 8; ++g) { const int ai = g >> 2, m = g & 3; const size_t ro = base + (size_t)(ai * 128 + m * 16) * ldc;
            if (g < 7) { const size_t rn = base + (size_t)(((g + 1) >> 2) * 128 + ((g + 1) & 3) * 16) * ldc;
#pragma unroll
                for (int q = 0; q < 4; ++q) nxt[q] = *(const f32x4*)(R + rn + UCOL(q >> 1, q & 1)); }
#pragma unroll
            for (int q = 0; q < 4; ++q) __builtin_nontemporal_store((f32x4)(cur[q] * ALPHA + acc[ai][q >> 1][m][q & 1]), (f32x4*)(O + ro + UCOL(q >> 1, q & 1)));
#pragma unroll
            for (int q = 0; q < 4; ++q) cur[q] = nxt[q]; }
    }
};
struct EpiF32 {
    static constexpr int NVM = 32;
    float* O; int ldc;
    __device__ __forceinline__ void operator()(const AccT& acc, const UnitD& u, int wr, int wc, int fr, int fq) const {
        ROWLOOP { const size_t ro = (size_t)(u.pm * 256 + UROW) * ldc + u.pn * 256;
#pragma unroll
            for (int bj = 0; bj < 2; ++bj)
#pragma unroll
                for (int n = 0; n < 2; ++n) *(f32x4*)(O + ro + UCOL(bj, n)) = acc[ai][bj][m][n]; }
    }
};

struct UnitG { int pm, blk, pn; };
struct SchedGate {
    typedef UnitG U;
    static constexpr bool GA = false, GB = false, PERM = true; static constexpr int Kk = 256, lda = D, ldb = 256;
    const bf16* XC; const bf16* WgT; int vcu;
    __device__ __forceinline__ const char* baseA(const U& u) const { return (const char*)(XC + (size_t)u.pm * 256 * D + u.blk * 256); }
    __device__ __forceinline__ const char* baseB(const U& u) const { return (const char*)(WgT + (size_t)(u.blk * 512 + u.pn * 256) * 256); }
    __device__ __forceinline__ bool next(int i, U& u) const { const int L = i * NWG + vcu; if (L >= 128 * 8) return false; u.pm = L >> 3; u.blk = (L >> 1) & 3; u.pn = L & 1; return true; }
    __device__ __forceinline__ int K(const U&) const { return 256; }
    __device__ __forceinline__ const char* rowA(const U& u, int r) const { return (const char*)(XC + (size_t)(u.pm * 256 + r) * D + u.blk * 256); }
    __device__ __forceinline__ const char* rowB(const U& u, int r) const { return (const char*)(WgT + (size_t)(u.blk * 512 + u.pn * 256 + r) * 256); }
};
struct EpiGate {
    static constexpr int NVM = 0;
    const bf16* XC; const float *ba, *bx, *lam; bf16* LA; bf16* UU;
    __device__ __forceinline__ void operator()(const AccT& acc, const UnitG& u, int wr, int wc, int fr, int fq) const {
        const int c0 = u.blk * 256 + u.pn * 128 + wc * 32 + 8 * fq;
        f32x4 vba[2], vbx[2], sp[2];
#pragma unroll
        for (int n = 0; n < 2; ++n) { vba[n] = *(const f32x4*)(ba + c0 + 4 * n); vbx[n] = *(const f32x4*)(bx + c0 + 4 * n); const f32x4 vl = *(const f32x4*)(lam + c0 + 4 * n);
#pragma unroll
            for (int j = 0; j < 4; ++j) { const float x = __expf(-vl[j]); sp[n][j] = 8.0f * x * (1.0f - x * (0.5f - x * (1.0f / 3.0f))); } }
        const size_t base = (size_t)(u.pm * 256 + wr * 64 + fr) * D + c0;
        u32x4 xw = *(const u32x4*)(XC + base);
#pragma unroll
        for (int g = 0; g < 8; ++g) { const int ai = g >> 2, m = g & 3; const size_t ro = base + (size_t)(ai * 128 + m * 16) * D;
            u32x4 xn = xw; if (g < 7) xn = *(const u32x4*)(XC + base + (size_t)(((g + 1) >> 2) * 128 + ((g + 1) & 3) * 16) * D);
            const float xc[8] = {bf_lo(xw.x), bf_hi(xw.x), bf_lo(xw.y), bf_hi(xw.y), bf_lo(xw.z), bf_hi(xw.z), bf_lo(xw.w), bf_hi(xw.w)};
            f32x4 la[2], uu[2];
#pragma unroll
            for (int n = 0; n < 2; ++n) { const f32x4 ga = acc[ai][0][m][n] + vba[n], gx = acc[ai][1][m][n] + vbx[n];
#pragma unroll
                for (int j = 0; j < 4; ++j) { const float r = sigmoidf_(ga[j]), ig = sigmoidf_(gx[j]); const float l = -r * sp[n][j]; la[n][j] = l;
                    const float mult = sqrtf(fmaxf(1.0f - __expf(2.0f * l), 0.f)); uu[n][j] = mult * ig * xc[4 * n + j]; } }
            *(u32x4*)(LA + ro) = pk8(la[0], la[1]); *(u32x4*)(UU + ro) = pk8(uu[0], uu[1]); xw = xn; }
    }
};

struct UnitE { int rb, pn, e, ti; };
struct SchedG1 {
    typedef UnitE U;
    static constexpr bool GA = true, GB = false, PERM = true; static constexpr int Kk = D, lda = D, ldb = D;
    const unsigned char* X; const unsigned char* W13T; const int* ROWA; const int* BLKE; int nrbt, vcu; int ev; const LAS unsigned* tab;
    __device__ __forceinline__ const char* baseA(const U&) const { return (const char*)X; }
    __device__ __forceinline__ const char* baseB(const U& u) const { return (const char*)(W13T + ((size_t)u.e * 512 + u.pn * 256) * D); }
    __device__ __forceinline__ unsigned goffA(const U& u, int r, int C) const { return tab[u.ti * 256 + r] + (unsigned)C * 2u; }
    __device__ __forceinline__ unsigned goffB(const U&, int, int) const { return 0u; }
    __device__ __forceinline__ bool next(int i, U& u) const { const int L = i * NWG + vcu; const int rb = L >> 1; if (rb >= nrbt) return false; u.rb = rb; u.pn = L & 1; u.ti = i; u.e = __builtin_amdgcn_readlane(ev, i); return true; }
    __device__ __forceinline__ int K(const U&) const { return D; }
};
struct PFSwiGLU { const AccT& acc;
    __device__ __forceinline__ u32x2 p8(int ai, int m, int) const { f32x4 h0, h1;
#pragma unroll
        for (int j = 0; j < 4; ++j) { const float a0 = acc[ai][0][m][0][j] * 0.015625f, a1 = acc[ai][0][m][1][j] * 0.015625f; h0[j] = a0 * sigmoidf_(a0) * (acc[ai][1][m][0][j] * 0.015625f); h1[j] = a1 * sigmoidf_(a1) * (acc[ai][1][m][1][j] * 0.015625f); }
        int t0 = __builtin_amdgcn_cvt_pk_fp8_f32(h0.x, h0.y, 0, false); t0 = __builtin_amdgcn_cvt_pk_fp8_f32(h0.z, h0.w, t0, true);
        int t1 = __builtin_amdgcn_cvt_pk_fp8_f32(h1.x, h1.y, 0, false); t1 = __builtin_amdgcn_cvt_pk_fp8_f32(h1.z, h1.w, t1, true); u32x2 w; w.x = (unsigned)t0; w.y = (unsigned)t1; return w; }
    __device__ __forceinline__ u32x4 p16(int, int, int) const { return (u32x4){0u, 0u, 0u, 0u}; } };
struct EpiSwiGLU {
    static constexpr int NVM = 0; static constexpr bool DEFER = false; static constexpr int soff(int) { return 0; }
    unsigned char* HID; LAS unsigned char* el;
    __device__ __forceinline__ void operator()(const AccT& acc, const UnitE& u, int wr, int wc, int fr, int fq) const {
        epi_coalesced<1, 1, PFSwiGLU, false>(el, PFSwiGLU{acc}, HID + ((size_t)u.rb * 256) * DE + u.pn * 128, DE, wr, wc, fr, fq);
    }
};
struct SchedG2 {
    typedef UnitE U;
    static constexpr bool GA = false, GB = false, PERM = true;
    const unsigned char* HID; const unsigned char* W2T; const int* BLKE; int nrbt, vcu; int ev; int Kk, lda, ldb;
    __device__ __forceinline__ const char* baseA(const U& u) const { return (const char*)(HID + (size_t)u.rb * 256 * DE); }
    __device__ __forceinline__ const char* baseB(const U& u) const { return (const char*)(W2T + ((size_t)u.e * D + u.pn * 256) * DE); }
    __device__ __forceinline__ bool next(int i, U& u) const { const int L = i * NWG + vcu; const int rb = L >> 2; if (rb >= nrbt) return false; u.rb = rb; u.pn = L & 3; u.ti = i; u.e = __builtin_amdgcn_readlane(ev, i); return true; }
    __device__ __forceinline__ int K(const U&) const { return DE; }
};
struct PFScatter { const AccT& acc;
    __device__ __forceinline__ u32x2 p8(int ai, int m, int bj) const { const f32x4 v0 = acc[ai][bj][m][0] * 0.25f, v1 = acc[ai][bj][m][1] * 0.25f;
        int t0 = __builtin_amdgcn_cvt_pk_fp8_f32(v0.x, v0.y, 0, false); t0 = __builtin_amdgcn_cvt_pk_fp8_f32(v0.z, v0.w, t0, true);
        int t1 = __builtin_amdgcn_cvt_pk_fp8_f32(v1.x, v1.y, 0, false); t1 = __builtin_amdgcn_cvt_pk_fp8_f32(v1.z, v1.w, t1, true); u32x2 w; w.x = (unsigned)t0; w.y = (unsigned)t1; return w; }
    __device__ __forceinline__ u32x4 p16(int, int, int) const { return (u32x4){0u, 0u, 0u, 0u}; } };
struct EpiScatter {
    static constexpr int NVM = 8; static constexpr bool DEFER = false; static constexpr int soff(int) { return 0; }
    bf16* YA; int dry; LAS unsigned char* el;
    __device__ __forceinline__ void operator()(const AccT& acc, const UnitE& u, int wr, int wc, int fr, int fq) const {
        epi_coalesced<1, 2>(el, PFScatter{acc}, (unsigned char*)YA + ((size_t)u.rb * 256) * D + u.pn * 256, D, wr, wc, fr, fq);
    }
};

__device__ __forceinline__ int rho_to_tok(int rho, int g) { const int sh = 14 - 2 * g; const int rp = rho & 16383; return (rho & ~16383) + (rp >> sh) + ((rp & ((1 << sh) - 1)) << (2 * g)); }
__device__ __forceinline__ int tok_to_rho(int t, int g) { const int sh = 14 - 2 * g; const int tp = t & 16383; return (t & ~16383) + ((tp & ((1 << (2 * g)) - 1)) << sh) + (tp >> (2 * g)); }
struct UnitQ { int type, g, pm, pn; };
struct SchedQK {
    typedef UnitQ U;
    static constexpr bool GA = false, GB = false, PERM = true; static constexpr int Kk = D, ldb = D;
    const unsigned char* X; const unsigned char* WqkT; int g, lda, vcu;
    __device__ __forceinline__ bool next(int i, U& u) const { const int L = i * NWG + vcu; if (L >= 512) return false; u.type = 0; u.g = g; u.pm = L >> 2; u.pn = L & 3; return true; }
    __device__ __forceinline__ int K(const U&) const { return D; }
    __device__ __forceinline__ const char* baseA(const U& u) const { return (const char*)(X + (size_t)rho_to_tok(u.pm * 256, g) * D); }
    __device__ __forceinline__ const char* baseB(const U& u) const { return (const char*)(WqkT + ((size_t)g * 1024 + u.pn * 256) * D); }
    __device__ __forceinline__ const char* rowA(const U& u, int r) const { return (const char*)(X + (size_t)rho_to_tok(u.pm * 256 + r, g) * D); }
    __device__ __forceinline__ const char* rowB(const U& u, int r) const { return (const char*)(WqkT + ((size_t)g * 1024 + u.pn * 256 + r) * D); }
};
struct SchedVT {
    typedef UnitQ U;
    static constexpr bool GA = false, GB = false, PERM = true; static constexpr int Kk = D, lda = D;
    const unsigned char* X; const unsigned char* WvT; int g, ldb, vcu;
    __device__ __forceinline__ bool next(int i, U& u) const { const int L = i * NWG + vcu; if (L >= 256) return false; u.type = 1; u.g = g; u.pn = L >> 1; u.pm = L & 1; return true; }
    __device__ __forceinline__ int K(const U&) const { return D; }
    __device__ __forceinline__ const char* baseA(const U& u) const { return (const char*)(WvT + ((size_t)g * 512 + u.pm * 256) * D); }
    __device__ __forceinline__ const char* baseB(const U& u) const { return (const char*)(X + (size_t)rho_to_tok(u.pn * 256, g) * D); }
    __device__ __forceinline__ const char* rowA(const U& u, int r) const { return (const char*)(WvT + ((size_t)g * 512 + u.pm * 256 + r) * D); }
    __device__ __forceinline__ const char* rowB(const U& u, int r) const { return (const char*)(X + (size_t)rho_to_tok(u.pn * 256 + r, g) * D); }
};
struct PFScaled { const AccT& acc; float sc;
    __device__ __forceinline__ u32x2 p8(int, int, int) const { return (u32x2){0u, 0u}; }
    __device__ __forceinline__ u32x4 p16(int ai, int m, int bj) const { return pk8(acc[ai][bj][m][0] * sc, acc[ai][bj][m][1] * sc); } };
struct EpiQKV {
    static constexpr int NVM = 16; static constexpr bool DEFER = false; static constexpr int soff(int) { return 0; }
    bf16* QK; bf16* VT; LAS unsigned char* el;
    __device__ __forceinline__ void operator()(const AccT& acc, const UnitQ& u, int wr, int wc, int fr, int fq) const {
        bf16* base; size_t ldc;
        if (u.type == 0) { base = QK + (size_t)u.g * M * 1024; ldc = 1024; } else { base = VT + (size_t)u.g * 512 * M; ldc = M; }
        epi_coalesced<2, 2>(el, PFScaled{acc, 0.015625f}, (unsigned char*)(base + (size_t)(u.pm * 256) * ldc + u.pn * 256), ldc * 2, wr, wc, fr, fq);
    }
};

__device__ __forceinline__ void tr_item(const float* src, int spitch, bf16* dst, int dpitch, LAS float* scr, int lane) {
#pragma unroll 4
    for (int i = 0; i < 16; ++i) { const int k = 4 * i + (lane >> 4), n4 = (lane & 15) * 4; const f32x4 v = *(const f32x4*)(src + (size_t)k * spitch + n4);
        LAS float* s = scr + k * 65 + n4; s[0] = v.x; s[1] = v.y; s[2] = v.z; s[3] = v.w; }
    LDS_WAIT(); asm volatile("" ::: "memory");
    const int c = lane & 7;
#pragma unroll
    for (int j = 0; j < 8; ++j) { const int n = 8 * j + (lane >> 3); const LAS float* s = scr + (8 * c) * 65 + n;
        u32x4 o; o.x = pk2(s[0], s[65]); o.y = pk2(s[2 * 65], s[3 * 65]); o.z = pk2(s[4 * 65], s[5 * 65]); o.w = pk2(s[6 * 65], s[7 * 65]);
        *(u32x4*)(dst + (size_t)n * dpitch + 8 * c) = o; }
    LDS_WAIT(); asm volatile("" ::: "memory");
}
__device__ __forceinline__ void tr_item8(const float* src, int spitch, unsigned char* dst, int dpitch, LAS float* scr, int lane) {
#pragma unroll 4
    for (int i = 0; i < 16; ++i) { const int k = 4 * i + (lane >> 4), n4 = (lane & 15) * 4; const f32x4 v = *(const f32x4*)(src + (size_t)k * spitch + n4);
        LAS float* s = scr + k * 65 + n4; s[0] = v.x; s[1] = v.y; s[2] = v.z; s[3] = v.w; }
    LDS_WAIT(); asm volatile("" ::: "memory");
    const int c = lane & 7;
#pragma unroll
    for (int j = 0; j < 8; ++j) { const int n = 8 * j + (lane >> 3); const LAS float* s = scr + (8 * c) * 65 + n;
        int t0 = __builtin_amdgcn_cvt_pk_fp8_f32(s[0] * 64.f, s[65] * 64.f, 0, false); t0 = __builtin_amdgcn_cvt_pk_fp8_f32(s[2 * 65] * 64.f, s[3 * 65] * 64.f, t0, true);
        int t1 = __builtin_amdgcn_cvt_pk_fp8_f32(s[4 * 65] * 64.f, s[5 * 65] * 64.f, 0, false); t1 = __builtin_amdgcn_cvt_pk_fp8_f32(s[6 * 65] * 64.f, s[7 * 65] * 64.f, t1, true);
        u32x2 o; o.x = (unsigned)t0; o.y = (unsigned)t1; *(u32x2*)(dst + (size_t)n * dpitch + 8 * c) = o; }
    LDS_WAIT(); asm volatile("" ::: "memory");
}
template <class RowMap>
__device__ __forceinline__ void tr_matrix(Frame& F, const float* W, int K, int N, bf16* WT, int dpitch, RowMap drow) {
    LAS float* scr = (LAS float*)(F.lds + F.wave * 16640);
    const int nkb = K / 64, nnb = N / 64;
    for (int it = F.vcu * NWAVES + F.wave; it < nkb * nnb; it += NGW) { const int kb = it / nnb, nb = it % nnb;
        tr_item(W + (size_t)(kb * 64) * N + nb * 64, N, WT + (size_t)drow(nb * 64) * dpitch + kb * 64, dpitch, scr, F.lane); }
}
template <class RowMap>
__device__ __forceinline__ void tr_matrix8(Frame& F, const float* W, int K, int N, unsigned char* WT, int dpitch, RowMap drow) {
    LAS float* scr = (LAS float*)(F.lds + F.wave * 16640);
    const int nkb = K / 64, nnb = N / 64;
    for (int it = F.vcu * NWAVES + F.wave; it < nkb * nnb; it += NGW) { const int kb = it / nnb, nb = it % nnb;
        tr_item8(W + (size_t)(kb * 64) * N + nb * 64, N, WT + (size_t)drow(nb * 64) * dpitch + kb * 64, dpitch, scr, F.lane); }
}
__device__ __forceinline__ void cv_src(int it, const float* w1, const float* w3, const float* w2, const float* s1, const float* s3, const float* s2, const float*& src, int& spitch) {
    const int e = it / 192, r = it % 192, which = r >> 6, tile = r & 63;
    if (which < 2) { const float* W = (e < 256) ? (which == 0 ? w1 : w3) + (size_t)e * (size_t)(D * DE) : (which == 0 ? s1 : s3); src = W + (size_t)((tile >> 2) * 64) * DE + (tile & 3) * 64; spitch = DE; }
    else { const float* W = (e < 256) ? w2 + (size_t)e * (size_t)(DE * D) : s2; src = W + (size_t)((tile >> 4) * 64) * D + (tile & 15) * 64; spitch = D; }
}
__device__ __forceinline__ void convert_experts(Frame& F, const float* w1, const float* w3, const float* w2, const float* s1, const float* s3, const float* s2, int layer, int part, int nparts) {
    LAS float* scr = (LAS float*)(F.lds + F.wave * 16640);
    unsigned char* W13T = WSP(unsigned char, WS_W13) + (size_t)layer * W13_LB; unsigned char* W2T = WSP(unsigned char, WS_W2) + (size_t)layer * W2_LB;
    const int lane = F.lane; const int NTOT = 257 * 192; const int it0 = (int)((long)NTOT * part / nparts), NIT = (int)((long)NTOT * (part + 1) / nparts);
    f32x4 cur[16], nxt[16];
    int it = it0 + F.vcu * NWAVES + F.wave;
    if (it < NIT) { const float* src; int sp; cv_src(it, w1, w3, w2, s1, s3, s2, src, sp);
#pragma unroll
        for (int i = 0; i < 16; ++i) cur[i] = __builtin_nontemporal_load((const f32x4*)(src + (size_t)(4 * i + (lane >> 4)) * sp + (lane & 15) * 4)); }
#pragma unroll 1
    for (; it < NIT; it += NGW) {
        const int itn = it + NGW;
        if (itn < NIT) { const float* src; int sp; cv_src(itn, w1, w3, w2, s1, s3, s2, src, sp);
#pragma unroll
            for (int i = 0; i < 16; ++i) nxt[i] = __builtin_nontemporal_load((const f32x4*)(src + (size_t)(4 * i + (lane >> 4)) * sp + (lane & 15) * 4)); }
#pragma unroll
        for (int i = 0; i < 16; ++i) { const int k = 4 * i + (lane >> 4), n4 = (lane & 15) * 4; LAS float* s = scr + k * 65 + n4; s[0] = cur[i].x; s[1] = cur[i].y; s[2] = cur[i].z; s[3] = cur[i].w; }
        LDS_WAIT(); asm volatile("" ::: "memory");
        const int e = it / 192, r = it % 192, which = r >> 6, tile = r & 63, c = lane & 7;
        if (which < 2) { const int kb = tile >> 2, nb = tile & 3; const int drow = (nb >> 1) * 256 + which * 128 + (nb & 1) * 64; unsigned char* dst = W13T + ((size_t)e * 512 + drow) * D + kb * 64;
#pragma unroll
            for (int j = 0; j < 8; ++j) { const int n = 8 * j + (lane >> 3); const LAS float* s = scr + (8 * c) * 65 + n;
                int t0 = __builtin_amdgcn_cvt_pk_fp8_f32(s[0] * 64.f, s[65] * 64.f, 0, false); t0 = __builtin_amdgcn_cvt_pk_fp8_f32(s[2 * 65] * 64.f, s[3 * 65] * 64.f, t0, true);
                int t1 = __builtin_amdgcn_cvt_pk_fp8_f32(s[4 * 65] * 64.f, s[5 * 65] * 64.f, 0, false); t1 = __builtin_amdgcn_cvt_pk_fp8_f32(s[6 * 65] * 64.f, s[7 * 65] * 64.f, t1, true);
                u32x2 o; o.x = (unsigned)t0; o.y = (unsigned)t1; __builtin_nontemporal_store(o, (u32x2*)(dst + (size_t)n * D + 8 * c)); } }
        else { const int kb = tile >> 4, nb = tile & 15; unsigned char* dst = W2T + ((size_t)e * D + nb * 64) * DE + kb * 64;
#pragma unroll
            for (int j = 0; j < 8; ++j) { const int n = 8 * j + (lane >> 3); const LAS float* s = scr + (8 * c) * 65 + n;
                int t0 = __builtin_amdgcn_cvt_pk_fp8_f32(s[0] * 64.f, s[65] * 64.f, 0, false); t0 = __builtin_amdgcn_cvt_pk_fp8_f32(s[2 * 65] * 64.f, s[3 * 65] * 64.f, t0, true);
                int t1 = __builtin_amdgcn_cvt_pk_fp8_f32(s[4 * 65] * 64.f, s[5 * 65] * 64.f, 0, false); t1 = __builtin_amdgcn_cvt_pk_fp8_f32(s[6 * 65] * 64.f, s[7 * 65] * 64.f, t1, true);
                u32x2 o; o.x = (unsigned)t0; o.y = (unsigned)t1; __builtin_nontemporal_store(o, (u32x2*)(dst + (size_t)n * DE + 8 * c)); } }
        LDS_WAIT(); asm volatile("" ::: "memory");
#pragma unroll
        for (int i = 0; i < 16; ++i) cur[i] = nxt[i];
    }
}
struct MapId { __device__ int operator()(int n0) const { return n0; } };
struct MapGate { int which; __device__ int operator()(int n0) const { return (n0 >> 7) * 256 + which * 128 + (n0 & 127); } };
struct MapQ { __device__ int operator()(int n0) const { return (n0 >> 9) * 1024 + (n0 & 511); } };
struct MapKV { __device__ int operator()(int n0) const { return n0 < 1536 ? (n0 >> 9) * 1024 + 512 + (n0 & 511) : 3072 + (n0 - 1536); } };

__device__ __forceinline__ void p0_prologue(Frame& F, const Args& A) {
    { const float* x = A.in[0]; unsigned char* XQ = WSP(unsigned char, WS_RA + RA_XB);
      for (size_t i = (size_t)F.vcu * NTHR + F.tid; i < (size_t)M * D / 8; i += NGT) { const f32x4 a = *(const f32x4*)(x + i * 8), b = *(const f32x4*)(x + i * 8 + 4);
          int t0 = __builtin_amdgcn_cvt_pk_fp8_f32(a.x, a.y, 0, false); t0 = __builtin_amdgcn_cvt_pk_fp8_f32(a.z, a.w, t0, true);
          int t1 = __builtin_amdgcn_cvt_pk_fp8_f32(b.x, b.y, 0, false); t1 = __builtin_amdgcn_cvt_pk_fp8_f32(b.z, b.w, t1, true);
          u32x2 o; o.x = (unsigned)t0; o.y = (unsigned)t1; *(u32x2*)(XQ + i * 8) = o; } }
    tr_matrix8(F, A.in[1], D, 2048, WSP(unsigned char, WS_WIN), D, MapId());
    for (int b = 0; b < 4; ++b) { tr_matrix(F, A.in[4] + b * 65536, 256, 256, WSP(bf16, WS_WG) + (size_t)b * 512 * 256, 256, MapGate{0});
                                  tr_matrix(F, A.in[6] + b * 65536, 256, 256, WSP(bf16, WS_WG) + (size_t)b * 512 * 256, 256, MapGate{1}); }
    tr_matrix(F, A.in[9], D, D, WSP(bf16, WS_WOUT), D, MapId());
    tr_matrix8(F, A.in[11], D, QW, WSP(unsigned char, WS_WQK), D, MapQ());
    tr_matrix8(F, A.in[10], D, 2 * QW, WSP(unsigned char, WS_WQK), D, MapKV());
    tr_matrix(F, A.in[12], OW, D, WSP(bf16, WS_WO), OW, MapId());
    for (int l = 0; l < 2; ++l) tr_matrix(F, A.in[13] + (size_t)l * D * NE, D, NE, WSP(bf16, WS_WR) + (size_t)l * NE * D, D, MapId());
}
static_assert(WS_WV == WS_WQK + (size_t)3072 * 1024 * 2, "WvT must follow WqkT");

__device__ __forceinline__ void ln_store(f32x4 (&v)[4], const float* g, const float* b, float* of, bf16* ob, int lane, unsigned char* oq = nullptr) {
    float s = 0.f;
#pragma unroll
    for (int j = 0; j < 4; ++j) s += (v[j].x + v[j].y) + (v[j].z + v[j].w);
    const float mean = wave_sum(s) * (1.f / D); float s2 = 0.f;
#pragma unroll
    for (int j = 0; j < 4; ++j) { v[j] = v[j] - mean; s2 += (v[j].x * v[j].x + v[j].y * v[j].y) + (v[j].z * v[j].z + v[j].w * v[j].w); }
    const float rstd = 1.f / sqrtf(wave_sum(s2) * (1.f / D) + LN_EPS);
#pragma unroll
    for (int j = 0; j < 4; ++j) { const int c = 4 * lane + 256 * j; const f32x4 gg = *(const f32x4*)(g + c), bb = *(const f32x4*)(b + c); const f32x4 y = v[j] * rstd * gg + bb;
        if (of) __builtin_nontemporal_store(y, (f32x4*)(of + c));
        if (ob) { u32x2 w; w.x = pk2(y.x, y.y); w.y = pk2(y.z, y.w); *(u32x2*)(ob + c) = w; }
        if (oq) { int t = __builtin_amdgcn_cvt_pk_fp8_f32(y.x, y.y, 0, false); t = __builtin_amdgcn_cvt_pk_fp8_f32(y.z, y.w, t, true); *(unsigned*)(oq + c) = (unsigned)t; } }
}

__device__ __forceinline__ int moe_unit_experts(Frame& F, const int* BLKE, int nrbt, int shift) { const int L = F.lane * NWG + F.vcu; const int rb = L >> shift; return rb < nrbt ? BLKE[rb] : 0; }
__device__ __forceinline__ const LAS unsigned* moe_row_table(Frame& F, const int* ROWA, int nrbt) {
    LAS unsigned* tab = (LAS unsigned*)(F.lds + LDS_TAB);
    if (F.tid < 256) { int a[15];
#pragma unroll
        for (int i = 0; i < 15; ++i) { const int rb = (i * NWG + F.vcu) >> 1; a[i] = rb < nrbt ? ROWA[rb * 256 + F.tid] : -1; }
#pragma unroll
        for (int i = 0; i < 15; ++i) { const int tok = a[i] < 0 ? 0 : (a[i] < 8 * M ? (a[i] >> 3) : a[i] - 8 * M); tab[i * 256 + F.tid] = (unsigned)tok * (unsigned)D; } }
    __syncthreads();
    return tab;
}
__device__ __forceinline__ void p_conv(Frame& F, const float* cw, const float* cb) {
    const bf16* XR = WSP(bf16, WS_RA + RA_XR); bf16* XC = WSP(bf16, WS_RA + RA_XC);
    for (int i = F.vcu * NTHR + F.tid; i < M * (D / 8); i += NGT) { const int t = i >> 7, c = (i & 127) * 8; const int ts = t & (SEQ - 1);
        float a[8];
#pragma unroll
        for (int q = 0; q < 8; ++q) a[q] = cb[c + q];
#pragma unroll
        for (int j = 0; j < 4; ++j) { if (ts - 3 + j >= 0) { const u32x4 w = *(const u32x4*)(XR + (size_t)(t - 3 + j) * D + c); const float* wj = cw + j * D + c;
            a[0] += wj[0] * bf_lo(w.x); a[1] += wj[1] * bf_hi(w.x); a[2] += wj[2] * bf_lo(w.y); a[3] += wj[3] * bf_hi(w.y);
            a[4] += wj[4] * bf_lo(w.z); a[5] += wj[5] * bf_hi(w.z); a[6] += wj[6] * bf_lo(w.w); a[7] += wj[7] * bf_hi(w.w); } }
        u32x4 o; o.x = pk2(a[0], a[1]); o.y = pk2(a[2], a[3]); o.z = pk2(a[4], a[5]); o.w = pk2(a[6], a[7]); *(u32x4*)(XC + (size_t)t * D + c) = o; }
}
constexpr int CH = 64, NCH = SEQ / CH;
__device__ __forceinline__ void p_scan1(Frame& F) {
    const bf16* LA = WSP(bf16, WS_RA + RA_LA); const bf16* UU = WSP(bf16, WS_RA + RA_U); float* CP = WSP(float, WS_CHP); float* CHh = WSP(float, WS_CHH);
    for (int i = F.vcu * NTHR + F.tid; i < BATCH * NCH * (D / 4); i += NGT) { const int c4 = (i & 255) * 4, ck = (i >> 8) & (NCH - 1), b = i >> 16;
        const size_t r0 = ((size_t)b * SEQ + (size_t)ck * CH) * D + c4; f32x4 h = {0.f, 0.f, 0.f, 0.f}, sl = {0.f, 0.f, 0.f, 0.f};
#pragma unroll 8
        for (int t = 0; t < CH; ++t) { const u32x2 lw = *(const u32x2*)(LA + r0 + (size_t)t * D), uw = *(const u32x2*)(UU + r0 + (size_t)t * D);
            const f32x4 la = {bf_lo(lw.x), bf_hi(lw.x), bf_lo(lw.y), bf_hi(lw.y)}, u = {bf_lo(uw.x), bf_hi(uw.x), bf_lo(uw.y), bf_hi(uw.y)};
#pragma unroll
            for (int j = 0; j < 4; ++j) { h[j] = __expf(la[j]) * h[j] + u[j]; sl[j] += la[j]; } }
#pragma unroll
        for (int j = 0; j < 4; ++j) { const size_t o = ((size_t)b * D + c4 + j) * NCH + ck; CP[o] = __expf(sl[j]); CHh[o] = h[j]; } }
}
__device__ __forceinline__ void p_scan2(Frame& F) {
    const float* CP = WSP(float, WS_CHP); const float* CHh = WSP(float, WS_CHH); float* CIN = WSP(float, WS_CIN);
    for (int s = F.vcu * NWAVES + F.wave; s < BATCH * D; s += NGW) { const size_t o = (size_t)s * NCH + 4 * F.lane;
        const f32x4 p4 = *(const f32x4*)(CP + o), h4 = *(const f32x4*)(CHh + o);
        float p = p4.x, h = h4.x; h = p4.y * h + h4.y; p *= p4.y; h = p4.z * h + h4.z; p *= p4.z; h = p4.w * h + h4.w; p *= p4.w;
#pragma unroll
        for (int off = 1; off < 64; off <<= 1) { const float pp = __shfl_up(p, off), hp = __shfl_up(h, off); if (F.lane >= off) { h = p * hp + h; p = pp * p; } }
        float c0 = __shfl_up(h, 1); if (F.lane == 0) c0 = 0.f;
        f32x4 ci; ci.x = c0; ci.y = p4.x * ci.x + h4.x; ci.z = p4.y * ci.y + h4.y; ci.w = p4.z * ci.z + h4.z;
        *(f32x4*)(CIN + o) = ci; }
}
__device__ __forceinline__ void p_scan3(Frame& F) {
    const bf16* LA = WSP(bf16, WS_RA + RA_LA); const bf16* UU = WSP(bf16, WS_RA + RA_U); const float* CIN = WSP(float, WS_CIN);
    const bf16* GG = WSP(bf16, WS_RA + RA_GG); bf16* YB = WSP(bf16, WS_RA + RA_YB);
    for (int i = F.vcu * NTHR + F.tid; i < BATCH * NCH * (D / 4); i += NGT) { const int c4 = (i & 255) * 4, ck = (i >> 8) & (NCH - 1), b = i >> 16;
        const size_t r0 = ((size_t)b * SEQ + (size_t)ck * CH) * D + c4; f32x4 h;
#pragma unroll
        for (int j = 0; j < 4; ++j) h[j] = CIN[((size_t)b * D + c4 + j) * NCH + ck];
#pragma unroll 1
        for (int t0 = 0; t0 < CH; t0 += 8) { u32x2 lw[8], uw[8], gw[8];
#pragma unroll
            for (int k = 0; k < 8; ++k) { const size_t o = r0 + (size_t)(t0 + k) * D; lw[k] = *(const u32x2*)(LA + o); uw[k] = *(const u32x2*)(UU + o); gw[k] = *(const u32x2*)(GG + o); }
#pragma unroll
            for (int k = 0; k < 8; ++k) { const f32x4 la = {bf_lo(lw[k].x), bf_hi(lw[k].x), bf_lo(lw[k].y), bf_hi(lw[k].y)}, u = {bf_lo(uw[k].x), bf_hi(uw[k].x), bf_lo(uw[k].y), bf_hi(uw[k].y)};
#pragma unroll
                for (int j = 0; j < 4; ++j) h[j] = __expf(la[j]) * h[j] + u[j];
                u32x2 o; o.x = pk2(h.x * bf_lo(gw[k].x), h.y * bf_hi(gw[k].x)); o.y = pk2(h.z * bf_lo(gw[k].y), h.w * bf_hi(gw[k].y)); *(u32x2*)(YB + r0 + (size_t)(t0 + k) * D) = o; } } }
}
__device__ __forceinline__ void p_ln(Frame& F, const float* V, const float* g, const float* b, float* Hf, bf16* Hb) {
    unsigned char* Hq = WSP(unsigned char, WS_HQ);
    for (int r = F.vcu * NWAVES + F.wave; r < M; r += NGW) { const f32x4* xr = (const f32x4*)(V + (size_t)r * D) + F.lane; f32x4 v[4];
#pragma unroll
        for (int j = 0; j < 4; ++j) v[j] = xr[64 * j];
        ln_store(v, g, b, Hf + (size_t)r * D, Hb + (size_t)r * D, F.lane, Hq + (size_t)r * D); }
}
template <int CTRL> __device__ __forceinline__ float dppf(float x) { return __builtin_bit_cast(float, __builtin_amdgcn_mov_dpp(__builtin_bit_cast(int, x), CTRL, 0xF, 0xF, true)); }
template <int CTRL> __device__ __forceinline__ unsigned dppu(unsigned x) { return (unsigned)__builtin_amdgcn_mov_dpp((int)x, CTRL, 0xF, 0xF, true); }
__device__ __forceinline__ float rdlane_f(float x, int l) { return __builtin_bit_cast(float, __builtin_amdgcn_readlane(__builtin_bit_cast(int, x), l)); }
__device__ __forceinline__ void p_route(Frame& F, const float* bias) {
    const float* LG = WSP(float, WS_LOGITS); int* TOPI = WSP(int, WS_TOPI); float* GATE = WSP(float, WS_GATE); int* HIST = WSP(int, WS_HIST);
    LAS int* hist = (LAS int*)F.lds; const int lane = F.lane;
    if (F.tid < 256) hist[F.tid] = 0;
    __syncthreads();
    const f32x4 bv = *(const f32x4*)(bias + 4 * lane);
#pragma unroll 2
    for (int j = 0; j < 16; ++j) { const int t = F.vcu * 128 + F.wave * 16 + j;
        const f32x4 z = *(const f32x4*)(LG + (size_t)t * NE + 4 * lane);
        const float s0 = sigmoidf_(z.x), s1 = sigmoidf_(z.y), s2 = sigmoidf_(z.z), s3 = sigmoidf_(z.w);
        const float v0 = s0 + bv.x, v1 = s1 + bv.y, v2 = s2 + bv.z, v3 = s3 + bv.w;
        float m1, m2; { const float a = fmaxf(v0, v1), b = fminf(v0, v1), c = fmaxf(v2, v3), d = fminf(v2, v3); m1 = fmaxf(a, c); m2 = fmaxf(fminf(a, c), fmaxf(b, d)); }
        { float o1 = dppf<0xB1>(m1), o2 = dppf<0xB1>(m2); float n1 = fmaxf(m1, o1), n2 = fmaxf(fminf(m1, o1), fmaxf(m2, o2)); m1 = n1; m2 = n2;
          o1 = dppf<0x4E>(m1); o2 = dppf<0x4E>(m2); n1 = fmaxf(m1, o1); n2 = fmaxf(fminf(m1, o1), fmaxf(m2, o2)); m1 = n1; m2 = n2;
          o1 = dppf<0x141>(m1); o2 = dppf<0x141>(m2); n1 = fmaxf(m1, o1); n2 = fmaxf(fminf(m1, o1), fmaxf(m2, o2)); m1 = n1; m2 = n2; }
        const float gs = m1 + m2; const int g = lane >> 3; int rank = 0;
#pragma unroll
        for (int q = 0; q < 8; ++q) { const float o = rdlane_f(gs, 8 * q); rank += (o > gs || (o == gs && q < g)) ? 1 : 0; }
        const bool sel = rank < 4;
        const unsigned ib = 255u - 4u * (unsigned)lane;
        unsigned k0 = sel ? ((__float_as_uint(v0 + 1.0f) & ~255u) | ib) : 0u, k1 = sel ? ((__float_as_uint(v1 + 1.0f) & ~255u) | (ib - 1u)) : 0u;
        unsigned k2 = sel ? ((__float_as_uint(v2 + 1.0f) & ~255u) | (ib - 2u)) : 0u, k3 = sel ? ((__float_as_uint(v3 + 1.0f) & ~255u) | (ib - 3u)) : 0u;
        int myidx = 0; float mys = 0.f, tot = 0.f;
#pragma unroll
        for (int k = 0; k < TOPK; ++k) {
            unsigned mk = max(max(k0, k1), max(k2, k3));
            mk = max(mk, dppu<0xB1>(mk)); mk = max(mk, dppu<0x4E>(mk)); mk = max(mk, dppu<0x141>(mk)); mk = max(mk, dppu<0x140>(mk));
            const unsigned win = max(max((unsigned)__builtin_amdgcn_readlane((int)mk, 0), (unsigned)__builtin_amdgcn_readlane((int)mk, 16)), max((unsigned)__builtin_amdgcn_readlane((int)mk, 32), (unsigned)__builtin_amdgcn_readlane((int)mk, 48)));
            const int idx = 255 - (int)(win & 255u);
            k0 = (k0 == win) ? 0u : k0; k1 = (k1 == win) ? 0u : k1; k2 = (k2 == win) ? 0u : k2; k3 = (k3 == win) ? 0u : k3;
            const int qq = idx & 3; const float sq = qq == 0 ? s0 : (qq == 1 ? s1 : (qq == 2 ? s2 : s3)); const float sw = rdlane_f(sq, idx >> 2);
            tot += sw; if (lane == k) { myidx = idx; mys = sw; }
        }
        if (lane < TOPK) { TOPI[t * TOPK + lane] = myidx; GATE[t * TOPK + lane] = mys / tot * 2.5f; atomicAdd((int*)&hist[myidx], 1); }
    }
    __syncthreads();
    if (F.tid < 256) HIST[F.vcu * 256 + F.tid] = hist[F.tid];
    __syncthreads();
}
__device__ __forceinline__ void p_sort(Frame& F) {
    const int* HIST = WSP(int, WS_HIST); const int* TOPI = WSP(int, WS_TOPI); int* ROWA = WSP(int, WS_ROWA); int* POS = WSP(int, WS_POS); int* BLKE = WSP(int, WS_BLKE); int* META = WSP(int, WS_META);
    LAS int* cnt = (LAS int*)F.lds; LAS int* myoff = cnt + 256; LAS int* nb = cnt + 512; LAS int* blk0 = cnt + 768; LAS int* lcnt = cnt + 1024;
    { typedef int i32x4 __attribute__((ext_vector_type(4)));
      const int q = F.tid >> 6, l = F.tid & 63; i32x4 c = {0, 0, 0, 0}, mo = {0, 0, 0, 0};
#pragma unroll 8
      for (int w = q; w < NWG; w += 8) { const i32x4 h = *(const i32x4*)(HIST + w * 256 + 4 * l); c += h; if (w < F.vcu) mo += h; }
      LAS int* redc = cnt + 1280; LAS int* redm = redc + 2048;
#pragma unroll
      for (int j = 0; j < 4; ++j) { redc[q * 256 + 4 * l + j] = c[j]; redm[q * 256 + 4 * l + j] = mo[j]; }
      __syncthreads();
      if (F.tid < 256) { const int e = F.tid; int cc = 0, mm = 0;
#pragma unroll
          for (int k = 0; k < 8; ++k) { cc += redc[k * 256 + e]; mm += redm[k * 256 + e]; }
          cnt[e] = cc; myoff[e] = mm; nb[e] = (cc + 255) >> 8; lcnt[e] = 0; } }
    __syncthreads();
    if (F.tid < 256) { int b = 0; for (int j = 0; j < F.tid; ++j) b += nb[j]; blk0[F.tid] = b; }
    __syncthreads();
    for (int al = F.tid; al < 1024; al += NTHR) { const int a = F.vcu * 1024 + al; const int e = TOPI[a]; const int pos = blk0[e] * 256 + myoff[e] + atomicAdd((int*)&lcnt[e], 1); ROWA[pos] = a; POS[a] = pos; }
    const int nrb = blk0[255] + nb[255];
    { const int e = F.vcu; const int start = blk0[e] * 256 + cnt[e], end = (blk0[e] + nb[e]) * 256;
      for (int p = start + F.tid; p < end; p += NTHR) ROWA[p] = -1;
      for (int j = F.tid; j < nb[e]; j += NTHR) BLKE[blk0[e] + j] = e; }
    for (int tl = F.tid; tl < 128; tl += NTHR) { const int t = F.vcu * 128 + tl; ROWA[nrb * 256 + t] = 8 * M + t; }
    if (F.vcu == 0) { for (int j = F.tid; j < 128; j += NTHR) BLKE[nrb + j] = 256; if (F.tid == 0) META[0] = nrb + 128; }
    __syncthreads();
}
__device__ __forceinline__ void p_combine(Frame& F, const float* Hin, const float* g, const float* b, float* Hf, unsigned char* Hq) {
    const bf16* YA = WSP(bf16, WS_RA); const float* GATE = WSP(float, WS_GATE); const int* POS = WSP(int, WS_POS); const int shrow0 = (*WSP(int, WS_META) - 128) * 256;
    for (int t = F.vcu * NWAVES + F.wave; t < M; t += NGW) { f32x4 v[4];
        const f32x4* hr = (const f32x4*)(Hin + (size_t)t * D) + F.lane;
#pragma unroll
        for (int j = 0; j < 4; ++j) v[j] = hr[64 * j] * ALPHA;
        f32x4 r[4];
#pragma unroll
        for (int j = 0; j < 4; ++j) r[j] = (f32x4){0.f, 0.f, 0.f, 0.f};
#pragma unroll
        for (int k = 0; k < TOPK; ++k) { const float gk = GATE[t * TOPK + k] * 0.0625f; const unsigned* yr = (const unsigned*)((const unsigned char*)YA + (size_t)POS[t * TOPK + k] * D) + F.lane;
#pragma unroll
            for (int j = 0; j < 4; ++j) { const unsigned w = yr[64 * j]; const f32x2 a = __builtin_amdgcn_cvt_pk_f32_fp8((int)w, false), c = __builtin_amdgcn_cvt_pk_f32_fp8((int)w, true);
                r[j].x += gk * a.x; r[j].y += gk * a.y; r[j].z += gk * c.x; r[j].w += gk * c.y; } }
        { const unsigned* yr = (const unsigned*)((const unsigned char*)YA + (size_t)(shrow0 + t) * D) + F.lane;
#pragma unroll
            for (int j = 0; j < 4; ++j) { const unsigned w = yr[64 * j]; const f32x2 a = __builtin_amdgcn_cvt_pk_f32_fp8((int)w, false), c = __builtin_amdgcn_cvt_pk_f32_fp8((int)w, true);
                v[j].x += r[j].x + 0.0625f * a.x; v[j].y += r[j].y + 0.0625f * a.y; v[j].z += r[j].z + 0.0625f * c.x; v[j].w += r[j].w + 0.0625f * c.y; } }
        ln_store(v, g, b, Hf + (size_t)t * D, nullptr, F.lane, Hq ? Hq + (size_t)t * D : nullptr); }
}
constexpr int AT_KP = 144, AT_VP = 784, AT_KBYTES = 384 * AT_KP, AT_VOFF = AT_KBYTES;
__device__ __forceinline__ void p_attn(Frame& F) {
    const bf16* QKb = WSP(bf16, WS_RA + RA_QK); const bf16* VTb = WSP(bf16, WS_RA + RA_VT); bf16* OGb = WSP(bf16, WS_RA + RA_OG); float* LSE = WSP(float, WS_LSE);
    const int lane = F.lane, q = lane & 31, hh = lane >> 5, w = F.wave;
    LAS unsigned char* lk = F.lds; LAS unsigned char* lv = F.lds + AT_VOFF;
#pragma unroll 1
    for (int it = F.vcu; it < 3 * 128 * 8; it += NWG) {
        const int g = it >> 10, rem = it & 1023, chunk = rem >> 3, h = rem & 7;
        const int sh = 14 - 2 * g, rq0 = chunk * 256, i0 = rq0 & ((1 << sh) - 1), rk0 = rq0 - 128;
        const bf16* QK = QKb + (size_t)g * M * 1024; const bf16* VT = VTb + (size_t)g * 512 * M;
        { const char* kb = (const char*)(QK + 512 + h * 64);
#pragma unroll
          for (int j = 0; j < 7; ++j) { const int ins = w + 8 * j; if (ins < 54) { const int p = ins * 64 + lane, row = p / 9, cc = p - row * 9; const int gr = rk0 + row < 0 ? 0 : rk0 + row;
              __builtin_amdgcn_global_load_lds((const unsigned*)(kb + (size_t)gr * 2048 + (cc > 7 ? 7 : cc) * 16), (LAS unsigned*)(lk + ins * 1024), 16, 0, 0); } }
          const char* vb = (const char*)(VT + (size_t)(h * 64) * M);
#pragma unroll
          for (int j = 0; j < 7; ++j) { const int ins = w + 8 * j; if (ins < 49) { const int p = ins * 64 + lane, row = p / 49, cc = p - row * 49; int col = rk0 + (cc > 47 ? 47 : cc) * 8; col = col < 0 ? 0 : col;
              __builtin_amdgcn_global_load_lds((const unsigned*)(vb + ((size_t)row * M + col) * 2), (LAS unsigned*)(lv + ins * 1024), 16, 0, 0); } } }
        bf16x8 Qf[4];
        { const bf16* qp = QK + (size_t)(rq0 + 32 * w + q) * 1024 + h * 64 + 8 * hh;
#pragma unroll
          for (int s2 = 0; s2 < 4; ++s2) Qf[s2] = *(const bf16x8*)(qp + 16 * s2); }
        asm volatile("s_waitcnt vmcnt(0)" ::: "memory");
        __syncthreads();
        const float slope2 = exp2f(-(float)(h + 1)) * (float)(1 << (2 * g)) * 1.4426950408889634f, sc = 0.125f * 1.4426950408889634f;
        float m_run = -1e30f, l_run = 0.f; f32x16 O0, O1;
#pragma unroll
        for (int r = 0; r < 16; ++r) { O0[r] = 0.f; O1[r] = 0.f; }
#pragma unroll 1
        for (int kt = 0; kt < 5; ++kt) { const int kr0 = 32 * w + 32 * kt; if (i0 + kr0 - 128 < 0) continue;
            bf16x8 Kf[4];
            { const LAS unsigned char* kp = lk + (kr0 + q) * AT_KP + 16 * hh;
#pragma unroll
              for (int s2 = 0; s2 < 4; ++s2) Kf[s2] = *(const LAS bf16x8*)(kp + 32 * s2); }
            bf16x8 Vf[2][2];
#pragma unroll
            for (int dd = 0; dd < 2; ++dd)
#pragma unroll
                for (int s2 = 0; s2 < 2; ++s2) { const LAS unsigned char* vp = lv + (32 * dd + q) * AT_VP + (kr0 + 16 * s2 + 4 * hh) * 2;
                    const u32x2 lo = *(const LAS u32x2*)vp, hi = *(const LAS u32x2*)(vp + 16); u32x4 wv; wv.x = lo.x; wv.y = lo.y; wv.z = hi.x; wv.w = hi.y; Vf[dd][s2] = __builtin_bit_cast(bf16x8, wv); }
            f32x16 S;
#pragma unroll
            for (int r = 0; r < 16; ++r) S[r] = 0.f;
#pragma unroll
            for (int s2 = 0; s2 < 4; ++s2) S = __builtin_amdgcn_mfma_f32_32x32x16_bf16(Kf[s2], Qf[s2], S, 0, 0, 0);
            float mx = -1e30f;
#pragma unroll
            for (int r = 0; r < 16; ++r) { const int krow = (r & 3) + 8 * (r >> 2) + 4 * hh; const int dist = 128 - 32 * kt + q - krow;
                const float sv = (dist >= 0 && dist <= 128) ? S[r] * sc - slope2 * (float)dist : -1e30f; S[r] = sv; mx = fmaxf(mx, sv); }
            mx = fmaxf(mx, __shfl_xor(mx, 32));
            const float m_new = fmaxf(m_run, mx), alpha = exp2f(m_run - m_new); float rs = 0.f;
#pragma unroll
            for (int r = 0; r < 16; ++r) { const float p = exp2f(S[r] - m_new); S[r] = p; rs += p; }
            rs += __shfl_xor(rs, 32);
            l_run = l_run * alpha + rs; m_run = m_new;
#pragma unroll
            for (int r = 0; r < 16; ++r) { O0[r] *= alpha; O1[r] *= alpha; }
            bf16x8 Pf[2];
#pragma unroll
            for (int s2 = 0; s2 < 2; ++s2) { u32x4 wv; wv.x = pk2(S[8 * s2 + 0], S[8 * s2 + 1]); wv.y = pk2(S[8 * s2 + 2], S[8 * s2 + 3]); wv.z = pk2(S[8 * s2 + 4], S[8 * s2 + 5]); wv.w = pk2(S[8 * s2 + 6], S[8 * s2 + 7]); Pf[s2] = __builtin_bit_cast(bf16x8, wv); }
#pragma unroll
            for (int s2 = 0; s2 < 2; ++s2) { O0 = __builtin_amdgcn_mfma_f32_32x32x16_bf16(Vf[0][s2], Pf[s2], O0, 0, 0, 0); O1 = __builtin_amdgcn_mfma_f32_32x32x16_bf16(Vf[1][s2], Pf[s2], O1, 0, 0, 0); }
        }
        const float inv = 1.0f / l_run;
        bf16* op = OGb + ((size_t)g * M + rq0 + 32 * w + q) * 512 + h * 64 + 4 * hh;
#pragma unroll
        for (int rg = 0; rg < 4; ++rg) { u32x2 wv; wv.x = pk2(O0[4 * rg] * inv, O0[4 * rg + 1] * inv); wv.y = pk2(O0[4 * rg + 2] * inv, O0[4 * rg + 3] * inv); *(u32x2*)(op + 8 * rg) = wv;
            u32x2 w1; w1.x = pk2(O1[4 * rg] * inv, O1[4 * rg + 1] * inv); w1.y = pk2(O1[4 * rg + 2] * inv, O1[4 * rg + 3] * inv); *(u32x2*)(op + 32 + 8 * rg) = w1; }
        if (hh == 0) LSE[((size_t)g * M + rq0 + 32 * w + q) * 8 + h] = (m_run + log2f(l_run)) * 0.6931471805599453f;
        __syncthreads();
    }
}
__device__ __forceinline__ void p_merge(Frame& F) {
    const bf16* OGb = WSP(bf16, WS_RA + RA_OG); const float* LSE = WSP(float, WS_LSE); bf16* OM = WSP(bf16, WS_RA + RA_OM);
    for (int t = F.vcu * NWAVES + F.wave; t < M; t += NGW) { const int hd = F.lane >> 3; float ls[3]; size_t ro[3];
#pragma unroll
        for (int g = 0; g < 3; ++g) { const int rho = tok_to_rho(t, g); ro[g] = ((size_t)g * M + rho); ls[g] = LSE[ro[g] * 8 + hd]; }
        const float mx = fmaxf(ls[0], fmaxf(ls[1], ls[2])); float w[3], ws = 0.f;
#pragma unroll
        for (int g = 0; g < 3; ++g) { w[g] = __expf(ls[g] - mx); ws += w[g]; }
        const float inv = 1.0f / ws; float o[8];
#pragma unroll
        for (int j = 0; j < 8; ++j) o[j] = 0.f;
#pragma unroll
        for (int g = 0; g < 3; ++g) { const u32x4 x = *(const u32x4*)(OGb + ro[g] * 512 + 8 * F.lane); const float wg = w[g] * inv;
            o[0] += wg * bf_lo(x.x); o[1] += wg * bf_hi(x.x); o[2] += wg * bf_lo(x.y); o[3] += wg * bf_hi(x.y); o[4] += wg * bf_lo(x.z); o[5] += wg * bf_hi(x.z); o[6] += wg * bf_lo(x.w); o[7] += wg * bf_hi(x.w); }
        u32x4 r; r.x = pk2(o[0], o[1]); r.y = pk2(o[2], o[3]); r.z = pk2(o[4], o[5]); r.w = pk2(o[6], o[7]); *(u32x4*)(OM + (size_t)t * OW + 8 * F.lane) = r; }
}

constexpr int NPHASE = 26;

__global__ void __launch_bounds__(NTHR, 2) yoco_fwd(Args args) {
    extern __shared__ __attribute__((aligned(16))) unsigned char lds[];
    Frame F;
    F.lds = (LAS unsigned char*)lds;
    F.tid = threadIdx.x; F.lane = F.tid & 63; F.wave = __builtin_amdgcn_readfirstlane(F.tid >> 6);
    { const int bx = blockIdx.x; F.vcu = (bx % 8) * (NWG / 8) + bx / 8; }
    F.ws = args.ws;
    volatile LAS unsigned* MISC = (volatile LAS unsigned*)(F.lds + LDS_BYTES - 64);
    if (F.tid < 16) MISC[F.tid] = 0u;
    __syncthreads();
    const int lo = args.ph_lo, hi = args.ph_hi;
    XcdBarrier bar; bar.bar = (unsigned*)(F.ws + WS_CTL) + 4096; bar.x = 0; bar.st = nullptr;
    if (hi - lo > 1) bar = xcd_barrier_post((unsigned*)(F.ws + WS_CTL) + 4096, MISC + 8);
#ifndef PROBE_G2
#define PROBE_G2 0
#endif
#ifndef DUP_MASK
#define DUP_MASK 0u
#endif
#ifndef PH_MASK
#define PH_MASK 0xFFFFFFFFu
#endif
#define IN(k) (((PH_MASK >> (k)) & 1u) && lo <= (k) && (k) < hi)
#define REP(k) for (int rep = 0, nrep = 1 + (int)((args.dup >> (k)) & 1u); rep < nrep; ++rep)
#define SEAM(k) do { if (IN(k) && IN((k) + 1)) xcd_barrier(bar); } while (0)

    const bool cv_first = ((F.vcu >> 5) & 1) == 0;
#define CONV_L0(part) convert_experts(F, args.in[15], args.in[16], args.in[17], args.in[18], args.in[19], args.in[20], 0, part, 3)
#define CONV_L1(part) convert_experts(F, args.in[15] + (size_t)NE * D * DE, args.in[16] + (size_t)NE * D * DE, args.in[17] + (size_t)NE * D * DE, args.in[18] + (size_t)D * DE, args.in[19] + (size_t)D * DE, args.in[20] + (size_t)D * DE, 1, part, 3)
    if (IN(0)) { p0_prologue(F, args); } SEAM(0);
    if (IN(1)) { if (cv_first) { CONV_L0(0); __syncthreads(); } SchedDense8 S{WSP(unsigned char, WS_RA + RA_XB), WSP(unsigned char, WS_WIN), D, D, D, M / 256, 8, F.vcu}; EpiXZ E{WSP(bf16, WS_RA + RA_XR), WSP(bf16, WS_RA + RA_GG)}; gemm_fast8(F.lds, S, E); if (!cv_first) { __syncthreads(); CONV_L0(0); } } SEAM(1);
    if (IN(2)) { p_conv(F, args.in[2], args.in[3]); } SEAM(2);
    if (IN(3)) { if (cv_first) { CONV_L0(1); __syncthreads(); } SchedGate S{WSP(bf16, WS_RA + RA_XC), WSP(bf16, WS_WG), F.vcu}; EpiGate E{WSP(bf16, WS_RA + RA_XC), args.in[5], args.in[7], args.in[8], WSP(bf16, WS_RA + RA_LA), WSP(bf16, WS_RA + RA_U)}; GEMM_PHASE(F.lds, S, E); if (!cv_first) { __syncthreads(); CONV_L0(1); } } SEAM(3);
    if (IN(4)) { p_scan1(F); } SEAM(4);
    if (IN(5)) { p_scan2(F); } SEAM(5);
    if (IN(6)) { p_scan3(F); } SEAM(6);
    if (IN(7)) { if (cv_first) { CONV_L0(2); __syncthreads(); } SchedDense S{WSP(bf16, WS_RA + RA_YB), WSP(bf16, WS_WOUT), D, D, D, M / 256, 4, F.vcu}; EpiResF32 E{args.in[0], WSP(float, WS_V), D}; GEMM_PHASE(F.lds, S, E); if (!cv_first) { __syncthreads(); CONV_L0(2); } } SEAM(7);
    if (IN(8)) { p_ln(F, WSP(float, WS_V), args.in[21] + 0 * D, args.in[22] + 0 * D, WSP(float, WS_HA), WSP(bf16, WS_HAB)); } SEAM(8);
    if (IN(9)) { SchedDense S{WSP(bf16, WS_HAB), WSP(bf16, WS_WR), D, D, D, M / 256, 1, F.vcu}; EpiF32 E{WSP(float, WS_LOGITS), NE}; GEMM_PHASE(F.lds, S, E); } SEAM(9);
    if (IN(10)) { p_route(F, args.in[14]); } SEAM(10);
    if (IN(11)) { p_sort(F); } SEAM(11);
    if (IN(12)) { if (cv_first) { CONV_L1(0); __syncthreads(); } const int nrbt = *WSP(int, WS_META); SchedG1 S{WSP(unsigned char, WS_HQ), WSP(unsigned char, WS_W13), WSP(int, WS_ROWA), WSP(int, WS_BLKE), nrbt, F.vcu, moe_unit_experts(F, WSP(int, WS_BLKE), nrbt, 1), moe_row_table(F, WSP(int, WS_ROWA), nrbt)}; EpiSwiGLU E{WSP(unsigned char, WS_HID), F.lds + LDS_EPI}; gemm_fast8(F.lds, S, E); if (!cv_first) { __syncthreads(); CONV_L1(0); } } SEAM(12);
    if (IN(13)) { if (cv_first) { CONV_L1(1); __syncthreads(); } const int nrbt = *WSP(int, WS_META); SchedG2 S{WSP(unsigned char, WS_HID), WSP(unsigned char, WS_W2), WSP(int, WS_BLKE), nrbt, F.vcu, moe_unit_experts(F, WSP(int, WS_BLKE), nrbt, 2), args.rt256, args.rt256, args.rt256}; EpiScatter E{WSP(bf16, WS_RA), 0, F.lds + LDS_EPI}; gemm_fast8(F.lds, S, E); if (!cv_first) { __syncthreads(); CONV_L1(1); } } SEAM(13);
    if (IN(14)) { p_combine(F, WSP(float, WS_HA), args.in[21] + 1 * D, args.in[22] + 1 * D, WSP(float, WS_HB), WSP(unsigned char, WS_HQ)); } SEAM(14);
    if (IN(15)) { if (cv_first) { CONV_L1(2); __syncthreads(); } EpiQKV E{WSP(bf16, WS_RA + RA_QK), WSP(bf16, WS_RA + RA_VT), F.lds + LDS_EPI}; for (int g = 0; g < 3; ++g) { SchedQK S{WSP(unsigned char, WS_HQ), WSP(unsigned char, WS_WQK), g, D << (2 * g), F.vcu}; gemm_fast8(F.lds, S, E); } for (int g = 0; g < 3; ++g) { SchedVT S{WSP(unsigned char, WS_HQ), WSP(unsigned char, WS_WQK) + (size_t)3072 * D, g, D << (2 * g), F.vcu}; gemm_fast8(F.lds, S, E); } if (!cv_first) { __syncthreads(); CONV_L1(2); } } SEAM(15);
    if (IN(16)) { p_attn(F); } SEAM(16);
    if (IN(17)) { p_merge(F); } SEAM(17);
    if (IN(18)) { SchedDense S{WSP(bf16, WS_RA + RA_OM), WSP(bf16, WS_WO), OW, OW, OW, M / 256, 4, F.vcu}; EpiResF32 E{WSP(float, WS_HB), WSP(float, WS_V), D}; GEMM_PHASE(F.lds, S, E); } SEAM(18);
    if (IN(19)) { p_ln(F, WSP(float, WS_V), args.in[21] + 2 * D, args.in[22] + 2 * D, WSP(float, WS_HA), WSP(bf16, WS_HAB)); } SEAM(19);
    if (IN(20)) { SchedDense S{WSP(bf16, WS_HAB), WSP(bf16, WS_WR) + (size_t)NE * D, D, D, D, M / 256, 1, F.vcu}; EpiF32 E{WSP(float, WS_LOGITS), NE}; GEMM_PHASE(F.lds, S, E); } SEAM(20);
    if (IN(21)) { p_route(F, args.in[14] + NE); } SEAM(21);
    if (IN(22)) { p_sort(F); } SEAM(22);
    if (IN(23)) { const int nrbt = *WSP(int, WS_META); SchedG1 S{WSP(unsigned char, WS_HQ), WSP(unsigned char, WS_W13) + W13_LB, WSP(int, WS_ROWA), WSP(int, WS_BLKE), nrbt, F.vcu, moe_unit_experts(F, WSP(int, WS_BLKE), nrbt, 1), moe_row_table(F, WSP(int, WS_ROWA), nrbt)}; EpiSwiGLU E{WSP(unsigned char, WS_HID), F.lds + LDS_EPI}; gemm_fast8(F.lds, S, E); } SEAM(23);
    if (IN(24)) { const int nrbt = *WSP(int, WS_META); SchedG2 S{WSP(unsigned char, WS_HID), WSP(unsigned char, WS_W2) + W2_LB, WSP(int, WS_BLKE), nrbt, F.vcu, moe_unit_experts(F, WSP(int, WS_BLKE), nrbt, 2), args.rt256, args.rt256, args.rt256}; EpiScatter E{WSP(bf16, WS_RA), 0, F.lds + LDS_EPI}; gemm_fast8(F.lds, S, E); } SEAM(24);
    if (IN(25)) { p_combine(F, WSP(float, WS_HA), args.in[21] + 3 * D, args.in[22] + 3 * D, args.out, nullptr); }
#undef IN
#undef SEAM
}

extern "C" void kernel_launch(void* const* d_in, const int* in_sizes, int n_in, void* d_out, int out_size, void* d_ws, size_t ws_size, hipStream_t stream) {
    static int ok = 0;
    if (ok == 0) {
        if (n_in != 23 || in_sizes[0] != M * D || out_size != M * D || ws_size < WS_END) { fprintf(stderr, "kernel_launch: unexpected shapes (n_in %d, in0 %d, out %d, ws %zu < %zu)\n", n_in, n_in > 0 ? in_sizes[0] : -1, out_size, ws_size, (size_t)WS_END); ok = -1; return; }
        if (hipFuncSetAttribute((const void*)yoco_fwd, hipFuncAttributeMaxDynamicSharedMemorySize, LDS_BYTES) != hipSuccess) { fprintf(stderr, "kernel_launch: hipFuncSetAttribute failed\n"); ok = -1; return; }
        int per_cu = 0;
        if (hipOccupancyMaxActiveBlocksPerMultiprocessor(&per_cu, (const void*)yoco_fwd, NTHR, LDS_BYTES) != hipSuccess || per_cu < 1) fprintf(stderr, "kernel_launch: occupancy query says %d\n", per_cu);
        (void)hipGetLastError();
        ok = 1;
    }
    if (ok < 0) return;
    if (hipMemsetAsync((char*)d_ws + WS_CTL, 0, CTL_ZERO_BYTES, stream) != hipSuccess) return;
    Args a{};
    for (int i = 0; i < 23; ++i) a.in[i] = (const float*)d_in[i];
    a.out = (float*)d_out; a.ws = (unsigned char*)d_ws; a.dup = 0u; a.rt256 = 256;
#if MK_ONE_LAUNCH
    a.ph_lo = 0; a.ph_hi = NPHASE;
    hipLaunchKernelGGL(yoco_fwd, dim3(NWG), dim3(NTHR), LDS_BYTES, stream, a);
#else
    for (int p = 0; p < NPHASE; ++p) { a.ph_lo = p; a.ph_hi = p + 1; hipLaunchKernelGGL(yoco_fwd, dim3(NWG), dim3(NTHR), LDS_BYTES, stream, a); }
#endif
}
```

```cpp
#include <hip/hip_runtime.h>
#include <cstdio>
#include <cstdint>

#ifndef MK_ONE_LAUNCH
#define MK_ONE_LAUNCH 1
#endif

constexpr int D = 1024, BATCH = 2, SEQ = 16384, M = BATCH * SEQ;
constexpr int NE = 256, TOPK = 8, DE = 256;
constexpr int HEADS = 8, HD = 64, QW = 1536, OW = 512;
constexpr float LN_EPS = 1e-5f, ALPHA = 1.41421356237f;
constexpr int RBMAX = 1024 + 256 + 128;
constexpr int NWG = 256, NTHR = 512, NWAVES = 8;
constexpr int NGW = NWG * NWAVES, NGT = NWG * NTHR;

constexpr size_t MiB = 1u << 20;
constexpr size_t WS_CTL = 0, CTL_ZERO_BYTES = 1 * MiB;
constexpr size_t WS_HIST = 1 * MiB, WS_BLKE = 1 * MiB + 512 * 1024, WS_META = 1 * MiB + 768 * 1024;
constexpr size_t WS_ROWA = 2 * MiB, WS_TOPI = 4 * MiB, WS_GATE = 5 * MiB, WS_CHP = 6 * MiB, WS_CHH = 8 * MiB, WS_CIN = 10 * MiB, WS_LSE = 12 * MiB;
constexpr size_t WS_WIN = 16 * MiB, WS_WG = 20 * MiB, WS_WOUT = 21 * MiB, WS_WQK = 23 * MiB, WS_WV = 29 * MiB, WS_WO = 32 * MiB, WS_WR = 33 * MiB;
constexpr size_t WS_LOGITS = 34 * MiB;
constexpr size_t WS_W13 = 66 * MiB, WS_W2 = 323 * MiB;
constexpr size_t W13_LB = (size_t)257 * 512 * 1024, W2_LB = (size_t)257 * 1024 * 256;
static_assert(WS_W13 + 2 * W13_LB <= WS_W2 && WS_W2 + 2 * W2_LB <= 452 * MiB, "both layers' fp8 expert weights fit");
constexpr size_t WS_V = 452 * MiB, WS_HA = 580 * MiB, WS_HAB = 708 * MiB, WS_HB = 772 * MiB, WS_HBB = 900 * MiB, WS_HID = 964 * MiB;
constexpr size_t WS_RA = 1140 * MiB;
constexpr size_t RA_XB = 0, RA_XR = 64 * MiB, RA_GG = 128 * MiB, RA_XC = 192 * MiB, RA_LA = 256 * MiB, RA_U = 384 * MiB, RA_YB = 512 * MiB;
constexpr size_t RA_QK = 0, RA_VT = 192 * MiB, RA_OG = 288 * MiB, RA_OM = 384 * MiB;
constexpr size_t WS_POS = 15 * MiB;
constexpr size_t WS_HQ = 1844 * MiB;
constexpr size_t WS_END = 1876 * MiB;

constexpr int LDS_BYTES = 163840;
constexpr int LDS_EPI = 131072, LDS_TAB = 147456;

#define GAS __attribute__((address_space(1)))
#define LAS __attribute__((address_space(3)))
typedef unsigned short bf16;
typedef unsigned u32x4 __attribute__((ext_vector_type(4)));
typedef unsigned u32x2 __attribute__((ext_vector_type(2)));
typedef float f32x4 __attribute__((ext_vector_type(4)));
typedef float f32x2 __attribute__((ext_vector_type(2)));
typedef float f32x16 __attribute__((ext_vector_type(16)));
typedef short bf16x8 __attribute__((ext_vector_type(8)));
typedef int i32x8 __attribute__((ext_vector_type(8)));
typedef GAS unsigned gu32;
#define RLX_AGENT __ATOMIC_RELAXED, __HIP_MEMORY_SCOPE_AGENT
#define LDS_WAIT() asm volatile("s_waitcnt lgkmcnt(0)" ::: "memory")
#define VM_WAIT() asm volatile("s_waitcnt vmcnt(0)" ::: "memory")

__device__ __forceinline__ unsigned pk2(float lo, float hi) { unsigned r; asm("v_cvt_pk_bf16_f32 %0, %1, %2" : "=v"(r) : "v"(lo), "v"(hi)); return r; }
__device__ __forceinline__ float bf_lo(unsigned w) { return __uint_as_float(w << 16); }
__device__ __forceinline__ float bf_hi(unsigned w) { return __uint_as_float(w & 0xffff0000u); }
__device__ __forceinline__ float wave_sum(float v) {
#pragma unroll
    for (int o = 1; o < 64; o <<= 1) v += __shfl_xor(v, o);
    return v;
}
__device__ __forceinline__ float gelu_tanh(float x) {
    const float u = 0.7978845608028654f * (x + 0.044715f * x * x * x);
    const float e = __expf(2.0f * u);
    const float t = 1.0f - 2.0f / (e + 1.0f);
    return 0.5f * x * (1.0f + t);
}
__device__ __forceinline__ float sigmoidf_(float x) { return 1.0f / (1.0f + __expf(-x)); }

#define XB_TMO      128
#define XB_XCNT(j)  (256  + 64 * (j))
#define XB_XSUB(j)  (1280 + 64 * (j))
#define XB_XGEN(j)  (2304 + 64 * (j))
#define XB_TOP      3328
#define XB_TOPGEN   3392
#define XCD_BAR_WORDS 3456
#define XB_SPIN_CAP (1u << 18)
__device__ __forceinline__ unsigned xb_ld(unsigned* p)              { return __hip_atomic_load(p, __ATOMIC_RELAXED, __HIP_MEMORY_SCOPE_AGENT); }
__device__ __forceinline__ unsigned xb_add(unsigned* p, unsigned v) { return __hip_atomic_fetch_add(p, v, __ATOMIC_RELAXED, __HIP_MEMORY_SCOPE_AGENT); }
__device__ __forceinline__ unsigned xb_xcc_id() { return (unsigned)__builtin_amdgcn_s_getreg((3 << 11) | 20) & 0xFu; }
#define XB_SPIN(cond, bar) do { unsigned _sp = 0; while (cond) { __builtin_amdgcn_s_sleep(1); \
    if ((++_sp & 255u) == 0u) { if (xb_ld(&(bar)[XB_TMO])) break; if (_sp > XB_SPIN_CAP) { atomicAdd(&(bar)[XB_TMO], 1u); break; } } } } while (0)
struct XcdBarrier { unsigned* bar; unsigned x; volatile LAS unsigned* st; };
__device__ __forceinline__ XcdBarrier xcd_barrier_post(unsigned* bar, volatile LAS unsigned* st) {
    XcdBarrier b; b.bar = bar; b.x = xb_xcc_id(); b.st = st;
    if (threadIdx.x == 0) (void)xb_add(&bar[XB_XCNT(b.x)], 1u);
    return b;
}
__device__ __forceinline__ void xcd_barrier_complete(unsigned* bar, unsigned x, unsigned& nloc, unsigned& nx) {
    const unsigned G = gridDim.x * gridDim.y * gridDim.z;
    unsigned sum, cnt, mine, sp = 0u;
    for (;;) {
        sum = 0u; cnt = 0u; mine = 0u;
#pragma unroll
        for (unsigned j = 0; j < 16; ++j) { const unsigned c = xb_ld(&bar[XB_XCNT(j)]); sum += c; cnt += (c > 0u) ? 1u : 0u; mine = (j == x) ? c : mine; }
        if (sum == G) break;
        __builtin_amdgcn_s_sleep(1);
        if ((++sp & 255u) == 0u) { if (xb_ld(&bar[XB_TMO])) break; if (sp > XB_SPIN_CAP) { atomicAdd(&bar[XB_TMO], 1u); break; } }
    }
    nloc = mine > 0u ? mine : 1u; nx = cnt > 0u ? cnt : 1u;
}
__device__ __forceinline__ void xcd_barrier(const XcdBarrier& b) {
    asm volatile("s_waitcnt vmcnt(0)" ::: "memory");
    __syncthreads();
    if (threadIdx.x == 0) {
        unsigned* bar = b.bar;
        __builtin_amdgcn_s_waitcnt(0);
        unsigned nloc = b.st[0], nx = b.st[1];
        if (nloc == 0u) { xcd_barrier_complete(bar, b.x, nloc, nx); b.st[0] = nloc; b.st[1] = nx; }
        const unsigned old = xb_add(&bar[XB_XSUB(b.x)], 1u);
        const unsigned gen = old / nloc;
        if (old + 1u == (gen + 1u) * nloc) {
            __builtin_amdgcn_fence(__ATOMIC_RELEASE, "agent");
            asm volatile("s_waitcnt vmcnt(0)" ::: "memory");
            const unsigned og = xb_add(&bar[XB_TOP], 1u);
            const unsigned tg = og / nx;
            if (og + 1u == (tg + 1u) * nx) xb_add(&bar[XB_TOPGEN], 1u);
            else XB_SPIN(xb_ld(&bar[XB_TOPGEN]) == tg, bar);
            __builtin_amdgcn_fence(__ATOMIC_ACQUIRE, "agent");
            xb_add(&bar[XB_XGEN(b.x)], 1u);
            asm volatile("s_waitcnt vmcnt(0)" ::: "memory");
        } else {
            XB_SPIN(xb_ld(&bar[XB_XGEN(b.x)]) == gen, bar);
            __builtin_amdgcn_fence(__ATOMIC_ACQUIRE, "agent");
            asm volatile("s_waitcnt vmcnt(0)" ::: "memory");
        }
    }
    __syncthreads();
}

struct Args { const float* in[23]; float* out; unsigned char* ws; int ph_lo, ph_hi; unsigned dup; int rt256; };
static_assert(sizeof(Args) == 23 * 8 + 8 + 8 + 16, "Args has no padding");
struct Frame {
    LAS unsigned char* lds;
    int tid, lane, wave, vcu;
    unsigned char* ws;
};
#define WSP(T, off) ((T*)(F.ws + (off)))

template <class S, class E>
__device__ __forceinline__ void gemm_simple(LAS unsigned char* lds, const S& sch, const E& epi) {
    const int tid = threadIdx.x, wid = tid >> 6, lane = tid & 63, wr = wid >> 2, wc = wid & 3, fr = lane & 15, fq = lane >> 4;
    constexpr int PITCH = 144;
    LAS unsigned char* As = lds; LAS unsigned char* Bs = lds + 256 * PITCH;
    typename S::U u;
    for (int i = 0; sch.next(i, u); ++i) {
        f32x4 acc[2][2][4][2];
#pragma unroll
        for (int a = 0; a < 2; ++a)
#pragma unroll
            for (int b = 0; b < 2; ++b)
#pragma unroll
                for (int m = 0; m < 4; ++m)
#pragma unroll
                    for (int n = 0; n < 2; ++n) acc[a][b][m][n] = (f32x4){0.f, 0.f, 0.f, 0.f};
        const int nt = sch.K(u) / 64;
        const char* pa[4]; const char* pb[4];
#pragma unroll
        for (int j = 0; j < 4; ++j) { const int row = (tid >> 3) + 64 * j; const int rb = S::PERM ? ((row & ~31) + 8 * ((row & 15) >> 2) + 4 * ((row >> 4) & 1) + (row & 3)) : row; pa[j] = sch.rowA(u, row) + (tid & 7) * 16; pb[j] = sch.rowB(u, rb) + (tid & 7) * 16; }
        for (int kt = 0; kt < nt; ++kt) {
            u32x4 va[4], vb[4];
#pragma unroll
            for (int j = 0; j < 4; ++j) { va[j] = *(const u32x4*)(pa[j] + kt * 128); vb[j] = *(const u32x4*)(pb[j] + kt * 128); }
            __syncthreads();
#pragma unroll
            for (int j = 0; j < 4; ++j) { const int row = (tid >> 3) + 64 * j;
                *(LAS u32x4*)(As + row * PITCH + (tid & 7) * 16) = va[j]; *(LAS u32x4*)(Bs + row * PITCH + (tid & 7) * 16) = vb[j]; }
            __syncthreads();
#pragma unroll
            for (int kk = 0; kk < 2; ++kk) {
                bf16x8 Bf[2][2];
#pragma unroll
                for (int b = 0; b < 2; ++b)
#pragma unroll
                    for (int n = 0; n < 2; ++n) Bf[b][n] = *(const LAS bf16x8*)(Bs + (b * 128 + wc * 32 + n * 16 + fr) * PITCH + kk * 64 + fq * 16);
#pragma unroll
                for (int a = 0; a < 2; ++a) {
                    bf16x8 Af[4];
#pragma unroll
                    for (int m = 0; m < 4; ++m) Af[m] = *(const LAS bf16x8*)(As + (a * 128 + wr * 64 + m * 16 + fr) * PITCH + kk * 64 + fq * 16);
#pragma unroll
                    for (int b = 0; b < 2; ++b)
#pragma unroll
                        for (int m = 0; m < 4; ++m)
#pragma unroll
                            for (int n = 0; n < 2; ++n) acc[a][b][m][n] = __builtin_amdgcn_mfma_f32_16x16x32_bf16(Bf[b][n], Af[m], acc[a][b][m][n], 0, 0, 0);
                }
            }
        }
        epi(acc, u, wr, wc, fr, fq);
    }
    __syncthreads();
}

namespace pg8 {
constexpr int HTB = 128 * 64 * 2;
__device__ __forceinline__ int lds_byte(int r, int c) { const int st = (r >> 4) * 2 + (c >> 5), rr = r & 15, cc = c & 31, ob = rr * 64 + cc * 2; return st * 1024 + (ob ^ (((ob >> 9) & 1) << 5)); }
__device__ __forceinline__ int perm32(int rho) { const int n = rho >> 4, i = rho & 15; return 8 * (i >> 2) + 4 * n + (i & 3); }
__device__ __forceinline__ int prow(int r) { return (r & ~31) + perm32(r & 31); }
__device__ __forceinline__ void stage_rc(int b, int& R, int& C) { const int st = b / 1024, sb = b % 1024, swz = sb ^ (((sb >> 9) & 1) << 5); R = (st >> 1) * 16 + swz / 64; C = (st & 1) * 32 + (swz % 64) / 2; }
}
template <class S, class E>
__device__ __forceinline__ void gemm_fast(LAS unsigned char* lds, const S& sch, const E& epi) {
    using namespace pg8;
    const int tid = threadIdx.x, wid = __builtin_amdgcn_readfirstlane(tid >> 6), lane = tid & 63, wr = wid >> 2, wc = wid & 3, fr = lane & 15, fq = lane >> 4;
    const int nt = sch.Kk / 64;
    int R0, C0; stage_rc(tid * 16, R0, C0);
    unsigned voffA[2], voffB[2]; unsigned cofA[4], nofA[4], cofB[4], nofB[4];
    size_t hstepA = 0, hstepB = 0;
    if constexpr (!S::GA) { voffA[0] = (unsigned)(R0 * sch.lda + C0) * 2u; voffA[1] = (unsigned)((R0 + 64) * sch.lda + C0) * 2u; hstepA = (size_t)128 * sch.lda * 2; }
    const int RB0 = S::PERM ? prow(R0) : R0;
    if constexpr (!S::GB) { voffB[0] = (unsigned)(RB0 * sch.ldb + C0) * 2u; voffB[1] = (unsigned)((RB0 + 64) * sch.ldb + C0) * 2u; hstepB = (size_t)128 * sch.ldb * 2; }
    const size_t kstep = 128;
    const unsigned ldsw = (unsigned)wid * 1024u;
    const int aoff = lds_byte(wr * 64 + fr, fq * 8), boff = lds_byte(wc * 32 + fr, fq * 8);
#define G_SA(b, h) (((b) * 2 + (h)) * HTB)
#define G_SB(b, h) ((4 + (b) * 2 + (h)) * HTB)
#define G_GLDS(src, dst) __builtin_amdgcn_global_load_lds((const unsigned*)(src), (LAS unsigned*)(dst), 16, 0, 0)
#define G_STAGE_A(bufoff, gp, h, nx) do { if constexpr (S::GA) { _Pragma("unroll") for (int _i = 0; _i < 2; ++_i) { const unsigned _o = (nx) ? nofA[2 * (h) + _i] : cofA[2 * (h) + _i]; G_GLDS((gp) + _o, lds + (bufoff) + ldsw + _i * 8192); } } \
        else { _Pragma("unroll") for (int _i = 0; _i < 2; ++_i) G_GLDS((gp) + (size_t)(h) * hstepA + voffA[_i], lds + (bufoff) + ldsw + _i * 8192); } } while (0)
#define G_STAGE_B(bufoff, gp, h, nx) do { if constexpr (S::GB) { _Pragma("unroll") for (int _i = 0; _i < 2; ++_i) { const unsigned _o = (nx) ? nofB[2 * (h) + _i] : cofB[2 * (h) + _i]; G_GLDS((gp) + _o, lds + (bufoff) + ldsw + _i * 8192); } } \
        else { _Pragma("unroll") for (int _i = 0; _i < 2; ++_i) G_GLDS((gp) + (size_t)(h) * hstepB + voffB[_i], lds + (bufoff) + ldsw + _i * 8192); } } while (0)
#define G_LDA(dst, b, h) do { _Pragma("unroll") for (int m = 0; m < 4; ++m) _Pragma("unroll") for (int k = 0; k < 2; ++k) dst[m][k] = *(const LAS bf16x8*)(lds + G_SA(b, h) + aoff + m * 2048 + k * 1024); } while (0)
#define G_LDB(dst, b, h) do { _Pragma("unroll") for (int n = 0; n < 2; ++n) _Pragma("unroll") for (int k = 0; k < 2; ++k) dst[n][k] = *(const LAS bf16x8*)(lds + G_SB(b, h) + boff + n * 2048 + k * 1024); } while (0)
#define G_MMA(ai, bj, At, Bt) do { __builtin_amdgcn_s_setprio(1); _Pragma("unroll") for (int m = 0; m < 4; ++m) _Pragma("unroll") for (int n = 0; n < 2; ++n) _Pragma("unroll") for (int k = 0; k < 2; ++k) \
        acc[ai][bj][m][n] = __builtin_amdgcn_mfma_f32_16x16x32_bf16(Bt[n][k], At[m][k], acc[ai][bj][m][n], 0, 0, 0); __builtin_amdgcn_s_setprio(0); } while (0)
#define G_WAIT_V(n) asm volatile("s_waitcnt vmcnt(" #n ")" ::: "memory")
#define G_WAIT_L(n) asm volatile("s_waitcnt lgkmcnt(" #n ")" ::: "memory")
#define G_BAR __builtin_amdgcn_s_barrier()
#define G_SCHED __builtin_amdgcn_sched_barrier(0)
    typename S::U cur, nxt; int ui = 0;
    if (!sch.next(0, cur)) return;
    f32x4 acc[2][2][4][2];
#pragma unroll
    for (int a = 0; a < 2; ++a)
#pragma unroll
        for (int b = 0; b < 2; ++b)
#pragma unroll
            for (int m = 0; m < 4; ++m)
#pragma unroll
                for (int n = 0; n < 2; ++n) acc[a][b][m][n] = (f32x4){0.f, 0.f, 0.f, 0.f};
    bf16x8 At[4][2], B0[2][2], B1[2][2];
    const char* cA = sch.baseA(cur); const char* cB = sch.baseB(cur);
    if constexpr (S::GA) {
#pragma unroll
        for (int j = 0; j < 4; ++j) { cofA[j] = sch.goffA(cur, (j >> 1) * 128 + R0 + (j & 1) * 64, C0); nofA[j] = cofA[j]; } }
    if constexpr (S::GB) {
#pragma unroll
        for (int j = 0; j < 4; ++j) { cofB[j] = sch.goffB(cur, (j >> 1) * 128 + RB0 + (j & 1) * 64, C0); nofB[j] = cofB[j]; } }
    G_STAGE_B(G_SB(0, 0), cB, 0, false); G_STAGE_B(G_SB(0, 1), cB, 1, false); G_STAGE_A(G_SA(0, 0), cA, 0, false); G_STAGE_A(G_SA(0, 1), cA, 1, false);
    if (wr == 1) G_BAR;
    G_WAIT_V(2); G_BAR;
    G_STAGE_B(G_SB(1, 0), cB + kstep, 0, false); G_STAGE_A(G_SA(1, 0), cA + kstep, 0, false); G_STAGE_B(G_SB(1, 1), cB + kstep, 1, false);
    G_WAIT_V(6); G_BAR;
    for (;;) {
        const bool has_next = sch.next(ui + 1, nxt);
        const char* nA = has_next ? sch.baseA(nxt) : cA; const char* nB = has_next ? sch.baseB(nxt) : cB;
        if constexpr (S::GA) { if (has_next) {
#pragma unroll
            for (int j = 0; j < 4; ++j) nofA[j] = sch.goffA(nxt, (j >> 1) * 128 + R0 + (j & 1) * 64, C0); } }
        if constexpr (S::GB) { if (has_next) {
#pragma unroll
            for (int j = 0; j < 4; ++j) nofB[j] = sch.goffB(nxt, (j >> 1) * 128 + RB0 + (j & 1) * 64, C0); } }
#pragma unroll 1
        for (int t = 0; t < nt; t += 2) {
            const bool last = (t == nt - 2);
            const char* a1 = cA + (size_t)(t + 1) * kstep;
            const char* a2 = last ? nA : cA + (size_t)(t + 2) * kstep; const char* b2 = last ? nB : cB + (size_t)(t + 2) * kstep;
            const char* a3 = a2 + kstep; const char* b3 = b2 + kstep;
            asm volatile("" : "+s"(a1), "+s"(a2), "+s"(a3), "+s"(b2), "+s"(b3));
            const bool post = (t == 0 && ui > 0);
#define G_WAIT_POST() do { if (post) { if constexpr (E::NVM == 8) G_WAIT_V(16); else if constexpr (E::NVM == 16) G_WAIT_V(24); else if constexpr (E::NVM == 32) G_WAIT_V(40); else G_WAIT_V(8); } else G_WAIT_V(8); } while (0)
            G_LDB(B0, 0, 0); G_LDB(B1, 0, 1); G_SCHED; G_LDA(At, 0, 0); if (!post) G_STAGE_A(G_SA(1, 1), a1, 1, false);
            G_WAIT_POST(); G_WAIT_L(0); G_BAR; G_MMA(0, 0, At, B0); G_MMA(0, 1, At, B1); G_BAR; G_SCHED;
            G_LDA(At, 0, 1); G_STAGE_B(G_SB(0, 0), b2, 0, last); G_STAGE_B(G_SB(0, 1), b2, 1, last); G_STAGE_A(G_SA(0, 0), a2, 0, last);
            G_WAIT_POST(); G_WAIT_L(0); G_BAR; G_MMA(1, 0, At, B0); G_MMA(1, 1, At, B1); G_BAR; G_SCHED;
            G_LDB(B0, 1, 0); G_LDB(B1, 1, 1); G_SCHED; G_LDA(At, 1, 0); G_STAGE_A(G_SA(0, 1), a2, 1, last);
            G_WAIT_POST(); G_WAIT_L(0); G_BAR; G_MMA(0, 0, At, B0); G_MMA(0, 1, At, B1); G_BAR; G_SCHED;
            G_LDA(At, 1, 1); G_STAGE_B(G_SB(1, 0), b3, 0, last); G_STAGE_B(G_SB(1, 1), b3, 1, last); G_STAGE_A(G_SA(1, 0), a3, 0, last);
            G_WAIT_V(8); G_WAIT_L(0); G_BAR; G_MMA(1, 0, At, B0); G_MMA(1, 1, At, B1); G_BAR; G_SCHED;
#undef G_WAIT_POST
        }
        if (wr == 0) G_BAR;
        if (has_next) { const char* n1 = nA + kstep; asm volatile("" : "+s"(n1)); G_STAGE_A(G_SA(1, 1), n1, 1, true); }
        { int tz = threadIdx.x; asm volatile("" : "+v"(tz));
          const int ewid = tz >> 6, el = tz & 63; epi(acc, cur, ewid >> 2, ewid & 3, el & 15, el >> 4); }
        if (!has_next) break;
#pragma unroll
        for (int a = 0; a < 2; ++a)
#pragma unroll
            for (int b = 0; b < 2; ++b)
#pragma unroll
                for (int m = 0; m < 4; ++m)
#pragma unroll
                    for (int n = 0; n < 2; ++n) acc[a][b][m][n] = (f32x4){0.f, 0.f, 0.f, 0.f};
        cur = nxt; cA = nA; cB = nB; ++ui;
        if constexpr (S::GA) {
#pragma unroll
            for (int j = 0; j < 4; ++j) cofA[j] = nofA[j]; }
        if constexpr (S::GB) {
#pragma unroll
            for (int j = 0; j < 4; ++j) cofB[j] = nofB[j]; }
        if (wr == 1) G_BAR;
    }
    G_WAIT_V(0);
    G_BAR;
#undef G_SA
#undef G_SB
#undef G_GLDS
#undef G_STAGE_A
#undef G_STAGE_B
#undef G_LDA
#undef G_LDB
#undef G_MMA
#undef G_WAIT_V
#undef G_WAIT_L
#undef G_BAR
#undef G_SCHED
}
template <class S, class E>
__device__ __forceinline__ void gemm_fast8(LAS unsigned char* lds, const S& sch, const E& epi) {
    using namespace pg8;
    const int tid = threadIdx.x, wid = __builtin_amdgcn_readfirstlane(tid >> 6), lane = tid & 63, wr = wid >> 2, wc = wid & 3, fr = lane & 15, fq = lane >> 4;
    const int nt = sch.Kk / 128;
    const int R0 = tid >> 3, C0 = ((tid & 7) ^ (((R0 >> 1) & 1) | (((R0 >> 2) & 1) << 2))) * 8;
    unsigned voffA[2], voffB[2]; unsigned cofA[4], nofA[4], cofB[4], nofB[4];
    size_t hstepA = 0, hstepB = 0;
    if constexpr (!S::GA) { voffA[0] = (unsigned)(R0 * sch.lda + C0 * 2); voffA[1] = (unsigned)((R0 + 64) * sch.lda + C0 * 2); hstepA = (size_t)128 * sch.lda; }
    const int RB0 = S::PERM ? prow(R0) : R0;
    if constexpr (!S::GB) { voffB[0] = (unsigned)(RB0 * sch.ldb + C0 * 2); voffB[1] = (unsigned)((RB0 + 64) * sch.ldb + C0 * 2); hstepB = (size_t)128 * sch.ldb; }
    const size_t kstep = 128;
    const unsigned ldsw = (unsigned)wid * 1024u;
    const int fsw = ((fr >> 1) & 1) | (((fr >> 2) & 1) << 2);
    const int aoff = ((wr * 64 + fr) * 8 + ((2 * fq) ^ fsw)) * 16, aoff1 = ((wr * 64 + fr) * 8 + ((2 * fq + 1) ^ fsw)) * 16, boff = ((wc * 32 + fr) * 8 + ((2 * fq) ^ fsw)) * 16, boff1 = ((wc * 32 + fr) * 8 + ((2 * fq + 1) ^ fsw)) * 16;
#define G_SA(b, h) (((b) * 2 + (h)) * HTB)
#define G_SB(b, h) ((4 + (b) * 2 + (h)) * HTB)
#define G_GLDS(src, dst) __builtin_amdgcn_global_load_lds((const unsigned*)(src), (LAS unsigned*)(dst), 16, 0, 0)
#define G_STAGE_A(bufoff, gp, h, nx) do { if constexpr (S::GA) { _Pragma("unroll") for (int _i = 0; _i < 2; ++_i) { const unsigned _o = (nx) ? nofA[2 * (h) + _i] : cofA[2 * (h) + _i]; G_GLDS((gp) + _o, lds + (bufoff) + ldsw + _i * 8192); } } \
        else { _Pragma("unroll") for (int _i = 0; _i < 2; ++_i) G_GLDS((gp) + (size_t)(h) * hstepA + voffA[_i], lds + (bufoff) + ldsw + _i * 8192); } } while (0)
#define G_STAGE_B(bufoff, gp, h, nx) do { if constexpr (S::GB) { _Pragma("unroll") for (int _i = 0; _i < 2; ++_i) { const unsigned _o = (nx) ? nofB[2 * (h) + _i] : cofB[2 * (h) + _i]; G_GLDS((gp) + _o, lds + (bufoff) + ldsw + _i * 8192); } } \
        else { _Pragma("unroll") for (int _i = 0; _i < 2; ++_i) G_GLDS((gp) + (size_t)(h) * hstepB + voffB[_i], lds + (bufoff) + ldsw + _i * 8192); } } while (0)
#define G_LDA(dst, b, h) do { _Pragma("unroll") for (int m = 0; m < 4; ++m) { const u32x4 _lo = *(const LAS u32x4*)(lds + G_SA(b, h) + aoff + m * 2048), _hi = *(const LAS u32x4*)(lds + G_SA(b, h) + aoff1 + m * 2048); dst[m] = (i32x8){(int)_lo.x, (int)_lo.y, (int)_lo.z, (int)_lo.w, (int)_hi.x, (int)_hi.y, (int)_hi.z, (int)_hi.w}; } } while (0)
#define G_LDB(dst, b, h) do { _Pragma("unroll") for (int n = 0; n < 2; ++n) { const u32x4 _lo = *(const LAS u32x4*)(lds + G_SB(b, h) + boff + n * 2048), _hi = *(const LAS u32x4*)(lds + G_SB(b, h) + boff1 + n * 2048); dst[n] = (i32x8){(int)_lo.x, (int)_lo.y, (int)_lo.z, (int)_lo.w, (int)_hi.x, (int)_hi.y, (int)_hi.z, (int)_hi.w}; } } while (0)
#define G_MMA(ai, bj, At, Bt) do { __builtin_amdgcn_s_setprio(1); _Pragma("unroll") for (int m = 0; m < 4; ++m) _Pragma("unroll") for (int n = 0; n < 2; ++n) \
        acc[ai][bj][m][n] = __builtin_amdgcn_mfma_scale_f32_16x16x128_f8f6f4(Bt[n], At[m], acc[ai][bj][m][n], 0, 0, 0, 0, 0, 0); __builtin_amdgcn_s_setprio(0); } while (0)
#define G_WAIT_V(n) asm volatile("s_waitcnt vmcnt(" #n ")" ::: "memory")
#define G_WAIT_L(n) asm volatile("s_waitcnt lgkmcnt(" #n ")" ::: "memory")
#define G_BAR __builtin_amdgcn_s_barrier()
#define G_SCHED __builtin_amdgcn_sched_barrier(0)
    typename S::U cur, nxt; int ui = 0;
    if (!sch.next(0, cur)) return;
    f32x4 acc[2][2][4][2];
#pragma unroll
    for (int a = 0; a < 2; ++a)
#pragma unroll
        for (int b = 0; b < 2; ++b)
#pragma unroll
            for (int m = 0; m < 4; ++m)
#pragma unroll
                for (int n = 0; n < 2; ++n) acc[a][b][m][n] = (f32x4){0.f, 0.f, 0.f, 0.f};
    i32x8 At[4], B0[2], B1[2];
    const char* cA = sch.baseA(cur); const char* cB = sch.baseB(cur);
    if constexpr (S::GA) {
#pragma unroll
        for (int j = 0; j < 4; ++j) { cofA[j] = sch.goffA(cur, (j >> 1) * 128 + R0 + (j & 1) * 64, C0); nofA[j] = cofA[j]; } }
    if constexpr (S::GB) {
#pragma unroll
        for (int j = 0; j < 4; ++j) { cofB[j] = sch.goffB(cur, (j >> 1) * 128 + RB0 + (j & 1) * 64, C0); nofB[j] = cofB[j]; } }
    G_STAGE_B(G_SB(0, 0), cB, 0, false); G_STAGE_B(G_SB(0, 1), cB, 1, false); G_STAGE_A(G_SA(0, 0), cA, 0, false); G_STAGE_A(G_SA(0, 1), cA, 1, false);
    if (wr == 1) G_BAR;
    G_WAIT_V(2); G_BAR;
    G_STAGE_B(G_SB(1, 0), cB + kstep, 0, false); G_STAGE_A(G_SA(1, 0), cA + kstep, 0, false); G_STAGE_B(G_SB(1, 1), cB + kstep, 1, false);
    G_WAIT_V(6); G_BAR;
    for (;;) {
        const bool has_next = sch.next(ui + 1, nxt);
        const char* nA = has_next ? sch.baseA(nxt) : cA; const char* nB = has_next ? sch.baseB(nxt) : cB;
        if constexpr (S::GA) { if (has_next) {
#pragma unroll
            for (int j = 0; j < 4; ++j) nofA[j] = sch.goffA(nxt, (j >> 1) * 128 + R0 + (j & 1) * 64, C0); } }
        if constexpr (S::GB) { if (has_next) {
#pragma unroll
            for (int j = 0; j < 4; ++j) nofB[j] = sch.goffB(nxt, (j >> 1) * 128 + RB0 + (j & 1) * 64, C0); } }
#pragma unroll 1
        for (int t = 0; t < nt; t += 2) {
            const bool last = (t == nt - 2);
            const char* a1 = cA + (size_t)(t + 1) * kstep;
            const char* a2 = last ? nA : cA + (size_t)(t + 2) * kstep; const char* b2 = last ? nB : cB + (size_t)(t + 2) * kstep;
            const char* a3 = a2 + kstep; const char* b3 = b2 + kstep;
            asm volatile("" : "+s"(a1), "+s"(a2), "+s"(a3), "+s"(b2), "+s"(b3));
            const bool post = (t == 0 && ui > 0);
#define G_WAIT_POST() do { if (post) { if constexpr (E::NVM == 8) G_WAIT_V(16); else if constexpr (E::NVM == 16) G_WAIT_V(24); else if constexpr (E::NVM == 32) G_WAIT_V(40); else G_WAIT_V(8); } else G_WAIT_V(8); } while (0)
            G_LDB(B0, 0, 0); G_LDB(B1, 0, 1); G_SCHED; G_LDA(At, 0, 0); if (!post) G_STAGE_A(G_SA(1, 1), a1, 1, false);
            G_WAIT_POST(); G_WAIT_L(0); G_BAR; G_MMA(0, 0, At, B0); G_MMA(0, 1, At, B1); G_BAR; G_SCHED;
            G_LDA(At, 0, 1); G_STAGE_B(G_SB(0, 0), b2, 0, last); G_STAGE_B(G_SB(0, 1), b2, 1, last); G_STAGE_A(G_SA(0, 0), a2, 0, last);
            G_WAIT_POST(); G_WAIT_L(0); G_BAR; G_MMA(1, 0, At, B0); G_MMA(1, 1, At, B1); G_BAR; G_SCHED;
            G_LDB(B0, 1, 0); G_LDB(B1, 1, 1); G_SCHED; G_LDA(At, 1, 0); G_STAGE_A(G_SA(0, 1), a2, 1, last);
            G_WAIT_POST(); G_WAIT_L(0); G_BAR; G_MMA(0, 0, At, B0); G_MMA(0, 1, At, B1); G_BAR; G_SCHED;
            G_LDA(At, 1, 1); G_STAGE_B(G_SB(1, 0), b3, 0, last); G_STAGE_B(G_SB(1, 1), b3, 1, last); G_STAGE_A(G_SA(1, 0), a3, 0, last);
            G_WAIT_V(8); G_WAIT_L(0); G_BAR; G_MMA(1, 0, At, B0); G_MMA(1, 1, At, B1); G_BAR; G_SCHED;
#undef G_WAIT_POST
        }
        if (wr == 0) G_BAR;
        if (has_next) { const char* n1 = nA + kstep; asm volatile("" : "+s"(n1)); G_STAGE_A(G_SA(1, 1), n1, 1, true); }
        { int tz = threadIdx.x; asm volatile("" : "+v"(tz));
          const int ewid = tz >> 6, el = tz & 63; epi(acc, cur, ewid >> 2, ewid & 3, el & 15, el >> 4); }
        if (!has_next) break;
#pragma unroll
        for (int a = 0; a < 2; ++a)
#pragma unroll
            for (int b = 0; b < 2; ++b)
#pragma unroll
                for (int m = 0; m < 4; ++m)
#pragma unroll
                    for (int n = 0; n < 2; ++n) acc[a][b][m][n] = (f32x4){0.f, 0.f, 0.f, 0.f};
        cur = nxt; cA = nA; cB = nB; ++ui;
        if constexpr (S::GA) {
#pragma unroll
            for (int j = 0; j < 4; ++j) cofA[j] = nofA[j]; }
        if constexpr (S::GB) {
#pragma unroll
            for (int j = 0; j < 4; ++j) cofB[j] = nofB[j]; }
        if (wr == 1) G_BAR;
    }
    G_WAIT_V(0);
    G_BAR;
#undef G_SA
#undef G_SB
#undef G_GLDS
#undef G_STAGE_A
#undef G_STAGE_B
#undef G_LDA
#undef G_LDB
#undef G_MMA
#undef G_WAIT_V
#undef G_WAIT_L
#undef G_BAR
#undef G_SCHED
}
#ifndef MK_FAST
#define MK_FAST 1
#endif
#if MK_FAST
#define GEMM_PHASE(lds, S, E) gemm_fast(lds, S, E)
#else
#define GEMM_PHASE(lds, S, E) gemm_simple(lds, S, E)
#endif


template <int ES, int NBJ, class PF, bool NT = true>
__device__ __forceinline__ void epi_coalesced(LAS unsigned char* el, const PF& pf, unsigned char* gbase, size_t pitch, int wr, int wc, int fr, int fq) {
    constexpr int RB = 128 * NBJ * ES, SL = RB / 16, MS = (16384 / (RB * 32)) > 4 ? 4 : (16384 / (RB * 32)), RP = 32 * MS, RI = 64 / SL, SM = SL < 16 ? SL - 1 : 15;
    const int wave = wr * 4 + wc, lane = fq * 16 + fr;
#pragma unroll
    for (int ai = 0; ai < 2; ++ai)
#pragma unroll
        for (int mp = 0; mp < 4 / MS; ++mp) {
#pragma unroll
            for (int mm = 0; mm < MS; ++mm) { const int m = mp * MS + mm, lr = wr * (16 * MS) + mm * 16 + fr;
#pragma unroll
                for (int bj = 0; bj < NBJ; ++bj) { const int cb = (bj * 128 + wc * 32 + 8 * fq) * ES; LAS unsigned char* p = el + lr * RB + ((((cb >> 4) ^ (lr & SM))) << 4) + (cb & 15);
                    if constexpr (ES == 1) *(LAS u32x2*)p = pf.p8(ai, m, bj); else *(LAS u32x4*)p = pf.p16(ai, m, bj); } }
            LDS_WAIT(); __builtin_amdgcn_s_barrier(); asm volatile("" ::: "memory"); __builtin_amdgcn_sched_barrier(0);
#pragma unroll
            for (int j = 0; j < 2; ++j) { const int lrr = wave * (RP / 8) + j * RI + lane / SL, c = lane % SL;
                const u32x4 v = *(const LAS u32x4*)(el + lrr * RB + ((c ^ (lrr & SM)) << 4));
                const int grow = ai * 128 + (lrr / (16 * MS)) * 64 + (mp * MS + ((lrr >> 4) % MS)) * 16 + (lrr & 15);
                if constexpr (NT) __builtin_nontemporal_store(v, (u32x4*)(gbase + (size_t)grow * pitch + c * 16)); else *(u32x4*)(gbase + (size_t)grow * pitch + c * 16) = v; }
            LDS_WAIT(); __builtin_amdgcn_s_barrier(); asm volatile("" ::: "memory"); __builtin_amdgcn_sched_barrier(0);
        }
}
#define ROWLOOP _Pragma("unroll") for (int ai = 0; ai < 2; ++ai) _Pragma("unroll") for (int m = 0; m < 4; ++m)
#define UROW (ai * 128 + wr * 64 + m * 16 + fr)
#define UCOL(bj, n) ((bj) * 128 + wc * 32 + (n) * 16 + 4 * fq)
#define UCOLP(bj) ((bj) * 128 + wc * 32 + 8 * fq)
__device__ __forceinline__ u32x4 pk8(const f32x4 a, const f32x4 b) { u32x4 w; w.x = pk2(a.x, a.y); w.y = pk2(a.z, a.w); w.z = pk2(b.x, b.y); w.w = pk2(b.z, b.w); return w; }
typedef f32x4 AccT[2][2][4][2];

struct UnitD { int pm, pn; };
template <bool PERM_> struct SchedDenseT {
    typedef UnitD U;
    static constexpr bool GA = false, GB = false, PERM = PERM_;
    const bf16* A; const bf16* Bt; int lda, ldb, Kk, nM, nN, vcu;
    __device__ __forceinline__ const char* baseA(const U& u) const { return (const char*)(A + (size_t)u.pm * 256 * lda); }
    __device__ __forceinline__ const char* baseB(const U& u) const { return (const char*)(Bt + (size_t)u.pn * 256 * ldb); }
    __device__ __forceinline__ bool next(int i, U& u) const { const int L = i * NWG + vcu; if (L >= nM * nN) return false; u.pm = L / nN; u.pn = L % nN; return true; }
    __device__ __forceinline__ int K(const U&) const { return Kk; }
    __device__ __forceinline__ const char* rowA(const U& u, int r) const { return (const char*)(A + (size_t)(u.pm * 256 + r) * lda); }
    __device__ __forceinline__ const char* rowB(const U& u, int r) const { return (const char*)(Bt + (size_t)(u.pn * 256 + r) * ldb); }
};
typedef SchedDenseT<false> SchedDense; typedef SchedDenseT<true> SchedDenseP;
struct SchedDense8 {
    typedef UnitD U;
    static constexpr bool GA = false, GB = false, PERM = true;
    const unsigned char* A; const unsigned char* Bt; int lda, ldb, Kk, nM, nN, vcu;
    __device__ __forceinline__ const char* baseA(const U& u) const { return (const char*)(A + (size_t)u.pm * 256 * lda); }
    __device__ __forceinline__ const char* baseB(const U& u) const { return (const char*)(Bt + (size_t)u.pn * 256 * ldb); }
    __device__ __forceinline__ bool next(int i, U& u) const { const int L = i * NWG + vcu; if (L >= nM * nN) return false; u.pm = L / nN; u.pn = L % nN; return true; }
};
struct EpiXZ {
    static constexpr int NVM = 16;
    bf16* XR; bf16* GG;
    __device__ __forceinline__ void operator()(const AccT& acc, const UnitD& u, int wr, int wc, int fr, int fq) const {
        const bool isg = u.pn >= 4; bf16* base = isg ? GG : XR; const int c0 = (u.pn & 3) * 256;
        ROWLOOP { bf16* rp = base + (size_t)(u.pm * 256 + UROW) * D + c0;
#pragma unroll
            for (int bj = 0; bj < 2; ++bj) { f32x4 v0 = acc[ai][bj][m][0] * 0.015625f, v1 = acc[ai][bj][m][1] * 0.015625f;
                if (isg) {
#pragma unroll
                    for (int j = 0; j < 4; ++j) { v0[j] = gelu_tanh(v0[j]); v1[j] = gelu_tanh(v1[j]); } }
                *(u32x4*)(rp + UCOLP(bj)) = pk8(v0, v1); } }
    }
};
struct EpiResF32 {
    static constexpr int NVM = 0;
    const float* R; float* O; int ldc;
    __device__ __forceinline__ void operator()(const AccT& acc, const UnitD& u, int wr, int wc, int fr, int fq) const {
        const size_t base = (size_t)(u.pm * 256 + wr * 64 + fr) * ldc + u.pn * 256;
        f32x4 cur[4], nxt[4];
#pragma unroll
        for (int q = 0; q < 4; ++q) cur[q] = *(const f32x4*)(R + base + UCOL(q >> 1, q & 1));
#pragma unroll
        for (int g = 0; g < 8; ++g) { const int ai = g >> 2, m = g & 3; const size_t ro = base + (size_t)(ai * 128 + m * 16) * ldc;
            if (g < 7) { const size_t rn = base + (size_t)(((g + 1) >> 2) * 128 + ((g + 1) & 3) * 16) * ldc;
#pragma unroll
                for (int q = 0; q < 4; ++q) nxt[q] = *(const f32x4*)(R + rn + UCOL(q >> 1, q & 1)); }
#pragma unroll
            for (int q = 0; q < 4; ++q) __builtin_nontemporal_store((f32x4)(cur[q] * ALPHA + acc[ai][q >> 1][m][q & 1]), (f32x4*)(O + ro + UCOL(q >> 1, q & 1)));
#pragma unroll
            for (int q = 0; q < 4; ++q) cur[q] = nxt[q]; }
    }
};
struct EpiF32 {
    static constexpr int NVM = 32;
    float* O; int ldc;
    __device__ __forceinline__ void operator()(const AccT& acc, const UnitD& u, int wr, int wc, int fr, int fq) const {
        ROWLOOP { const size_t ro = (size_t)(u.pm * 256 + UROW) * ldc + u.pn * 256;
#pragma unroll
            for (int bj = 0; bj < 2; ++bj)
#pragma unroll
                for (int n = 0; n < 2; ++n) *(f32x4*)(O + ro + UCOL(bj, n)) = acc[ai][bj][m][n]; }
    }
};

struct UnitG { int pm, blk, pn; };
struct SchedGate {
    typedef UnitG U;
    static constexpr bool GA = false, GB = false, PERM = true; static constexpr int Kk = 256, lda = D, ldb = 256;
    const bf16* XC; const bf16* WgT; int vcu;
    __device__ __forceinline__ const char* baseA(const U& u) const { return (const char*)(XC + (size_t)u.pm * 256 * D + u.blk * 256); }
    __device__ __forceinline__ const char* baseB(const U& u) const { return (const char*)(WgT + (size_t)(u.blk * 512 + u.pn * 256) * 256); }
    __device__ __forceinline__ bool next(int i, U& u) const { const int L = i * NWG + vcu; if (L >= 128 * 8) return false; u.pm = L >> 3; u.blk = (L >> 1) & 3; u.pn = L & 1; return true; }
    __device__ __forceinline__ int K(const U&) const { return 256; }
    __device__ __forceinline__ const char* rowA(const U& u, int r) const { return (const char*)(XC + (size_t)(u.pm * 256 + r) * D + u.blk * 256); }
    __device__ __forceinline__ const char* rowB(const U& u, int r) const { return (const char*)(WgT + (size_t)(u.blk * 512 + u.pn * 256 + r) * 256); }
};
struct EpiGate {
    static constexpr int NVM = 0;
    const bf16* XC; const float *ba, *bx, *lam; bf16* LA; bf16* UU;
    __device__ __forceinline__ void operator()(const AccT& acc, const UnitG& u, int wr, int wc, int fr, int fq) const {
        const int c0 = u.blk * 256 + u.pn * 128 + wc * 32 + 8 * fq;
        f32x4 vba[2], vbx[2], sp[2];
#pragma unroll
        for (int n = 0; n < 2; ++n) { vba[n] = *(const f32x4*)(ba + c0 + 4 * n); vbx[n] = *(const f32x4*)(bx + c0 + 4 * n); const f32x4 vl = *(const f32x4*)(lam + c0 + 4 * n);
#pragma unroll
            for (int j = 0; j < 4; ++j) { const float x = __expf(-vl[j]); sp[n][j] = 8.0f * x * (1.0f - x * (0.5f - x * (1.0f / 3.0f))); } }
        const size_t base = (size_t)(u.pm * 256 + wr * 64 + fr) * D + c0;
        u32x4 xw = *(const u32x4*)(XC + base);
#pragma unroll
        for (int g = 0; g < 8; ++g) { const int ai = g >> 2, m = g & 3; const size_t ro = base + (size_t)(ai * 128 + m * 16) * D;
            u32x4 xn = xw; if (g < 7) xn = *(const u32x4*)(XC + base + (size_t)(((g + 1) >> 2) * 128 + ((g + 1) & 3) * 16) * D);
            const float xc[8] = {bf_lo(xw.x), bf_hi(xw.x), bf_lo(xw.y), bf_hi(xw.y), bf_lo(xw.z), bf_hi(xw.z), bf_lo(xw.w), bf_hi(xw.w)};
            f32x4 la[2], uu[2];
#pragma unroll
            for (int n = 0; n < 2; ++n) { const f32x4 ga = acc[ai][0][m][n] + vba[n], gx = acc[ai][1][m][n] + vbx[n];
#pragma unroll
                for (int j = 0; j < 4; ++j) { const float r = sigmoidf_(ga[j]), ig = sigmoidf_(gx[j]); const float l = -r * sp[n][j]; la[n][j] = l;
                    const float mult = sqrtf(fmaxf(1.0f - __expf(2.0f * l), 0.f)); uu[n][j] = mult * ig * xc[4 * n + j]; } }
            *(u32x4*)(LA + ro) = pk8(la[0], la[1]); *(u32x4*)(UU + ro) = pk8(uu[0], uu[1]); xw = xn; }
    }
};

struct UnitE { int rb, pn, e, ti; };
struct SchedG1 {
    typedef UnitE U;
    static constexpr bool GA = true, GB = false, PERM = true; static constexpr int Kk = D, lda = D, ldb = D;
    const unsigned char* X; const unsigned char* W13T; const int* ROWA; const int* BLKE; int nrbt, vcu; int ev; const LAS unsigned* tab;
    __device__ __forceinline__ const char* baseA(const U&) const { return (const char*)X; }
    __device__ __forceinline__ const char* baseB(const U& u) const { return (const char*)(W13T + ((size_t)u.e * 512 + u.pn * 256) * D); }
    __device__ __forceinline__ unsigned goffA(const U& u, int r, int C) const { return tab[u.ti * 256 + r] + (unsigned)C * 2u; }
    __device__ __forceinline__ unsigned goffB(const U&, int, int) const { return 0u; }
    __device__ __forceinline__ bool next(int i, U& u) const { const int L = i * NWG + vcu; const int rb = L >> 1; if (rb >= nrbt) return false; u.rb = rb; u.pn = L & 1; u.ti = i; u.e = __builtin_amdgcn_readlane(ev, i); return true; }
    __device__ __forceinline__ int K(const U&) const { return D; }
};
struct PFSwiGLU { const AccT& acc;
    __device__ __forceinline__ u32x2 p8(int ai, int m, int) const { f32x4 h0, h1;
#pragma unroll
        for (int j = 0; j < 4; ++j) { const float a0 = acc[ai][0][m][0][j] * 0.015625f, a1 = acc[ai][0][m][1][j] * 0.015625f; h0[j] = a0 * sigmoidf_(a0) * (acc[ai][1][m][0][j] * 0.015625f); h1[j] = a1 * sigmoidf_(a1) * (acc[ai][1][m][1][j] * 0.015625f); }
        int t0 = __builtin_amdgcn_cvt_pk_fp8_f32(h0.x, h0.y, 0, false); t0 = __builtin_amdgcn_cvt_pk_fp8_f32(h0.z, h0.w, t0, true);
        int t1 = __builtin_amdgcn_cvt_pk_fp8_f32(h1.x, h1.y, 0, false); t1 = __builtin_amdgcn_cvt_pk_fp8_f32(h1.z, h1.w, t1, true); u32x2 w; w.x = (unsigned)t0; w.y = (unsigned)t1; return w; }
    __device__ __forceinline__ u32x4 p16(int, int, int) const { return (u32x4){0u, 0u, 0u, 0u}; } };
struct EpiSwiGLU {
    static constexpr int NVM = 0; static constexpr bool DEFER = false; static constexpr int soff(int) { return 0; }
    unsigned char* HID; LAS unsigned char* el;
    __device__ __forceinline__ void operator()(const AccT& acc, const UnitE& u, int wr, int wc, int fr, int fq) const {
        epi_coalesced<1, 1, PFSwiGLU, false>(el, PFSwiGLU{acc}, HID + ((size_t)u.rb * 256) * DE + u.pn * 128, DE, wr, wc, fr, fq);
    }
};
struct SchedG2 {
    typedef UnitE U;
    static constexpr bool GA = false, GB = false, PERM = true;
    const unsigned char* HID; const unsigned char* W2T; const int* BLKE; int nrbt, vcu; int ev; int Kk, lda, ldb;
    __device__ __forceinline__ const char* baseA(const U& u) const { return (const char*)(HID + (size_t)u.rb * 256 * DE); }
    __device__ __forceinline__ const char* baseB(const U& u) const { return (const char*)(W2T + ((size_t)u.e * D + u.pn * 256) * DE); }
    __device__ __forceinline__ bool next(int i, U& u) const { const int L = i * NWG + vcu; const int rb = L >> 2; if (rb >= nrbt) return false; u.rb = rb; u.pn = L & 3; u.ti = i; u.e = __builtin_amdgcn_readlane(ev, i); return true; }
    __device__ __forceinline__ int K(const U&) const { return DE; }
};
struct PFScatter { const AccT& acc;
    __device__ __forceinline__ u32x2 p8(int ai, int m, int bj) const { const f32x4 v0 = acc[ai][bj][m][0] * 0.25f, v1 = acc[ai][bj][m][1] * 0.25f;
        int t0 = __builtin_amdgcn_cvt_pk_fp8_f32(v0.x, v0.y, 0, false); t0 = __builtin_amdgcn_cvt_pk_fp8_f32(v0.z, v0.w, t0, true);
        int t1 = __builtin_amdgcn_cvt_pk_fp8_f32(v1.x, v1.y, 0, false); t1 = __builtin_amdgcn_cvt_pk_fp8_f32(v1.z, v1.w, t1, true); u32x2 w; w.x = (unsigned)t0; w.y = (unsigned)t1; return w; }
    __device__ __forceinline__ u32x4 p16(int, int, int) const { return (u32x4){0u, 0u, 0u, 0u}; } };
struct EpiScatter {
    static constexpr int NVM = 8; static constexpr bool DEFER = false; static constexpr int soff(int) { return 0; }
    bf16* YA; int dry; LAS unsigned char* el;
    __device__ __forceinline__ void operator()(const AccT& acc, const UnitE& u, int wr, int wc, int fr, int fq) const {
        epi_coalesced<1, 2>(el, PFScatter{acc}, (unsigned char*)YA + ((size_t)u.rb * 256) * D + u.pn * 256, D, wr, wc, fr, fq);
    }
};

__device__ __forceinline__ int rho_to_tok(int rho, int g) { const int sh = 14 - 2 * g; const int rp = rho & 16383; return (rho & ~16383) + (rp >> sh) + ((rp & ((1 << sh) - 1)) << (2 * g)); }
__device__ __forceinline__ int tok_to_rho(int t, int g) { const int sh = 14 - 2 * g; const int tp = t & 16383; return (t & ~16383) + ((tp & ((1 << (2 * g)) - 1)) << sh) + (tp >> (2 * g)); }
struct UnitQ { int type, g, pm, pn; };
struct SchedQK {
    typedef UnitQ U;
    static constexpr bool GA = false, GB = false, PERM = true; static constexpr int Kk = D, ldb = D;
    const unsigned char* X; const unsigned char* WqkT; int g, lda, vcu;
    __device__ __forceinline__ bool next(int i, U& u) const { const int L = i * NWG + vcu; if (L >= 512) return false; u.type = 0; u.g = g; u.pm = L >> 2; u.pn = L & 3; return true; }
    __device__ __forceinline__ int K(const U&) const { return D; }
    __device__ __forceinline__ const char* baseA(const U& u) const { return (const char*)(X + (size_t)rho_to_tok(u.pm * 256, g) * D); }
    __device__ __forceinline__ const char* baseB(const U& u) const { return (const char*)(WqkT + ((size_t)g * 1024 + u.pn * 256) * D); }
    __device__ __forceinline__ const char* rowA(const U& u, int r) const { return (const char*)(X + (size_t)rho_to_tok(u.pm * 256 + r, g) * D); }
    __device__ __forceinline__ const char* rowB(const U& u, int r) const { return (const char*)(WqkT + ((size_t)g * 1024 + u.pn * 256 + r) * D); }
};
struct SchedVT {
    typedef UnitQ U;
    static constexpr bool GA = false, GB = false, PERM = true; static constexpr int Kk = D, lda = D;
    const unsigned char* X; const unsigned char* WvT; int g, ldb, vcu;
    __device__ __forceinline__ bool next(int i, U& u) const { const int L = i * NWG + vcu; if (L >= 256) return false; u.type = 1; u.g = g; u.pn = L >> 1; u.pm = L & 1; return true; }
    __device__ __forceinline__ int K(const U&) const { return D; }
    __device__ __forceinline__ const char* baseA(const U& u) const { return (const char*)(WvT + ((size_t)g * 512 + u.pm * 256) * D); }
    __device__ __forceinline__ const char* baseB(const U& u) const { return (const char*)(X + (size_t)rho_to_tok(u.pn * 256, g) * D); }
    __device__ __forceinline__ const char* rowA(const U& u, int r) const { return (const char*)(WvT + ((size_t)g * 512 + u.pm * 256 + r) * D); }
    __device__ __forceinline__ const char* rowB(const U& u, int r) const { return (const char*)(X + (size_t)rho_to_tok(u.pn * 256 + r, g) * D); }
};
struct PFScaled { const AccT& acc; float sc;
    __device__ __forceinline__ u32x2 p8(int, int, int) const { return (u32x2){0u, 0u}; }
    __device__ __forceinline__ u32x4 p16(int ai, int m, int bj) const { return pk8(acc[ai][bj][m][0] * sc, acc[ai][bj][m][1] * sc); } };
struct EpiQKV {
    static constexpr int NVM = 16; static constexpr bool DEFER = false; static constexpr int soff(int) { return 0; }
    bf16* QK; bf16* VT; LAS unsigned char* el;
    __device__ __forceinline__ void operator()(const AccT& acc, const UnitQ& u, int wr, int wc, int fr, int fq) const {
        bf16* base; size_t ldc;
        if (u.type == 0) { base = QK + (size_t)u.g * M * 1024; ldc = 1024; } else { base = VT + (size_t)u.g * 512 * M; ldc = M; }
        epi_coalesced<2, 2>(el, PFScaled{acc, 0.015625f}, (unsigned char*)(base + (size_t)(u.pm * 256) * ldc + u.pn * 256), ldc * 2, wr, wc, fr, fq);
    }
};

__device__ __forceinline__ void tr_item(const float* src, int spitch, bf16* dst, int dpitch, LAS float* scr, int lane) {
#pragma unroll 4
    for (int i = 0; i < 16; ++i) { const int k = 4 * i + (lane >> 4), n4 = (lane & 15) * 4; const f32x4 v = *(const f32x4*)(src + (size_t)k * spitch + n4);
        LAS float* s = scr + k * 65 + n4; s[0] = v.x; s[1] = v.y; s[2] = v.z; s[3] = v.w; }
    LDS_WAIT(); asm volatile("" ::: "memory");
    const int c = lane & 7;
#pragma unroll
    for (int j = 0; j < 8; ++j) { const int n = 8 * j + (lane >> 3); const LAS float* s = scr + (8 * c) * 65 + n;
        u32x4 o; o.x = pk2(s[0], s[65]); o.y = pk2(s[2 * 65], s[3 * 65]); o.z = pk2(s[4 * 65], s[5 * 65]); o.w = pk2(s[6 * 65], s[7 * 65]);
        *(u32x4*)(dst + (size_t)n * dpitch + 8 * c) = o; }
    LDS_WAIT(); asm volatile("" ::: "memory");
}
__device__ __forceinline__ void tr_item8(const float* src, int spitch, unsigned char* dst, int dpitch, LAS float* scr, int lane) {
#pragma unroll 4
    for (int i = 0; i < 16; ++i) { const int k = 4 * i + (lane >> 4), n4 = (lane & 15) * 4; const f32x4 v = *(const f32x4*)(src + (size_t)k * spitch + n4);
        LAS float* s = scr + k * 65 + n4; s[0] = v.x; s[1] = v.y; s[2] = v.z; s[3] = v.w; }
    LDS_WAIT(); asm volatile("" ::: "memory");
    const int c = lane & 7;
#pragma unroll
    for (int j = 0; j < 8; ++j) { const int n = 8 * j + (lane >> 3); const LAS float* s = scr + (8 * c) * 65 + n;
        int t0 = __builtin_amdgcn_cvt_pk_fp8_f32(s[0] * 64.f, s[65] * 64.f, 0, false); t0 = __builtin_amdgcn_cvt_pk_fp8_f32(s[2 * 65] * 64.f, s[3 * 65] * 64.f, t0, true);
        int t1 = __builtin_amdgcn_cvt_pk_fp8_f32(s[4 * 65] * 64.f, s[5 * 65] * 64.f, 0, false); t1 = __builtin_amdgcn_cvt_pk_fp8_f32(s[6 * 65] * 64.f, s[7 * 65] * 64.f, t1, true);
        u32x2 o; o.x = (unsigned)t0; o.y = (unsigned)t1; *(u32x2*)(dst + (size_t)n * dpitch + 8 * c) = o; }
    LDS_WAIT(); asm volatile("" ::: "memory");
}
template <class RowMap>
__device__ __forceinline__ void tr_matrix(Frame& F, const float* W, int K, int N, bf16* WT, int dpitch, RowMap drow) {
    LAS float* scr = (LAS float*)(F.lds + F.wave * 16640);
    const int nkb = K / 64, nnb = N / 64;
    for (int it = F.vcu * NWAVES + F.wave; it < nkb * nnb; it += NGW) { const int kb = it / nnb, nb = it % nnb;
        tr_item(W + (size_t)(kb * 64) * N + nb * 64, N, WT + (size_t)drow(nb * 64) * dpitch + kb * 64, dpitch, scr, F.lane); }
}
template <class RowMap>
__device__ __forceinline__ void tr_matrix8(Frame& F, const float* W, int K, int N, unsigned char* WT, int dpitch, RowMap drow) {
    LAS float* scr = (LAS float*)(F.lds + F.wave * 16640);
    const int nkb = K / 64, nnb = N / 64;
    for (int it = F.vcu * NWAVES + F.wave; it < nkb * nnb; it += NGW) { const int kb = it / nnb, nb = it % nnb;
        tr_item8(W + (size_t)(kb * 64) * N + nb * 64, N, WT + (size_t)drow(nb * 64) * dpitch + kb * 64, dpitch, scr, F.lane); }
}
__device__ __forceinline__ void cv_src(int it, const float* w1, const float* w3, const float* w2, const float* s1, const float* s3, const float* s2, const float*& src, int& spitch) {
    const int e = it / 192, r = it % 192, which = r >> 6, tile = r & 63;
    if (which < 2) { const float* W = (e < 256) ? (which == 0 ? w1 : w3) + (size_t)e * (size_t)(D * DE) : (which == 0 ? s1 : s3); src = W + (size_t)((tile >> 2) * 64) * DE + (tile & 3) * 64; spitch = DE; }
    else { const float* W = (e < 256) ? w2 + (size_t)e * (size_t)(DE * D) : s2; src = W + (size_t)((tile >> 4) * 64) * D + (tile & 15) * 64; spitch = D; }
}
__device__ __forceinline__ void convert_experts(Frame& F, const float* w1, const float* w3, const float* w2, const float* s1, const float* s3, const float* s2, int layer, int part, int nparts) {
    LAS float* scr = (LAS float*)(F.lds + F.wave * 16640);
    unsigned char* W13T = WSP(unsigned char, WS_W13) + (size_t)layer * W13_LB; unsigned char* W2T = WSP(unsigned char, WS_W2) + (size_t)layer * W2_LB;
    const int lane = F.lane; const int NTOT = 257 * 192; const int it0 = (int)((long)NTOT * part / nparts), NIT = (int)((long)NTOT * (part + 1) / nparts);
    f32x4 cur[16], nxt[16];
    int it = it0 + F.vcu * NWAVES + F.wave;
    if (it < NIT) { const float* src; int sp; cv_src(it, w1, w3, w2, s1, s3, s2, src, sp);
#pragma unroll
        for (int i = 0; i < 16; ++i) cur[i] = __builtin_nontemporal_load((const f32x4*)(src + (size_t)(4 * i + (lane >> 4)) * sp + (lane & 15) * 4)); }
#pragma unroll 1
    for (; it < NIT; it += NGW) {
        const int itn = it + NGW;
        if (itn < NIT) { const float* src; int sp; cv_src(itn, w1, w3, w2, s1, s3, s2, src, sp);
#pragma unroll
            for (int i = 0; i < 16; ++i) nxt[i] = __builtin_nontemporal_load((const f32x4*)(src + (size_t)(4 * i + (lane >> 4)) * sp + (lane & 15) * 4)); }
#pragma unroll
        for (int i = 0; i < 16; ++i) { const int k = 4 * i + (lane >> 4), n4 = (lane & 15) * 4; LAS float* s = scr + k * 65 + n4; s[0] = cur[i].x; s[1] = cur[i].y; s[2] = cur[i].z; s[3] = cur[i].w; }
        LDS_WAIT(); asm volatile("" ::: "memory");
        const int e = it / 192, r = it % 192, which = r >> 6, tile = r & 63, c = lane & 7;
        if (which < 2) { const int kb = tile >> 2, nb = tile & 3; const int drow = (nb >> 1) * 256 + which * 128 + (nb & 1) * 64; unsigned char* dst = W13T + ((size_t)e * 512 + drow) * D + kb * 64;
#pragma unroll
            for (int j = 0; j < 8; ++j) { const int n = 8 * j + (lane >> 3); const LAS float* s = scr + (8 * c) * 65 + n;
                int t0 = __builtin_amdgcn_cvt_pk_fp8_f32(s[0] * 64.f, s[65] * 64.f, 0, false); t0 = __builtin_amdgcn_cvt_pk_fp8_f32(s[2 * 65] * 64.f, s[3 * 65] * 64.f, t0, true);
                int t1 = __builtin_amdgcn_cvt_pk_fp8_f32(s[4 * 65] * 64.f, s[5 * 65] * 64.f, 0, false); t1 = __builtin_amdgcn_cvt_pk_fp8_f32(s[6 * 65] * 64.f, s[7 * 65] * 64.f, t1, true);
                u32x2 o; o.x = (unsigned)t0; o.y = (unsigned)t1; __builtin_nontemporal_store(o, (u32x2*)(dst + (size_t)n * D + 8 * c)); } }
        else { const int kb = tile >> 4, nb = tile & 15; unsigned char* dst = W2T + ((size_t)e * D + nb * 64) * DE + kb * 64;
#pragma unroll
            for (int j = 0; j < 8; ++j) { const int n = 8 * j + (lane >> 3); const LAS float* s = scr + (8 * c) * 65 + n;
                int t0 = __builtin_amdgcn_cvt_pk_fp8_f32(s[0] * 64.f, s[65] * 64.f, 0, false); t0 = __builtin_amdgcn_cvt_pk_fp8_f32(s[2 * 65] * 64.f, s[3 * 65] * 64.f, t0, true);
                int t1 = __builtin_amdgcn_cvt_pk_fp8_f32(s[4 * 65] * 64.f, s[5 * 65] * 64.f, 0, false); t1 = __builtin_amdgcn_cvt_pk_fp8_f32(s[6 * 65] * 64.f, s[7 * 65] * 64.f, t1, true);
                u32x2 o; o.x = (unsigned)t0; o.y = (unsigned)t1; __builtin_nontemporal_store(o, (u32x2*)(dst + (size_t)n * DE + 8 * c)); } }
        LDS_WAIT(); asm volatile("" ::: "memory");
#pragma unroll
        for (int i = 0; i < 16; ++i) cur[i] = nxt[i];
    }
}
struct MapId { __device__ int operator()(int n0) const { return n0; } };
struct MapGate { int which; __device__ int operator()(int n0) const { return (n0 >> 7) * 256 + which * 128 + (n0 & 127); } };
struct MapQ { __device__ int operator()(int n0) const { return (n0 >> 9) * 1024 + (n0 & 511); } };
struct MapKV { __device__ int operator()(int n0) const { return n0 < 1536 ? (n0 >> 9) * 1024 + 512 + (n0 & 511) : 3072 + (n0 - 1536); } };

__device__ __forceinline__ void p0_prologue(Frame& F, const Args& A) {
    { const float* x = A.in[0]; unsigned char* XQ = WSP(unsigned char, WS_RA + RA_XB);
      for (size_t i = (size_t)F.vcu * NTHR + F.tid; i < (size_t)M * D / 8; i += NGT) { const f32x4 a = *(const f32x4*)(x + i * 8), b = *(const f32x4*)(x + i * 8 + 4);
          int t0 = __builtin_amdgcn_cvt_pk_fp8_f32(a.x, a.y, 0, false); t0 = __builtin_amdgcn_cvt_pk_fp8_f32(a.z, a.w, t0, true);
          int t1 = __builtin_amdgcn_cvt_pk_fp8_f32(b.x, b.y, 0, false); t1 = __builtin_amdgcn_cvt_pk_fp8_f32(b.z, b.w, t1, true);
          u32x2 o; o.x = (unsigned)t0; o.y = (unsigned)t1; *(u32x2*)(XQ + i * 8) = o; } }
    tr_matrix8(F, A.in[1], D, 2048, WSP(unsigned char, WS_WIN), D, MapId());
    for (int b = 0; b < 4; ++b) { tr_matrix(F, A.in[4] + b * 65536, 256, 256, WSP(bf16, WS_WG) + (size_t)b * 512 * 256, 256, MapGate{0});
                                  tr_matrix(F, A.in[6] + b * 65536, 256, 256, WSP(bf16, WS_WG) + (size_t)b * 512 * 256, 256, MapGate{1}); }
    tr_matrix(F, A.in[9], D, D, WSP(bf16, WS_WOUT), D, MapId());
    tr_matrix8(F, A.in[11], D, QW, WSP(unsigned char, WS_WQK), D, MapQ());
    tr_matrix8(F, A.in[10], D, 2 * QW, WSP(unsigned char, WS_WQK), D, MapKV());
    tr_matrix(F, A.in[12], OW, D, WSP(bf16, WS_WO), OW, MapId());
    for (int l = 0; l < 2; ++l) tr_matrix(F, A.in[13] + (size_t)l * D * NE, D, NE, WSP(bf16, WS_WR) + (size_t)l * NE * D, D, MapId());
}
static_assert(WS_WV == WS_WQK + (size_t)3072 * 1024 * 2, "WvT must follow WqkT");

__device__ __forceinline__ void ln_store(f32x4 (&v)[4], const float* g, const float* b, float* of, bf16* ob, int lane, unsigned char* oq = nullptr) {
    float s = 0.f;
#pragma unroll
    for (int j = 0; j < 4; ++j) s += (v[j].x + v[j].y) + (v[j].z + v[j].w);
    const float mean = wave_sum(s) * (1.f / D); float s2 = 0.f;
#pragma unroll
    for (int j = 0; j < 4; ++j) { v[j] = v[j] - mean; s2 += (v[j].x * v[j].x + v[j].y * v[j].y) + (v[j].z * v[j].z + v[j].w * v[j].w); }
    const float rstd = 1.f / sqrtf(wave_sum(s2) * (1.f / D) + LN_EPS);
#pragma unroll
    for (int j = 0; j < 4; ++j) { const int c = 4 * lane + 256 * j; const f32x4 gg = *(const f32x4*)(g + c), bb = *(const f32x4*)(b + c); const f32x4 y = v[j] * rstd * gg + bb;
        if (of) __builtin_nontemporal_store(y, (f32x4*)(of + c));
        if (ob) { u32x2 w; w.x = pk2(y.x, y.y); w.y = pk2(y.z, y.w); *(u32x2*)(ob + c) = w; }
        if (oq) { int t = __builtin_amdgcn_cvt_pk_fp8_f32(y.x, y.y, 0, false); t = __builtin_amdgcn_cvt_pk_fp8_f32(y.z, y.w, t, true); *(unsigned*)(oq + c) = (unsigned)t; } }
}

__device__ __forceinline__ int moe_unit_experts(Frame& F, const int* BLKE, int nrbt, int shift) { const int L = F.lane * NWG + F.vcu; const int rb = L >> shift; return rb < nrbt ? BLKE[rb] : 0; }
__device__ __forceinline__ const LAS unsigned* moe_row_table(Frame& F, const int* ROWA, int nrbt) {
    LAS unsigned* tab = (LAS unsigned*)(F.lds + LDS_TAB);
    if (F.tid < 256) { int a[15];
#pragma unroll
        for (int i = 0; i < 15; ++i) { const int rb = (i * NWG + F.vcu) >> 1; a[i] = rb < nrbt ? ROWA[rb * 256 + F.tid] : -1; }
#pragma unroll
        for (int i = 0; i < 15; ++i) { const int tok = a[i] < 0 ? 0 : (a[i] < 8 * M ? (a[i] >> 3) : a[i] - 8 * M); tab[i * 256 + F.tid] = (unsigned)tok * (unsigned)D; } }
    __syncthreads();
    return tab;
}
__device__ __forceinline__ void p_conv(Frame& F, const float* cw, const float* cb) {
    const bf16* XR = WSP(bf16, WS_RA + RA_XR); bf16* XC = WSP(bf16, WS_RA + RA_XC);
    for (int i = F.vcu * NTHR + F.tid; i < M * (D / 8); i += NGT) { const int t = i >> 7, c = (i & 127) * 8; const int ts = t & (SEQ - 1);
        float a[8];
#pragma unroll
        for (int q = 0; q < 8; ++q) a[q] = cb[c + q];
#pragma unroll
        for (int j = 0; j < 4; ++j) { if (ts - 3 + j >= 0) { const u32x4 w = *(const u32x4*)(XR + (size_t)(t - 3 + j) * D + c); const float* wj = cw + j * D + c;
            a[0] += wj[0] * bf_lo(w.x); a[1] += wj[1] * bf_hi(w.x); a[2] += wj[2] * bf_lo(w.y); a[3] += wj[3] * bf_hi(w.y);
            a[4] += wj[4] * bf_lo(w.z); a[5] += wj[5] * bf_hi(w.z); a[6] += wj[6] * bf_lo(w.w); a[7] += wj[7] * bf_hi(w.w); } }
        u32x4 o; o.x = pk2(a[0], a[1]); o.y = pk2(a[2], a[3]); o.z = pk2(a[4], a[5]); o.w = pk2(a[6], a[7]); *(u32x4*)(XC + (size_t)t * D + c) = o; }
}
constexpr int CH = 64, NCH = SEQ / CH;
__device__ __forceinline__ void p_scan1(Frame& F) {
    const bf16* LA = WSP(bf16, WS_RA + RA_LA); const bf16* UU = WSP(bf16, WS_RA + RA_U); float* CP = WSP(float, WS_CHP); float* CHh = WSP(float, WS_CHH);
    for (int i = F.vcu * NTHR + F.tid; i < BATCH * NCH * (D / 4); i += NGT) { const int c4 = (i & 255) * 4, ck = (i >> 8) & (NCH - 1), b = i >> 16;
        const size_t r0 = ((size_t)b * SEQ + (size_t)ck * CH) * D + c4; f32x4 h = {0.f, 0.f, 0.f, 0.f}, sl = {0.f, 0.f, 0.f, 0.f};
#pragma unroll 8
        for (int t = 0; t < CH; ++t) { const u32x2 lw = *(const u32x2*)(LA + r0 + (size_t)t * D), uw = *(const u32x2*)(UU + r0 + (size_t)t * D);
            const f32x4 la = {bf_lo(lw.x), bf_hi(lw.x), bf_lo(lw.y), bf_hi(lw.y)}, u = {bf_lo(uw.x), bf_hi(uw.x), bf_lo(uw.y), bf_hi(uw.y)};
#pragma unroll
            for (int j = 0; j < 4; ++j) { h[j] = __expf(la[j]) * h[j] + u[j]; sl[j] += la[j]; } }
#pragma unroll
        for (int j = 0; j < 4; ++j) { const size_t o = ((size_t)b * D + c4 + j) * NCH + ck; CP[o] = __expf(sl[j]); CHh[o] = h[j]; } }
}
__device__ __forceinline__ void p_scan2(Frame& F) {
    const float* CP = WSP(float, WS_CHP); const float* CHh = WSP(float, WS_CHH); float* CIN = WSP(float, WS_CIN);
    for (int s = F.vcu * NWAVES + F.wave; s < BATCH * D; s += NGW) { const size_t o = (size_t)s * NCH + 4 * F.lane;
        const f32x4 p4 = *(const f32x4*)(CP + o), h4 = *(const f32x4*)(CHh + o);
        float p = p4.x, h = h4.x; h = p4.y * h + h4.y; p *= p4.y; h = p4.z * h + h4.z; p *= p4.z; h = p4.w * h + h4.w; p *= p4.w;
#pragma unroll
        for (int off = 1; off < 64; off <<= 1) { const float pp = __shfl_up(p, off), hp = __shfl_up(h, off); if (F.lane >= off) { h = p * hp + h; p = pp * p; } }
        float c0 = __shfl_up(h, 1); if (F.lane == 0) c0 = 0.f;
        f32x4 ci; ci.x = c0; ci.y = p4.x * ci.x + h4.x; ci.z = p4.y * ci.y + h4.y; ci.w = p4.z * ci.z + h4.z;
        *(f32x4*)(CIN + o) = ci; }
}
__device__ __forceinline__ void p_scan3(Frame& F) {
    const bf16* LA = WSP(bf16, WS_RA + RA_LA); const bf16* UU = WSP(bf16, WS_RA + RA_U); const float* CIN = WSP(float, WS_CIN);
    const bf16* GG = WSP(bf16, WS_RA + RA_GG); bf16* YB = WSP(bf16, WS_RA + RA_YB);
    for (int i = F.vcu * NTHR + F.tid; i < BATCH * NCH * (D / 4); i += NGT) { const int c4 = (i & 255) * 4, ck = (i >> 8) & (NCH - 1), b = i >> 16;
        const size_t r0 = ((size_t)b * SEQ + (size_t)ck * CH) * D + c4; f32x4 h;
#pragma unroll
        for (int j = 0; j < 4; ++j) h[j] = CIN[((size_t)b * D + c4 + j) * NCH + ck];
#pragma unroll 1
        for (int t0 = 0; t0 < CH; t0 += 8) { u32x2 lw[8], uw[8], gw[8];
#pragma unroll
            for (int k = 0; k < 8; ++k) { const size_t o = r0 + (size_t)(t0 + k) * D; lw[k] = __builtin_nontemporal_load((const u32x2*)(LA + o)); uw[k] = __builtin_nontemporal_load((const u32x2*)(UU + o)); gw[k] = __builtin_nontemporal_load((const u32x2*)(GG + o)); }
#pragma unroll
            for (int k = 0; k < 8; ++k) { const f32x4 la = {bf_lo(lw[k].x), bf_hi(lw[k].x), bf_lo(lw[k].y), bf_hi(lw[k].y)}, u = {bf_lo(uw[k].x), bf_hi(uw[k].x), bf_lo(uw[k].y), bf_hi(uw[k].y)};
#pragma unroll
                for (int j = 0; j < 4; ++j) h[j] = __expf(la[j]) * h[j] + u[j];
                u32x2 o; o.x = pk2(h.x * bf_lo(gw[k].x), h.y * bf_hi(gw[k].x)); o.y = pk2(h.z * bf_lo(gw[k].y), h.w * bf_hi(gw[k].y)); *(u32x2*)(YB + r0 + (size_t)(t0 + k) * D) = o; } } }
}
__device__ __forceinline__ void p_ln(Frame& F, const float* V, const float* g, const float* b, float* Hf, bf16* Hb) {
    unsigned char* Hq = WSP(unsigned char, WS_HQ);
    for (int r = F.vcu * NWAVES + F.wave; r < M; r += NGW) { const f32x4* xr = (const f32x4*)(V + (size_t)r * D) + F.lane; f32x4 v[4];
#pragma unroll
        for (int j = 0; j < 4; ++j) v[j] = __builtin_nontemporal_load(xr + 64 * j);
        ln_store(v, g, b, Hf + (size_t)r * D, Hb + (size_t)r * D, F.lane, Hq + (size_t)r * D); }
}
template <int CTRL> __device__ __forceinline__ float dppf(float x) { return __builtin_bit_cast(float, __builtin_amdgcn_mov_dpp(__builtin_bit_cast(int, x), CTRL, 0xF, 0xF, true)); }
template <int CTRL> __device__ __forceinline__ unsigned dppu(unsigned x) { return (unsigned)__builtin_amdgcn_mov_dpp((int)x, CTRL, 0xF, 0xF, true); }
__device__ __forceinline__ float rdlane_f(float x, int l) { return __builtin_bit_cast(float, __builtin_amdgcn_readlane(__builtin_bit_cast(int, x), l)); }
__device__ __forceinline__ void p_route(Frame& F, const float* bias) {
    const float* LG = WSP(float, WS_LOGITS); int* TOPI = WSP(int, WS_TOPI); float* GATE = WSP(float, WS_GATE); int* HIST = WSP(int, WS_HIST);
    LAS int* hist = (LAS int*)F.lds; const int lane = F.lane;
    if (F.tid < 256) hist[F.tid] = 0;
    __syncthreads();
    const f32x4 bv = *(const f32x4*)(bias + 4 * lane);
#pragma unroll 2
    for (int j = 0; j < 16; ++j) { const int t = F.vcu * 128 + F.wave * 16 + j;
        const f32x4 z = *(const f32x4*)(LG + (size_t)t * NE + 4 * lane);
        const float s0 = sigmoidf_(z.x), s1 = sigmoidf_(z.y), s2 = sigmoidf_(z.z), s3 = sigmoidf_(z.w);
        const float v0 = s0 + bv.x, v1 = s1 + bv.y, v2 = s2 + bv.z, v3 = s3 + bv.w;
        float m1, m2; { const float a = fmaxf(v0, v1), b = fminf(v0, v1), c = fmaxf(v2, v3), d = fminf(v2, v3); m1 = fmaxf(a, c); m2 = fmaxf(fminf(a, c), fmaxf(b, d)); }
        { float o1 = dppf<0xB1>(m1), o2 = dppf<0xB1>(m2); float n1 = fmaxf(m1, o1), n2 = fmaxf(fminf(m1, o1), fmaxf(m2, o2)); m1 = n1; m2 = n2;
          o1 = dppf<0x4E>(m1); o2 = dppf<0x4E>(m2); n1 = fmaxf(m1, o1); n2 = fmaxf(fminf(m1, o1), fmaxf(m2, o2)); m1 = n1; m2 = n2;
          o1 = dppf<0x141>(m1); o2 = dppf<0x141>(m2); n1 = fmaxf(m1, o1); n2 = fmaxf(fminf(m1, o1), fmaxf(m2, o2)); m1 = n1; m2 = n2; }
        const float gs = m1 + m2; const int g = lane >> 3; int rank = 0;
#pragma unroll
        for (int q = 0; q < 8; ++q) { const float o = rdlane_f(gs, 8 * q); rank += (o > gs || (o == gs && q < g)) ? 1 : 0; }
        const bool sel = rank < 4;
        const unsigned ib = 255u - 4u * (unsigned)lane;
        unsigned k0 = sel ? ((__float_as_uint(v0 + 1.0f) & ~255u) | ib) : 0u, k1 = sel ? ((__float_as_uint(v1 + 1.0f) & ~255u) | (ib - 1u)) : 0u;
        unsigned k2 = sel ? ((__float_as_uint(v2 + 1.0f) & ~255u) | (ib - 2u)) : 0u, k3 = sel ? ((__float_as_uint(v3 + 1.0f) & ~255u) | (ib - 3u)) : 0u;
        int myidx = 0; float mys = 0.f, tot = 0.f;
#pragma unroll
        for (int k = 0; k < TOPK; ++k) {
            unsigned mk = max(max(k0, k1), max(k2, k3));
            mk = max(mk, dppu<0xB1>(mk)); mk = max(mk, dppu<0x4E>(mk)); mk = max(mk, dppu<0x141>(mk)); mk = max(mk, dppu<0x140>(mk));
            const unsigned win = max(max((unsigned)__builtin_amdgcn_readlane((int)mk, 0), (unsigned)__builtin_amdgcn_readlane((int)mk, 16)), max((unsigned)__builtin_amdgcn_readlane((int)mk, 32), (unsigned)__builtin_amdgcn_readlane((int)mk, 48)));
            const int idx = 255 - (int)(win & 255u);
            k0 = (k0 == win) ? 0u : k0; k1 = (k1 == win) ? 0u : k1; k2 = (k2 == win) ? 0u : k2; k3 = (k3 == win) ? 0u : k3;
            const int qq = idx & 3; const float sq = qq == 0 ? s0 : (qq == 1 ? s1 : (qq == 2 ? s2 : s3)); const float sw = rdlane_f(sq, idx >> 2);
            tot += sw; if (lane == k) { myidx = idx; mys = sw; }
        }
        if (lane < TOPK) { TOPI[t * TOPK + lane] = myidx; GATE[t * TOPK + lane] = mys / tot * 2.5f; atomicAdd((int*)&hist[myidx], 1); }
    }
    __syncthreads();
    if (F.tid < 256) HIST[F.vcu * 256 + F.tid] = hist[F.tid];
    __syncthreads();
}
__device__ __forceinline__ void p_sort(Frame& F) {
    const int* HIST = WSP(int, WS_HIST); const int* TOPI = WSP(int, WS_TOPI); int* ROWA = WSP(int, WS_ROWA); int* POS = WSP(int, WS_POS); int* BLKE = WSP(int, WS_BLKE); int* META = WSP(int, WS_META);
    LAS int* cnt = (LAS int*)F.lds; LAS int* myoff = cnt + 256; LAS int* nb = cnt + 512; LAS int* blk0 = cnt + 768; LAS int* lcnt = cnt + 1024;
    { typedef int i32x4 __attribute__((ext_vector_type(4)));
      const int q = F.tid >> 6, l = F.tid & 63; i32x4 c = {0, 0, 0, 0}, mo = {0, 0, 0, 0};
#pragma unroll 8
      for (int w = q; w < NWG; w += 8) { const i32x4 h = *(const i32x4*)(HIST + w * 256 + 4 * l); c += h; if (w < F.vcu) mo += h; }
      LAS int* redc = cnt + 1280; LAS int* redm = redc + 2048;
#pragma unroll
      for (int j = 0; j < 4; ++j) { redc[q * 256 + 4 * l + j] = c[j]; redm[q * 256 + 4 * l + j] = mo[j]; }
      __syncthreads();
      if (F.tid < 256) { const int e = F.tid; int cc = 0, mm = 0;
#pragma unroll
          for (int k = 0; k < 8; ++k) { cc += redc[k * 256 + e]; mm += redm[k * 256 + e]; }
          cnt[e] = cc; myoff[e] = mm; nb[e] = (cc + 255) >> 8; lcnt[e] = 0; } }
    __syncthreads();
    if (F.tid < 256) { int b = 0; for (int j = 0; j < F.tid; ++j) b += nb[j]; blk0[F.tid] = b; }
    __syncthreads();
    for (int al = F.tid; al < 1024; al += NTHR) { const int a = F.vcu * 1024 + al; const int e = TOPI[a]; const int pos = blk0[e] * 256 + myoff[e] + atomicAdd((int*)&lcnt[e], 1); ROWA[pos] = a; POS[a] = pos; }
    const int nrb = blk0[255] + nb[255];
    { const int e = F.vcu; const int start = blk0[e] * 256 + cnt[e], end = (blk0[e] + nb[e]) * 256;
      for (int p = start + F.tid; p < end; p += NTHR) ROWA[p] = -1;
      for (int j = F.tid; j < nb[e]; j += NTHR) BLKE[blk0[e] + j] = e; }
    for (int tl = F.tid; tl < 128; tl += NTHR) { const int t = F.vcu * 128 + tl; ROWA[nrb * 256 + t] = 8 * M + t; }
    if (F.vcu == 0) { for (int j = F.tid; j < 128; j += NTHR) BLKE[nrb + j] = 256; if (F.tid == 0) META[0] = nrb + 128; }
    __syncthreads();
}
__device__ __forceinline__ void p_combine(Frame& F, const float* Hin, const float* g, const float* b, float* Hf, unsigned char* Hq) {
    const bf16* YA = WSP(bf16, WS_RA); const float* GATE = WSP(float, WS_GATE); const int* POS = WSP(int, WS_POS); const int shrow0 = (*WSP(int, WS_META) - 128) * 256;
    for (int t = F.vcu * NWAVES + F.wave; t < M; t += NGW) { f32x4 v[4];
        const f32x4* hr = (const f32x4*)(Hin + (size_t)t * D) + F.lane;
#pragma unroll
        for (int j = 0; j < 4; ++j) v[j] = __builtin_nontemporal_load(hr + 64 * j) * ALPHA;
        f32x4 r[4];
#pragma unroll
        for (int j = 0; j < 4; ++j) r[j] = (f32x4){0.f, 0.f, 0.f, 0.f};
#pragma unroll
        for (int k = 0; k < TOPK; ++k) { const float gk = GATE[t * TOPK + k] * 0.0625f; const unsigned* yr = (const unsigned*)((const unsigned char*)YA + (size_t)POS[t * TOPK + k] * D) + F.lane;
#pragma unroll
            for (int j = 0; j < 4; ++j) { const unsigned w = yr[64 * j]; const f32x2 a = __builtin_amdgcn_cvt_pk_f32_fp8((int)w, false), c = __builtin_amdgcn_cvt_pk_f32_fp8((int)w, true);
                r[j].x += gk * a.x; r[j].y += gk * a.y; r[j].z += gk * c.x; r[j].w += gk * c.y; } }
        { const unsigned* yr = (const unsigned*)((const unsigned char*)YA + (size_t)(shrow0 + t) * D) + F.lane;
#pragma unroll
            for (int j = 0; j < 4; ++j) { const unsigned w = yr[64 * j]; const f32x2 a = __builtin_amdgcn_cvt_pk_f32_fp8((int)w, false), c = __builtin_amdgcn_cvt_pk_f32_fp8((int)w, true);
                v[j].x += r[j].x + 0.0625f * a.x; v[j].y += r[j].y + 0.0625f * a.y; v[j].z += r[j].z + 0.0625f * c.x; v[j].w += r[j].w + 0.0625f * c.y; } }
        ln_store(v, g, b, Hf + (size_t)t * D, nullptr, F.lane, Hq ? Hq + (size_t)t * D : nullptr); }
}
constexpr int AT_KP = 144, AT_VP = 784, AT_KBYTES = 384 * AT_KP, AT_VOFF = AT_KBYTES;
__device__ __forceinline__ void p_attn(Frame& F) {
    const bf16* QKb = WSP(bf16, WS_RA + RA_QK); const bf16* VTb = WSP(bf16, WS_RA + RA_VT); bf16* OGb = WSP(bf16, WS_RA + RA_OG); float* LSE = WSP(float, WS_LSE);
    const int lane = F.lane, q = lane & 31, hh = lane >> 5, w = F.wave;
    LAS unsigned char* lk = F.lds; LAS unsigned char* lv = F.lds + AT_VOFF;
#pragma unroll 1
    for (int it = F.vcu; it < 3 * 128 * 8; it += NWG) {
        const int g = it >> 10, rem = it & 1023, chunk = rem >> 3, h = rem & 7;
        const int sh = 14 - 2 * g, rq0 = chunk * 256, i0 = rq0 & ((1 << sh) - 1), rk0 = rq0 - 128;
        const bf16* QK = QKb + (size_t)g * M * 1024; const bf16* VT = VTb + (size_t)g * 512 * M;
        { const char* kb = (const char*)(QK + 512 + h * 64);
#pragma unroll
          for (int j = 0; j < 7; ++j) { const int ins = w + 8 * j; if (ins < 54) { const int p = ins * 64 + lane, row = p / 9, cc = p - row * 9; const int gr = rk0 + row < 0 ? 0 : rk0 + row;
              __builtin_amdgcn_global_load_lds((const unsigned*)(kb + (size_t)gr * 2048 + (cc > 7 ? 7 : cc) * 16), (LAS unsigned*)(lk + ins * 1024), 16, 0, 0); } }
          const char* vb = (const char*)(VT + (size_t)(h * 64) * M);
#pragma unroll
          for (int j = 0; j < 7; ++j) { const int ins = w + 8 * j; if (ins < 49) { const int p = ins * 64 + lane, row = p / 49, cc = p - row * 49; int col = rk0 + (cc > 47 ? 47 : cc) * 8; col = col < 0 ? 0 : col;
              __builtin_amdgcn_global_load_lds((const unsigned*)(vb + ((size_t)row * M + col) * 2), (LAS unsigned*)(lv + ins * 1024), 16, 0, 0); } } }
        bf16x8 Qf[4];
        { const bf16* qp = QK + (size_t)(rq0 + 32 * w + q) * 1024 + h * 64 + 8 * hh;
#pragma unroll
          for (int s2 = 0; s2 < 4; ++s2) Qf[s2] = *(const bf16x8*)(qp + 16 * s2); }
        asm volatile("s_waitcnt vmcnt(0)" ::: "memory");
        __syncthreads();
        const float slope2 = exp2f(-(float)(h + 1)) * (float)(1 << (2 * g)) * 1.4426950408889634f, sc = 0.125f * 1.4426950408889634f;
        float m_run = -1e30f, l_run = 0.f; f32x16 O0, O1;
#pragma unroll
        for (int r = 0; r < 16; ++r) { O0[r] = 0.f; O1[r] = 0.f; }
#pragma unroll 1
        for (int kt = 0; kt < 5; ++kt) { const int kr0 = 32 * w + 32 * kt; if (i0 + kr0 - 128 < 0) continue;
            bf16x8 Kf[4];
            { const LAS unsigned char* kp = lk + (kr0 + q) * AT_KP + 16 * hh;
#pragma unroll
              for (int s2 = 0; s2 < 4; ++s2) Kf[s2] = *(const LAS bf16x8*)(kp + 32 * s2); }
            bf16x8 Vf[2][2];
#pragma unroll
            for (int dd = 0; dd < 2; ++dd)
#pragma unroll
                for (int s2 = 0; s2 < 2; ++s2) { const LAS unsigned char* vp = lv + (32 * dd + q) * AT_VP + (kr0 + 16 * s2 + 4 * hh) * 2;
                    const u32x2 lo = *(const LAS u32x2*)vp, hi = *(const LAS u32x2*)(vp + 16); u32x4 wv; wv.x = lo.x; wv.y = lo.y; wv.z = hi.x; wv.w = hi.y; Vf[dd][s2] = __builtin_bit_cast(bf16x8, wv); }
            f32x16 S;
#pragma unroll
            for (int r = 0; r < 16; ++r) S[r] = 0.f;
#pragma unroll
            for (int s2 = 0; s2 < 4; ++s2) S = __builtin_amdgcn_mfma_f32_32x32x16_bf16(Kf[s2], Qf[s2], S, 0, 0, 0);
            float mx = -1e30f;
#pragma unroll
            for (int r = 0; r < 16; ++r) { const int krow = (r & 3) + 8 * (r >> 2) + 4 * hh; const int dist = 128 - 32 * kt + q - krow;
                const float sv = (dist >= 0 && dist <= 128) ? S[r] * sc - slope2 * (float)dist : -1e30f; S[r] = sv; mx = fmaxf(mx, sv); }
            mx = fmaxf(mx, __shfl_xor(mx, 32));
            const float m_new = fmaxf(m_run, mx), alpha = exp2f(m_run - m_new); float rs = 0.f;
#pragma unroll
            for (int r = 0; r < 16; ++r) { const float p = exp2f(S[r] - m_new); S[r] = p; rs += p; }
            rs += __shfl_xor(rs, 32);
            l_run = l_run * alpha + rs; m_run = m_new;
#pragma unroll
            for (int r = 0; r < 16; ++r) { O0[r] *= alpha; O1[r] *= alpha; }
            bf16x8 Pf[2];
#pragma unroll
            for (int s2 = 0; s2 < 2; ++s2) { u32x4 wv; wv.x = pk2(S[8 * s2 + 0], S[8 * s2 + 1]); wv.y = pk2(S[8 * s2 + 2], S[8 * s2 + 3]); wv.z = pk2(S[8 * s2 + 4], S[8 * s2 + 5]); wv.w = pk2(S[8 * s2 + 6], S[8 * s2 + 7]); Pf[s2] = __builtin_bit_cast(bf16x8, wv); }
#pragma unroll
            for (int s2 = 0; s2 < 2; ++s2) { O0 = __builtin_amdgcn_mfma_f32_32x32x16_bf16(Vf[0][s2], Pf[s2], O0, 0, 0, 0); O1 = __builtin_amdgcn_mfma_f32_32x32x16_bf16(Vf[1][s2], Pf[s2], O1, 0, 0, 0); }
        }
        const float inv = 1.0f / l_run;
        bf16* op = OGb + ((size_t)g * M + rq0 + 32 * w + q) * 512 + h * 64 + 4 * hh;
#pragma unroll
        for (int rg = 0; rg < 4; ++rg) { u32x2 wv; wv.x = pk2(O0[4 * rg] * inv, O0[4 * rg + 1] * inv); wv.y = pk2(O0[4 * rg + 2] * inv, O0[4 * rg + 3] * inv); *(u32x2*)(op + 8 * rg) = wv;
            u32x2 w1; w1.x = pk2(O1[4 * rg] * inv, O1[4 * rg + 1] * inv); w1.y = pk2(O1[4 * rg + 2] * inv, O1[4 * rg + 3] * inv); *(u32x2*)(op + 32 + 8 * rg) = w1; }
        if (hh == 0) LSE[((size_t)g * M + rq0 + 32 * w + q) * 8 + h] = (m_run + log2f(l_run)) * 0.6931471805599453f;
        __syncthreads();
    }
}
__device__ __forceinline__ void p_merge(Frame& F) {
    const bf16* OGb = WSP(bf16, WS_RA + RA_OG); const float* LSE = WSP(float, WS_LSE); bf16* OM = WSP(bf16, WS_RA + RA_OM);
    for (int t = F.vcu * NWAVES + F.wave; t < M; t += NGW) { const int hd = F.lane >> 3; float ls[3]; size_t ro[3];
#pragma unroll
        for (int g = 0; g < 3; ++g) { const int rho = tok_to_rho(t, g); ro[g] = ((size_t)g * M + rho); ls[g] = LSE[ro[g] * 8 + hd]; }
        const float mx = fmaxf(ls[0], fmaxf(ls[1], ls[2])); float w[3], ws = 0.f;
#pragma unroll
        for (int g = 0; g < 3; ++g) { w[g] = __expf(ls[g] - mx); ws += w[g]; }
        const float inv = 1.0f / ws; float o[8];
#pragma unroll
        for (int j = 0; j < 8; ++j) o[j] = 0.f;
#pragma unroll
        for (int g = 0; g < 3; ++g) { const u32x4 x = *(const u32x4*)(OGb + ro[g] * 512 + 8 * F.lane); const float wg = w[g] * inv;
            o[0] += wg * bf_lo(x.x); o[1] += wg * bf_hi(x.x); o[2] += wg * bf_lo(x.y); o[3] += wg * bf_hi(x.y); o[4] += wg * bf_lo(x.z); o[5] += wg * bf_hi(x.z); o[6] += wg * bf_lo(x.w); o[7] += wg * bf_hi(x.w); }
        u32x4 r; r.x = pk2(o[0], o[1]); r.y = pk2(o[2], o[3]); r.z = pk2(o[4], o[5]); r.w = pk2(o[6], o[7]); *(u32x4*)(OM + (size_t)t * OW + 8 * F.lane) = r; }
}

constexpr int NPHASE = 26;

__global__ void __launch_bounds__(NTHR, 2) yoco_fwd(Args args) {
    extern __shared__ __attribute__((aligned(16))) unsigned char lds[];
    Frame F;
    F.lds = (LAS unsigned char*)lds;
    F.tid = threadIdx.x; F.lane = F.tid & 63; F.wave = __builtin_amdgcn_readfirstlane(F.tid >> 6);
    { const int bx = blockIdx.x; F.vcu = (bx % 8) * (NWG / 8) + bx / 8; }
    F.ws = args.ws;
    volatile LAS unsigned* MISC = (volatile LAS unsigned*)(F.lds + LDS_BYTES - 64);
    if (F.tid < 16) MISC[F.tid] = 0u;
    __syncthreads();
    const int lo = args.ph_lo, hi = args.ph_hi;
    XcdBarrier bar; bar.bar = (unsigned*)(F.ws + WS_CTL) + 4096; bar.x = 0; bar.st = nullptr;
    if (hi - lo > 1) bar = xcd_barrier_post((unsigned*)(F.ws + WS_CTL) + 4096, MISC + 8);
#ifndef PROBE_G2
#define PROBE_G2 0
#endif
#ifndef DUP_MASK
#define DUP_MASK 0u
#endif
#ifndef PH_MASK
#define PH_MASK 0xFFFFFFFFu
#endif
#define IN(k) (((PH_MASK >> (k)) & 1u) && lo <= (k) && (k) < hi)
#define REP(k) for (int rep = 0, nrep = 1 + (int)((args.dup >> (k)) & 1u); rep < nrep; ++rep)
#define SEAM(k) do { if (IN(k) && IN((k) + 1)) xcd_barrier(bar); } while (0)

    const bool cv_first = ((F.vcu >> 5) & 1) == 0;
#define CONV_L0(part) convert_experts(F, args.in[15], args.in[16], args.in[17], args.in[18], args.in[19], args.in[20], 0, part, 3)
#define CONV_L1(part) convert_experts(F, args.in[15] + (size_t)NE * D * DE, args.in[16] + (size_t)NE * D * DE, args.in[17] + (size_t)NE * D * DE, args.in[18] + (size_t)D * DE, args.in[19] + (size_t)D * DE, args.in[20] + (size_t)D * DE, 1, part, 3)
    if (IN(0)) { p0_prologue(F, args); } SEAM(0);
    if (IN(1)) { if (cv_first) { CONV_L0(0); __syncthreads(); } SchedDense8 S{WSP(unsigned char, WS_RA + RA_XB), WSP(unsigned char, WS_WIN), D, D, D, M / 256, 8, F.vcu}; EpiXZ E{WSP(bf16, WS_RA + RA_XR), WSP(bf16, WS_RA + RA_GG)}; gemm_fast8(F.lds, S, E); if (!cv_first) { __syncthreads(); CONV_L0(0); } } SEAM(1);
    if (IN(2)) { p_conv(F, args.in[2], args.in[3]); } SEAM(2);
    if (IN(3)) { if (cv_first) { CONV_L0(1); __syncthreads(); } SchedGate S{WSP(bf16, WS_RA + RA_XC), WSP(bf16, WS_WG), F.vcu}; EpiGate E{WSP(bf16, WS_RA + RA_XC), args.in[5], args.in[7], args.in[8], WSP(bf16, WS_RA + RA_LA), WSP(bf16, WS_RA + RA_U)}; GEMM_PHASE(F.lds, S, E); if (!cv_first) { __syncthreads(); CONV_L0(1); } } SEAM(3);
    if (IN(4)) { p_scan1(F); } SEAM(4);
    if (IN(5)) { p_scan2(F); } SEAM(5);
    if (IN(6)) { p_scan3(F); } SEAM(6);
    if (IN(7)) { if (cv_first) { CONV_L0(2); __syncthreads(); } SchedDense S{WSP(bf16, WS_RA + RA_YB), WSP(bf16, WS_WOUT), D, D, D, M / 256, 4, F.vcu}; EpiResF32 E{args.in[0], WSP(float, WS_V), D}; GEMM_PHASE(F.lds, S, E); if (!cv_first) { __syncthreads(); CONV_L0(2); } } SEAM(7);
    if (IN(8)) { p_ln(F, WSP(float, WS_V), args.in[21] + 0 * D, args.in[22] + 0 * D, WSP(float, WS_HA), WSP(bf16, WS_HAB)); } SEAM(8);
    if (IN(9)) { SchedDense S{WSP(bf16, WS_HAB), WSP(bf16, WS_WR), D, D, D, M / 256, 1, F.vcu}; EpiF32 E{WSP(float, WS_LOGITS), NE}; GEMM_PHASE(F.lds, S, E); } SEAM(9);
    if (IN(10)) { p_route(F, args.in[14]); } SEAM(10);
    if (IN(11)) { p_sort(F); } SEAM(11);
    if (IN(12)) { if (cv_first) { CONV_L1(0); __syncthreads(); } const int nrbt = *WSP(int, WS_META); SchedG1 S{WSP(unsigned char, WS_HQ), WSP(unsigned char, WS_W13), WSP(int, WS_ROWA), WSP(int, WS_BLKE), nrbt, F.vcu, moe_unit_experts(F, WSP(int, WS_BLKE), nrbt, 1), moe_row_table(F, WSP(int, WS_ROWA), nrbt)}; EpiSwiGLU E{WSP(unsigned char, WS_HID), F.lds + LDS_EPI}; gemm_fast8(F.lds, S, E); if (!cv_first) { __syncthreads(); CONV_L1(0); } } SEAM(12);
    if (IN(13)) { if (cv_first) { CONV_L1(1); __syncthreads(); } const int nrbt = *WSP(int, WS_META); SchedG2 S{WSP(unsigned char, WS_HID), WSP(unsigned char, WS_W2), WSP(int, WS_BLKE), nrbt, F.vcu, moe_unit_experts(F, WSP(int, WS_BLKE), nrbt, 2), args.rt256, args.rt256, args.rt256}; EpiScatter E{WSP(bf16, WS_RA), 0, F.lds + LDS_EPI}; gemm_fast8(F.lds, S, E); if (!cv_first) { __syncthreads(); CONV_L1(1); } } SEAM(13);
    if (IN(14)) { p_combine(F, WSP(float, WS_HA), args.in[21] + 1 * D, args.in[22] + 1 * D, WSP(float, WS_HB), WSP(unsigned char, WS_HQ)); } SEAM(14);
    if (IN(15)) { if (cv_first) { CONV_L1(2); __syncthreads(); } EpiQKV E{WSP(bf16, WS_RA + RA_QK), WSP(bf16, WS_RA + RA_VT), F.lds + LDS_EPI}; for (int g = 0; g < 3; ++g) { SchedQK S{WSP(unsigned char, WS_HQ), WSP(unsigned char, WS_WQK), g, D << (2 * g), F.vcu}; gemm_fast8(F.lds, S, E); } for (int g = 0; g < 3; ++g) { SchedVT S{WSP(unsigned char, WS_HQ), WSP(unsigned char, WS_WQK) + (size_t)3072 * D, g, D << (2 * g), F.vcu}; gemm_fast8(F.lds, S, E); } if (!cv_first) { __syncthreads(); CONV_L1(2); } } SEAM(15);
    if (IN(16)) { p_attn(F); } SEAM(16);
    if (IN(17)) { p_merge(F); } SEAM(17);
    if (IN(18)) { SchedDense S{WSP(bf16, WS_RA + RA_OM), WSP(bf16, WS_WO), OW, OW, OW, M / 256, 4, F.vcu}; EpiResF32 E{WSP(float, WS_HB), WSP(float, WS_V), D}; GEMM_PHASE(F.lds, S, E); } SEAM(18);
    if (IN(19)) { p_ln(F, WSP(float, WS_V), args.in[21] + 2 * D, args.in[22] + 2 * D, WSP(float, WS_HA), WSP(bf16, WS_HAB)); } SEAM(19);
    if (IN(20)) { SchedDense S{WSP(bf16, WS_HAB), WSP(bf16, WS_WR) + (size_t)NE * D, D, D, D, M / 256, 1, F.vcu}; EpiF32 E{WSP(float, WS_LOGITS), NE}; GEMM_PHASE(F.lds, S, E); } SEAM(20);
    if (IN(21)) { p_route(F, args.in[14] + NE); } SEAM(21);
    if (IN(22)) { p_sort(F); } SEAM(22);
    if (IN(23)) { const int nrbt = *WSP(int, WS_META); SchedG1 S{WSP(unsigned char, WS_HQ), WSP(unsigned char, WS_W13) + W13_LB, WSP(int, WS_ROWA), WSP(int, WS_BLKE), nrbt, F.vcu, moe_unit_experts(F, WSP(int, WS_BLKE), nrbt, 1), moe_row_table(F, WSP(int, WS_ROWA), nrbt)}; EpiSwiGLU E{WSP(unsigned char, WS_HID), F.lds + LDS_EPI}; gemm_fast8(F.lds, S, E); } SEAM(23);
    if (IN(24)) { const int nrbt = *WSP(int, WS_META); SchedG2 S{WSP(unsigned char, WS_HID), WSP(unsigned char, WS_W2) + W2_LB, WSP(int, WS_BLKE), nrbt, F.vcu, moe_unit_experts(F, WSP(int, WS_BLKE), nrbt, 2), args.rt256, args.rt256, args.rt256}; EpiScatter E{WSP(bf16, WS_RA), 0, F.lds + LDS_EPI}; gemm_fast8(F.lds, S, E); } SEAM(24);
    if (IN(25)) { p_combine(F, WSP(float, WS_HA), args.in[21] + 3 * D, args.in[22] + 3 * D, args.out, nullptr); }
#undef IN
#undef SEAM
}

extern "C" void kernel_launch(void* const* d_in, const int* in_sizes, int n_in, void* d_out, int out_size, void* d_ws, size_t ws_size, hipStream_t stream) {
    static int ok = 0;
    if (ok == 0) {
        if (n_in != 23 || in_sizes[0] != M * D || out_size != M * D || ws_size < WS_END) { fprintf(stderr, "kernel_launch: unexpected shapes (n_in %d, in0 %d, out %d, ws %zu < %zu)\n", n_in, n_in > 0 ? in_sizes[0] : -1, out_size, ws_size, (size_t)WS_END); ok = -1; return; }
        if (hipFuncSetAttribute((const void*)yoco_fwd, hipFuncAttributeMaxDynamicSharedMemorySize, LDS_BYTES) != hipSuccess) { fprintf(stderr, "kernel_launch: hipFuncSetAttribute failed\n"); ok = -1; return; }
        int per_cu = 0;
        if (hipOccupancyMaxActiveBlocksPerMultiprocessor(&per_cu, (const void*)yoco_fwd, NTHR, LDS_BYTES) != hipSuccess || per_cu < 1) fprintf(stderr, "kernel_launch: occupancy query says %d\n", per_cu);
        (void)hipGetLastError();
        ok = 1;
    }
    if (ok < 0) return;
    if (hipMemsetAsync((char*)d_ws + WS_CTL, 0, CTL_ZERO_BYTES, stream) != hipSuccess) return;
    Args a{};
    for (int i = 0; i < 23; ++i) a.in[i] = (const float*)d_in[i];
    a.out = (float*)d_out; a.ws = (unsigned char*)d_ws; a.dup = 0u; a.rt256 = 256;
#if MK_ONE_LAUNCH
    a.ph_lo = 0; a.ph_hi = NPHASE;
    hipLaunchKernelGGL(yoco_fwd, dim3(NWG), dim3(NTHR), LDS_BYTES, stream, a);
#else
    for (int p = 0; p < NPHASE; ++p) { a.ph_lo = p; a.ph_hi = p + 1; hipLaunchKernelGGL(yoco_fwd, dim3(NWG), dim3(NTHR), LDS_BYTES, stream, a); }
#endif
}
```

```cpp
#include <hip/hip_runtime.h>
#include <cstdio>
#include <cstdint>

#ifndef MK_ONE_LAUNCH
#define MK_ONE_LAUNCH 1
#endif

constexpr int D = 1024, BATCH = 2, SEQ = 16384, M = BATCH * SEQ;
constexpr int NE = 256, TOPK = 8, DE = 256;
constexpr int HEADS = 8, HD = 64, QW = 1536, OW = 512;
constexpr float LN_EPS = 1e-5f, ALPHA = 1.41421356237f;
constexpr int RBMAX = 1024 + 256 + 128;
constexpr int NWG = 256, NTHR = 512, NWAVES = 8;
constexpr int NGW = NWG * NWAVES, NGT = NWG * NTHR;

constexpr size_t MiB = 1u << 20;
constexpr size_t WS_CTL = 0, CTL_ZERO_BYTES = 1 * MiB;
constexpr size_t WS_HIST = 1 * MiB, WS_BLKE = 1 * MiB + 512 * 1024, WS_META = 1 * MiB + 768 * 1024;
constexpr size_t WS_ROWA = 2 * MiB, WS_TOPI = 4 * MiB, WS_GATE = 5 * MiB, WS_CHP = 6 * MiB, WS_CHH = 8 * MiB, WS_CIN = 10 * MiB, WS_LSE = 12 * MiB;
constexpr size_t WS_WIN = 16 * MiB, WS_WG = 20 * MiB, WS_WOUT = 21 * MiB, WS_WQK = 23 * MiB, WS_WV = 29 * MiB, WS_WO = 32 * MiB, WS_WR = 33 * MiB;
constexpr size_t WS_LOGITS = 34 * MiB;
constexpr size_t WS_W13 = 66 * MiB, WS_W2 = 323 * MiB;
constexpr size_t W13_LB = (size_t)257 * 512 * 1024, W2_LB = (size_t)257 * 1024 * 256;
static_assert(WS_W13 + 2 * W13_LB <= WS_W2 && WS_W2 + 2 * W2_LB <= 452 * MiB, "both layers' fp8 expert weights fit");
constexpr size_t WS_V = 452 * MiB, WS_HA = 580 * MiB, WS_HAB = 708 * MiB, WS_HB = 772 * MiB, WS_HBB = 900 * MiB, WS_HID = 964 * MiB;
constexpr size_t WS_RA = 1140 * MiB;
constexpr size_t RA_XB = 0, RA_XR = 64 * MiB, RA_GG = 128 * MiB, RA_XC = 192 * MiB, RA_LA = 256 * MiB, RA_U = 384 * MiB, RA_YB = 512 * MiB;
constexpr size_t RA_QK = 0, RA_VT = 192 * MiB, RA_OG = 288 * MiB, RA_OM = 384 * MiB;
constexpr size_t WS_POS = 15 * MiB;
constexpr size_t WS_HQ = 1844 * MiB;
constexpr size_t WS_END = 1876 * MiB;

constexpr int LDS_BYTES = 163840;
constexpr int LDS_EPI = 131072, LDS_TAB = 147456;

#define GAS __attribute__((address_space(1)))
#define LAS __attribute__((address_space(3)))
typedef unsigned short bf16;
typedef unsigned u32x4 __attribute__((ext_vector_type(4)));
typedef unsigned u32x2 __attribute__((ext_vector_type(2)));
typedef float f32x4 __attribute__((ext_vector_type(4)));
typedef float f32x2 __attribute__((ext_vector_type(2)));
typedef float f32x16 __attribute__((ext_vector_type(16)));
typedef short bf16x8 __attribute__((ext_vector_type(8)));
typedef int i32x8 __attribute__((ext_vector_type(8)));
typedef GAS unsigned gu32;
#define RLX_AGENT __ATOMIC_RELAXED, __HIP_MEMORY_SCOPE_AGENT
#define LDS_WAIT() asm volatile("s_waitcnt lgkmcnt(0)" ::: "memory")
#define VM_WAIT() asm volatile("s_waitcnt vmcnt(0)" ::: "memory")

__device__ __forceinline__ unsigned pk2(float lo, float hi) { unsigned r; asm("v_cvt_pk_bf16_f32 %0, %1, %2" : "=v"(r) : "v"(lo), "v"(hi)); return r; }
__device__ __forceinline__ float bf_lo(unsigned w) { return __uint_as_float(w << 16); }
__device__ __forceinline__ float bf_hi(unsigned w) { return __uint_as_float(w & 0xffff0000u); }
__device__ __forceinline__ float wave_sum(float v) {
#pragma unroll
    for (int o = 1; o < 64; o <<= 1) v += __shfl_xor(v, o);
    return v;
}
__device__ __forceinline__ float gelu_tanh(float x) {
    const float u = 0.7978845608028654f * (x + 0.044715f * x * x * x);
    const float e = __expf(2.0f * u);
    const float t = 1.0f - 2.0f / (e + 1.0f);
    return 0.5f * x * (1.0f + t);
}
__device__ __forceinline__ float sigmoidf_(float x) { return 1.0f / (1.0f + __expf(-x)); }

#define XB_TMO      128
#define XB_XCNT(j)  (256  + 64 * (j))
#define XB_XSUB(j)  (1280 + 64 * (j))
#define XB_XGEN(j)  (2304 + 64 * (j))
#define XB_TOP      3328
#define XB_TOPGEN   3392
#define XCD_BAR_WORDS 3456
#define XB_SPIN_CAP (1u << 18)
__device__ __forceinline__ unsigned xb_ld(unsigned* p)              { return __hip_atomic_load(p, __ATOMIC_RELAXED, __HIP_MEMORY_SCOPE_AGENT); }
__device__ __forceinline__ unsigned xb_add(unsigned* p, unsigned v) { return __hip_atomic_fetch_add(p, v, __ATOMIC_RELAXED, __HIP_MEMORY_SCOPE_AGENT); }
__device__ __forceinline__ unsigned xb_xcc_id() { return (unsigned)__builtin_amdgcn_s_getreg((3 << 11) | 20) & 0xFu; }
#define XB_SPIN(cond, bar) do { unsigned _sp = 0; while (cond) { __builtin_amdgcn_s_sleep(1); \
    if ((++_sp & 255u) == 0u) { if (xb_ld(&(bar)[XB_TMO])) break; if (_sp > XB_SPIN_CAP) { atomicAdd(&(bar)[XB_TMO], 1u); break; } } } } while (0)
struct XcdBarrier { unsigned* bar; unsigned x; volatile LAS unsigned* st; };
__device__ __forceinline__ XcdBarrier xcd_barrier_post(unsigned* bar, volatile LAS unsigned* st) {
    XcdBarrier b; b.bar = bar; b.x = xb_xcc_id(); b.st = st;
    if (threadIdx.x == 0) (void)xb_add(&bar[XB_XCNT(b.x)], 1u);
    return b;
}
__device__ __forceinline__ void xcd_barrier_complete(unsigned* bar, unsigned x, unsigned& nloc, unsigned& nx) {
    const unsigned G = gridDim.x * gridDim.y * gridDim.z;
    unsigned sum, cnt, mine, sp = 0u;
    for (;;) {
        sum = 0u; cnt = 0u; mine = 0u;
#pragma unroll
        for (unsigned j = 0; j < 16; ++j) { const unsigned c = xb_ld(&bar[XB_XCNT(j)]); sum += c; cnt += (c > 0u) ? 1u : 0u; mine = (j == x) ? c : mine; }
        if (sum == G) break;
        __builtin_amdgcn_s_sleep(1);
        if ((++sp & 255u) == 0u) { if (xb_ld(&bar[XB_TMO])) break; if (sp > XB_SPIN_CAP) { atomicAdd(&bar[XB_TMO], 1u); break; } }
    }
    nloc = mine > 0u ? mine : 1u; nx = cnt > 0u ? cnt : 1u;
}
__device__ __forceinline__ void xcd_barrier(const XcdBarrier& b) {
    asm volatile("s_waitcnt vmcnt(0)" ::: "memory");
    __syncthreads();
    if (threadIdx.x == 0) {
        unsigned* bar = b.bar;
        __builtin_amdgcn_s_waitcnt(0);
        unsigned nloc = b.st[0], nx = b.st[1];
        if (nloc == 0u) { xcd_barrier_complete(bar, b.x, nloc, nx); b.st[0] = nloc; b.st[1] = nx; }
        const unsigned old = xb_add(&bar[XB_XSUB(b.x)], 1u);
        const unsigned gen = old / nloc;
        if (old + 1u == (gen + 1u) * nloc) {
            __builtin_amdgcn_fence(__ATOMIC_RELEASE, "agent");
            asm volatile("s_waitcnt vmcnt(0)" ::: "memory");
            const unsigned og = xb_add(&bar[XB_TOP], 1u);
            const unsigned tg = og / nx;
            if (og + 1u == (tg + 1u) * nx) xb_add(&bar[XB_TOPGEN], 1u);
            else XB_SPIN(xb_ld(&bar[XB_TOPGEN]) == tg, bar);
            __builtin_amdgcn_fence(__ATOMIC_ACQUIRE, "agent");
            xb_add(&bar[XB_XGEN(b.x)], 1u);
            asm volatile("s_waitcnt vmcnt(0)" ::: "memory");
        } else {
            XB_SPIN(xb_ld(&bar[XB_XGEN(b.x)]) == gen, bar);
            __builtin_amdgcn_fence(__ATOMIC_ACQUIRE, "agent");
            asm volatile("s_waitcnt vmcnt(0)" ::: "memory");
        }
    }
    __syncthreads();
}

struct Args { const float* in[23]; float* out; unsigned char* ws; int ph_lo, ph_hi; unsigned dup; int rt256; };
static_assert(sizeof(Args) == 23 * 8 + 8 + 8 + 16, "Args has no padding");
struct Frame {
    LAS unsigned char* lds;
    int tid, lane, wave, vcu;
    unsigned char* ws;
};
#define WSP(T, off) ((T*)(F.ws + (off)))

template <class S, class E>
__device__ __forceinline__ void gemm_simple(LAS unsigned char* lds, const S& sch, const E& epi) {
    const int tid = threadIdx.x, wid = tid >> 6, lane = tid & 63, wr = wid >> 2, wc = wid & 3, fr = lane & 15, fq = lane >> 4;
    constexpr int PITCH = 144;
    LAS unsigned char* As = lds; LAS unsigned char* Bs = lds + 256 * PITCH;
    typename S::U u;
    for (int i = 0; sch.next(i, u); ++i) {
        f32x4 acc[2][2][4][2];
#pragma unroll
        for (int a = 0; a < 2; ++a)
#pragma unroll
            for (int b = 0; b < 2; ++b)
#pragma unroll
                for (int m = 0; m < 4; ++m)
#pragma unroll
                    for (int n = 0; n < 2; ++n) acc[a][b][m][n] = (f32x4){0.f, 0.f, 0.f, 0.f};
        const int nt = sch.K(u) / 64;
        const char* pa[4]; const char* pb[4];
#pragma unroll
        for (int j = 0; j < 4; ++j) { const int row = (tid >> 3) + 64 * j; const int rb = S::PERM ? ((row & ~31) + 8 * ((row & 15) >> 2) + 4 * ((row >> 4) & 1) + (row & 3)) : row; pa[j] = sch.rowA(u, row) + (tid & 7) * 16; pb[j] = sch.rowB(u, rb) + (tid & 7) * 16; }
        for (int kt = 0; kt < nt; ++kt) {
            u32x4 va[4], vb[4];
#pragma unroll
            for (int j = 0; j < 4; ++j) { va[j] = *(const u32x4*)(pa[j] + kt * 128); vb[j] = *(const u32x4*)(pb[j] + kt * 128); }
            __syncthreads();
#pragma unroll
            for (int j = 0; j < 4; ++j) { const int row = (tid >> 3) + 64 * j;
                *(LAS u32x4*)(As + row * PITCH + (tid & 7) * 16) = va[j]; *(LAS u32x4*)(Bs + row * PITCH + (tid & 7) * 16) = vb[j]; }
            __syncthreads();
#pragma unroll
            for (int kk = 0; kk < 2; ++kk) {
                bf16x8 Bf[2][2];
#pragma unroll
                for (int b = 0; b < 2; ++b)
#pragma unroll
                    for (int n = 0; n < 2; ++n) Bf[b][n] = *(const LAS bf16x8*)(Bs + (b * 128 + wc * 32 + n * 16 + fr) * PITCH + kk * 64 + fq * 16);
#pragma unroll
                for (int a = 0; a < 2; ++a) {
                    bf16x8 Af[4];
#pragma unroll
                    for (int m = 0; m < 4; ++m) Af[m] = *(const LAS bf16x8*)(As + (a * 128 + wr * 64 + m * 16 + fr) * PITCH + kk * 64 + fq * 16);
#pragma unroll
                    for (int b = 0; b < 2; ++b)
#pragma unroll
                        for (int m = 0; m < 4; ++m)
#pragma unroll
                            for (int n = 0; n < 2; ++n) acc[a][b][m][n] = __builtin_amdgcn_mfma_f32_16x16x32_bf16(Bf[b][n], Af[m], acc[a][b][m][n], 0, 0, 0);
                }
            }
        }
        epi(acc, u, wr, wc, fr, fq);
    }
    __syncthreads();
}

namespace pg8 {
constexpr int HTB = 128 * 64 * 2;
__device__ __forceinline__ int lds_byte(int r, int c) { const int st = (r >> 4) * 2 + (c >> 5), rr = r & 15, cc = c & 31, ob = rr * 64 + cc * 2; return st * 1024 + (ob ^ (((ob >> 9) & 1) << 5)); }
__device__ __forceinline__ int perm32(int rho) { const int n = rho >> 4, i = rho & 15; return 8 * (i >> 2) + 4 * n + (i & 3); }
__device__ __forceinline__ int prow(int r) { return (r & ~31) + perm32(r & 31); }
__device__ __forceinline__ void stage_rc(int b, int& R, int& C) { const int st = b / 1024, sb = b % 1024, swz = sb ^ (((sb >> 9) & 1) << 5); R = (st >> 1) * 16 + swz / 64; C = (st & 1) * 32 + (swz % 64) / 2; }
}
template <class S, class E>
__device__ __forceinline__ void gemm_fast(LAS unsigned char* lds, const S& sch, const E& epi) {
    using namespace pg8;
    const int tid = threadIdx.x, wid = __builtin_amdgcn_readfirstlane(tid >> 6), lane = tid & 63, wr = wid >> 2, wc = wid & 3, fr = lane & 15, fq = lane >> 4;
    const int nt = sch.Kk / 64;
    int R0, C0; stage_rc(tid * 16, R0, C0);
    unsigned voffA[2], voffB[2]; unsigned cofA[4], nofA[4], cofB[4], nofB[4];
    size_t hstepA = 0, hstepB = 0;
    if constexpr (!S::GA) { voffA[0] = (unsigned)(R0 * sch.lda + C0) * 2u; voffA[1] = (unsigned)((R0 + 64) * sch.lda + C0) * 2u; hstepA = (size_t)128 * sch.lda * 2; }
    const int RB0 = S::PERM ? prow(R0) : R0;
    if constexpr (!S::GB) { voffB[0] = (unsigned)(RB0 * sch.ldb + C0) * 2u; voffB[1] = (unsigned)((RB0 + 64) * sch.ldb + C0) * 2u; hstepB = (size_t)128 * sch.ldb * 2; }
    const size_t kstep = 128;
    const unsigned ldsw = (unsigned)wid * 1024u;
    const int aoff = lds_byte(wr * 64 + fr, fq * 8), boff = lds_byte(wc * 32 + fr, fq * 8);
#define G_SA(b, h) (((b) * 2 + (h)) * HTB)
#define G_SB(b, h) ((4 + (b) * 2 + (h)) * HTB)
#define G_GLDS(src, dst) __builtin_amdgcn_global_load_lds((const unsigned*)(src), (LAS unsigned*)(dst), 16, 0, 0)
#define G_STAGE_A(bufoff, gp, h, nx) do { if constexpr (S::GA) { _Pragma("unroll") for (int _i = 0; _i < 2; ++_i) { const unsigned _o = (nx) ? nofA[2 * (h) + _i] : cofA[2 * (h) + _i]; G_GLDS((gp) + _o, lds + (bufoff) + ldsw + _i * 8192); } } \
        else { _Pragma("unroll") for (int _i = 0; _i < 2; ++_i) G_GLDS((gp) + (size_t)(h) * hstepA + voffA[_i], lds + (bufoff) + ldsw + _i * 8192); } } while (0)
#define G_STAGE_B(bufoff, gp, h, nx) do { if constexpr (S::GB) { _Pragma("unroll") for (int _i = 0; _i < 2; ++_i) { const unsigned _o = (nx) ? nofB[2 * (h) + _i] : cofB[2 * (h) + _i]; G_GLDS((gp) + _o, lds + (bufoff) + ldsw + _i * 8192); } } \
        else { _Pragma("unroll") for (int _i = 0; _i < 2; ++_i) G_GLDS((gp) + (size_t)(h) * hstepB + voffB[_i], lds + (bufoff) + ldsw + _i * 8192); } } while (0)
#define G_LDA(dst, b, h) do { _Pragma("unroll") for (int m = 0; m < 4; ++m) _Pragma("unroll") for (int k = 0; k < 2; ++k) dst[m][k] = *(const LAS bf16x8*)(lds + G_SA(b, h) + aoff + m * 2048 + k * 1024); } while (0)
#define G_LDB(dst, b, h) do { _Pragma("unroll") for (int n = 0; n < 2; ++n) _Pragma("unroll") for (int k = 0; k < 2; ++k) dst[n][k] = *(const LAS bf16x8*)(lds + G_SB(b, h) + boff + n * 2048 + k * 1024); } while (0)
#define G_MMA(ai, bj, At, Bt) do { __builtin_amdgcn_s_setprio(1); _Pragma("unroll") for (int m = 0; m < 4; ++m) _Pragma("unroll") for (int n = 0; n < 2; ++n) _Pragma("unroll") for (int k = 0; k < 2; ++k) \
        acc[ai][bj][m][n] = __builtin_amdgcn_mfma_f32_16x16x32_bf16(Bt[n][k], At[m][k], acc[ai][bj][m][n], 0, 0, 0); __builtin_amdgcn_s_setprio(0); } while (0)
#define G_WAIT_V(n) asm volatile("s_waitcnt vmcnt(" #n ")" ::: "memory")
#define G_WAIT_L(n) asm volatile("s_waitcnt lgkmcnt(" #n ")" ::: "memory")
#define G_BAR __builtin_amdgcn_s_barrier()
#define G_SCHED __builtin_amdgcn_sched_barrier(0)
    typename S::U cur, nxt; int ui = 0;
    if (!sch.next(0, cur)) return;
    f32x4 acc[2][2][4][2];
#pragma unroll
    for (int a = 0; a < 2; ++a)
#pragma unroll
        for (int b = 0; b < 2; ++b)
#pragma unroll
            for (int m = 0; m < 4; ++m)
#pragma unroll
                for (int n = 0; n < 2; ++n) acc[a][b][m][n] = (f32x4){0.f, 0.f, 0.f, 0.f};
    bf16x8 At[4][2], B0[2][2], B1[2][2];
    const char* cA = sch.baseA(cur); const char* cB = sch.baseB(cur);
    if constexpr (S::GA) {
#pragma unroll
        for (int j = 0; j < 4; ++j) { cofA[j] = sch.goffA(cur, (j >> 1) * 128 + R0 + (j & 1) * 64, C0); nofA[j] = cofA[j]; } }
    if constexpr (S::GB) {
#pragma unroll
        for (int j = 0; j < 4; ++j) { cofB[j] = sch.goffB(cur, (j >> 1) * 128 + RB0 + (j & 1) * 64, C0); nofB[j] = cofB[j]; } }
    G_STAGE_B(G_SB(0, 0), cB, 0, false); G_STAGE_B(G_SB(0, 1), cB, 1, false); G_STAGE_A(G_SA(0, 0), cA, 0, false); G_STAGE_A(G_SA(0, 1), cA, 1, false);
    if (wr == 1) G_BAR;
    G_WAIT_V(2); G_BAR;
    G_STAGE_B(G_SB(1, 0), cB + kstep, 0, false); G_STAGE_A(G_SA(1, 0), cA + kstep, 0, false); G_STAGE_B(G_SB(1, 1), cB + kstep, 1, false);
    G_WAIT_V(6); G_BAR;
    for (;;) {
        const bool has_next = sch.next(ui + 1, nxt);
        const char* nA = has_next ? sch.baseA(nxt) : cA; const char* nB = has_next ? sch.baseB(nxt) : cB;
        if constexpr (S::GA) { if (has_next) {
#pragma unroll
            for (int j = 0; j < 4; ++j) nofA[j] = sch.goffA(nxt, (j >> 1) * 128 + R0 + (j & 1) * 64, C0); } }
        if constexpr (S::GB) { if (has_next) {
#pragma unroll
            for (int j = 0; j < 4; ++j) nofB[j] = sch.goffB(nxt, (j >> 1) * 128 + RB0 + (j & 1) * 64, C0); } }
#pragma unroll 1
        for (int t = 0; t < nt; t += 2) {
            const bool last = (t == nt - 2);
            const char* a1 = cA + (size_t)(t + 1) * kstep;
            const char* a2 = last ? nA : cA + (size_t)(t + 2) * kstep; const char* b2 = last ? nB : cB + (size_t)(t + 2) * kstep;
            const char* a3 = a2 + kstep; const char* b3 = b2 + kstep;
            asm volatile("" : "+s"(a1), "+s"(a2), "+s"(a3), "+s"(b2), "+s"(b3));
            const bool post = (t == 0 && ui > 0);
#define G_WAIT_POST() do { if (post) { if constexpr (E::NVM == 8) G_WAIT_V(16); else if constexpr (E::NVM == 16) G_WAIT_V(24); else if constexpr (E::NVM == 32) G_WAIT_V(40); else G_WAIT_V(8); } else G_WAIT_V(8); } while (0)
            G_LDB(B0, 0, 0); G_LDB(B1, 0, 1); G_SCHED; G_LDA(At, 0, 0); if (!post) G_STAGE_A(G_SA(1, 1), a1, 1, false);
            G_WAIT_POST(); G_WAIT_L(0); G_BAR; G_MMA(0, 0, At, B0); G_MMA(0, 1, At, B1); G_BAR; G_SCHED;
            G_LDA(At, 0, 1); G_STAGE_B(G_SB(0, 0), b2, 0, last); G_STAGE_B(G_SB(0, 1), b2, 1, last); G_STAGE_A(G_SA(0, 0), a2, 0, last);
            G_WAIT_POST(); G_WAIT_L(0); G_BAR; G_MMA(1, 0, At, B0); G_MMA(1, 1, At, B1); G_BAR; G_SCHED;
            G_LDB(B0, 1, 0); G_LDB(B1, 1, 1); G_SCHED; G_LDA(At, 1, 0); G_STAGE_A(G_SA(0, 1), a2, 1, last);
            G_WAIT_POST(); G_WAIT_L(0); G_BAR; G_MMA(0, 0, At, B0); G_MMA(0, 1, At, B1); G_BAR; G_SCHED;
            G_LDA(At, 1, 1); G_STAGE_B(G_SB(1, 0), b3, 0, last); G_STAGE_B(G_SB(1, 1), b3, 1, last); G_STAGE_A(G_SA(1, 0), a3, 0, last);
            G_WAIT_V(8); G_WAIT_L(0); G_BAR; G_MMA(1, 0, At, B0); G_MMA(1, 1, At, B1); G_BAR; G_SCHED;
#undef G_WAIT_POST
        }
        if (wr == 0) G_BAR;
        if (has_next) { const char* n1 = nA + kstep; asm volatile("" : "+s"(n1)); G_STAGE_A(G_SA(1, 1), n1, 1, true); }
        { int tz = threadIdx.x; asm volatile("" : "+v"(tz));
          const int ewid = tz >> 6, el = tz & 63; epi(acc, cur, ewid >> 2, ewid & 3, el & 15, el >> 4); }
        if (!has_next) break;
#pragma unroll
        for (int a = 0; a < 2; ++a)
#pragma unroll
            for (int b = 0; b < 2; ++b)
#pragma unroll
                for (int m = 0; m < 4; ++m)
#pragma unroll
                    for (int n = 0; n < 2; ++n) acc[a][b][m][n] = (f32x4){0.f, 0.f, 0.f, 0.f};
        cur = nxt; cA = nA; cB = nB; ++ui;
        if constexpr (S::GA) {
#pragma unroll
            for (int j = 0; j < 4; ++j) cofA[j] = nofA[j]; }
        if constexpr (S::GB) {
#pragma unroll
            for (int j = 0; j < 4; ++j) cofB[j] = nofB[j]; }
        if (wr == 1) G_BAR;
    }
    G_WAIT_V(0);
    G_BAR;
#undef G_SA
#undef G_SB
#undef G_GLDS
#undef G_STAGE_A
#undef G_STAGE_B
#undef G_LDA
#undef G_LDB
#undef G_MMA
#undef G_WAIT_V
#undef G_WAIT_L
#undef G_BAR
#undef G_SCHED
}
template <class S, class E>
__device__ __forceinline__ void gemm_fast8(LAS unsigned char* lds, const S& sch, const E& epi) {
    using namespace pg8;
    const int tid = threadIdx.x, wid = __builtin_amdgcn_readfirstlane(tid >> 6), lane = tid & 63, wr = wid >> 2, wc = wid & 3, fr = lane & 15, fq = lane >> 4;
    const int nt = sch.Kk / 128;
    const int R0 = tid >> 3, C0 = ((tid & 7) ^ (((R0 >> 1) & 1) | (((R0 >> 2) & 1) << 2))) * 8;
    unsigned voffA[2], voffB[2]; unsigned cofA[4], nofA[4], cofB[4], nofB[4];
    size_t hstepA = 0, hstepB = 0;
    if constexpr (!S::GA) { voffA[0] = (unsigned)(R0 * sch.lda + C0 * 2); voffA[1] = (unsigned)((R0 + 64) * sch.lda + C0 * 2); hstepA = (size_t)128 * sch.lda; }
    const int RB0 = S::PERM ? prow(R0) : R0;
    if constexpr (!S::GB) { voffB[0] = (unsigned)(RB0 * sch.ldb + C0 * 2); voffB[1] = (unsigned)((RB0 + 64) * sch.ldb + C0 * 2); hstepB = (size_t)128 * sch.ldb; }
    const size_t kstep = 128;
    const unsigned ldsw = (unsigned)wid * 1024u;
    const int fsw = ((fr >> 1) & 1) | (((fr >> 2) & 1) << 2);
    const int aoff = ((wr * 64 + fr) * 8 + ((2 * fq) ^ fsw)) * 16, aoff1 = ((wr * 64 + fr) * 8 + ((2 * fq + 1) ^ fsw)) * 16, boff = ((wc * 32 + fr) * 8 + ((2 * fq) ^ fsw)) * 16, boff1 = ((wc * 32 + fr) * 8 + ((2 * fq + 1) ^ fsw)) * 16;
#define G_SA(b, h) (((b) * 2 + (h)) * HTB)
#define G_SB(b, h) ((4 + (b) * 2 + (h)) * HTB)
#define G_GLDS(src, dst) __builtin_amdgcn_global_load_lds((const unsigned*)(src), (LAS unsigned*)(dst), 16, 0, 0)
#define G_STAGE_A(bufoff, gp, h, nx) do { if constexpr (S::GA) { _Pragma("unroll") for (int _i = 0; _i < 2; ++_i) { const unsigned _o = (nx) ? nofA[2 * (h) + _i] : cofA[2 * (h) + _i]; G_GLDS((gp) + _o, lds + (bufoff) + ldsw + _i * 8192); } } \
        else { _Pragma("unroll") for (int _i = 0; _i < 2; ++_i) G_GLDS((gp) + (size_t)(h) * hstepA + voffA[_i], lds + (bufoff) + ldsw + _i * 8192); } } while (0)
#define G_STAGE_B(bufoff, gp, h, nx) do { if constexpr (S::GB) { _Pragma("unroll") for (int _i = 0; _i < 2; ++_i) { const unsigned _o = (nx) ? nofB[2 * (h) + _i] : cofB[2 * (h) + _i]; G_GLDS((gp) + _o, lds + (bufoff) + ldsw + _i * 8192); } } \
        else { _Pragma("unroll") for (int _i = 0; _i < 2; ++_i) G_GLDS((gp) + (size_t)(h) * hstepB + voffB[_i], lds + (bufoff) + ldsw + _i * 8192); } } while (0)
#define G_LDA(dst, b, h) do { _Pragma("unroll") for (int m = 0; m < 4; ++m) { const u32x4 _lo = *(const LAS u32x4*)(lds + G_SA(b, h) + aoff + m * 2048), _hi = *(const LAS u32x4*)(lds + G_SA(b, h) + aoff1 + m * 2048); dst[m] = (i32x8){(int)_lo.x, (int)_lo.y, (int)_lo.z, (int)_lo.w, (int)_hi.x, (int)_hi.y, (int)_hi.z, (int)_hi.w}; } } while (0)
#define G_LDB(dst, b, h) do { _Pragma("unroll") for (int n = 0; n < 2; ++n) { const u32x4 _lo = *(const LAS u32x4*)(lds + G_SB(b, h) + boff + n * 2048), _hi = *(const LAS u32x4*)(lds + G_SB(b, h) + boff1 + n * 2048); dst[n] = (i32x8){(int)_lo.x, (int)_lo.y, (int)_lo.z, (int)_lo.w, (int)_hi.x, (int)_hi.y, (int)_hi.z, (int)_hi.w}; } } while (0)
#define G_MMA(ai, bj, At, Bt) do { __builtin_amdgcn_s_setprio(1); _Pragma("unroll") for (int m = 0; m < 4; ++m) _Pragma("unroll") for (int n = 0; n < 2; ++n) \
        acc[ai][bj][m][n] = __builtin_amdgcn_mfma_scale_f32_16x16x128_f8f6f4(Bt[n], At[m], acc[ai][bj][m][n], 0, 0, 0, 0, 0, 0); __builtin_amdgcn_s_setprio(0); } while (0)
#define G_WAIT_V(n) asm volatile("s_waitcnt vmcnt(" #n ")" ::: "memory")
#define G_WAIT_L(n) asm volatile("s_waitcnt lgkmcnt(" #n ")" ::: "memory")
#define G_BAR __builtin_amdgcn_s_barrier()
#define G_SCHED __builtin_amdgcn_sched_barrier(0)
    typename S::U cur, nxt; int ui = 0;
    if (!sch.next(0, cur)) return;
    f32x4 acc[2][2][4][2];
#pragma unroll
    for (int a = 0; a < 2; ++a)
#pragma unroll
        for (int b = 0; b < 2; ++b)
#pragma unroll
            for (int m = 0; m < 4; ++m)
#pragma unroll
                for (int n = 0; n < 2; ++n) acc[a][b][m][n] = (f32x4){0.f, 0.f, 0.f, 0.f};
    i32x8 At[4], B0[2], B1[2];
    const char* cA = sch.baseA(cur); const char* cB = sch.baseB(cur);
    if constexpr (S::GA) {
#pragma unroll
        for (int j = 0; j < 4; ++j) { cofA[j] = sch.goffA(cur, (j >> 1) * 128 + R0 + (j & 1) * 64, C0); nofA[j] = cofA[j]; } }
    if constexpr (S::GB) {
#pragma unroll
        for (int j = 0; j < 4; ++j) { cofB[j] = sch.goffB(cur, (j >> 1) * 128 + RB0 + (j & 1) * 64, C0); nofB[j] = cofB[j]; } }
    G_STAGE_B(G_SB(0, 0), cB, 0, false); G_STAGE_B(G_SB(0, 1), cB, 1, false); G_STAGE_A(G_SA(0, 0), cA, 0, false); G_STAGE_A(G_SA(0, 1), cA, 1, false);
    if (wr == 1) G_BAR;
    G_WAIT_V(2); G_BAR;
    G_STAGE_B(G_SB(1, 0), cB + kstep, 0, false); G_STAGE_A(G_SA(1, 0), cA + kstep, 0, false); G_STAGE_B(G_SB(1, 1), cB + kstep, 1, false);
    G_WAIT_V(6); G_BAR;
    for (;;) {
        const bool has_next = sch.next(ui + 1, nxt);
        const char* nA = has_next ? sch.baseA(nxt) : cA; const char* nB = has_next ? sch.baseB(nxt) : cB;
        if constexpr (S::GA) { if (has_next) {
#pragma unroll
            for (int j = 0; j < 4; ++j) nofA[j] = sch.goffA(nxt, (j >> 1) * 128 + R0 + (j & 1) * 64, C0); } }
        if constexpr (S::GB) { if (has_next) {
#pragma unroll
            for (int j = 0; j < 4; ++j) nofB[j] = sch.goffB(nxt, (j >> 1) * 128 + RB0 + (j & 1) * 64, C0); } }
#pragma unroll 1
        for (int t = 0; t < nt; t += 2) {
            const bool last = (t == nt - 2);
            const char* a1 = cA + (size_t)(t + 1) * kstep;
            const char* a2 = last ? nA : cA + (size_t)(t + 2) * kstep; const char* b2 = last ? nB : cB + (size_t)(t + 2) * kstep;
            const char* a3 = a2 + kstep; const char* b3 = b2 + kstep;
            asm volatile("" : "+s"(a1), "+s"(a2), "+s"(a3), "+s"(b2), "+s"(b3));
            const bool post = (t == 0 && ui > 0);
#define G_WAIT_POST() do { if (post) { if constexpr (E::NVM == 8) G_WAIT_V(16); else if constexpr (E::NVM == 16) G_WAIT_V(24); else if constexpr (E::NVM == 32) G_WAIT_V(40); else G_WAIT_V(8); } else G_WAIT_V(8); } while (0)
            G_LDB(B0, 0, 0); G_LDB(B1, 0, 1); G_SCHED; G_LDA(At, 0, 0); if (!post) G_STAGE_A(G_SA(1, 1), a1, 1, false);
            G_WAIT_POST(); G_WAIT_L(0); G_BAR; G_MMA(0, 0, At, B0); G_MMA(0, 1, At, B1); G_BAR; G_SCHED;
            G_LDA(At, 0, 1); G_STAGE_B(G_SB(0, 0), b2, 0, last); G_STAGE_B(G_SB(0, 1), b2, 1, last); G_STAGE_A(G_SA(0, 0), a2, 0, last);
            G_WAIT_POST(); G_WAIT_L(0); G_BAR; G_MMA(1, 0, At, B0); G_MMA(1, 1, At, B1); G_BAR; G_SCHED;
            G_LDB(B0, 1, 0); G_LDB(B1, 1, 1); G_SCHED; G_LDA(At, 1, 0); G_STAGE_A(G_SA(0, 1), a2, 1, last);
            G_WAIT_POST(); G_WAIT_L(0); G_BAR; G_MMA(0, 0, At, B0); G_MMA(0, 1, At, B1); G_BAR; G_SCHED;
            G_LDA(At, 1, 1); G_STAGE_B(G_SB(1, 0), b3, 0, last); G_STAGE_B(G_SB(1, 1), b3, 1, last); G_STAGE_A(G_SA(1, 0), a3, 0, last);
            G_WAIT_V(8); G_WAIT_L(0); G_BAR; G_MMA(1, 0, At, B0); G_MMA(1, 1, At, B1); G_BAR; G_SCHED;
#undef G_WAIT_POST
        }
        if (wr == 0) G_BAR;
        if (has_next) { const char* n1 = nA + kstep; asm volatile("" : "+s"(n1)); G_STAGE_A(G_SA(1, 1), n1, 1, true); }
        { int tz = threadIdx.x; asm volatile("" : "+v"(tz));
          const int ewid = tz >> 6, el = tz & 63; epi(acc, cur, ewid >> 2, ewid & 3, el & 15, el >> 4); }
        if (!has_next) break;
#pragma unroll
        for (int a = 0; a < 2; ++a)
#pragma unroll
            for (int b = 0; b < 2; ++b)
#pragma unroll
                for (int m = 0; m < 4; ++m)
#pragma unroll
                    for (int n = 0; n < 2; ++n) acc[a][b][m][n] = (f32x4){0.f, 0.f, 0.f, 0.f};
        cur = nxt; cA = nA; cB = nB; ++ui;
        if constexpr (S::GA) {
#pragma unroll
            for (int j = 0; j < 4; ++j) cofA[j] = nofA[j]; }
        if constexpr (S::GB) {
#pragma unroll
            for (int j = 0; j < 4; ++j) cofB[j] = nofB[j]; }
        if (wr == 1) G_BAR;
    }
    G_WAIT_V(0);
    G_BAR;
#undef G_SA
#undef G_SB
#undef G_GLDS
#undef G_STAGE_A
#undef G_STAGE_B
#undef G_LDA
#undef G_LDB
#undef G_MMA
#undef G_WAIT_V
#undef G_WAIT_L
#undef G_BAR
#undef G_SCHED
}
#ifndef MK_FAST
#define MK_FAST 1
#endif
#if MK_FAST
#define GEMM_PHASE(lds, S, E) gemm_fast(lds, S, E)
#else
#define GEMM_PHASE(lds, S, E) gemm_simple(lds, S, E)
#endif


template <int ES, int NBJ, class PF, bool NT = true>
__device__ __forceinline__ void epi_coalesced(LAS unsigned char* el, const PF& pf, unsigned char* gbase, size_t pitch, int wr, int wc, int fr, int fq) {
    constexpr int RB = 128 * NBJ * ES, SL = RB / 16, MS = (16384 / (RB * 32)) > 4 ? 4 : (16384 / (RB * 32)), RP = 32 * MS, RI = 64 / SL, SM = SL < 16 ? SL - 1 : 15;
    const int wave = wr * 4 + wc, lane = fq * 16 + fr;
#pragma unroll
    for (int ai = 0; ai < 2; ++ai)
#pragma unroll
        for (int mp = 0; mp < 4 / MS; ++mp) {
#pragma unroll
            for (int mm = 0; mm < MS; ++mm) { const int m = mp * MS + mm, lr = wr * (16 * MS) + mm * 16 + fr;
#pragma unroll
                for (int bj = 0; bj < NBJ; ++bj) { const int cb = (bj * 128 + wc * 32 + 8 * fq) * ES; LAS unsigned char* p = el + lr * RB + ((((cb >> 4) ^ (lr & SM))) << 4) + (cb & 15);
                    if constexpr (ES == 1) *(LAS u32x2*)p = pf.p8(ai, m, bj); else *(LAS u32x4*)p = pf.p16(ai, m, bj); } }
            LDS_WAIT(); __builtin_amdgcn_s_barrier(); asm volatile("" ::: "memory"); __builtin_amdgcn_sched_barrier(0);
#pragma unroll
            for (int j = 0; j < 2; ++j) { const int lrr = wave * (RP / 8) + j * RI + lane / SL, c = lane % SL;
                const u32x4 v = *(const LAS u32x4*)(el + lrr * RB + ((c ^ (lrr & SM)) << 4));
                const int grow = ai * 128 + (lrr / (16 * MS)) * 64 + (mp * MS + ((lrr >> 4) % MS)) * 16 + (lrr & 15);
                if constexpr (NT) __builtin_nontemporal_store(v, (u32x4*)(gbase + (size_t)grow * pitch + c * 16)); else *(u32x4*)(gbase + (size_t)grow * pitch + c * 16) = v; }
            LDS_WAIT(); __builtin_amdgcn_s_barrier(); asm volatile("" ::: "memory"); __builtin_amdgcn_sched_barrier(0);
        }
}
#define ROWLOOP _Pragma("unroll") for (int ai = 0; ai < 2; ++ai) _Pragma("unroll") for (int m = 0; m < 4; ++m)
#define UROW (ai * 128 + wr * 64 + m * 16 + fr)
#define UCOL(bj, n) ((bj) * 128 + wc * 32 + (n) * 16 + 4 * fq)
#define UCOLP(bj) ((bj) * 128 + wc * 32 + 8 * fq)
__device__ __forceinline__ u32x4 pk8(const f32x4 a, const f32x4 b) { u32x4 w; w.x = pk2(a.x, a.y); w.y = pk2(a.z, a.w); w.z = pk2(b.x, b.y); w.w = pk2(b.z, b.w); return w; }
typedef f32x4 AccT[2][2][4][2];

struct UnitD { int pm, pn; };
template <bool PERM_> struct SchedDenseT {
    typedef UnitD U;
    static constexpr bool GA = false, GB = false, PERM = PERM_;
    const bf16* A; const bf16* Bt; int lda, ldb, Kk, nM, nN, vcu;
    __device__ __forceinline__ const char* baseA(const U& u) const { return (const char*)(A + (size_t)u.pm * 256 * lda); }
    __device__ __forceinline__ const char* baseB(const U& u) const { return (const char*)(Bt + (size_t)u.pn * 256 * ldb); }
    __device__ __forceinline__ bool next(int i, U& u) const { const int L = i * NWG + vcu; if (L >= nM * nN) return false; u.pm = L / nN; u.pn = L % nN; return true; }
    __device__ __forceinline__ int K(const U&) const { return Kk; }
    __device__ __forceinline__ const char* rowA(const U& u, int r) const { return (const char*)(A + (size_t)(u.pm * 256 + r) * lda); }
    __device__ __forceinline__ const char* rowB(const U& u, int r) const { return (const char*)(Bt + (size_t)(u.pn * 256 + r) * ldb); }
};
typedef SchedDenseT<false> SchedDense; typedef SchedDenseT<true> SchedDenseP;
struct SchedDense8 {
    typedef UnitD U;
    static constexpr bool GA = false, GB = false, PERM = true;
    const unsigned char* A; const unsigned char* Bt; int lda, ldb, Kk, nM, nN, vcu;
    __device__ __forceinline__ const char* baseA(const U& u) const { return (const char*)(A + (size_t)u.pm * 256 * lda); }
    __device__ __forceinline__ const char* baseB(const U& u) const { return (const char*)(Bt + (size_t)u.pn * 256 * ldb); }
    __device__ __forceinline__ bool next(int i, U& u) const { const int L = i * NWG + vcu; if (L >= nM * nN) return false; u.pm = L / nN; u.pn = L % nN; return true; }
};
struct EpiXZ {
    static constexpr int NVM = 16;
    bf16* XR; bf16* GG;
    __device__ __forceinline__ void operator()(const AccT& acc, const UnitD& u, int wr, int wc, int fr, int fq) const {
        const bool isg = u.pn >= 4; bf16* base = isg ? GG : XR; const int c0 = (u.pn & 3) * 256;
        ROWLOOP { bf16* rp = base + (size_t)(u.pm * 256 + UROW) * D + c0;
#pragma unroll
            for (int bj = 0; bj < 2; ++bj) { f32x4 v0 = acc[ai][bj][m][0] * 0.015625f, v1 = acc[ai][bj][m][1] * 0.015625f;
                if (isg) {
#pragma unroll
                    for (int j = 0; j < 4; ++j) { v0[j] = gelu_tanh(v0[j]); v1[j] = gelu_tanh(v1[j]); } }
                *(u32x4*)(rp + UCOLP(bj)) = pk8(v0, v1); } }
    }
};
struct EpiResF32 {
    static constexpr int NVM = 0;
    const float* R; float* O; int ldc;
    __device__ __forceinline__ void operator()(const AccT& acc, const UnitD& u, int wr, int wc, int fr, int fq) const {
        const size_t base = (size_t)(u.pm * 256 + wr * 64 + fr) * ldc + u.pn * 256;
        f32x4 cur[4], nxt[4];
#pragma unroll
        for (int q = 0; q < 4; ++q) cur[q] = *(const f32x4*)(R + base + UCOL(q >> 1, q & 1));
#pragma unroll
        for (int g = 0; g < 8; ++g) { const int ai = g >> 2, m = g & 3; const size_t ro = base + (size_t)(ai * 128 + m * 16) * ldc;
            if (g < 7) { const size_t rn = base + (size_t)(((g + 1) >> 2) * 128 + ((g + 1) & 3) * 16) * ldc;
#pragma unroll
                for (int q = 0; q < 4; ++q) nxt[q] = *(const f32x4*)(R + rn + UCOL(q >> 1, q & 1)); }
#pragma unroll
            for (int q = 0; q < 4; ++q) __builtin_nontemporal_store((f32x4)(cur[q] * ALPHA + acc[ai][q >> 1][m][q & 1]), (f32x4*)(O + ro + UCOL(q >> 1, q & 1)));
#pragma unroll
            for (int q = 0; q < 4; ++q) cur[q] = nxt[q]; }
    }
};
struct EpiF32 {
    static constexpr int NVM = 32;
    float* O; int ldc;
    __device__ __forceinline__ void operator()(const AccT& acc, const UnitD& u, int wr, int wc, int fr, int fq) const {
        ROWLOOP { const size_t ro = (size_t)(u.pm * 256 + UROW) * ldc + u.pn * 256;
#pragma unroll
            for (int bj = 0; bj < 2; ++bj)
#pragma unroll
                for (int n = 0; n < 2; ++n) *(f32x4*)(O + ro + UCOL(bj, n)) = acc[ai][bj][m][n]; }
    }
};

struct UnitG { int pm, blk, pn; };
struct SchedGate {
    typedef UnitG U;
    static constexpr bool GA = false, GB = false, PERM = true; static constexpr int Kk = 256, lda = D, ldb = 256;
    const bf16* XC; const bf16* WgT; int vcu;
    __device__ __forceinline__ const char* baseA(const U& u) const { return (const char*)(XC + (size_t)u.pm * 256 * D + u.blk * 256); }
    __device__ __forceinline__ const char* baseB(const U& u) const { return (const char*)(WgT + (size_t)(u.blk * 512 + u.pn * 256) * 256); }
    __device__ __forceinline__ bool next(int i, U& u) const { const int L = i * NWG + vcu; if (L >= 128 * 8) return false; u.pm = L >> 3; u.blk = (L >> 1) & 3; u.pn = L & 1; return true; }
    __device__ __forceinline__ int K(const U&) const { return 256; }
    __device__ __forceinline__ const char* rowA(const U& u, int r) const { return (const char*)(XC + (size_t)(u.pm * 256 + r) * D + u.blk * 256); }
    __device__ __forceinline__ const char* rowB(const U& u, int r) const { return (const char*)(WgT + (size_t)(u.blk * 512 + u.pn * 256 + r) * 256); }
};
struct EpiGate {
    static constexpr int NVM = 0;
    const bf16* XC; const float *ba, *bx, *lam; bf16* LA; bf16* UU;
    __device__ __forceinline__ void operator()(const AccT& acc, const UnitG& u, int wr, int wc, int fr, int fq) const {
        const int c0 = u.blk * 256 + u.pn * 128 + wc * 32 + 8 * fq;
        f32x4 vba[2], vbx[2], sp[2];
#pragma unroll
        for (int n = 0; n < 2; ++n) { vba[n] = *(const f32x4*)(ba + c0 + 4 * n); vbx[n] = *(const f32x4*)(bx + c0 + 4 * n); const f32x4 vl = *(const f32x4*)(lam + c0 + 4 * n);
#pragma unroll
            for (int j = 0; j < 4; ++j) { const float x = __expf(-vl[j]); sp[n][j] = 8.0f * x * (1.0f - x * (0.5f - x * (1.0f / 3.0f))); } }
        const size_t base = (size_t)(u.pm * 256 + wr * 64 + fr) * D + c0;
        u32x4 xw = *(const u32x4*)(XC + base);
#pragma unroll
        for (int g = 0; g < 8; ++g) { const int ai = g >> 2, m = g & 3; const size_t ro = base + (size_t)(ai * 128 + m * 16) * D;
            u32x4 xn = xw; if (g < 7) xn = *(const u32x4*)(XC + base + (size_t)(((g + 1) >> 2) * 128 + ((g + 1) & 3) * 16) * D);
            const float xc[8] = {bf_lo(xw.x), bf_hi(xw.x), bf_lo(xw.y), bf_hi(xw.y), bf_lo(xw.z), bf_hi(xw.z), bf_lo(xw.w), bf_hi(xw.w)};
            f32x4 la[2], uu[2];
#pragma unroll
            for (int n = 0; n < 2; ++n) { const f32x4 ga = acc[ai][0][m][n] + vba[n], gx = acc[ai][1][m][n] + vbx[n];
#pragma unroll
                for (int j = 0; j < 4; ++j) { const float r = sigmoidf_(ga[j]), ig = sigmoidf_(gx[j]); const float l = -r * sp[n][j]; la[n][j] = l;
                    const float mult = sqrtf(fmaxf(1.0f - __expf(2.0f * l), 0.f)); uu[n][j] = mult * ig * xc[4 * n + j]; } }
            *(u32x4*)(LA + ro) = pk8(la[0], la[1]); *(u32x4*)(UU + ro) = pk8(uu[0], uu[1]); xw = xn; }
    }
};

struct UnitE { int rb, pn, e, ti; };
struct SchedG1 {
    typedef UnitE U;
    static constexpr bool GA = true, GB = false, PERM = true; static constexpr int Kk = D, lda = D, ldb = D;
    const unsigned char* X; const unsigned char* W13T; const int* ROWA; const int* BLKE; int nrbt, vcu; int ev; const LAS unsigned* tab;
    __device__ __forceinline__ const char* baseA(const U&) const { return (const char*)X; }
    __device__ __forceinline__ const char* baseB(const U& u) const { return (const char*)(W13T + ((size_t)u.e * 512 + u.pn * 256) * D); }
    __device__ __forceinline__ unsigned goffA(const U& u, int r, int C) const { return tab[u.ti * 256 + r] + (unsigned)C * 2u; }
    __device__ __forceinline__ unsigned goffB(const U&, int, int) const { return 0u; }
    __device__ __forceinline__ bool next(int i, U& u) const { const int L = i * NWG + vcu; const int rb = L >> 1; if (rb >= nrbt) return false; u.rb = rb; u.pn = L & 1; u.ti = i; u.e = __builtin_amdgcn_readlane(ev, i); return true; }
    __device__ __forceinline__ int K(const U&) const { return D; }
};
struct PFSwiGLU { const AccT& acc;
    __device__ __forceinline__ u32x2 p8(int ai, int m, int) const { f32x4 h0, h1;
#pragma unroll
        for (int j = 0; j < 4; ++j) { const float a0 = acc[ai][0][m][0][j] * 0.015625f, a1 = acc[ai][0][m][1][j] * 0.015625f; h0[j] = a0 * sigmoidf_(a0) * (acc[ai][1][m][0][j] * 0.015625f); h1[j] = a1 * sigmoidf_(a1) * (acc[ai][1][m][1][j] * 0.015625f); }
        int t0 = __builtin_amdgcn_cvt_pk_fp8_f32(h0.x, h0.y, 0, false); t0 = __builtin_amdgcn_cvt_pk_fp8_f32(h0.z, h0.w, t0, true);
        int t1 = __builtin_amdgcn_cvt_pk_fp8_f32(h1.x, h1.y, 0, false); t1 = __builtin_amdgcn_cvt_pk_fp8_f32(h1.z, h1.w, t1, true); u32x2 w; w.x = (unsigned)t0; w.y = (unsigned)t1; return w; }
    __device__ __forceinline__ u32x4 p16(int, int, int) const { return (u32x4){0u, 0u, 0u, 0u}; } };
struct EpiSwiGLU {
    static constexpr int NVM = 0; static constexpr bool DEFER = false; static constexpr int soff(int) { return 0; }
    unsigned char* HID; LAS unsigned char* el;
    __device__ __forceinline__ void operator()(const AccT& acc, const UnitE& u, int wr, int wc, int fr, int fq) const {
        epi_coalesced<1, 1, PFSwiGLU, false>(el, PFSwiGLU{acc}, HID + ((size_t)u.rb * 256) * DE + u.pn * 128, DE, wr, wc, fr, fq);
    }
};
struct SchedG2 {
    typedef UnitE U;
    static constexpr bool GA = false, GB = false, PERM = true;
    const unsigned char* HID; const unsigned char* W2T; const int* BLKE; int nrbt, vcu; int ev; int Kk, lda, ldb;
    __device__ __forceinline__ const char* baseA(const U& u) const { return (const char*)(HID + (size_t)u.rb * 256 * DE); }
    __device__ __forceinline__ const char* baseB(const U& u) const { return (const char*)(W2T + ((size_t)u.e * D + u.pn * 256) * DE); }
    __device__ __forceinline__ bool next(int i, U& u) const { const int L = i * NWG + vcu; const int rb = L >> 2; if (rb >= nrbt) return false; u.rb = rb; u.pn = L & 3; u.ti = i; u.e = __builtin_amdgcn_readlane(ev, i); return true; }
    __device__ __forceinline__ int K(const U&) const { return DE; }
};
struct PFScatter { const AccT& acc;
    __device__ __forceinline__ u32x2 p8(int ai, int m, int bj) const { const f32x4 v0 = acc[ai][bj][m][0] * 0.25f, v1 = acc[ai][bj][m][1] * 0.25f;
        int t0 = __builtin_amdgcn_cvt_pk_fp8_f32(v0.x, v0.y, 0, false); t0 = __builtin_amdgcn_cvt_pk_fp8_f32(v0.z, v0.w, t0, true);
        int t1 = __builtin_amdgcn_cvt_pk_fp8_f32(v1.x, v1.y, 0, false); t1 = __builtin_amdgcn_cvt_pk_fp8_f32(v1.z, v1.w, t1, true); u32x2 w; w.x = (unsigned)t0; w.y = (unsigned)t1; return w; }
    __device__ __forceinline__ u32x4 p16(int, int, int) const { return (u32x4){0u, 0u, 0u, 0u}; } };
struct EpiScatter {
    static constexpr int NVM = 8; static constexpr bool DEFER = false; static constexpr int soff(int) { return 0; }
    bf16* YA; int dry; LAS unsigned char* el;
    __device__ __forceinline__ void operator()(const AccT& acc, const UnitE& u, int wr, int wc, int fr, int fq) const {
        epi_coalesced<1, 2>(el, PFScatter{acc}, (unsigned char*)YA + ((size_t)u.rb * 256) * D + u.pn * 256, D, wr, wc, fr, fq);
    }
};

__device__ __forceinline__ int rho_to_tok(int rho, int g) { const int sh = 14 - 2 * g; const int rp = rho & 16383; return (rho & ~16383) + (rp >> sh) + ((rp & ((1 << sh) - 1)) << (2 * g)); }
__device__ __forceinline__ int tok_to_rho(int t, int g) { const int sh = 14 - 2 * g; const int tp = t & 16383; return (t & ~16383) + ((tp & ((1 << (2 * g)) - 1)) << sh) + (tp >> (2 * g)); }
struct UnitQ { int type, g, pm, pn; };
struct SchedQK {
    typedef UnitQ U;
    static constexpr bool GA = false, GB = false, PERM = true; static constexpr int Kk = D, ldb = D;
    const unsigned char* X; const unsigned char* WqkT; int g, lda, vcu;
    __device__ __forceinline__ bool next(int i, U& u) const { const int L = i * NWG + vcu; if (L >= 512) return false; u.type = 0; u.g = g; u.pm = L >> 2; u.pn = L & 3; return true; }
    __device__ __forceinline__ int K(const U&) const { return D; }
    __device__ __forceinline__ const char* baseA(const U& u) const { return (const char*)(X + (size_t)rho_to_tok(u.pm * 256, g) * D); }
    __device__ __forceinline__ const char* baseB(const U& u) const { return (const char*)(WqkT + ((size_t)g * 1024 + u.pn * 256) * D); }
    __device__ __forceinline__ const char* rowA(const U& u, int r) const { return (const char*)(X + (size_t)rho_to_tok(u.pm * 256 + r, g) * D); }
    __device__ __forceinline__ const char* rowB(const U& u, int r) const { return (const char*)(WqkT + ((size_t)g * 1024 + u.pn * 256 + r) * D); }
};
struct SchedVT {
    typedef UnitQ U;
    static constexpr bool GA = false, GB = false, PERM = true; static constexpr int Kk = D, lda = D;
    const unsigned char* X; const unsigned char* WvT; int g, ldb, vcu;
    __device__ __forceinline__ bool next(int i, U& u) const { const int L = i * NWG + vcu; if (L >= 256) return false; u.type = 1; u.g = g; u.pn = L >> 1; u.pm = L & 1; return true; }
    __device__ __forceinline__ int K(const U&) const { return D; }
    __device__ __forceinline__ const char* baseA(const U& u) const { return (const char*)(WvT + ((size_t)g * 512 + u.pm * 256) * D); }
    __device__ __forceinline__ const char* baseB(const U& u) const { return (const char*)(X + (size_t)rho_to_tok(u.pn * 256, g) * D); }
    __device__ __forceinline__ const char* rowA(const U& u, int r) const { return (const char*)(WvT + ((size_t)g * 512 + u.pm * 256 + r) * D); }
    __device__ __forceinline__ const char* rowB(const U& u, int r) const { return (const char*)(X + (size_t)rho_to_tok(u.pn * 256 + r, g) * D); }
};
struct PFScaled { const AccT& acc; float sc;
    __device__ __forceinline__ u32x2 p8(int, int, int) const { return (u32x2){0u, 0u}; }
    __device__ __forceinline__ u32x4 p16(int ai, int m, int bj) const { return pk8(acc[ai][bj][m][0] * sc, acc[ai][bj][m][1] * sc); } };
struct EpiQKV {
    static constexpr int NVM = 16; static constexpr bool DEFER = false; static constexpr int soff(int) { return 0; }
    bf16* QK; bf16* VT; LAS unsigned char* el;
    __device__ __forceinline__ void operator()(const AccT& acc, const UnitQ& u, int wr, int wc, int fr, int fq) const {
        bf16* base; size_t ldc;
        if (u.type == 0) { base = QK + (size_t)u.g * M * 1024; ldc = 1024; } else { base = VT + (size_t)u.g * 512 * M; ldc = M; }
        epi_coalesced<2, 2>(el, PFScaled{acc, 0.015625f}, (unsigned char*)(base + (size_t)(u.pm * 256) * ldc + u.pn * 256), ldc * 2, wr, wc, fr, fq);
    }
};

__device__ __forceinline__ void tr_item(const float* src, int spitch, bf16* dst, int dpitch, LAS float* scr, int lane) {
#pragma unroll 4
    for (int i = 0; i < 16; ++i) { const int k = 4 * i + (lane >> 4), n4 = (lane & 15) * 4; const f32x4 v = *(const f32x4*)(src + (size_t)k * spitch + n4);
        LAS float* s = scr + k * 65 + n4; s[0] = v.x; s[1] = v.y; s[2] = v.z; s[3] = v.w; }
    LDS_WAIT(); asm volatile("" ::: "memory");
    const int c = lane & 7;
#pragma unroll
    for (int j = 0; j < 8; ++j) { const int n = 8 * j + (lane >> 3); const LAS float* s = scr + (8 * c) * 65 + n;
        u32x4 o; o.x = pk2(s[0], s[65]); o.y = pk2(s[2 * 65], s[3 * 65]); o.z = pk2(s[4 * 65], s[5 * 65]); o.w = pk2(s[6 * 65], s[7 * 65]);
        *(u32x4*)(dst + (size_t)n * dpitch + 8 * c) = o; }
    LDS_WAIT(); asm volatile("" ::: "memory");
}
__device__ __forceinline__ void tr_item8(const float* src, int spitch, unsigned char* dst, int dpitch, LAS float* scr, int lane) {
#pragma unroll 4
    for (int i = 0; i < 16; ++i) { const int k = 4 * i + (lane >> 4), n4 = (lane & 15) * 4; const f32x4 v = *(const f32x4*)(src + (size_t)k * spitch + n4);
        LAS float* s = scr + k * 65 + n4; s[0] = v.x; s[1] = v.y; s[2] = v.z; s[3] = v.w; }
    LDS_WAIT(); asm volatile("" ::: "memory");
    const int c = lane & 7;
#pragma unroll
    for (int j = 0; j < 8; ++j) { const int n = 8 * j + (lane >> 3); const LAS float* s = scr + (8 * c) * 65 + n;
        int t0 = __builtin_amdgcn_cvt_pk_fp8_f32(s[0] * 64.f, s[65] * 64.f, 0, false); t0 = __builtin_amdgcn_cvt_pk_fp8_f32(s[2 * 65] * 64.f, s[3 * 65] * 64.f, t0, true);
        int t1 = __builtin_amdgcn_cvt_pk_fp8_f32(s[4 * 65] * 64.f, s[5 * 65] * 64.f, 0, false); t1 = __builtin_amdgcn_cvt_pk_fp8_f32(s[6 * 65] * 64.f, s[7 * 65] * 64.f, t1, true);
        u32x2 o; o.x = (unsigned)t0; o.y = (unsigned)t1; *(u32x2*)(dst + (size_t)n * dpitch + 8 * c) = o; }
    LDS_WAIT(); asm volatile("" ::: "memory");
}
template <class RowMap>
__device__ __forceinline__ void tr_matrix(Frame& F, const float* W, int K, int N, bf16* WT, int dpitch, RowMap drow) {
    LAS float* scr = (LAS float*)(F.lds + F.wave * 16640);
    const int nkb = K / 64, nnb = N / 64;
    for (int it = F.vcu * NWAVES + F.wave; it < nkb * nnb; it += NGW) { const int kb = it / nnb, nb = it % nnb;
        tr_item(W + (size_t)(kb * 64) * N + nb * 64, N, WT + (size_t)drow(nb * 64) * dpitch + kb * 64, dpitch, scr, F.lane); }
}
template <class RowMap>
__device__ __forceinline__ void tr_matrix8(Frame& F, const float* W, int K, int N, unsigned char* WT, int dpitch, RowMap drow) {
    LAS float* scr = (LAS float*)(F.lds + F.wave * 16640);
    const int nkb = K / 64, nnb = N / 64;
    for (int it = F.vcu * NWAVES + F.wave; it < nkb * nnb; it += NGW) { const int kb = it / nnb, nb = it % nnb;
        tr_item8(W + (size_t)(kb * 64) * N + nb * 64, N, WT + (size_t)drow(nb * 64) * dpitch + kb * 64, dpitch, scr, F.lane); }
}
__device__ __forceinline__ void cv_src(int it, const float* w1, const float* w3, const float* w2, const float* s1, const float* s3, const float* s2, const float*& src, int& spitch) {
    const int e = it / 192, r = it % 192, which = r >> 6, tile = r & 63;
    if (which < 2) { const float* W = (e < 256) ? (which == 0 ? w1 : w3) + (size_t)e * (size_t)(D * DE) : (which == 0 ? s1 : s3); src = W + (size_t)((tile >> 2) * 64) * DE + (tile & 3) * 64; spitch = DE; }
    else { const float* W = (e < 256) ? w2 + (size_t)e * (size_t)(DE * D) : s2; src = W + (size_t)((tile >> 4) * 64) * D + (tile & 15) * 64; spitch = D; }
}
__device__ __forceinline__ void convert_experts(Frame& F, const float* w1, const float* w3, const float* w2, const float* s1, const float* s3, const float* s2, int layer, int part, int nparts) {
    LAS float* scr = (LAS float*)(F.lds + F.wave * 16640);
    unsigned char* W13T = WSP(unsigned char, WS_W13) + (size_t)layer * W13_LB; unsigned char* W2T = WSP(unsigned char, WS_W2) + (size_t)layer * W2_LB;
    const int lane = F.lane; const int NTOT = 257 * 192; const int it0 = (int)((long)NTOT * part / nparts), NIT = (int)((long)NTOT * (part + 1) / nparts);
    f32x4 cur[16], nxt[16];
    int it = it0 + F.vcu * NWAVES + F.wave;
    if (it < NIT) { const float* src; int sp; cv_src(it, w1, w3, w2, s1, s3, s2, src, sp);
#pragma unroll
        for (int i = 0; i < 16; ++i) cur[i] = __builtin_nontemporal_load((const f32x4*)(src + (size_t)(4 * i + (lane >> 4)) * sp + (lane & 15) * 4)); }
#pragma unroll 1
    for (; it < NIT; it += NGW) {
        const int itn = it + NGW;
        if (itn < NIT) { const float* src; int sp; cv_src(itn, w1, w3, w2, s1, s3, s2, src, sp);
#pragma unroll
            for (int i = 0; i < 16; ++i) nxt[i] = __builtin_nontemporal_load((const f32x4*)(src + (size_t)(4 * i + (lane >> 4)) * sp + (lane & 15) * 4)); }
#pragma unroll
        for (int i = 0; i < 16; ++i) { const int k = 4 * i + (lane >> 4), n4 = (lane & 15) * 4; LAS float* s = scr + k * 65 + n4; s[0] = cur[i].x; s[1] = cur[i].y; s[2] = cur[i].z; s[3] = cur[i].w; }
        LDS_WAIT(); asm volatile("" ::: "memory");
        const int e = it / 192, r = it % 192, which = r >> 6, tile = r & 63, c = lane & 7;
        if (which < 2) { const int kb = tile >> 2, nb = tile & 3; const int drow = (nb >> 1) * 256 + which * 128 + (nb & 1) * 64; unsigned char* dst = W13T + ((size_t)e * 512 + drow) * D + kb * 64;
#pragma unroll
            for (int j = 0; j < 8; ++j) { const int n = 8 * j + (lane >> 3); const LAS float* s = scr + (8 * c) * 65 + n;
                int t0 = __builtin_amdgcn_cvt_pk_fp8_f32(s[0] * 64.f, s[65] * 64.f, 0, false); t0 = __builtin_amdgcn_cvt_pk_fp8_f32(s[2 * 65] * 64.f, s[3 * 65] * 64.f, t0, true);
                int t1 = __builtin_amdgcn_cvt_pk_fp8_f32(s[4 * 65] * 64.f, s[5 * 65] * 64.f, 0, false); t1 = __builtin_amdgcn_cvt_pk_fp8_f32(s[6 * 65] * 64.f, s[7 * 65] * 64.f, t1, true);
                u32x2 o; o.x = (unsigned)t0; o.y = (unsigned)t1; __builtin_nontemporal_store(o, (u32x2*)(dst + (size_t)n * D + 8 * c)); } }
        else { const int kb = tile >> 4, nb = tile & 15; unsigned char* dst = W2T + ((size_t)e * D + nb * 64) * DE + kb * 64;
#pragma unroll
            for (int j = 0; j < 8; ++j) { const int n = 8 * j + (lane >> 3); const LAS float* s = scr + (8 * c) * 65 + n;
                int t0 = __builtin_amdgcn_cvt_pk_fp8_f32(s[0] * 64.f, s[65] * 64.f, 0, false); t0 = __builtin_amdgcn_cvt_pk_fp8_f32(s[2 * 65] * 64.f, s[3 * 65] * 64.f, t0, true);
                int t1 = __builtin_amdgcn_cvt_pk_fp8_f32(s[4 * 65] * 64.f, s[5 * 65] * 64.f, 0, false); t1 = __builtin_amdgcn_cvt_pk_fp8_f32(s[6 * 65] * 64.f, s[7 * 65] * 64.f, t1, true);
                u32x2 o; o.x = (unsigned)t0; o.y = (unsigned)t1; __builtin_nontemporal_store(o, (u32x2*)(dst + (size_t)n * DE + 8 * c)); } }
        LDS_WAIT(); asm volatile("" ::: "memory");
#pragma unroll
        for (int i = 0; i < 16; ++i) cur[i] = nxt[i];
    }
}
struct MapId { __device__ int operator()(int n0) const { return n0; } };
struct MapGate { int which; __device__ int operator()(int n0) const { return (n0 >> 7) * 256 + which * 128 + (n0 & 127); } };
struct MapQ { __device__ int operator()(int n0) const { return (n0 >> 9) * 1024 + (n0 & 511); } };
struct MapKV { __device__ int operator()(int n0) const { return n0 < 1536 ? (n0 >> 9) * 1024 + 512 + (n0 & 511) : 3072 + (n0 - 1536); } };

__device__ __forceinline__ void p0_prologue(Frame& F, const Args& A) {
    { const float* x = A.in[0]; unsigned char* XQ = WSP(unsigned char, WS_RA + RA_XB);
      for (size_t i = (size_t)F.vcu * NTHR + F.tid; i < (size_t)M * D / 8; i += NGT) { const f32x4 a = *(const f32x4*)(x + i * 8), b = *(const f32x4*)(x + i * 8 + 4);
          int t0 = __builtin_amdgcn_cvt_pk_fp8_f32(a.x, a.y, 0, false); t0 = __builtin_amdgcn_cvt_pk_fp8_f32(a.z, a.w, t0, true);
          int t1 = __builtin_amdgcn_cvt_pk_fp8_f32(b.x, b.y, 0, false); t1 = __builtin_amdgcn_cvt_pk_fp8_f32(b.z, b.w, t1, true);
          u32x2 o; o.x = (unsigned)t0; o.y = (unsigned)t1; *(u32x2*)(XQ + i * 8) = o; } }
    tr_matrix8(F, A.in[1], D, 2048, WSP(unsigned char, WS_WIN), D, MapId());
    for (int b = 0; b < 4; ++b) { tr_matrix(F, A.in[4] + b * 65536, 256, 256, WSP(bf16, WS_WG) + (size_t)b * 512 * 256, 256, MapGate{0});
                                  tr_matrix(F, A.in[6] + b * 65536, 256, 256, WSP(bf16, WS_WG) + (size_t)b * 512 * 256, 256, MapGate{1}); }
    tr_matrix(F, A.in[9], D, D, WSP(bf16, WS_WOUT), D, MapId());
    tr_matrix8(F, A.in[11], D, QW, WSP(unsigned char, WS_WQK), D, MapQ());
    tr_matrix8(F, A.in[10], D, 2 * QW, WSP(unsigned char, WS_WQK), D, MapKV());
    tr_matrix(F, A.in[12], OW, D, WSP(bf16, WS_WO), OW, MapId());
    for (int l = 0; l < 2; ++l) tr_matrix(F, A.in[13] + (size_t)l * D * NE, D, NE, WSP(bf16, WS_WR) + (size_t)l * NE * D, D, MapId());
}
static_assert(WS_WV == WS_WQK + (size_t)3072 * 1024 * 2, "WvT must follow WqkT");

__device__ __forceinline__ void ln_store(f32x4 (&v)[4], const float* g, const float* b, float* of, bf16* ob, int lane, unsigned char* oq = nullptr) {
    float s = 0.f;
#pragma unroll
    for (int j = 0; j < 4; ++j) s += (v[j].x + v[j].y) + (v[j].z + v[j].w);
    const float mean = wave_sum(s) * (1.f / D); float s2 = 0.f;
#pragma unroll
    for (int j = 0; j < 4; ++j) { v[j] = v[j] - mean; s2 += (v[j].x * v[j].x + v[j].y * v[j].y) + (v[j].z * v[j].z + v[j].w * v[j].w); }
    const float rstd = 1.f / sqrtf(wave_sum(s2) * (1.f / D) + LN_EPS);
#pragma unroll
    for (int j = 0; j < 4; ++j) { const int c = 4 * lane + 256 * j; const f32x4 gg = *(const f32x4*)(g + c), bb = *(const f32x4*)(b + c); const f32x4 y = v[j] * rstd * gg + bb;
        if (of) __builtin_nontemporal_store(y, (f32x4*)(of + c));
        if (ob) { u32x2 w; w.x = pk2(y.x, y.y); w.y = pk2(y.z, y.w); *(u32x2*)(ob + c) = w; }
        if (oq) { int t = __builtin_amdgcn_cvt_pk_fp8_f32(y.x, y.y, 0, false); t = __builtin_amdgcn_cvt_pk_fp8_f32(y.z, y.w, t, true); *(unsigned*)(oq + c) = (unsigned)t; } }
}

__device__ __forceinline__ int moe_unit_experts(Frame& F, const int* BLKE, int nrbt, int shift) { const int L = F.lane * NWG + F.vcu; const int rb = L >> shift; return rb < nrbt ? BLKE[rb] : 0; }
__device__ __forceinline__ const LAS unsigned* moe_row_table(Frame& F, const int* ROWA, int nrbt) {
    LAS unsigned* tab = (LAS unsigned*)(F.lds + LDS_TAB);
    if (F.tid < 256) { int a[15];
#pragma unroll
        for (int i = 0; i < 15; ++i) { const int rb = (i * NWG + F.vcu) >> 1; a[i] = rb < nrbt ? ROWA[rb * 256 + F.tid] : -1; }
#pragma unroll
        for (int i = 0; i < 15; ++i) { const int tok = a[i] < 0 ? 0 : (a[i] < 8 * M ? (a[i] >> 3) : a[i] - 8 * M); tab[i * 256 + F.tid] = (unsigned)tok * (unsigned)D; } }
    __syncthreads();
    return tab;
}
__device__ __forceinline__ void p_conv(Frame& F, const float* cw, const float* cb) {
    const bf16* XR = WSP(bf16, WS_RA + RA_XR); bf16* XC = WSP(bf16, WS_RA + RA_XC);
    for (int i = F.vcu * NTHR + F.tid; i < M * (D / 8); i += NGT) { const int t = i >> 7, c = (i & 127) * 8; const int ts = t & (SEQ - 1);
        float a[8];
#pragma unroll
        for (int q = 0; q < 8; ++q) a[q] = cb[c + q];
#pragma unroll
        for (int j = 0; j < 4; ++j) { if (ts - 3 + j >= 0) { const u32x4 w = *(const u32x4*)(XR + (size_t)(t - 3 + j) * D + c); const float* wj = cw + j * D + c;
            a[0] += wj[0] * bf_lo(w.x); a[1] += wj[1] * bf_hi(w.x); a[2] += wj[2] * bf_lo(w.y); a[3] += wj[3] * bf_hi(w.y);
            a[4] += wj[4] * bf_lo(w.z); a[5] += wj[5] * bf_hi(w.z); a[6] += wj[6] * bf_lo(w.w); a[7] += wj[7] * bf_hi(w.w); } }
        u32x4 o; o.x = pk2(a[0], a[1]); o.y = pk2(a[2], a[3]); o.z = pk2(a[4], a[5]); o.w = pk2(a[6], a[7]); *(u32x4*)(XC + (size_t)t * D + c) = o; }
}
constexpr int CH = 64, NCH = SEQ / CH;
__device__ __forceinline__ void p_scan1(Frame& F) {
    const bf16* LA = WSP(bf16, WS_RA + RA_LA); const bf16* UU = WSP(bf16, WS_RA + RA_U); float* CP = WSP(float, WS_CHP); float* CHh = WSP(float, WS_CHH);
    for (int i = F.vcu * NTHR + F.tid; i < BATCH * NCH * (D / 4); i += NGT) { const int c4 = (i & 255) * 4, ck = (i >> 8) & (NCH - 1), b = i >> 16;
        const size_t r0 = ((size_t)b * SEQ + (size_t)ck * CH) * D + c4; f32x4 h = {0.f, 0.f, 0.f, 0.f}, sl = {0.f, 0.f, 0.f, 0.f};
#pragma unroll 8
        for (int t = 0; t < CH; ++t) { const u32x2 lw = *(const u32x2*)(LA + r0 + (size_t)t * D), uw = *(const u32x2*)(UU + r0 + (size_t)t * D);
            const f32x4 la = {bf_lo(lw.x), bf_hi(lw.x), bf_lo(lw.y), bf_hi(lw.y)}, u = {bf_lo(uw.x), bf_hi(uw.x), bf_lo(uw.y), bf_hi(uw.y)};
#pragma unroll
            for (int j = 0; j < 4; ++j) { h[j] = __expf(la[j]) * h[j] + u[j]; sl[j] += la[j]; } }
#pragma unroll
        for (int j = 0; j < 4; ++j) { const size_t o = ((size_t)b * D + c4 + j) * NCH + ck; CP[o] = __expf(sl[j]); CHh[o] = h[j]; } }
}
__device__ __forceinline__ void p_scan2(Frame& F) {
    const float* CP = WSP(float, WS_CHP); const float* CHh = WSP(float, WS_CHH); float* CIN = WSP(float, WS_CIN);
    for (int s = F.vcu * NWAVES + F.wave; s < BATCH * D; s += NGW) { const size_t o = (size_t)s * NCH + 4 * F.lane;
        const f32x4 p4 = *(const f32x4*)(CP + o), h4 = *(const f32x4*)(CHh + o);
        float p = p4.x, h = h4.x; h = p4.y * h + h4.y; p *= p4.y; h = p4.z * h + h4.z; p *= p4.z; h = p4.w * h + h4.w; p *= p4.w;
#pragma unroll
        for (int off = 1; off < 64; off <<= 1) { const float pp = __shfl_up(p, off), hp = __shfl_up(h, off); if (F.lane >= off) { h = p * hp + h; p = pp * p; } }
        float c0 = __shfl_up(h, 1); if (F.lane == 0) c0 = 0.f;
        f32x4 ci; ci.x = c0; ci.y = p4.x * ci.x + h4.x; ci.z = p4.y * ci.y + h4.y; ci.w = p4.z * ci.z + h4.z;
        *(f32x4*)(CIN + o) = ci; }
}
__device__ __forceinline__ void p_scan3(Frame& F) {
    const bf16* LA = WSP(bf16, WS_RA + RA_LA); const bf16* UU = WSP(bf16, WS_RA + RA_U); const float* CIN = WSP(float, WS_CIN);
    const bf16* GG = WSP(bf16, WS_RA + RA_GG); bf16* YB = WSP(bf16, WS_RA + RA_YB);
    for (int i = F.vcu * NTHR + F.tid; i < BATCH * NCH * (D / 4); i += NGT) { const int c4 = (i & 255) * 4, ck = (i >> 8) & (NCH - 1), b = i >> 16;
        const size_t r0 = ((size_t)b * SEQ + (size_t)ck * CH) * D + c4; f32x4 h;
#pragma unroll
        for (int j = 0; j < 4; ++j) h[j] = CIN[((size_t)b * D + c4 + j) * NCH + ck];
#pragma unroll 1
        for (int t0 = 0; t0 < CH; t0 += 8) { u32x2 lw[8], uw[8], gw[8];
#pragma unroll
            for (int k = 0; k < 8; ++k) { const size_t o = r0 + (size_t)(t0 + k) * D; lw[k] = __builtin_nontemporal_load((const u32x2*)(LA + o)); uw[k] = __builtin_nontemporal_load((const u32x2*)(UU + o)); gw[k] = __builtin_nontemporal_load((const u32x2*)(GG + o)); }
#pragma unroll
            for (int k = 0; k < 8; ++k) { const f32x4 la = {bf_lo(lw[k].x), bf_hi(lw[k].x), bf_lo(lw[k].y), bf_hi(lw[k].y)}, u = {bf_lo(uw[k].x), bf_hi(uw[k].x), bf_lo(uw[k].y), bf_hi(uw[k].y)};
#pragma unroll
                for (int j = 0; j < 4; ++j) h[j] = __expf(la[j]) * h[j] + u[j];
                u32x2 o; o.x = pk2(h.x * bf_lo(gw[k].x), h.y * bf_hi(gw[k].x)); o.y = pk2(h.z * bf_lo(gw[k].y), h.w * bf_hi(gw[k].y)); *(u32x2*)(YB + r0 + (size_t)(t0 + k) * D) = o; } } }
}
__device__ __forceinline__ void p_ln(Frame& F, const float* V, const float* g, const float* b, float* Hf, bf16* Hb) {
    unsigned char* Hq = WSP(unsigned char, WS_HQ);
    for (int r = F.vcu * NWAVES + F.wave; r < M; r += NGW) { const f32x4* xr = (const f32x4*)(V + (size_t)r * D) + F.lane; f32x4 v[4];
#pragma unroll
        for (int j = 0; j < 4; ++j) v[j] = __builtin_nontemporal_load(xr + 64 * j);
        ln_store(v, g, b, Hf + (size_t)r * D, Hb + (size_t)r * D, F.lane, Hq + (size_t)r * D); }
}
template <int CTRL> __device__ __forceinline__ float dppf(float x) { return __builtin_bit_cast(float, __builtin_amdgcn_mov_dpp(__builtin_bit_cast(int, x), CTRL, 0xF, 0xF, true)); }
template <int CTRL> __device__ __forceinline__ unsigned dppu(unsigned x) { return (unsigned)__builtin_amdgcn_mov_dpp((int)x, CTRL, 0xF, 0xF, true); }
__device__ __forceinline__ float rdlane_f(float x, int l) { return __builtin_bit_cast(float, __builtin_amdgcn_readlane(__builtin_bit_cast(int, x), l)); }
__device__ __forceinline__ void p_route(Frame& F, const float* bias) {
    const float* LG = WSP(float, WS_LOGITS); int* TOPI = WSP(int, WS_TOPI); float* GATE = WSP(float, WS_GATE); int* HIST = WSP(int, WS_HIST);
    LAS int* hist = (LAS int*)F.lds; const int lane = F.lane;
    if (F.tid < 256) hist[F.tid] = 0;
    __syncthreads();
    const f32x4 bv = *(const f32x4*)(bias + 4 * lane);
#pragma unroll 2
    for (int j = 0; j < 16; ++j) { const int t = F.vcu * 128 + F.wave * 16 + j;
        const f32x4 z = *(const f32x4*)(LG + (size_t)t * NE + 4 * lane);
        const float s0 = sigmoidf_(z.x), s1 = sigmoidf_(z.y), s2 = sigmoidf_(z.z), s3 = sigmoidf_(z.w);
        const float v0 = s0 + bv.x, v1 = s1 + bv.y, v2 = s2 + bv.z, v3 = s3 + bv.w;
        float m1, m2; { const float a = fmaxf(v0, v1), b = fminf(v0, v1), c = fmaxf(v2, v3), d = fminf(v2, v3); m1 = fmaxf(a, c); m2 = fmaxf(fminf(a, c), fmaxf(b, d)); }
        { float o1 = dppf<0xB1>(m1), o2 = dppf<0xB1>(m2); float n1 = fmaxf(m1, o1), n2 = fmaxf(fminf(m1, o1), fmaxf(m2, o2)); m1 = n1; m2 = n2;
          o1 = dppf<0x4E>(m1); o2 = dppf<0x4E>(m2); n1 = fmaxf(m1, o1); n2 = fmaxf(fminf(m1, o1), fmaxf(m2, o2)); m1 = n1; m2 = n2;
          o1 = dppf<0x141>(m1); o2 = dppf<0x141>(m2); n1 = fmaxf(m1, o1); n2 = fmaxf(fminf(m1, o1), fmaxf(m2, o2)); m1 = n1; m2 = n2; }
        const float gs = m1 + m2; const int g = lane >> 3; int rank = 0;
#pragma unroll
        for (int q = 0; q < 8; ++q) { const float o = rdlane_f(gs, 8 * q); rank += (o > gs || (o == gs && q < g)) ? 1 : 0; }
        const bool sel = rank < 4;
        const unsigned ib = 255u - 4u * (unsigned)lane;
        unsigned k0 = sel ? ((__float_as_uint(v0 + 1.0f) & ~255u) | ib) : 0u, k1 = sel ? ((__float_as_uint(v1 + 1.0f) & ~255u) | (ib - 1u)) : 0u;
        unsigned k2 = sel ? ((__float_as_uint(v2 + 1.0f) & ~255u) | (ib - 2u)) : 0u, k3 = sel ? ((__float_as_uint(v3 + 1.0f) & ~255u) | (ib - 3u)) : 0u;
        int myidx = 0; float mys = 0.f, tot = 0.f;
#pragma unroll
        for (int k = 0; k < TOPK; ++k) {
            unsigned mk = max(max(k0, k1), max(k2, k3));
            mk = max(mk, dppu<0xB1>(mk)); mk = max(mk, dppu<0x4E>(mk)); mk = max(mk, dppu<0x141>(mk)); mk = max(mk, dppu<0x140>(mk));
            const unsigned win = max(max((unsigned)__builtin_amdgcn_readlane((int)mk, 0), (unsigned)__builtin_amdgcn_readlane((int)mk, 16)), max((unsigned)__builtin_amdgcn_readlane((int)mk, 32), (unsigned)__builtin_amdgcn_readlane((int)mk, 48)));
            const int idx = 255 - (int)(win & 255u);
            k0 = (k0 == win) ? 0u : k0; k1 = (k1 == win) ? 0u : k1; k2 = (k2 == win) ? 0u : k2; k3 = (k3 == win) ? 0u : k3;
            const int qq = idx & 3; const float sq = qq == 0 ? s0 : (qq == 1 ? s1 : (qq == 2 ? s2 : s3)); const float sw = rdlane_f(sq, idx >> 2);
            tot += sw; if (lane == k) { myidx = idx; mys = sw; }
        }
        if (lane < TOPK) { TOPI[t * TOPK + lane] = myidx; GATE[t * TOPK + lane] = mys / tot * 2.5f; atomicAdd((int*)&hist[myidx], 1); }
    }
    __syncthreads();
    if (F.tid < 256) HIST[F.vcu * 256 + F.tid] = hist[F.tid];
    __syncthreads();
}
__device__ __forceinline__ void p_sort(Frame& F) {
    const int* HIST = WSP(int, WS_HIST); const int* TOPI = WSP(int, WS_TOPI); int* ROWA = WSP(int, WS_ROWA); int* POS = WSP(int, WS_POS); int* BLKE = WSP(int, WS_BLKE); int* META = WSP(int, WS_META);
    LAS int* cnt = (LAS int*)F.lds; LAS int* myoff = cnt + 256; LAS int* nb = cnt + 512; LAS int* blk0 = cnt + 768; LAS int* lcnt = cnt + 1024;
    { typedef int i32x4 __attribute__((ext_vector_type(4)));
      const int q = F.tid >> 6, l = F.tid & 63; i32x4 c = {0, 0, 0, 0}, mo = {0, 0, 0, 0};
#pragma unroll 8
      for (int w = q; w < NWG; w += 8) { const i32x4 h = *(const i32x4*)(HIST + w * 256 + 4 * l); c += h; if (w < F.vcu) mo += h; }
      LAS int* redc = cnt + 1280; LAS int* redm = redc + 2048;
#pragma unroll
      for (int j = 0; j < 4; ++j) { redc[q * 256 + 4 * l + j] = c[j]; redm[q * 256 + 4 * l + j] = mo[j]; }
      __syncthreads();
      if (F.tid < 256) { const int e = F.tid; int cc = 0, mm = 0;
#pragma unroll
          for (int k = 0; k < 8; ++k) { cc += redc[k * 256 + e]; mm += redm[k * 256 + e]; }
          cnt[e] = cc; myoff[e] = mm; nb[e] = (cc + 255) >> 8; lcnt[e] = 0; } }
    __syncthreads();
    if (F.tid < 256) { int b = 0; for (int j = 0; j < F.tid; ++j) b += nb[j]; blk0[F.tid] = b; }
    __syncthreads();
    for (int al = F.tid; al < 1024; al += NTHR) { const int a = F.vcu * 1024 + al; const int e = TOPI[a]; const int pos = blk0[e] * 256 + myoff[e] + atomicAdd((int*)&lcnt[e], 1); ROWA[pos] = a; POS[a] = pos; }
    const int nrb = blk0[255] + nb[255];
    { const int e = F.vcu; const int start = blk0[e] * 256 + cnt[e], end = (blk0[e] + nb[e]) * 256;
      for (int p = start + F.tid; p < end; p += NTHR) ROWA[p] = -1;
      for (int j = F.tid; j < nb[e]; j += NTHR) BLKE[blk0[e] + j] = e; }
    for (int tl = F.tid; tl < 128; tl += NTHR) { const int t = F.vcu * 128 + tl; ROWA[nrb * 256 + t] = 8 * M + t; }
    if (F.vcu == 0) { for (int j = F.tid; j < 128; j += NTHR) BLKE[nrb + j] = 256; if (F.tid == 0) META[0] = nrb + 128; }
    __syncthreads();
}
__device__ __forceinline__ void p_combine(Frame& F, const float* Hin, const float* g, const float* b, float* Hf, unsigned char* Hq) {
    const bf16* YA = WSP(bf16, WS_RA); const float* GATE = WSP(float, WS_GATE); const int* POS = WSP(int, WS_POS); const int shrow0 = (*WSP(int, WS_META) - 128) * 256;
    for (int t = F.vcu * NWAVES + F.wave; t < M; t += NGW) { f32x4 v[4];
        const f32x4* hr = (const f32x4*)(Hin + (size_t)t * D) + F.lane;
#pragma unroll
        for (int j = 0; j < 4; ++j) v[j] = __builtin_nontemporal_load(hr + 64 * j) * ALPHA;
        float r16[16];
#pragma unroll
        for (int i = 0; i < 16; ++i) r16[i] = 0.f;
#pragma unroll
        for (int k = 0; k <= TOPK; ++k) { const float gk = (k < TOPK ? GATE[t * TOPK + (k < TOPK ? k : 0)] : 1.0f) * 0.0625f; const size_t row = k < TOPK ? (size_t)POS[t * TOPK + (k < TOPK ? k : 0)] : (size_t)(shrow0 + t);
            const u32x4 w = __builtin_nontemporal_load((const u32x4*)((const unsigned char*)YA + row * D) + F.lane); const unsigned ww[4] = {w.x, w.y, w.z, w.w};
#pragma unroll
            for (int q = 0; q < 4; ++q) { const f32x2 a = __builtin_amdgcn_cvt_pk_f32_fp8((int)ww[q], false), c = __builtin_amdgcn_cvt_pk_f32_fp8((int)ww[q], true);
                r16[4 * q] += gk * a.x; r16[4 * q + 1] += gk * a.y; r16[4 * q + 2] += gk * c.x; r16[4 * q + 3] += gk * c.y; } }
        { LAS float* ws = (LAS float*)(F.lds + F.wave * 4096);
#pragma unroll
          for (int q = 0; q < 4; ++q) *(LAS f32x4*)(ws + 16 * F.lane + 4 * q) = (f32x4){r16[4 * q], r16[4 * q + 1], r16[4 * q + 2], r16[4 * q + 3]};
          LDS_WAIT(); asm volatile("" ::: "memory");
#pragma unroll
          for (int j = 0; j < 4; ++j) v[j] += *(const LAS f32x4*)(ws + 4 * F.lane + 256 * j);
          LDS_WAIT(); asm volatile("" ::: "memory"); }
        ln_store(v, g, b, Hf + (size_t)t * D, nullptr, F.lane, Hq ? Hq + (size_t)t * D : nullptr); }
}
constexpr int AT_KP = 144, AT_VP = 784, AT_KBYTES = 384 * AT_KP, AT_VOFF = AT_KBYTES;
__device__ __forceinline__ void p_attn(Frame& F) {
    const bf16* QKb = WSP(bf16, WS_RA + RA_QK); const bf16* VTb = WSP(bf16, WS_RA + RA_VT); bf16* OGb = WSP(bf16, WS_RA + RA_OG); float* LSE = WSP(float, WS_LSE);
    const int lane = F.lane, q = lane & 31, hh = lane >> 5, w = F.wave;
    LAS unsigned char* lk = F.lds; LAS unsigned char* lv = F.lds + AT_VOFF;
#pragma unroll 1
    for (int it = F.vcu; it < 3 * 128 * 8; it += NWG) {
        const int g = it >> 10, rem = it & 1023, chunk = rem >> 3, h = rem & 7;
        const int sh = 14 - 2 * g, rq0 = chunk * 256, i0 = rq0 & ((1 << sh) - 1), rk0 = rq0 - 128;
        const bf16* QK = QKb + (size_t)g * M * 1024; const bf16* VT = VTb + (size_t)g * 512 * M;
        { const char* kb = (const char*)(QK + 512 + h * 64);
#pragma unroll
          for (int j = 0; j < 7; ++j) { const int ins = w + 8 * j; if (ins < 54) { const int p = ins * 64 + lane, row = p / 9, cc = p - row * 9; const int gr = rk0 + row < 0 ? 0 : rk0 + row;
              __builtin_amdgcn_global_load_lds((const unsigned*)(kb + (size_t)gr * 2048 + (cc > 7 ? 7 : cc) * 16), (LAS unsigned*)(lk + ins * 1024), 16, 0, 0); } }
          const char* vb = (const char*)(VT + (size_t)(h * 64) * M);
#pragma unroll
          for (int j = 0; j < 7; ++j) { const int ins = w + 8 * j; if (ins < 49) { const int p = ins * 64 + lane, row = p / 49, cc = p - row * 49; int col = rk0 + (cc > 47 ? 47 : cc) * 8; col = col < 0 ? 0 : col;
              __builtin_amdgcn_global_load_lds((const unsigned*)(vb + ((size_t)row * M + col) * 2), (LAS unsigned*)(lv + ins * 1024), 16, 0, 0); } } }
        bf16x8 Qf[4];
        { const bf16* qp = QK + (size_t)(rq0 + 32 * w + q) * 1024 + h * 64 + 8 * hh;
#pragma unroll
          for (int s2 = 0; s2 < 4; ++s2) Qf[s2] = *(const bf16x8*)(qp + 16 * s2); }
        asm volatile("s_waitcnt vmcnt(0)" ::: "memory");
        __syncthreads();
        const float slope2 = exp2f(-(float)(h + 1)) * (float)(1 << (2 * g)) * 1.4426950408889634f, sc = 0.125f * 1.4426950408889634f;
        float m_run = -1e30f, l_run = 0.f; f32x16 O0, O1;
#pragma unroll
        for (int r = 0; r < 16; ++r) { O0[r] = 0.f; O1[r] = 0.f; }
#pragma unroll 1
        for (int kt = 0; kt < 5; ++kt) { const int kr0 = 32 * w + 32 * kt; if (i0 + kr0 - 128 < 0) continue;
            bf16x8 Kf[4];
            { const LAS unsigned char* kp = lk + (kr0 + q) * AT_KP + 16 * hh;
#pragma unroll
              for (int s2 = 0; s2 < 4; ++s2) Kf[s2] = *(const LAS bf16x8*)(kp + 32 * s2); }
            bf16x8 Vf[2][2];
#pragma unroll
            for (int dd = 0; dd < 2; ++dd)
#pragma unroll
                for (int s2 = 0; s2 < 2; ++s2) { const LAS unsigned char* vp = lv + (32 * dd + q) * AT_VP + (kr0 + 16 * s2 + 4 * hh) * 2;
                    const u32x2 lo = *(const LAS u32x2*)vp, hi = *(const LAS u32x2*)(vp + 16); u32x4 wv; wv.x = lo.x; wv.y = lo.y; wv.z = hi.x; wv.w = hi.y; Vf[dd][s2] = __builtin_bit_cast(bf16x8, wv); }
            f32x16 S;
#pragma unroll
            for (int r = 0; r < 16; ++r) S[r] = 0.f;
#pragma unroll
            for (int s2 = 0; s2 < 4; ++s2) S = __builtin_amdgcn_mfma_f32_32x32x16_bf16(Kf[s2], Qf[s2], S, 0, 0, 0);
            float mx = -1e30f;
#pragma unroll
            for (int r = 0; r < 16; ++r) { const int krow = (r & 3) + 8 * (r >> 2) + 4 * hh; const int dist = 128 - 32 * kt + q - krow;
                const float sv = (dist >= 0 && dist <= 128) ? S[r] * sc - slope2 * (float)dist : -1e30f; S[r] = sv; mx = fmaxf(mx, sv); }
            mx = fmaxf(mx, __shfl_xor(mx, 32));
            const float m_new = fmaxf(m_run, mx), alpha = exp2f(m_run - m_new); float rs = 0.f;
#pragma unroll
            for (int r = 0; r < 16; ++r) { const float p = exp2f(S[r] - m_new); S[r] = p; rs += p; }
            rs += __shfl_xor(rs, 32);
            l_run = l_run * alpha + rs; m_run = m_new;
#pragma unroll
            for (int r = 0; r < 16; ++r) { O0[r] *= alpha; O1[r] *= alpha; }
            bf16x8 Pf[2];
#pragma unroll
            for (int s2 = 0; s2 < 2; ++s2) { u32x4 wv; wv.x = pk2(S[8 * s2 + 0], S[8 * s2 + 1]); wv.y = pk2(S[8 * s2 + 2], S[8 * s2 + 3]); wv.z = pk2(S[8 * s2 + 4], S[8 * s2 + 5]); wv.w = pk2(S[8 * s2 + 6], S[8 * s2 + 7]); Pf[s2] = __builtin_bit_cast(bf16x8, wv); }
#pragma unroll
            for (int s2 = 0; s2 < 2; ++s2) { O0 = __builtin_amdgcn_mfma_f32_32x32x16_bf16(Vf[0][s2], Pf[s2], O0, 0, 0, 0); O1 = __builtin_amdgcn_mfma_f32_32x32x16_bf16(Vf[1][s2], Pf[s2], O1, 0, 0, 0); }
        }
        const float inv = 1.0f / l_run;
        bf16* op = OGb + ((size_t)g * M + rq0 + 32 * w + q) * 512 + h * 64 + 4 * hh;
#pragma unroll
        for (int rg = 0; rg < 4; ++rg) { u32x2 wv; wv.x = pk2(O0[4 * rg] * inv, O0[4 * rg + 1] * inv); wv.y = pk2(O0[4 * rg + 2] * inv, O0[4 * rg + 3] * inv); *(u32x2*)(op + 8 * rg) = wv;
            u32x2 w1; w1.x = pk2(O1[4 * rg] * inv, O1[4 * rg + 1] * inv); w1.y = pk2(O1[4 * rg + 2] * inv, O1[4 * rg + 3] * inv); *(u32x2*)(op + 32 + 8 * rg) = w1; }
        if (hh == 0) LSE[((size_t)g * M + rq0 + 32 * w + q) * 8 + h] = (m_run + log2f(l_run)) * 0.6931471805599453f;
        __syncthreads();
    }
}
__device__ __forceinline__ void p_merge(Frame& F) {
    const bf16* OGb = WSP(bf16, WS_RA + RA_OG); const float* LSE = WSP(float, WS_LSE); bf16* OM = WSP(bf16, WS_RA + RA_OM);
    for (int t = F.vcu * NWAVES + F.wave; t < M; t += NGW) { const int hd = F.lane >> 3; float ls[3]; size_t ro[3];
#pragma unroll
        for (int g = 0; g < 3; ++g) { const int rho = tok_to_rho(t, g); ro[g] = ((size_t)g * M + rho); ls[g] = LSE[ro[g] * 8 + hd]; }
        const float mx = fmaxf(ls[0], fmaxf(ls[1], ls[2])); float w[3], ws = 0.f;
#pragma unroll
        for (int g = 0; g < 3; ++g) { w[g] = __expf(ls[g] - mx); ws += w[g]; }
        const float inv = 1.0f / ws; float o[8];
#pragma unroll
        for (int j = 0; j < 8; ++j) o[j] = 0.f;
#pragma unroll
        for (int g = 0; g < 3; ++g) { const u32x4 x = *(const u32x4*)(OGb + ro[g] * 512 + 8 * F.lane); const float wg = w[g] * inv;
            o[0] += wg * bf_lo(x.x); o[1] += wg * bf_hi(x.x); o[2] += wg * bf_lo(x.y); o[3] += wg * bf_hi(x.y); o[4] += wg * bf_lo(x.z); o[5] += wg * bf_hi(x.z); o[6] += wg * bf_lo(x.w); o[7] += wg * bf_hi(x.w); }
        u32x4 r; r.x = pk2(o[0], o[1]); r.y = pk2(o[2], o[3]); r.z = pk2(o[4], o[5]); r.w = pk2(o[6], o[7]); *(u32x4*)(OM + (size_t)t * OW + 8 * F.lane) = r; }
}

constexpr int NPHASE = 26;

__global__ void __launch_bounds__(NTHR, 2) yoco_fwd(Args args) {
    extern __shared__ __attribute__((aligned(16))) unsigned char lds[];
    Frame F;
    F.lds = (LAS unsigned char*)lds;
    F.tid = threadIdx.x; F.lane = F.tid & 63; F.wave = __builtin_amdgcn_readfirstlane(F.tid >> 6);
    { const int bx = blockIdx.x; F.vcu = (bx % 8) * (NWG / 8) + bx / 8; }
    F.ws = args.ws;
    volatile LAS unsigned* MISC = (volatile LAS unsigned*)(F.lds + LDS_BYTES - 64);
    if (F.tid < 16) MISC[F.tid] = 0u;
    __syncthreads();
    const int lo = args.ph_lo, hi = args.ph_hi;
    XcdBarrier bar; bar.bar = (unsigned*)(F.ws + WS_CTL) + 4096; bar.x = 0; bar.st = nullptr;
    if (hi - lo > 1) bar = xcd_barrier_post((unsigned*)(F.ws + WS_CTL) + 4096, MISC + 8);
#ifndef PROBE_G2
#define PROBE_G2 0
#endif
#ifndef DUP_MASK
#define DUP_MASK 0u
#endif
#ifndef PH_MASK
#define PH_MASK 0xFFFFFFFFu
#endif
#define IN(k) (((PH_MASK >> (k)) & 1u) && lo <= (k) && (k) < hi)
#define REP(k) for (int rep = 0, nrep = 1 + (int)((args.dup >> (k)) & 1u); rep < nrep; ++rep)
#define SEAM(k) do { if (IN(k) && IN((k) + 1)) xcd_barrier(bar); } while (0)

    const bool cv_first = ((F.vcu >> 5) & 1) == 0;
#define CONV_L0(part) convert_experts(F, args.in[15], args.in[16], args.in[17], args.in[18], args.in[19], args.in[20], 0, part, 3)
#define CONV_L1(part) convert_experts(F, args.in[15] + (size_t)NE * D * DE, args.in[16] + (size_t)NE * D * DE, args.in[17] + (size_t)NE * D * DE, args.in[18] + (size_t)D * DE, args.in[19] + (size_t)D * DE, args.in[20] + (size_t)D * DE, 1, part, 3)
    if (IN(0)) { p0_prologue(F, args); } SEAM(0);
    if (IN(1)) { if (cv_first) { CONV_L0(0); __syncthreads(); } SchedDense8 S{WSP(unsigned char, WS_RA + RA_XB), WSP(unsigned char, WS_WIN), D, D, D, M / 256, 8, F.vcu}; EpiXZ E{WSP(bf16, WS_RA + RA_XR), WSP(bf16, WS_RA + RA_GG)}; gemm_fast8(F.lds, S, E); if (!cv_first) { __syncthreads(); CONV_L0(0); } } SEAM(1);
    if (IN(2)) { p_conv(F, args.in[2], args.in[3]); } SEAM(2);
    if (IN(3)) { if (cv_first) { CONV_L0(1); __syncthreads(); } SchedGate S{WSP(bf16, WS_RA + RA_XC), WSP(bf16, WS_WG), F.vcu}; EpiGate E{WSP(bf16, WS_RA + RA_XC), args.in[5], args.in[7], args.in[8], WSP(bf16, WS_RA + RA_LA), WSP(bf16, WS_RA + RA_U)}; GEMM_PHASE(F.lds, S, E); if (!cv_first) { __syncthreads(); CONV_L0(1); } } SEAM(3);
    if (IN(4)) { p_scan1(F); } SEAM(4);
    if (IN(5)) { p_scan2(F); } SEAM(5);
    if (IN(6)) { p_scan3(F); } SEAM(6);
    if (IN(7)) { if (cv_first) { CONV_L0(2); __syncthreads(); } SchedDense S{WSP(bf16, WS_RA + RA_YB), WSP(bf16, WS_WOUT), D, D, D, M / 256, 4, F.vcu}; EpiResF32 E{args.in[0], WSP(float, WS_V), D}; GEMM_PHASE(F.lds, S, E); if (!cv_first) { __syncthreads(); CONV_L0(2); } } SEAM(7);
    if (IN(8)) { p_ln(F, WSP(float, WS_V), args.in[21] + 0 * D, args.in[22] + 0 * D, WSP(float, WS_HA), WSP(bf16, WS_HAB)); } SEAM(8);
    if (IN(9)) { SchedDense S{WSP(bf16, WS_HAB), WSP(bf16, WS_WR), D, D, D, M / 256, 1, F.vcu}; EpiF32 E{WSP(float, WS_LOGITS), NE}; GEMM_PHASE(F.lds, S, E); } SEAM(9);
    if (IN(10)) { p_route(F, args.in[14]); } SEAM(10);
    if (IN(11)) { p_sort(F); } SEAM(11);
    if (IN(12)) { if (cv_first) { CONV_L1(0); __syncthreads(); } const int nrbt = *WSP(int, WS_META); SchedG1 S{WSP(unsigned char, WS_HQ), WSP(unsigned char, WS_W13), WSP(int, WS_ROWA), WSP(int, WS_BLKE), nrbt, F.vcu, moe_unit_experts(F, WSP(int, WS_BLKE), nrbt, 1), moe_row_table(F, WSP(int, WS_ROWA), nrbt)}; EpiSwiGLU E{WSP(unsigned char, WS_HID), F.lds + LDS_EPI}; gemm_fast8(F.lds, S, E); if (!cv_first) { __syncthreads(); CONV_L1(0); } } SEAM(12);
    if (IN(13)) { if (cv_first) { CONV_L1(1); __syncthreads(); } const int nrbt = *WSP(int, WS_META); SchedG2 S{WSP(unsigned char, WS_HID), WSP(unsigned char, WS_W2), WSP(int, WS_BLKE), nrbt, F.vcu, moe_unit_experts(F, WSP(int, WS_BLKE), nrbt, 2), args.rt256, args.rt256, args.rt256}; EpiScatter E{WSP(bf16, WS_RA), 0, F.lds + LDS_EPI}; gemm_fast8(F.lds, S, E); if (!cv_first) { __syncthreads(); CONV_L1(1); } } SEAM(13);
    if (IN(14)) { p_combine(F, WSP(float, WS_HA), args.in[21] + 1 * D, args.in[22] + 1 * D, WSP(float, WS_HB), WSP(unsigned char, WS_HQ)); } SEAM(14);
    if (IN(15)) { if (cv_first) { CONV_L1(2); __syncthreads(); } EpiQKV E{WSP(bf16, WS_RA + RA_QK), WSP(bf16, WS_RA + RA_VT), F.lds + LDS_EPI}; for (int g = 0; g < 3; ++g) { SchedQK S{WSP(unsigned char, WS_HQ), WSP(unsigned char, WS_WQK), g, D << (2 * g), F.vcu}; gemm_fast8(F.lds, S, E); } for (int g = 0; g < 3; ++g) { SchedVT S{WSP(unsigned char, WS_HQ), WSP(unsigned char, WS_WQK) + (size_t)3072 * D, g, D << (2 * g), F.vcu}; gemm_fast8(F.lds, S, E); } if (!cv_first) { __syncthreads(); CONV_L1(2); } } SEAM(15);
    if (IN(16)) { p_attn(F); } SEAM(16);
    if (IN(17)) { p_merge(F); } SEAM(17);
    if (IN(18)) { SchedDense S{WSP(bf16, WS_RA + RA_OM), WSP(bf16, WS_WO), OW, OW, OW, M / 256, 4, F.vcu}; EpiResF32 E{WSP(float, WS_HB), WSP(float, WS_V), D}; GEMM_PHASE(F.lds, S, E); } SEAM(18);
    if (IN(19)) { p_ln(F, WSP(float, WS_V), args.in[21] + 2 * D, args.in[22] + 2 * D, WSP(float, WS_HA), WSP(bf16, WS_HAB)); } SEAM(19);
    if (IN(20)) { SchedDense S{WSP(bf16, WS_HAB), WSP(bf16, WS_WR) + (size_t)NE * D, D, D, D, M / 256, 1, F.vcu}; EpiF32 E{WSP(float, WS_LOGITS), NE}; GEMM_PHASE(F.lds, S, E); } SEAM(20);
    if (IN(21)) { p_route(F, args.in[14] + NE); } SEAM(21);
    if (IN(22)) { p_sort(F); } SEAM(22);
    if (IN(23)) { const int nrbt = *WSP(int, WS_META); SchedG1 S{WSP(unsigned char, WS_HQ), WSP(unsigned char, WS_W13) + W13_LB, WSP(int, WS_ROWA), WSP(int, WS_BLKE), nrbt, F.vcu, moe_unit_experts(F, WSP(int, WS_BLKE), nrbt, 1), moe_row_table(F, WSP(int, WS_ROWA), nrbt)}; EpiSwiGLU E{WSP(unsigned char, WS_HID), F.lds + LDS_EPI}; gemm_fast8(F.lds, S, E); } SEAM(23);
    if (IN(24)) { const int nrbt = *WSP(int, WS_META); SchedG2 S{WSP(unsigned char, WS_HID), WSP(unsigned char, WS_W2) + W2_LB, WSP(int, WS_BLKE), nrbt, F.vcu, moe_unit_experts(F, WSP(int, WS_BLKE), nrbt, 2), args.rt256, args.rt256, args.rt256}; EpiScatter E{WSP(bf16, WS_RA), 0, F.lds + LDS_EPI}; gemm_fast8(F.lds, S, E); } SEAM(24);
    if (IN(25)) { p_combine(F, WSP(float, WS_HA), args.in[21] + 3 * D, args.in[22] + 3 * D, args.out, nullptr); }
#undef IN
#undef SEAM
}

extern "C" void kernel_launch(void* const* d_in, const int* in_sizes, int n_in, void* d_out, int out_size, void* d_ws, size_t ws_size, hipStream_t stream) {
    static int ok = 0;
    if (ok == 0) {
        if (n_in != 23 || in_sizes[0] != M * D || out_size != M * D || ws_size < WS_END) { fprintf(stderr, "kernel_launch: unexpected shapes (n_in %d, in0 %d, out %d, ws %zu < %zu)\n", n_in, n_in > 0 ? in_sizes[0] : -1, out_size, ws_size, (size_t)WS_END); ok = -1; return; }
        if (hipFuncSetAttribute((const void*)yoco_fwd, hipFuncAttributeMaxDynamicSharedMemorySize, LDS_BYTES) != hipSuccess) { fprintf(stderr, "kernel_launch: hipFuncSetAttribute failed\n"); ok = -1; return; }
        int per_cu = 0;
        if (hipOccupancyMaxActiveBlocksPerMultiprocessor(&per_cu, (const void*)yoco_fwd, NTHR, LDS_BYTES) != hipSuccess || per_cu < 1) fprintf(stderr, "kernel_launch: occupancy query says %d\n", per_cu);
        (void)hipGetLastError();
        ok = 1;
    }
    if (ok < 0) return;
    if (hipMemsetAsync((char*)d_ws + WS_CTL, 0, CTL_ZERO_BYTES, stream) != hipSuccess) return;
    Args a{};
    for (int i = 0; i < 23; ++i) a.in[i] = (const float*)d_in[i];
    a.out = (float*)d_out; a.ws = (unsigned char*)d_ws; a.dup = 0u; a.rt256 = 256;
#if MK_ONE_LAUNCH
    a.ph_lo = 0; a.ph_hi = NPHASE;
    hipLaunchKernelGGL(yoco_fwd, dim3(NWG), dim3(NTHR), LDS_BYTES, stream, a);
#else
    for (int p = 0; p < NPHASE; ++p) { a.ph_lo = p; a.ph_hi = p + 1; hipLaunchKernelGGL(yoco_fwd, dim3(NWG), dim3(NTHR), LDS_BYTES, stream, a); }
#endif
}
```
